# Optimizing an MI355X kernel written in HIP

```python
import math
import jax
import jax.numpy as jnp
from jax import lax
import numpy as np

D_MODEL = 2048
BATCH = 2
SEQ = 8192
DEPTH = 2

GRID_W = 64
CTX_LEN = 256
NORM_EPS = 1e-6
N_MOD = 6

SHORT_CONV = 3
CONV_W = 512

SSD_HEADS = 8
SSD_HEAD_DIM = 64
SSD_INNER = SSD_HEADS * SSD_HEAD_DIM
SSD_STATE = 128
SSD_GROUPS = 2
SSD_CHUNK = 128
SSD_XBC = SSD_INNER + 2 * SSD_GROUPS * SSD_STATE

DA_HEADS = 8
DA_HEAD_DIM = 64
DA_V_DIM = 2 * DA_HEAD_DIM
DA_QK = DA_HEADS * 2 * DA_HEAD_DIM
DA_WIDTH = DA_HEADS * DA_V_DIM
DA_SCALE = DA_HEAD_DIM ** -0.5
Q_BLOCK = 128
ROPE_THETA = 10000.0

MIX_WIDTH = CONV_W + SSD_INNER + DA_WIDTH

COL_CONV = 0
COL_Z = COL_CONV + 3 * CONV_W
COL_Q = COL_Z + SSD_INNER
COL_XBC = COL_Q + DA_QK
COL_DT = COL_XBC + SSD_XBC
COL_K = COL_DT + 2 * SSD_HEADS
COL_V = COL_K + DA_QK
IN_COLS = COL_V + DA_WIDTH
CTX_STATE_COL = COL_XBC

FFN_DENSE = 5632
N_EXPERTS = 8
TOP_K = 2
FFN_EXPERT = 2816

kernel_name = 'hybrid_parallel_group_flow_block'


def _rms(x, g):
    xf = x.astype(jnp.float32)
    y = xf * lax.rsqrt(jnp.mean(xf * xf, axis=-1, keepdims=True) + NORM_EPS)
    return (y * g.astype(jnp.float32)).astype(x.dtype)


def _modulate(x, g, shift, scale):
    return _rms(x, g) * (1 + scale) + shift


def _cols(p, lo, width, base):
    return p[..., lo - base: lo - base + width]


def _short_conv(u, w, b=None):
    k = w.shape[0]
    n = u.shape[1]
    pad = k // 2
    up = jnp.pad(u, ((0, 0), (pad, pad), (0, 0)))
    y = up[:, 0:n] * w[0]
    for j in range(1, k):
        y = y + up[:, j:j + n] * w[j]
    if b is not None:
        y = y + b
    return y


def _axial_rope_tables(n_tokens):
    rows = n_tokens // GRID_W
    row = jnp.repeat(jnp.arange(rows, dtype=jnp.float32), GRID_W)
    col = jnp.broadcast_to(jnp.arange(GRID_W, dtype=jnp.float32), (rows, GRID_W)).reshape(-1)
    n_freq = DA_HEAD_DIM // 4
    inv = ROPE_THETA ** (-jnp.arange(n_freq, dtype=jnp.float32) / n_freq)
    ang_r = row[:, None] * inv
    ang_c = col[:, None] * inv
    ex = lambda a: a[:, None, None, :]
    return (ex(jnp.cos(ang_r)), ex(jnp.sin(ang_r)), ex(jnp.cos(ang_c)), ex(jnp.sin(ang_c)))


def _rope2d(t, tabs):
    cr, sr, cc, sc = tabs
    f = DA_HEAD_DIM // 4
    h = DA_HEAD_DIM // 2
    tf = t.astype(jnp.float32)

    def rot(seg, cos, sin):
        a1, a2 = seg[..., :f], seg[..., f:]
        return jnp.concatenate([a1 * cos - a2 * sin, a2 * cos + a1 * sin], axis=-1)

    return jnp.concatenate([rot(tf[..., :h], cr, sr), rot(tf[..., h:], cc, sc)], axis=-1).astype(t.dtype)


def _conv_mixer(p, w):
    bg = _cols(p, COL_CONV, CONV_W, 0)
    cg = _cols(p, COL_CONV + CONV_W, CONV_W, 0)
    hv = _cols(p, COL_CONV + 2 * CONV_W, CONV_W, 0)
    return bg * _short_conv(cg * hv, w)


def _segsum(a):
    t = a.shape[-1]
    xr = jnp.broadcast_to(a[..., :, None], a.shape + (t,))
    xr = jnp.where(jnp.tril(jnp.ones((t, t), dtype=bool), -1), xr, 0.0)
    s = jnp.cumsum(xr, axis=-2)
    return jnp.where(jnp.tril(jnp.ones((t, t), dtype=bool), 0), s, -jnp.inf)


def _ssd_states(xdt, da, bm, init):
    b, s, h, p = xdt.shape
    n = bm.shape[-1]
    c = s // SSD_CHUNK
    x = xdt.reshape(b, c, SSD_CHUNK, h, p)
    bc = bm.reshape(b, c, SSD_CHUNK, h, n)
    a = jnp.moveaxis(da.reshape(b, c, SSD_CHUNK, h), -1, 1)
    a_cum = jnp.cumsum(a, axis=-1)
    decay = jnp.exp(a_cum[..., -1:] - a_cum)
    states = jnp.einsum('bclhn,bhcl,bclhp->bchpn', bc, decay, x)
    states = jnp.concatenate([init[:, None], states], axis=1)
    chunk_decay = jnp.exp(_segsum(jnp.pad(a_cum[..., -1], ((0, 0), (0, 0), (1, 0)))))
    new = jnp.einsum('bhzc,bchpn->bzhpn', chunk_decay, states)
    return x, bc, a, a_cum, new[:, :-1], new[:, -1]


def _ssd_scan(xdt, da, bm, cm, init):
    b, s, h, p = xdt.shape
    x, bc, a, a_cum, prev, final = _ssd_states(xdt, da, bm, init)
    cc = cm.reshape(bc.shape)
    decay_in = jnp.exp(_segsum(a))
    g = jnp.einsum('bclhn,bcshn->bhcls', cc, bc) * decay_in
    y_diag = jnp.einsum('bhcls,bcshp->bclhp', g, x)
    y_off = jnp.einsum('bclhn,bchpn->bclhp', cc, prev) * jnp.exp(a_cum).transpose(0, 2, 3, 1)[..., None]
    return (y_diag + y_off).reshape(b, s, h, p), final


def _ssd_inputs(p, base, conv_w, conv_b, dt_bias):
    b, n = p.shape[:2]
    xbc = jax.nn.silu(_short_conv(_cols(p, COL_XBC, SSD_XBC, base), conv_w, conv_b)).astype(jnp.float32)
    gs = SSD_GROUPS * SSD_STATE
    rep = SSD_HEADS // SSD_GROUPS
    xh = xbc[..., :SSD_INNER].reshape(b, n, SSD_HEADS, SSD_HEAD_DIM)
    bm = jnp.repeat(xbc[..., SSD_INNER:SSD_INNER + gs].reshape(b, n, SSD_GROUPS, SSD_STATE), rep, axis=2)
    cm = jnp.repeat(xbc[..., SSD_INNER + gs:].reshape(b, n, SSD_GROUPS, SSD_STATE), rep, axis=2)
    dt_raw = _cols(p, COL_DT, 2 * SSD_HEADS, base).astype(jnp.float32).reshape(b, n, 2, SSD_HEADS)
    dt = jax.nn.softplus(dt_raw + dt_bias.astype(jnp.float32))
    return xh, bm, cm, dt


def _ssd_gate_norm(y, z, g):
    b, n = y.shape[:2]
    u = y.reshape(b, n, SSD_INNER) * jax.nn.silu(z.astype(jnp.float32))
    u = u.reshape(b, n, SSD_GROUPS, SSD_INNER // SSD_GROUPS)
    u = u * lax.rsqrt(jnp.mean(u * u, axis=-1, keepdims=True) + NORM_EPS)
    return (u.reshape(b, n, SSD_INNER) * g.astype(jnp.float32)).astype(z.dtype)


def _ssd_mixer(pl, pc, base_c, conv_w, conv_b, a_log, dt_bias, d_skip, norm_g, ctx_out):
    xl, bl, cl, dtl = _ssd_inputs(pl, 0, conv_w, conv_b, dt_bias)
    xc, bc, cc, dtc = _ssd_inputs(pc, base_c, conv_w, conv_b, dt_bias)
    a = -jnp.exp(a_log.astype(jnp.float32))
    d = d_skip.astype(jnp.float32)[:, None]
    yl = d * xl
    yc = d * xc
    init = jnp.zeros((xc.shape[0], SSD_HEADS, SSD_HEAD_DIM, SSD_STATE), jnp.float32)
    for di in range(2):
        fl = (lambda t: jnp.flip(t, axis=1)) if di == 1 else (lambda t: t)
        dt_c = dtc[:, :, di]
        dt_l = dtl[:, :, di]
        xdt_c, da_c, b_c = fl(xc * dt_c[..., None]), fl(dt_c * a[di]), fl(bc)
        if ctx_out:
            y_d, h_c = _ssd_scan(xdt_c, da_c, b_c, fl(cc), init)
            yc = yc + fl(y_d)
        else:
            h_c = _ssd_states(xdt_c, da_c, b_c, init)[-1]
        y_d, _ = _ssd_scan(fl(xl * dt_l[..., None]), fl(dt_l * a[di]), fl(bl), fl(cl), h_c)
        yl = yl + fl(y_d)
    out_l = _ssd_gate_norm(yl, _cols(pl, COL_Z, SSD_INNER, 0), norm_g)
    if not ctx_out:
        return out_l, None
    return out_l, _ssd_gate_norm(yc, _cols(pc, COL_Z, SSD_INNER, 0), norm_g)


def _diff_mix(q, k, v, lam):
    s = jnp.einsum('bhmqd,bhmkd->bhmqk', q, k).astype(jnp.float32) * DA_SCALE
    p = jax.nn.softmax(s, axis=-1)
    w = p[:, :, 0] - lam * p[:, :, 1]
    return jnp.einsum('bhqk,bhkv->bhqv', w.astype(v.dtype), v)


def _head_out(o, g, lam_init):
    b, n = o.shape[:2]
    return (_rms(o, g) * (1.0 - lam_init)).reshape(b, n, DA_WIDTH)


def _diff_attention(pl, pc, base_c, da_lambda, da_subln, lam_init, rope, ctx_out):
    b, n_lat = pl.shape[:2]
    n_ctx = pc.shape[1]
    qk_shape = lambda n: (b, n, DA_HEADS, 2, DA_HEAD_DIM)
    q_l = _rope2d(_cols(pl, COL_Q, DA_QK, 0).reshape(qk_shape(n_lat)), rope)
    k_l = _rope2d(_cols(pl, COL_K, DA_QK, 0).reshape(qk_shape(n_lat)), rope)
    v_l = _cols(pl, COL_V, DA_WIDTH, 0).reshape(b, n_lat, DA_HEADS, DA_V_DIM)
    k_c = _cols(pc, COL_K, DA_QK, base_c).reshape(qk_shape(n_ctx))
    v_c = _cols(pc, COL_V, DA_WIDTH, base_c).reshape(b, n_ctx, DA_HEADS, DA_V_DIM)
    lv = da_lambda.astype(jnp.float32)
    lam = jnp.exp(jnp.sum(lv[0] * lv[1])) - jnp.exp(jnp.sum(lv[2] * lv[3])) + lam_init
    k_all = jnp.concatenate([k_c, k_l], axis=1).transpose(0, 2, 3, 1, 4)
    v_all = jnp.concatenate([v_c, v_l], axis=1).transpose(0, 2, 1, 3)
    nb = n_lat // Q_BLOCK
    qb = q_l.reshape(b, nb, Q_BLOCK, DA_HEADS, 2, DA_HEAD_DIM).transpose(1, 0, 3, 4, 2, 5)
    o = lax.map(lambda q: _diff_mix(q, k_all, v_all, lam), qb)
    o_l = o.transpose(1, 0, 3, 2, 4).reshape(b, n_lat, DA_HEADS, DA_V_DIM)
    y_l = _head_out(o_l, da_subln, lam_init)
    if not ctx_out:
        return y_l, None
    q_c = _cols(pc, COL_Q, DA_QK, 0).reshape(qk_shape(n_ctx))
    o_c = _diff_mix(q_c.transpose(0, 2, 3, 1, 4), k_c.transpose(0, 2, 3, 1, 4),
                    v_c.transpose(0, 2, 1, 3), lam).transpose(0, 2, 1, 3)
    return y_l, _head_out(o_c, da_subln, lam_init)


def _mixer(hl, hc, w_in, conv_w, ssd_conv_w, ssd_conv_b, ssd_a_log, ssd_dt_bias, ssd_d, ssd_norm,
           da_lambda, da_subln, w_out, lam_init, rope, ctx_out):
    base_c = 0 if ctx_out else CTX_STATE_COL
    pl = hl @ w_in
    pc = hc @ w_in[:, base_c:]
    ya_l = _conv_mixer(pl, conv_w)
    yb_l, yb_c = _ssd_mixer(pl, pc, base_c, ssd_conv_w, ssd_conv_b, ssd_a_log, ssd_dt_bias,
                            ssd_d, ssd_norm, ctx_out)
    yc_l, yc_c = _diff_attention(pl, pc, base_c, da_lambda, da_subln, lam_init, rope, ctx_out)
    out_l = jnp.concatenate([ya_l, yb_l, yc_l], axis=-1) @ w_out
    if not ctx_out:
        return out_l, None
    ya_c = _conv_mixer(pc, conv_w)
    out_c = jnp.concatenate([ya_c, yb_c, yc_c], axis=-1) @ w_out
    return out_l, out_c


def _swiglu(h, wg, wu, wd):
    return (jax.nn.silu(h @ wg) * (h @ wu)) @ wd


def _moe(h, w_router, b_router, w_gate, w_up, w_down):
    logits = (h @ w_router + b_router).astype(jnp.float32)
    top_v, top_i = lax.top_k(logits, TOP_K)
    probs = jax.nn.softmax(top_v, axis=-1)
    combine = jnp.sum(jax.nn.one_hot(top_i, N_EXPERTS, dtype=jnp.float32) * probs[..., None], axis=-2)
    y = jnp.zeros_like(h)
    for e in range(N_EXPERTS):
        y = y + combine[..., e:e + 1].astype(h.dtype) * _swiglu(h, w_gate[e], w_up[e], w_down[e])
    return y


def setup_inputs(seed: int = 0) -> dict:
    key = jax.random.key(seed)
    ks = iter(jax.random.split(key, 32))
    f32 = jnp.float32
    nrm = lambda shape, scale: jax.random.normal(next(ks), shape, f32) * scale
    D = D_MODEL
    L = DEPTH
    nd = (DEPTH + 1) // 2
    nm = DEPTH // 2
    x = nrm((BATCH, SEQ, D), 1.0)
    c = nrm((BATCH, D), 1.0)
    ctx = nrm((BATCH, CTX_LEN, D), 1.0)
    c_ctx = nrm((D,), 1.0)
    w_mod = nrm((L, D, N_MOD * D), 0.3 * D ** -0.5)
    b_mod = nrm((L, N_MOD * D), 0.02)
    g_mix = 1.0 + nrm((L, D), 0.02)
    g_ffn = 1.0 + nrm((L, D), 0.02)
    w_in = nrm((L, D, IN_COLS), D ** -0.5)
    conv_w = nrm((L, SHORT_CONV, CONV_W), SHORT_CONV ** -0.5)
    ssd_conv_w = nrm((L, SHORT_CONV, SSD_XBC), SHORT_CONV ** -0.5)
    ssd_conv_b = nrm((L, SSD_XBC), 0.02)
    ssd_a_log = jnp.log(jax.random.uniform(next(ks), (L, 2, SSD_HEADS), f32, 1.0, 16.0))
    dt0 = jnp.exp(jax.random.uniform(next(ks), (L, 2, SSD_HEADS), f32, math.log(1e-3), math.log(1e-1)))
    ssd_dt_bias = dt0 + jnp.log(-jnp.expm1(-dt0))
    ssd_d = 1.0 + nrm((L, SSD_HEADS), 0.1)
    ssd_norm = 1.0 + nrm((L, SSD_INNER), 0.02)
    da_lambda = nrm((L, 4, DA_HEAD_DIM), 0.1)
    da_subln = 1.0 + nrm((L, DA_V_DIM), 0.02)
    w_out = nrm((L, MIX_WIDTH, D), MIX_WIDTH ** -0.5)
    ffn_w_gate = nrm((nd, D, FFN_DENSE), D ** -0.5)
    ffn_w_up = nrm((nd, D, FFN_DENSE), D ** -0.5)
    ffn_w_down = nrm((nd, FFN_DENSE, D), FFN_DENSE ** -0.5)
    moe_w_router = nrm((nm, D, N_EXPERTS), D ** -0.5)
    moe_b_router = nrm((nm, N_EXPERTS), 0.01)
    moe_w_gate = nrm((nm, N_EXPERTS, D, FFN_EXPERT), D ** -0.5)
    moe_w_up = nrm((nm, N_EXPERTS, D, FFN_EXPERT), D ** -0.5)
    moe_w_down = nrm((nm, N_EXPERTS, FFN_EXPERT, D), FFN_EXPERT ** -0.5)
    g_final = 1.0 + nrm((D,), 0.02)
    return {'x': x, 'c': c, 'ctx': ctx, 'c_ctx': c_ctx, 'w_mod': w_mod, 'b_mod': b_mod,
            'g_mix': g_mix, 'g_ffn': g_ffn, 'w_in': w_in, 'conv_w': conv_w,
            'ssd_conv_w': ssd_conv_w, 'ssd_conv_b': ssd_conv_b, 'ssd_a_log': ssd_a_log,
            'ssd_dt_bias': ssd_dt_bias, 'ssd_d': ssd_d, 'ssd_norm': ssd_norm,
            'da_lambda': da_lambda, 'da_subln': da_subln, 'w_out': w_out,
            'ffn_w_gate': ffn_w_gate, 'ffn_w_up': ffn_w_up, 'ffn_w_down': ffn_w_down,
            'moe_w_router': moe_w_router, 'moe_b_router': moe_b_router, 'moe_w_gate': moe_w_gate,
            'moe_w_up': moe_w_up, 'moe_w_down': moe_w_down, 'g_final': g_final}


def reference(x, c, ctx, c_ctx, w_mod, b_mod, g_mix, g_ffn, w_in, conv_w, ssd_conv_w, ssd_conv_b,
              ssd_a_log, ssd_dt_bias, ssd_d, ssd_norm, da_lambda, da_subln, w_out,
              ffn_w_gate, ffn_w_up, ffn_w_down, moe_w_router, moe_b_router, moe_w_gate,
              moe_w_up, moe_w_down, g_final):
    b, n_lat, d_model = x.shape
    rope = _axial_rope_tables(n_lat)
    xl, xc = x, ctx
    for i in range(DEPTH):
        ctx_out = i < DEPTH - 1
        lam_init = 0.8 - 0.6 * math.exp(-0.3 * i)
        ml = (jax.nn.silu(c) @ w_mod[i] + b_mod[i]).reshape(b, N_MOD, 1, d_model)
        mc = (jax.nn.silu(c_ctx) @ w_mod[i] + b_mod[i]).reshape(N_MOD, d_model)
        hl = _modulate(xl, g_mix[i], ml[:, 0], ml[:, 1])
        hc = _modulate(xc, g_mix[i], mc[0], mc[1])
        ol, oc = _mixer(hl, hc, w_in[i], conv_w[i], ssd_conv_w[i], ssd_conv_b[i], ssd_a_log[i],
                        ssd_dt_bias[i], ssd_d[i], ssd_norm[i], da_lambda[i], da_subln[i], w_out[i],
                        lam_init, rope, ctx_out)
        xl = xl + ml[:, 2] * ol
        if i % 2 == 0:
            j = i // 2
            chan = lambda h: _swiglu(h, ffn_w_gate[j], ffn_w_up[j], ffn_w_down[j])
        else:
            j = i // 2
            chan = lambda h: _moe(h, moe_w_router[j], moe_b_router[j], moe_w_gate[j],
                                  moe_w_up[j], moe_w_down[j])
        xl = xl + ml[:, 5] * chan(_modulate(xl, g_ffn[i], ml[:, 3], ml[:, 4]))
        if ctx_out:
            xc = xc + mc[2] * oc
            xc = xc + mc[5] * chan(_modulate(xc, g_ffn[i], mc[3], mc[4]))
    return _rms(xl, g_final)
```

```cpp
#ifndef DBG
#define DBG 0
#endif
#ifndef DBG_L
#define DBG_L 0
#endif
#ifndef DBG_REPORT
#define DBG_REPORT -1
#endif
#ifndef DBG_MASK
#define DBG_MASK 31
#endif
#ifndef SIMPLE_BAR
#define SIMPLE_BAR 0
#endif
#include <hip/hip_runtime.h>
#include <cstdio>
#include <cstdint>

#define GAS __attribute__((address_space(1)))
#define LAS __attribute__((address_space(3)))
typedef unsigned short bf16;
typedef unsigned v4u __attribute__((ext_vector_type(4)));
typedef unsigned v2u __attribute__((ext_vector_type(2)));
typedef float f32x4 __attribute__((ext_vector_type(4)));
typedef float f32x2 __attribute__((ext_vector_type(2)));
typedef float f32x16 __attribute__((ext_vector_type(16)));
typedef short bf16x8 __attribute__((ext_vector_type(8)));
typedef short s16x4 __attribute__((ext_vector_type(4)));
typedef GAS unsigned gu32;
#define RLX_AGENT __ATOMIC_RELAXED, __HIP_MEMORY_SCOPE_AGENT
#define LDS_WAIT() asm volatile("s_waitcnt lgkmcnt(0)" ::: "memory")
#define VM_WAIT() asm volatile("s_waitcnt vmcnt(0)" ::: "memory")

constexpr int D = 2048, NB = 2, SEQ = 8192, CTXL = 256;
constexpr int NLAT = NB * SEQ, NCTX = NB * CTXL, T = NLAT + NCTX;
constexpr int KVLEN = CTXL + SEQ;
constexpr int IN_COLS = 6160, NIN = 6400;
constexpr int COL_Z = 1536, COL_Q = 2048, COL_XBC = 3072, COL_DT = 4096, COL_K = 4112, COL_V = 5136;
constexpr int FFD = 5632, FFE = 2816, NE = 8;
constexpr int NCH = 66;
constexpr float NORM_EPS = 1e-6f;
constexpr int NWAVES = 8;

constexpr size_t MiB = 1u << 20;
constexpr size_t WS_CTL = 0, CTL_ZERO_BYTES = 1 * MiB;
constexpr size_t WS_MOD = 1 * MiB;
constexpr size_t WS_ROPE = WS_MOD + 512 * 1024;
constexpr size_t WS_TOT = WS_ROPE + 64 * 1024;
constexpr size_t WS_ROUTE = 2 * MiB;
constexpr size_t WS_W = 4 * MiB;
constexpr size_t SZ_WIN = (size_t)NIN * D * 2, SZ_WOUT = (size_t)D * D * 2, SZ_WGU = (size_t)2 * FFD * D * 2, SZ_WDN = (size_t)D * FFD * 2;
constexpr size_t SZ_MGU = (size_t)2 * FFE * D * 2, SZ_MDN = (size_t)D * FFE * 2;
constexpr size_t WS_WIN = WS_W, WS_WOUT = WS_WIN + 2 * SZ_WIN, WS_WGU = WS_WOUT + 2 * SZ_WOUT, WS_WDN = WS_WGU + SZ_WGU, WS_MGU = WS_WDN + SZ_WDN, WS_MDN = WS_MGU + NE * SZ_MGU;
constexpr size_t WS_XL = WS_MDN + NE * SZ_MDN;
constexpr size_t WS_H = WS_XL + (size_t)T * D * 4;
constexpr size_t WS_CAT = WS_H + (size_t)T * D * 2;
constexpr size_t WS_TMP = WS_CAT + (size_t)T * D * 2;
constexpr size_t WS_CONV = WS_TMP;
constexpr size_t WS_Z = WS_CONV + (size_t)T * 1536 * 2;
constexpr size_t WS_Q = WS_Z + (size_t)T * 512 * 2;
constexpr size_t WS_XBC = WS_Q + (size_t)T * 1024 * 2;
constexpr size_t WS_KB = WS_XBC + (size_t)T * 1024 * 2;
constexpr size_t WS_VB = WS_KB + (size_t)T * 1024 * 2;
constexpr size_t WS_DT = WS_VB + (size_t)T * 1024 * 2;
constexpr size_t WS_XBCC = WS_DT + (size_t)T * 16 * 4;
constexpr size_t WS_YD = WS_XBCC + (size_t)T * 1024 * 2;
constexpr size_t WS_CUM = WS_YD + (size_t)T * 512 * 4;
constexpr size_t WS_SB = WS_CUM + (size_t)T * 16 * 4;
constexpr size_t WS_HP = WS_SB + (size_t)32 * NCH * 8192 * 4;
constexpr size_t WS_TMP_END_MIX = WS_HP + (size_t)32 * NCH * 8192 * 2;
constexpr size_t WS_ACT = WS_TMP;
constexpr int MOE_MAXROWS = 2 * NLAT + NE * 256;
constexpr size_t WS_AG = WS_TMP;
constexpr size_t WS_MACT = WS_AG + (size_t)MOE_MAXROWS * D * 2;
constexpr size_t WS_TMP_END_MOE = WS_MACT + (size_t)MOE_MAXROWS * FFE * 2;
constexpr size_t WS_END = (WS_TMP_END_MIX > WS_TMP_END_MOE ? WS_TMP_END_MIX : WS_TMP_END_MOE);
static_assert(WS_ACT + (size_t)T * FFD * 2 <= WS_END, "act fits");
constexpr int CW_TMO = 0, CW_CODE = 1;
constexpr int CW_BAR = 4096;
constexpr int CW_CNT = 8192;
constexpr int CW_DIAG = 12288;

constexpr int RING_OFF = 0, RING_BYTES = 131072;
constexpr int LDSCTL_OFF = RING_BYTES, MISC_OFF = LDSCTL_OFF + 320;
constexpr int LDS_BYTES = 147456;

__device__ __forceinline__ unsigned f2bf(float f) { unsigned u = __builtin_bit_cast(unsigned, f); return (u + 0x7fffu + ((u >> 16) & 1u)) >> 16; }
__device__ __forceinline__ unsigned pk2(float lo, float hi) { return f2bf(lo) | (f2bf(hi) << 16); }
__device__ __forceinline__ unsigned cvtpk(float lo, float hi) { unsigned r; asm volatile("v_cvt_pk_bf16_f32 %0, %1, %2" : "=v"(r) : "v"(lo), "v"(hi)); return r; }
__device__ __forceinline__ float bf2f(unsigned short b) { return __builtin_bit_cast(float, ((unsigned)b) << 16); }
__device__ __forceinline__ float bflo(unsigned w) { return __builtin_bit_cast(float, w << 16); }
__device__ __forceinline__ float bfhi(unsigned w) { return __builtin_bit_cast(float, w & 0xffff0000u); }
__device__ __forceinline__ float fast_exp(float x) { return __builtin_amdgcn_exp2f(x * 1.4426950408889634f); }
__device__ __forceinline__ float silu_f(float x) { return x * __builtin_amdgcn_rcpf(1.0f + fast_exp(-x)); }
__device__ __forceinline__ float dpp_f(float v, const int ctrl_sel) {
    int r;
    switch (ctrl_sel) {
        case 0: r = __builtin_amdgcn_update_dpp(0, __builtin_bit_cast(int, v), 0xB1, 0xF, 0xF, true); break;
        case 1: r = __builtin_amdgcn_update_dpp(0, __builtin_bit_cast(int, v), 0x4E, 0xF, 0xF, true); break;
        case 2: r = __builtin_amdgcn_update_dpp(0, __builtin_bit_cast(int, v), 0x141, 0xF, 0xF, true); break;
        default: r = __builtin_amdgcn_update_dpp(0, __builtin_bit_cast(int, v), 0x140, 0xF, 0xF, true); break;
    }
    return __builtin_bit_cast(float, r);
}
__device__ __forceinline__ float half_sum(float v) {
    v += dpp_f(v, 0); v += dpp_f(v, 1); v += dpp_f(v, 2); v += dpp_f(v, 3);
    v += __builtin_bit_cast(float, __builtin_amdgcn_ds_swizzle(__builtin_bit_cast(int, v), 0x401F));
    return v;
}
__device__ __forceinline__ void swap32u(unsigned& a, unsigned& b) {
    asm volatile("s_nop 1\n\tv_permlane32_swap_b32 %0, %1\n\ts_nop 1" : "+v"(a), "+v"(b));
}
__device__ __forceinline__ void swap32(float v, float& x, float& y) {
    unsigned a = __builtin_bit_cast(unsigned, v), b = a; swap32u(a, b);
    x = __builtin_bit_cast(float, a); y = __builtin_bit_cast(float, b);
}
__device__ __forceinline__ float wave_sum(float v) {
    v = half_sum(v);
    float x, y; swap32(v, x, y); return x + y;
}
__device__ __forceinline__ float cross_max(float v) { float x, y; swap32(v, x, y); return fmaxf(x, y); }
__device__ __forceinline__ float cross_sum(float v) { float x, y; swap32(v, x, y); return x + y; }

__device__ __forceinline__ int fresh_tid() { int t = threadIdx.x; asm volatile("" : "+v"(t)); return t; }
__device__ __forceinline__ int fresh_s(int v) { asm volatile("" : "+s"(v)); return v; }
__device__ __forceinline__ unsigned char* fresh_ws(unsigned char* p) { asm volatile("" : "+s"(p)); return p; }
#define XB_TMO      128
#define XB_XCNT(j)  (256  + 64 * (j))
#define XB_XSUB(j)  (1280 + 64 * (j))
#define XB_XGEN(j)  (2304 + 64 * (j))
#define XB_TOP      3328
#define XB_TOPGEN   3392
#define XCD_BAR_WORDS 3456
#define XB_SPIN_CAP (1u << 22)

__device__ __forceinline__ unsigned xb_ld(unsigned* p)              { return __hip_atomic_load(p, __ATOMIC_RELAXED, __HIP_MEMORY_SCOPE_AGENT); }
__device__ __forceinline__ unsigned xb_add(unsigned* p, unsigned v) { return __hip_atomic_fetch_add(p, v, __ATOMIC_RELAXED, __HIP_MEMORY_SCOPE_AGENT); }
__device__ __forceinline__ unsigned xb_xcc_id() { return (unsigned)__builtin_amdgcn_s_getreg((3 << 11) | 20) & 0xFu; }
#define XB_SPIN(cond, bar) do { unsigned _sp = 0; while (cond) { __builtin_amdgcn_s_sleep(1); \
    if ((++_sp & 255u) == 0u) { if (xb_ld(&(bar)[XB_TMO])) break; if (_sp > XB_SPIN_CAP) { atomicAdd(&(bar)[XB_TMO], 1u); break; } } } } while (0)

struct XcdBarrier { unsigned* bar; unsigned x; volatile LAS unsigned* st; };

__device__ __forceinline__ XcdBarrier xcd_barrier_post(unsigned* bar, volatile LAS unsigned* st) {
    XcdBarrier b; b.bar = bar; b.x = xb_xcc_id(); b.st = st;
    if (threadIdx.x == 0) (void)xb_add(&bar[XB_XCNT(b.x)], 1u);
    return b;
}
__device__ __forceinline__ void xcd_barrier_complete(unsigned* bar, unsigned x, unsigned& nloc, unsigned& nx) {
    const unsigned G = gridDim.x * gridDim.y * gridDim.z;
    unsigned sum, cnt, mine, sp = 0u;
    for (;;) {
        sum = 0u; cnt = 0u; mine = 0u;
#pragma unroll
        for (unsigned j = 0; j < 16; ++j) { const unsigned c = xb_ld(&bar[XB_XCNT(j)]); sum += c; cnt += (c > 0u) ? 1u : 0u; mine = (j == x) ? c : mine; }
        if (sum == G) break;
        __builtin_amdgcn_s_sleep(1);
        if ((++sp & 255u) == 0u) { if (xb_ld(&bar[XB_TMO])) break; if (sp > XB_SPIN_CAP) { atomicAdd(&bar[XB_TMO], 1u); break; } }
    }
    nloc = mine > 0u ? mine : 1u; nx = cnt > 0u ? cnt : 1u;
}
__device__ __forceinline__ void xcd_barrier(const XcdBarrier& b) {
    asm volatile("s_waitcnt vmcnt(0)" ::: "memory");
    __syncthreads();
    if (fresh_tid() == 0) {
        unsigned* bar = b.bar;
        const unsigned bx = xb_xcc_id();
        __builtin_amdgcn_s_waitcnt(0);
        unsigned nloc = b.st[0], nx = b.st[1];
        if (nloc == 0u) { xcd_barrier_complete(bar, bx, nloc, nx); b.st[0] = nloc; b.st[1] = nx; }
        const unsigned old = xb_add(&bar[XB_XSUB(bx)], 1u);
        const unsigned gen = old / nloc;
        if (old + 1u == (gen + 1u) * nloc) {
            __builtin_amdgcn_fence(__ATOMIC_RELEASE, "agent");
            asm volatile("s_waitcnt vmcnt(0)" ::: "memory");
            const unsigned og = xb_add(&bar[XB_TOP], 1u);
            const unsigned tg = og / nx;
            if (og + 1u == (tg + 1u) * nx) xb_add(&bar[XB_TOPGEN], 1u);
            else XB_SPIN(xb_ld(&bar[XB_TOPGEN]) == tg, bar);
            __builtin_amdgcn_fence(__ATOMIC_ACQUIRE, "agent");
            xb_add(&bar[XB_XGEN(bx)], 1u);
            asm volatile("s_waitcnt vmcnt(0)" ::: "memory");
        } else {
            XB_SPIN(xb_ld(&bar[XB_XGEN(bx)]) == gen, bar);
            __builtin_amdgcn_fence(__ATOMIC_ACQUIRE, "agent");
            asm volatile("s_waitcnt vmcnt(0)" ::: "memory");
        }
    }
    __syncthreads();
}

#if SIMPLE_BAR
__device__ __forceinline__ void simple_barrier(unsigned* cnt, unsigned target) {
    asm volatile("s_waitcnt vmcnt(0)" ::: "memory");
    __syncthreads();
    if (fresh_tid() == 0) {
        __threadfence();
        asm volatile("s_waitcnt vmcnt(0)" ::: "memory");
        __hip_atomic_fetch_add(cnt, 1u, __ATOMIC_RELAXED, __HIP_MEMORY_SCOPE_AGENT);
        unsigned sp = 0;
        while (__hip_atomic_load(cnt, __ATOMIC_RELAXED, __HIP_MEMORY_SCOPE_AGENT) < target) { __builtin_amdgcn_s_sleep(2); if (++sp > (1u << 24)) break; }
        __threadfence();
        asm volatile("s_waitcnt vmcnt(0)" ::: "memory");
    }
    __syncthreads();
}
#endif
namespace pg8 {
constexpr int BM = 256, BK = 64, HALF = 128, HTB = HALF * BK * 2, STAGE_BYTES = 8 * HTB, NXCD = 8, WGM = 8;
__host__ __device__ __forceinline__ int lds_byte(int r, int c) { const int st = (r >> 4) * 2 + (c >> 5), rr = r & 15, cc = c & 31, ob = rr * 64 + cc * 2; return st * 1024 + (ob ^ (((ob >> 9) & 1) << 5)); }
__host__ __device__ __forceinline__ void stage_rc(int b, int& R, int& C) { const int st = b / 1024, sb = b % 1024, swz = sb ^ (((sb >> 9) & 1) << 5); R = (st >> 1) * 16 + swz / 64; C = (st & 1) * 32 + (swz % 64) / 2; }
__host__ __device__ __forceinline__ int perm32(int rho) { const int n = rho >> 4, i = rho & 15; return 8 * (i >> 2) + 4 * n + (i & 3); }

struct Unit { int pm, pn; };
struct OrderBase {
    int nM, nN, nwg, G, c;
    __device__ void init(int nM_, int nN_, int G_, int c_) { nM = nM_; nN = nN_; nwg = nM * nN; G = G_; c = c_; }
    __device__ bool next(int i, Unit& u) const {
        const long L = (long)i * G + c; if (L >= nwg) return false;
        int wgid = (int)L; { const int q = nwg / NXCD, r = nwg % NXCD, xcd = wgid % NXCD, off = wgid / NXCD; wgid = (xcd < r ? xcd * (q + 1) : r * (q + 1) + (xcd - r) * q) + off; }
        const int nig = WGM * nN, gid = wgid / nig, fm = gid * WGM, gsz = (nM - fm) < WGM ? (nM - fm) : WGM;
        u.pm = fm + ((wgid % nig) % gsz); u.pn = (wgid % nig) / gsz; return true;
    }
};
struct PlainSched : OrderBase {
    const char* A; const char* Bt; size_t tstep;
    __device__ __forceinline__ const char* abase(const Unit& u) const { return A + (size_t)u.pm * tstep; }
    __device__ __forceinline__ const char* bbase(const Unit& u) const { return Bt + (size_t)u.pn * tstep; }
};
struct MoeSched : OrderBase {
    const char* A; const char* Bt; size_t tstep, estride; int ps1, ps2, ps3, ps4, ps5, ps6, ps7;
    __device__ __forceinline__ int expert(int pm) const { return (pm >= ps1) + (pm >= ps2) + (pm >= ps3) + (pm >= ps4) + (pm >= ps5) + (pm >= ps6) + (pm >= ps7); }
    __device__ __forceinline__ const char* abase(const Unit& u) const { return A + (size_t)u.pm * tstep; }
    __device__ __forceinline__ const char* bbase(const Unit& u) const { return Bt + (size_t)expert(u.pm) * estride + (size_t)u.pn * tstep; }
};

template <class Epi, class Sched, bool ALIGN_EPI, bool SP2>
__device__ __forceinline__ void gemm_phase(LAS unsigned char* lds, const int K, const Sched& S, const Epi& E) {
    int tid = threadIdx.x; asm volatile("" : "+v"(tid)); const int wid = __builtin_amdgcn_readfirstlane(tid >> 6), lane = tid & 63, wr = wid >> 2, wc = wid & 3, fr = lane & 15, fq = lane >> 4;
    const int nt = K / BK;
    unsigned voffA[2];
#pragma unroll
    for (int i = 0; i < 2; ++i) { int R, C; stage_rc(tid * 16 + i * 8192, R, C); voffA[i] = (unsigned)(R * K + C) * 2u; }
#define voffB voffA
    const size_t kstep = (size_t)(BK * 2);
    const size_t hstep = (size_t)HALF * K * 2;
    const unsigned ldsw = (unsigned)wid * 1024u;
    const int aoff = lds_byte(wr * 64 + fr, fq * 8), boff = lds_byte(wc * 32 + fr, fq * 8);
#define PG8_SA(b, h) (((b) * 2 + (h)) * HTB)
#define PG8_SB(b, h) ((4 + (b) * 2 + (h)) * HTB)
#define PG8_STAGE(bufoff, gbase, voff) do { _Pragma("unroll") for (int _i = 0; _i < 2; ++_i) \
        __builtin_amdgcn_global_load_lds((const unsigned*)((const char*)(gbase) + (voff)[_i]), (LAS unsigned*)(lds + (bufoff) + ldsw + _i * 8192), 16, 0, 0); } while (0)
#define PG8_LDA(dst, b, h) do { _Pragma("unroll") for (int m = 0; m < 4; ++m) _Pragma("unroll") for (int k = 0; k < 2; ++k) dst[m][k] = *(const LAS bf16x8*)(lds + PG8_SA(b, h) + aoff + m * 2048 + k * 1024); } while (0)
#define PG8_LDB(dst, b, h) do { _Pragma("unroll") for (int n = 0; n < 2; ++n) _Pragma("unroll") for (int k = 0; k < 2; ++k) dst[n][k] = *(const LAS bf16x8*)(lds + PG8_SB(b, h) + boff + n * 2048 + k * 1024); } while (0)
#define PG8_MMA(ai, bj, At, Bt) do { __builtin_amdgcn_s_setprio(1); _Pragma("unroll") for (int m = 0; m < 4; ++m) _Pragma("unroll") for (int n = 0; n < 2; ++n) _Pragma("unroll") for (int k = 0; k < 2; ++k) \
        acc[ai][bj][m][n] = __builtin_amdgcn_mfma_f32_16x16x32_bf16(Bt[n][k], At[m][k], acc[ai][bj][m][n], 0, 0, 0); __builtin_amdgcn_s_setprio(0); } while (0)
#define PG8_WAIT_V(n) asm volatile("s_waitcnt vmcnt(" #n ")" ::: "memory")
#define PG8_WAIT_L(n) asm volatile("s_waitcnt lgkmcnt(" #n ")" ::: "memory")
#define PG8_BAR __builtin_amdgcn_s_barrier()
#define PG8_SCHED __builtin_amdgcn_sched_barrier(0)
    Unit cur, nxt; int ui = 0;
    if (!S.next(0, cur)) return;
    f32x4 acc[2][2][4][2];
#pragma unroll
    for (int a = 0; a < 2; ++a)
#pragma unroll
        for (int b = 0; b < 2; ++b)
#pragma unroll
            for (int m = 0; m < 4; ++m)
#pragma unroll
                for (int n = 0; n < 2; ++n) acc[a][b][m][n] = (f32x4){0.f, 0.f, 0.f, 0.f};
    bf16x8 At[4][2], B0[2][2], B1[2][2];
    const char* cA = S.abase(cur); const char* cB = S.bbase(cur);
    if constexpr (SP2) {
        PG8_STAGE(PG8_SB(0, 0), cB, voffB); PG8_STAGE(PG8_SB(0, 1), cB + hstep, voffB); PG8_STAGE(PG8_SA(0, 0), cA, voffA); PG8_STAGE(PG8_SA(0, 1), cA + hstep, voffA);
        if (wr == 1) PG8_BAR;
        PG8_WAIT_V(2); PG8_BAR;
        PG8_STAGE(PG8_SB(1, 0), cB + kstep, voffB); PG8_STAGE(PG8_SA(1, 0), cA + kstep, voffA); PG8_STAGE(PG8_SB(1, 1), cB + hstep + kstep, voffB);
        PG8_WAIT_V(6); PG8_BAR;
    } else {
        PG8_STAGE(PG8_SB(0, 0), cB, voffB); PG8_STAGE(PG8_SA(0, 0), cA, voffA); PG8_STAGE(PG8_SB(0, 1), cB + hstep, voffB); PG8_STAGE(PG8_SA(0, 1), cA + hstep, voffA);
        if (wr == 1) PG8_BAR;
        PG8_WAIT_V(4); PG8_BAR;
        PG8_STAGE(PG8_SB(1, 0), cB + kstep, voffB); PG8_STAGE(PG8_SA(1, 0), cA + kstep, voffA); PG8_STAGE(PG8_SB(1, 1), cB + hstep + kstep, voffB);
        PG8_WAIT_V(6); PG8_BAR;
    }
    for (;;) {
        const bool has_next = S.next(ui + 1, nxt);
        const char* nA = has_next ? S.abase(nxt) : cA; const char* nB = has_next ? S.bbase(nxt) : cB;
        for (int t = 0; t < nt; t += 2) {
            const bool last = (t == nt - 2);
            const char* a1 = cA + (size_t)(t + 1) * kstep;
            const char* a2 = last ? nA : cA + (size_t)(t + 2) * kstep; const char* b2 = last ? nB : cB + (size_t)(t + 2) * kstep;
            const char* a3 = a2 + kstep; const char* b3 = b2 + kstep;
            if constexpr (SP2) {
            PG8_LDB(B0, 0, 0); PG8_LDB(B1, 0, 1); PG8_SCHED; PG8_LDA(At, 0, 0); PG8_STAGE(PG8_SA(1, 1), a1 + hstep, voffA);
            PG8_WAIT_V(8); PG8_WAIT_L(0); PG8_BAR; PG8_MMA(0, 0, At, B0); PG8_MMA(0, 1, At, B1); PG8_BAR; PG8_SCHED;
            PG8_LDA(At, 0, 1); PG8_STAGE(PG8_SB(0, 0), b2, voffB); PG8_STAGE(PG8_SB(0, 1), b2 + hstep, voffB); PG8_STAGE(PG8_SA(0, 0), a2, voffA);
            PG8_WAIT_V(8); PG8_WAIT_L(0); PG8_BAR; PG8_MMA(1, 0, At, B0); PG8_MMA(1, 1, At, B1); PG8_BAR; PG8_SCHED;
            PG8_LDB(B0, 1, 0); PG8_LDB(B1, 1, 1); PG8_SCHED; PG8_LDA(At, 1, 0); PG8_STAGE(PG8_SA(0, 1), a2 + hstep, voffA);
            PG8_WAIT_V(8); PG8_WAIT_L(0); PG8_BAR; PG8_MMA(0, 0, At, B0); PG8_MMA(0, 1, At, B1); PG8_BAR; PG8_SCHED;
            PG8_LDA(At, 1, 1); PG8_STAGE(PG8_SB(1, 0), b3, voffB); PG8_STAGE(PG8_SB(1, 1), b3 + hstep, voffB); PG8_STAGE(PG8_SA(1, 0), a3, voffA);
            PG8_WAIT_V(8); PG8_WAIT_L(0); PG8_BAR; PG8_MMA(1, 0, At, B0); PG8_MMA(1, 1, At, B1); PG8_BAR; PG8_SCHED;
            } else {
            PG8_LDB(B0, 0, 0); PG8_SCHED; PG8_LDA(At, 0, 0); PG8_STAGE(PG8_SA(1, 1), a1 + hstep, voffA);
            PG8_WAIT_L(8); PG8_BAR; PG8_WAIT_L(0); PG8_MMA(0, 0, At, B0); PG8_BAR; PG8_SCHED;
            PG8_LDB(B1, 0, 1); PG8_STAGE(PG8_SB(0, 0), b2, voffB);
            PG8_BAR; PG8_WAIT_L(0); PG8_MMA(0, 1, At, B1); PG8_BAR;
            PG8_LDA(At, 0, 1); PG8_STAGE(PG8_SA(0, 0), a2, voffA);
            PG8_BAR; PG8_WAIT_L(0); PG8_MMA(1, 0, At, B0); PG8_BAR; PG8_SCHED;
            PG8_STAGE(PG8_SB(0, 1), b2 + hstep, voffB);
            PG8_WAIT_V(6); PG8_BAR; PG8_MMA(1, 1, At, B1); PG8_BAR;
            PG8_LDB(B0, 1, 0); PG8_SCHED; PG8_LDA(At, 1, 0); PG8_STAGE(PG8_SA(0, 1), a2 + hstep, voffA);
            PG8_WAIT_L(8); PG8_BAR; PG8_WAIT_L(0); PG8_MMA(0, 0, At, B0); PG8_BAR; PG8_SCHED;
            PG8_LDB(B1, 1, 1); PG8_STAGE(PG8_SB(1, 0), b3, voffB);
            PG8_BAR; PG8_WAIT_L(0); PG8_MMA(0, 1, At, B1); PG8_BAR;
            PG8_LDA(At, 1, 1); PG8_STAGE(PG8_SA(1, 0), a3, voffA);
            PG8_BAR; PG8_WAIT_L(0); PG8_MMA(1, 0, At, B0); PG8_BAR; PG8_SCHED;
            PG8_STAGE(PG8_SB(1, 1), b3 + hstep, voffB);
            PG8_WAIT_V(6); PG8_BAR; PG8_MMA(1, 1, At, B1); PG8_BAR;
            }
        }
        if constexpr (ALIGN_EPI) { if (wr == 0) PG8_BAR; }
        E(acc, cur, wr, wc, fr, fq);
        if (!has_next) break;
#pragma unroll
        for (int a = 0; a < 2; ++a)
#pragma unroll
            for (int b = 0; b < 2; ++b)
#pragma unroll
                for (int m = 0; m < 4; ++m)
#pragma unroll
                    for (int n = 0; n < 2; ++n) acc[a][b][m][n] = (f32x4){0.f, 0.f, 0.f, 0.f};
        cur = nxt; cA = nA; cB = nB; ++ui;
        if constexpr (ALIGN_EPI) { if (wr == 1) PG8_BAR; }
    }
    PG8_WAIT_V(0);
    if constexpr (!ALIGN_EPI) { if (wr == 0) PG8_BAR; }
    PG8_BAR;
#undef voffB
#undef PG8_SA
#undef PG8_SB
#undef PG8_STAGE
#undef PG8_LDA
#undef PG8_LDB
#undef PG8_MMA
#undef PG8_WAIT_V
#undef PG8_WAIT_L
#undef PG8_BAR
#undef PG8_SCHED
}
}
namespace pg8 {
__device__ __forceinline__ void st8(bf16* p, const f32x4& v0, const f32x4& v1) {
    v4u w; w.x = cvtpk(v0[0], v0[1]); w.y = cvtpk(v0[2], v0[3]); w.z = cvtpk(v1[0], v1[1]); w.w = cvtpk(v1[2], v1[3]);
    *(v4u*)p = w;
}
struct EpiIn {
    bf16 *convb, *zb, *qb, *xbcb, *kb, *vb; float* dtb; const float* ropec; const float* ropes;
    __device__ __forceinline__ void operator()(const f32x4 (&acc)[2][2][4][2], const Unit& u, int wr, int wc, int fr, int fq) const {
        const int pn = u.pn, pm = u.pm;
        if (pn == 24) {
            if (wc == 0) {
#pragma unroll
                for (int ai = 0; ai < 2; ++ai)
#pragma unroll
                    for (int m = 0; m < 4; ++m) { const int r = pm * 256 + ai * 128 + wr * 64 + m * 16 + fr; *(f32x4*)(dtb + (size_t)r * 16 + 4 * fq) = acc[ai][0][m][0]; }
            }
            return;
        }
        bf16* base; int ld, col0; bool rope = false, kv = false;
        if (pn < 6) { base = convb; ld = 1536; col0 = 256 * pn; }
        else if (pn < 8) { base = zb; ld = 512; col0 = 256 * (pn - 6); }
        else if (pn < 12) { base = qb; ld = 1024; col0 = 256 * (pn - 8); rope = pm < 64; }
        else if (pn < 16) { base = xbcb; ld = 1024; col0 = 256 * (pn - 12); }
        else if (pn < 20) { base = kb; ld = 1024; col0 = 256 * (pn - 16); rope = pm < 64; kv = true; }
        else { base = vb; ld = 1024; col0 = 256 * (pn - 20); kv = true; }
        const size_t rowbase = !kv ? (size_t)pm * 256 : (pm < 64 ? (size_t)(pm >> 5) * KVLEN + CTXL + (size_t)(pm & 31) * 256 : (size_t)(pm - 64) * KVLEN);
        bf16* bp = base + rowbase * ld + col0 + wc * 32 + 8 * fq;
        if (rope) {
#pragma unroll
            for (int ai = 0; ai < 2; ++ai)
#pragma unroll
                for (int m = 0; m < 4; ++m) {
                    const int rl = ai * 128 + wr * 64 + m * 16 + fr;
                    const int pos = (wc & 1) ? 128 + m * 16 + fr : 4 * (pm & 31) + 2 * ai + wr;
                    const f32x4 cs = *(const f32x4*)(ropec + pos * 16 + 4 * fq), sn = *(const f32x4*)(ropes + pos * 16 + 4 * fq);
#pragma unroll
                    for (int bj = 0; bj < 2; ++bj) {
                        const f32x4 a1 = acc[ai][bj][m][0], a2 = acc[ai][bj][m][1];
                        const f32x4 o1 = a1 * cs - a2 * sn, o2 = a2 * cs + a1 * sn;
                        st8(bp + (size_t)rl * ld + bj * 128, o1, o2);
                    }
                }
        } else {
#pragma unroll
            for (int ai = 0; ai < 2; ++ai)
#pragma unroll
                for (int m = 0; m < 4; ++m) {
                    const int rl = ai * 128 + wr * 64 + m * 16 + fr;
#pragma unroll
                    for (int bj = 0; bj < 2; ++bj) st8(bp + (size_t)rl * ld + bj * 128, acc[ai][bj][m][0], acc[ai][bj][m][1]);
                }
        }
    }
};
struct EpiResid {
    const float* srcLat; const float* srcCtx; float* dst; const float* gate;
    __device__ __forceinline__ void operator()(const f32x4 (&acc)[2][2][4][2], const Unit& u, int wr, int wc, int fr, int fq) const {
        const int pm = u.pm; const int v = pm < 32 ? 0 : (pm < 64 ? 1 : 2);
        const float* gv = gate + (size_t)v * 6 * D;
        const float* src = pm < 64 ? srcLat + (size_t)pm * 256 * D : srcCtx + (size_t)(pm - 64) * 256 * D;
        float* dp = dst + (size_t)pm * 256 * D;
        const int colb = u.pn * 256 + wc * 32 + 4 * fq;
        f32x4 g[2][2];
#pragma unroll
        for (int bj = 0; bj < 2; ++bj)
#pragma unroll
            for (int n = 0; n < 2; ++n) g[bj][n] = *(const f32x4*)(gv + colb + bj * 128 + n * 16);
#pragma unroll
        for (int ai = 0; ai < 2; ++ai)
#pragma unroll
            for (int m = 0; m < 4; ++m) {
                const size_t off = (size_t)(ai * 128 + wr * 64 + m * 16 + fr) * D + colb;
#pragma unroll
                for (int bj = 0; bj < 2; ++bj)
#pragma unroll
                    for (int n = 0; n < 2; ++n) { const f32x4 s = *(const f32x4*)(src + off + bj * 128 + n * 16); *(f32x4*)(dp + off + bj * 128 + n * 16) = s + g[bj][n] * acc[ai][bj][m][n]; }
                asm volatile("" ::: "memory");
            }
    }
};
struct EpiSwiGLU {
    bf16* act; int ld;
    __device__ __forceinline__ void operator()(const f32x4 (&acc)[2][2][4][2], const Unit& u, int wr, int wc, int fr, int fq) const {
        bf16* bp = act + (size_t)u.pm * 256 * ld + u.pn * 128 + wc * 32 + 8 * fq;
#pragma unroll
        for (int ai = 0; ai < 2; ++ai)
#pragma unroll
            for (int m = 0; m < 4; ++m) {
                const int rl = ai * 128 + wr * 64 + m * 16 + fr;
                f32x4 o[2];
#pragma unroll
                for (int bj = 0; bj < 2; ++bj) { const f32x4 g = acc[ai][bj][m][0], up = acc[ai][bj][m][1];
#pragma unroll
                    for (int j = 0; j < 4; ++j) o[bj][j] = silu_f(g[j]) * up[j]; }
                st8(bp + (size_t)rl * ld, o[0], o[1]);
            }
    }
};
struct EpiBf16 {
    bf16* O; int ld;
    __device__ __forceinline__ void operator()(const f32x4 (&acc)[2][2][4][2], const Unit& u, int wr, int wc, int fr, int fq) const {
        bf16* bp = O + (size_t)u.pm * 256 * ld + u.pn * 256 + wc * 32 + 8 * fq;
#pragma unroll
        for (int ai = 0; ai < 2; ++ai)
#pragma unroll
            for (int m = 0; m < 4; ++m) {
                const int rl = ai * 128 + wr * 64 + m * 16 + fr;
#pragma unroll
                for (int bj = 0; bj < 2; ++bj) st8(bp + (size_t)rl * ld + bj * 128, acc[ai][bj][m][0], acc[ai][bj][m][1]);
                asm volatile("" ::: "memory");
            }
    }
};
}
struct Params { const float* in[28]; float* out; unsigned char* ws; };
enum { I_X = 0, I_C, I_CTX, I_CCTX, I_WMOD, I_BMOD, I_GMIX, I_GFFN, I_WIN, I_CONVW, I_SCONVW, I_SCONVB, I_ALOG, I_DTB, I_SSDD, I_SNORM, I_LAMBDA, I_SUBLN, I_WOUT,
       I_FG, I_FU, I_FD, I_RW, I_RB, I_MG, I_MU, I_MD, I_GFIN };
struct Frame {
    LAS unsigned char* lds; volatile LAS unsigned* MISC; gu32* ctl;
    int wave, vcu, G;
};
struct Lane { int tid, lane; __device__ __forceinline__ Lane() { tid = fresh_tid(); lane = tid & 63; } };

__device__ __forceinline__ void tr_item(const float* colptr, int ld, bool perm, bf16* wt, int K, int k0, LAS float* scr, int lane) {
    const int j = lane & 31;
#pragma unroll 8
    for (int i = 0; i < 32; ++i) { const int kk = 2 * i + (lane >> 5); scr[kk * 33 + j] = colptr ? colptr[(size_t)(k0 + kk) * ld] : 0.f; }
    LDS_WAIT(); asm volatile("" ::: "memory");
    const int c = lane & 7;
#pragma unroll
    for (int jj = 0; jj < 4; ++jj) { const int n = (lane >> 3) + 8 * jj; const int slot = perm ? pg8::perm32(n) : n; const LAS float* s = scr + (8 * c) * 33 + slot;
        v4u o; o.x = pk2(s[0 * 33], s[1 * 33]); o.y = pk2(s[2 * 33], s[3 * 33]); o.z = pk2(s[4 * 33], s[5 * 33]); o.w = pk2(s[6 * 33], s[7 * 33]);
        *(GAS v4u*)(wt + (size_t)n * K + k0 + 8 * c) = o; }
    LDS_WAIT(); asm volatile("" ::: "memory");
}
__device__ __forceinline__ const float* gu_colptr(const float* gate, const float* up, int nb, int j) {
    const int pn = nb >> 3, r = nb & 7, bj = r >> 2, wc = r & 3, n = j >> 4, i = j & 15, fq = i >> 2, jj = i & 3;
    return (n ? up : gate) + 128 * pn + 32 * wc + 8 * fq + 4 * bj + jj;
}
__device__ __forceinline__ void p0_prologue(Frame& F, const Params& P) {
    const Lane L;
    unsigned char* ws = fresh_ws(P.ws);
    if (F.vcu < 192) {
        const int l = F.vcu / 96, cb = F.vcu % 96;
        LAS float* sv = (LAS float*)(F.lds);
        LAS float* red = (LAS float*)(F.lds + 32768);
        for (int i = L.tid; i < 3 * D; i += 512) { const int v = i / D, k = i % D; const float c = v < 2 ? P.in[I_C][v * D + k] : P.in[I_CCTX][k]; sv[i] = c / (1.0f + __expf(-c)); }
        __syncthreads();
        const float* W = P.in[I_WMOD] + (size_t)l * D * 12288 + cb * 128 + 2 * L.lane;
        f32x2 a0 = {0.f, 0.f}, a1 = {0.f, 0.f}, a2 = {0.f, 0.f};
        const int kb = F.wave * 256;
#pragma unroll 16
        for (int k = 0; k < 256; ++k) { const f32x2 w = *(const f32x2*)(W + (size_t)(kb + k) * 12288); a0 += w * sv[kb + k]; a1 += w * sv[D + kb + k]; a2 += w * sv[2 * D + kb + k]; }
        *(LAS f32x2*)(red + (F.wave * 3 + 0) * 128 + 2 * L.lane) = a0; *(LAS f32x2*)(red + (F.wave * 3 + 1) * 128 + 2 * L.lane) = a1; *(LAS f32x2*)(red + (F.wave * 3 + 2) * 128 + 2 * L.lane) = a2;
        __syncthreads();
        if (L.tid < 384) { const int v = L.tid >> 7, col = L.tid & 127; float s = P.in[I_BMOD][l * 12288 + cb * 128 + col];
#pragma unroll
            for (int w = 0; w < 8; ++w) s += red[(w * 3 + v) * 128 + col];
            ((float*)(ws + WS_MOD))[(size_t)(l * 3 + v) * 12288 + cb * 128 + col] = s; }
        __syncthreads();
    } else if (F.vcu == 192) {
        float* rc = (float*)(ws + WS_ROPE); float* rs = rc + 192 * 16;
        for (int i = L.tid; i < 192 * 16; i += 512) { const int pos = i >> 4, f = i & 15; const float inv = exp2f(-(float)f * (13.287712379549449f / 16.0f)); const float ang = (float)(pos < 128 ? pos : pos - 128) * inv; rc[i] = cosf(ang); rs[i] = sinf(ang); }
    }
    LAS float* scr = (LAS float*)(F.lds + F.wave * 16384);
    const int gw = F.vcu * NWAVES + F.wave, NGW = F.G * NWAVES, lane = L.lane, j = lane & 31;
    constexpr int I_IN = 200 * 32, I_OUT = 64 * 32, I_GU = 352 * 32, I_DN = 64 * 88, I_MGU1 = 176 * 32, I_MDN1 = 64 * 44;
    constexpr int NITEMS = 2 * I_IN + 2 * I_OUT + I_GU + I_DN + NE * I_MGU1 + NE * I_MDN1;
    for (int it = gw; it < NITEMS; it += NGW) {
        int r = it;
        if (r < 2 * I_IN) { const int l = r / I_IN; r -= l * I_IN; const int nb = r >> 5, kb = r & 31, n0 = 32 * nb;
            const float* w = P.in[I_WIN] + (size_t)l * D * IN_COLS; const float* cp; bool perm;
            if (n0 < 4096) { cp = w + n0 + j; perm = !(n0 >= 2048 && n0 < 3072); }
            else if (n0 < 5120) { cp = w + COL_K + (n0 - 4096) + j; perm = false; }
            else if (n0 < 6144) { cp = w + COL_V + (n0 - 5120) + j; perm = true; }
            else if (n0 == 6144) { cp = j < 16 ? w + COL_DT + j : nullptr; perm = false; }
            else { cp = nullptr; perm = false; }
            tr_item(cp, IN_COLS, perm, (bf16*)(ws + WS_WIN + l * SZ_WIN) + (size_t)n0 * D, D, 64 * kb, scr, lane); continue; }
        r -= 2 * I_IN;
        if (r < 2 * I_OUT) { const int l = r / I_OUT; r -= l * I_OUT; const int nb = r >> 5, kb = r & 31, n0 = 32 * nb;
            tr_item(P.in[I_WOUT] + (size_t)l * D * D + n0 + j, D, false, (bf16*)(ws + WS_WOUT + l * SZ_WOUT) + (size_t)n0 * D, D, 64 * kb, scr, lane); continue; }
        r -= 2 * I_OUT;
        if (r < I_GU) { const int nb = r >> 5, kb = r & 31;
            tr_item(gu_colptr(P.in[I_FG], P.in[I_FU], nb, j), FFD, false, (bf16*)(ws + WS_WGU) + (size_t)(32 * nb) * D, D, 64 * kb, scr, lane); continue; }
        r -= I_GU;
        if (r < I_DN) { const int nb = r / 88, kb = r % 88, n0 = 32 * nb;
            tr_item(P.in[I_FD] + n0 + j, D, false, (bf16*)(ws + WS_WDN) + (size_t)n0 * FFD, FFD, 64 * kb, scr, lane); continue; }
        r -= I_DN;
        if (r < NE * I_MGU1) { const int e = r / I_MGU1; r -= e * I_MGU1; const int nb = r >> 5, kb = r & 31;
            tr_item(gu_colptr(P.in[I_MG] + (size_t)e * D * FFE, P.in[I_MU] + (size_t)e * D * FFE, nb, j), FFE, false, (bf16*)(ws + WS_MGU + e * SZ_MGU) + (size_t)(32 * nb) * D, D, 64 * kb, scr, lane); continue; }
        r -= NE * I_MGU1;
        { const int e = r / I_MDN1; r -= e * I_MDN1; const int nb = r / 44, kb = r % 44, n0 = 32 * nb;
            tr_item(P.in[I_MD] + (size_t)e * FFE * D + n0 + j, D, true, (bf16*)(ws + WS_MDN + e * SZ_MDN) + (size_t)n0 * FFE, FFE, 64 * kb, scr, lane); }
    }
}

template <bool ROUTE>
__device__ __forceinline__ void norm_phase(Frame& F, const float* srcLat, const float* srcCtx, const float* gvec, const float* modl, int ishift, int iscale, bf16* h, int nrows,
                                           const float* wrouter, const float* brouter, int* tok_e, int* tok_slot, float* tok_p) {
    const Lane L;
    LAS float* wrT = (LAS float*)F.lds;
    if (ROUTE) {
        for (int i = L.tid; i < D * NE; i += 512) { const int k = i >> 3, e = i & 7; wrT[e * D + k] = wrouter[i]; }
        __syncthreads();
    }
    const int gw = F.vcu * NWAVES + F.wave, NGW = F.G * NWAVES, lane = L.lane;
    for (int run = gw; run < nrows / 8; run += NGW) {
        const int r0 = run * 8; const int v = r0 < SEQ ? 0 : (r0 < NLAT ? 1 : 2);
        const float* sh = modl + (size_t)(v * 6 + ishift) * D; const float* sc = modl + (size_t)(v * 6 + iscale) * D;
        f32x4 A[8], B[8];
#pragma unroll
        for (int jq = 0; jq < 8; ++jq) { const int c = 4 * lane + 256 * jq; const f32x4 g = *(const f32x4*)(gvec + c), s = *(const f32x4*)(sc + c); A[jq] = g * (s + 1.0f); B[jq] = *(const f32x4*)(sh + c); }
        for (int rr = 0; rr < 8; ++rr) {
            const int r = r0 + rr;
            const float* xr = r < NLAT ? srcLat + (size_t)r * D : srcCtx + (size_t)(r - NLAT) * D;
            f32x4 x[8]; float ss = 0.f;
#pragma unroll
            for (int jq = 0; jq < 8; ++jq) { x[jq] = *(const f32x4*)(xr + 4 * lane + 256 * jq); ss += (x[jq][0] * x[jq][0] + x[jq][1] * x[jq][1]) + (x[jq][2] * x[jq][2] + x[jq][3] * x[jq][3]); }
            const float rstd = 1.0f / sqrtf(wave_sum(ss) * (1.0f / D) + NORM_EPS);
#pragma unroll
            for (int jq = 0; jq < 8; ++jq) x[jq] = (x[jq] * rstd) * A[jq] + B[jq];
            bf16* hr = h + (size_t)r * D;
#pragma unroll
            for (int jq = 0; jq < 8; ++jq) { v2u w; w.x = cvtpk(x[jq][0], x[jq][1]); w.y = cvtpk(x[jq][2], x[jq][3]); *(v2u*)(hr + 4 * lane + 256 * jq) = w; }
            if (ROUTE) {
                float lg[NE];
#pragma unroll
                for (int e = 0; e < NE; ++e) { float p = 0.f;
#pragma unroll
                    for (int jq = 0; jq < 8; ++jq) { const f32x4 w = *(const LAS f32x4*)(wrT + e * D + 4 * lane + 256 * jq); p += (x[jq][0] * w[0] + x[jq][1] * w[1]) + (x[jq][2] * w[2] + x[jq][3] * w[3]); }
                    lg[e] = wave_sum(p) + brouter[e]; }
                int i0 = 0; float v0 = lg[0];
#pragma unroll
                for (int e = 1; e < NE; ++e) if (lg[e] > v0) { v0 = lg[e]; i0 = e; }
                int i1 = -1; float v1 = -3.0e38f;
#pragma unroll
                for (int e = 0; e < NE; ++e) if (e != i0 && lg[e] > v1) { v1 = lg[e]; i1 = e; }
                if (lane == 0) {
                    const float p0 = 1.0f / (1.0f + __expf(v1 - v0));
                    const int s0 = (int)__hip_atomic_fetch_add(F.ctl + CW_CNT + 64 * i0, 1u, RLX_AGENT);
                    const int s1 = (int)__hip_atomic_fetch_add(F.ctl + CW_CNT + 64 * i1, 1u, RLX_AGENT);
                    tok_e[2 * r] = i0; tok_e[2 * r + 1] = i1; tok_slot[2 * r] = s0; tok_slot[2 * r + 1] = s1; tok_p[2 * r] = p0; tok_p[2 * r + 1] = 1.0f - p0;
                }
            }
        }
    }
    if (ROUTE) __syncthreads();
}

__device__ __forceinline__ void ld8f(const bf16* p, float (&o)[8]) { const v4u w = *(const v4u*)p; o[0] = bflo(w.x); o[1] = bfhi(w.x); o[2] = bflo(w.y); o[3] = bfhi(w.y); o[4] = bflo(w.z); o[5] = bfhi(w.z); o[6] = bflo(w.w); o[7] = bfhi(w.w); }
__device__ __forceinline__ void st8f(bf16* p, const float (&o)[8]) { v4u w; w.x = cvtpk(o[0], o[1]); w.y = cvtpk(o[2], o[3]); w.z = cvtpk(o[4], o[5]); w.w = cvtpk(o[6], o[7]); *(v4u*)p = w; }
__device__ __forceinline__ void conv_phase(Frame& F, const bf16* convb, const bf16* xbcb, bf16* cat, bf16* xbcc, const float* cw  , const float* sw  , const float* sb  ) {
    const Lane L;
    const int gt = F.vcu * 512 + L.tid, NT = F.G * 512;
    constexpr int NRUN = T / 16, NITEM = NRUN * 192;
    for (int it = gt; it < NITEM; it += NT) {
        const int cc = it % 192, run = it / 192, r0 = run * 16;
        const int tl = r0 < NLAT ? (r0 % SEQ) : ((r0 - NLAT) % CTXL); const int sl = r0 < NLAT ? SEQ : CTXL;
        const bool first = tl == 0, last = tl + 16 == sl;
        if (cc < 64) {
            const int c0 = 8 * cc; float w0[8], w1[8], w2[8];
#pragma unroll
            for (int j = 0; j < 8; ++j) { w0[j] = cw[c0 + j]; w1[j] = cw[512 + c0 + j]; w2[j] = cw[1024 + c0 + j]; }
            float up[8], uc[8], un[8], a[8], b[8];
            if (first) {
#pragma unroll
                for (int j = 0; j < 8; ++j) up[j] = 0.f;
            } else { ld8f(convb + (size_t)(r0 - 1) * 1536 + 512 + c0, a); ld8f(convb + (size_t)(r0 - 1) * 1536 + 1024 + c0, b);
#pragma unroll
                for (int j = 0; j < 8; ++j) up[j] = a[j] * b[j]; }
            ld8f(convb + (size_t)r0 * 1536 + 512 + c0, a); ld8f(convb + (size_t)r0 * 1536 + 1024 + c0, b);
#pragma unroll
            for (int j = 0; j < 8; ++j) uc[j] = a[j] * b[j];
            for (int t = 0; t < 16; ++t) {
                const int r = r0 + t;
                if (t == 15 && last) {
#pragma unroll
                    for (int j = 0; j < 8; ++j) un[j] = 0.f;
                } else { ld8f(convb + (size_t)(r + 1) * 1536 + 512 + c0, a); ld8f(convb + (size_t)(r + 1) * 1536 + 1024 + c0, b);
#pragma unroll
                    for (int j = 0; j < 8; ++j) un[j] = a[j] * b[j]; }
                float g[8], o[8]; ld8f(convb + (size_t)r * 1536 + c0, g);
#pragma unroll
                for (int j = 0; j < 8; ++j) { o[j] = g[j] * ((up[j] * w0[j] + uc[j] * w1[j]) + un[j] * w2[j]); up[j] = uc[j]; uc[j] = un[j]; }
                st8f(cat + (size_t)r * D + c0, o);
            }
        } else {
            const int c0 = 8 * (cc - 64); float w0[8], w1[8], w2[8], bb[8];
#pragma unroll
            for (int j = 0; j < 8; ++j) { w0[j] = sw[c0 + j]; w1[j] = sw[1024 + c0 + j]; w2[j] = sw[2048 + c0 + j]; bb[j] = sb[c0 + j]; }
            float up[8], uc[8], un[8];
            if (first) {
#pragma unroll
                for (int j = 0; j < 8; ++j) up[j] = 0.f;
            } else ld8f(xbcb + (size_t)(r0 - 1) * 1024 + c0, up);
            ld8f(xbcb + (size_t)r0 * 1024 + c0, uc);
            for (int t = 0; t < 16; ++t) {
                const int r = r0 + t;
                if (t == 15 && last) {
#pragma unroll
                    for (int j = 0; j < 8; ++j) un[j] = 0.f;
                } else ld8f(xbcb + (size_t)(r + 1) * 1024 + c0, un);
                float o[8];
#pragma unroll
                for (int j = 0; j < 8; ++j) { const float y = ((up[j] * w0[j] + uc[j] * w1[j]) + un[j] * w2[j]) + bb[j]; o[j] = silu_f(y); up[j] = uc[j]; uc[j] = un[j]; }
                st8f(xbcc + (size_t)r * 1024 + c0, o);
            }
        }
    }
}
__device__ __forceinline__ int chain_pos(int dir, int cn) { return dir == 0 ? cn : (cn < 2 ? 1 - cn : 67 - cn); }
__device__ __forceinline__ int crow(int r, int hi) { return (r & 3) + 8 * (r >> 2) + 4 * hi; }
__device__ __forceinline__ float softplus_f(float x) { return x > 20.f ? x : log1pf(__expf(x)); }
constexpr int TS = 136;

__device__ __forceinline__ void ssd_local_phase(Frame& F, const Params& P, int layer) {
    unsigned char* ws = fresh_ws(P.ws);
    const bf16* xbcc = (const bf16*)(ws + WS_XBCC); const float* dtb = (const float*)(ws + WS_DT);
    float* yd = (float*)(ws + WS_YD); float* cumb = (float*)(ws + WS_CUM); float* Sb = (float*)(ws + WS_SB); float* tot = (float*)(ws + WS_TOT);
    LAS bf16* Cs = (LAS bf16*)(F.lds); LAS bf16* Bs = (LAS bf16*)(F.lds + 34816); LAS bf16* XT = (LAS bf16*)(F.lds + 69632);
    LAS bf16* Gs = (LAS bf16*)(F.lds + 87040) + F.wave * 1280;
    LAS float* fa = (LAS float*)(F.lds + 107520);
    LAS float* daA = fa, *cumA = fa + 256, *dtA = fa + 512, *scA = fa + 768;
    const int wave = F.wave;
    for (int uid = F.vcu; uid < NCH * NB * 8; uid += F.G) {
        const int tid = fresh_tid(), lane = tid & 63, r32 = lane & 31, hi = lane >> 5;
        const int h = uid & 7, b = (uid >> 3) & 1, cn = uid >> 4, g = h >> 2;
        const int row0 = cn < 2 ? NLAT + b * CTXL + 128 * cn : b * SEQ + 128 * (cn - 2);
#pragma unroll
        for (int i = 0; i < 4; ++i) { const int q = tid + 512 * i, s = q >> 4, c8 = (q & 15) * 8;
            *(LAS v4u*)(Cs + s * TS + c8) = *(const v4u*)(xbcc + (size_t)(row0 + s) * 1024 + 768 + g * 128 + c8);
            *(LAS v4u*)(Bs + s * TS + c8) = *(const v4u*)(xbcc + (size_t)(row0 + s) * 1024 + 512 + g * 128 + c8); }
#pragma unroll
        for (int i = 0; i < 2; ++i) { const int q = tid + 512 * i, s = q >> 3, p8 = (q & 7) * 8;
            const v4u w = *(const v4u*)(xbcc + (size_t)(row0 + s) * 1024 + h * 64 + p8);
            XT[(p8 + 0) * TS + s] = (bf16)(w.x & 0xffff); XT[(p8 + 1) * TS + s] = (bf16)(w.x >> 16); XT[(p8 + 2) * TS + s] = (bf16)(w.y & 0xffff); XT[(p8 + 3) * TS + s] = (bf16)(w.y >> 16);
            XT[(p8 + 4) * TS + s] = (bf16)(w.z & 0xffff); XT[(p8 + 5) * TS + s] = (bf16)(w.z >> 16); XT[(p8 + 6) * TS + s] = (bf16)(w.w & 0xffff); XT[(p8 + 7) * TS + s] = (bf16)(w.w >> 16); }
        if (tid < 256) { const int dir = tid >> 7, s = tid & 127;
            const float raw = dtb[(size_t)(row0 + s) * 16 + dir * 8 + h] + P.in[I_DTB][layer * 16 + dir * 8 + h];
            const float dt = softplus_f(raw); const float A = -__expf(P.in[I_ALOG][layer * 16 + dir * 8 + h]);
            dtA[tid] = dt; daA[tid] = dt * A; }
        __syncthreads();
        if (tid < 256) { const int dir = tid >> 7, s = tid & 127; float cum = 0.f, total = 0.f;
            for (int k = 0; k < 128; ++k) { const float a = daA[dir * 128 + k]; total += a; if (dir == 0 ? (k <= s) : (k >= s)) cum += a; }
            cumA[tid] = cum; scA[tid] = __expf(total - cum) * dtA[tid];
            cumb[(size_t)(row0 + s) * 16 + dir * 8 + h] = cum;
            if (s == 0) tot[((dir * 2 + b) * 8 + h) * NCH + chain_pos(dir, cn)] = total; }
        __syncthreads();
        {
            const int rb = wave >> 1, cb = wave & 1;
            f32x16 Y = {};
            float cl0[16], cl1[16];
#pragma unroll
            for (int r = 0; r < 16; ++r) { cl0[r] = cumA[32 * rb + crow(r, hi)]; cl1[r] = cumA[128 + 32 * rb + crow(r, hi)]; }
            for (int sb = 0; sb < 4; ++sb) {
                f32x16 CB = {};
#pragma unroll
                for (int ks = 0; ks < 8; ++ks) {
                    const bf16x8 a = *(const LAS bf16x8*)(Cs + (32 * rb + r32) * TS + 16 * ks + 8 * hi);
                    const bf16x8 bb = *(const LAS bf16x8*)(Bs + (32 * sb + r32) * TS + 16 * ks + 8 * hi);
                    CB = __builtin_amdgcn_mfma_f32_32x32x16_bf16(a, bb, CB, 0, 0, 0);
                }
                const int s = 32 * sb + r32; const float cs0 = cumA[s], cs1 = cumA[128 + s], d0 = dtA[s], d1 = dtA[128 + s];
#pragma unroll
                for (int r = 0; r < 16; ++r) { const int l = 32 * rb + crow(r, hi);
                    const float f0 = (s <= l) ? __expf(cl0[r] - cs0) * d0 : 0.f, f1 = (s >= l) ? __expf(cl1[r] - cs1) * d1 : 0.f;
                    Gs[crow(r, hi) * 40 + r32] = (bf16)f2bf(CB[r] * (f0 + f1)); }
                LDS_WAIT(); asm volatile("" ::: "memory");
#pragma unroll
                for (int k2 = 0; k2 < 2; ++k2) {
                    const bf16x8 ag = *(const LAS bf16x8*)(Gs + r32 * 40 + 16 * k2 + 8 * hi);
                    const bf16x8 bx = *(const LAS bf16x8*)(XT + (32 * cb + r32) * TS + 32 * sb + 16 * k2 + 8 * hi);
                    Y = __builtin_amdgcn_mfma_f32_32x32x16_bf16(ag, bx, Y, 0, 0, 0);
                }
                LDS_WAIT(); asm volatile("" ::: "memory");
            }
#pragma unroll
            for (int r = 0; r < 16; ++r) yd[(size_t)(row0 + 32 * rb + crow(r, hi)) * 512 + h * 64 + 32 * cb + r32] = Y[r];
        }
        __syncthreads();
        LAS bf16* BT = Cs;
#pragma unroll
        for (int i = 0; i < 4; ++i) { const int q = tid + 512 * i, s = q >> 4, n8 = (q & 15) * 8; const v4u w = *(const LAS v4u*)(Bs + s * TS + n8);
            BT[(n8 + 0) * TS + s] = (bf16)(w.x & 0xffff); BT[(n8 + 1) * TS + s] = (bf16)(w.x >> 16); BT[(n8 + 2) * TS + s] = (bf16)(w.y & 0xffff); BT[(n8 + 3) * TS + s] = (bf16)(w.y >> 16);
            BT[(n8 + 4) * TS + s] = (bf16)(w.z & 0xffff); BT[(n8 + 5) * TS + s] = (bf16)(w.z >> 16); BT[(n8 + 6) * TS + s] = (bf16)(w.w & 0xffff); BT[(n8 + 7) * TS + s] = (bf16)(w.w >> 16); }
        __syncthreads();
        {
            const int dir = wave & 1, nb = wave >> 1;
            f32x16 S0 = {}, S1 = {};
#pragma unroll
            for (int ks = 0; ks < 8; ++ks) {
                const int s0 = 16 * ks + 8 * hi;
                const f32x4 sc0 = *(const LAS f32x4*)(scA + dir * 128 + s0), sc1 = *(const LAS f32x4*)(scA + dir * 128 + s0 + 4);
                const bf16x8 bb = *(const LAS bf16x8*)(BT + (32 * nb + r32) * TS + s0);
#pragma unroll
                for (int pb = 0; pb < 2; ++pb) {
                    const v4u xr = *(const LAS v4u*)(XT + (32 * pb + r32) * TS + s0);
                    v4u xs; xs.x = cvtpk(bflo(xr.x) * sc0[0], bfhi(xr.x) * sc0[1]); xs.y = cvtpk(bflo(xr.y) * sc0[2], bfhi(xr.y) * sc0[3]);
                    xs.z = cvtpk(bflo(xr.z) * sc1[0], bfhi(xr.z) * sc1[1]); xs.w = cvtpk(bflo(xr.w) * sc1[2], bfhi(xr.w) * sc1[3]);
                    const bf16x8 a = __builtin_bit_cast(bf16x8, xs);
                    if (pb == 0) S0 = __builtin_amdgcn_mfma_f32_32x32x16_bf16(a, bb, S0, 0, 0, 0); else S1 = __builtin_amdgcn_mfma_f32_32x32x16_bf16(a, bb, S1, 0, 0, 0);
                }
            }
            float* sp = Sb + ((size_t)(((dir * 2 + b) * 8 + h) * NCH + chain_pos(dir, cn))) * 8192;
#pragma unroll
            for (int r = 0; r < 16; ++r) { sp[(size_t)crow(r, hi) * 128 + 32 * nb + r32] = S0[r]; sp[(size_t)(32 + crow(r, hi)) * 128 + 32 * nb + r32] = S1[r]; }
        }
        __syncthreads();
    }
}

__device__ __forceinline__ void ssd_scan_phase(Frame& F, const Params& P) {
    unsigned char* ws = fresh_ws(P.ws);
    const float* Sb = (const float*)(ws + WS_SB); bf16* Hp = (bf16*)(ws + WS_HP); const float* tot = (const float*)(ws + WS_TOT);
    const Lane L;
    for (int e = F.vcu * 512 + L.tid; e < 32 * 8192; e += F.G * 512) {
        const int chain = e >> 13, idx = e & 8191;
        const float* sp = Sb + (size_t)chain * NCH * 8192 + idx; bf16* hp = Hp + (size_t)chain * NCH * 8192 + idx; const float* tp = tot + chain * NCH;
        float H = 0.f;
        for (int i0 = 0; i0 < NCH; i0 += 6) {
            float sv[6], dv[6];
#pragma unroll
            for (int q = 0; q < 6; ++q) { sv[q] = sp[(size_t)(i0 + q) * 8192]; dv[q] = __expf(tp[i0 + q]); }
#pragma unroll
            for (int q = 0; q < 6; ++q) { hp[(size_t)(i0 + q) * 8192] = (bf16)f2bf(H); H = dv[q] * H + sv[q]; }
        }
    }
}

__device__ __forceinline__ void ssd_out_phase(Frame& F, const Params& P, int layer) {
    unsigned char* ws = fresh_ws(P.ws);
    const bf16* xbcc = (const bf16*)(ws + WS_XBCC); const bf16* zb = (const bf16*)(ws + WS_Z); const float* yd = (const float*)(ws + WS_YD); const float* cumb = (const float*)(ws + WS_CUM);
    const bf16* Hp = (const bf16*)(ws + WS_HP); bf16* cat = (bf16*)(ws + WS_CAT);
    constexpr int YS = 260;
    LAS bf16* Cs = (LAS bf16*)(F.lds); LAS float* ec = (LAS float*)(F.lds + 34816); LAS float* Yl = (LAS float*)(F.lds + 34816 + 4096);
    const int wave = F.wave;
    for (int uid = F.vcu; uid < NCH * NB * 2; uid += F.G) {
        const int tid = fresh_tid(), lane = tid & 63, r32 = lane & 31, hi = lane >> 5;
        const int g = uid & 1, b = (uid >> 1) & 1, cn = uid >> 2;
        const int row0 = cn < 2 ? NLAT + b * CTXL + 128 * cn : b * SEQ + 128 * (cn - 2);
#pragma unroll
        for (int i = 0; i < 4; ++i) { const int q = tid + 512 * i, s = q >> 4, c8 = (q & 15) * 8;
            *(LAS v4u*)(Cs + s * TS + c8) = *(const v4u*)(xbcc + (size_t)(row0 + s) * 1024 + 768 + g * 128 + c8); }
#pragma unroll
        for (int i = 0; i < 2; ++i) { const int idx = tid + 512 * i, hd = idx >> 7, s = idx & 127; ec[idx] = __expf(cumb[(size_t)(row0 + s) * 16 + (hd & 1) * 8 + 4 * g + (hd >> 1)]); }
        __syncthreads();
        const int hh = wave >> 1, cb = wave & 1, h = 4 * g + hh;
        f32x16 ys[4] = {};
        {
            bf16x8 Hf[2][8];
#pragma unroll
            for (int dir = 0; dir < 2; ++dir) {
                const bf16* hp = Hp + ((size_t)(((dir * 2 + b) * 8 + h) * NCH + chain_pos(dir, cn))) * 8192 + (size_t)(32 * cb + r32) * 128 + 8 * hi;
#pragma unroll
                for (int ks = 0; ks < 8; ++ks) Hf[dir][ks] = *(const bf16x8*)(hp + 16 * ks);
            }
#pragma unroll
            for (int rb = 0; rb < 4; ++rb) {
                bf16x8 af[8];
#pragma unroll
                for (int ks = 0; ks < 8; ++ks) af[ks] = *(const LAS bf16x8*)(Cs + (32 * rb + r32) * TS + 16 * ks + 8 * hi);
#pragma unroll
                for (int dir = 0; dir < 2; ++dir) {
                    f32x16 a0 = {};
#pragma unroll
                    for (int ks = 0; ks < 8; ++ks) a0 = __builtin_amdgcn_mfma_f32_32x32x16_bf16(af[ks], Hf[dir][ks], a0, 0, 0, 0);
#pragma unroll
                    for (int r = 0; r < 16; ++r) ys[rb][r] += a0[r] * ec[(hh * 2 + dir) * 128 + 32 * rb + crow(r, hi)];
                }
                asm volatile("" ::: "memory");
            }
        }
        const int lane2 = fresh_tid() & 63;
        const float dsk = P.in[I_SSDD][layer * 8 + 4 * g + (lane2 >> 4)];
        const f32x4 ng = *(const f32x4*)(P.in[I_SNORM] + layer * 512 + g * 256 + 4 * lane2);
#pragma unroll
        for (int half = 0; half < 2; ++half) {
#pragma unroll
            for (int rb2 = 0; rb2 < 2; ++rb2)
#pragma unroll
                for (int r = 0; r < 16; ++r) Yl[(32 * rb2 + crow(r, hi)) * YS + hh * 64 + 32 * cb + r32] = ys[2 * half + rb2][r];
            __syncthreads();
#pragma unroll 2
            for (int q = 0; q < 8; ++q) {
                const int rl = 8 * wave + q, row = row0 + 64 * half + rl;
                const f32x4 yo = *(const LAS f32x4*)(Yl + rl * YS + 4 * lane2);
                const f32x4 ydv = *(const f32x4*)(yd + (size_t)row * 512 + g * 256 + 4 * lane2);
                const v2u xv = *(const v2u*)(xbcc + (size_t)row * 1024 + g * 256 + 4 * lane2), zv = *(const v2u*)(zb + (size_t)row * 512 + g * 256 + 4 * lane2);
                f32x4 u;
                u[0] = (yo[0] + ydv[0] + dsk * bflo(xv.x)) * silu_f(bflo(zv.x)); u[1] = (yo[1] + ydv[1] + dsk * bfhi(xv.x)) * silu_f(bfhi(zv.x));
                u[2] = (yo[2] + ydv[2] + dsk * bflo(xv.y)) * silu_f(bflo(zv.y)); u[3] = (yo[3] + ydv[3] + dsk * bfhi(xv.y)) * silu_f(bfhi(zv.y));
                const float ss = wave_sum((u[0] * u[0] + u[1] * u[1]) + (u[2] * u[2] + u[3] * u[3]));
                const float rstd = 1.0f / sqrtf(ss * (1.0f / 256.0f) + NORM_EPS);
                v2u o; o.x = cvtpk(u[0] * rstd * ng[0], u[1] * rstd * ng[1]); o.y = cvtpk(u[2] * rstd * ng[2], u[3] * rstd * ng[3]);
                *(v2u*)(cat + (size_t)row * D + 512 + g * 256 + 4 * lane2) = o;
            }
            __syncthreads();
        }
    }
}
namespace att {
constexpr int KVBLK = 64, LDQ = 1024, LDK = 1024;
constexpr float SCALE = 0.125f;
constexpr float THR = 8.f;
constexpr size_t SHM_V = KVBLK * 128 * 2, SHM_K = KVBLK * 128 * 2;
#define KSWZ(row, colB) ((row) * 256 + ((colB) ^ (((row) & 7) << 4)))
#define SBAR() __builtin_amdgcn_sched_barrier(0)
__device__ __forceinline__ void partialSM(f32x16& p0, f32x16& p1, float& m_reg, float& mn, float& alpha) {
  constexpr float C = SCALE * 1.4426950408889634f;
  float pmax = p0[0];
#pragma unroll
  for (int r = 1; r < 16; ++r) pmax = fmaxf(pmax, p0[r]);
#pragma unroll
  for (int r = 0; r < 16; ++r) pmax = fmaxf(pmax, p1[r]);
  pmax = cross_max(pmax);
  if (__builtin_expect(__all(pmax - m_reg <= THR / SCALE), 1)) { mn = m_reg; alpha = 1.f; }
  else { mn = fmaxf(m_reg, pmax); alpha = __builtin_amdgcn_exp2f((m_reg - mn) * C); m_reg = mn; }
  float mnC = -mn * C;
#pragma unroll
  for (int r = 0; r < 16; ++r) p0[r] = fmaf(p0[r], C, mnC);
#pragma unroll
  for (int r = 0; r < 16; ++r) p1[r] = fmaf(p1[r], C, mnC);
#pragma unroll
  for (int r = 0; r < 16; ++r) p0[r] = __builtin_amdgcn_exp2f(p0[r]);
}
__device__ __forceinline__ void finishSM(f32x16& p0, f32x16& p1, float alpha, float& l_reg, bf16x8& pa0, bf16x8& pa1, bf16x8& pa2, bf16x8& pa3) {
#pragma unroll
  for (int r = 0; r < 16; ++r) p1[r] = __builtin_amdgcn_exp2f(p1[r]);
  float ps = 0;
#pragma unroll
  for (int r = 0; r < 16; ++r) ps += p0[r];
#pragma unroll
  for (int r = 0; r < 16; ++r) ps += p1[r];
  ps = cross_sum(ps);
  l_reg = l_reg * alpha + ps;
#define PK4(P, BASE, OUT) do { unsigned a0 = cvtpk(P[BASE + 0], P[BASE + 1]), a1 = cvtpk(P[BASE + 2], P[BASE + 3]);   \
    unsigned b0 = cvtpk(P[BASE + 4], P[BASE + 5]), b1 = cvtpk(P[BASE + 6], P[BASE + 7]);                              \
    swap32u(a0, b0); swap32u(a1, b1); \
    v4u w = {a0, a1, b0, b1}; OUT = __builtin_bit_cast(bf16x8, w); } while (0)
  PK4(p0, 0, pa0); PK4(p0, 8, pa1); PK4(p1, 0, pa2); PK4(p1, 8, pa3);
#undef PK4
}
__device__ __forceinline__ void qkt(f32x16& p0, f32x16& p1, const char* Ks, const bf16x8* qr, int r32, int hi, int map) {
  p0 = f32x16{}; p1 = f32x16{};
#pragma unroll
  for (int d0 = 0; d0 < 4; ++d0) { int cb = (map * 64 + d0 * 16 + hi * 8) * 2;
    bf16x8 b0 = *reinterpret_cast<const bf16x8*>(Ks + KSWZ(r32, cb));
    bf16x8 b1 = *reinterpret_cast<const bf16x8*>(Ks + KSWZ(32 + r32, cb));
    p0 = __builtin_amdgcn_mfma_f32_32x32x16_bf16(b0, qr[d0], p0, 0, 0, 0);
    p1 = __builtin_amdgcn_mfma_f32_32x32x16_bf16(b1, qr[d0], p1, 0, 0, 0); }
}
__device__ __forceinline__ int v_st(int k, int c) { const int kk = (k & ~0xC) | ((k & 4) << 1) | ((k & 8) >> 1); return ((kk >> 3) * 4 + (c >> 5)) * 512 + ((kk & 7) * 32 + (c & 31)) * 2; }
__device__ __forceinline__ int v_rd_base(int lane) { return ((lane & 3) << 3) | (((lane >> 2) & 3) << 6) | (((lane >> 4) & 1) << 5) | (((lane >> 5) & 1) << 8); }
constexpr int v_rd_off(int d0, int ks, int half) { return d0 * 512 + ks * 4096 + half * 2048; }
template <int OFF> __device__ __forceinline__ s16x4 tr_read(int vb) {
  s16x4 r; asm volatile("ds_read_b64_tr_b16 %0, %1 offset:%2" : "=&v"(r) : "v"(vb), "i"(OFF) : "memory"); return r;
}
template <int D0> __device__ __forceinline__ void pv_one(f32x16& od, int vb, bf16x8 pa0, bf16x8 pa1, bf16x8 pa2, bf16x8 pa3) {
  const s16x4 l0 = tr_read<v_rd_off(D0, 0, 0)>(vb), h0 = tr_read<v_rd_off(D0, 0, 1)>(vb), l1 = tr_read<v_rd_off(D0, 1, 0)>(vb), h1 = tr_read<v_rd_off(D0, 1, 1)>(vb);
  const s16x4 l2 = tr_read<v_rd_off(D0, 2, 0)>(vb), h2 = tr_read<v_rd_off(D0, 2, 1)>(vb), l3 = tr_read<v_rd_off(D0, 3, 0)>(vb), h3 = tr_read<v_rd_off(D0, 3, 1)>(vb);
  asm volatile("s_waitcnt lgkmcnt(0)" ::: "memory"); SBAR();
#define PK(L, H) (bf16x8){L[0], L[1], L[2], L[3], H[0], H[1], H[2], H[3]}
  od = __builtin_amdgcn_mfma_f32_32x32x16_bf16(pa0, PK(l0, h0), od, 0, 0, 0);
  od = __builtin_amdgcn_mfma_f32_32x32x16_bf16(pa1, PK(l1, h1), od, 0, 0, 0);
  od = __builtin_amdgcn_mfma_f32_32x32x16_bf16(pa2, PK(l2, h2), od, 0, 0, 0);
  od = __builtin_amdgcn_mfma_f32_32x32x16_bf16(pa3, PK(l3, h3), od, 0, 0, 0);
#undef PK
}
__device__ __forceinline__ void pv_d0(f32x16* o, int vb, bf16x8 pa0, bf16x8 pa1, bf16x8 pa2, bf16x8 pa3) {
  pv_one<0>(o[0], vb, pa0, pa1, pa2, pa3); pv_one<1>(o[1], vb, pa0, pa1, pa2, pa3); pv_one<2>(o[2], vb, pa0, pa1, pa2, pa3); pv_one<3>(o[3], vb, pa0, pa1, pa2, pa3);
}
__device__ __forceinline__ void diff_attn_unit(const bf16* __restrict__ Qb, const bf16* __restrict__ Kh, const bf16* __restrict__ Vh, bf16* __restrict__ Ob, int seq, char* lds,
                                               float lam, const float* gsub, float oscale) {
  const int tid = fresh_tid(), wid = tid >> 6, lane = tid & 63, r32 = lane & 31, hi = lane >> 5, map = wid >> 2, wq = wid & 3;
  char* V_lds = lds; char* K_lds = lds + 2 * SHM_V;
  float* wsf = (float*)(lds + 2 * SHM_V + 2 * SHM_K) + wid * 64; float* li_l = wsf; float* al_l = wsf + 32;
  float m_reg = -1e30f, l_reg = 0; f32x16 o[4] = {}; bf16x8 qr[4];
  const bf16* Qw = Qb + (long)(wq * 32 + r32) * LDQ + map * 64 + hi * 8;
#pragma unroll
  for (int d0 = 0; d0 < 4; ++d0) qr[d0] = *reinterpret_cast<const bf16x8*>(Qw + d0 * 16);
  const int sr = tid >> 4, sc = (tid & 15) * 8, vst0 = v_st(sr, sc), vst1 = v_st(32 + sr, sc);
  const int vb0 = (int)(uintptr_t)V_lds + v_rd_base(lane);
  struct { bf16x8 vs0, vs1, ks0, ks1; } sr_[2];
#define SLOAD(i, k0) do { sr_[i].vs0 = *(const bf16x8*)(&Vh[(long)((k0) + sr) * LDK + sc]); sr_[i].vs1 = *(const bf16x8*)(&Vh[(long)((k0) + 32 + sr) * LDK + sc]); \
    sr_[i].ks0 = *(const bf16x8*)(&Kh[(long)((k0) + sr) * LDK + sc]); sr_[i].ks1 = *(const bf16x8*)(&Kh[(long)((k0) + 32 + sr) * LDK + sc]); } while (0)
#define SWRITE(b, i) do { *(bf16x8*)(V_lds + (b) * SHM_V + vst0) = sr_[i].vs0;          \
    *(bf16x8*)(V_lds + (b) * SHM_V + vst1) = sr_[i].vs1; int kc = sc * 2;               \
    *(bf16x8*)(K_lds + (b) * SHM_K + KSWZ(sr, kc)) = sr_[i].ks0;                       \
    *(bf16x8*)(K_lds + (b) * SHM_K + KSWZ(32 + sr, kc)) = sr_[i].ks1; } while (0)
#define SWAIT() asm volatile("s_waitcnt vmcnt(4)" ::: "memory")
#define RESC(a) do { if (__any((a) < 1.f)) { if (hi == 0) al_l[r32] = (a); asm volatile("s_waitcnt lgkmcnt(0)" ::: "memory"); \
    _Pragma("unroll") for (int d = 0; d < 4; ++d) _Pragma("unroll") for (int r = 0; r < 16; ++r) o[d][r] *= al_l[crow(r, hi)]; } } while (0)
  f32x16 pA0, pA1, pB0, pB1; float mnA, mnB, alA, alB; bf16x8 pa0, pa1, pa2, pa3; const int NT = seq / KVBLK;
  constexpr int SE = 0, SO = 1;
  SLOAD(SE, 0); asm volatile("s_waitcnt vmcnt(0)" ::: "memory"); SWRITE(0, SE); __syncthreads();
  qkt(pA0, pA1, K_lds, qr, r32, hi, map); partialSM(pA0, pA1, m_reg, mnA, alA);
  SLOAD(SO, KVBLK); if (2 < NT) SLOAD(SE, 2 * KVBLK);
  SWAIT(); SWRITE(1, SO); __syncthreads();
  for (int j = 1; j + 1 < NT; j += 2) {
    SBAR(); qkt(pB0, pB1, K_lds + SHM_K, qr, r32, hi, map);
    finishSM(pA0, pA1, alA, l_reg, pa0, pa1, pa2, pa3); SBAR();
    SLOAD(SO, (j + 2) * KVBLK); SBAR();
    pv_d0(o, vb0, pa0, pa1, pa2, pa3); partialSM(pB0, pB1, m_reg, mnB, alB);
    __syncthreads(); SWAIT(); SWRITE(0, SE);
    RESC(alB); __syncthreads();
    SBAR(); qkt(pA0, pA1, K_lds, qr, r32, hi, map);
    finishSM(pB0, pB1, alB, l_reg, pa0, pa1, pa2, pa3); SBAR();
    if (j + 3 < NT) SLOAD(SE, (j + 3) * KVBLK); SBAR();
    pv_d0(o, vb0 + (int)SHM_V, pa0, pa1, pa2, pa3); partialSM(pA0, pA1, m_reg, mnA, alA);
    __syncthreads(); SWAIT(); SWRITE(1, SO);
    RESC(alA); __syncthreads();
  }
  SBAR(); qkt(pB0, pB1, K_lds + SHM_K, qr, r32, hi, map);
  finishSM(pA0, pA1, alA, l_reg, pa0, pa1, pa2, pa3); SBAR();
  pv_d0(o, vb0, pa0, pa1, pa2, pa3); partialSM(pB0, pB1, m_reg, mnB, alB);
  __syncthreads(); RESC(alB);
  finishSM(pB0, pB1, alB, l_reg, pa0, pa1, pa2, pa3); SBAR();
  pv_d0(o, vb0 + (int)SHM_V, pa0, pa1, pa2, pa3);
  if (hi == 0) li_l[r32] = l_reg; asm volatile("s_waitcnt lgkmcnt(0)" ::: "memory");
  float rli[16];
#pragma unroll
  for (int r = 0; r < 16; ++r) rli[r] = __builtin_amdgcn_rcpf(li_l[crow(r, hi)]);
  __syncthreads();
  float* X = (float*)lds;
  if (map == 1) {
#pragma unroll
    for (int r = 0; r < 16; ++r)
#pragma unroll
      for (int d0 = 0; d0 < 4; ++d0) X[(wq * 32 + crow(r, hi)) * 128 + d0 * 32 + r32] = o[d0][r] * rli[r] * lam;
  }
  __syncthreads();
  if (map == 0) {
    float gs[4];
#pragma unroll
    for (int d0 = 0; d0 < 4; ++d0) gs[d0] = gsub[d0 * 32 + r32] * oscale;
    bf16* Ow = Ob + (long)(wq * 32) * D;
#pragma unroll
    for (int r = 0; r < 16; ++r) {
      float ss = 0.f;
#pragma unroll
      for (int d0 = 0; d0 < 4; ++d0) { const float v = o[d0][r] * rli[r] - X[(wq * 32 + crow(r, hi)) * 128 + d0 * 32 + r32]; o[d0][r] = v; ss += v * v; }
      ss = half_sum(ss);
      const float rs = 1.0f / sqrtf(ss * (1.0f / 128.0f) + NORM_EPS);
#pragma unroll
      for (int d0 = 0; d0 < 4; ++d0) Ow[(long)crow(r, hi) * D + d0 * 32 + r32] = (bf16)f2bf(o[d0][r] * rs * gs[d0]);
    }
  }
  __syncthreads();
#undef SLOAD
#undef SWRITE
#undef SWAIT
#undef RESC
}
#undef KSWZ
}

__device__ __forceinline__ void attn_phase(Frame& F, const Params& P, int layer, bool ctx_out, unsigned char* ldsg) {
    unsigned char* ws = fresh_ws(P.ws);
    const bf16* qb = (const bf16*)(ws + WS_Q); const bf16* kb = (const bf16*)(ws + WS_KB); const bf16* vb = (const bf16*)(ws + WS_VB); bf16* cat = (bf16*)(ws + WS_CAT);
    const Lane L;
    const float lam_init = 0.8f - 0.6f * expf(-0.3f * (float)layer);
    const float* lv = P.in[I_LAMBDA] + layer * 256;
    const float d1 = wave_sum(lv[L.lane] * lv[64 + L.lane]), d2 = wave_sum(lv[128 + L.lane] * lv[192 + L.lane]);
    const float lam = expf(d1) - expf(d2) + lam_init;
    const float* gsub = P.in[I_SUBLN] + layer * 128;
    const int nun = NB * 8 * 64 + (ctx_out ? NB * 8 * 2 : 0);
    for (int uid = F.vcu; uid < nun; uid += F.G) {
        if (uid < NB * 8 * 64) {
            const int qt = uid & 63, h = (uid >> 6) & 7, b = uid >> 9;
            const size_t qrow = (size_t)b * SEQ + 128 * qt;
            att::diff_attn_unit(qb + qrow * 1024 + h * 128, kb + (size_t)b * KVLEN * 1024 + h * 128, vb + (size_t)b * KVLEN * 1024 + h * 128,
                                cat + qrow * D + 1024 + h * 128, KVLEN, (char*)ldsg, lam, gsub, 1.0f - lam_init);
        } else {
            const int u2 = uid - NB * 8 * 64, qt = u2 & 1, h = (u2 >> 1) & 7, b = u2 >> 4;
            const size_t qrow = (size_t)NLAT + b * CTXL + 128 * qt;
            att::diff_attn_unit(qb + qrow * 1024 + h * 128, kb + (size_t)b * KVLEN * 1024 + h * 128, vb + (size_t)b * KVLEN * 1024 + h * 128,
                                cat + qrow * D + 1024 + h * 128, CTXL, (char*)ldsg, lam, gsub, 1.0f - lam_init);
        }
    }
}
struct MoePanels { int ps[9]; };
__device__ __forceinline__ MoePanels moe_panels(Frame& F) {
    MoePanels m; int acc = 0;
#pragma unroll
    for (int e = 0; e < NE; ++e) { m.ps[e] = acc; const int c = (int)__builtin_amdgcn_readfirstlane(__hip_atomic_load(F.ctl + CW_CNT + 64 * e, RLX_AGENT)); acc += (c + 255) >> 8; }
    m.ps[8] = acc; return m;
}
__device__ __forceinline__ void moe_gather_phase(Frame& F, const Params& P) {
    unsigned char* ws = fresh_ws(P.ws);
    const bf16* h = (const bf16*)(ws + WS_H); bf16* Ag = (bf16*)(ws + WS_AG);
    const int* tok_e = (const int*)(ws + WS_ROUTE); const int* tok_slot = tok_e + 2 * NLAT;
    const MoePanels mp = moe_panels(F);
    const Lane L; const int gw = F.vcu * NWAVES + F.wave, NGW = F.G * NWAVES, lane = L.lane;
    for (int a = gw; a < 2 * NLAT; a += NGW) {
        const int r = a >> 1, e = tok_e[a], slot = tok_slot[a];
        int pse = 0;
#pragma unroll
        for (int q = 0; q < NE; ++q) pse = (q == e) ? mp.ps[q] : pse;
        const v4u* src = (const v4u*)(h + (size_t)r * D) + lane; v4u* dst = (v4u*)(Ag + ((size_t)pse * 256 + slot) * D) + lane;
#pragma unroll
        for (int j = 0; j < 4; ++j) dst[64 * j] = src[64 * j];
    }
    for (int e = 0; e < NE; ++e) {
        const int c = (int)__builtin_amdgcn_readfirstlane(__hip_atomic_load(F.ctl + CW_CNT + 64 * e, RLX_AGENT));
        const int pad = ((c + 255) & ~255) - c;
        for (int q = gw; q < pad; q += NGW) { v4u* dst = (v4u*)(Ag + ((size_t)mp.ps[e] * 256 + c + q) * D) + lane;
#pragma unroll
            for (int j = 0; j < 4; ++j) dst[64 * j] = (v4u){0u, 0u, 0u, 0u}; }
    }
}
__device__ __forceinline__ void final_phase(Frame& F, const Params& P, const float* modl) {
    unsigned char* ws = fresh_ws(P.ws);
    const float* xl = (const float*)(ws + WS_XL); const bf16* yb = (const bf16*)(ws + WS_AG);
    const int* tok_e = (const int*)(ws + WS_ROUTE); const int* tok_slot = tok_e + 2 * NLAT; const float* tok_p = (const float*)(tok_slot + 2 * NLAT);
    const MoePanels mp = moe_panels(F);
    const Lane L; const int gw = F.vcu * NWAVES + F.wave, NGW = F.G * NWAVES, lane = L.lane;
    const float* gf = P.in[I_GFIN];
    for (int r = gw; r < NLAT; r += NGW) {
        const int v = r < SEQ ? 0 : 1; const float* g5 = modl + (size_t)(v * 6 + 5) * D;
        const int e0 = tok_e[2 * r], e1 = tok_e[2 * r + 1];
        int p0s = 0, p1s = 0;
#pragma unroll
        for (int q = 0; q < NE; ++q) { p0s = (q == e0) ? mp.ps[q] : p0s; p1s = (q == e1) ? mp.ps[q] : p1s; }
        const bf16* y0 = yb + ((size_t)p0s * 256 + tok_slot[2 * r]) * D; const bf16* y1 = yb + ((size_t)p1s * 256 + tok_slot[2 * r + 1]) * D;
        const float w0 = tok_p[2 * r], w1 = tok_p[2 * r + 1];
        f32x4 x[8]; float ss = 0.f;
#pragma unroll
        for (int jq = 0; jq < 8; ++jq) { const int c = 4 * lane + 256 * jq;
            const v2u a = *(const v2u*)(y0 + c), bq = *(const v2u*)(y1 + c); const f32x4 g = *(const f32x4*)(g5 + c); const f32x4 xv = *(const f32x4*)(xl + (size_t)r * D + c);
            f32x4 y; y[0] = w0 * bflo(a.x) + w1 * bflo(bq.x); y[1] = w0 * bfhi(a.x) + w1 * bfhi(bq.x); y[2] = w0 * bflo(a.y) + w1 * bflo(bq.y); y[3] = w0 * bfhi(a.y) + w1 * bfhi(bq.y);
            x[jq] = xv + g * y; ss += (x[jq][0] * x[jq][0] + x[jq][1] * x[jq][1]) + (x[jq][2] * x[jq][2] + x[jq][3] * x[jq][3]); }
        const float rstd = 1.0f / sqrtf(wave_sum(ss) * (1.0f / D) + NORM_EPS);
#pragma unroll
        for (int jq = 0; jq < 8; ++jq) { const int c = 4 * lane + 256 * jq; *(f32x4*)(P.out + (size_t)r * D + c) = (x[jq] * rstd) * *(const f32x4*)(gf + c); }
    }
}
#if DBG
constexpr size_t WS_DBG = 3 * MiB;
__device__ __forceinline__ void dbg_err(Frame& F, int k, float got, float want, float scale) {
    float e = fabsf(got - want) / scale; if (!(e == e)) e = 1e9f;
    atomicMax((unsigned*)(F.ctl + CW_DIAG + 64 * k), __float_as_uint(e));
}
__device__ __forceinline__ unsigned dbg_hash(unsigned x) { x ^= x >> 16; x *= 0x7feb352du; x ^= x >> 15; x *= 0x846ca68bu; x ^= x >> 16; return x; }
__device__ __forceinline__ float block_sum(float v, LAS float* red, int tid) {
    v = wave_sum(v); __syncthreads(); if ((tid & 63) == 0) red[tid >> 6] = v; __syncthreads();
    float s = 0.f; for (int w = 0; w < 8; ++w) s += red[w]; __syncthreads(); return s;
}
__device__ __forceinline__ float block_max(float v, LAS float* red, int tid) {
    v = fmaxf(v, dpp_f(v, 0)); v = fmaxf(v, dpp_f(v, 1)); v = fmaxf(v, dpp_f(v, 2)); v = fmaxf(v, dpp_f(v, 3));
    v = fmaxf(v, __builtin_bit_cast(float, __builtin_amdgcn_ds_swizzle(__builtin_bit_cast(int, v), 0x401F)));
    v = cross_max(v);
    __syncthreads(); if ((tid & 63) == 0) red[tid >> 6] = v; __syncthreads();
    float s = red[0]; for (int w = 1; w < 8; ++w) s = fmaxf(s, red[w]); __syncthreads(); return s;
}
__device__ __forceinline__ const float* dbg_res_row(const Params& P, int layer, int r) {
    const float* xl = (const float*)(fresh_ws(P.ws) + WS_XL);
    if (layer == 0) return r < NLAT ? P.in[I_X] + (size_t)r * D : P.in[I_CTX] + (size_t)(r - NLAT) * D;
    return xl + (size_t)r * D;
}
__device__ __forceinline__ int dbg_vec(int r) { return r < SEQ ? 0 : (r < NLAT ? 1 : 2); }

__device__ __forceinline__ void dbg_check_norm(Frame& F, const Params& P, int layer) {
    const int tid = fresh_tid(); LAS float* hn = (LAS float*)F.lds; LAS float* red = hn + D;
    const float* modl = (const float*)(fresh_ws(P.ws) + WS_MOD) + (size_t)layer * 3 * 12288;
    { const float t1 = block_sum(1.0f, red, tid), t2 = block_sum((float)tid, red, tid), t3 = wave_sum((float)(tid & 63));
      dbg_err(F, 2, t1, 512.0f, 1.0f); dbg_err(F, 3, t2, 130816.0f, 1.0f); dbg_err(F, 4, t3, 2016.0f, 1.0f); }
    for (int s = F.vcu; s < 256; s += F.G) {
        const unsigned hsh = dbg_hash(s * 2654435761u + 17u + layer);
        const int r = (s & 7) == 7 ? NLAT + (hsh % NCTX) : (int)(hsh % NLAT);
        const float* xr = dbg_res_row(P, layer, r); const int v = dbg_vec(r);
        float ss = 0.f; for (int k = tid; k < D; k += 512) ss += xr[k] * xr[k];
        ss = block_sum(ss, red, tid); const float rstd = 1.0f / sqrtf(ss / D + NORM_EPS);
        const bf16* hr = (const bf16*)(fresh_ws(P.ws) + WS_H) + (size_t)r * D;
        for (int k = tid; k < D; k += 512) { const float want = (xr[k] * rstd * P.in[I_GMIX][layer * D + k]) * (1.0f + modl[(v * 6 + 1) * D + k]) + modl[(v * 6 + 0) * D + k]; dbg_err(F, 0, bf2f(hr[k]), want, 1.0f); }
        const int v2 = s % 3, j = (int)((hsh >> 5) % 12288);
        float a = 0.f; for (int k = tid; k < D; k += 512) { const float c = v2 < 2 ? P.in[I_C][v2 * D + k] : P.in[I_CCTX][k]; a += c / (1.0f + expf(-c)) * P.in[I_WMOD][((size_t)layer * D + k) * 12288 + j]; }
        a = block_sum(a, red, tid);
        if (tid == 0) dbg_err(F, 1, modl[v2 * 12288 + j], a + P.in[I_BMOD][layer * 12288 + j], 1.0f);
        __syncthreads();
    }
}
__device__ __forceinline__ void dbg_check_inproj(Frame& F, const Params& P, int layer) {
    const int tid = fresh_tid(); LAS float* hn = (LAS float*)F.lds; LAS float* red = hn + D;
    const float* modl = (const float*)(fresh_ws(P.ws) + WS_MOD) + (size_t)layer * 3 * 12288;
    for (int s = F.vcu; s < 256; s += F.G) {
        const unsigned hsh = dbg_hash(s * 2654435761u + 17u + layer);
        const int r = (s & 7) == 7 ? NLAT + (hsh % NCTX) : (int)(hsh % NLAT);
        int c = (int)((hsh >> 8) % IN_COLS); if ((s & 3) == 1) c = COL_Q + (int)((hsh >> 8) % 1024); if ((s & 3) == 2) c = COL_K + (int)((hsh >> 8) % 1024); if ((s & 15) == 3) c = COL_DT + (int)((hsh >> 8) % 16);
        const float* xr = dbg_res_row(P, layer, r); const int v = dbg_vec(r);
        float ss = 0.f; for (int k = tid; k < D; k += 512) ss += xr[k] * xr[k];
        ss = block_sum(ss, red, tid); const float rstd = 1.0f / sqrtf(ss / D + NORM_EPS);
        for (int k = tid; k < D; k += 512) hn[k] = (xr[k] * rstd * P.in[I_GMIX][layer * D + k]) * (1.0f + modl[(v * 6 + 1) * D + k]) + modl[(v * 6 + 0) * D + k];
        __syncthreads();
        const float* w = P.in[I_WIN] + (size_t)layer * D * IN_COLS;
        const bool qk = (c >= COL_Q && c < COL_Q + 1024) || (c >= COL_K && c < COL_K + 1024);
        int cp = c; if (qk) { const int base = c >= COL_K ? COL_K : COL_Q; const int cl = (c - base) & 31; cp = c - cl + ((cl + 16) & 31); }
        float d0 = 0.f, d1 = 0.f; for (int k = tid; k < D; k += 512) { d0 += hn[k] * w[(size_t)k * IN_COLS + c]; d1 += hn[k] * w[(size_t)k * IN_COLS + cp]; }
        d0 = block_sum(d0, red, tid); d1 = block_sum(d1, red, tid);
        if (tid == 0) {
            float want = d0, got;
            if (c < COL_Z) got = bf2f(((const bf16*)(fresh_ws(P.ws) + WS_CONV))[(size_t)r * 1536 + c]);
            else if (c < COL_Q) got = bf2f(((const bf16*)(fresh_ws(P.ws) + WS_Z))[(size_t)r * 512 + c - COL_Z]);
            else if (c < COL_XBC) got = 0.f;
            else if (c < COL_DT) got = bf2f(((const bf16*)(fresh_ws(P.ws) + WS_XBC))[(size_t)r * 1024 + c - COL_XBC]);
            else if (c < COL_K) got = ((const float*)(fresh_ws(P.ws) + WS_DT))[(size_t)r * 16 + c - COL_DT];
            else if (c < COL_V) got = 0.f;
            else { const size_t kr = r < NLAT ? (size_t)(r / SEQ) * KVLEN + CTXL + (r % SEQ) : (size_t)((r - NLAT) / CTXL) * KVLEN + (r - NLAT) % CTXL; got = bf2f(((const bf16*)(fresh_ws(P.ws) + WS_VB))[kr * 1024 + c - COL_V]); }
            if (qk) {
                const int base = c >= COL_K ? COL_K : COL_Q; const int cc = c - base, cl = cc & 31, seg = (cc >> 5) & 1, f = cl & 15;
                if (r < NLAT) { const int t = r % SEQ; const float pos = seg ? (float)(t % 64) : (float)(t / 64); const float inv = powf(10000.0f, -(float)f / 16.0f); const float ang = pos * inv;
                    want = cl < 16 ? d0 * cosf(ang) - d1 * sinf(ang) : d0 * cosf(ang) + d1 * sinf(ang); }
                const int mem = (cc & ~31) + pg8::perm32(cl);
                if (base == COL_Q) got = bf2f(((const bf16*)(fresh_ws(P.ws) + WS_Q))[(size_t)r * 1024 + mem]);
                else { const size_t kr = r < NLAT ? (size_t)(r / SEQ) * KVLEN + CTXL + (r % SEQ) : (size_t)((r - NLAT) / CTXL) * KVLEN + (r - NLAT) % CTXL; got = bf2f(((const bf16*)(fresh_ws(P.ws) + WS_KB))[kr * 1024 + mem]); }
            }
            { const int seg = ((c - (c >= COL_K ? COL_K : COL_Q)) >> 5) & 1; const int slot = (r < NLAT ? 0 : 3) + (qk ? 1 + seg : 0); dbg_err(F, slot, got, want, 1.0f); }
        }
        __syncthreads();
    }
}
__device__ __forceinline__ void dbg_check_attn(Frame& F, const Params& P, int layer) {
    const int tid = fresh_tid(); LAS float* sc1 = (LAS float*)F.lds; LAS float* sc2 = sc1 + KVLEN; LAS float* red = sc2 + KVLEN; LAS float* ov = red + 16; LAS float* qv = ov + 512;
    const bf16* qb = (const bf16*)(fresh_ws(P.ws) + WS_Q); const bf16* kb = (const bf16*)(fresh_ws(P.ws) + WS_KB); const bf16* vb = (const bf16*)(fresh_ws(P.ws) + WS_VB); const bf16* cat = (const bf16*)(fresh_ws(P.ws) + WS_CAT);
    const float lam_init = 0.8f - 0.6f * expf(-0.3f * (float)layer); const float* lv = P.in[I_LAMBDA] + layer * 256;
    float d1 = 0.f, d2 = 0.f; for (int i = 0; i < 64; ++i) { d1 += lv[i] * lv[64 + i]; d2 += lv[128 + i] * lv[192 + i]; }
    const float lam = expf(d1) - expf(d2) + lam_init;
    for (int s = F.vcu; s < 64; s += F.G) {
        const unsigned hsh = dbg_hash(s * 2654435761u + 99u + layer);
        const bool isctx = layer == 0 && (s & 7) == 7; const int h = (hsh >> 4) & 7;
        const int r = isctx ? NLAT + (int)(hsh % NCTX) : (int)((hsh >> 7) % NLAT);
        const int b = isctx ? (r - NLAT) / CTXL : r / SEQ; const int nk = isctx ? CTXL : KVLEN;
        if (tid < 128) qv[tid] = bf2f(qb[(size_t)r * 1024 + h * 128 + tid]);
        __syncthreads();
        float m1 = -1e30f, m2 = -1e30f;
        for (int k = tid; k < nk; k += 512) { const bf16* kr = kb + ((size_t)b * KVLEN + k) * 1024 + h * 128; float a = 0.f, c2 = 0.f;
            for (int d = 0; d < 64; ++d) { a += qv[d] * bf2f(kr[d]); c2 += qv[64 + d] * bf2f(kr[64 + d]); }
            a *= 0.125f; c2 *= 0.125f; sc1[k] = a; sc2[k] = c2; m1 = fmaxf(m1, a); m2 = fmaxf(m2, c2); }
        m1 = block_max(m1, red, tid); m2 = block_max(m2, red, tid);
        float l1 = 0.f, l2 = 0.f;
        for (int k = tid; k < nk; k += 512) { const float p1 = expf(sc1[k] - m1), p2 = expf(sc2[k] - m2); sc1[k] = p1; sc2[k] = p2; l1 += p1; l2 += p2; }
        l1 = block_sum(l1, red, tid); l2 = block_sum(l2, red, tid);
        { const int d = tid & 127, part = tid >> 7; float o = 0.f;
          for (int k = part; k < nk; k += 4) o += (sc1[k] / l1 - lam * sc2[k] / l2) * bf2f(vb[((size_t)b * KVLEN + k) * 1024 + h * 128 + d]);
          ov[tid] = o; }
        __syncthreads();
        float o = 0.f, sq = 0.f; if (tid < 128) { o = ov[tid] + ov[128 + tid] + ov[256 + tid] + ov[384 + tid]; sq = o * o; }
        sq = block_sum(sq, red, tid);
        if (tid < 128) { const float want = o / sqrtf(sq / 128.0f + NORM_EPS) * P.in[I_SUBLN][layer * 128 + tid] * (1.0f - lam_init);
            dbg_err(F, 1, bf2f(cat[(size_t)r * D + 1024 + h * 128 + tid]), want, 1.0f); }
        __syncthreads();
    }
}
__device__ __forceinline__ void dbg_expect_rows(Frame& F, const Params& P, int layer, int which) {
    const int tid = fresh_tid(); LAS float* hn = (LAS float*)F.lds; LAS float* act = hn + D; LAS float* red = act + FFD;
    const float* modl = (const float*)(fresh_ws(P.ws) + WS_MOD) + (size_t)layer * 3 * 12288; float* ex = (float*)(fresh_ws(P.ws) + WS_DBG) + (size_t)which * 16 * D;
    for (int s = F.vcu; s < 16; s += F.G) {
        const unsigned hsh = dbg_hash(s * 2654435761u + 7u + which * 131u + layer);
        const int r = (s & 7) == 7 && layer == 0 ? NLAT + (int)(hsh % NCTX) : (int)(hsh % NLAT); const int v = dbg_vec(r);
        if (which == 0) {
            const bf16* cr = (const bf16*)(fresh_ws(P.ws) + WS_CAT) + (size_t)r * D; const float* w = P.in[I_WOUT] + (size_t)layer * D * D; const float* res = dbg_res_row(P, layer, r);
            for (int k = tid; k < D; k += 512) hn[k] = bf2f(cr[k]);
            __syncthreads();
            for (int c = tid; c < D; c += 512) { float a = 0.f; for (int k = 0; k < D; ++k) a += hn[k] * w[(size_t)k * D + c]; ex[s * D + c] = res[c] + modl[(v * 6 + 2) * D + c] * a; }
        } else {
            const float* xr = (const float*)(fresh_ws(P.ws) + WS_XL) + (size_t)r * D;
            float ss = 0.f; for (int k = tid; k < D; k += 512) ss += xr[k] * xr[k];
            ss = block_sum(ss, red, tid); const float rstd = 1.0f / sqrtf(ss / D + NORM_EPS);
            for (int k = tid; k < D; k += 512) hn[k] = (xr[k] * rstd * P.in[I_GFFN][layer * D + k]) * (1.0f + modl[(v * 6 + 4) * D + k]) + modl[(v * 6 + 3) * D + k];
            __syncthreads();
            for (int j = tid; j < FFD; j += 512) { float g = 0.f, u = 0.f; for (int k = 0; k < D; ++k) { g += hn[k] * P.in[I_FG][(size_t)k * FFD + j]; u += hn[k] * P.in[I_FU][(size_t)k * FFD + j]; } act[j] = g / (1.0f + expf(-g)) * u; }
            __syncthreads();
            { float* ex2 = (float*)(fresh_ws(P.ws) + WS_DBG + 256 * 1024) + (size_t)s * 7680; for (int k = tid; k < D; k += 512) ex2[k] = hn[k]; for (int j = tid; j < FFD; j += 512) ex2[D + j] = act[j]; }
            for (int c = tid; c < D; c += 512) { float a = 0.f; for (int j = 0; j < FFD; ++j) a += act[j] * P.in[I_FD][(size_t)j * D + c]; ex[s * D + c] = xr[c] + modl[(v * 6 + 5) * D + c] * a; }
        }
        __syncthreads();
    }
}
__device__ __forceinline__ void dbg_compare_rows(Frame& F, const Params& P, int layer, int which) {
    const int tid = fresh_tid(); const float* ex = (const float*)(fresh_ws(P.ws) + WS_DBG) + (size_t)which * 16 * D;
    for (int s = F.vcu; s < 16; s += F.G) {
        const unsigned hsh = dbg_hash(s * 2654435761u + 7u + which * 131u + layer);
        const int r = (s & 7) == 7 && layer == 0 ? NLAT + (int)(hsh % NCTX) : (int)(hsh % NLAT);
        const float* xr = (const float*)(fresh_ws(P.ws) + WS_XL) + (size_t)r * D;
        for (int c = tid; c < D; c += 512) dbg_err(F, 2 + which, xr[c], ex[s * D + c], 1.0f);
        if (which == 1) { const float* ex2 = (const float*)(fresh_ws(P.ws) + WS_DBG + 256 * 1024) + (size_t)s * 7680;
            const bf16* hr = (const bf16*)(fresh_ws(P.ws) + WS_H) + (size_t)r * D; const bf16* ar = (const bf16*)(fresh_ws(P.ws) + WS_ACT) + (size_t)r * FFD;
            for (int k = tid; k < D; k += 512) dbg_err(F, 0, bf2f(hr[k]), ex2[k], 1.0f);
            for (int j = tid; j < FFD; j += 512) dbg_err(F, 1, bf2f(ar[j]), ex2[D + j], 1.0f); }
    }
}
__device__ __forceinline__ void dbg_check_moe(Frame& F, const Params& P) {
    const int tid = fresh_tid(); LAS float* hn = (LAS float*)F.lds; LAS float* act = hn + D; LAS float* yv = act + FFE; LAS float* red = yv + D; LAS float* lg = red + 16;
    const float* modl = (const float*)(fresh_ws(P.ws) + WS_MOD) + (size_t)1 * 3 * 12288;
    for (int s = F.vcu; s < 16; s += F.G) {
        const unsigned hsh = dbg_hash(s * 2654435761u + 1234u); const int r = (int)(hsh % NLAT), v = dbg_vec(r);
        const float* xr = (const float*)(fresh_ws(P.ws) + WS_XL) + (size_t)r * D;
        float ss = 0.f; for (int k = tid; k < D; k += 512) ss += xr[k] * xr[k];
        ss = block_sum(ss, red, tid); const float rstd = 1.0f / sqrtf(ss / D + NORM_EPS);
        for (int k = tid; k < D; k += 512) { hn[k] = (xr[k] * rstd * P.in[I_GFFN][D + k]) * (1.0f + modl[(v * 6 + 4) * D + k]) + modl[(v * 6 + 3) * D + k]; yv[k] = 0.f; }
        __syncthreads();
        for (int e = 0; e < NE; ++e) { float a = 0.f; for (int k = tid; k < D; k += 512) a += hn[k] * P.in[I_RW][k * NE + e]; a = block_sum(a, red, tid); if (tid == 0) lg[e] = a + P.in[I_RB][e]; }
        __syncthreads();
        int i0 = 0; for (int e = 1; e < NE; ++e) if (lg[e] > lg[i0]) i0 = e;
        int i1 = -1; for (int e = 0; e < NE; ++e) if (e != i0 && (i1 < 0 || lg[e] > lg[i1])) i1 = e;
        const float p0 = 1.0f / (1.0f + expf(lg[i1] - lg[i0])), p1 = 1.0f - p0;
        for (int kk = 0; kk < 2; ++kk) {
            const int e = kk ? i1 : i0; const float pe = kk ? p1 : p0;
            const float* wg = P.in[I_MG] + (size_t)e * D * FFE; const float* wu = P.in[I_MU] + (size_t)e * D * FFE; const float* wd = P.in[I_MD] + (size_t)e * FFE * D;
            for (int j = tid; j < FFE; j += 512) { float g = 0.f, u = 0.f; for (int k = 0; k < D; ++k) { g += hn[k] * wg[(size_t)k * FFE + j]; u += hn[k] * wu[(size_t)k * FFE + j]; } act[j] = g / (1.0f + expf(-g)) * u; }
            __syncthreads();
            for (int c = tid; c < D; c += 512) { float a = 0.f; for (int j = 0; j < FFE; ++j) a += act[j] * wd[(size_t)j * D + c]; yv[c] += pe * a; }
            __syncthreads();
        }
        float q = 0.f; for (int c = tid; c < D; c += 512) { const float o = xr[c] + modl[(v * 6 + 5) * D + c] * yv[c]; yv[c] = o; q += o * o; }
        q = block_sum(q, red, tid); const float rs = 1.0f / sqrtf(q / D + NORM_EPS);
        for (int c = tid; c < D; c += 512) dbg_err(F, 4, P.out[(size_t)r * D + c], yv[c] * rs * P.in[I_GFIN][c], 1.0f);
        if (tid == 0) { const int* te = (const int*)(fresh_ws(P.ws) + WS_ROUTE); const float* tp = (const float*)(te + 4 * NLAT);
            const bool close = fabsf(lg[i1] - lg[i0]) < 1e-3f;
            if (!close) { dbg_err(F, 5, (float)te[2 * r], (float)i0, 1.0f); dbg_err(F, 5, tp[2 * r], p0, 1.0f); } }
        __syncthreads();
    }
}
__device__ __forceinline__ void dbg_report(Frame& F, const Params& P) {
    const int tid = fresh_tid();
    for (size_t i = (size_t)F.vcu * 512 + tid; i < (size_t)NLAT * D; i += (size_t)F.G * 512) P.out[i] = 0.f;
    if (F.vcu == 0 && tid == 0) {
#if DBG_REPORT >= 0
        const float e = __uint_as_float(__hip_atomic_load(F.ctl + CW_DIAG + 64 * DBG_REPORT, RLX_AGENT));
        int bucket = 0; { float t = e * 1024.0f; while (t >= 2.0f && bucket < 60) { t *= 0.5f; ++bucket; } }
        P.out[0] = 1000.0f * (float)(10 + bucket);
#else
        const float thr[6] = {0.06f, 0.06f, 0.08f, 0.08f, 0.06f, 0.06f}; int mask = 0;
        for (int k = 0; k < 6; ++k) { const float e = __uint_as_float(__hip_atomic_load(F.ctl + CW_DIAG + 64 * k, RLX_AGENT)); if (e > thr[k]) mask |= 1 << k; }
        P.out[0] = 1000.0f * (float)(10 + mask);
#endif
    }
}
#endif
#ifndef EN_PRO
#define EN_PRO 1
#endif
#ifndef EN_NORM
#define EN_NORM 1
#endif
#ifndef EN_GIN
#define EN_GIN 1
#endif
#ifndef EN_CONV
#define EN_CONV 1
#endif
#ifndef EN_S1
#define EN_S1 1
#endif
#ifndef EN_S2
#define EN_S2 1
#endif
#ifndef EN_S3
#define EN_S3 1
#endif
#ifndef EN_ATT
#define EN_ATT 1
#endif
#ifndef EN_WOUT
#define EN_WOUT 1
#endif
#ifndef EN_GU
#define EN_GU 1
#endif
#ifndef EN_DN
#define EN_DN 1
#endif
#ifndef EN_ROUTE
#define EN_ROUTE 1
#endif
#ifndef EN_GATH
#define EN_GATH 1
#endif
#ifndef EN_MGU
#define EN_MGU 1
#endif
#ifndef EN_MDN
#define EN_MDN 1
#endif
#ifndef EN_FIN
#define EN_FIN 1
#endif
__global__ void __launch_bounds__(NWAVES * 64, 2) fwd_kernel(Params P) {
    extern __shared__ __attribute__((aligned(16))) unsigned char lds[];
    Frame F;
    F.lds = (LAS unsigned char*)lds;
    F.MISC = (volatile LAS unsigned*)(F.lds + MISC_OFF);
    F.wave = __builtin_amdgcn_readfirstlane(threadIdx.x >> 6);
    F.G = gridDim.x; { const int bx = blockIdx.x; F.vcu = (F.G % 8 == 0) ? (bx % 8) * (F.G / 8) + bx / 8 : bx; }
    unsigned char* ws = P.ws;
    F.ctl = (gu32*)(ws + WS_CTL);
    for (int u = threadIdx.x; u < (LDS_BYTES - LDSCTL_OFF) / 4; u += NWAVES * 64) ((LAS unsigned*)(F.lds + LDSCTL_OFF))[u] = 0u;
    __syncthreads();
    XcdBarrier bar = xcd_barrier_post((unsigned*)(ws + WS_CTL) + CW_BAR, F.MISC + 8);
#if SIMPLE_BAR
    unsigned nbar = 0;
#define GRID_BAR() do { ++nbar; simple_barrier((unsigned*)(ws + WS_CTL) + 2048, nbar * (unsigned)gridDim.x); } while (0)
#else
#define GRID_BAR() xcd_barrier(bar)
#endif

    float* xl = (float*)(ws + WS_XL); bf16* hb = (bf16*)(ws + WS_H); bf16* cat = (bf16*)(ws + WS_CAT);
    const float* mod = (const float*)(ws + WS_MOD);
    int* tok_e = (int*)(ws + WS_ROUTE); int* tok_slot = tok_e + 2 * NLAT; float* tok_p = (float*)(tok_slot + 2 * NLAT);

#if EN_PRO
    p0_prologue(F, P);
#endif
    GRID_BAR();

    for (int layer = 0; layer < 2; ++layer) {
        ws = fresh_ws(P.ws); F.wave = fresh_s(F.wave); F.vcu = fresh_s(F.vcu); F.G = fresh_s(F.G);
        const float* modl = mod + (size_t)layer * 3 * 12288;
        const float* resLat = layer == 0 ? P.in[I_X] : xl; const float* resCtx = layer == 0 ? P.in[I_CTX] : xl + (size_t)NLAT * D;
#if EN_NORM
        norm_phase<false>(F, resLat, resCtx, P.in[I_GMIX] + layer * D, modl, 0, 1, hb, T, nullptr, nullptr, nullptr, nullptr, nullptr);
#endif
        GRID_BAR();
#if DBG
        if ((DBG_MASK & 32) && layer == DBG_L) { dbg_check_norm(F, P, layer); }
#endif
        {
            pg8::PlainSched S; S.init(T / 256, NIN / 256, F.G, (int)blockIdx.x); S.A = (const char*)hb; S.Bt = (const char*)(ws + WS_WIN + layer * SZ_WIN); S.tstep = (size_t)256 * D * 2;
            pg8::EpiIn E{(bf16*)(ws + WS_CONV), (bf16*)(ws + WS_Z), (bf16*)(ws + WS_Q), (bf16*)(ws + WS_XBC), (bf16*)(ws + WS_KB), (bf16*)(ws + WS_VB), (float*)(ws + WS_DT),
                         (const float*)(ws + WS_ROPE), (const float*)(ws + WS_ROPE) + 192 * 16};
#if EN_GIN
            pg8::gemm_phase<pg8::EpiIn, pg8::PlainSched, true, true>(F.lds + RING_OFF, D, S, E);
#endif
        }
        GRID_BAR();
#if DBG
        if ((DBG_MASK & 1) && layer == DBG_L) { dbg_check_inproj(F, P, layer); }
#endif
#if EN_CONV
        conv_phase(F, (const bf16*)(ws + WS_CONV), (const bf16*)(ws + WS_XBC), cat, (bf16*)(ws + WS_XBCC), P.in[I_CONVW] + layer * 1536, P.in[I_SCONVW] + layer * 3072, P.in[I_SCONVB] + layer * 1024);
#endif
        GRID_BAR();
#if EN_S1
        ssd_local_phase(F, P, layer);
#endif
        GRID_BAR();
#if EN_S2
        ssd_scan_phase(F, P);
#endif
        GRID_BAR();
#if EN_S3
        ssd_out_phase(F, P, layer);
#endif
#if EN_ATT
        attn_phase(F, P, layer, layer == 0, lds);
#endif
        GRID_BAR();
#if DBG
        if (layer == DBG_L) { if (DBG_MASK & 2) dbg_check_attn(F, P, layer); if (DBG_MASK & 4) dbg_expect_rows(F, P, layer, 0); GRID_BAR(); }
#endif
        {
            pg8::PlainSched S; S.init(layer == 0 ? T / 256 : NLAT / 256, D / 256, F.G, (int)blockIdx.x); S.A = (const char*)cat; S.Bt = (const char*)(ws + WS_WOUT + layer * SZ_WOUT); S.tstep = (size_t)256 * D * 2;
            pg8::EpiResid E{resLat, resCtx, xl, modl + 2 * D};
#if EN_WOUT
            pg8::gemm_phase<pg8::EpiResid, pg8::PlainSched, true, true>(F.lds + RING_OFF, D, S, E);
#endif
        }
        GRID_BAR();
#if DBG
        if ((DBG_MASK & 4) && layer == DBG_L) { dbg_compare_rows(F, P, layer, 0); }
        if ((DBG_MASK & 8) && layer == 0) { dbg_expect_rows(F, P, layer, 1); GRID_BAR(); }
#endif
        if (layer == 0) {
            norm_phase<false>(F, xl, xl + (size_t)NLAT * D, P.in[I_GFFN], modl, 3, 4, hb, T, nullptr, nullptr, nullptr, nullptr, nullptr);
            GRID_BAR();
            {
                pg8::PlainSched S; S.init(T / 256, 2 * FFD / 256, F.G, (int)blockIdx.x); S.A = (const char*)hb; S.Bt = (const char*)(ws + WS_WGU); S.tstep = (size_t)256 * D * 2;
                pg8::EpiSwiGLU E{(bf16*)(ws + WS_ACT), FFD};
#if EN_GU
                pg8::gemm_phase<pg8::EpiSwiGLU, pg8::PlainSched, true, true>(F.lds + RING_OFF, D, S, E);
#endif
            }
            GRID_BAR();
            {
                pg8::PlainSched S; S.init(T / 256, D / 256, F.G, (int)blockIdx.x); S.A = (const char*)(ws + WS_ACT); S.Bt = (const char*)(ws + WS_WDN); S.tstep = (size_t)256 * FFD * 2;
                pg8::EpiResid E{xl, xl + (size_t)NLAT * D, xl, modl + 5 * D};
#if EN_DN
                pg8::gemm_phase<pg8::EpiResid, pg8::PlainSched, true, true>(F.lds + RING_OFF, FFD, S, E);
#endif
            }
            GRID_BAR();
#if DBG
            if (DBG_MASK & 8) dbg_compare_rows(F, P, layer, 1);
#endif
        } else {
#if EN_ROUTE
            norm_phase<true>(F, xl, xl + (size_t)NLAT * D, P.in[I_GFFN] + D, modl, 3, 4, hb, NLAT, P.in[I_RW], P.in[I_RB], tok_e, tok_slot, tok_p);
#endif
            GRID_BAR();
#if EN_GATH
            moe_gather_phase(F, P);
#endif
            GRID_BAR();
            {
                const MoePanels mp = moe_panels(F);
                pg8::MoeSched S; S.init(mp.ps[8], 2 * FFE / 256, F.G, (int)blockIdx.x); S.A = (const char*)(ws + WS_AG); S.Bt = (const char*)(ws + WS_MGU); S.tstep = (size_t)256 * D * 2; S.estride = SZ_MGU;
                S.ps1 = mp.ps[1]; S.ps2 = mp.ps[2]; S.ps3 = mp.ps[3]; S.ps4 = mp.ps[4]; S.ps5 = mp.ps[5]; S.ps6 = mp.ps[6]; S.ps7 = mp.ps[7];
                pg8::EpiSwiGLU E{(bf16*)(ws + WS_MACT), FFE};
#if EN_MGU
                pg8::gemm_phase<pg8::EpiSwiGLU, pg8::MoeSched, true, true>(F.lds + RING_OFF, D, S, E);
#endif
            }
            GRID_BAR();
            {
                const MoePanels mp = moe_panels(F);
                pg8::MoeSched S; S.init(mp.ps[8], D / 256, F.G, (int)blockIdx.x); S.A = (const char*)(ws + WS_MACT); S.Bt = (const char*)(ws + WS_MDN); S.tstep = (size_t)256 * FFE * 2; S.estride = SZ_MDN;
                S.ps1 = mp.ps[1]; S.ps2 = mp.ps[2]; S.ps3 = mp.ps[3]; S.ps4 = mp.ps[4]; S.ps5 = mp.ps[5]; S.ps6 = mp.ps[6]; S.ps7 = mp.ps[7];
                pg8::EpiBf16 E{(bf16*)(ws + WS_AG), D};
#if EN_MDN
                pg8::gemm_phase<pg8::EpiBf16, pg8::MoeSched, true, true>(F.lds + RING_OFF, FFE, S, E);
#endif
            }
            GRID_BAR();
#if EN_FIN
            final_phase(F, P, modl);
#endif
#if DBG
            GRID_BAR(); if (DBG_MASK & 16) dbg_check_moe(F, P); GRID_BAR(); dbg_report(F, P);
#endif
        }
    }
}

extern "C" void kernel_launch(void* const* d_in, const int* in_sizes, int n_in, void* d_out, int out_size, void* d_ws, size_t ws_size, hipStream_t stream) {
    static int grid = 0;
    if (grid == 0) {
        if (n_in != 28 || in_sizes[0] != NLAT * D || out_size != NLAT * D || ws_size < WS_END) {
            fprintf(stderr, "kernel_launch: built for 28 inputs, x/out of %d floats, >= %zu bytes of workspace; got n_in %d, in0 %d, out %d, ws %zu; nothing launched\n", NLAT * D, (size_t)WS_END, n_in, n_in > 0 ? in_sizes[0] : -1, out_size, ws_size);
            grid = -1; return; }
        int dev = 0, cus = 0, per_cu = 0;
        if (hipGetDevice(&dev) != hipSuccess || hipDeviceGetAttribute(&cus, hipDeviceAttributeMultiprocessorCount, dev) != hipSuccess) { fprintf(stderr, "kernel_launch: device query failed\n"); grid = -1; return; }
        if (hipFuncSetAttribute((const void*)fwd_kernel, hipFuncAttributeMaxDynamicSharedMemorySize, LDS_BYTES) != hipSuccess) { fprintf(stderr, "kernel_launch: hipFuncSetAttribute failed\n"); grid = -1; return; }
        if (hipOccupancyMaxActiveBlocksPerMultiprocessor(&per_cu, (const void*)fwd_kernel, NWAVES * 64, LDS_BYTES) != hipSuccess || per_cu < 1)
            fprintf(stderr, "kernel_launch: note: occupancy query reports %d workgroups per CU\n", per_cu);
        (void)hipGetLastError();
        grid = cus;
    }
    if (grid < 0) return;
    if (hipMemsetAsync((char*)d_ws + WS_CTL, 0, CTL_ZERO_BYTES, stream) != hipSuccess) { fprintf(stderr, "kernel_launch: memset failed\n"); return; }
    Params p{};
    for (int i = 0; i < 28; ++i) p.in[i] = (const float*)d_in[i];
    p.out = (float*)d_out; p.ws = (unsigned char*)d_ws;
    hipLaunchKernelGGL(fwd_kernel, dim3(grid), dim3(NWAVES * 64), LDS_BYTES, stream, p);
    const hipError_t le = hipPeekAtLastError();
    if (le != hipSuccess) fprintf(stderr, "kernel_launch: launch failed: %s\n", hipGetErrorName(le));
}
```

```cpp
#ifndef DBG
#define DBG 0
#endif
#ifndef DBG_L
#define DBG_L 0
#endif
#ifndef DBG_REPORT
#define DBG_REPORT -1
#endif
#ifndef DBG_MASK
#define DBG_MASK 31
#endif
#ifndef SIMPLE_BAR
#define SIMPLE_BAR 0
#endif
#ifndef TSEL_A
#define TSEL_A 1ull
#endif
#ifndef TSEL_B
#define TSEL_B 0ull
#endif
#ifndef DUP_ATT
#define DUP_ATT 0
#endif
#ifndef DUP_GIN
#define DUP_GIN 0
#endif
#ifndef DUP_PRO
#define DUP_PRO 0
#endif
#ifndef ATT_PVPF
#define ATT_PVPF 1
#endif
#ifndef DUP_SMALL
#define DUP_SMALL 0
#endif
#ifndef ATT_NEGM
#define ATT_NEGM 1
#endif
#ifndef ATT_NOSWAP
#define ATT_NOSWAP 1
#endif
#ifndef ATT_LMFMA
#define ATT_LMFMA 0
#endif
#ifndef ATT_DMA
#define ATT_DMA 1
#endif
#ifndef ATT_FP8
#define ATT_FP8 1
#endif
#ifndef NO_DNSPLIT
#define NO_DNSPLIT 0
#endif
#ifndef ATT_QK8
#define ATT_QK8 1
#endif

#ifndef I8_CLIP
#define I8_CLIP 4.0f
#endif

#ifndef I8_IN
#define I8_IN 1
#endif
#ifndef I8_GU
#define I8_GU 1
#endif

#ifndef I8DBG
#define I8DBG 0
#endif

#ifndef ATT_PVX
#define ATT_PVX 1
#endif
#ifndef PVX_MASK
#define PVX_MASK 0x400
#endif

#ifndef ATT_Y8
#define ATT_Y8 1
#endif
#ifndef Y8_C
#define Y8_C 0.0f
#endif

#ifndef ATT_LEAD
#define ATT_LEAD 5
#endif

#ifndef ATT_STAG
#define ATT_STAG 0
#endif

#ifndef ATT_BAR2
#define ATT_BAR2 1
#endif

#ifndef DUP_MODV
#define DUP_MODV 0
#endif

#ifndef ITEM_NBFAST
#define ITEM_NBFAST 1
#endif

#ifndef DUP_BAR
#define DUP_BAR 0
#endif

#ifndef DUP_S1V
#define DUP_S1V 0
#endif

#ifndef S1_NT
#define S1_NT 0
#endif

#ifndef S1_LDSST
#define S1_LDSST 0
#endif

#ifndef ATT_PRIO
#define ATT_PRIO 0
#endif

#ifndef ATT_AB
#define ATT_AB 0
#endif

#ifndef PROBE
#define PROBE 0
#endif

#ifndef ATT_KPF
#define ATT_KPF 0
#endif

#ifndef ATT_P2
#define ATT_P2 0
#endif

#ifndef P2_KPF
#define P2_KPF 0
#endif
#ifndef P2_VPF
#define P2_VPF 0
#endif

#ifndef P2_AB
#define P2_AB 1
#endif

#ifndef TAIL2
#define TAIL2 0
#endif

#ifndef DEFER
#define DEFER 1
#endif
#ifndef IPW_G
#define IPW_G 6
#endif
#ifndef IPW_S
#define IPW_S 3
#endif

#ifndef IPW_T
#define IPW_T 0
#endif

#ifndef MOE_SPARSE
#define MOE_SPARSE 1
#endif

#ifndef NOSTORE_PROBE
#define NOSTORE_PROBE 0
#endif

#ifndef FIN_NT
#define FIN_NT 0
#endif

#ifndef DUP_FIN
#define DUP_FIN 0
#endif

#ifndef K8_DIRECT
#define K8_DIRECT 1
#endif

#ifndef Q8_DIRECT
#define Q8_DIRECT 0
#endif

#ifndef PERM_OUT
#define PERM_OUT 1
#endif

#ifndef SB16
#define SB16 1
#endif

#ifndef YD16
#define YD16 0
#endif

#ifndef CV_PAIR
#define CV_PAIR 0
#endif

#ifndef V8_DIRECT
#define V8_DIRECT 1
#endif

#ifndef V8_NOSWAP
#define V8_NOSWAP 0
#endif

#ifndef S1_PF
#define S1_PF 0
#endif

#ifndef S2_DEPTH
#define S2_DEPTH 22
#endif
#include <hip/hip_runtime.h>
#include <cstdio>
#include <cstdint>

#define GAS __attribute__((address_space(1)))
#define LAS __attribute__((address_space(3)))
typedef unsigned short bf16;
typedef unsigned v4u __attribute__((ext_vector_type(4)));
typedef unsigned v2u __attribute__((ext_vector_type(2)));
typedef float f32x4 __attribute__((ext_vector_type(4)));
typedef float f32x2 __attribute__((ext_vector_type(2)));
typedef float f32x16 __attribute__((ext_vector_type(16)));
typedef short bf16x8 __attribute__((ext_vector_type(8)));
typedef short s16x4 __attribute__((ext_vector_type(4)));
typedef GAS unsigned gu32;
#define RLX_AGENT __ATOMIC_RELAXED, __HIP_MEMORY_SCOPE_AGENT
#define LDS_WAIT() asm volatile("s_waitcnt lgkmcnt(0)" ::: "memory")
#define VM_WAIT() asm volatile("s_waitcnt vmcnt(0)" ::: "memory")

constexpr int D = 2048, NB = 2, SEQ = 8192, CTXL = 256;
constexpr int NLAT = NB * SEQ, NCTX = NB * CTXL, T = NLAT + NCTX;
constexpr int KVLEN = CTXL + SEQ;
constexpr int IN_COLS = 6160, NIN = 6400;
constexpr int COL_Z = 1536, COL_Q = 2048, COL_XBC = 3072, COL_DT = 4096, COL_K = 4112, COL_V = 5136;
constexpr int FFD = 5632, FFE = 2816, NE = 8;
constexpr int NCH = 66;
constexpr float NORM_EPS = 1e-6f;
constexpr int NWAVES = 8;

constexpr size_t MiB = 1u << 20;
constexpr size_t WS_CTL = 0, CTL_ZERO_BYTES = 1 * MiB;
constexpr size_t WS_MOD = 1 * MiB;
constexpr size_t WS_ROPE = WS_MOD + 512 * 1024;
constexpr size_t WS_TOT = WS_ROPE + 64 * 1024;
constexpr size_t WS_ROUTE = 2 * MiB;
constexpr size_t WS_HS = 2 * MiB + 512 * 1024;
constexpr size_t WS_AGS = WS_HS + 256 * 1024;
constexpr size_t WS_AGS2 = 3 * MiB + 512 * 1024;
constexpr size_t WS_CS = 3 * MiB;
constexpr size_t CS_WIN = 0, CS_WGU = 2 * 6400, CS_MGU = CS_WGU + 11264;
constexpr size_t WS_W = 4 * MiB;
constexpr size_t SZ_WIN = (size_t)NIN * D * 2, SZ_WOUT = (size_t)D * D * 2, SZ_WGU = (size_t)2 * FFD * D * 2, SZ_WDN = (size_t)D * FFD * 2;
constexpr size_t SZ_MGU = (size_t)2 * FFE * D * 2, SZ_MDN = (size_t)D * FFE * 2;
constexpr size_t WS_WIN = WS_W, WS_WOUT = WS_WIN + 2 * SZ_WIN, WS_WGU = WS_WOUT + 2 * SZ_WOUT, WS_WDN = WS_WGU + SZ_WGU, WS_MGU = WS_WDN + SZ_WDN, WS_MDN = WS_MGU + NE * SZ_MGU;
constexpr size_t WS_XL = WS_MDN + NE * SZ_MDN;
constexpr size_t WS_H = WS_XL + (size_t)T * D * 4;
constexpr size_t WS_CAT = WS_H + (size_t)T * D * 2;
constexpr size_t WS_TMP = WS_CAT + (size_t)T * D * 2;
constexpr size_t WS_CONV = WS_TMP;
constexpr size_t WS_Z = WS_CONV + (size_t)T * 1536 * 2;
constexpr size_t WS_Q = WS_Z + (size_t)T * 512 * 2;
constexpr size_t WS_XBC = WS_Q + (size_t)T * 1024 * 2;
constexpr size_t WS_KB = WS_XBC + (size_t)T * 1024 * 2;
constexpr size_t WS_VB = WS_KB + (size_t)T * 1024 * 2;
constexpr size_t WS_DT = WS_VB + (size_t)T * 1024 * 2;
constexpr size_t WS_XBCC = WS_DT + (size_t)T * 16 * 4;
constexpr size_t WS_YD = WS_XBCC + (size_t)T * 1024 * 2;
constexpr size_t WS_CUM = WS_YD + (size_t)T * 512 * 4;
constexpr size_t WS_SB = WS_CUM + (size_t)T * 16 * 4;
constexpr size_t WS_HP = WS_SB + (size_t)32 * NCH * 8192 * 4;
constexpr size_t WS_TMP_END_MIX = WS_HP + (size_t)32 * NCH * 8192 * 2;
constexpr size_t WS_ACT = WS_TMP;
constexpr int MOE_MAXROWS = 2 * NLAT + NE * 256;
constexpr size_t WS_AG = WS_TMP;
#if MOE_SPARSE
constexpr size_t WS_MACT = WS_AG + (size_t)NE * NLAT * D;
constexpr size_t WS_TMP_END_MOE = WS_MACT + (size_t)MOE_MAXROWS * FFE;
#else
constexpr size_t WS_MACT = WS_AG + (size_t)MOE_MAXROWS * D * 2;
constexpr size_t WS_TMP_END_MOE = WS_MACT + (size_t)MOE_MAXROWS * FFE * 2;
#endif
constexpr size_t WS_PART = WS_TMP + 200 * MiB;
constexpr size_t WS_V8 = (WS_TMP_END_MIX > WS_TMP_END_MOE ? WS_TMP_END_MIX : WS_TMP_END_MOE);
constexpr size_t WS_K8 = WS_V8 + (size_t)NB * (KVLEN / 64) * 8 * 8192;
constexpr size_t WS_END = WS_K8 + (size_t)NB * (KVLEN / 64) * 8 * 8192;
static_assert(WS_PART + (size_t)11 * NCTX * D * 4 <= WS_V8 && WS_PART >= WS_ACT + (size_t)T * FFD * 2, "partials");
static_assert(WS_ACT + (size_t)T * FFD * 2 <= WS_END, "act fits");
constexpr int CW_TMO = 0, CW_CODE = 1;
constexpr int CW_BAR = 4096;
constexpr int CW_CNT = 8192;
constexpr int CW_DIAG = 12288;

constexpr int RING_OFF = 0, RING_BYTES = 131072;
constexpr int LDSCTL_OFF = RING_BYTES, MISC_OFF = LDSCTL_OFF + 320;
constexpr int LDS_BYTES = 147456;

__device__ __forceinline__ unsigned f2bf(float f) { unsigned u = __builtin_bit_cast(unsigned, f); return (u + 0x7fffu + ((u >> 16) & 1u)) >> 16; }
__device__ __forceinline__ unsigned pk2(float lo, float hi) { return f2bf(lo) | (f2bf(hi) << 16); }
__device__ __forceinline__ unsigned cvtpk(float lo, float hi) { unsigned r; asm volatile("v_cvt_pk_bf16_f32 %0, %1, %2" : "=v"(r) : "v"(lo), "v"(hi)); return r; }
__device__ __forceinline__ float bf2f(unsigned short b) { return __builtin_bit_cast(float, ((unsigned)b) << 16); }
__device__ __forceinline__ float bflo(unsigned w) { return __builtin_bit_cast(float, w << 16); }
__device__ __forceinline__ float bfhi(unsigned w) { return __builtin_bit_cast(float, w & 0xffff0000u); }
__device__ __forceinline__ float fast_exp(float x) { return __builtin_amdgcn_exp2f(x * 1.4426950408889634f); }
__device__ __forceinline__ float silu_f(float x) { return x * __builtin_amdgcn_rcpf(1.0f + fast_exp(-x)); }
__device__ __forceinline__ float dpp_f(float v, const int ctrl_sel) {
    int r;
    switch (ctrl_sel) {
        case 0: r = __builtin_amdgcn_update_dpp(0, __builtin_bit_cast(int, v), 0xB1, 0xF, 0xF, true); break;
        case 1: r = __builtin_amdgcn_update_dpp(0, __builtin_bit_cast(int, v), 0x4E, 0xF, 0xF, true); break;
        case 2: r = __builtin_amdgcn_update_dpp(0, __builtin_bit_cast(int, v), 0x141, 0xF, 0xF, true); break;
        default: r = __builtin_amdgcn_update_dpp(0, __builtin_bit_cast(int, v), 0x140, 0xF, 0xF, true); break;
    }
    return __builtin_bit_cast(float, r);
}
__device__ __forceinline__ float half_sum(float v) {
    v += dpp_f(v, 0); v += dpp_f(v, 1); v += dpp_f(v, 2); v += dpp_f(v, 3);
    v += __builtin_bit_cast(float, __builtin_amdgcn_ds_swizzle(__builtin_bit_cast(int, v), 0x401F));
    return v;
}
__device__ __forceinline__ void swap32u(unsigned& a, unsigned& b) {
    asm volatile("s_nop 1\n\tv_permlane32_swap_b32 %0, %1\n\ts_nop 1" : "+v"(a), "+v"(b));
}
__device__ __forceinline__ void swap32(float v, float& x, float& y) {
    unsigned a = __builtin_bit_cast(unsigned, v), b = a; swap32u(a, b);
    x = __builtin_bit_cast(float, a); y = __builtin_bit_cast(float, b);
}
__device__ __forceinline__ float wave_sum(float v) {
    v = half_sum(v);
    float x, y; swap32(v, x, y); return x + y;
}
__device__ __forceinline__ f32x4 ld4_f32(const float* p) { return *(const f32x4*)p; }
__device__ __forceinline__ f32x4 ld4_bf16(const unsigned short* p) { const v2u w = *(const v2u*)p; f32x4 r; r[0] = bflo(w.x); r[1] = bfhi(w.x); r[2] = bflo(w.y); r[3] = bfhi(w.y); return r; }
__device__ __forceinline__ void st4_bf16(unsigned short* p, const f32x4& v) { v2u w; w.x = cvtpk(v[0], v[1]); w.y = cvtpk(v[2], v[3]); *(v2u*)p = w; }
__device__ __forceinline__ float wave_max(float v) {
    v = fmaxf(v, dpp_f(v, 0)); v = fmaxf(v, dpp_f(v, 1)); v = fmaxf(v, dpp_f(v, 2)); v = fmaxf(v, dpp_f(v, 3));
    v = fmaxf(v, __builtin_bit_cast(float, __builtin_amdgcn_ds_swizzle(__builtin_bit_cast(int, v), 0x401F)));
    float x, y; swap32(v, x, y); return fmaxf(x, y);
}
__device__ __forceinline__ unsigned pk_i8(float a, float b, float c, float d) {
    const float M = 12582912.0f;
    const unsigned ua = __builtin_bit_cast(unsigned, a + M), ub = __builtin_bit_cast(unsigned, b + M), uc = __builtin_bit_cast(unsigned, c + M), ud = __builtin_bit_cast(unsigned, d + M);
    return __builtin_amdgcn_perm(ub, ua, 0x0c0c0400u) | (__builtin_amdgcn_perm(ud, uc, 0x0c0c0400u) << 16);
}
__device__ __forceinline__ float cross_max(float v) { float x, y; swap32(v, x, y); return fmaxf(x, y); }
__device__ __forceinline__ float cross_sum(float v) { float x, y; swap32(v, x, y); return x + y; }

__device__ __forceinline__ int lane_id() { int l; asm volatile("v_mbcnt_lo_u32_b32 %0, -1, 0\n\tv_mbcnt_hi_u32_b32 %0, -1, %0" : "=v"(l)); return l; }
__device__ __forceinline__ int fresh_tid(int wave) { return wave * 64 + lane_id(); }
__device__ __forceinline__ int fresh_s(int v) { asm volatile("" : "+s"(v)); return v; }
__device__ __forceinline__ unsigned char* fresh_ws(unsigned char* p) { unsigned z = 0; asm volatile("" : "+s"(z)); return p + z; }
#define XB_TMO      128
#define XB_XCNT(j)  (256  + 64 * (j))
#define XB_XSUB(j)  (1280 + 64 * (j))
#define XB_XGEN(j)  (2304 + 64 * (j))
#define XB_TOP      3328
#define XB_TOPGEN   3392
#define XCD_BAR_WORDS 3456
#define XB_SPIN_CAP (1u << 22)

__device__ __forceinline__ unsigned xb_ld(unsigned* p)              { return __hip_atomic_load(p, __ATOMIC_RELAXED, __HIP_MEMORY_SCOPE_AGENT); }
__device__ __forceinline__ unsigned xb_add(unsigned* p, unsigned v) { return __hip_atomic_fetch_add(p, v, __ATOMIC_RELAXED, __HIP_MEMORY_SCOPE_AGENT); }
__device__ __forceinline__ unsigned xb_xcc_id() { return (unsigned)__builtin_amdgcn_s_getreg((3 << 11) | 20) & 0xFu; }
#define XB_SPIN(cond, bar) do { unsigned _sp = 0; while (cond) { __builtin_amdgcn_s_sleep(1); \
    if ((++_sp & 255u) == 0u) { if (xb_ld(&(bar)[XB_TMO])) break; if (_sp > XB_SPIN_CAP) { atomicAdd(&(bar)[XB_TMO], 1u); break; } } } } while (0)

struct XcdBarrier { unsigned* bar; unsigned x; volatile LAS unsigned* st; int wave; };

__device__ __forceinline__ XcdBarrier xcd_barrier_post(unsigned* bar, volatile LAS unsigned* st) {
    XcdBarrier b; b.bar = bar; b.x = xb_xcc_id(); b.st = st; b.wave = __builtin_amdgcn_readfirstlane(threadIdx.x >> 6);
    if (threadIdx.x == 0) (void)xb_add(&bar[XB_XCNT(b.x)], 1u);
    return b;
}
__device__ __forceinline__ void xcd_barrier_complete(unsigned* bar, unsigned x, unsigned& nloc, unsigned& nx) {
    const unsigned G = gridDim.x * gridDim.y * gridDim.z;
    unsigned sum, cnt, mine, sp = 0u;
    for (;;) {
        sum = 0u; cnt = 0u; mine = 0u;
#pragma unroll
        for (unsigned j = 0; j < 16; ++j) { const unsigned c = xb_ld(&bar[XB_XCNT(j)]); sum += c; cnt += (c > 0u) ? 1u : 0u; mine = (j == x) ? c : mine; }
        if (sum == G) break;
        __builtin_amdgcn_s_sleep(1);
        if ((++sp & 255u) == 0u) { if (xb_ld(&bar[XB_TMO])) break; if (sp > XB_SPIN_CAP) { atomicAdd(&bar[XB_TMO], 1u); break; } }
    }
    nloc = mine > 0u ? mine : 1u; nx = cnt > 0u ? cnt : 1u;
}
__device__ __forceinline__ void xcd_barrier(const XcdBarrier& b) {
    asm volatile("s_waitcnt vmcnt(0)" ::: "memory");
    __syncthreads();
    if (b.wave == 0 && lane_id() == 0) {
        unsigned* bar = b.bar;
        const unsigned bx = xb_xcc_id();
        __builtin_amdgcn_s_waitcnt(0);
        unsigned nloc = b.st[0], nx = b.st[1];
        if (nloc == 0u) { xcd_barrier_complete(bar, bx, nloc, nx); b.st[0] = nloc; b.st[1] = nx; }
        const unsigned old = xb_add(&bar[XB_XSUB(bx)], 1u);
        const unsigned gen = old / nloc;
        if (old + 1u == (gen + 1u) * nloc) {
            __builtin_amdgcn_fence(__ATOMIC_RELEASE, "agent");
            asm volatile("s_waitcnt vmcnt(0)" ::: "memory");
            const unsigned og = xb_add(&bar[XB_TOP], 1u);
            const unsigned tg = og / nx;
            if (og + 1u == (tg + 1u) * nx) xb_add(&bar[XB_TOPGEN], 1u);
            else XB_SPIN(xb_ld(&bar[XB_TOPGEN]) == tg, bar);
            __builtin_amdgcn_fence(__ATOMIC_ACQUIRE, "agent");
            xb_add(&bar[XB_XGEN(bx)], 1u);
            asm volatile("s_waitcnt vmcnt(0)" ::: "memory");
        } else {
            XB_SPIN(xb_ld(&bar[XB_XGEN(bx)]) == gen, bar);
            __builtin_amdgcn_fence(__ATOMIC_ACQUIRE, "agent");
            asm volatile("s_waitcnt vmcnt(0)" ::: "memory");
        }
    }
    __syncthreads();
}

#if SIMPLE_BAR
__device__ __forceinline__ void simple_barrier(unsigned* cnt, unsigned target) {
    asm volatile("s_waitcnt vmcnt(0)" ::: "memory");
    __syncthreads();
    if (threadIdx.x == 0) {
        __threadfence();
        asm volatile("s_waitcnt vmcnt(0)" ::: "memory");
        __hip_atomic_fetch_add(cnt, 1u, __ATOMIC_RELAXED, __HIP_MEMORY_SCOPE_AGENT);
        unsigned sp = 0;
        while (__hip_atomic_load(cnt, __ATOMIC_RELAXED, __HIP_MEMORY_SCOPE_AGENT) < target) { __builtin_amdgcn_s_sleep(2); if (++sp > (1u << 24)) break; }
        __threadfence();
        asm volatile("s_waitcnt vmcnt(0)" ::: "memory");
    }
    __syncthreads();
}
#endif
namespace pg8 {
constexpr int BM = 256, BK = 64, HALF = 128, HTB = HALF * BK * 2, STAGE_BYTES = 8 * HTB, NXCD = 8, WGM = 8;
__host__ __device__ __forceinline__ int lds_byte(int r, int c) { const int st = (r >> 4) * 2 + (c >> 5), rr = r & 15, cc = c & 31, ob = rr * 64 + cc * 2; return st * 1024 + (ob ^ (((ob >> 9) & 1) << 5)); }
__host__ __device__ __forceinline__ void stage_rc(int b, int& R, int& C) { const int st = b / 1024, sb = b % 1024, swz = sb ^ (((sb >> 9) & 1) << 5); R = (st >> 1) * 16 + swz / 64; C = (st & 1) * 32 + (swz % 64) / 2; }
__host__ __device__ __forceinline__ int perm32(int rho) { const int n = rho >> 4, i = rho & 15; return 8 * (i >> 2) + 4 * n + (i & 3); }

struct Unit { int pm, pn, ks, half; };
struct OrderBase {
    int nM, nN, nwg, G, c;
    __device__ void init(int nM_, int nN_, int G_, int c_) { nM = nM_; nN = nN_; nwg = nM * nN; G = G_; c = c_; }
    __device__ bool next(int i, Unit& u) const {
        long L = (long)i * G + c; u.half = 0;
#if TAIL2
        { const int R = nwg / G, rem = nwg - R * G;
          if (rem > 0 && 2 * rem <= G && i >= R) { if (i > R || c >= 2 * rem) return false; L = (long)R * G + (c >> 1); u.half = 1 + (c & 1); } }
#endif
        if (L >= nwg) return false;
        int wgid = (int)L; { const int q = nwg / NXCD, r = nwg % NXCD, xcd = wgid % NXCD, off = wgid / NXCD; wgid = (xcd < r ? xcd * (q + 1) : r * (q + 1) + (xcd - r) * q) + off; }
        const int nig = WGM * nN, gid = wgid / nig, fm = gid * WGM, gsz = (nM - fm) < WGM ? (nM - fm) : WGM;
        u.pm = fm + ((wgid % nig) % gsz); u.pn = (wgid % nig) / gsz; u.ks = 0; return true;
    }
};
struct PlainSched : OrderBase {
    const char* A; const char* Bt; size_t tstep; int swap_from = 1 << 30, swap_to = 0;
    __device__ __forceinline__ bool swapped(const Unit& u) const { return u.pn >= swap_from && u.pn < swap_to; }
    __device__ __forceinline__ const char* abase(const Unit& u) const { return swapped(u) ? Bt + (size_t)u.pn * tstep : A + (size_t)u.pm * tstep; }
    __device__ __forceinline__ const char* bbase(const Unit& u) const { return swapped(u) ? A + (size_t)u.pm * tstep : Bt + (size_t)u.pn * tstep; }
    __device__ __forceinline__ int brow(const Unit& u) const { return u.pn * 256; }
    __device__ __forceinline__ int arow(const Unit& u) const { return u.pm * 256; }
};
struct MoeSched : OrderBase {
    const char* A; const char* Bt; size_t tstep, estride; int ps1, ps2, ps3, ps4, ps5, ps6, ps7, erows;
    __device__ __forceinline__ int expert(int pm) const { return (pm >= ps1) + (pm >= ps2) + (pm >= ps3) + (pm >= ps4) + (pm >= ps5) + (pm >= ps6) + (pm >= ps7); }
    __device__ __forceinline__ bool swapped(const Unit&) const { return false; }
    int sparse, caprows;
    __device__ __forceinline__ int pstart(int pm) const { int p0 = 0; p0 = pm >= ps1 ? ps1 : p0; p0 = pm >= ps2 ? ps2 : p0; p0 = pm >= ps3 ? ps3 : p0; p0 = pm >= ps4 ? ps4 : p0; p0 = pm >= ps5 ? ps5 : p0; p0 = pm >= ps6 ? ps6 : p0; p0 = pm >= ps7 ? ps7 : p0; return p0; }
    __device__ __forceinline__ int arow(const Unit& u) const { return sparse ? expert(u.pm) * caprows + (u.pm - pstart(u.pm)) * 256 : u.pm * 256; }
    __device__ __forceinline__ const char* abase(const Unit& u) const { return A + (size_t)arow(u) * (tstep >> 8); }
    __device__ __forceinline__ const char* bbase(const Unit& u) const { return Bt + (size_t)expert(u.pm) * estride + (size_t)u.pn * tstep; }
    __device__ __forceinline__ int brow(const Unit& u) const { return expert(u.pm) * erows + u.pn * 256; }
};

struct CtxSplitSched {
    int nN, nS, G, c; const char* A; const char* Bt; size_t tstep; size_t kslice;
    __device__ bool next(int i, Unit& u) const { const int L = i * G + c; if (L >= 2 * nN * nS) return false; u.pm = 64 + (L & 1); u.pn = (L >> 1) % nN; u.ks = (L >> 1) / nN; u.half = 0; return true; }
    __device__ __forceinline__ const char* abase(const Unit& u) const { return A + (size_t)u.pm * tstep + (size_t)u.ks * kslice; }
    __device__ __forceinline__ const char* bbase(const Unit& u) const { return Bt + (size_t)u.pn * tstep + (size_t)u.ks * kslice; }
    __device__ __forceinline__ int brow(const Unit& u) const { return u.pn * 256; }
    __device__ __forceinline__ int arow(const Unit& u) const { return u.pm * 256; }
    __device__ __forceinline__ bool swapped(const Unit&) const { return false; }
};
template <class Epi, class Sched, bool ALIGN_EPI, bool SP2, int MODE = 0>
__device__ __forceinline__ void gemm_phase(LAS unsigned char* lds, const int K, const Sched& S, const Epi& E, const int wave, const int ktiles = 0, const int sc_w = 0x7F7F7F7F, const int sc_a = 0x7F7F7F7F,
                                           const float* rs = nullptr, const float* cs = nullptr) {
    constexpr bool F8 = (MODE == 1), I8 = (MODE == 2);
    const int tid = fresh_tid(wave); const int wid = __builtin_amdgcn_readfirstlane(tid >> 6), lane = tid & 63, wr = wid >> 2, wc = wid & 3, fr = lane & 15, fq = lane >> 4;
    const int nt = ktiles ? ktiles : K / BK;
    unsigned voffA[2];
#pragma unroll
    for (int i = 0; i < 2; ++i) { int R, C; stage_rc(tid * 16 + i * 8192, R, C); voffA[i] = (unsigned)(R * K + C) * 2u; }
#define voffB voffA
    const size_t kstep = (size_t)(BK * 2);
    const size_t hstep = (size_t)HALF * K * 2;
    const unsigned ldsw = (unsigned)wid * 1024u;
    const int aoff = lds_byte(wr * 64 + fr, fq * 8), boff = lds_byte(wc * 32 + fr, fq * 8);
#define PG8_SA(b, h) (((b) * 2 + (h)) * HTB)
#define PG8_SB(b, h) ((4 + (b) * 2 + (h)) * HTB)
#define PG8_STAGE(bufoff, gbase, voff) do { _Pragma("unroll") for (int _i = 0; _i < 2; ++_i) \
        __builtin_amdgcn_global_load_lds((const unsigned*)((const char*)(gbase) + (voff)[_i]), (LAS unsigned*)(lds + (bufoff) + ldsw + _i * 8192), 16, 0, 0); } while (0)
#define PG8_LDA(dst, b, h) do { if constexpr (F8) { _Pragma("unroll") for (int m = 0; m < 4; ++m) { \
            const v4i_ lo_ = *(const LAS v4i_*)(lds + PG8_SA(b, h) + aoff + m * 2048), hi_ = *(const LAS v4i_*)(lds + PG8_SA(b, h) + aoff + m * 2048 + 1024); \
            dst##8[m] = __builtin_shufflevector(lo_, hi_, 0, 1, 2, 3, 4, 5, 6, 7); } } \
        else { _Pragma("unroll") for (int m = 0; m < 4; ++m) _Pragma("unroll") for (int k = 0; k < 2; ++k) dst[m][k] = *(const LAS bf16x8*)(lds + PG8_SA(b, h) + aoff + m * 2048 + k * 1024); } } while (0)
#define PG8_LDB(dst, b, h) do { if constexpr (F8) { _Pragma("unroll") for (int n = 0; n < 2; ++n) { \
            const v4i_ lo_ = *(const LAS v4i_*)(lds + PG8_SB(b, h) + boff + n * 2048), hi_ = *(const LAS v4i_*)(lds + PG8_SB(b, h) + boff + n * 2048 + 1024); \
            dst##8[n] = __builtin_shufflevector(lo_, hi_, 0, 1, 2, 3, 4, 5, 6, 7); } } \
        else { _Pragma("unroll") for (int n = 0; n < 2; ++n) _Pragma("unroll") for (int k = 0; k < 2; ++k) dst[n][k] = *(const LAS bf16x8*)(lds + PG8_SB(b, h) + boff + n * 2048 + k * 1024); } } while (0)
#define PG8_MMA(ai, bj, At, Bt) do { __builtin_amdgcn_s_setprio(1); \
        if constexpr (F8) { _Pragma("unroll") for (int m = 0; m < 4; ++m) _Pragma("unroll") for (int n = 0; n < 2; ++n) \
            asm volatile("v_mfma_scale_f32_16x16x128_f8f6f4 %0, %1, %2, %0, %3, %4 op_sel_hi:[0,0,0]" : "+v"(acc[ai][bj][m][n]) : "v"(Bt##8[n]), "v"(At##8[m]), "v"(sc_w), "v"(sc_a)); } \
        else if constexpr (I8) { _Pragma("unroll") for (int m = 0; m < 4; ++m) _Pragma("unroll") for (int n = 0; n < 2; ++n) _Pragma("unroll") for (int k = 0; k < 2; ++k) \
            acc[ai][bj][m][n] = __builtin_bit_cast(f32x4, __builtin_amdgcn_mfma_i32_16x16x64_i8(__builtin_bit_cast(v4i_, Bt[n][k]), __builtin_bit_cast(v4i_, At[m][k]), __builtin_bit_cast(v4i_, acc[ai][bj][m][n]), 0, 0, 0)); } \
        else { _Pragma("unroll") for (int m = 0; m < 4; ++m) _Pragma("unroll") for (int n = 0; n < 2; ++n) _Pragma("unroll") for (int k = 0; k < 2; ++k) \
            acc[ai][bj][m][n] = __builtin_amdgcn_mfma_f32_16x16x32_bf16(Bt[n][k], At[m][k], acc[ai][bj][m][n], 0, 0, 0); } \
        __builtin_amdgcn_s_setprio(0); } while (0)
#define PG8_WAIT_V(n) asm volatile("s_waitcnt vmcnt(" #n ")" ::: "memory")
#define PG8_WAIT_L(n) asm volatile("s_waitcnt lgkmcnt(" #n ")" ::: "memory")
#define PG8_BAR __builtin_amdgcn_s_barrier()
#define PG8_SCHED __builtin_amdgcn_sched_barrier(0)
    Unit cur, nxt; int ui = 0;
    if (!S.next(0, cur)) return;
    f32x4 acc[2][2][4][2];
#pragma unroll
    for (int a = 0; a < 2; ++a)
#pragma unroll
        for (int b = 0; b < 2; ++b)
#pragma unroll
            for (int m = 0; m < 4; ++m)
#pragma unroll
                for (int n = 0; n < 2; ++n) acc[a][b][m][n] = (f32x4){0.f, 0.f, 0.f, 0.f};
    typedef int v8i_ __attribute__((ext_vector_type(8))); typedef int v4i_ __attribute__((ext_vector_type(4)));
    bf16x8 At[4][2], B0[2][2], B1[2][2]; v8i_ At8[4], B08[2], B18[2];
    const char* cA = S.abase(cur); const char* cB = S.bbase(cur);
    if constexpr (SP2) {
        PG8_STAGE(PG8_SB(0, 0), cB, voffB); PG8_STAGE(PG8_SB(0, 1), cB + hstep, voffB); PG8_STAGE(PG8_SA(0, 0), cA, voffA); PG8_STAGE(PG8_SA(0, 1), cA + hstep, voffA);
        if (wr == 1) PG8_BAR;
        PG8_WAIT_V(2); PG8_BAR;
        PG8_STAGE(PG8_SB(1, 0), cB + kstep, voffB); PG8_STAGE(PG8_SA(1, 0), cA + kstep, voffA); PG8_STAGE(PG8_SB(1, 1), cB + hstep + kstep, voffB);
        PG8_WAIT_V(6); PG8_BAR;
    } else {
        PG8_STAGE(PG8_SB(0, 0), cB, voffB); PG8_STAGE(PG8_SA(0, 0), cA, voffA); PG8_STAGE(PG8_SB(0, 1), cB + hstep, voffB); PG8_STAGE(PG8_SA(0, 1), cA + hstep, voffA);
        if (wr == 1) PG8_BAR;
        PG8_WAIT_V(4); PG8_BAR;
        PG8_STAGE(PG8_SB(1, 0), cB + kstep, voffB); PG8_STAGE(PG8_SA(1, 0), cA + kstep, voffA); PG8_STAGE(PG8_SB(1, 1), cB + hstep + kstep, voffB);
        PG8_WAIT_V(6); PG8_BAR;
    }
    for (;;) {
        const bool has_next = S.next(ui + 1, nxt);
        const char* nA = has_next ? S.abase(nxt) : cA; const char* nB = has_next ? S.bbase(nxt) : cB;
        for (int t = 0; t < nt; t += 2) {
            const bool last = (t == nt - 2);
            const char* a1 = cA + (size_t)(t + 1) * kstep;
            const char* a2 = last ? nA : cA + (size_t)(t + 2) * kstep; const char* b2 = last ? nB : cB + (size_t)(t + 2) * kstep;
            const char* a3 = a2 + kstep; const char* b3 = b2 + kstep;
            if constexpr (SP2) {
            PG8_LDB(B0, 0, 0); PG8_LDB(B1, 0, 1); PG8_SCHED; PG8_LDA(At, 0, 0); PG8_STAGE(PG8_SA(1, 1), a1 + hstep, voffA);
            PG8_WAIT_V(8); PG8_WAIT_L(0); PG8_BAR; if (!TAIL2 || cur.half != 2) { PG8_MMA(0, 0, At, B0); PG8_MMA(0, 1, At, B1); } PG8_BAR; PG8_SCHED;
            PG8_LDA(At, 0, 1); PG8_STAGE(PG8_SB(0, 0), b2, voffB); PG8_STAGE(PG8_SB(0, 1), b2 + hstep, voffB); PG8_STAGE(PG8_SA(0, 0), a2, voffA);
            PG8_WAIT_V(8); PG8_WAIT_L(0); PG8_BAR; if (!TAIL2 || cur.half != 1) { PG8_MMA(1, 0, At, B0); PG8_MMA(1, 1, At, B1); } PG8_BAR; PG8_SCHED;
            PG8_LDB(B0, 1, 0); PG8_LDB(B1, 1, 1); PG8_SCHED; PG8_LDA(At, 1, 0); PG8_STAGE(PG8_SA(0, 1), a2 + hstep, voffA);
            PG8_WAIT_V(8); PG8_WAIT_L(0); PG8_BAR; if (!TAIL2 || cur.half != 2) { PG8_MMA(0, 0, At, B0); PG8_MMA(0, 1, At, B1); } PG8_BAR; PG8_SCHED;
            PG8_LDA(At, 1, 1); PG8_STAGE(PG8_SB(1, 0), b3, voffB); PG8_STAGE(PG8_SB(1, 1), b3 + hstep, voffB); PG8_STAGE(PG8_SA(1, 0), a3, voffA);
            PG8_WAIT_V(8); PG8_WAIT_L(0); PG8_BAR; if (!TAIL2 || cur.half != 1) { PG8_MMA(1, 0, At, B0); PG8_MMA(1, 1, At, B1); } PG8_BAR; PG8_SCHED;
            } else {
            PG8_LDB(B0, 0, 0); PG8_SCHED; PG8_LDA(At, 0, 0); PG8_STAGE(PG8_SA(1, 1), a1 + hstep, voffA);
            PG8_WAIT_L(8); PG8_BAR; PG8_WAIT_L(0); PG8_MMA(0, 0, At, B0); PG8_BAR; PG8_SCHED;
            PG8_LDB(B1, 0, 1); PG8_STAGE(PG8_SB(0, 0), b2, voffB);
            PG8_BAR; PG8_WAIT_L(0); PG8_MMA(0, 1, At, B1); PG8_BAR;
            PG8_LDA(At, 0, 1); PG8_STAGE(PG8_SA(0, 0), a2, voffA);
            PG8_BAR; PG8_WAIT_L(0); PG8_MMA(1, 0, At, B0); PG8_BAR; PG8_SCHED;
            PG8_STAGE(PG8_SB(0, 1), b2 + hstep, voffB);
            PG8_WAIT_V(6); PG8_BAR; PG8_MMA(1, 1, At, B1); PG8_BAR;
            PG8_LDB(B0, 1, 0); PG8_SCHED; PG8_LDA(At, 1, 0); PG8_STAGE(PG8_SA(0, 1), a2 + hstep, voffA);
            PG8_WAIT_L(8); PG8_BAR; PG8_WAIT_L(0); PG8_MMA(0, 0, At, B0); PG8_BAR; PG8_SCHED;
            PG8_LDB(B1, 1, 1); PG8_STAGE(PG8_SB(1, 0), b3, voffB);
            PG8_BAR; PG8_WAIT_L(0); PG8_MMA(0, 1, At, B1); PG8_BAR;
            PG8_LDA(At, 1, 1); PG8_STAGE(PG8_SA(1, 0), a3, voffA);
            PG8_BAR; PG8_WAIT_L(0); PG8_MMA(1, 0, At, B0); PG8_BAR; PG8_SCHED;
            PG8_STAGE(PG8_SB(1, 1), b3 + hstep, voffB);
            PG8_WAIT_V(6); PG8_BAR; PG8_MMA(1, 1, At, B1); PG8_BAR;
            }
        }
        if constexpr (ALIGN_EPI) { if (wr == 0) PG8_BAR; }
        if constexpr (F8) asm volatile("s_nop 15\n\ts_nop 15" ::: "memory");
        if constexpr (I8) {
            const int l3_ = lane_id(); const int fr_ = l3_ & 15, fq_ = l3_ >> 4; const bool sw_ = S.swapped(cur);
            const float* rowS = sw_ ? cs + S.brow(cur) : rs + S.arow(cur); const float* colS = sw_ ? rs + S.arow(cur) : cs + S.brow(cur);
            f32x4 csv[2][2];
#pragma unroll
            for (int bj = 0; bj < 2; ++bj)
#pragma unroll
                for (int n = 0; n < 2; ++n) csv[bj][n] = *(const f32x4*)(colS + 128 * bj + 32 * wc + 16 * n + 4 * fq_);
#pragma unroll
            for (int ai = 0; ai < 2; ++ai)
#pragma unroll
                for (int m = 0; m < 4; ++m) { const float rsv = rowS[128 * ai + 64 * wr + 16 * m + fr_];
#pragma unroll
                    for (int bj = 0; bj < 2; ++bj)
#pragma unroll
                        for (int n = 0; n < 2; ++n)
#pragma unroll
                            for (int j = 0; j < 4; ++j) { const float t_ = acc[ai][bj][m][n][j];
                                acc[ai][bj][m][n][j] = (float)__float_as_int(t_) * (rsv * csv[bj][n][j]); } }
        }
        { const int l2_ = lane_id(); E(acc, cur, wr, wc, l2_ & 15, l2_ >> 4); }
        if (!has_next) break;
#pragma unroll
        for (int a = 0; a < 2; ++a)
#pragma unroll
            for (int b = 0; b < 2; ++b)
#pragma unroll
                for (int m = 0; m < 4; ++m)
#pragma unroll
                    for (int n = 0; n < 2; ++n) acc[a][b][m][n] = (f32x4){0.f, 0.f, 0.f, 0.f};
        cur = nxt; cA = nA; cB = nB; ++ui;
        if constexpr (ALIGN_EPI) { if (wr == 1) PG8_BAR; }
    }
    PG8_WAIT_V(0);
    if constexpr (!ALIGN_EPI) { if (wr == 0) PG8_BAR; }
    PG8_BAR;
#undef voffB
#undef PG8_SA
#undef PG8_SB
#undef PG8_STAGE
#undef PG8_LDA
#undef PG8_LDB
#undef PG8_MMA
#undef PG8_WAIT_V
#undef PG8_WAIT_L
#undef PG8_BAR
#undef PG8_SCHED
}
}
namespace pg8 {
__device__ __forceinline__ void st8(bf16* p, const f32x4& v0, const f32x4& v1) {
    v4u w; w.x = cvtpk(v0[0], v0[1]); w.y = cvtpk(v0[2], v0[3]); w.z = cvtpk(v1[0], v1[1]); w.w = cvtpk(v1[2], v1[3]);
    *(v4u*)p = w;
}
struct EpiIn {
    bf16 *convb, *zb, *qb, *xbcb, *kb, *vb; float* dtb; const float* ropec; const float* ropes; unsigned char* k8; unsigned char* v8;
    __device__ __forceinline__ void st_k8(int pm, int pn, int bj, int ai, int wr, int wc, int m, int fr, int fq, const f32x4& o1, const f32x4& o2) const {
        const int b = pm < 64 ? (pm >> 5) : (pm - 64), t = (pm < 64 ? CTXL / 64 + (pm & 31) * 4 : 0) + 2 * ai + wr, h = 2 * (pn - 16) + bj;
        const int chunk = (((wc >> 1) * 2 + (wc & 1)) * 2 + (fq >> 1)) * 64 + m * 16 + fr;
        const f32x4 lo = __builtin_elementwise_min(__builtin_elementwise_max(o1, (f32x4){-448.f, -448.f, -448.f, -448.f}), (f32x4){448.f, 448.f, 448.f, 448.f});
        const f32x4 hh = __builtin_elementwise_min(__builtin_elementwise_max(o2, (f32x4){-448.f, -448.f, -448.f, -448.f}), (f32x4){448.f, 448.f, 448.f, 448.f});
        v2u w;
        w.x = (unsigned)__builtin_amdgcn_cvt_pk_fp8_f32(lo[2], lo[3], __builtin_amdgcn_cvt_pk_fp8_f32(lo[0], lo[1], 0, false), true);
        w.y = (unsigned)__builtin_amdgcn_cvt_pk_fp8_f32(hh[2], hh[3], __builtin_amdgcn_cvt_pk_fp8_f32(hh[0], hh[1], 0, false), true);
        *(v2u*)(k8 + ((size_t)(b * (KVLEN / 64) + t) * 8 + h) * 8192 + chunk * 16 + 8 * (fq & 1)) = w;
    }
    __device__ __forceinline__ void st_q8(unsigned char* p, const f32x4& o1, const f32x4& o2) const {
        constexpr float C = 0.125f * 1.4426950408889634f * (ATT_Y8 ? 8.0f : 1.0f);
        const f32x4 lo = __builtin_elementwise_min(__builtin_elementwise_max(o1 * C, (f32x4){-448.f, -448.f, -448.f, -448.f}), (f32x4){448.f, 448.f, 448.f, 448.f});
        const f32x4 hh = __builtin_elementwise_min(__builtin_elementwise_max(o2 * C, (f32x4){-448.f, -448.f, -448.f, -448.f}), (f32x4){448.f, 448.f, 448.f, 448.f});
        v2u w;
        w.x = (unsigned)__builtin_amdgcn_cvt_pk_fp8_f32(lo[2], lo[3], __builtin_amdgcn_cvt_pk_fp8_f32(lo[0], lo[1], 0, false), true);
        w.y = (unsigned)__builtin_amdgcn_cvt_pk_fp8_f32(hh[2], hh[3], __builtin_amdgcn_cvt_pk_fp8_f32(hh[0], hh[1], 0, false), true);
        *(v2u*)p = w;
    }
    __device__ __forceinline__ void st_v8(const f32x4 (&acc)[2][2][4][2], int pm, int pn, int wr, int wc, int fr, int fq) const {
        const int b = pm < 64 ? (pm >> 5) : (pm - 64), t0 = (pm < 64 ? CTXL / 64 + (pm & 31) * 4 : 0) + (wc >> 1);
#pragma unroll
        for (int ai = 0; ai < 2; ++ai) { const int h = 2 * (pn - 20) + ai;
#pragma unroll
            for (int bj = 0; bj < 2; ++bj) { unsigned char* tile = v8 + ((size_t)(b * (KVLEN / 64) + t0 + 2 * bj) * 8 + h) * 8192;
#pragma unroll
                for (int m = 0; m < 4; ++m) {
                    unsigned Dw[2];
#pragma unroll
                    for (int n = 0; n < 2; ++n) { const f32x4 c = __builtin_elementwise_min(__builtin_elementwise_max(acc[ai][bj][m][n], (f32x4){-448.f, -448.f, -448.f, -448.f}), (f32x4){448.f, 448.f, 448.f, 448.f});
                        Dw[n] = (unsigned)__builtin_amdgcn_cvt_pk_fp8_f32(c[2], c[3], __builtin_amdgcn_cvt_pk_fp8_f32(c[0], c[1], 0, false), true); }
                    const int chunk = (((2 * wr + (m >> 1)) * 2 + (fq & 1)) * 2 + (wc & 1)) * 32 + 16 * (m & 1) + fr;
#if V8_NOSWAP
                    *(unsigned*)(tile + chunk * 16 + (fq >> 1) * 4) = Dw[0]; *(unsigned*)(tile + chunk * 16 + 8 + (fq >> 1) * 4) = Dw[1];
#else
                    swap32u(Dw[0], Dw[1]);
                    v2u w; w.x = Dw[0]; w.y = Dw[1];
                    *(v2u*)(tile + chunk * 16 + (fq >> 1) * 8) = w;
#endif
                } } }
    }
    __device__ __forceinline__ void operator()(const f32x4 (&acc)[2][2][4][2], const Unit& u, int wr, int wc, int fr, int fq) const {
        const int pn = u.pn, pm = u.pm;
        if (V8_DIRECT && pn >= 20 && pn < 24) { st_v8(acc, pm, pn, wr, wc, fr, fq); return; }
        if (pn == 24) {
            if (wc == 0) {
#pragma unroll
                for (int ai = 0; ai < 2; ++ai)
#pragma unroll
                    for (int m = 0; m < 4; ++m) { if (TAIL2 && u.half != 0 && u.half != ai + 1) continue; const int r = pm * 256 + ai * 128 + wr * 64 + m * 16 + fr; *(f32x4*)(dtb + (size_t)r * 16 + 4 * fq) = acc[ai][0][m][0]; }
            }
            return;
        }
        bf16* base; int ld, col0; bool rope = false, kv = false;
        if (pn < 6) { base = convb; ld = 1536; col0 = 256 * pn; }
        else if (pn < 8) { base = zb; ld = 512; col0 = 256 * (pn - 6); }
        else if (pn < 12) { base = qb; ld = 1024; col0 = 256 * (pn - 8); rope = pm < 64; }
        else if (pn < 16) { base = xbcb; ld = 1024; col0 = 256 * (pn - 12); }
        else if (pn < 20) { base = kb; ld = 1024; col0 = 256 * (pn - 16); rope = pm < 64; kv = true; }
        else { base = vb; ld = 1024; col0 = 256 * (pn - 20); kv = true; }
        const size_t rowbase = !kv ? (size_t)pm * 256 : (pm < 64 ? (size_t)(pm >> 5) * KVLEN + CTXL + (size_t)(pm & 31) * 256 : (size_t)(pm - 64) * KVLEN);
        bf16* bp = base + rowbase * ld + col0 + wc * 32 + 8 * fq;
        if (rope) {
#pragma unroll
            for (int ai = 0; ai < 2; ++ai)
#pragma unroll
                for (int m = 0; m < 4; ++m) { if (TAIL2 && u.half != 0 && u.half != ai + 1) continue;
                    const int rl = ai * 128 + wr * 64 + m * 16 + fr;
                    const int pos = (wc & 1) ? 128 + m * 16 + fr : 4 * (pm & 31) + 2 * ai + wr;
                    const f32x4 cs = *(const f32x4*)(ropec + pos * 16 + 4 * fq), sn = *(const f32x4*)(ropes + pos * 16 + 4 * fq);
#pragma unroll
                    for (int bj = 0; bj < 2; ++bj) {
                        const f32x4 a1 = acc[ai][bj][m][0], a2 = acc[ai][bj][m][1];
                        const f32x4 o1 = a1 * cs - a2 * sn, o2 = a2 * cs + a1 * sn;
                        if (K8_DIRECT && kv) st_k8(pm, pn, bj, ai, wr, wc, m, fr, fq, o1, o2);
                        else if (Q8_DIRECT && !kv) st_q8((unsigned char*)qb + (size_t)(pm * 16 + ai * 8 + wr * 4 + m) * 16384 + (size_t)(((col0 + bj * 128 + wc * 32) >> 3) + fq) * 128 + fr * 8, o1, o2);
                        else st8(bp + (size_t)rl * ld + bj * 128, o1, o2);
                    }
                }
        } else {
#pragma unroll
            for (int ai = 0; ai < 2; ++ai)
#pragma unroll
                for (int m = 0; m < 4; ++m) { if (TAIL2 && u.half != 0 && u.half != ai + 1) continue;
                    const int rl = ai * 128 + wr * 64 + m * 16 + fr;
#pragma unroll
                    for (int bj = 0; bj < 2; ++bj) { if (K8_DIRECT && kv && pn < 20) st_k8(pm, pn, bj, ai, wr, wc, m, fr, fq, acc[ai][bj][m][0], acc[ai][bj][m][1]);
                        else if (Q8_DIRECT && pn >= 8 && pn < 12) st_q8((unsigned char*)qb + (size_t)(pm * 16 + ai * 8 + wr * 4 + m) * 16384 + (size_t)(((col0 + bj * 128 + wc * 32) >> 3) + fq) * 128 + fr * 8, acc[ai][bj][m][0], acc[ai][bj][m][1]);
                        else st8(bp + (size_t)rl * ld + bj * 128, acc[ai][bj][m][0], acc[ai][bj][m][1]); }
                }
        }
    }
};
__device__ __forceinline__ void ld8b(const bf16* p, float (&o)[8]) { const v4u w = *(const v4u*)p; o[0] = bflo(w.x); o[1] = bfhi(w.x); o[2] = bflo(w.y); o[3] = bfhi(w.y); o[4] = bflo(w.z); o[5] = bfhi(w.z); o[6] = bflo(w.w); o[7] = bfhi(w.w); }
template <bool SRC16>
struct EpiResidT {
    const void* srcLat; const void* srcCtx; bf16* dst; const float* gate;
    __device__ __forceinline__ void operator()(const f32x4 (&acc)[2][2][4][2], const Unit& u, int wr, int wc, int fr, int fq) const {
        const int pm = u.pm; const int v = pm < 32 ? 0 : (pm < 64 ? 1 : 2);
        const float* gv = gate + (size_t)v * 6 * D;
        const size_t sro = pm < 64 ? (size_t)pm * 256 * D : (size_t)(pm - 64) * 256 * D;
        const float* s32 = (const float*)(pm < 64 ? srcLat : srcCtx) + sro; const bf16* s16 = (const bf16*)(pm < 64 ? srcLat : srcCtx) + sro;
        bf16* dp = dst + (size_t)pm * 256 * D;
#if PERM_OUT
        const int colb = u.pn * 256 + wc * 32 + 8 * fq;
        f32x4 g[2][2];
#pragma unroll
        for (int bj = 0; bj < 2; ++bj)
#pragma unroll
            for (int n = 0; n < 2; ++n) g[bj][n] = *(const f32x4*)(gv + colb + bj * 128 + n * 4);
#pragma unroll
        for (int ai = 0; ai < 2; ++ai)
#pragma unroll
            for (int m = 0; m < 4; ++m) { if (TAIL2 && u.half != 0 && u.half != ai + 1) continue;
                const size_t off = (size_t)(ai * 128 + wr * 64 + m * 16 + fr) * D + colb;
#pragma unroll
                for (int bj = 0; bj < 2; ++bj) { f32x4 s0, s1;
                    if (SRC16) { float t[8]; ld8b(s16 + off + bj * 128, t); s0 = (f32x4){t[0], t[1], t[2], t[3]}; s1 = (f32x4){t[4], t[5], t[6], t[7]}; }
                    else { s0 = ld4_f32(s32 + off + bj * 128); s1 = ld4_f32(s32 + off + bj * 128 + 4); }
                    st8(dp + off + bj * 128, s0 + g[bj][0] * acc[ai][bj][m][0], s1 + g[bj][1] * acc[ai][bj][m][1]); }
                asm volatile("" ::: "memory");
            }
#else
        const int colb = u.pn * 256 + wc * 32 + 4 * fq;
        f32x4 g[2][2];
#pragma unroll
        for (int bj = 0; bj < 2; ++bj)
#pragma unroll
            for (int n = 0; n < 2; ++n) g[bj][n] = *(const f32x4*)(gv + colb + bj * 128 + n * 16);
#pragma unroll
        for (int ai = 0; ai < 2; ++ai)
#pragma unroll
            for (int m = 0; m < 4; ++m) { if (TAIL2 && u.half != 0 && u.half != ai + 1) continue;
                const size_t off = (size_t)(ai * 128 + wr * 64 + m * 16 + fr) * D + colb;
#pragma unroll
                for (int bj = 0; bj < 2; ++bj)
#pragma unroll
                    for (int n = 0; n < 2; ++n) { const f32x4 s = SRC16 ? ld4_bf16(s16 + off + bj * 128 + n * 16) : ld4_f32(s32 + off + bj * 128 + n * 16);
                        st4_bf16(dp + off + bj * 128 + n * 16, s + g[bj][n] * acc[ai][bj][m][n]); }
                asm volatile("" ::: "memory");
            }
#endif
    }
};
struct EpiSwiGLU {
    bf16* act; int ld;
    __device__ __forceinline__ void operator()(const f32x4 (&acc)[2][2][4][2], const Unit& u, int wr, int wc, int fr, int fq) const {
        bf16* bp = act + (size_t)u.pm * 256 * ld + u.pn * 128 + wc * 32 + 8 * fq;
#pragma unroll
        for (int ai = 0; ai < 2; ++ai)
#pragma unroll
            for (int m = 0; m < 4; ++m) { if (TAIL2 && u.half != 0 && u.half != ai + 1) continue;
                const int rl = ai * 128 + wr * 64 + m * 16 + fr;
                f32x4 o[2];
#pragma unroll
                for (int bj = 0; bj < 2; ++bj) { const f32x4 g = acc[ai][bj][m][0], up = acc[ai][bj][m][1];
#pragma unroll
                    for (int j = 0; j < 4; ++j) o[bj][j] = silu_f(g[j]) * up[j]; }
                st8(bp + (size_t)rl * ld, o[0], o[1]);
            }
    }
};
constexpr float ACT_SCALE = 4.0f; constexpr int ACT_SC8 = 0x7D7D7D7D;
struct EpiSwiGLU8 {
    unsigned char* act; int ld;
    __device__ __forceinline__ void operator()(const f32x4 (&acc)[2][2][4][2], const Unit& u, int wr, int wc, int fr, int fq) const {
        unsigned char* bp = act + (size_t)u.pm * 256 * ld + u.pn * 128 + wc * 32 + 8 * fq;
#pragma unroll
        for (int ai = 0; ai < 2; ++ai)
#pragma unroll
            for (int m = 0; m < 4; ++m) { if (TAIL2 && u.half != 0 && u.half != ai + 1) continue;
                const int rl = ai * 128 + wr * 64 + m * 16 + fr;
                float o[8];
#pragma unroll
                for (int bj = 0; bj < 2; ++bj) { const f32x4 g = acc[ai][bj][m][0], up = acc[ai][bj][m][1];
#pragma unroll
                    for (int j = 0; j < 4; ++j) o[4 * bj + j] = fminf(fmaxf(silu_f(g[j]) * up[j] * ACT_SCALE, -448.f), 448.f); }
                v2u w;
                w.x = (unsigned)__builtin_amdgcn_cvt_pk_fp8_f32(o[2], o[3], __builtin_amdgcn_cvt_pk_fp8_f32(o[0], o[1], 0, false), true);
                w.y = (unsigned)__builtin_amdgcn_cvt_pk_fp8_f32(o[6], o[7], __builtin_amdgcn_cvt_pk_fp8_f32(o[4], o[5], 0, false), true);
                *(v2u*)(bp + (size_t)rl * ld) = w;
            }
    }
};
struct EpiBf16 {
    bf16* O; int ld;
    __device__ __forceinline__ void operator()(const f32x4 (&acc)[2][2][4][2], const Unit& u, int wr, int wc, int fr, int fq) const {
        bf16* bp = O + (size_t)u.pm * 256 * ld + u.pn * 256 + wc * 32 + 8 * fq;
#pragma unroll
        for (int ai = 0; ai < 2; ++ai)
#pragma unroll
            for (int m = 0; m < 4; ++m) { if (TAIL2 && u.half != 0 && u.half != ai + 1) continue;
                const int rl = ai * 128 + wr * 64 + m * 16 + fr;
#pragma unroll
                for (int bj = 0; bj < 2; ++bj) st8(bp + (size_t)rl * ld + bj * 128, acc[ai][bj][m][0], acc[ai][bj][m][1]);
                asm volatile("" ::: "memory");
            }
    }
};
struct EpiPartial {
    float* part;
    __device__ __forceinline__ void operator()(const f32x4 (&acc)[2][2][4][2], const Unit& u, int wr, int wc, int fr, int fq) const {
        float* dp = part + ((size_t)u.ks * NCTX + (size_t)(u.pm - 64) * 256) * D + u.pn * 256 + wc * 32 + (PERM_OUT ? 8 : 4) * fq;
#pragma unroll
        for (int ai = 0; ai < 2; ++ai)
#pragma unroll
            for (int m = 0; m < 4; ++m) { if (TAIL2 && u.half != 0 && u.half != ai + 1) continue;
                const size_t off = (size_t)(ai * 128 + wr * 64 + m * 16 + fr) * D;
#pragma unroll
                for (int bj = 0; bj < 2; ++bj)
#pragma unroll
                    for (int n = 0; n < 2; ++n) *(f32x4*)(dp + off + bj * 128 + n * (PERM_OUT ? 4 : 16)) = acc[ai][bj][m][n];
                asm volatile("" ::: "memory");
            }
    }
};
}
struct Params { const float* in[28]; float* out; unsigned char* ws; };
enum { I_X = 0, I_C, I_CTX, I_CCTX, I_WMOD, I_BMOD, I_GMIX, I_GFFN, I_WIN, I_CONVW, I_SCONVW, I_SCONVB, I_ALOG, I_DTB, I_SSDD, I_SNORM, I_LAMBDA, I_SUBLN, I_WOUT,
       I_FG, I_FU, I_FD, I_RW, I_RB, I_MG, I_MU, I_MD, I_GFIN };
struct Frame {
    LAS unsigned char* lds; volatile LAS unsigned* MISC; gu32* ctl;
    int wave, vcu, G;
};
struct Lane { int tid, lane; __device__ __forceinline__ Lane(int wave) { tid = fresh_tid(wave); lane = tid & 63; } };

#define g_nostore (*(volatile LAS int*)(unsigned)(MISC_OFF + 512))
__device__ __forceinline__ void tr_item(const float* colptr, int ld, bool perm, bf16* wt, int K, int k0, LAS float* scr, int lane) {
    const int j = lane & 31;
    float tv[32];
#pragma unroll
    for (int i = 0; i < 32; ++i) { const int kk = 2 * i + (lane >> 5); tv[i] = colptr[(size_t)(k0 + kk) * ld]; }
#pragma unroll
    for (int i = 0; i < 32; ++i) { const int kk = 2 * i + (lane >> 5); scr[kk * 33 + j] = tv[i]; }
    LDS_WAIT(); asm volatile("" ::: "memory");
    const int c = lane & 7;
#pragma unroll
    for (int jj = 0; jj < 4; ++jj) { const int n = (lane >> 3) + 8 * jj; const int slot = perm ? pg8::perm32(n) : n; const LAS float* s = scr + (8 * c) * 33 + slot;
        v4u o; o.x = pk2(s[0 * 33], s[1 * 33]); o.y = pk2(s[2 * 33], s[3 * 33]); o.z = pk2(s[4 * 33], s[5 * 33]); o.w = pk2(s[6 * 33], s[7 * 33]);
        if (NOSTORE_PROBE && g_nostore) { asm volatile("" :: "v"(o.x), "v"(o.y), "v"(o.z), "v"(o.w)); } else *(GAS v4u*)(wt + (size_t)n * K + k0 + 8 * c) = o; }
    LDS_WAIT(); asm volatile("" ::: "memory");
}
constexpr float W8_SCALE = 64.0f; constexpr int W8_SC8 = 0x79797979;
template <bool I8 = false, bool MAYNULL = false>
__device__ __forceinline__ void tr_item8(const float* colptr, int ld, bool perm, unsigned char* wt, int K, int k0, LAS float* scr, int lane, float mulA = 0.f, float mulB = 0.f) {
    const int j = lane & 31;
    float tv[32];
#pragma unroll
    for (int i = 0; i < 32; ++i) { const int kk = 2 * i + (lane >> 5); tv[i] = (!MAYNULL || colptr) ? colptr[(size_t)(k0 + kk) * ld] : 0.f; }
#pragma unroll
    for (int i = 0; i < 32; ++i) { const int kk = 2 * i + (lane >> 5); scr[kk * 33 + j] = tv[i]; }
    LDS_WAIT(); asm volatile("" ::: "memory");
    const int c = lane & 3;
#pragma unroll
    for (int jj = 0; jj < 2; ++jj) { const int n = (lane >> 2) + 16 * jj; const int slot = perm ? pg8::perm32(n) : n; const LAS float* s = scr + (16 * c) * 33 + slot;
        float v[16]; v4u o;
        if constexpr (I8) { const float mul = jj ? mulB : mulA;
#pragma unroll
            for (int i = 0; i < 16; ++i) v[i] = __builtin_amdgcn_fmed3f(s[i * 33] * mul, -127.f, 127.f);
            o.x = pk_i8(v[0], v[1], v[2], v[3]); o.y = pk_i8(v[4], v[5], v[6], v[7]); o.z = pk_i8(v[8], v[9], v[10], v[11]); o.w = pk_i8(v[12], v[13], v[14], v[15]);
        } else {
#pragma unroll
        for (int i = 0; i < 16; ++i) v[i] = fminf(fmaxf(s[i * 33] * W8_SCALE, -448.f), 448.f);
        o.x = (unsigned)__builtin_amdgcn_cvt_pk_fp8_f32(v[2], v[3], __builtin_amdgcn_cvt_pk_fp8_f32(v[0], v[1], 0, false), true);
        o.y = (unsigned)__builtin_amdgcn_cvt_pk_fp8_f32(v[6], v[7], __builtin_amdgcn_cvt_pk_fp8_f32(v[4], v[5], 0, false), true);
        o.z = (unsigned)__builtin_amdgcn_cvt_pk_fp8_f32(v[10], v[11], __builtin_amdgcn_cvt_pk_fp8_f32(v[8], v[9], 0, false), true);
        o.w = (unsigned)__builtin_amdgcn_cvt_pk_fp8_f32(v[14], v[15], __builtin_amdgcn_cvt_pk_fp8_f32(v[12], v[13], 0, false), true);
        }
        if (NOSTORE_PROBE && g_nostore) { asm volatile("" :: "v"(o.x), "v"(o.y), "v"(o.z), "v"(o.w)); } else *(GAS v4u*)(wt + (size_t)n * K + k0 + 16 * c) = o; }
    LDS_WAIT(); asm volatile("" ::: "memory");
}
template <bool I8, bool MAYNULL>
__device__ __forceinline__ void tr_pair8(const float* colptr, int ld, bool perm, unsigned char* wt, int K, int k0, LAS float* scr, int lane, float mulA = 0.f, float mulB = 0.f) {
    const int j = lane & 31;
#pragma unroll
    for (int hf = 0; hf < 2; ++hf) {
        float tv[32];
#pragma unroll
        for (int i = 0; i < 32; ++i) { const int kk = 64 * hf + 2 * i + (lane >> 5); tv[i] = (!MAYNULL || colptr) ? colptr[(size_t)(k0 + kk) * ld] : 0.f; }
#pragma unroll
        for (int i = 0; i < 32; ++i) { const int kk = 64 * hf + 2 * i + (lane >> 5); scr[kk * 32 + (j ^ (4 * (kk >> 4)))] = tv[i]; }
    }
    LDS_WAIT(); asm volatile("" ::: "memory");
    const int c = lane & 7;
#pragma unroll
    for (int jj = 0; jj < 4; ++jj) { const int n = (lane >> 3) + 8 * jj; const int slot = perm ? pg8::perm32(n) : n; const LAS float* s = scr + (16 * c) * 32 + (slot ^ (4 * c));
        float v[16]; v4u o;
        if constexpr (I8) { const float mul = jj >= 2 ? mulB : mulA;
#pragma unroll
            for (int i = 0; i < 16; ++i) v[i] = __builtin_amdgcn_fmed3f(s[i * 32] * mul, -127.f, 127.f);
            o.x = pk_i8(v[0], v[1], v[2], v[3]); o.y = pk_i8(v[4], v[5], v[6], v[7]); o.z = pk_i8(v[8], v[9], v[10], v[11]); o.w = pk_i8(v[12], v[13], v[14], v[15]);
        } else {
#pragma unroll
            for (int i = 0; i < 16; ++i) v[i] = fminf(fmaxf(s[i * 32] * W8_SCALE, -448.f), 448.f);
            o.x = (unsigned)__builtin_amdgcn_cvt_pk_fp8_f32(v[2], v[3], __builtin_amdgcn_cvt_pk_fp8_f32(v[0], v[1], 0, false), true);
            o.y = (unsigned)__builtin_amdgcn_cvt_pk_fp8_f32(v[6], v[7], __builtin_amdgcn_cvt_pk_fp8_f32(v[4], v[5], 0, false), true);
            o.z = (unsigned)__builtin_amdgcn_cvt_pk_fp8_f32(v[10], v[11], __builtin_amdgcn_cvt_pk_fp8_f32(v[8], v[9], 0, false), true);
            o.w = (unsigned)__builtin_amdgcn_cvt_pk_fp8_f32(v[14], v[15], __builtin_amdgcn_cvt_pk_fp8_f32(v[12], v[13], 0, false), true);
        }
        *(GAS v4u*)(wt + (size_t)n * K + k0 + 16 * c) = o; }
    LDS_WAIT(); asm volatile("" ::: "memory");
}
__device__ __forceinline__ const float* gu_colptr(const float* gate, const float* up, int nb, int j) {
    const int pn = nb >> 3, r = nb & 7, bj = r >> 2, wc = r & 3, n = j >> 4, i = j & 15, fq = i >> 2, jj = i & 3;
    return (n ? up : gate) + 128 * pn + 32 * wc + 8 * fq + 4 * bj + jj;
}

#if CV_PAIR
constexpr int CV_IN = 200 * 16, CV_OUT = 64 * 32, CV_GU = 352 * 16, CV_DN = 64 * 44, CV_MGU1 = 176 * 16, CV_MDN1 = 64 * 22;
#else
constexpr int CV_IN = 200 * 32, CV_OUT = 64 * 32, CV_GU = 352 * 32, CV_DN = 64 * 88, CV_MGU1 = 176 * 32, CV_MDN1 = 64 * 44;
#endif
constexpr int CV_NEARLY = CV_IN + CV_OUT + CV_GU + CV_DN, CV_NITEMS = 2 * CV_IN + 2 * CV_OUT + CV_GU + CV_DN + NE * CV_MGU1 + NE * CV_MDN1, CV_NDEF = CV_NITEMS - CV_NEARLY;
__device__ __forceinline__ void conv_item(Frame& F, const Params& P, int it) {
    unsigned char* ws = fresh_ws(P.ws);
    const LAS float* wsc = (const LAS float*)(F.lds + MISC_OFF + 256);
    float* csw = (float*)(ws + WS_CS);
    LAS float* scr = (LAS float*)(F.lds + F.wave * 16384);
    const int lane = lane_id(), j = lane & 31;
    int r = it, l = 0;
    if (r >= CV_NEARLY) { r -= CV_NEARLY; l = 1; }
    if (r < CV_IN) { const int nb = r % 200, kb = r / 200, n0 = 32 * nb;
        const float* w = P.in[I_WIN] + (size_t)l * D * IN_COLS; const float* cp; bool perm;
        if (n0 < 4096) { cp = w + n0 + j; perm = !(n0 >= 2048 && n0 < 3072); }
        else if (n0 < 5120) { cp = w + COL_K + (n0 - 4096) + j; perm = false; }
        else if (n0 < 6144) { cp = w + COL_V + (n0 - 5120) + j; perm = !V8_DIRECT; }
        else if (n0 == 6144) { cp = j < 16 ? w + COL_DT + j : nullptr; perm = false; }
        else { cp = nullptr; perm = false; }
        const float st = wsc[l], inv = 1.0f / st;
        if (kb == 0 && lane < 32) csw[CS_WIN + l * 6400 + n0 + lane] = st;
        if (CV_PAIR) tr_pair8<true, true>(cp, IN_COLS, perm, ws + WS_WIN + l * SZ_WIN + (size_t)n0 * D, D, 128 * kb, scr, lane, inv, inv);
        else tr_item8<true, true>(cp, IN_COLS, perm, ws + WS_WIN + l * SZ_WIN + (size_t)n0 * D, D, 64 * kb, scr, lane, inv, inv);
        return; }
    r -= CV_IN;
    if (r < CV_OUT) { const int nb = r % 64, kb = r / 64, n0 = 32 * nb;
        tr_item(P.in[I_WOUT] + (size_t)l * D * D + n0 + j, D, PERM_OUT != 0, (bf16*)(ws + WS_WOUT + l * SZ_WOUT) + (size_t)n0 * D, D, 64 * kb, scr, lane); return; }
    r -= CV_OUT;
    if (l == 0) {
        if (r < CV_GU) { const int nb = r % 352, kb = r / 352;
            const float sg = wsc[2], su = wsc[3];
            if (kb == 0 && lane < 32) csw[CS_WGU + 32 * nb + lane] = lane < 16 ? sg : su;
            if (CV_PAIR) tr_pair8<true, false>(gu_colptr(P.in[I_FG], P.in[I_FU], nb, j), FFD, false, ws + WS_WGU + (size_t)(32 * nb) * D, D, 128 * kb, scr, lane, 1.0f / sg, 1.0f / su);
            else tr_item8<true>(gu_colptr(P.in[I_FG], P.in[I_FU], nb, j), FFD, false, ws + WS_WGU + (size_t)(32 * nb) * D, D, 64 * kb, scr, lane, 1.0f / sg, 1.0f / su);
            return; }
        r -= CV_GU;
        { const int nb = r % 64, kb = r / 64, n0 = 32 * nb;
          if (CV_PAIR) tr_pair8<false, false>(P.in[I_FD] + n0 + j, D, PERM_OUT != 0, ws + WS_WDN + (size_t)n0 * FFD, FFD, 128 * kb, scr, lane);
          else tr_item8(P.in[I_FD] + n0 + j, D, PERM_OUT != 0, ws + WS_WDN + (size_t)n0 * FFD, FFD, 64 * kb, scr, lane);
          return; }
    }
    if (r < NE * CV_MGU1) { const int e = r / CV_MGU1; r -= e * CV_MGU1; const int nb = r % 176, kb = r / 176;
        const float sg = wsc[4 + e], su = wsc[12 + e];
        if (kb == 0 && lane < 32) csw[CS_MGU + e * (2 * FFE) + 32 * nb + lane] = lane < 16 ? sg : su;
        if (CV_PAIR) tr_pair8<true, false>(gu_colptr(P.in[I_MG] + (size_t)e * D * FFE, P.in[I_MU] + (size_t)e * D * FFE, nb, j), FFE, false, ws + WS_MGU + e * (SZ_MGU / 2) + (size_t)(32 * nb) * D, D, 128 * kb, scr, lane, 1.0f / sg, 1.0f / su);
        else tr_item8<true>(gu_colptr(P.in[I_MG] + (size_t)e * D * FFE, P.in[I_MU] + (size_t)e * D * FFE, nb, j), FFE, false, ws + WS_MGU + e * (SZ_MGU / 2) + (size_t)(32 * nb) * D, D, 64 * kb, scr, lane, 1.0f / sg, 1.0f / su);
        return; }
    r -= NE * CV_MGU1;
    { const int e = r / CV_MDN1; r -= e * CV_MDN1; const int nb = r % 64, kb = r / 64, n0 = 32 * nb;
      if (CV_PAIR) tr_pair8<false, false>(P.in[I_MD] + (size_t)e * FFE * D + n0 + j, D, true, ws + WS_MDN + e * (SZ_MDN / 2) + (size_t)n0 * FFE, FFE, 128 * kb, scr, lane);
      else tr_item8(P.in[I_MD] + (size_t)e * FFE * D + n0 + j, D, true, ws + WS_MDN + e * (SZ_MDN / 2) + (size_t)n0 * FFE, FFE, 64 * kb, scr, lane); }
}
#define ITEM_NB(r, N, NKB, OLD) (ITEM_NBFAST == 2 ? (((r) >> 3) / (NKB)) * 8 + ((r) & 7) : ITEM_NBFAST == 1 ? (r) % (N) : (OLD))
#define ITEM_KB(r, N, NKB, OLD) (ITEM_NBFAST == 2 ? ((r) >> 3) % (NKB) : ITEM_NBFAST == 1 ? (r) / (N) : (OLD))
__device__ __forceinline__ void p0_prologue(Frame& F, const Params& P) {
    const Lane L(F.wave);
    unsigned char* ws = fresh_ws(P.ws);
    if (F.vcu < 192) {
      for (int rep_ = 0; rep_ <= DUP_MODV; ++rep_) {
        const int l = F.vcu / 96, cb = F.vcu % 96;
        LAS float* sv = (LAS float*)(F.lds);
        LAS float* red = (LAS float*)(F.lds + 32768);
        for (int i = L.tid; i < 3 * D; i += 512) { const int v = i / D, k = i % D; const float c = v < 2 ? P.in[I_C][v * D + k] : P.in[I_CCTX][k]; sv[i] = c / (1.0f + __expf(-c)); }
        __syncthreads();
        const float* W = P.in[I_WMOD] + (size_t)l * D * 12288 + cb * 128 + 2 * L.lane;
        f32x2 a0 = {0.f, 0.f}, a1 = {0.f, 0.f}, a2 = {0.f, 0.f};
        const int kb = F.wave * 256;
#pragma unroll 16
        for (int k = 0; k < 256; ++k) { const f32x2 w = *(const f32x2*)(W + (size_t)(kb + k) * 12288); a0 += w * sv[kb + k]; a1 += w * sv[D + kb + k]; a2 += w * sv[2 * D + kb + k]; }
        *(LAS f32x2*)(red + (F.wave * 3 + 0) * 128 + 2 * L.lane) = a0; *(LAS f32x2*)(red + (F.wave * 3 + 1) * 128 + 2 * L.lane) = a1; *(LAS f32x2*)(red + (F.wave * 3 + 2) * 128 + 2 * L.lane) = a2;
        __syncthreads();
        if (L.tid < 384) { const int v = L.tid >> 7, col = L.tid & 127; float s = P.in[I_BMOD][l * 12288 + cb * 128 + col];
#pragma unroll
            for (int w = 0; w < 8; ++w) s += red[(w * 3 + v) * 128 + col];
            ((float*)(ws + WS_MOD))[(size_t)(l * 3 + v) * 12288 + cb * 128 + col] = s; }
        __syncthreads();
      }
    } else if (F.vcu == 192) {
        float* rc = (float*)(ws + WS_ROPE); float* rs = rc + 192 * 16;
        for (int i = L.tid; i < 192 * 16; i += 512) { const int pos = i >> 4, f = i & 15; const float inv = exp2f(-(float)f * (13.287712379549449f / 16.0f)); const float ang = (float)(pos < 128 ? pos : pos - 128) * inv; rc[i] = cosf(ang); rs[i] = sinf(ang); }
    }
    LAS float* wsc = (LAS float*)(F.lds + MISC_OFF + 256);
    for (int t = F.wave; t < 20; t += NWAVES) {
        const float* tp = t < 2 ? P.in[I_WIN] + (size_t)t * D * IN_COLS : t == 2 ? P.in[I_FG] : t == 3 ? P.in[I_FU] : t < 12 ? P.in[I_MG] + (size_t)(t - 4) * D * FFE : P.in[I_MU] + (size_t)(t - 12) * D * FFE;
        float ss = 0.f;
#pragma unroll
        for (int i = 0; i < 16; ++i) { const f32x4 w = *(const f32x4*)(tp + 4 * (L.lane + 64 * i)); ss += (w[0] * w[0] + w[1] * w[1]) + (w[2] * w[2] + w[3] * w[3]); }
        ss = wave_sum(ss);
        if (L.lane == 0) wsc[t] = sqrtf(ss * (1.0f / 4096.0f)) * (I8_CLIP / 127.0f);
    }
    __syncthreads();
    float* csw = (float*)(ws + WS_CS);
    const int gw = F.vcu * NWAVES + F.wave, NGW = F.G * NWAVES;
    constexpr int NPRE = 63 * NWAVES * (CV_PAIR ? 4 : 7);
    const bool early = F.vcu > 192;
    const int nA = early ? NPRE : 0, sA = early ? (F.vcu - 193) * NWAVES + F.wave : 0, stA = 63 * NWAVES;
    for (int ph = 0; ph < 2; ++ph) {
      const int lo = ph == 0 ? sA : NPRE + gw, hi2 = ph == 0 ? nA : ((DEFER && F.G == 256) ? CV_NEARLY : CV_NITEMS), st = ph == 0 ? stA : NGW;
      for (int it = lo; it < hi2; it += st) conv_item(F, P, it);
    }
}
__device__ __forceinline__ void deferred_slot(Frame& F, const Params& P, int dpos, int k, int nIdle, int ipw) {
    const int w0 = k * NWAVES + F.wave, st = nIdle * NWAVES;
    for (int i = 0; i < ipw; ++i) { const int it = CV_NEARLY + dpos + w0 + i * st; if (it < CV_NITEMS) conv_item(F, P, it); }
}
__device__ __forceinline__ void deferred_rest(Frame& F, const Params& P, int dpos) {
    for (int it = CV_NEARLY + dpos + F.vcu * NWAVES + F.wave; it < CV_NITEMS; it += F.G * NWAVES) conv_item(F, P, it);
}

__device__ __forceinline__ void store_row_i8(unsigned char* hr, float* hs, int r, const f32x4 (&x)[8], int lane) {
    float am = 0.f;
#pragma unroll
    for (int jq = 0; jq < 8; ++jq) am = fmaxf(fmaxf(am, fmaxf(fabsf(x[jq][0]), fabsf(x[jq][1]))), fmaxf(fabsf(x[jq][2]), fabsf(x[jq][3])));
    am = fmaxf(wave_max(am), 1e-30f);
    const float inv = 127.0f / am;
#pragma unroll
    for (int jq = 0; jq < 8; ++jq) *(unsigned*)(hr + 4 * lane + 256 * jq) = pk_i8(x[jq][0] * inv, x[jq][1] * inv, x[jq][2] * inv, x[jq][3] * inv);
    if (lane == 0) hs[r] = am * (1.0f / 127.0f);
}
template <bool ROUTE, int OUT8 = 0, bool SL16 = false, bool SC16 = false>
__device__ __forceinline__ void norm_phase(Frame& F, const void* srcLatV, const void* srcCtxV, const float* gvec, const float* modl, int ishift, int iscale, bf16* h, int nrows,
                                           const float* wrouter, const float* brouter, int* tok_e, int* tok_slot, float* tok_p,
                                           const float* part = nullptr, int nsl = 0, const float* pgate = nullptr, bf16* wb = nullptr, float* hs = nullptr) {
    const Lane L(F.wave);
    LAS float* wrT = (LAS float*)F.lds;
    if (ROUTE) {
        for (int i = L.tid; i < D * NE; i += 512) { const int k = i >> 3, e = i & 7; wrT[e * D + k] = wrouter[i]; }
        __syncthreads();
    }
    const int gw = F.vcu * NWAVES + F.wave, NGW = F.G * NWAVES, lane = L.lane;
    const int nmain = part != nullptr ? NLAT / 8 : nrows / 8;
    for (int run = gw; run < nmain; run += NGW) {
        const int r0 = run * 8; const int v = r0 < SEQ ? 0 : (r0 < NLAT ? 1 : 2);
        const float* sh = modl + (size_t)(v * 6 + ishift) * D; const float* sc = modl + (size_t)(v * 6 + iscale) * D;
        f32x4 A[8], B[8];
#pragma unroll
        for (int jq = 0; jq < 8; ++jq) { const int c = 4 * lane + 256 * jq; const f32x4 g = *(const f32x4*)(gvec + c), s = *(const f32x4*)(sc + c); A[jq] = g * (s + 1.0f); B[jq] = *(const f32x4*)(sh + c); }
        for (int rr = 0; rr < 8; ++rr) {
            const int r = r0 + rr;
            f32x4 x[8]; float ss = 0.f;
            if (r < NLAT) {
#pragma unroll
                for (int jq = 0; jq < 8; ++jq) x[jq] = SL16 ? ld4_bf16((const bf16*)srcLatV + (size_t)r * D + 4 * lane + 256 * jq) : ld4_f32((const float*)srcLatV + (size_t)r * D + 4 * lane + 256 * jq);
            } else {
#pragma unroll
                for (int jq = 0; jq < 8; ++jq) x[jq] = SC16 ? ld4_bf16((const bf16*)srcCtxV + (size_t)(r - NLAT) * D + 4 * lane + 256 * jq) : ld4_f32((const float*)srcCtxV + (size_t)(r - NLAT) * D + 4 * lane + 256 * jq);
            }
#pragma unroll
            for (int jq = 0; jq < 8; ++jq) ss += (x[jq][0] * x[jq][0] + x[jq][1] * x[jq][1]) + (x[jq][2] * x[jq][2] + x[jq][3] * x[jq][3]);
            const float rstd = 1.0f / sqrtf(wave_sum(ss) * (1.0f / D) + NORM_EPS);
#pragma unroll
            for (int jq = 0; jq < 8; ++jq) x[jq] = (x[jq] * rstd) * A[jq] + B[jq];
            if constexpr (OUT8 == 2 && ROUTE && MOE_SPARSE) {   }
            else if constexpr (OUT8 == 2) store_row_i8((unsigned char*)h + (size_t)r * D, hs, r, x, lane);
            else if constexpr (OUT8 == 1) {
                unsigned char* hr8 = (unsigned char*)h + (size_t)r * D;
#pragma unroll
                for (int jq = 0; jq < 8; ++jq) { const f32x4 y = __builtin_elementwise_min(__builtin_elementwise_max(x[jq], (f32x4){-448.f, -448.f, -448.f, -448.f}), (f32x4){448.f, 448.f, 448.f, 448.f});
                    *(unsigned*)(hr8 + 4 * lane + 256 * jq) = (unsigned)__builtin_amdgcn_cvt_pk_fp8_f32(y[2], y[3], __builtin_amdgcn_cvt_pk_fp8_f32(y[0], y[1], 0, false), true); }
            } else {
            bf16* hr = h + (size_t)r * D;
#pragma unroll
            for (int jq = 0; jq < 8; ++jq) { v2u w; w.x = cvtpk(x[jq][0], x[jq][1]); w.y = cvtpk(x[jq][2], x[jq][3]); *(v2u*)(hr + 4 * lane + 256 * jq) = w; }
            }
            if (ROUTE) {
                float lg[NE];
#pragma unroll
                for (int e = 0; e < NE; ++e) { float p = 0.f;
#pragma unroll
                    for (int jq = 0; jq < 8; ++jq) { const f32x4 w = *(const LAS f32x4*)(wrT + e * D + 4 * lane + 256 * jq); p += (x[jq][0] * w[0] + x[jq][1] * w[1]) + (x[jq][2] * w[2] + x[jq][3] * w[3]); }
                    lg[e] = wave_sum(p) + brouter[e]; }
                int i0 = 0; float v0 = lg[0];
#pragma unroll
                for (int e = 1; e < NE; ++e) if (lg[e] > v0) { v0 = lg[e]; i0 = e; }
                int i1 = -1; float v1 = -3.0e38f;
#pragma unroll
                for (int e = 0; e < NE; ++e) if (e != i0 && lg[e] > v1) { v1 = lg[e]; i1 = e; }
                int s0 = 0, s1 = 0;
                if (lane == 0) {
                    const float p0 = 1.0f / (1.0f + __expf(v1 - v0));
                    s0 = (int)__hip_atomic_fetch_add(F.ctl + CW_CNT + 64 * i0, 1u, RLX_AGENT);
                    s1 = (int)__hip_atomic_fetch_add(F.ctl + CW_CNT + 64 * i1, 1u, RLX_AGENT);
                    tok_e[2 * r] = i0; tok_e[2 * r + 1] = i1; tok_slot[2 * r] = s0; tok_slot[2 * r + 1] = s1; tok_p[2 * r] = p0; tok_p[2 * r + 1] = 1.0f - p0;
                }
                if constexpr (OUT8 == 2 && MOE_SPARSE) {
                    s0 = __builtin_amdgcn_readfirstlane(s0); s1 = __builtin_amdgcn_readfirstlane(s1);
                    float am = 0.f;
#pragma unroll
                    for (int jq = 0; jq < 8; ++jq) am = fmaxf(fmaxf(am, fmaxf(fabsf(x[jq][0]), fabsf(x[jq][1]))), fmaxf(fabsf(x[jq][2]), fabsf(x[jq][3])));
                    am = fmaxf(wave_max(am), 1e-30f);
                    const float inv = 127.0f / am;
                    const size_t ra = (size_t)i0 * NLAT + s0, rb = (size_t)i1 * NLAT + s1;
                    unsigned char* d0 = (unsigned char*)h + ra * D; unsigned char* d1 = (unsigned char*)h + rb * D;
#pragma unroll
                    for (int jq = 0; jq < 8; ++jq) { const unsigned w = pk_i8(x[jq][0] * inv, x[jq][1] * inv, x[jq][2] * inv, x[jq][3] * inv);
                        *(unsigned*)(d0 + 4 * lane + 256 * jq) = w; *(unsigned*)(d1 + 4 * lane + 256 * jq) = w; }
                    if (lane == 0) { hs[ra] = am * (1.0f / 127.0f); hs[rb] = am * (1.0f / 127.0f); }
                }
            }
        }
    }
    if (part != nullptr) {
        const float* sh = modl + (size_t)(2 * 6 + ishift) * D; const float* sc = modl + (size_t)(2 * 6 + iscale) * D;
        for (int r = NLAT + gw; r < NLAT + NCTX; r += NGW) {
            f32x4 x[8]; float ss = 0.f;
#pragma unroll
            for (int jq = 0; jq < 8; ++jq) { const int c = 4 * lane + 256 * jq; f32x4 a = *(const f32x4*)(part + (size_t)(r - NLAT) * D + c);
                for (int s = 1; s < nsl; ++s) a += *(const f32x4*)(part + ((size_t)s * NCTX + (r - NLAT)) * D + c);
                const f32x4 xs = SC16 ? ld4_bf16((const bf16*)srcCtxV + (size_t)(r - NLAT) * D + c) : ld4_f32((const float*)srcCtxV + (size_t)(r - NLAT) * D + c);
                x[jq] = xs + *(const f32x4*)(pgate + c) * a;
                ss += (x[jq][0] * x[jq][0] + x[jq][1] * x[jq][1]) + (x[jq][2] * x[jq][2] + x[jq][3] * x[jq][3]); }
            if (wb) {
#pragma unroll
                for (int jq = 0; jq < 8; ++jq) st4_bf16(wb + (size_t)r * D + 4 * lane + 256 * jq, x[jq]);
            }
            const float rstd = 1.0f / sqrtf(wave_sum(ss) * (1.0f / D) + NORM_EPS);
            bf16* hr = h + (size_t)r * D;
            if constexpr (OUT8 == 2) {
#pragma unroll
                for (int jq = 0; jq < 8; ++jq) { const int c = 4 * lane + 256 * jq; const f32x4 g = *(const f32x4*)(gvec + c), s = *(const f32x4*)(sc + c), b = *(const f32x4*)(sh + c); x[jq] = (x[jq] * rstd) * (g * (s + 1.0f)) + b; }
                store_row_i8((unsigned char*)h + (size_t)r * D, hs, r, x, lane);
            } else
#pragma unroll
            for (int jq = 0; jq < 8; ++jq) { const int c = 4 * lane + 256 * jq; const f32x4 g = *(const f32x4*)(gvec + c), s = *(const f32x4*)(sc + c), b = *(const f32x4*)(sh + c);
                f32x4 y = (x[jq] * rstd) * (g * (s + 1.0f)) + b;
                if constexpr (OUT8 == 1) { y = __builtin_elementwise_min(__builtin_elementwise_max(y, (f32x4){-448.f, -448.f, -448.f, -448.f}), (f32x4){448.f, 448.f, 448.f, 448.f});
                    *(unsigned*)((unsigned char*)h + (size_t)r * D + c) = (unsigned)__builtin_amdgcn_cvt_pk_fp8_f32(y[2], y[3], __builtin_amdgcn_cvt_pk_fp8_f32(y[0], y[1], 0, false), true); }
                else { v2u w; w.x = cvtpk(y[0], y[1]); w.y = cvtpk(y[2], y[3]); *(v2u*)(hr + c) = w; } }
        }
    }
    if (ROUTE) __syncthreads();
}

__device__ __forceinline__ void ld8f(const bf16* p, float (&o)[8]) { const v4u w = *(const v4u*)p; o[0] = bflo(w.x); o[1] = bfhi(w.x); o[2] = bflo(w.y); o[3] = bfhi(w.y); o[4] = bflo(w.z); o[5] = bfhi(w.z); o[6] = bflo(w.w); o[7] = bfhi(w.w); }
__device__ __forceinline__ void st8f(bf16* p, const float (&o)[8]) { v4u w; w.x = cvtpk(o[0], o[1]); w.y = cvtpk(o[2], o[3]); w.z = cvtpk(o[4], o[5]); w.w = cvtpk(o[6], o[7]); *(v4u*)p = w; }
__device__ __forceinline__ void conv_phase(Frame& F, const bf16* convb, const bf16* xbcb, bf16* cat, bf16* xbcc, const float* cw  , const float* sw  , const float* sb  ) {
    const Lane L(F.wave);
    const int gt = F.vcu * 512 + L.tid, NT = F.G * 512;
    constexpr int NRUN = T / 16, NITEM = NRUN * 192;
    for (int it = gt; it < NITEM; it += NT) {
        const int cc = it % 192, run = it / 192, r0 = run * 16;
        const int tl = r0 < NLAT ? (r0 % SEQ) : ((r0 - NLAT) % CTXL); const int sl = r0 < NLAT ? SEQ : CTXL;
        const bool first = tl == 0, last = tl + 16 == sl;
        if (cc < 64) {
            const int c0 = 8 * cc; float w0[8], w1[8], w2[8];
#pragma unroll
            for (int j = 0; j < 8; ++j) { w0[j] = cw[c0 + j]; w1[j] = cw[512 + c0 + j]; w2[j] = cw[1024 + c0 + j]; }
            float up[8], uc[8], un[8], a[8], b[8];
            if (first) {
#pragma unroll
                for (int j = 0; j < 8; ++j) up[j] = 0.f;
            } else { ld8f(convb + (size_t)(r0 - 1) * 1536 + 512 + c0, a); ld8f(convb + (size_t)(r0 - 1) * 1536 + 1024 + c0, b);
#pragma unroll
                for (int j = 0; j < 8; ++j) up[j] = a[j] * b[j]; }
            ld8f(convb + (size_t)r0 * 1536 + 512 + c0, a); ld8f(convb + (size_t)r0 * 1536 + 1024 + c0, b);
#pragma unroll
            for (int j = 0; j < 8; ++j) uc[j] = a[j] * b[j];
            for (int t = 0; t < 16; ++t) {
                const int r = r0 + t;
                if (t == 15 && last) {
#pragma unroll
                    for (int j = 0; j < 8; ++j) un[j] = 0.f;
                } else { ld8f(convb + (size_t)(r + 1) * 1536 + 512 + c0, a); ld8f(convb + (size_t)(r + 1) * 1536 + 1024 + c0, b);
#pragma unroll
                    for (int j = 0; j < 8; ++j) un[j] = a[j] * b[j]; }
                float g[8], o[8]; ld8f(convb + (size_t)r * 1536 + c0, g);
#pragma unroll
                for (int j = 0; j < 8; ++j) { o[j] = g[j] * ((up[j] * w0[j] + uc[j] * w1[j]) + un[j] * w2[j]); up[j] = uc[j]; uc[j] = un[j]; }
                st8f(cat + (size_t)r * D + c0, o);
            }
        } else {
            const int c0 = 8 * (cc - 64); float w0[8], w1[8], w2[8], bb[8];
#pragma unroll
            for (int j = 0; j < 8; ++j) { w0[j] = sw[c0 + j]; w1[j] = sw[1024 + c0 + j]; w2[j] = sw[2048 + c0 + j]; bb[j] = sb[c0 + j]; }
            float up[8], uc[8], un[8];
            if (first) {
#pragma unroll
                for (int j = 0; j < 8; ++j) up[j] = 0.f;
            } else ld8f(xbcb + (size_t)(r0 - 1) * 1024 + c0, up);
            ld8f(xbcb + (size_t)r0 * 1024 + c0, uc);
            for (int t = 0; t < 16; ++t) {
                const int r = r0 + t;
                if (t == 15 && last) {
#pragma unroll
                    for (int j = 0; j < 8; ++j) un[j] = 0.f;
                } else ld8f(xbcb + (size_t)(r + 1) * 1024 + c0, un);
                float o[8];
#pragma unroll
                for (int j = 0; j < 8; ++j) { const float y = ((up[j] * w0[j] + uc[j] * w1[j]) + un[j] * w2[j]) + bb[j]; o[j] = silu_f(y); up[j] = uc[j]; uc[j] = un[j]; }
                st8f(xbcc + (size_t)r * 1024 + c0, o);
            }
        }
    }
}
__device__ __forceinline__ int chain_pos(int dir, int cn) { return dir == 0 ? cn : (cn < 2 ? 1 - cn : 67 - cn); }
__device__ __forceinline__ int crow(int r, int hi) { return (r & 3) + 8 * (r >> 2) + 4 * hi; }
__device__ __forceinline__ float softplus_f(float x) { return fmaxf(x, 0.f) + __logf(1.0f + __expf(-fabsf(x))); }
constexpr int TS = 136;

template <int SVAR = 0>
__device__ __forceinline__ void ssd_local_phase(Frame& F, const Params& P, int layer) {
    unsigned char* ws = fresh_ws(P.ws);
    const bf16* xbcc = (const bf16*)(ws + WS_XBCC); const float* dtb = (const float*)(ws + WS_DT);
    float* yd = (float*)(ws + WS_YD); float* cumb = (float*)(ws + WS_CUM); float* Sb = (float*)(ws + WS_SB); float* tot = (float*)(ws + WS_TOT);
    LAS bf16* Cs = (LAS bf16*)(F.lds); LAS bf16* Bs = (LAS bf16*)(F.lds + 34816); LAS bf16* XT = (LAS bf16*)(F.lds + 69632);
    LAS bf16* Gs = (LAS bf16*)(F.lds + 87040) + F.wave * 1280;
    LAS float* fa = (LAS float*)(F.lds + 107520);
    LAS float* daA = fa, *cumA = fa + 256, *dtA = fa + 512, *scA = fa + 768;
    const int wave = F.wave;
#if S1_PF
    v4u pfc[4], pfb[4], pfx[2]; float pfraw = 0.f;
#define S1_GLOAD(uid_) do { const int t_ = fresh_tid(F.wave); const int h_ = (uid_) & 7, b_ = ((uid_) >> 3) & 1, cn_ = (uid_) >> 4, g_ = h_ >> 2; \
        const int row0_ = cn_ < 2 ? NLAT + b_ * CTXL + 128 * cn_ : b_ * SEQ + 128 * (cn_ - 2); \
        _Pragma("unroll") for (int i = 0; i < 4; ++i) { const int q = t_ + 512 * i, s_ = q >> 4, c8 = (q & 15) * 8; \
            pfc[i] = *(const v4u*)(xbcc + (size_t)(row0_ + s_) * 1024 + 768 + g_ * 128 + c8); pfb[i] = *(const v4u*)(xbcc + (size_t)(row0_ + s_) * 1024 + 512 + g_ * 128 + c8); } \
        _Pragma("unroll") for (int i = 0; i < 2; ++i) { const int q = t_ + 512 * i, s_ = q & 127, p8 = (q >> 7) * 8; pfx[i] = *(const v4u*)(xbcc + (size_t)(row0_ + s_) * 1024 + h_ * 64 + p8); } \
        if (t_ < 256) { const int dir = t_ >> 7, s_ = t_ & 127; pfraw = dtb[(size_t)(row0_ + s_) * 16 + dir * 8 + h_] + P.in[I_DTB][layer * 16 + dir * 8 + h_]; } } while (0)
    if (F.vcu < NCH * NB * 8) S1_GLOAD(F.vcu);
#endif
    for (int uid = F.vcu; uid < NCH * NB * 8; uid += F.G) {
        const int tid = fresh_tid(F.wave), lane = tid & 63, r32 = lane & 31, hi = lane >> 5;
        const int h = uid & 7, b = (uid >> 3) & 1, cn = uid >> 4, g = h >> 2;
        const int row0 = cn < 2 ? NLAT + b * CTXL + 128 * cn : b * SEQ + 128 * (cn - 2);
#if S1_PF
#pragma unroll
        for (int i = 0; i < 4; ++i) { const int q = tid + 512 * i, s = q >> 4, c8 = (q & 15) * 8; *(LAS v4u*)(Cs + s * TS + c8) = pfc[i]; *(LAS v4u*)(Bs + s * TS + c8) = pfb[i]; }
#pragma unroll
        for (int i = 0; i < 2; ++i) { const int q = tid + 512 * i, s = q & 127, p8 = (q >> 7) * 8; const v4u w = pfx[i];
            XT[(p8 + 0) * TS + s] = (bf16)(w.x & 0xffff); XT[(p8 + 1) * TS + s] = (bf16)(w.x >> 16); XT[(p8 + 2) * TS + s] = (bf16)(w.y & 0xffff); XT[(p8 + 3) * TS + s] = (bf16)(w.y >> 16);
            XT[(p8 + 4) * TS + s] = (bf16)(w.z & 0xffff); XT[(p8 + 5) * TS + s] = (bf16)(w.z >> 16); XT[(p8 + 6) * TS + s] = (bf16)(w.w & 0xffff); XT[(p8 + 7) * TS + s] = (bf16)(w.w >> 16); }
        if (tid < 256) { const int dir = tid >> 7;
            const float dt = softplus_f(pfraw); const float A = -__expf(P.in[I_ALOG][layer * 16 + dir * 8 + h]);
            dtA[tid] = dt; daA[tid] = dt * A; }
        if (uid + F.G < NCH * NB * 8) S1_GLOAD(uid + F.G);
#else
#pragma unroll
        for (int i = 0; i < 4; ++i) { const int q = tid + 512 * i, s = q >> 4, c8 = (q & 15) * 8;
            *(LAS v4u*)(Cs + s * TS + c8) = *(const v4u*)(xbcc + (size_t)(row0 + s) * 1024 + 768 + g * 128 + c8);
            *(LAS v4u*)(Bs + s * TS + c8) = *(const v4u*)(xbcc + (size_t)(row0 + s) * 1024 + 512 + g * 128 + c8); }
#pragma unroll
        for (int i = 0; i < 2; ++i) { const int q = tid + 512 * i, s = q & 127, p8 = (q >> 7) * 8;
            const v4u w = *(const v4u*)(xbcc + (size_t)(row0 + s) * 1024 + h * 64 + p8);
            XT[(p8 + 0) * TS + s] = (bf16)(w.x & 0xffff); XT[(p8 + 1) * TS + s] = (bf16)(w.x >> 16); XT[(p8 + 2) * TS + s] = (bf16)(w.y & 0xffff); XT[(p8 + 3) * TS + s] = (bf16)(w.y >> 16);
            XT[(p8 + 4) * TS + s] = (bf16)(w.z & 0xffff); XT[(p8 + 5) * TS + s] = (bf16)(w.z >> 16); XT[(p8 + 6) * TS + s] = (bf16)(w.w & 0xffff); XT[(p8 + 7) * TS + s] = (bf16)(w.w >> 16); }
        if (tid < 256) { const int dir = tid >> 7, s = tid & 127;
            const float raw = dtb[(size_t)(row0 + s) * 16 + dir * 8 + h] + P.in[I_DTB][layer * 16 + dir * 8 + h];
            const float dt = softplus_f(raw); const float A = -__expf(P.in[I_ALOG][layer * 16 + dir * 8 + h]);
            dtA[tid] = dt; daA[tid] = dt * A; }
#endif
        __syncthreads();
        float cloc = 0.f;
        if (tid < 256) { const int dir = tid >> 7, s = tid & 127, b8 = s & ~7;
#pragma unroll
            for (int k = 0; k < 8; ++k) { const float a = daA[dir * 128 + b8 + k]; if (dir == 0 ? (b8 + k <= s) : (b8 + k >= s)) cloc += a; }
            if (dir == 0 ? ((s & 7) == 7) : ((s & 7) == 0)) scA[dir * 16 + (s >> 3)] = cloc; }
        __syncthreads();
        float cum = cloc, total = 0.f;
        if (tid < 256) { const int dir = tid >> 7, s = tid & 127, bi = s >> 3;
#pragma unroll
            for (int k = 0; k < 16; ++k) { const float a = scA[dir * 16 + k]; total += a; if (dir == 0 ? (k < bi) : (k > bi)) cum += a; } }
        __syncthreads();
        if (tid < 256) { const int dir = tid >> 7, s = tid & 127;
            cumA[tid] = cum; scA[tid] = __expf(total - cum) * dtA[tid];
            cumb[(size_t)(row0 + s) * 16 + dir * 8 + h] = cum;
            if (s == 0) tot[((dir * 2 + b) * 8 + h) * NCH + chain_pos(dir, cn)] = total; }
        __syncthreads();
        if (SVAR < 1 || SVAR == 4) {
            const int rb = wave >> 1, cb = wave & 1;
            f32x16 Y = {};
            float cl0[16], cl1[16];
#pragma unroll
            for (int r = 0; r < 16; ++r) { cl0[r] = cumA[32 * rb + crow(r, hi)]; cl1[r] = cumA[128 + 32 * rb + crow(r, hi)]; }
            for (int sb = 0; sb < 4; ++sb) {
                f32x16 CB = {};
#pragma unroll
                for (int ks = 0; ks < 8; ++ks) {
                    const bf16x8 a = *(const LAS bf16x8*)(Cs + (32 * rb + r32) * TS + 16 * ks + 8 * hi);
                    const bf16x8 bb = *(const LAS bf16x8*)(Bs + (32 * sb + r32) * TS + 16 * ks + 8 * hi);
                    CB = __builtin_amdgcn_mfma_f32_32x32x16_bf16(a, bb, CB, 0, 0, 0);
                }
                const int s = 32 * sb + r32; const float cs0 = cumA[s], cs1 = cumA[128 + s], d0 = dtA[s], d1 = dtA[128 + s];
#pragma unroll
                for (int r = 0; r < 16; ++r) { const int l = 32 * rb + crow(r, hi);
                    const float f0 = (s <= l) ? __expf(cl0[r] - cs0) * d0 : 0.f, f1 = (s >= l) ? __expf(cl1[r] - cs1) * d1 : 0.f;
                    Gs[crow(r, hi) * 40 + r32] = (bf16)f2bf(CB[r] * (f0 + f1)); }
                LDS_WAIT(); asm volatile("" ::: "memory");
#pragma unroll
                for (int k2 = 0; k2 < 2; ++k2) {
                    const bf16x8 ag = *(const LAS bf16x8*)(Gs + r32 * 40 + 16 * k2 + 8 * hi);
                    const bf16x8 bx = *(const LAS bf16x8*)(XT + (32 * cb + r32) * TS + 32 * sb + 16 * k2 + 8 * hi);
                    Y = __builtin_amdgcn_mfma_f32_32x32x16_bf16(ag, bx, Y, 0, 0, 0);
                }
                LDS_WAIT(); asm volatile("" ::: "memory");
            }
#if YD16
            {
                unsigned* yd16 = (unsigned*)yd; const int odd = r32 & 1;
#pragma unroll
                for (int r = 0; r < 16; r += 2) {
                    const float a = fminf(fmaxf(Y[r], -65504.f), 65504.f), bq = fminf(fmaxf(Y[r + 1], -65504.f), 65504.f);
                    const float pa = dpp_f(a, 0), pb = dpp_f(bq, 0);
                    const _Float16 lo = (_Float16)(odd ? pb : a), hh = (_Float16)(odd ? bq : pa);
                    const unsigned w = (unsigned)__builtin_bit_cast(unsigned short, lo) | ((unsigned)__builtin_bit_cast(unsigned short, hh) << 16);
                    yd16[((size_t)(row0 + 32 * rb + crow(r + odd, hi)) * 512 + h * 64 + 32 * cb + r32 - odd) >> 1] = w; }
            }
#else
#pragma unroll
            for (int r = 0; r < 16; ++r) yd[(size_t)(row0 + 32 * rb + crow(r, hi)) * 512 + h * 64 + 32 * cb + r32] = Y[r];
#endif
        }
        __syncthreads();
        LAS bf16* BT = Cs;
        if (SVAR < 2 || SVAR == 3) {
#pragma unroll
        for (int i = 0; i < 4; ++i) { const int q = tid + 512 * i, s = q & 127, n8 = (q >> 7) * 8; const v4u w = *(const LAS v4u*)(Bs + s * TS + n8);
            BT[(n8 + 0) * TS + s] = (bf16)(w.x & 0xffff); BT[(n8 + 1) * TS + s] = (bf16)(w.x >> 16); BT[(n8 + 2) * TS + s] = (bf16)(w.y & 0xffff); BT[(n8 + 3) * TS + s] = (bf16)(w.y >> 16);
            BT[(n8 + 4) * TS + s] = (bf16)(w.z & 0xffff); BT[(n8 + 5) * TS + s] = (bf16)(w.z >> 16); BT[(n8 + 6) * TS + s] = (bf16)(w.w & 0xffff); BT[(n8 + 7) * TS + s] = (bf16)(w.w >> 16); }
        __syncthreads();
        {
            const int dir = wave & 1, nb = wave >> 1;
            f32x16 S0 = {}, S1 = {};
#pragma unroll
            for (int ks = 0; ks < 8; ++ks) {
                const int s0 = 16 * ks + 8 * hi;
                const f32x4 sc0 = *(const LAS f32x4*)(scA + dir * 128 + s0), sc1 = *(const LAS f32x4*)(scA + dir * 128 + s0 + 4);
                const bf16x8 bb = *(const LAS bf16x8*)(BT + (32 * nb + r32) * TS + s0);
#pragma unroll
                for (int pb = 0; pb < 2; ++pb) {
                    const v4u xr = *(const LAS v4u*)(XT + (32 * pb + r32) * TS + s0);
                    v4u xs; xs.x = cvtpk(bflo(xr.x) * sc0[0], bfhi(xr.x) * sc0[1]); xs.y = cvtpk(bflo(xr.y) * sc0[2], bfhi(xr.y) * sc0[3]);
                    xs.z = cvtpk(bflo(xr.z) * sc1[0], bfhi(xr.z) * sc1[1]); xs.w = cvtpk(bflo(xr.w) * sc1[2], bfhi(xr.w) * sc1[3]);
                    const bf16x8 a = __builtin_bit_cast(bf16x8, xs);
                    if (pb == 0) S0 = __builtin_amdgcn_mfma_f32_32x32x16_bf16(a, bb, S0, 0, 0, 0); else S1 = __builtin_amdgcn_mfma_f32_32x32x16_bf16(a, bb, S1, 0, 0, 0);
                }
            }
#if S1_LDSST
            __syncthreads();
            LAS float* St = (LAS float*)F.lds;
#pragma unroll
            for (int r = 0; r < 16; ++r) { St[(dir * 64 + crow(r, hi)) * 128 + 32 * nb + r32] = S0[r]; St[(dir * 64 + 32 + crow(r, hi)) * 128 + 32 * nb + r32] = S1[r]; }
            __syncthreads();
            { const int tid3 = fresh_tid(F.wave);
#pragma unroll
              for (int i = 0; i < 8; ++i) { const int q = tid3 + 512 * i, d2 = q >> 11, e4 = (q & 2047) * 4;
                  float* sp2 = Sb + ((size_t)(((d2 * 2 + b) * 8 + h) * NCH + chain_pos(d2, cn))) * 8192;
                  *(f32x4*)(sp2 + e4) = *(const LAS f32x4*)(St + d2 * 8192 + e4); } }
#elif SB16
            { unsigned* sp16 = (unsigned*)Sb + ((size_t)(((dir * 2 + b) * 8 + h) * NCH + chain_pos(dir, cn))) * 4096;
              const int odd = r32 & 1;
#pragma unroll
              for (int r = 0; r < 16; ++r) {
                  const float p0 = dpp_f(S0[r], 0), p1 = dpp_f(S1[r], 0);
                  const unsigned w = odd ? cvtpk(p1, S1[r]) : cvtpk(S0[r], p0);
                  sp16[(size_t)((odd ? 32 : 0) + crow(r, hi)) * 64 + 16 * nb + (r32 >> 1)] = w; } }
#else
            float* sp = Sb + ((size_t)(((dir * 2 + b) * 8 + h) * NCH + chain_pos(dir, cn))) * 8192;
#pragma unroll
            for (int r = 0; r < 16; ++r) { if (SVAR == 3) { asm volatile("" :: "v"(S0[r]), "v"(S1[r])); } else if (S1_NT) { __builtin_nontemporal_store(S0[r], sp + (size_t)crow(r, hi) * 128 + 32 * nb + r32); __builtin_nontemporal_store(S1[r], sp + (size_t)(32 + crow(r, hi)) * 128 + 32 * nb + r32); } else { sp[(size_t)crow(r, hi) * 128 + 32 * nb + r32] = S0[r]; sp[(size_t)(32 + crow(r, hi)) * 128 + 32 * nb + r32] = S1[r]; } }
#endif
        }
        }
        __syncthreads();
    }
}

__device__ __forceinline__ void ssd_scan_phase(Frame& F, const Params& P) {
    unsigned char* ws = fresh_ws(P.ws);
    bf16* Hp = (bf16*)(ws + WS_HP); const float* tot = (const float*)(ws + WS_TOT);
    const Lane L(F.wave);
#if SB16
    const unsigned* Sb = (const unsigned*)(ws + WS_SB);
    for (int e = F.vcu * 512 + L.tid; e < 32 * 4096; e += F.G * 512) {
        const int chain = e >> 12, idx = e & 4095;
        const unsigned* sp = Sb + (size_t)chain * NCH * 4096 + idx; unsigned* hp = (unsigned*)Hp + (size_t)chain * NCH * 4096 + idx; const float* tp = tot + chain * NCH;
        float H0 = 0.f, H1 = 0.f;
        for (int i0 = 0; i0 < NCH; i0 += S2_DEPTH) {
            unsigned sv[S2_DEPTH]; float dv[S2_DEPTH];
#pragma unroll
            for (int q = 0; q < S2_DEPTH; ++q) { sv[q] = sp[(size_t)(i0 + q) * 4096]; dv[q] = __expf(tp[i0 + q]); }
#pragma unroll
            for (int q = 0; q < S2_DEPTH; ++q) { hp[(size_t)(i0 + q) * 4096] = cvtpk(H0, H1); H0 = dv[q] * H0 + bflo(sv[q]); H1 = dv[q] * H1 + bfhi(sv[q]); }
        }
    }
#else
    const float* Sb = (const float*)(ws + WS_SB);
    for (int e = F.vcu * 512 + L.tid; e < 32 * 8192; e += F.G * 512) {
        const int chain = e >> 13, idx = e & 8191;
        const float* sp = Sb + (size_t)chain * NCH * 8192 + idx; bf16* hp = Hp + (size_t)chain * NCH * 8192 + idx; const float* tp = tot + chain * NCH;
        float H = 0.f;
        for (int i0 = 0; i0 < NCH; i0 += 6) {
            float sv[6], dv[6];
#pragma unroll
            for (int q = 0; q < 6; ++q) { sv[q] = sp[(size_t)(i0 + q) * 8192]; dv[q] = __expf(tp[i0 + q]); }
#pragma unroll
            for (int q = 0; q < 6; ++q) { hp[(size_t)(i0 + q) * 8192] = (bf16)f2bf(H); H = dv[q] * H + sv[q]; }
        }
    }
#endif
}

__device__ __forceinline__ void ssd_out_phase(Frame& F, const Params& P, int layer) {
    unsigned char* ws = fresh_ws(P.ws);
    const bf16* xbcc = (const bf16*)(ws + WS_XBCC); const bf16* zb = (const bf16*)(ws + WS_Z); const float* yd = (const float*)(ws + WS_YD); const float* cumb = (const float*)(ws + WS_CUM);
    const bf16* Hp = (const bf16*)(ws + WS_HP); bf16* cat = (bf16*)(ws + WS_CAT);
    constexpr int YS = 260;
    LAS bf16* Cs = (LAS bf16*)(F.lds); LAS float* ec = (LAS float*)(F.lds + 34816); LAS float* Yl = (LAS float*)(F.lds + 34816 + 4096);
    const int wave = F.wave;
    for (int uid = (layer == 1 ? 8 : 0) + F.vcu; uid < NCH * NB * 2; uid += F.G) {
        const int tid = fresh_tid(F.wave), lane = tid & 63, r32 = lane & 31, hi = lane >> 5;
        const int g = uid & 1, b = (uid >> 1) & 1, cn = uid >> 2;
        const int row0 = cn < 2 ? NLAT + b * CTXL + 128 * cn : b * SEQ + 128 * (cn - 2);
#pragma unroll
        for (int i = 0; i < 4; ++i) { const int q = tid + 512 * i, s = q >> 4, c8 = (q & 15) * 8;
            *(LAS v4u*)(Cs + s * TS + c8) = *(const v4u*)(xbcc + (size_t)(row0 + s) * 1024 + 768 + g * 128 + c8); }
#pragma unroll
        for (int i = 0; i < 2; ++i) { const int idx = tid + 512 * i, hd = idx >> 7, s = idx & 127; ec[idx] = __expf(cumb[(size_t)(row0 + s) * 16 + (hd & 1) * 8 + 4 * g + (hd >> 1)]); }
        __syncthreads();
        const int hh = wave >> 1, cb = wave & 1, h = 4 * g + hh;
        f32x16 ys[4] = {};
        {
            bf16x8 Hf[2][8];
#pragma unroll
            for (int dir = 0; dir < 2; ++dir) {
                const bf16* hp = Hp + ((size_t)(((dir * 2 + b) * 8 + h) * NCH + chain_pos(dir, cn))) * 8192 + (size_t)(32 * cb + r32) * 128 + 8 * hi;
#pragma unroll
                for (int ks = 0; ks < 8; ++ks) Hf[dir][ks] = *(const bf16x8*)(hp + 16 * ks);
            }
#pragma unroll
            for (int rb = 0; rb < 4; ++rb) {
                bf16x8 af[8];
#pragma unroll
                for (int ks = 0; ks < 8; ++ks) af[ks] = *(const LAS bf16x8*)(Cs + (32 * rb + r32) * TS + 16 * ks + 8 * hi);
#pragma unroll
                for (int dir = 0; dir < 2; ++dir) {
                    f32x16 a0 = {};
#pragma unroll
                    for (int ks = 0; ks < 8; ++ks) a0 = __builtin_amdgcn_mfma_f32_32x32x16_bf16(af[ks], Hf[dir][ks], a0, 0, 0, 0);
#pragma unroll
                    for (int r = 0; r < 16; ++r) ys[rb][r] += a0[r] * ec[(hh * 2 + dir) * 128 + 32 * rb + crow(r, hi)];
                }
                asm volatile("" ::: "memory");
            }
        }
        const int lane2 = fresh_tid(F.wave) & 63;
        const float dsk = P.in[I_SSDD][layer * 8 + 4 * g + (lane2 >> 4)];
        const f32x4 ng = *(const f32x4*)(P.in[I_SNORM] + layer * 512 + g * 256 + 4 * lane2);
#pragma unroll
        for (int half = 0; half < 2; ++half) {
#pragma unroll
            for (int rb2 = 0; rb2 < 2; ++rb2)
#pragma unroll
                for (int r = 0; r < 16; ++r) Yl[(32 * rb2 + crow(r, hi)) * YS + hh * 64 + 32 * cb + r32] = ys[2 * half + rb2][r];
            __syncthreads();
#pragma unroll 2
            for (int q = 0; q < 8; ++q) {
                const int rl = 8 * wave + q, row = row0 + 64 * half + rl;
                const f32x4 yo = *(const LAS f32x4*)(Yl + rl * YS + 4 * lane2);
#if YD16
                f32x4 ydv; { const v2u yw = *(const v2u*)((const unsigned short*)yd + (size_t)row * 512 + g * 256 + 4 * lane2);
                  ydv[0] = (float)__builtin_bit_cast(_Float16, (unsigned short)(yw.x & 0xffff)); ydv[1] = (float)__builtin_bit_cast(_Float16, (unsigned short)(yw.x >> 16));
                  ydv[2] = (float)__builtin_bit_cast(_Float16, (unsigned short)(yw.y & 0xffff)); ydv[3] = (float)__builtin_bit_cast(_Float16, (unsigned short)(yw.y >> 16)); }
#else
                const f32x4 ydv = *(const f32x4*)(yd + (size_t)row * 512 + g * 256 + 4 * lane2);
#endif
                const v2u xv = *(const v2u*)(xbcc + (size_t)row * 1024 + g * 256 + 4 * lane2), zv = *(const v2u*)(zb + (size_t)row * 512 + g * 256 + 4 * lane2);
                f32x4 u;
                u[0] = (yo[0] + ydv[0] + dsk * bflo(xv.x)) * silu_f(bflo(zv.x)); u[1] = (yo[1] + ydv[1] + dsk * bfhi(xv.x)) * silu_f(bfhi(zv.x));
                u[2] = (yo[2] + ydv[2] + dsk * bflo(xv.y)) * silu_f(bflo(zv.y)); u[3] = (yo[3] + ydv[3] + dsk * bfhi(xv.y)) * silu_f(bfhi(zv.y));
                const float ss = wave_sum((u[0] * u[0] + u[1] * u[1]) + (u[2] * u[2] + u[3] * u[3]));
                const float rstd = 1.0f / sqrtf(ss * (1.0f / 256.0f) + NORM_EPS);
                v2u o; o.x = cvtpk(u[0] * rstd * ng[0], u[1] * rstd * ng[1]); o.y = cvtpk(u[2] * rstd * ng[2], u[3] * rstd * ng[3]);
                *(v2u*)(cat + (size_t)row * D + 512 + g * 256 + 4 * lane2) = o;
            }
            __syncthreads();
        }
    }
}
namespace att {
constexpr int KVBLK = 64, LDQ = 1024, LDK = 1024;
constexpr float SCALE = 0.125f;
constexpr float THR = 8.f;
constexpr size_t SHM_V = KVBLK * 128 * 2, SHM_K = KVBLK * 128 * 2;
#define KSWZ(row, colB) ((row) * 256 + ((colB) ^ (((row) & 7) << 4)))
#define SBAR() __builtin_amdgcn_sched_barrier(0)
constexpr float THRL = 11.5f;
#if ATT_FP8
constexpr float WLO = 0.5f, WHI = 7.5f, WMID = 4.0f;
#else
constexpr float WLO = -THRL, WHI = THRL, WMID = 0.f;
#endif
typedef int v8i __attribute__((ext_vector_type(8)));
__device__ __forceinline__ float max3f(float a, float b, float c) { return __builtin_fmaxf(__builtin_fmaxf(a, b), c); }
#if ATT_NEGM
typedef f32x16 mref_t;
#define MREF_INIT f32x16{}
__device__ __forceinline__ f32x16 mref_acc(const mref_t& m) { return m; }
#else
typedef float mref_t;
#define MREF_INIT 0.f
__device__ __forceinline__ f32x16 mref_acc(const mref_t&) { return f32x16{}; }
#endif
template <bool DOEXP = true>
__device__ __forceinline__ void partialSM(f32x16& p0, f32x16& p1, mref_t& mref, float& alpha) {
  float pmax = max3f(p0[0], p0[1], p0[2]);
#pragma unroll
  for (int r = 3; r < 15; r += 2) pmax = max3f(pmax, p0[r], p0[r + 1]);
  pmax = max3f(pmax, p0[15], p1[0]);
#pragma unroll
  for (int r = 1; r < 15; r += 2) pmax = max3f(pmax, p1[r], p1[r + 1]);
  pmax = fmaxf(pmax, p1[15]);
  pmax = cross_max(pmax);
#if ATT_NEGM
  if (__builtin_expect(__all(pmax >= WLO && pmax <= WHI), 1)) { alpha = 1.f; }
  else {
    const float d = (pmax < WLO || pmax > WHI) ? pmax - WMID : 0.f;
    alpha = __builtin_amdgcn_exp2f(-d);
#pragma unroll
    for (int r = 0; r < 16; ++r) { p0[r] -= d; p1[r] -= d; mref[r] -= d; }
  }
#else
  if (__builtin_expect(__all(fabsf(pmax - mref) <= THRL), 1)) { alpha = 1.f; }
  else { const float d = fabsf(pmax - mref) > THRL ? pmax - mref : 0.f; alpha = __builtin_amdgcn_exp2f(-d); mref += d; }
#pragma unroll
  for (int r = 0; r < 16; ++r) { p0[r] -= mref; p1[r] -= mref; }
#endif
  if constexpr (DOEXP) {
#pragma unroll
  for (int r = 0; r < 16; ++r) p0[r] = __builtin_amdgcn_exp2f(p0[r]);
  }
}
__device__ __forceinline__ void finishSM(f32x16& p0, f32x16& p1, float alpha, float& l_reg, bf16x8& pa0, bf16x8& pa1, bf16x8& pa2, bf16x8& pa3) {
#pragma unroll
  for (int r = 0; r < 16; ++r) p1[r] = __builtin_amdgcn_exp2f(p1[r]);
#if !ATT_LMFMA
  float ps = 0;
#pragma unroll
  for (int r = 0; r < 16; ++r) ps += p0[r];
#pragma unroll
  for (int r = 0; r < 16; ++r) ps += p1[r];
  ps = cross_sum(ps);
  l_reg = l_reg * alpha + ps;
#else
  (void)alpha; (void)l_reg;
#endif
#define PK4(P, BASE, OUT) do { unsigned a0 = cvtpk(P[BASE + 0], P[BASE + 1]), a1 = cvtpk(P[BASE + 2], P[BASE + 3]);   \
    unsigned b0 = cvtpk(P[BASE + 4], P[BASE + 5]), b1 = cvtpk(P[BASE + 6], P[BASE + 7]);                              \
    if (!ATT_NOSWAP) { swap32u(a0, b0); swap32u(a1, b1); } \
    v4u w = {a0, a1, b0, b1}; OUT = __builtin_bit_cast(bf16x8, w); } while (0)
  PK4(p0, 0, pa0); PK4(p0, 8, pa1); PK4(p1, 0, pa2); PK4(p1, 8, pa3);
#undef PK4
}

#if ATT_FP8
__device__ __forceinline__ void finishSM8(f32x16& p0, f32x16& p1, float alpha, float& l_reg, v8i& P8) {
#pragma unroll
  for (int r = 0; r < 16; ++r) p1[r] = __builtin_amdgcn_exp2f(p1[r]);
  float ps = 0;
#pragma unroll
  for (int r = 0; r < 16; ++r) ps += p0[r];
#pragma unroll
  for (int r = 0; r < 16; ++r) ps += p1[r];
  ps = cross_sum(ps);
  l_reg = l_reg * alpha + ps;
#pragma unroll
  for (int w = 0; w < 4; ++w) {
    P8[w]     = __builtin_amdgcn_cvt_pk_fp8_f32(p0[4 * w + 2], p0[4 * w + 3], __builtin_amdgcn_cvt_pk_fp8_f32(p0[4 * w], p0[4 * w + 1], 0, false), true);
    P8[4 + w] = __builtin_amdgcn_cvt_pk_fp8_f32(p1[4 * w + 2], p1[4 * w + 3], __builtin_amdgcn_cvt_pk_fp8_f32(p1[4 * w], p1[4 * w + 1], 0, false), true);
  }
}
__device__ __forceinline__ void pv8(f32x16* o, const LAS char* vb, const v8i& P8) {
  v4u lo[4], hh[4];
#pragma unroll
  for (int d0 = 0; d0 < 4; ++d0) { lo[d0] = *(const LAS v4u*)(vb + d0 * 2048); hh[d0] = *(const LAS v4u*)(vb + d0 * 2048 + 512); }
#pragma unroll
  for (int d0 = 0; d0 < 4; ++d0) {
    v8i B; B[0] = (int)lo[d0].x; B[1] = (int)lo[d0].y; B[2] = (int)lo[d0].z; B[3] = (int)lo[d0].w; B[4] = (int)hh[d0].x; B[5] = (int)hh[d0].y; B[6] = (int)hh[d0].z; B[7] = (int)hh[d0].w;
    o[d0] = __builtin_amdgcn_mfma_scale_f32_32x32x64_f8f6f4(P8, B, o[d0], 0, 0, 0, 0x7F7F7F7F, 0, 0x7F7F7F7F);
  }
}
__device__ __forceinline__ void pv8_exp(f32x16* o, const LAS char* vb, const v8i& P8, f32x16& pn) {
  v4u lo[4], hh[4];
#pragma unroll
  for (int d0 = 0; d0 < 4; ++d0) { lo[d0] = *(const LAS v4u*)(vb + d0 * 2048); hh[d0] = *(const LAS v4u*)(vb + d0 * 2048 + 512); }
  asm volatile("s_waitcnt lgkmcnt(0)" ::: "memory"); SBAR();
#pragma unroll
  for (int d0 = 0; d0 < 4; ++d0) {
    v8i B; B[0] = (int)lo[d0].x; B[1] = (int)lo[d0].y; B[2] = (int)lo[d0].z; B[3] = (int)lo[d0].w; B[4] = (int)hh[d0].x; B[5] = (int)hh[d0].y; B[6] = (int)hh[d0].z; B[7] = (int)hh[d0].w;
    o[d0] = __builtin_amdgcn_mfma_scale_f32_32x32x64_f8f6f4(P8, B, o[d0], 0, 0, 0, 0x7F7F7F7F, 0, 0x7F7F7F7F);
#pragma unroll
    for (int r = 0; r < 4; ++r) pn[4 * d0 + r] = __builtin_amdgcn_exp2f(pn[4 * d0 + r]);
  }
  asm volatile("" :: "v"(pn[0]), "v"(pn[1]), "v"(pn[2]), "v"(pn[3]), "v"(pn[4]), "v"(pn[5]), "v"(pn[6]), "v"(pn[7]), "v"(pn[8]), "v"(pn[9]), "v"(pn[10]), "v"(pn[11]), "v"(pn[12]), "v"(pn[13]), "v"(pn[14]), "v"(pn[15]));
#pragma unroll
  for (int d0 = 0; d0 < 4; ++d0) { __builtin_amdgcn_sched_group_barrier(0x008, 1, 0); __builtin_amdgcn_sched_group_barrier(PVX_MASK, 4, 0); }
  SBAR();
}

constexpr float YB = 56.0f + Y8_C, YLO = 8.0f * WLO + YB, YHI = 8.0f * WHI + YB, YMID = 8.0f * WMID + YB;
__device__ __forceinline__ void partialSMY(f32x16& p0, f32x16& p1, mref_t& mref, float& alpha) {
  float pmax = max3f(p0[0], p0[1], p0[2]);
#pragma unroll
  for (int r = 3; r < 15; r += 2) pmax = max3f(pmax, p0[r], p0[r + 1]);
  pmax = max3f(pmax, p0[15], p1[0]);
#pragma unroll
  for (int r = 1; r < 15; r += 2) pmax = max3f(pmax, p1[r], p1[r + 1]);
  pmax = fmaxf(pmax, p1[15]);
  pmax = cross_max(pmax);
  if (__builtin_expect(__all(pmax >= YLO && pmax <= YHI), 1)) { alpha = 1.f; }
  else {
    const float d = (pmax < YLO || pmax > YHI) ? 8.0f * __builtin_rintf((pmax - YMID) * 0.125f) : 0.f;
    alpha = __builtin_amdgcn_exp2f(-0.125f * d);
#pragma unroll
    for (int r = 0; r < 16; ++r) { p0[r] -= d; p1[r] -= d; mref[r] -= d; }
  }
}
__device__ __forceinline__ void finishSMY(const f32x16& p0, const f32x16& p1, v8i& P8) {
#pragma unroll
  for (int w = 0; w < 4; ++w) {
    unsigned a = 0u, b = 0u;
#pragma unroll
    for (int i = 0; i < 4; ++i) { a = __builtin_amdgcn_cvt_pk_u8_f32(p0[4 * w + i], (unsigned)i, a); b = __builtin_amdgcn_cvt_pk_u8_f32(p1[4 * w + i], (unsigned)i, b); }
    P8[w] = (int)a; P8[4 + w] = (int)b;
  }
}
__device__ __forceinline__ void pv8s(f32x16* o, f32x16& lacc, const LAS char* vb, const v8i& P8) {
  v4u lo[4], hh[4];
#pragma unroll
  for (int d0 = 0; d0 < 4; ++d0) { lo[d0] = *(const LAS v4u*)(vb + d0 * 2048); hh[d0] = *(const LAS v4u*)(vb + d0 * 2048 + 512); }
  if (ATT_PRIO) __builtin_amdgcn_s_setprio(1);
  { const v8i ones = {0x38383838, 0x38383838, 0x38383838, 0x38383838, 0x38383838, 0x38383838, 0x38383838, 0x38383838};
    lacc = __builtin_amdgcn_mfma_scale_f32_32x32x64_f8f6f4(P8, ones, lacc, 0, 0, 0, 0x7F7F7F7F, 0, 0x7F7F7F7F); }
#pragma unroll
  for (int d0 = 0; d0 < 4; ++d0) {
    v8i B; B[0] = (int)lo[d0].x; B[1] = (int)lo[d0].y; B[2] = (int)lo[d0].z; B[3] = (int)lo[d0].w; B[4] = (int)hh[d0].x; B[5] = (int)hh[d0].y; B[6] = (int)hh[d0].z; B[7] = (int)hh[d0].w;
    o[d0] = __builtin_amdgcn_mfma_scale_f32_32x32x64_f8f6f4(P8, B, o[d0], 0, 0, 0, 0x7F7F7F7F, 0, 0x7F7F7F7F);
  }
  if (ATT_PRIO) __builtin_amdgcn_s_setprio(0);
}
#endif
__device__ __forceinline__ void qkt(f32x16& p0, f32x16& p1, const LAS char* Ks, const bf16x8* qr, int r32, int hi, int map, const mref_t& negm) {
  p0 = mref_acc(negm); p1 = p0;
#pragma unroll
  for (int d0 = 0; d0 < 4; ++d0) { int cb = (map * 64 + d0 * 16 + hi * 8) * 2;
    bf16x8 b0 = *(const LAS bf16x8*)(Ks + KSWZ(r32, cb));
    bf16x8 b1 = *(const LAS bf16x8*)(Ks + KSWZ(32 + r32, cb));
    p0 = __builtin_amdgcn_mfma_f32_32x32x16_bf16(b0, qr[d0], p0, 0, 0, 0);
    p1 = __builtin_amdgcn_mfma_f32_32x32x16_bf16(b1, qr[d0], p1, 0, 0, 0); }
}
#if ATT_NOSWAP
__device__ __forceinline__ int v_st(int k, int c) { return ((k >> 3) * 4 + (c >> 5)) * 512 + ((k & 7) * 32 + (c & 31)) * 2; }
#else
__device__ __forceinline__ int v_st(int k, int c) { const int kk = (k & ~0xC) | ((k & 4) << 1) | ((k & 8) >> 1); return ((kk >> 3) * 4 + (c >> 5)) * 512 + ((kk & 7) * 32 + (c & 31)) * 2; }
#endif
__device__ __forceinline__ int v_rd_base(int lane) { return ((lane & 3) << 3) | (((lane >> 2) & 3) << 6) | (((lane >> 4) & 1) << 5) | (((lane >> 5) & 1) << 8); }
constexpr int v_rd_off(int d0, int ks, int half) { return d0 * 512 + ks * 4096 + half * 2048; }
template <int OFF> __device__ __forceinline__ s16x4 tr_read(int vb) {
  s16x4 r; asm volatile("ds_read_b64_tr_b16 %0, %1 offset:%2" : "=&v"(r) : "v"(vb), "i"(OFF) : "memory"); return r;
}
struct VG { s16x4 l0, h0, l1, h1, l2, h2, l3, h3; };
template <int D0> __device__ __forceinline__ void pv_load(VG& g, int vb) {
  g.l0 = tr_read<v_rd_off(D0, 0, 0)>(vb); g.h0 = tr_read<v_rd_off(D0, 0, 1)>(vb); g.l1 = tr_read<v_rd_off(D0, 1, 0)>(vb); g.h1 = tr_read<v_rd_off(D0, 1, 1)>(vb);
  g.l2 = tr_read<v_rd_off(D0, 2, 0)>(vb); g.h2 = tr_read<v_rd_off(D0, 2, 1)>(vb); g.l3 = tr_read<v_rd_off(D0, 3, 0)>(vb); g.h3 = tr_read<v_rd_off(D0, 3, 1)>(vb);
}
__device__ __forceinline__ void pv_mma(f32x16& od, const VG& g, bf16x8 pa0, bf16x8 pa1, bf16x8 pa2, bf16x8 pa3) {
#define PK(L, H) (bf16x8){L[0], L[1], L[2], L[3], H[0], H[1], H[2], H[3]}
  od = __builtin_amdgcn_mfma_f32_32x32x16_bf16(pa0, PK(g.l0, g.h0), od, 0, 0, 0);
  od = __builtin_amdgcn_mfma_f32_32x32x16_bf16(pa1, PK(g.l1, g.h1), od, 0, 0, 0);
  od = __builtin_amdgcn_mfma_f32_32x32x16_bf16(pa2, PK(g.l2, g.h2), od, 0, 0, 0);
  od = __builtin_amdgcn_mfma_f32_32x32x16_bf16(pa3, PK(g.l3, g.h3), od, 0, 0, 0);
#undef PK
}
__device__ __forceinline__ void pv_d0(f32x16* o, int vb, bf16x8 pa0, bf16x8 pa1, bf16x8 pa2, bf16x8 pa3, f32x16& lacc) {
#if ATT_LMFMA
  { const bf16x8 ones = {0x3F80, 0x3F80, 0x3F80, 0x3F80, 0x3F80, 0x3F80, 0x3F80, 0x3F80};
    lacc = __builtin_amdgcn_mfma_f32_32x32x16_bf16(pa0, ones, lacc, 0, 0, 0); lacc = __builtin_amdgcn_mfma_f32_32x32x16_bf16(pa1, ones, lacc, 0, 0, 0);
    lacc = __builtin_amdgcn_mfma_f32_32x32x16_bf16(pa2, ones, lacc, 0, 0, 0); lacc = __builtin_amdgcn_mfma_f32_32x32x16_bf16(pa3, ones, lacc, 0, 0, 0); }
#endif
#if ATT_PVPF
  VG ga, gb;
  pv_load<0>(ga, vb); pv_load<1>(gb, vb);
  asm volatile("s_waitcnt lgkmcnt(8)" ::: "memory"); SBAR(); pv_mma(o[0], ga, pa0, pa1, pa2, pa3);
  pv_load<2>(ga, vb);
  asm volatile("s_waitcnt lgkmcnt(8)" ::: "memory"); SBAR(); pv_mma(o[1], gb, pa0, pa1, pa2, pa3);
  pv_load<3>(gb, vb);
  asm volatile("s_waitcnt lgkmcnt(8)" ::: "memory"); SBAR(); pv_mma(o[2], ga, pa0, pa1, pa2, pa3);
  asm volatile("s_waitcnt lgkmcnt(0)" ::: "memory"); SBAR(); pv_mma(o[3], gb, pa0, pa1, pa2, pa3);
#else
  VG g;
  pv_load<0>(g, vb); asm volatile("s_waitcnt lgkmcnt(0)" ::: "memory"); SBAR(); pv_mma(o[0], g, pa0, pa1, pa2, pa3);
  pv_load<1>(g, vb); asm volatile("s_waitcnt lgkmcnt(0)" ::: "memory"); SBAR(); pv_mma(o[1], g, pa0, pa1, pa2, pa3);
  pv_load<2>(g, vb); asm volatile("s_waitcnt lgkmcnt(0)" ::: "memory"); SBAR(); pv_mma(o[2], g, pa0, pa1, pa2, pa3);
  pv_load<3>(g, vb); asm volatile("s_waitcnt lgkmcnt(0)" ::: "memory"); SBAR(); pv_mma(o[3], g, pa0, pa1, pa2, pa3);
#endif
}
template <int VAR>
__device__ __forceinline__ void diff_attn_unit(const bf16* __restrict__ Qb, const bf16* __restrict__ Kh, const bf16* __restrict__ Vh, bf16* __restrict__ Ob, int seq, LAS char* lds,
                                               float lam, const float* gsub, float oscale, const int wave, const unsigned char* V8h, const unsigned char* q8base = nullptr) {
  const int tid = fresh_tid(wave), wid = tid >> 6, lane = tid & 63, r32 = lane & 31, hi = lane >> 5, map = wid >> 2, wq = wid & 3;
  constexpr int BUFB = (int)(SHM_V + SHM_K), WSF_OFF = RING_BYTES + 1024;
  LAS float* wsf = (LAS float*)(lds + WSF_OFF) + wid * 64; LAS float* li_l = wsf; LAS float* al_l = wsf + 32;
  float l_reg = 0; f32x16 o[4], lacc; mref_t negm = MREF_INIT; bf16x8 qr[4];
  { float zf_ = 0.f; asm volatile("" : "+v"(zf_));
#pragma unroll
    for (int r = 0; r < 16; ++r) { lacc[r] = zf_; o[0][r] = zf_; o[1][r] = zf_; o[2][r] = zf_; o[3][r] = zf_; } }
  const bf16* Qw = Qb + (long)(wq * 32 + r32) * LDQ + map * 64 + hi * 8;
#pragma unroll
  for (int d0 = 0; d0 < 4; ++d0) { const v4u w = *reinterpret_cast<const v4u*>(Qw + d0 * 16); constexpr float C = SCALE * 1.4426950408889634f;
    v4u q; q.x = cvtpk(bflo(w.x) * C, bfhi(w.x) * C); q.y = cvtpk(bflo(w.y) * C, bfhi(w.y) * C); q.z = cvtpk(bflo(w.z) * C, bfhi(w.z) * C); q.w = cvtpk(bflo(w.w) * C, bfhi(w.w) * C);
    qr[d0] = __builtin_bit_cast(bf16x8, q); }
#if ATT_DMA && ATT_FP8 && ATT_QK8
  constexpr int TB = 16384, LEAD = ATT_LEAD, NBUF = LEAD > 2 ? 8 : 4;
  const unsigned pcoff = (unsigned)(wid * 1024 + lane * 16);
  const LAS char* vrd = lds + hi * 1024 + r32 * 16;
  const LAS char* krd = lds + 8192 + (map * 2 + hi) * 2048 + r32 * 16;
  v8i P8, Q8;
#if Q8_DIRECT
  {
    const unsigned char* q8b = (const unsigned char*)q8base; const long off_ = (const unsigned char*)Qb - q8b; const int row_ = (int)(off_ >> 10) + wq * 32 + r32, hcol_ = (int)(off_ & 1023) + map * 64 + hi * 32;
    const unsigned char* q8 = q8b + (size_t)(row_ >> 4) * 16384 + (size_t)(hcol_ >> 3) * 128 + (row_ & 15) * 8;
    const v2u a_ = *(const v2u*)q8, b_ = *(const v2u*)(q8 + 128), c_ = *(const v2u*)(q8 + 256), d_ = *(const v2u*)(q8 + 384);
    Q8 = (v8i){(int)a_.x, (int)a_.y, (int)b_.x, (int)b_.y, (int)c_.x, (int)c_.y, (int)d_.x, (int)d_.y}; }
#else
  { constexpr float C = SCALE * 1.4426950408889634f * (ATT_Y8 ? 8.0f : 1.0f); const bf16* qp = Qb + (long)(wq * 32 + r32) * LDQ + map * 64 + hi * 32;
#pragma unroll
    for (int w4 = 0; w4 < 4; ++w4) { float a[8]; ld8f(qp + 8 * w4, a);
      Q8[2 * w4]     = __builtin_amdgcn_cvt_pk_fp8_f32(a[2] * C, a[3] * C, __builtin_amdgcn_cvt_pk_fp8_f32(a[0] * C, a[1] * C, 0, false), true);
      Q8[2 * w4 + 1] = __builtin_amdgcn_cvt_pk_fp8_f32(a[6] * C, a[7] * C, __builtin_amdgcn_cvt_pk_fp8_f32(a[4] * C, a[5] * C, 0, false), true); } }
#endif
  const unsigned char* K8h = V8h + (WS_K8 - WS_V8);
#define DMA(t_) do { const int bo_ = ((t_) & (NBUF - 1)) * TB; \
    __builtin_amdgcn_global_load_lds((const unsigned*)(V8h + (size_t)(t_) * 65536 + pcoff), (LAS unsigned*)(lds + bo_ + wid * 1024), 16, 0, 0); \
    __builtin_amdgcn_global_load_lds((const unsigned*)(K8h + (size_t)(t_) * 65536 + pcoff), (LAS unsigned*)(lds + bo_ + 8192 + wid * 1024), 16, 0, 0); } while (0)
#define RESC(a) do { if (__any((a) != 1.f)) { if (hi == 0) al_l[r32] = (a); asm volatile("s_waitcnt lgkmcnt(0)" ::: "memory"); \
    _Pragma("unroll") for (int r = 0; r < 16; ++r) { const float a_ = al_l[crow(r, hi)]; lacc[r] *= a_; _Pragma("unroll") for (int d = 0; d < 4; ++d) o[d][r] *= a_; } } } while (0)
#define TBAR() do { asm volatile("s_waitcnt lgkmcnt(0)" ::: "memory"); __builtin_amdgcn_s_barrier(); asm volatile("" ::: "memory"); } while (0)
#if ATT_KPF || ATT_P2
  v8i kfa, kfb;
#define KLOAD(t_) do { const LAS char* kb_ = krd + ((t_) & (NBUF - 1)) * TB; \
    const v4u k0l = *(const LAS v4u*)(kb_), k0h = *(const LAS v4u*)(kb_ + 1024), k1l = *(const LAS v4u*)(kb_ + 512), k1h = *(const LAS v4u*)(kb_ + 1536); \
    kfa = (v8i){(int)k0l.x, (int)k0l.y, (int)k0l.z, (int)k0l.w, (int)k0h.x, (int)k0h.y, (int)k0h.z, (int)k0h.w}; kfb = (v8i){(int)k1l.x, (int)k1l.y, (int)k1l.z, (int)k1l.w, (int)k1h.x, (int)k1h.y, (int)k1h.z, (int)k1h.w}; } while (0)
#define QK8(P0, P1, t_) do { \
    P0 = __builtin_amdgcn_mfma_scale_f32_32x32x64_f8f6f4(kfa, Q8, mref_acc(negm), 0, 0, 0, 0x7F7F7F7F, 0, 0x7F7F7F7F); \
    P1 = __builtin_amdgcn_mfma_scale_f32_32x32x64_f8f6f4(kfb, Q8, mref_acc(negm), 0, 0, 0, 0x7F7F7F7F, 0, 0x7F7F7F7F); \
    SBAR(); if ((t_) + 1 < NT) KLOAD((t_) + 1); } while (0)
#else
#define KLOAD(t_) do {} while (0)
#define QK8(P0, P1, t_) do { const LAS char* kb_ = krd + ((t_) & (NBUF - 1)) * TB; \
    const v4u k0l = *(const LAS v4u*)(kb_), k0h = *(const LAS v4u*)(kb_ + 1024), k1l = *(const LAS v4u*)(kb_ + 512), k1h = *(const LAS v4u*)(kb_ + 1536); \
    v8i ka_ = {(int)k0l.x, (int)k0l.y, (int)k0l.z, (int)k0l.w, (int)k0h.x, (int)k0h.y, (int)k0h.z, (int)k0h.w}, kb2_ = {(int)k1l.x, (int)k1l.y, (int)k1l.z, (int)k1l.w, (int)k1h.x, (int)k1h.y, (int)k1h.z, (int)k1h.w}; \
    P0 = __builtin_amdgcn_mfma_scale_f32_32x32x64_f8f6f4(ka_, Q8, mref_acc(negm), 0, 0, 0, 0x7F7F7F7F, 0, 0x7F7F7F7F); \
    P1 = __builtin_amdgcn_mfma_scale_f32_32x32x64_f8f6f4(kb2_, Q8, mref_acc(negm), 0, 0, 0, 0x7F7F7F7F, 0, 0x7F7F7F7F); } while (0)
#endif
  f32x16 pA0, pA1, pB0, pB1; float alA, alB; const int NT = seq / KVBLK;
  (void)qr; (void)Qw;
#if ATT_Y8
  { float yb_ = YB; asm volatile("" : "+v"(yb_));
#pragma unroll
    for (int r = 0; r < 16; ++r) negm[r] = yb_; }
#define PSM(P0, P1, AL) partialSMY(P0, P1, negm, AL)
#else
#define PSM(P0, P1, AL) partialSM(P0, P1, negm, AL)
#endif
#define VMW(n) asm volatile("s_waitcnt vmcnt(%0)" :: "n"(n) : "memory")
#if ATT_Y8 && ATT_P2
  static_assert(LEAD == 5 && NBUF == 8, "pipeline v2");
  v8i vf[4]; float al2;
#define VLOAD(t_) do { const LAS char* vb_ = vrd + ((t_) & (NBUF - 1)) * TB; _Pragma("unroll") for (int d0 = 0; d0 < 4; ++d0) { const v4u l_ = *(const LAS v4u*)(vb_ + d0 * 2048), h_ = *(const LAS v4u*)(vb_ + d0 * 2048 + 512); \
    vf[d0] = (v8i){(int)l_.x, (int)l_.y, (int)l_.z, (int)l_.w, (int)h_.x, (int)h_.y, (int)h_.z, (int)h_.w}; } } while (0)
#define QKM() do { pA0 = __builtin_amdgcn_mfma_scale_f32_32x32x64_f8f6f4(kfa, Q8, mref_acc(negm), 0, 0, 0, 0x7F7F7F7F, 0, 0x7F7F7F7F); \
    pA1 = __builtin_amdgcn_mfma_scale_f32_32x32x64_f8f6f4(kfb, Q8, mref_acc(negm), 0, 0, 0, 0x7F7F7F7F, 0, 0x7F7F7F7F); } while (0)
#define PVM() do { { int on_ = 0x38383838; asm volatile("" : "+v"(on_)); const v8i ones_ = {on_, on_, on_, on_, on_, on_, on_, on_}; \
      lacc = __builtin_amdgcn_mfma_scale_f32_32x32x64_f8f6f4(P8, ones_, lacc, 0, 0, 0, 0x7F7F7F7F, 0, 0x7F7F7F7F); } \
    _Pragma("unroll") for (int d0 = 0; d0 < 4; ++d0) o[d0] = __builtin_amdgcn_mfma_scale_f32_32x32x64_f8f6f4(P8, vf[d0], o[d0], 0, 0, 0, 0x7F7F7F7F, 0, 0x7F7F7F7F); } while (0)
#define STEP(j) do { SBAR(); if (!P2_KPF) KLOAD(j); if (!P2_VPF) VLOAD((j) - 1); asm volatile("s_waitcnt lgkmcnt(0)" ::: "memory"); QKM(); PVM(); SBAR(); \
    if (P2_KPF) { if ((j) + 1 < NT) KLOAD((j) + 1); } if (P2_VPF) VLOAD(j); SBAR(); \
    partialSMY(pA0, pA1, negm, al2); RESC(al2); finishSMY(pA0, pA1, P8); } while (0)
#pragma unroll
  for (int t = 0; t <= LEAD; ++t) if (t < NT) DMA(t);
  if (LEAD < NT) VMW(2 * (LEAD - 1)); else VMW(0);
  TBAR();
#if P2_AB
  auto run_ = [&](auto G_) __attribute__((always_inline)) { constexpr int GRP = decltype(G_)::value;
  KLOAD(0); asm volatile("s_waitcnt lgkmcnt(0)" ::: "memory"); QKM(); SBAR();
  if constexpr (GRP == 0) { partialSMY(pA0, pA1, negm, al2); finishSMY(pA0, pA1, P8); }
  if (LEAD < NT) VMW(2 * (LEAD - 3)); else VMW(0);
  TBAR();
#define STEPB(j) do { SBAR(); partialSMY(pA0, pA1, negm, al2); RESC(al2); finishSMY(pA0, pA1, P8); SBAR(); \
    KLOAD(j); asm volatile("s_waitcnt lgkmcnt(0)" ::: "memory"); QKM(); SBAR(); VLOAD((j) - 1); asm volatile("s_waitcnt lgkmcnt(0)" ::: "memory"); PVM(); SBAR(); } while (0)
  if constexpr (GRP == 0) {
    for (int j = 1; j + 1 < NT; j += 2) {
      if (j + LEAD < NT) DMA(j + LEAD); if (j + LEAD + 1 < NT) DMA(j + LEAD + 1);
      STEP(j); STEP(j + 1);
      if (j + LEAD + 1 < NT) VMW(2 * (LEAD - 3)); else VMW(0); TBAR();
    }
    STEP(NT - 1);
  } else {
    for (int j = 1; j + 1 < NT; j += 2) {
      if (j + LEAD < NT) DMA(j + LEAD); if (j + LEAD + 1 < NT) DMA(j + LEAD + 1);
      STEPB(j); STEPB(j + 1);
      if (j + LEAD + 1 < NT) VMW(2 * (LEAD - 3)); else VMW(0); TBAR();
    }
    STEPB(NT - 1);
    partialSMY(pA0, pA1, negm, al2); RESC(al2); finishSMY(pA0, pA1, P8);
  }
  VLOAD(NT - 1);
  asm volatile("s_waitcnt lgkmcnt(0)" ::: "memory"); PVM();
#undef STEPB
#else
  KLOAD(0); asm volatile("s_waitcnt lgkmcnt(0)" ::: "memory"); QKM(); SBAR(); if (P2_KPF) KLOAD(1); if (P2_VPF) VLOAD(0); SBAR();
  partialSMY(pA0, pA1, negm, al2); finishSMY(pA0, pA1, P8);
  if (LEAD < NT) VMW(2 * (LEAD - 3)); else VMW(0);
  TBAR();
  for (int j = 1; j + 1 < NT; j += 2) {
    if (j + LEAD < NT) DMA(j + LEAD); if (j + LEAD + 1 < NT) DMA(j + LEAD + 1);
    STEP(j);
    STEP(j + 1);
    if (j + LEAD + 1 < NT) VMW(2 * (LEAD - 3)); else VMW(0); TBAR();
  }
  STEP(NT - 1);
  if (!P2_VPF) VLOAD(NT - 1);
  asm volatile("s_waitcnt lgkmcnt(0)" ::: "memory"); PVM();
#endif
  (void)pB0; (void)pB1; (void)alA; (void)alB;
#undef STEP
#undef PVM
#undef QKM
#undef VLOAD
#elif ATT_Y8 && ATT_AB
  static_assert(LEAD == 5 && NBUF == 8, "anti-phase schedule");
#pragma unroll
  for (int t = 0; t <= LEAD; ++t) if (t < NT) DMA(t);
  if (LEAD < NT) VMW(2 * LEAD); else VMW(0);
  TBAR();
  QK8(pA0, pA1, 0); PSM(pA0, pA1, alA);
  if (LEAD < NT) VMW(2 * (LEAD - 3)); else VMW(0);
  TBAR();
#define XCV(PO0, PO1, j) do { finishSMY(PO0, PO1, P8); SBAR(); pv8s(o, lacc, vrd + (((j) - 1) & (NBUF - 1)) * TB, P8); } while (0)
  if (map == 0) {
#define ITERA(j, PN0, PN1, ALN, PO0, PO1) do { SBAR(); QK8(PN0, PN1, j); XCV(PO0, PO1, j); partialSMY(PN0, PN1, negm, ALN); RESC(ALN); } while (0)
    for (int j = 1; j + 1 < NT; j += 2) {
      if (j + LEAD < NT) DMA(j + LEAD); if (j + LEAD + 1 < NT) DMA(j + LEAD + 1);
      ITERA(j, pB0, pB1, alB, pA0, pA1);
      ITERA(j + 1, pA0, pA1, alA, pB0, pB1);
      if (j + LEAD + 1 < NT) VMW(2 * (LEAD - 3)); else VMW(0); TBAR();
    }
    ITERA(NT - 1, pB0, pB1, alB, pA0, pA1);
#undef ITERA
  } else {
    QK8(pB0, pB1, 1);
#define ITERB(j, PN0, PN1, ALN, PO0, PO1) do { SBAR(); XCV(PO0, PO1, j); partialSMY(PN0, PN1, negm, ALN); RESC(ALN); SBAR(); if ((j) + 1 < NT) QK8(PO0, PO1, (j) + 1); } while (0)
    for (int j = 1; j + 1 < NT; j += 2) {
      if (j + LEAD < NT) DMA(j + LEAD); if (j + LEAD + 1 < NT) DMA(j + LEAD + 1);
      ITERB(j, pB0, pB1, alB, pA0, pA1);
      ITERB(j + 1, pA0, pA1, alA, pB0, pB1);
      if (j + LEAD + 1 < NT) VMW(2 * (LEAD - 3)); else VMW(0); TBAR();
    }
    ITERB(NT - 1, pB0, pB1, alB, pA0, pA1);
#undef ITERB
  }
  finishSMY(pB0, pB1, P8); SBAR();
  pv8s(o, lacc, vrd + ((NT - 1) & (NBUF - 1)) * TB, P8);
#undef XCV
#else
#pragma unroll
  for (int t = 0; t <= LEAD; ++t) if (t < NT) DMA(t);
  if (LEAD < NT) VMW(2 * (LEAD - ATT_KPF)); else VMW(0);
  TBAR();
  KLOAD(0);
  QK8(pA0, pA1, 0); PSM(pA0, pA1, alA);
  if (LEAD < NT) VMW(2 * (LEAD - 1 - ATT_BAR2 - ATT_KPF)); else VMW(0);
  TBAR();
#define ITER(j, PN0, PN1, ALN, PO0, PO1, ALO) do { \
    if (!ATT_BAR2) { if ((j) + LEAD < NT) DMA((j) + LEAD); } \
    SBAR(); if (!(ATT_STAG && map == 1)) QK8(PN0, PN1, j); \
    if (ATT_Y8) { if (VAR != 4) finishSMY(PO0, PO1, P8); SBAR(); \
        if (VAR == 2) { const LAS char* vb_ = vrd + (((j) - 1) & (NBUF - 1)) * TB; _Pragma("unroll") for (int d0 = 0; d0 < 4; ++d0) { const v4u l_ = *(const LAS v4u*)(vb_ + d0 * 2048), h_ = *(const LAS v4u*)(vb_ + d0 * 2048 + 512); asm volatile("" :: "v"(l_), "v"(h_)); } } \
        else if (VAR != 1) pv8s(o, lacc, vrd + (((j) - 1) & (NBUF - 1)) * TB, P8); \
        if (ATT_STAG && map == 1) { SBAR(); QK8(PN0, PN1, j); } \
        if (VAR != 5) partialSMY(PN0, PN1, negm, ALN); else ALN = 1.f; } \
    else { finishSM8(PO0, PO1, ALO, l_reg, P8); SBAR(); } \
    if (ATT_Y8) {} else if (ATT_PVX) { partialSM<false>(PN0, PN1, negm, ALN); SBAR(); pv8_exp(o, vrd + (((j) - 1) & (NBUF - 1)) * TB, P8, PN0); } \
    else { pv8(o, vrd + (((j) - 1) & (NBUF - 1)) * TB, P8); partialSM(PN0, PN1, negm, ALN); } \
    RESC(ALN); \
    if (!ATT_BAR2) { if ((j) + LEAD < NT) VMW(2 * (LEAD - 1)); else VMW(0); \
    TBAR(); } } while (0)
  for (int j = 1; j + 1 < NT; j += 2) {
    if (ATT_BAR2) { if (j + LEAD < NT) DMA(j + LEAD); if (j + LEAD + 1 < NT) DMA(j + LEAD + 1); }
    ITER(j, pB0, pB1, alB, pA0, pA1, alA);
    ITER(j + 1, pA0, pA1, alA, pB0, pB1, alB);
    if (ATT_BAR2) { if (j + LEAD + 1 < NT) VMW(2 * (LEAD - 2 - ATT_KPF)); else VMW(0); TBAR(); }
  }
  ITER(NT - 1, pB0, pB1, alB, pA0, pA1, alA);
#if ATT_Y8
  finishSMY(pB0, pB1, P8); SBAR();
  pv8s(o, lacc, vrd + ((NT - 1) & (NBUF - 1)) * TB, P8);
#else
  finishSM8(pB0, pB1, alB, l_reg, P8); SBAR();
  pv8(o, vrd + ((NT - 1) & (NBUF - 1)) * TB, P8);
#endif
#endif
#undef PSM
#undef VMW
#undef DMA
#undef TBAR
#undef QK8
#undef KLOAD
#undef ITER
#elif ATT_DMA && ATT_FP8
  const int vb0 = (int)(unsigned)(uintptr_t)lds + v_rd_base(lane);
  unsigned voffV[2], voffK[2];
#pragma unroll
  for (int t = 0; t < 2; ++t) { const int vi = wid * 2 + t, kg = vi >> 1, pair = vi & 1, sub = lane >> 5, row = (lane >> 2) & 7, chunk = lane & 3;
    voffV[t] = (unsigned)((8 * kg + row) * LDK + 32 * (2 * pair + sub) + 8 * chunk) * 2u;
    const int krow = 4 * vi + (lane >> 4), p = lane & 15;
    voffK[t] = (unsigned)(krow * LDK) * 2u + (unsigned)((p ^ (krow & 7)) * 16); }
  const int ldsw = wid * 2048; const unsigned v8off = (unsigned)(wid * 1024 + lane * 16); const LAS char* vrd = lds + hi * 1024 + r32 * 16; v8i P8;
  (void)voffV; (void)vb0;
#define DMA(t_) do { const char* vt_ = (const char*)(Vh + (size_t)(t_) * KVBLK * LDK); const char* kt_ = (const char*)(Kh + (size_t)(t_) * KVBLK * LDK); const int bo_ = ((t_) & 3) * BUFB; \
    _Pragma("unroll") for (int i_ = 0; i_ < 2; ++i_) { \
      __builtin_amdgcn_global_load_lds((const unsigned*)(kt_ + voffK[i_]), (LAS unsigned*)(lds + bo_ + (int)SHM_V + ldsw + i_ * 1024), 16, 0, 0); } \
    __builtin_amdgcn_global_load_lds((const unsigned*)(V8h + (size_t)(t_) * 65536 + v8off), (LAS unsigned*)(lds + bo_ + wid * 1024), 16, 0, 0); (void)vt_; } while (0)
#define RESC(a) do { if (__any((a) != 1.f)) { if (hi == 0) al_l[r32] = (a); asm volatile("s_waitcnt lgkmcnt(0)" ::: "memory"); \
    _Pragma("unroll") for (int r = 0; r < 16; ++r) { const float a_ = al_l[crow(r, hi)]; lacc[r] *= a_; _Pragma("unroll") for (int d = 0; d < 4; ++d) o[d][r] *= a_; } } } while (0)
#define TBAR() do { asm volatile("s_waitcnt lgkmcnt(0)" ::: "memory"); __builtin_amdgcn_s_barrier(); asm volatile("" ::: "memory"); } while (0)
#define KBUF(t_) (lds + ((t_) & 3) * BUFB + (int)SHM_V)
#define VBUF(t_) (vb0 + ((t_) & 3) * BUFB)
  f32x16 pA0, pA1, pB0, pB1; float alA, alB; bf16x8 pa0, pa1, pa2, pa3; const int NT = seq / KVBLK;
  DMA(0); DMA(1); if (2 < NT) DMA(2);
  if (2 < NT) asm volatile("s_waitcnt vmcnt(6)" ::: "memory"); else asm volatile("s_waitcnt vmcnt(3)" ::: "memory");
  TBAR();
  qkt(pA0, pA1, KBUF(0), qr, r32, hi, map, negm); partialSM(pA0, pA1, negm, alA);
  if (2 < NT) asm volatile("s_waitcnt vmcnt(3)" ::: "memory"); else asm volatile("s_waitcnt vmcnt(0)" ::: "memory");
  TBAR();
#define ITER(j, PN0, PN1, ALN, PO0, PO1, ALO) do { \
    if ((j) + 2 < NT) DMA((j) + 2); \
    SBAR(); qkt(PN0, PN1, KBUF(j), qr, r32, hi, map, negm); \
    finishSM8(PO0, PO1, ALO, l_reg, P8); SBAR(); \
    pv8(o, vrd + (((j) - 1) & 3) * BUFB, P8); partialSM(PN0, PN1, negm, ALN); \
    RESC(ALN); \
    if ((j) + 2 < NT) asm volatile("s_waitcnt vmcnt(3)" ::: "memory"); else asm volatile("s_waitcnt vmcnt(0)" ::: "memory"); \
    TBAR(); } while (0)
  for (int j = 1; j + 1 < NT; j += 2) {
    ITER(j, pB0, pB1, alB, pA0, pA1, alA);
    ITER(j + 1, pA0, pA1, alA, pB0, pB1, alB);
  }
  ITER(NT - 1, pB0, pB1, alB, pA0, pA1, alA);
  finishSM8(pB0, pB1, alB, l_reg, P8); SBAR();
  pv8(o, vrd + ((NT - 1) & 3) * BUFB, P8);
#undef DMA
#undef TBAR
#undef KBUF
#undef VBUF
#undef ITER
#elif ATT_DMA
  const int vb0 = (int)(unsigned)(uintptr_t)lds + v_rd_base(lane);
  unsigned voffV[2], voffK[2];
#pragma unroll
  for (int t = 0; t < 2; ++t) { const int vi = wid * 2 + t, kg = vi >> 1, pair = vi & 1, sub = lane >> 5, row = (lane >> 2) & 7, chunk = lane & 3;
    voffV[t] = (unsigned)((8 * kg + row) * LDK + 32 * (2 * pair + sub) + 8 * chunk) * 2u;
    const int krow = 4 * vi + (lane >> 4), p = lane & 15;
    voffK[t] = (unsigned)(krow * LDK) * 2u + (unsigned)((p ^ (krow & 7)) * 16); }
  const int ldsw = wid * 2048;
#define DMA(t_) do { const char* vt_ = (const char*)(Vh + (size_t)(t_) * KVBLK * LDK); const char* kt_ = (const char*)(Kh + (size_t)(t_) * KVBLK * LDK); const int bo_ = ((t_) & 3) * BUFB; \
    _Pragma("unroll") for (int i_ = 0; i_ < 2; ++i_) { \
      __builtin_amdgcn_global_load_lds((const unsigned*)(vt_ + voffV[i_]), (LAS unsigned*)(lds + bo_ + ldsw + i_ * 1024), 16, 0, 0); \
      __builtin_amdgcn_global_load_lds((const unsigned*)(kt_ + voffK[i_]), (LAS unsigned*)(lds + bo_ + (int)SHM_V + ldsw + i_ * 1024), 16, 0, 0); } } while (0)
#define RESC(a) do { if (__any((a) != 1.f)) { if (hi == 0) al_l[r32] = (a); asm volatile("s_waitcnt lgkmcnt(0)" ::: "memory"); \
    _Pragma("unroll") for (int r = 0; r < 16; ++r) { const float a_ = al_l[crow(r, hi)]; lacc[r] *= a_; _Pragma("unroll") for (int d = 0; d < 4; ++d) o[d][r] *= a_; } } } while (0)
#define TBAR() do { asm volatile("s_waitcnt lgkmcnt(0)" ::: "memory"); __builtin_amdgcn_s_barrier(); asm volatile("" ::: "memory"); } while (0)
#define KBUF(t_) (lds + ((t_) & 3) * BUFB + (int)SHM_V)
#define VBUF(t_) (vb0 + ((t_) & 3) * BUFB)
  f32x16 pA0, pA1, pB0, pB1; float alA, alB; bf16x8 pa0, pa1, pa2, pa3; const int NT = seq / KVBLK;
  DMA(0); DMA(1); if (2 < NT) DMA(2);
  if (2 < NT) asm volatile("s_waitcnt vmcnt(8)" ::: "memory"); else asm volatile("s_waitcnt vmcnt(4)" ::: "memory");
  TBAR();
  qkt(pA0, pA1, KBUF(0), qr, r32, hi, map, negm); partialSM(pA0, pA1, negm, alA);
  if (2 < NT) asm volatile("s_waitcnt vmcnt(4)" ::: "memory"); else asm volatile("s_waitcnt vmcnt(0)" ::: "memory");
  TBAR();
#define ITER(j, PN0, PN1, ALN, PO0, PO1, ALO) do { \
    if ((j) + 2 < NT) DMA((j) + 2); \
    SBAR(); qkt(PN0, PN1, KBUF(j), qr, r32, hi, map, negm); \
    finishSM(PO0, PO1, ALO, l_reg, pa0, pa1, pa2, pa3); SBAR(); \
    pv_d0(o, VBUF((j) - 1), pa0, pa1, pa2, pa3, lacc); partialSM(PN0, PN1, negm, ALN); \
    RESC(ALN); \
    if ((j) + 2 < NT) asm volatile("s_waitcnt vmcnt(4)" ::: "memory"); else asm volatile("s_waitcnt vmcnt(0)" ::: "memory"); \
    TBAR(); } while (0)
  for (int j = 1; j + 1 < NT; j += 2) {
    ITER(j, pB0, pB1, alB, pA0, pA1, alA);
    ITER(j + 1, pA0, pA1, alA, pB0, pB1, alB);
  }
  ITER(NT - 1, pB0, pB1, alB, pA0, pA1, alA);
  finishSM(pB0, pB1, alB, l_reg, pa0, pa1, pa2, pa3); SBAR();
  pv_d0(o, VBUF(NT - 1), pa0, pa1, pa2, pa3, lacc);
#undef DMA
#undef TBAR
#undef KBUF
#undef VBUF
#undef ITER
#else
  const int sr = tid >> 4, sc = (tid & 15) * 8, vst0 = v_st(sr, sc), vst1 = v_st(32 + sr, sc);
  const int vb0 = (int)(unsigned)(uintptr_t)lds + v_rd_base(lane);
  struct { bf16x8 vs0, vs1, ks0, ks1; } sr_[2];
  const unsigned goff = (unsigned)(sr * LDK + sc) * 2u;
#define SLOAD(i, k0) do { const char* vt_ = (const char*)(Vh + (size_t)(k0) * LDK); const char* kt_ = (const char*)(Kh + (size_t)(k0) * LDK); \
    sr_[i].vs0 = *(const bf16x8*)(vt_ + goff); sr_[i].vs1 = *(const bf16x8*)(vt_ + (size_t)32 * LDK * 2 + goff); sr_[i].ks0 = *(const bf16x8*)(kt_ + goff); sr_[i].ks1 = *(const bf16x8*)(kt_ + (size_t)32 * LDK * 2 + goff); } while (0)
#define SWRITE(b, i) do { *(LAS bf16x8*)(lds + (b) * BUFB + vst0) = sr_[i].vs0; *(LAS bf16x8*)(lds + (b) * BUFB + vst1) = sr_[i].vs1; const int kc = sc * 2; \
    *(LAS bf16x8*)(lds + (b) * BUFB + (int)SHM_V + KSWZ(sr, kc)) = sr_[i].ks0; *(LAS bf16x8*)(lds + (b) * BUFB + (int)SHM_V + KSWZ(32 + sr, kc)) = sr_[i].ks1; } while (0)
#define SWAIT() asm volatile("s_waitcnt vmcnt(4)" ::: "memory")
#define RESC(a) do { if (__any((a) != 1.f)) { if (hi == 0) al_l[r32] = (a); asm volatile("s_waitcnt lgkmcnt(0)" ::: "memory"); \
    _Pragma("unroll") for (int r = 0; r < 16; ++r) { const float a_ = al_l[crow(r, hi)]; lacc[r] *= a_; _Pragma("unroll") for (int d = 0; d < 4; ++d) o[d][r] *= a_; } } } while (0)
  f32x16 pA0, pA1, pB0, pB1; float alA, alB; bf16x8 pa0, pa1, pa2, pa3; const int NT = seq / KVBLK;
  constexpr int SE = 0, SO = 1;
  LAS char* K0 = lds + (int)SHM_V; LAS char* K1 = lds + BUFB + (int)SHM_V;
  SLOAD(SE, 0); asm volatile("s_waitcnt vmcnt(0)" ::: "memory"); SWRITE(0, SE); __syncthreads();
  qkt(pA0, pA1, K0, qr, r32, hi, map, negm); partialSM(pA0, pA1, negm, alA);
  SLOAD(SO, KVBLK); if (2 < NT) SLOAD(SE, 2 * KVBLK);
  SWAIT(); SWRITE(1, SO); __syncthreads();
#define XBAR() do { if (VAR != 1) __syncthreads(); } while (0)
#define XQK(P0, P1, KK) do { if (VAR != 5) qkt(P0, P1, KK, qr, r32, hi, map, negm); } while (0)
#define XFIN(P0, P1, AL) do { if (VAR != 2) finishSM(P0, P1, AL, l_reg, pa0, pa1, pa2, pa3); } while (0)
#define XPAR(P0, P1, AL) do { if (VAR != 2) partialSM(P0, P1, negm, AL); } while (0)
#define XPV(VB) do { if (VAR != 3) pv_d0(o, VB, pa0, pa1, pa2, pa3, lacc); } while (0)
#define XLOAD(i, k0) do { if (VAR != 4) SLOAD(i, k0); } while (0)
#define XWRITE(b, i) do { if (VAR != 4) { SWAIT(); SWRITE(b, i); } } while (0)
  if (VAR == 2) { pa0 = qr[0]; pa1 = qr[1]; pa2 = qr[2]; pa3 = qr[3]; alA = 1.f; alB = 1.f; }
  if (VAR == 5) { pA0 = f32x16{}; pA1 = pA0; pB0 = pA0; pB1 = pA0; }
  for (int j = 1; j + 1 < NT; j += 2) {
    SBAR(); XQK(pB0, pB1, K1);
    XFIN(pA0, pA1, alA); SBAR();
    XLOAD(SO, (j + 2) * KVBLK); SBAR();
    XPV(vb0); XPAR(pB0, pB1, alB);
    XBAR(); XWRITE(0, SE);
    RESC(alB); XBAR();
    SBAR(); XQK(pA0, pA1, K0);
    XFIN(pB0, pB1, alB); SBAR();
    if (j + 3 < NT) XLOAD(SE, (j + 3) * KVBLK); SBAR();
    XPV(vb0 + BUFB); XPAR(pA0, pA1, alA);
    XBAR(); XWRITE(1, SO);
    RESC(alA); XBAR();
  }
  SBAR(); qkt(pB0, pB1, K1, qr, r32, hi, map, negm);
  finishSM(pA0, pA1, alA, l_reg, pa0, pa1, pa2, pa3); SBAR();
  pv_d0(o, vb0, pa0, pa1, pa2, pa3, lacc); partialSM(pB0, pB1, negm, alB);
  __syncthreads(); RESC(alB);
  finishSM(pB0, pB1, alB, l_reg, pa0, pa1, pa2, pa3); SBAR();
  pv_d0(o, vb0 + BUFB, pa0, pa1, pa2, pa3, lacc);
#endif
  {
    const int tid2 = fresh_tid(wave), wid2 = tid2 >> 6, lane2 = tid2 & 63, r32b = lane2 & 31, hib = lane2 >> 5, mapb = wid2 >> 2, wqb = wid2 & 3;
    LAS float* li2 = (LAS float*)(lds + WSF_OFF) + wid2 * 64;
    float rli[16];
#if ATT_LMFMA || ATT_Y8
    (void)li2;
#pragma unroll
    for (int r = 0; r < 16; ++r) rli[r] = __builtin_amdgcn_rcpf(lacc[r]);
#else
    if (hib == 0) li2[r32b] = l_reg; asm volatile("s_waitcnt lgkmcnt(0)" ::: "memory");
#pragma unroll
    for (int r = 0; r < 16; ++r) rli[r] = __builtin_amdgcn_rcpf(li2[crow(r, hib)]);
#endif
    __syncthreads();
    LAS float* X = (LAS float*)lds + (wqb * 32 + 4 * hib) * 128 + r32b;
    if (mapb == 1) {
#pragma unroll
      for (int r = 0; r < 16; ++r)
#pragma unroll
        for (int d0 = 0; d0 < 4; ++d0) X[((r & 3) + 8 * (r >> 2)) * 128 + d0 * 32] = o[d0][r] * rli[r] * lam;
    }
    __syncthreads();
    if (mapb == 0) {
      float gs[4];
#pragma unroll
      for (int d0 = 0; d0 < 4; ++d0) gs[d0] = gsub[d0 * 32 + r32b] * oscale;
      bf16* Ow = Ob + (long)(wqb * 32 + 4 * hib) * D + r32b;
#pragma unroll
      for (int r = 0; r < 16; ++r) {
        float ss = 0.f;
#pragma unroll
        for (int d0 = 0; d0 < 4; ++d0) { const float v = o[d0][r] * rli[r] - X[((r & 3) + 8 * (r >> 2)) * 128 + d0 * 32]; o[d0][r] = v; ss += v * v; }
        ss = half_sum(ss);
        const float rs = 1.0f / sqrtf(ss * (1.0f / 128.0f) + NORM_EPS);
#pragma unroll
        for (int d0 = 0; d0 < 4; ++d0) Ow[(long)((r & 3) + 8 * (r >> 2)) * D + d0 * 32] = (bf16)f2bf(o[d0][r] * rs * gs[d0]);
      }
    }
    __syncthreads();
  }
#if ATT_DMA && ATT_FP8 && ATT_QK8 && ATT_Y8 && ATT_P2 && P2_AB
  };
  if (map == 0) run_(std::integral_constant<int, 0>{}); else run_(std::integral_constant<int, 1>{});
#endif
#if !ATT_DMA
#undef XBAR
#undef XQK
#undef XFIN
#undef XPAR
#undef XPV
#undef XLOAD
#undef XWRITE
#undef SLOAD
#undef SWRITE
#undef SWAIT
#endif
#undef RESC
}
#undef KSWZ
}


__device__ __forceinline__ void v8_phase(Frame& F, const Params& P) {
    unsigned char* ws = fresh_ws(P.ws);
    const bf16* vb = (const bf16*)(ws + WS_VB); unsigned char* v8 = ws + WS_V8;
    const Lane L(F.wave); const int gw = F.vcu * NWAVES + F.wave, NGW = F.G * NWAVES, lane = L.lane;
    for (int tile = gw; tile < NB * (KVLEN / 64) * 8; tile += NGW) {
        const int h = tile & 7, t = (tile >> 3) % (KVLEN / 64), b = (tile >> 3) / (KVLEN / 64);
        const bf16* src = vb + ((size_t)b * KVLEN + 64 * t) * 1024 + h * 128;
        v4u* dst = (v4u*)(v8 + (size_t)tile * 8192);
#pragma unroll 2
        for (int q = 0; q < 8; ++q) {
            const int c = lane + 64 * q, d = c & 31, half = (c >> 5) & 1, hi = (c >> 6) & 1, d0 = c >> 7;
            const bf16* col = src + 32 * d0 + d + (size_t)(4 * hi + 32 * half) * 1024;
            float v[16];
#pragma unroll
            for (int j = 0; j < 16; ++j) { const float x = bf2f(col[(size_t)((j & 3) + 8 * (j >> 2)) * 1024]); v[j] = fminf(fmaxf(x, -448.f), 448.f); }
            v4u w;
            w.x = (unsigned)__builtin_amdgcn_cvt_pk_fp8_f32(v[2], v[3], __builtin_amdgcn_cvt_pk_fp8_f32(v[0], v[1], 0, false), true);
            w.y = (unsigned)__builtin_amdgcn_cvt_pk_fp8_f32(v[6], v[7], __builtin_amdgcn_cvt_pk_fp8_f32(v[4], v[5], 0, false), true);
            w.z = (unsigned)__builtin_amdgcn_cvt_pk_fp8_f32(v[10], v[11], __builtin_amdgcn_cvt_pk_fp8_f32(v[8], v[9], 0, false), true);
            w.w = (unsigned)__builtin_amdgcn_cvt_pk_fp8_f32(v[14], v[15], __builtin_amdgcn_cvt_pk_fp8_f32(v[12], v[13], 0, false), true);
            dst[c] = w;
        }
#if ATT_QK8 && !K8_DIRECT
        const bf16* ksrc = (const bf16*)(ws + WS_KB) + ((size_t)b * KVLEN + 64 * t) * 1024 + h * 128;
        v4u* kdst = (v4u*)(ws + WS_K8 + (size_t)tile * 8192);
#pragma unroll 2
        for (int q = 0; q < 8; ++q) {
            const int c = lane + 64 * q, key = c & 63, half = (c >> 6) & 1, hi = (c >> 7) & 1, map = c >> 8;
            const bf16* p = ksrc + (size_t)key * 1024 + map * 64 + 32 * hi + 16 * half;
            float v[16]; { float a[8], bq[8]; ld8f(p, a); ld8f(p + 8, bq);
#pragma unroll
              for (int j = 0; j < 8; ++j) { v[j] = fminf(fmaxf(a[j], -448.f), 448.f); v[8 + j] = fminf(fmaxf(bq[j], -448.f), 448.f); } }
            v4u w;
            w.x = (unsigned)__builtin_amdgcn_cvt_pk_fp8_f32(v[2], v[3], __builtin_amdgcn_cvt_pk_fp8_f32(v[0], v[1], 0, false), true);
            w.y = (unsigned)__builtin_amdgcn_cvt_pk_fp8_f32(v[6], v[7], __builtin_amdgcn_cvt_pk_fp8_f32(v[4], v[5], 0, false), true);
            w.z = (unsigned)__builtin_amdgcn_cvt_pk_fp8_f32(v[10], v[11], __builtin_amdgcn_cvt_pk_fp8_f32(v[8], v[9], 0, false), true);
            w.w = (unsigned)__builtin_amdgcn_cvt_pk_fp8_f32(v[14], v[15], __builtin_amdgcn_cvt_pk_fp8_f32(v[12], v[13], 0, false), true);
            kdst[c] = w;
        }
#endif
    }
}
template <int VAR>
__device__ __forceinline__ void attn_phase(Frame& F, const Params& P, int layer, bool ctx_out, unsigned char* ldsg) {
    (void)ldsg;
    unsigned char* ws = fresh_ws(P.ws);
    const bf16* qb = (const bf16*)(ws + WS_Q); const bf16* kb = (const bf16*)(ws + WS_KB); const bf16* vb = (const bf16*)(ws + WS_VB); bf16* cat = (bf16*)(ws + (VAR == 0 ? WS_CAT : WS_H));
    const Lane L(F.wave);
    const float lam_init = __builtin_bit_cast(float, __builtin_amdgcn_readfirstlane(__builtin_bit_cast(int, 0.8f - 0.6f * expf(-0.3f * (float)layer))));
    const float* lv = P.in[I_LAMBDA] + layer * 256;
    const float d1 = wave_sum(lv[L.lane] * lv[64 + L.lane]), d2 = wave_sum(lv[128 + L.lane] * lv[192 + L.lane]);
    const float lam = __builtin_bit_cast(float, __builtin_amdgcn_readfirstlane(__builtin_bit_cast(int, expf(d1) - expf(d2) + lam_init)));
    const float* gsub = P.in[I_SUBLN] + layer * 128;
    const int nun = NB * 8 * 64 + (ctx_out ? NB * 8 * 2 : 0);
    for (int uid = F.vcu; uid < nun; uid += F.G) {
        int qt, h, b, seq; size_t qrow;
        if (uid < NB * 8 * 64) { qt = uid & 63; h = (uid >> 6) & 7; b = uid >> 9; qrow = (size_t)b * SEQ + 128 * qt; seq = KVLEN; }
        else { const int u2 = uid - NB * 8 * 64; qt = u2 & 1; h = (u2 >> 1) & 7; b = u2 >> 4; qrow = (size_t)NLAT + b * CTXL + 128 * qt; seq = CTXL; }
        att::diff_attn_unit<VAR>(Q8_DIRECT ? (const bf16*)((const unsigned char*)qb + qrow * 1024 + h * 128) : qb + qrow * 1024 + h * 128, kb + (size_t)b * KVLEN * 1024 + h * 128, vb + (size_t)b * KVLEN * 1024 + h * 128,
                            cat + qrow * D + 1024 + h * 128, seq, (LAS char*)F.lds, lam, gsub, 1.0f - lam_init, F.wave, ws + WS_V8 + ((size_t)b * (KVLEN / 64) * 8 + h) * 8192, (const unsigned char*)qb);
    }
}
struct MoePanels { int ps[9]; };
__device__ __forceinline__ MoePanels moe_panels(Frame& F) {
    MoePanels m; int acc = 0;
#pragma unroll
    for (int e = 0; e < NE; ++e) { m.ps[e] = acc; const int c = (int)__builtin_amdgcn_readfirstlane(__hip_atomic_load(F.ctl + CW_CNT + 64 * e, RLX_AGENT)); acc += (c + 255) >> 8; }
    m.ps[8] = acc; return m;
}
__device__ __forceinline__ void moe_gather_phase(Frame& F, const Params& P) {
    unsigned char* ws = fresh_ws(P.ws);
    const bf16* h = (const bf16*)(ws + WS_H); bf16* Ag = (bf16*)(ws + WS_AG);
    const int* tok_e = (const int*)(ws + WS_ROUTE); const int* tok_slot = tok_e + 2 * NLAT;
    const float* hs = (const float*)(ws + WS_HS); float* ags = (float*)(ws + WS_AGS);
    const MoePanels mp = moe_panels(F);
    const Lane L(F.wave); const int gw = F.vcu * NWAVES + F.wave, NGW = F.G * NWAVES, lane = L.lane;
    for (int a = gw; a < 2 * NLAT; a += NGW) {
        const int r = a >> 1, e = tok_e[a], slot = tok_slot[a];
        int pse = 0;
#pragma unroll
        for (int q = 0; q < NE; ++q) pse = (q == e) ? mp.ps[q] : pse;
        const v4u* src = (const v4u*)((const unsigned char*)h + (size_t)r * D) + lane; v4u* dst = (v4u*)((unsigned char*)Ag + ((size_t)pse * 256 + slot) * D) + lane;
#pragma unroll
        for (int j = 0; j < 2; ++j) dst[64 * j] = src[64 * j];
#if I8_GU
        if (lane == 0) ags[pse * 256 + slot] = hs[r];
#endif
    }
    for (int e = 0; e < NE; ++e) {
        const int c = (int)__builtin_amdgcn_readfirstlane(__hip_atomic_load(F.ctl + CW_CNT + 64 * e, RLX_AGENT));
        const int pad = ((c + 255) & ~255) - c;
        for (int q = gw; q < pad; q += NGW) { v4u* dst = (v4u*)((unsigned char*)Ag + ((size_t)mp.ps[e] * 256 + c + q) * D) + lane;
#pragma unroll
            for (int j = 0; j < 2; ++j) dst[64 * j] = (v4u){0u, 0u, 0u, 0u};
#if I8_GU
            if (lane == 0) ags[mp.ps[e] * 256 + c + q] = 0.f;
#endif
        }
    }
}
__device__ __forceinline__ void final_phase(Frame& F, const Params& P, const float* modl) {
    unsigned char* ws = fresh_ws(P.ws);
    const bf16* xl = (const bf16*)(ws + WS_XL); const bf16* yb = (const bf16*)(ws + WS_AG);
    const int* tok_e = (const int*)(ws + WS_ROUTE); const int* tok_slot = tok_e + 2 * NLAT; const float* tok_p = (const float*)(tok_slot + 2 * NLAT);
    const MoePanels mp = moe_panels(F);
    const Lane L(F.wave); const int gw = F.vcu * NWAVES + F.wave, NGW = F.G * NWAVES, lane = L.lane;
    const float* gf = P.in[I_GFIN];
    for (int r = gw; r < NLAT; r += NGW) {
        const int v = r < SEQ ? 0 : 1; const float* g5 = modl + (size_t)(v * 6 + 5) * D;
        const int e0 = tok_e[2 * r], e1 = tok_e[2 * r + 1];
        int p0s = 0, p1s = 0;
#pragma unroll
        for (int q = 0; q < NE; ++q) { p0s = (q == e0) ? mp.ps[q] : p0s; p1s = (q == e1) ? mp.ps[q] : p1s; }
        const bf16* y0 = yb + ((size_t)p0s * 256 + tok_slot[2 * r]) * D; const bf16* y1 = yb + ((size_t)p1s * 256 + tok_slot[2 * r + 1]) * D;
        const float w0 = tok_p[2 * r], w1 = tok_p[2 * r + 1];
        f32x4 x[8]; float ss = 0.f;
#pragma unroll
        for (int jq = 0; jq < 8; ++jq) { const int c = 4 * lane + 256 * jq;
            const v2u a = *(const v2u*)(y0 + c), bq = *(const v2u*)(y1 + c); const f32x4 g = *(const f32x4*)(g5 + c); const f32x4 xv = ld4_bf16(xl + (size_t)r * D + c);
            f32x4 y; y[0] = w0 * bflo(a.x) + w1 * bflo(bq.x); y[1] = w0 * bfhi(a.x) + w1 * bfhi(bq.x); y[2] = w0 * bflo(a.y) + w1 * bflo(bq.y); y[3] = w0 * bfhi(a.y) + w1 * bfhi(bq.y);
            x[jq] = xv + g * y; ss += (x[jq][0] * x[jq][0] + x[jq][1] * x[jq][1]) + (x[jq][2] * x[jq][2] + x[jq][3] * x[jq][3]); }
        const float rstd = 1.0f / sqrtf(wave_sum(ss) * (1.0f / D) + NORM_EPS);
#pragma unroll
        for (int jq = 0; jq < 8; ++jq) { const int c = 4 * lane + 256 * jq; const f32x4 ov_ = (x[jq] * rstd) * *(const f32x4*)(gf + c); if (FIN_NT) __builtin_nontemporal_store(ov_, (f32x4*)(P.out + (size_t)r * D + c)); else *(f32x4*)(P.out + (size_t)r * D + c) = ov_; }
    }
}
#if DBG == 1
constexpr size_t WS_DBG = 3 * MiB;
__device__ __forceinline__ void dbg_err(Frame& F, int k, float got, float want, float scale) {
    float e = fabsf(got - want) / scale; if (!(e == e)) e = 1e9f;
    atomicMax((unsigned*)(F.ctl + CW_DIAG + 64 * k), __float_as_uint(e));
}
__device__ __forceinline__ unsigned dbg_hash(unsigned x) { x ^= x >> 16; x *= 0x7feb352du; x ^= x >> 15; x *= 0x846ca68bu; x ^= x >> 16; return x; }
__device__ __forceinline__ float block_sum(float v, LAS float* red, int tid) {
    v = wave_sum(v); __syncthreads(); if ((tid & 63) == 0) red[tid >> 6] = v; __syncthreads();
    float s = 0.f; for (int w = 0; w < 8; ++w) s += red[w]; __syncthreads(); return s;
}
__device__ __forceinline__ float block_max(float v, LAS float* red, int tid) {
    v = fmaxf(v, dpp_f(v, 0)); v = fmaxf(v, dpp_f(v, 1)); v = fmaxf(v, dpp_f(v, 2)); v = fmaxf(v, dpp_f(v, 3));
    v = fmaxf(v, __builtin_bit_cast(float, __builtin_amdgcn_ds_swizzle(__builtin_bit_cast(int, v), 0x401F)));
    v = cross_max(v);
    __syncthreads(); if ((tid & 63) == 0) red[tid >> 6] = v; __syncthreads();
    float s = red[0]; for (int w = 1; w < 8; ++w) s = fmaxf(s, red[w]); __syncthreads(); return s;
}
__device__ __forceinline__ const float* dbg_res_row(const Params& P, int layer, int r) {
    const float* xl = (const float*)(fresh_ws(P.ws) + WS_XL);
    if (layer == 0) return r < NLAT ? P.in[I_X] + (size_t)r * D : P.in[I_CTX] + (size_t)(r - NLAT) * D;
    return xl + (size_t)r * D;
}
__device__ __forceinline__ int dbg_vec(int r) { return r < SEQ ? 0 : (r < NLAT ? 1 : 2); }

__device__ __forceinline__ void dbg_check_norm(Frame& F, const Params& P, int layer) {
    const int tid = fresh_tid(F.wave); LAS float* hn = (LAS float*)F.lds; LAS float* red = hn + D;
    const float* modl = (const float*)(fresh_ws(P.ws) + WS_MOD) + (size_t)layer * 3 * 12288;
    { const float t1 = block_sum(1.0f, red, tid), t2 = block_sum((float)tid, red, tid), t3 = wave_sum((float)(tid & 63));
      dbg_err(F, 2, t1, 512.0f, 1.0f); dbg_err(F, 3, t2, 130816.0f, 1.0f); dbg_err(F, 4, t3, 2016.0f, 1.0f); }
    for (int s = F.vcu; s < 256; s += F.G) {
        const unsigned hsh = dbg_hash(s * 2654435761u + 17u + layer);
        const int r = (s & 7) == 7 ? NLAT + (hsh % NCTX) : (int)(hsh % NLAT);
        const float* xr = dbg_res_row(P, layer, r); const int v = dbg_vec(r);
        float ss = 0.f; for (int k = tid; k < D; k += 512) ss += xr[k] * xr[k];
        ss = block_sum(ss, red, tid); const float rstd = 1.0f / sqrtf(ss / D + NORM_EPS);
        const bf16* hr = (const bf16*)(fresh_ws(P.ws) + WS_H) + (size_t)r * D;
        for (int k = tid; k < D; k += 512) { const float want = (xr[k] * rstd * P.in[I_GMIX][layer * D + k]) * (1.0f + modl[(v * 6 + 1) * D + k]) + modl[(v * 6 + 0) * D + k]; dbg_err(F, 0, bf2f(hr[k]), want, 1.0f); }
        const int v2 = s % 3, j = (int)((hsh >> 5) % 12288);
        float a = 0.f; for (int k = tid; k < D; k += 512) { const float c = v2 < 2 ? P.in[I_C][v2 * D + k] : P.in[I_CCTX][k]; a += c / (1.0f + expf(-c)) * P.in[I_WMOD][((size_t)layer * D + k) * 12288 + j]; }
        a = block_sum(a, red, tid);
        if (tid == 0) dbg_err(F, 1, modl[v2 * 12288 + j], a + P.in[I_BMOD][layer * 12288 + j], 1.0f);
        __syncthreads();
    }
}
__device__ __forceinline__ void dbg_check_inproj(Frame& F, const Params& P, int layer) {
    const int tid = fresh_tid(F.wave); LAS float* hn = (LAS float*)F.lds; LAS float* red = hn + D;
    const float* modl = (const float*)(fresh_ws(P.ws) + WS_MOD) + (size_t)layer * 3 * 12288;
    for (int s = F.vcu; s < 256; s += F.G) {
        const unsigned hsh = dbg_hash(s * 2654435761u + 17u + layer);
        const int r = (s & 7) == 7 ? NLAT + (hsh % NCTX) : (int)(hsh % NLAT);
        int c = (int)((hsh >> 8) % IN_COLS); if ((s & 3) == 1) c = COL_Q + (int)((hsh >> 8) % 1024); if ((s & 3) == 2) c = COL_K + (int)((hsh >> 8) % 1024); if ((s & 15) == 3) c = COL_DT + (int)((hsh >> 8) % 16);
        const float* xr = dbg_res_row(P, layer, r); const int v = dbg_vec(r);
        float ss = 0.f; for (int k = tid; k < D; k += 512) ss += xr[k] * xr[k];
        ss = block_sum(ss, red, tid); const float rstd = 1.0f / sqrtf(ss / D + NORM_EPS);
        for (int k = tid; k < D; k += 512) hn[k] = (xr[k] * rstd * P.in[I_GMIX][layer * D + k]) * (1.0f + modl[(v * 6 + 1) * D + k]) + modl[(v * 6 + 0) * D + k];
        __syncthreads();
        const float* w = P.in[I_WIN] + (size_t)layer * D * IN_COLS;
        const bool qk = (c >= COL_Q && c < COL_Q + 1024) || (c >= COL_K && c < COL_K + 1024);
        int cp = c; if (qk) { const int base = c >= COL_K ? COL_K : COL_Q; const int cl = (c - base) & 31; cp = c - cl + ((cl + 16) & 31); }
        float d0 = 0.f, d1 = 0.f; for (int k = tid; k < D; k += 512) { d0 += hn[k] * w[(size_t)k * IN_COLS + c]; d1 += hn[k] * w[(size_t)k * IN_COLS + cp]; }
        d0 = block_sum(d0, red, tid); d1 = block_sum(d1, red, tid);
        if (tid == 0) {
            float want = d0, got;
            if (c < COL_Z) got = bf2f(((const bf16*)(fresh_ws(P.ws) + WS_CONV))[(size_t)r * 1536 + c]);
            else if (c < COL_Q) got = bf2f(((const bf16*)(fresh_ws(P.ws) + WS_Z))[(size_t)r * 512 + c - COL_Z]);
            else if (c < COL_XBC) got = 0.f;
            else if (c < COL_DT) got = bf2f(((const bf16*)(fresh_ws(P.ws) + WS_XBC))[(size_t)r * 1024 + c - COL_XBC]);
            else if (c < COL_K) got = ((const float*)(fresh_ws(P.ws) + WS_DT))[(size_t)r * 16 + c - COL_DT];
            else if (c < COL_V) got = 0.f;
            else { const size_t kr = r < NLAT ? (size_t)(r / SEQ) * KVLEN + CTXL + (r % SEQ) : (size_t)((r - NLAT) / CTXL) * KVLEN + (r - NLAT) % CTXL; got = bf2f(((const bf16*)(fresh_ws(P.ws) + WS_VB))[kr * 1024 + c - COL_V]); }
            if (qk) {
                const int base = c >= COL_K ? COL_K : COL_Q; const int cc = c - base, cl = cc & 31, seg = (cc >> 5) & 1, f = cl & 15;
                if (r < NLAT) { const int t = r % SEQ; const float pos = seg ? (float)(t % 64) : (float)(t / 64); const float inv = powf(10000.0f, -(float)f / 16.0f); const float ang = pos * inv;
                    want = cl < 16 ? d0 * cosf(ang) - d1 * sinf(ang) : d0 * cosf(ang) + d1 * sinf(ang); }
                const int mem = (cc & ~31) + pg8::perm32(cl);
                if (base == COL_Q) got = bf2f(((const bf16*)(fresh_ws(P.ws) + WS_Q))[(size_t)r * 1024 + mem]);
                else { const size_t kr = r < NLAT ? (size_t)(r / SEQ) * KVLEN + CTXL + (r % SEQ) : (size_t)((r - NLAT) / CTXL) * KVLEN + (r - NLAT) % CTXL; got = bf2f(((const bf16*)(fresh_ws(P.ws) + WS_KB))[kr * 1024 + mem]); }
            }
            { const int seg = ((c - (c >= COL_K ? COL_K : COL_Q)) >> 5) & 1; const int slot = (r < NLAT ? 0 : 3) + (qk ? 1 + seg : 0); dbg_err(F, slot, got, want, 1.0f); }
        }
        __syncthreads();
    }
}
__device__ __forceinline__ void dbg_check_attn(Frame& F, const Params& P, int layer) {
    const int tid = fresh_tid(F.wave); LAS float* sc1 = (LAS float*)F.lds; LAS float* sc2 = sc1 + KVLEN; LAS float* red = sc2 + KVLEN; LAS float* ov = red + 16; LAS float* qv = ov + 512;
    const bf16* qb = (const bf16*)(fresh_ws(P.ws) + WS_Q); const bf16* kb = (const bf16*)(fresh_ws(P.ws) + WS_KB); const bf16* vb = (const bf16*)(fresh_ws(P.ws) + WS_VB); const bf16* cat = (const bf16*)(fresh_ws(P.ws) + WS_CAT);
    const float lam_init = 0.8f - 0.6f * expf(-0.3f * (float)layer); const float* lv = P.in[I_LAMBDA] + layer * 256;
    float d1 = 0.f, d2 = 0.f; for (int i = 0; i < 64; ++i) { d1 += lv[i] * lv[64 + i]; d2 += lv[128 + i] * lv[192 + i]; }
    const float lam = expf(d1) - expf(d2) + lam_init;
    for (int s = F.vcu; s < 64; s += F.G) {
        const unsigned hsh = dbg_hash(s * 2654435761u + 99u + layer);
        const bool isctx = layer == 0 && (s & 7) == 7; const int h = (hsh >> 4) & 7;
        const int r = isctx ? NLAT + (int)(hsh % NCTX) : (int)((hsh >> 7) % NLAT);
        const int b = isctx ? (r - NLAT) / CTXL : r / SEQ; const int nk = isctx ? CTXL : KVLEN;
        if (tid < 128) qv[tid] = bf2f(qb[(size_t)r * 1024 + h * 128 + tid]);
        __syncthreads();
        float m1 = -1e30f, m2 = -1e30f;
        for (int k = tid; k < nk; k += 512) { const bf16* kr = kb + ((size_t)b * KVLEN + k) * 1024 + h * 128; float a = 0.f, c2 = 0.f;
            for (int d = 0; d < 64; ++d) { a += qv[d] * bf2f(kr[d]); c2 += qv[64 + d] * bf2f(kr[64 + d]); }
            a *= 0.125f; c2 *= 0.125f; sc1[k] = a; sc2[k] = c2; m1 = fmaxf(m1, a); m2 = fmaxf(m2, c2); }
        m1 = block_max(m1, red, tid); m2 = block_max(m2, red, tid);
        float l1 = 0.f, l2 = 0.f;
        for (int k = tid; k < nk; k += 512) { const float p1 = expf(sc1[k] - m1), p2 = expf(sc2[k] - m2); sc1[k] = p1; sc2[k] = p2; l1 += p1; l2 += p2; }
        l1 = block_sum(l1, red, tid); l2 = block_sum(l2, red, tid);
        { const int d = tid & 127, part = tid >> 7; float o = 0.f;
          for (int k = part; k < nk; k += 4) o += (sc1[k] / l1 - lam * sc2[k] / l2) * bf2f(vb[((size_t)b * KVLEN + k) * 1024 + h * 128 + d]);
          ov[tid] = o; }
        __syncthreads();
        float o = 0.f, sq = 0.f; if (tid < 128) { o = ov[tid] + ov[128 + tid] + ov[256 + tid] + ov[384 + tid]; sq = o * o; }
        sq = block_sum(sq, red, tid);
        if (tid < 128) { const float want = o / sqrtf(sq / 128.0f + NORM_EPS) * P.in[I_SUBLN][layer * 128 + tid] * (1.0f - lam_init);
            dbg_err(F, 1, bf2f(cat[(size_t)r * D + 1024 + h * 128 + tid]), want, 1.0f); }
        __syncthreads();
    }
}
__device__ __forceinline__ void dbg_expect_rows(Frame& F, const Params& P, int layer, int which) {
    const int tid = fresh_tid(F.wave); LAS float* hn = (LAS float*)F.lds; LAS float* act = hn + D; LAS float* red = act + FFD;
    const float* modl = (const float*)(fresh_ws(P.ws) + WS_MOD) + (size_t)layer * 3 * 12288; float* ex = (float*)(fresh_ws(P.ws) + WS_DBG) + (size_t)which * 16 * D;
    for (int s = F.vcu; s < 16; s += F.G) {
        const unsigned hsh = dbg_hash(s * 2654435761u + 7u + which * 131u + layer);
        const int r = (s & 7) == 7 && layer == 0 ? NLAT + (int)(hsh % NCTX) : (int)(hsh % NLAT); const int v = dbg_vec(r);
        if (which == 0) {
            const bf16* cr = (const bf16*)(fresh_ws(P.ws) + WS_CAT) + (size_t)r * D; const float* w = P.in[I_WOUT] + (size_t)layer * D * D; const float* res = dbg_res_row(P, layer, r);
            for (int k = tid; k < D; k += 512) hn[k] = bf2f(cr[k]);
            __syncthreads();
            for (int c = tid; c < D; c += 512) { float a = 0.f; for (int k = 0; k < D; ++k) a += hn[k] * w[(size_t)k * D + c]; ex[s * D + c] = res[c] + modl[(v * 6 + 2) * D + c] * a; }
        } else {
            const float* xr = (const float*)(fresh_ws(P.ws) + WS_XL) + (size_t)r * D;
            float ss = 0.f; for (int k = tid; k < D; k += 512) ss += xr[k] * xr[k];
            ss = block_sum(ss, red, tid); const float rstd = 1.0f / sqrtf(ss / D + NORM_EPS);
            for (int k = tid; k < D; k += 512) hn[k] = (xr[k] * rstd * P.in[I_GFFN][layer * D + k]) * (1.0f + modl[(v * 6 + 4) * D + k]) + modl[(v * 6 + 3) * D + k];
            __syncthreads();
            for (int j = tid; j < FFD; j += 512) { float g = 0.f, u = 0.f; for (int k = 0; k < D; ++k) { g += hn[k] * P.in[I_FG][(size_t)k * FFD + j]; u += hn[k] * P.in[I_FU][(size_t)k * FFD + j]; } act[j] = g / (1.0f + expf(-g)) * u; }
            __syncthreads();
            { float* ex2 = (float*)(fresh_ws(P.ws) + WS_DBG + 256 * 1024) + (size_t)s * 7680; for (int k = tid; k < D; k += 512) ex2[k] = hn[k]; for (int j = tid; j < FFD; j += 512) ex2[D + j] = act[j]; }
            for (int c = tid; c < D; c += 512) { float a = 0.f; for (int j = 0; j < FFD; ++j) a += act[j] * P.in[I_FD][(size_t)j * D + c]; ex[s * D + c] = xr[c] + modl[(v * 6 + 5) * D + c] * a; }
        }
        __syncthreads();
    }
}
__device__ __forceinline__ void dbg_compare_rows(Frame& F, const Params& P, int layer, int which) {
    const int tid = fresh_tid(F.wave); const float* ex = (const float*)(fresh_ws(P.ws) + WS_DBG) + (size_t)which * 16 * D;
    for (int s = F.vcu; s < 16; s += F.G) {
        const unsigned hsh = dbg_hash(s * 2654435761u + 7u + which * 131u + layer);
        const int r = (s & 7) == 7 && layer == 0 ? NLAT + (int)(hsh % NCTX) : (int)(hsh % NLAT);
        const float* xr = (const float*)(fresh_ws(P.ws) + WS_XL) + (size_t)r * D;
        for (int c = tid; c < D; c += 512) dbg_err(F, 2 + which, xr[c], ex[s * D + c], 1.0f);
        if (which == 1) { const float* ex2 = (const float*)(fresh_ws(P.ws) + WS_DBG + 256 * 1024) + (size_t)s * 7680;
            const bf16* hr = (const bf16*)(fresh_ws(P.ws) + WS_H) + (size_t)r * D; const bf16* ar = (const bf16*)(fresh_ws(P.ws) + WS_ACT) + (size_t)r * FFD;
            for (int k = tid; k < D; k += 512) dbg_err(F, 0, bf2f(hr[k]), ex2[k], 1.0f);
            for (int j = tid; j < FFD; j += 512) dbg_err(F, 1, bf2f(ar[j]), ex2[D + j], 1.0f); }
    }
}
__device__ __forceinline__ void dbg_check_moe(Frame& F, const Params& P) {
    const int tid = fresh_tid(F.wave); LAS float* hn = (LAS float*)F.lds; LAS float* act = hn + D; LAS float* yv = act + FFE; LAS float* red = yv + D; LAS float* lg = red + 16;
    const float* modl = (const float*)(fresh_ws(P.ws) + WS_MOD) + (size_t)1 * 3 * 12288;
    for (int s = F.vcu; s < 16; s += F.G) {
        const unsigned hsh = dbg_hash(s * 2654435761u + 1234u); const int r = (int)(hsh % NLAT), v = dbg_vec(r);
        const float* xr = (const float*)(fresh_ws(P.ws) + WS_XL) + (size_t)r * D;
        float ss = 0.f; for (int k = tid; k < D; k += 512) ss += xr[k] * xr[k];
        ss = block_sum(ss, red, tid); const float rstd = 1.0f / sqrtf(ss / D + NORM_EPS);
        for (int k = tid; k < D; k += 512) { hn[k] = (xr[k] * rstd * P.in[I_GFFN][D + k]) * (1.0f + modl[(v * 6 + 4) * D + k]) + modl[(v * 6 + 3) * D + k]; yv[k] = 0.f; }
        __syncthreads();
        for (int e = 0; e < NE; ++e) { float a = 0.f; for (int k = tid; k < D; k += 512) a += hn[k] * P.in[I_RW][k * NE + e]; a = block_sum(a, red, tid); if (tid == 0) lg[e] = a + P.in[I_RB][e]; }
        __syncthreads();
        int i0 = 0; for (int e = 1; e < NE; ++e) if (lg[e] > lg[i0]) i0 = e;
        int i1 = -1; for (int e = 0; e < NE; ++e) if (e != i0 && (i1 < 0 || lg[e] > lg[i1])) i1 = e;
        const float p0 = 1.0f / (1.0f + expf(lg[i1] - lg[i0])), p1 = 1.0f - p0;
        for (int kk = 0; kk < 2; ++kk) {
            const int e = kk ? i1 : i0; const float pe = kk ? p1 : p0;
            const float* wg = P.in[I_MG] + (size_t)e * D * FFE; const float* wu = P.in[I_MU] + (size_t)e * D * FFE; const float* wd = P.in[I_MD] + (size_t)e * FFE * D;
            for (int j = tid; j < FFE; j += 512) { float g = 0.f, u = 0.f; for (int k = 0; k < D; ++k) { g += hn[k] * wg[(size_t)k * FFE + j]; u += hn[k] * wu[(size_t)k * FFE + j]; } act[j] = g / (1.0f + expf(-g)) * u; }
            __syncthreads();
            for (int c = tid; c < D; c += 512) { float a = 0.f; for (int j = 0; j < FFE; ++j) a += act[j] * wd[(size_t)j * D + c]; yv[c] += pe * a; }
            __syncthreads();
        }
        float q = 0.f; for (int c = tid; c < D; c += 512) { const float o = xr[c] + modl[(v * 6 + 5) * D + c] * yv[c]; yv[c] = o; q += o * o; }
        q = block_sum(q, red, tid); const float rs = 1.0f / sqrtf(q / D + NORM_EPS);
        for (int c = tid; c < D; c += 512) dbg_err(F, 4, P.out[(size_t)r * D + c], yv[c] * rs * P.in[I_GFIN][c], 1.0f);
        if (tid == 0) { const int* te = (const int*)(fresh_ws(P.ws) + WS_ROUTE); const float* tp = (const float*)(te + 4 * NLAT);
            const bool close = fabsf(lg[i1] - lg[i0]) < 1e-3f;
            if (!close) { dbg_err(F, 5, (float)te[2 * r], (float)i0, 1.0f); dbg_err(F, 5, tp[2 * r], p0, 1.0f); } }
        __syncthreads();
    }
}
__device__ __forceinline__ void dbg_report(Frame& F, const Params& P) {
    const int tid = fresh_tid(F.wave);
    for (size_t i = (size_t)F.vcu * 512 + tid; i < (size_t)NLAT * D; i += (size_t)F.G * 512) P.out[i] = 0.f;
    if (F.vcu == 0 && tid == 0) {
#if DBG_REPORT >= 0
        const float e = __uint_as_float(__hip_atomic_load(F.ctl + CW_DIAG + 64 * DBG_REPORT, RLX_AGENT));
        int bucket = 0; { float t = e * 1024.0f; while (t >= 2.0f && bucket < 60) { t *= 0.5f; ++bucket; } }
        P.out[0] = 1000.0f * (float)(10 + bucket);
#else
        const float thr[6] = {0.06f, 0.06f, 0.08f, 0.08f, 0.06f, 0.06f}; int mask = 0;
        for (int k = 0; k < 6; ++k) { const float e = __uint_as_float(__hip_atomic_load(F.ctl + CW_DIAG + 64 * k, RLX_AGENT)); if (e > thr[k]) mask |= 1 << k; }
        P.out[0] = 1000.0f * (float)(10 + mask);
#endif
    }
}
#endif
#ifndef EN_PRO
#define EN_PRO 1
#endif
#ifndef EN_NORM
#define EN_NORM 1
#endif
#ifndef EN_GIN
#define EN_GIN 1
#endif
#ifndef EN_CONV
#define EN_CONV 1
#endif
#ifndef EN_S1
#define EN_S1 1
#endif
#ifndef EN_S2
#define EN_S2 1
#endif
#ifndef EN_S3
#define EN_S3 1
#endif
#ifndef EN_ATT
#define EN_ATT 1
#endif
#ifndef EN_WOUT
#define EN_WOUT 1
#endif
#ifndef EN_GU
#define EN_GU 1
#endif
#ifndef EN_DN
#define EN_DN 1
#endif
#ifndef EN_ROUTE
#define EN_ROUTE 1
#endif
#ifndef EN_GATH
#define EN_GATH 1
#endif
#ifndef EN_MGU
#define EN_MGU 1
#endif
#ifndef EN_MDN
#define EN_MDN 1
#endif
#ifndef EN_FIN
#define EN_FIN 1
#endif
__global__ void __launch_bounds__(NWAVES * 64, 2) fwd_kernel(Params P) {
    extern __shared__ __attribute__((aligned(16))) unsigned char lds[];
    Frame F;
    F.lds = (LAS unsigned char*)lds;
    F.MISC = (volatile LAS unsigned*)(F.lds + MISC_OFF);
    F.wave = __builtin_amdgcn_readfirstlane(threadIdx.x >> 6);
    F.G = gridDim.x; { const int bx = blockIdx.x; F.vcu = (F.G % 8 == 0) ? (bx % 8) * (F.G / 8) + bx / 8 : bx; }
    unsigned char* ws = P.ws;
    F.ctl = (gu32*)(ws + WS_CTL);
    for (int u = threadIdx.x; u < (LDS_BYTES - LDSCTL_OFF) / 4; u += NWAVES * 64) ((LAS unsigned*)(F.lds + LDSCTL_OFF))[u] = 0u;
    __syncthreads();
    XcdBarrier bar = xcd_barrier_post((unsigned*)(ws + WS_CTL) + CW_BAR, F.MISC + 8);
#if DBG == 2
    unsigned long long* tsb = (unsigned long long*)(ws + WS_ROUTE + 512 * 1024); int nst = 0;
#define STAMP() do { if (blockIdx.x == 0 && threadIdx.x == 0) tsb[nst] = __builtin_amdgcn_s_memrealtime(); ++nst; } while (0)
    STAMP();
#else
#define STAMP() do {} while (0)
#endif
#if SIMPLE_BAR
    unsigned nbar = 0;
#define GRID_BAR() do { ++nbar; simple_barrier((unsigned*)(ws + WS_CTL) + 2048, nbar * (unsigned)gridDim.x); } while (0)
#else
#define GRID_BAR() do { xcd_barrier(bar); STAMP(); } while (0)
#endif

    bf16* xl = (bf16*)(ws + WS_XL); bf16* hb = (bf16*)(ws + WS_H); bf16* cat = (bf16*)(ws + WS_CAT);
    const float* mod = (const float*)(ws + WS_MOD);
    int* tok_e = (int*)(ws + WS_ROUTE); int* tok_slot = tok_e + 2 * NLAT; float* tok_p = (float*)(tok_slot + 2 * NLAT);

#if DUP_BAR
    for (int i_ = 0; i_ < DUP_BAR; ++i_) GRID_BAR();
#endif
#if EN_PRO
    p0_prologue(F, P);
#if DUP_PRO
    __syncthreads(); if (NOSTORE_PROBE) { if (threadIdx.x == 0) g_nostore = 1; __syncthreads(); } p0_prologue(F, P); if (NOSTORE_PROBE) { __syncthreads(); if (threadIdx.x == 0) g_nostore = 0; __syncthreads(); }
#endif
#endif
    GRID_BAR();

    constexpr int G0 = 256, RM_A = ((T / 256) * (NIN / 256)) % G0, RM_B = (NCH * NB * 8) % G0, RM_C = ((T / 256) * (2 * FFD / 256)) % G0;
    constexpr int CAP_T = (IPW_T > 0) ? (G0 - 32) * NWAVES * IPW_T + 24 * NWAVES * (IPW_T - 1) : 0;
    constexpr int DP_A0 = 0, DP_B0 = DP_A0 + (G0 - RM_A) * NWAVES * IPW_G, DP_T0 = DP_B0 + (G0 - RM_B) * NWAVES * IPW_S, DP_C0 = DP_T0 + CAP_T, DP_A1 = DP_C0 + (G0 - RM_C) * NWAVES * IPW_G,
                  DP_B1 = DP_A1 + (G0 - RM_A) * NWAVES * IPW_G, DP_END = DP_B1 + (G0 - RM_B) * NWAVES * IPW_S;
    static_assert(DP_A1 >= CV_IN + CV_OUT, "layer 1's w_in / w_out must be converted during layer 0");
    const bool slots = DEFER && (F.G == G0);
#define TAIL_SLOT(rem, myidx, ipw, dpos) do { if (slots && (myidx) >= (rem)) deferred_slot(F, P, (dpos), (myidx) - (rem), G0 - (rem), (ipw)); } while (0)
    for (int layer = 0; layer < 2; ++layer) {
        ws = fresh_ws(P.ws); F.wave = fresh_s(F.wave); F.vcu = fresh_s(F.vcu); F.G = fresh_s(F.G);
        const float* modl = mod + (size_t)layer * 3 * 12288;
        const void* resLat = layer == 0 ? (const void*)P.in[I_X] : (const void*)xl; const void* resCtx = layer == 0 ? (const void*)P.in[I_CTX] : (const void*)(xl + (size_t)NLAT * D);
#if EN_NORM
        if (layer == 0) norm_phase<false, I8_IN ? 2 : 0, false, false>(F, resLat, resCtx, P.in[I_GMIX] + layer * D, modl, 0, 1, hb, T, nullptr, nullptr, nullptr, nullptr, nullptr, nullptr, 11, nullptr, nullptr, (float*)(ws + WS_HS));
        else norm_phase<false, I8_IN ? 2 : 0, true, true>(F, resLat, resCtx, P.in[I_GMIX] + layer * D, modl, 0, 1, hb, T, nullptr, nullptr, nullptr, nullptr, nullptr,
                          (const float*)(ws + WS_PART), 11, mod + (size_t)(2 * 6 + 5) * D, nullptr, (float*)(ws + WS_HS));
#if DUP_SMALL & 16
        norm_phase<false>(F, resLat, resCtx, P.in[I_GMIX] + layer * D, modl, 0, 1, hb, T, nullptr, nullptr, nullptr, nullptr, nullptr);
#endif
#endif
        GRID_BAR();
#if DBG == 1
        if ((DBG_MASK & 32) && layer == DBG_L) { dbg_check_norm(F, P, layer); }
#endif
        {
            pg8::PlainSched S; S.init(T / 256, NIN / 256, F.G, (int)blockIdx.x); S.A = (const char*)hb; S.Bt = (const char*)(ws + WS_WIN + layer * SZ_WIN); S.tstep = (size_t)256 * D * (I8_IN ? 1 : 2);
            pg8::EpiIn E{(bf16*)(ws + WS_CONV), (bf16*)(ws + WS_Z), (bf16*)(ws + WS_Q), (bf16*)(ws + WS_XBC), (bf16*)(ws + WS_KB), (bf16*)(ws + WS_VB), (float*)(ws + WS_DT),
                         (const float*)(ws + WS_ROPE), (const float*)(ws + WS_ROPE) + 192 * 16, ws + WS_K8, ws + WS_V8};
            if (V8_DIRECT) { S.swap_from = 20; S.swap_to = 24; }
#if EN_GIN && I8_IN
#if DUP_GIN
            pg8::gemm_phase<pg8::EpiIn, pg8::PlainSched, true, true, 2>(F.lds + RING_OFF, D / 2, S, E, F.wave, DUP_GIN == 2 ? 8 : 0, 0, 0, (const float*)(ws + WS_HS), (const float*)(ws + WS_CS) + CS_WIN + layer * 6400); __syncthreads();
#endif
            pg8::gemm_phase<pg8::EpiIn, pg8::PlainSched, true, true, 2>(F.lds + RING_OFF, D / 2, S, E, F.wave, 0, 0, 0, (const float*)(ws + WS_HS), (const float*)(ws + WS_CS) + CS_WIN + layer * 6400);
            TAIL_SLOT(RM_A, (int)blockIdx.x, IPW_G, layer ? DP_A1 : DP_A0);
#elif EN_GIN
            pg8::gemm_phase<pg8::EpiIn, pg8::PlainSched, true, true>(F.lds + RING_OFF, D, S, E, F.wave);
#if DUP_GIN
            __syncthreads(); pg8::gemm_phase<pg8::EpiIn, pg8::PlainSched, true, true>(F.lds + RING_OFF, D, S, E, F.wave);
#endif
#endif
        }
        GRID_BAR();
#if DBG == 1
        if ((DBG_MASK & 1) && layer == DBG_L) { dbg_check_inproj(F, P, layer); }
#endif
#if EN_CONV
        conv_phase(F, (const bf16*)(ws + WS_CONV), (const bf16*)(ws + WS_XBC), cat, (bf16*)(ws + WS_XBCC), P.in[I_CONVW] + layer * 1536, P.in[I_SCONVW] + layer * 3072, P.in[I_SCONVB] + layer * 1024);
#if ATT_FP8 && ATT_DMA && !V8_DIRECT
        v8_phase(F, P);
#endif
#if DUP_SMALL & 8
        conv_phase(F, (const bf16*)(ws + WS_CONV), (const bf16*)(ws + WS_XBC), cat, (bf16*)(ws + WS_XBCC), P.in[I_CONVW] + layer * 1536, P.in[I_SCONVW] + layer * 3072, P.in[I_SCONVB] + layer * 1024);
#endif
#endif
        GRID_BAR();
#if EN_S1
#if DUP_S1V
        ssd_local_phase<DUP_S1V>(F, P, layer);
#endif
        ssd_local_phase(F, P, layer);
        TAIL_SLOT(RM_B, F.vcu, IPW_S, layer ? DP_B1 : DP_B0);
#if DUP_SMALL & 1
        ssd_local_phase(F, P, layer);
#endif
#endif
        GRID_BAR();
#if EN_S2
        ssd_scan_phase(F, P);
#if DUP_SMALL & 2
        ssd_scan_phase(F, P);
#endif
#endif
        GRID_BAR();
#if EN_S3
        ssd_out_phase(F, P, layer);
#if DUP_SMALL & 4
        ssd_out_phase(F, P, layer);
#endif
#endif
#if EN_ATT
        attn_phase<0>(F, P, layer, layer == 0, lds);
        if (IPW_T > 0 && slots && layer == 0) {
            if (F.vcu >= 32) deferred_slot(F, P, DP_T0, F.vcu - 32, G0 - 32, IPW_T);
            else if (F.vcu >= 8 && IPW_T > 1) deferred_slot(F, P, DP_T0 + (G0 - 32) * NWAVES * IPW_T, F.vcu - 8, 24, IPW_T - 1);
        }
#if DUP_ATT
        attn_phase<DUP_ATT - 1>(F, P, layer, layer == 0, lds);
#endif
#endif
        GRID_BAR();
#if DBG == 1
        if (layer == DBG_L) { if (DBG_MASK & 2) dbg_check_attn(F, P, layer); if (DBG_MASK & 4) dbg_expect_rows(F, P, layer, 0); GRID_BAR(); }
#endif
        {
            pg8::PlainSched S; S.init(NLAT / 256, D / 256, F.G, (int)blockIdx.x); S.A = (const char*)cat; S.Bt = (const char*)(ws + WS_WOUT + layer * SZ_WOUT); S.tstep = (size_t)256 * D * 2;
#if EN_WOUT
            if (layer == 0) { pg8::EpiResidT<false> E{resLat, resCtx, xl, modl + 2 * D}; pg8::gemm_phase<pg8::EpiResidT<false>, pg8::PlainSched, true, true>(F.lds + RING_OFF, D, S, E, F.wave); }
            else { pg8::EpiResidT<true> E{resLat, resCtx, xl, modl + 2 * D}; pg8::gemm_phase<pg8::EpiResidT<true>, pg8::PlainSched, true, true>(F.lds + RING_OFF, D, S, E, F.wave); }
            if (layer == 0) {
                __syncthreads();
                pg8::CtxSplitSched C; C.nN = D / 256; C.nS = 8; C.G = F.G; C.c = (int)blockIdx.x; C.A = (const char*)cat; C.Bt = S.Bt; C.tstep = S.tstep; C.kslice = (size_t)(D / 8) * 2;
                pg8::EpiPartial EP{(float*)(ws + WS_PART)};
                pg8::gemm_phase<pg8::EpiPartial, pg8::CtxSplitSched, true, true>(F.lds + RING_OFF, D, C, EP, F.wave, D / 8 / 64);
            }
#endif
        }
        GRID_BAR();
#if DBG == 1
        if ((DBG_MASK & 4) && layer == DBG_L) { dbg_compare_rows(F, P, layer, 0); }
        if ((DBG_MASK & 8) && layer == 0) { dbg_expect_rows(F, P, layer, 1); GRID_BAR(); }
#endif
        if (layer == 0) {
            norm_phase<false, I8_GU ? 2 : 1, true, false>(F, xl, P.in[I_CTX], P.in[I_GFFN], modl, 3, 4, hb, T, nullptr, nullptr, nullptr, nullptr, nullptr,
                              (const float*)(ws + WS_PART), 8, modl + (size_t)(2 * 6 + 2) * D, xl, (float*)(ws + WS_HS));
            GRID_BAR();
            {
                pg8::PlainSched S; S.init(T / 256, 2 * FFD / 256, F.G, (int)blockIdx.x); S.A = (const char*)hb; S.Bt = (const char*)(ws + WS_WGU); S.tstep = (size_t)256 * D;
                pg8::EpiSwiGLU8 E{ws + WS_ACT, FFD};
#if EN_GU
#if I8_GU
                pg8::gemm_phase<pg8::EpiSwiGLU8, pg8::PlainSched, true, true, 2>(F.lds + RING_OFF, D / 2, S, E, F.wave, 0, 0, 0, (const float*)(ws + WS_HS), (const float*)(ws + WS_CS) + CS_WGU);
                TAIL_SLOT(RM_C, (int)blockIdx.x, IPW_G, DP_C0);
#else
                pg8::gemm_phase<pg8::EpiSwiGLU8, pg8::PlainSched, true, true, true>(F.lds + RING_OFF, D / 2, S, E, F.wave, 0, W8_SC8, 0x7F7F7F7F);
#endif
#endif
            }
            GRID_BAR();
            {
                pg8::PlainSched S; S.init(NLAT / 256, D / 256, F.G, (int)blockIdx.x); S.A = (const char*)(ws + WS_ACT); S.Bt = (const char*)(ws + WS_WDN); S.tstep = (size_t)256 * FFD;
                pg8::EpiResidT<true> E{xl, xl + (size_t)NLAT * D, xl, modl + 5 * D};
#if EN_DN
                pg8::gemm_phase<pg8::EpiResidT<true>, pg8::PlainSched, true, true, true>(F.lds + RING_OFF, FFD / 2, S, E, F.wave, 0, W8_SC8, pg8::ACT_SC8);
#if !NO_DNSPLIT
                {
                    __syncthreads();
                    pg8::CtxSplitSched C; C.nN = D / 256; C.nS = 11; C.G = F.G; C.c = (int)blockIdx.x; C.A = S.A; C.Bt = S.Bt; C.tstep = S.tstep; C.kslice = (size_t)512;
                    pg8::EpiPartial EP{(float*)(ws + WS_PART)};
                    pg8::gemm_phase<pg8::EpiPartial, pg8::CtxSplitSched, true, true, true>(F.lds + RING_OFF, FFD / 2, C, EP, F.wave, 4, W8_SC8, pg8::ACT_SC8);
                }
#endif
#endif
            }
            GRID_BAR();
#if DBG == 1
            if (DBG_MASK & 8) dbg_compare_rows(F, P, layer, 1);
#endif
        } else {
#if EN_ROUTE
#if MOE_SPARSE
            norm_phase<true, 2, true, true>(F, xl, xl + (size_t)NLAT * D, P.in[I_GFFN] + D, modl, 3, 4, (bf16*)(ws + WS_AG), NLAT, P.in[I_RW], P.in[I_RB], tok_e, tok_slot, tok_p, nullptr, 0, nullptr, nullptr, (float*)(ws + WS_AGS2));
            if (slots) deferred_rest(F, P, DP_END);
#else
            norm_phase<true, I8_GU ? 2 : 1, true, true>(F, xl, xl + (size_t)NLAT * D, P.in[I_GFFN] + D, modl, 3, 4, hb, NLAT, P.in[I_RW], P.in[I_RB], tok_e, tok_slot, tok_p, nullptr, 0, nullptr, nullptr, (float*)(ws + WS_HS));
#endif
#endif
            GRID_BAR();
#if !MOE_SPARSE
#if EN_GATH
            moe_gather_phase(F, P);
#endif
#if DEFER
            if (slots) { __syncthreads(); deferred_rest(F, P, DP_END); }
#endif
            GRID_BAR();
#endif
            {
                const MoePanels mp = moe_panels(F);
                pg8::MoeSched S; S.init(mp.ps[8], 2 * FFE / 256, F.G, (int)blockIdx.x); S.A = (const char*)(ws + WS_AG); S.Bt = (const char*)(ws + WS_MGU); S.tstep = (size_t)256 * D; S.estride = SZ_MGU / 2; S.erows = 2 * FFE; S.sparse = MOE_SPARSE; S.caprows = NLAT;
                S.ps1 = mp.ps[1]; S.ps2 = mp.ps[2]; S.ps3 = mp.ps[3]; S.ps4 = mp.ps[4]; S.ps5 = mp.ps[5]; S.ps6 = mp.ps[6]; S.ps7 = mp.ps[7];
                pg8::EpiSwiGLU8 E{ws + WS_MACT, FFE};
#if EN_MGU
#if I8_GU
                pg8::gemm_phase<pg8::EpiSwiGLU8, pg8::MoeSched, true, true, 2>(F.lds + RING_OFF, D / 2, S, E, F.wave, 0, 0, 0, (const float*)(ws + (MOE_SPARSE ? WS_AGS2 : WS_AGS)), (const float*)(ws + WS_CS) + CS_MGU);
#else
                pg8::gemm_phase<pg8::EpiSwiGLU8, pg8::MoeSched, true, true, true>(F.lds + RING_OFF, D / 2, S, E, F.wave, 0, W8_SC8, 0x7F7F7F7F);
#endif
#endif
            }
            GRID_BAR();
            {
                const MoePanels mp = moe_panels(F);
                pg8::MoeSched S; S.init(mp.ps[8], D / 256, F.G, (int)blockIdx.x); S.A = (const char*)(ws + WS_MACT); S.Bt = (const char*)(ws + WS_MDN); S.tstep = (size_t)256 * FFE; S.estride = SZ_MDN / 2; S.erows = D; S.sparse = 0; S.caprows = 0;
                S.ps1 = mp.ps[1]; S.ps2 = mp.ps[2]; S.ps3 = mp.ps[3]; S.ps4 = mp.ps[4]; S.ps5 = mp.ps[5]; S.ps6 = mp.ps[6]; S.ps7 = mp.ps[7];
                pg8::EpiBf16 E{(bf16*)(ws + WS_AG), D};
#if EN_MDN
                pg8::gemm_phase<pg8::EpiBf16, pg8::MoeSched, true, true, true>(F.lds + RING_OFF, FFE / 2, S, E, F.wave, 0, W8_SC8, pg8::ACT_SC8);
#endif
            }
            GRID_BAR();
#if EN_FIN
            final_phase(F, P, modl);
#if DUP_FIN
            final_phase(F, P, modl);
#endif
#endif
#if PROBE
            {
                typedef int v8i_ __attribute__((ext_vector_type(8)));
                const int role = (F.wave < 4) ? (PROBE == 1 || PROBE == 2 || PROBE == 4 ? 1 : (PROBE == 3 ? 2 : 0)) : (PROBE == 1 ? 1 : (PROBE == 2 || PROBE == 3 || PROBE == 5 ? 2 : 0));
                f32x16 c0 = {}, c1 = {}, c2 = {}, c3 = {}; v8i_ a = {0x38383838, 0x38383838, 0x38383838, 0x38383838, 0x38383838, 0x38383838, 0x38383838, 0x38383838};
                float x0 = 1.0f, x1 = 2.0f, x2 = 3.0f, x3 = 4.0f;
                for (int it = 0; it < 2000; ++it) {
                    if (role == 1) {
#pragma unroll
                        for (int q = 0; q < 2; ++q) {
                            c0 = __builtin_amdgcn_mfma_scale_f32_32x32x64_f8f6f4(a, a, c0, 0, 0, 0, 0x7F7F7F7F, 0, 0x7F7F7F7F); c1 = __builtin_amdgcn_mfma_scale_f32_32x32x64_f8f6f4(a, a, c1, 0, 0, 0, 0x7F7F7F7F, 0, 0x7F7F7F7F);
                            c2 = __builtin_amdgcn_mfma_scale_f32_32x32x64_f8f6f4(a, a, c2, 0, 0, 0, 0x7F7F7F7F, 0, 0x7F7F7F7F); c3 = __builtin_amdgcn_mfma_scale_f32_32x32x64_f8f6f4(a, a, c3, 0, 0, 0, 0x7F7F7F7F, 0, 0x7F7F7F7F); }
                    } else if (role == 2) {
#pragma unroll
                        for (int q = 0; q < 32; ++q) asm volatile("v_fma_f32 %0, %0, %0, %0\n\tv_fma_f32 %1, %1, %1, %1\n\tv_fma_f32 %2, %2, %2, %2\n\tv_fma_f32 %3, %3, %3, %3" : "+v"(x0), "+v"(x1), "+v"(x2), "+v"(x3));
                    }
                }
                asm volatile("" :: "v"(c0), "v"(c1), "v"(c2), "v"(c3), "v"(x0), "v"(x1), "v"(x2), "v"(x3));
            }
#endif
#if DBG == 1
            GRID_BAR(); if (DBG_MASK & 16) dbg_check_moe(F, P); GRID_BAR(); dbg_report(F, P);
#endif
#if DBG == 2
            GRID_BAR();
            { const int tid = fresh_tid(F.wave);
              for (size_t i = (size_t)F.vcu * 512 + tid; i < (size_t)NLAT * D; i += (size_t)F.G * 512) P.out[i] = 0.f;
              __syncthreads(); GRID_BAR();
              float A = 0.f, B = 0.f;
              for (int i = 0; i + 1 < nst - 1; ++i) { const float d = (float)(tsb[i + 1] - tsb[i]) * 0.01f; if ((TSEL_A >> i) & 1ull) A += d; if ((TSEL_B >> i) & 1ull) B += d; }
              for (size_t i = (size_t)F.vcu * 512 + tid; i < 1000001; i += (size_t)F.G * 512) P.out[i] = i == 0 ? A : 10.0f * B; }
#endif
        }
    }
}

extern "C" void kernel_launch(void* const* d_in, const int* in_sizes, int n_in, void* d_out, int out_size, void* d_ws, size_t ws_size, hipStream_t stream) {
    static int grid = 0;
    if (grid == 0) {
        if (n_in != 28 || in_sizes[0] != NLAT * D || out_size != NLAT * D || ws_size < WS_END) {
            fprintf(stderr, "kernel_launch: built for 28 inputs, x/out of %d floats, >= %zu bytes of workspace; got n_in %d, in0 %d, out %d, ws %zu; nothing launched\n", NLAT * D, (size_t)WS_END, n_in, n_in > 0 ? in_sizes[0] : -1, out_size, ws_size);
            grid = -1; return; }
        int dev = 0, cus = 0, per_cu = 0;
        if (hipGetDevice(&dev) != hipSuccess || hipDeviceGetAttribute(&cus, hipDeviceAttributeMultiprocessorCount, dev) != hipSuccess) { fprintf(stderr, "kernel_launch: device query failed\n"); grid = -1; return; }
        if (hipFuncSetAttribute((const void*)fwd_kernel, hipFuncAttributeMaxDynamicSharedMemorySize, LDS_BYTES) != hipSuccess) { fprintf(stderr, "kernel_launch: hipFuncSetAttribute failed\n"); grid = -1; return; }
        if (hipOccupancyMaxActiveBlocksPerMultiprocessor(&per_cu, (const void*)fwd_kernel, NWAVES * 64, LDS_BYTES) != hipSuccess || per_cu < 1)
            fprintf(stderr, "kernel_launch: note: occupancy query reports %d workgroups per CU\n", per_cu);
        (void)hipGetLastError();
        grid = cus;
    }
    if (grid < 0) return;
    if (hipMemsetAsync((char*)d_ws + WS_CTL, 0, CTL_ZERO_BYTES, stream) != hipSuccess) { fprintf(stderr, "kernel_launch: memset failed\n"); return; }
    Params p{};
    for (int i = 0; i < 28; ++i) p.in[i] = (const float*)d_in[i];
    p.out = (float*)d_out; p.ws = (unsigned char*)d_ws;
    hipLaunchKernelGGL(fwd_kernel, dim3(grid), dim3(NWAVES * 64), LDS_BYTES, stream, p);
    const hipError_t le = hipPeekAtLastError();
    if (le != hipSuccess) fprintf(stderr, "kernel_launch: launch failed: %s\n", hipGetErrorName(le));
}
```

```cpp
#ifndef DBG
#define DBG 0
#endif
#ifndef DBG_L
#define DBG_L 0
#endif
#ifndef DBG_REPORT
#define DBG_REPORT -1
#endif
#ifndef DBG_MASK
#define DBG_MASK 31
#endif
#ifndef SIMPLE_BAR
#define SIMPLE_BAR 0
#endif
#ifndef TSEL_A
#define TSEL_A 1ull
#endif
#ifndef TSEL_B
#define TSEL_B 0ull
#endif
#ifndef DUP_ATT
#define DUP_ATT 0
#endif
#ifndef DUP_GIN
#define DUP_GIN 0
#endif
#ifndef DUP_PRO
#define DUP_PRO 0
#endif
#ifndef ATT_PVPF
#define ATT_PVPF 1
#endif
#ifndef DUP_SMALL
#define DUP_SMALL 0
#endif
#ifndef ATT_NEGM
#define ATT_NEGM 1
#endif
#ifndef ATT_NOSWAP
#define ATT_NOSWAP 1
#endif
#ifndef ATT_LMFMA
#define ATT_LMFMA 0
#endif
#ifndef ATT_DMA
#define ATT_DMA 1
#endif
#ifndef ATT_FP8
#define ATT_FP8 1
#endif
#ifndef NO_DNSPLIT
#define NO_DNSPLIT 0
#endif
#ifndef ATT_QK8
#define ATT_QK8 1
#endif

#ifndef I8_CLIP
#define I8_CLIP 4.0f
#endif

#ifndef I8_IN
#define I8_IN 1
#endif
#ifndef I8_GU
#define I8_GU 1
#endif

#ifndef I8DBG
#define I8DBG 0
#endif

#ifndef ATT_PVX
#define ATT_PVX 1
#endif
#ifndef PVX_MASK
#define PVX_MASK 0x400
#endif

#ifndef ATT_Y8
#define ATT_Y8 1
#endif
#ifndef Y8_C
#define Y8_C 0.0f
#endif

#ifndef ATT_LEAD
#define ATT_LEAD 5
#endif

#ifndef ATT_STAG
#define ATT_STAG 0
#endif

#ifndef ATT_BAR2
#define ATT_BAR2 1
#endif

#ifndef DUP_MODV
#define DUP_MODV 0
#endif

#ifndef ITEM_NBFAST
#define ITEM_NBFAST 1
#endif

#ifndef DUP_BAR
#define DUP_BAR 0
#endif

#ifndef DUP_S1V
#define DUP_S1V 0
#endif

#ifndef S1_NT
#define S1_NT 0
#endif

#ifndef S1_LDSST
#define S1_LDSST 0
#endif

#ifndef ATT_PRIO
#define ATT_PRIO 0
#endif

#ifndef ATT_AB
#define ATT_AB 0
#endif

#ifndef PROBE
#define PROBE 0
#endif

#ifndef ATT_KPF
#define ATT_KPF 0
#endif

#ifndef ATT_P2
#define ATT_P2 0
#endif

#ifndef P2_KPF
#define P2_KPF 0
#endif
#ifndef P2_VPF
#define P2_VPF 0
#endif

#ifndef P2_AB
#define P2_AB 1
#endif

#ifndef TAIL2
#define TAIL2 0
#endif

#ifndef DEFER
#define DEFER 1
#endif
#ifndef IPW_G
#define IPW_G 6
#endif
#ifndef IPW_S
#define IPW_S 3
#endif

#ifndef IPW_T
#define IPW_T 0
#endif

#ifndef MOE_SPARSE
#define MOE_SPARSE 1
#endif

#ifndef NOSTORE_PROBE
#define NOSTORE_PROBE 0
#endif

#ifndef FIN_NT
#define FIN_NT 0
#endif

#ifndef DUP_FIN
#define DUP_FIN 0
#endif

#ifndef K8_DIRECT
#define K8_DIRECT 1
#endif

#ifndef Q8_DIRECT
#define Q8_DIRECT 0
#endif

#ifndef PERM_OUT
#define PERM_OUT 1
#endif

#ifndef SB16
#define SB16 1
#endif

#ifndef YD16
#define YD16 0
#endif

#ifndef CV_PAIR
#define CV_PAIR 0
#endif

#ifndef V8_DIRECT
#define V8_DIRECT 1
#endif

#ifndef V8_NOSWAP
#define V8_NOSWAP 0
#endif

#ifndef S1_PF
#define S1_PF 0
#endif

#ifndef S2_DEPTH
#define S2_DEPTH 6
#endif

#ifndef CONV_U
#define CONV_U 1
#endif
#include <hip/hip_runtime.h>
#include <cstdio>
#include <cstdint>

#define GAS __attribute__((address_space(1)))
#define LAS __attribute__((address_space(3)))
typedef unsigned short bf16;
typedef unsigned v4u __attribute__((ext_vector_type(4)));
typedef unsigned v2u __attribute__((ext_vector_type(2)));
typedef float f32x4 __attribute__((ext_vector_type(4)));
typedef float f32x2 __attribute__((ext_vector_type(2)));
typedef float f32x16 __attribute__((ext_vector_type(16)));
typedef short bf16x8 __attribute__((ext_vector_type(8)));
typedef short s16x4 __attribute__((ext_vector_type(4)));
typedef GAS unsigned gu32;
#define RLX_AGENT __ATOMIC_RELAXED, __HIP_MEMORY_SCOPE_AGENT
#define LDS_WAIT() asm volatile("s_waitcnt lgkmcnt(0)" ::: "memory")
#define VM_WAIT() asm volatile("s_waitcnt vmcnt(0)" ::: "memory")

constexpr int D = 2048, NB = 2, SEQ = 8192, CTXL = 256;
constexpr int NLAT = NB * SEQ, NCTX = NB * CTXL, T = NLAT + NCTX;
constexpr int KVLEN = CTXL + SEQ;
constexpr int IN_COLS = 6160, NIN = 6400;
constexpr int COL_Z = 1536, COL_Q = 2048, COL_XBC = 3072, COL_DT = 4096, COL_K = 4112, COL_V = 5136;
constexpr int FFD = 5632, FFE = 2816, NE = 8;
constexpr int NCH = 66;
constexpr float NORM_EPS = 1e-6f;
constexpr int NWAVES = 8;

constexpr size_t MiB = 1u << 20;
constexpr size_t WS_CTL = 0, CTL_ZERO_BYTES = 1 * MiB;
constexpr size_t WS_MOD = 1 * MiB;
constexpr size_t WS_ROPE = WS_MOD + 512 * 1024;
constexpr size_t WS_TOT = WS_ROPE + 64 * 1024;
constexpr size_t WS_ROUTE = 2 * MiB;
constexpr size_t WS_HS = 2 * MiB + 512 * 1024;
constexpr size_t WS_AGS = WS_HS + 256 * 1024;
constexpr size_t WS_AGS2 = 3 * MiB + 512 * 1024;
constexpr size_t WS_CS = 3 * MiB;
constexpr size_t CS_WIN = 0, CS_WGU = 2 * 6400, CS_MGU = CS_WGU + 11264;
constexpr size_t WS_W = 4 * MiB;
constexpr size_t SZ_WIN = (size_t)NIN * D * 2, SZ_WOUT = (size_t)D * D * 2, SZ_WGU = (size_t)2 * FFD * D * 2, SZ_WDN = (size_t)D * FFD * 2;
constexpr size_t SZ_MGU = (size_t)2 * FFE * D * 2, SZ_MDN = (size_t)D * FFE * 2;
constexpr size_t WS_WIN = WS_W, WS_WOUT = WS_WIN + 2 * SZ_WIN, WS_WGU = WS_WOUT + 2 * SZ_WOUT, WS_WDN = WS_WGU + SZ_WGU, WS_MGU = WS_WDN + SZ_WDN, WS_MDN = WS_MGU + NE * SZ_MGU;
constexpr size_t WS_XL = WS_MDN + NE * SZ_MDN;
constexpr size_t WS_H = WS_XL + (size_t)T * D * 4;
constexpr size_t WS_CAT = WS_H + (size_t)T * D * 2;
constexpr size_t WS_TMP = WS_CAT + (size_t)T * D * 2;
constexpr size_t WS_CONV = WS_TMP;
constexpr size_t WS_Z = WS_CONV + (size_t)T * 1536 * 2;
constexpr size_t WS_Q = WS_Z + (size_t)T * 512 * 2;
constexpr size_t WS_XBC = WS_Q + (size_t)T * 1024 * 2;
constexpr size_t WS_KB = WS_XBC + (size_t)T * 1024 * 2;
constexpr size_t WS_VB = WS_KB + (size_t)T * 1024 * 2;
constexpr size_t WS_DT = WS_VB + (size_t)T * 1024 * 2;
constexpr size_t WS_XBCC = WS_DT + (size_t)T * 16 * 4;
constexpr size_t WS_YD = WS_XBCC + (size_t)T * 1024 * 2;
constexpr size_t WS_CUM = WS_YD + (size_t)T * 512 * 4;
constexpr size_t WS_SB = WS_CUM + (size_t)T * 16 * 4;
constexpr size_t WS_HP = WS_SB + (size_t)32 * NCH * 8192 * 4;
constexpr size_t WS_TMP_END_MIX = WS_HP + (size_t)32 * NCH * 8192 * 2;
constexpr size_t WS_ACT = WS_TMP;
constexpr int MOE_MAXROWS = 2 * NLAT + NE * 256;
constexpr size_t WS_AG = WS_TMP;
#if MOE_SPARSE
constexpr size_t WS_MACT = WS_AG + (size_t)NE * NLAT * D;
constexpr size_t WS_TMP_END_MOE = WS_MACT + (size_t)MOE_MAXROWS * FFE;
#else
constexpr size_t WS_MACT = WS_AG + (size_t)MOE_MAXROWS * D * 2;
constexpr size_t WS_TMP_END_MOE = WS_MACT + (size_t)MOE_MAXROWS * FFE * 2;
#endif
constexpr size_t WS_PART = WS_TMP + 200 * MiB;
constexpr size_t WS_V8 = (WS_TMP_END_MIX > WS_TMP_END_MOE ? WS_TMP_END_MIX : WS_TMP_END_MOE);
constexpr size_t WS_K8 = WS_V8 + (size_t)NB * (KVLEN / 64) * 8 * 8192;
constexpr size_t WS_END = WS_K8 + (size_t)NB * (KVLEN / 64) * 8 * 8192;
static_assert(WS_PART + (size_t)11 * NCTX * D * 4 <= WS_V8 && WS_PART >= WS_ACT + (size_t)T * FFD * 2, "partials");
static_assert(WS_ACT + (size_t)T * FFD * 2 <= WS_END, "act fits");
constexpr int CW_TMO = 0, CW_CODE = 1;
constexpr int CW_BAR = 4096;
constexpr int CW_CNT = 8192;
constexpr int CW_DIAG = 12288;

constexpr int RING_OFF = 0, RING_BYTES = 131072;
constexpr int LDSCTL_OFF = RING_BYTES, MISC_OFF = LDSCTL_OFF + 320;
constexpr int LDS_BYTES = 147456;

__device__ __forceinline__ unsigned f2bf(float f) { unsigned u = __builtin_bit_cast(unsigned, f); return (u + 0x7fffu + ((u >> 16) & 1u)) >> 16; }
__device__ __forceinline__ unsigned pk2(float lo, float hi) { return f2bf(lo) | (f2bf(hi) << 16); }
__device__ __forceinline__ unsigned cvtpk(float lo, float hi) { unsigned r; asm volatile("v_cvt_pk_bf16_f32 %0, %1, %2" : "=v"(r) : "v"(lo), "v"(hi)); return r; }
__device__ __forceinline__ float bf2f(unsigned short b) { return __builtin_bit_cast(float, ((unsigned)b) << 16); }
__device__ __forceinline__ float bflo(unsigned w) { return __builtin_bit_cast(float, w << 16); }
__device__ __forceinline__ float bfhi(unsigned w) { return __builtin_bit_cast(float, w & 0xffff0000u); }
__device__ __forceinline__ float fast_exp(float x) { return __builtin_amdgcn_exp2f(x * 1.4426950408889634f); }
__device__ __forceinline__ float silu_f(float x) { return x * __builtin_amdgcn_rcpf(1.0f + fast_exp(-x)); }
__device__ __forceinline__ float dpp_f(float v, const int ctrl_sel) {
    int r;
    switch (ctrl_sel) {
        case 0: r = __builtin_amdgcn_update_dpp(0, __builtin_bit_cast(int, v), 0xB1, 0xF, 0xF, true); break;
        case 1: r = __builtin_amdgcn_update_dpp(0, __builtin_bit_cast(int, v), 0x4E, 0xF, 0xF, true); break;
        case 2: r = __builtin_amdgcn_update_dpp(0, __builtin_bit_cast(int, v), 0x141, 0xF, 0xF, true); break;
        default: r = __builtin_amdgcn_update_dpp(0, __builtin_bit_cast(int, v), 0x140, 0xF, 0xF, true); break;
    }
    return __builtin_bit_cast(float, r);
}
__device__ __forceinline__ float half_sum(float v) {
    v += dpp_f(v, 0); v += dpp_f(v, 1); v += dpp_f(v, 2); v += dpp_f(v, 3);
    v += __builtin_bit_cast(float, __builtin_amdgcn_ds_swizzle(__builtin_bit_cast(int, v), 0x401F));
    return v;
}
__device__ __forceinline__ void swap32u(unsigned& a, unsigned& b) {
    asm volatile("s_nop 1\n\tv_permlane32_swap_b32 %0, %1\n\ts_nop 1" : "+v"(a), "+v"(b));
}
__device__ __forceinline__ void swap32(float v, float& x, float& y) {
    unsigned a = __builtin_bit_cast(unsigned, v), b = a; swap32u(a, b);
    x = __builtin_bit_cast(float, a); y = __builtin_bit_cast(float, b);
}
__device__ __forceinline__ float wave_sum(float v) {
    v = half_sum(v);
    float x, y; swap32(v, x, y); return x + y;
}
__device__ __forceinline__ f32x4 ld4_f32(const float* p) { return *(const f32x4*)p; }
__device__ __forceinline__ f32x4 ld4_bf16(const unsigned short* p) { const v2u w = *(const v2u*)p; f32x4 r; r[0] = bflo(w.x); r[1] = bfhi(w.x); r[2] = bflo(w.y); r[3] = bfhi(w.y); return r; }
__device__ __forceinline__ void st4_bf16(unsigned short* p, const f32x4& v) { v2u w; w.x = cvtpk(v[0], v[1]); w.y = cvtpk(v[2], v[3]); *(v2u*)p = w; }
__device__ __forceinline__ float wave_max(float v) {
    v = fmaxf(v, dpp_f(v, 0)); v = fmaxf(v, dpp_f(v, 1)); v = fmaxf(v, dpp_f(v, 2)); v = fmaxf(v, dpp_f(v, 3));
    v = fmaxf(v, __builtin_bit_cast(float, __builtin_amdgcn_ds_swizzle(__builtin_bit_cast(int, v), 0x401F)));
    float x, y; swap32(v, x, y); return fmaxf(x, y);
}
__device__ __forceinline__ unsigned pk_i8(float a, float b, float c, float d) {
    const float M = 12582912.0f;
    const unsigned ua = __builtin_bit_cast(unsigned, a + M), ub = __builtin_bit_cast(unsigned, b + M), uc = __builtin_bit_cast(unsigned, c + M), ud = __builtin_bit_cast(unsigned, d + M);
    return __builtin_amdgcn_perm(ub, ua, 0x0c0c0400u) | (__builtin_amdgcn_perm(ud, uc, 0x0c0c0400u) << 16);
}
__device__ __forceinline__ float cross_max(float v) { float x, y; swap32(v, x, y); return fmaxf(x, y); }
__device__ __forceinline__ float cross_sum(float v) { float x, y; swap32(v, x, y); return x + y; }

__device__ __forceinline__ int lane_id() { int l; asm volatile("v_mbcnt_lo_u32_b32 %0, -1, 0\n\tv_mbcnt_hi_u32_b32 %0, -1, %0" : "=v"(l)); return l; }
__device__ __forceinline__ int fresh_tid(int wave) { return wave * 64 + lane_id(); }
__device__ __forceinline__ int fresh_s(int v) { asm volatile("" : "+s"(v)); return v; }
__device__ __forceinline__ unsigned char* fresh_ws(unsigned char* p) { unsigned z = 0; asm volatile("" : "+s"(z)); return p + z; }
#define XB_TMO      128
#define XB_XCNT(j)  (256  + 64 * (j))
#define XB_XSUB(j)  (1280 + 64 * (j))
#define XB_XGEN(j)  (2304 + 64 * (j))
#define XB_TOP      3328
#define XB_TOPGEN   3392
#define XCD_BAR_WORDS 3456
#define XB_SPIN_CAP (1u << 22)

__device__ __forceinline__ unsigned xb_ld(unsigned* p)              { return __hip_atomic_load(p, __ATOMIC_RELAXED, __HIP_MEMORY_SCOPE_AGENT); }
__device__ __forceinline__ unsigned xb_add(unsigned* p, unsigned v) { return __hip_atomic_fetch_add(p, v, __ATOMIC_RELAXED, __HIP_MEMORY_SCOPE_AGENT); }
__device__ __forceinline__ unsigned xb_xcc_id() { return (unsigned)__builtin_amdgcn_s_getreg((3 << 11) | 20) & 0xFu; }
#define XB_SPIN(cond, bar) do { unsigned _sp = 0; while (cond) { __builtin_amdgcn_s_sleep(1); \
    if ((++_sp & 255u) == 0u) { if (xb_ld(&(bar)[XB_TMO])) break; if (_sp > XB_SPIN_CAP) { atomicAdd(&(bar)[XB_TMO], 1u); break; } } } } while (0)

struct XcdBarrier { unsigned* bar; unsigned x; volatile LAS unsigned* st; int wave; };

__device__ __forceinline__ XcdBarrier xcd_barrier_post(unsigned* bar, volatile LAS unsigned* st) {
    XcdBarrier b; b.bar = bar; b.x = xb_xcc_id(); b.st = st; b.wave = __builtin_amdgcn_readfirstlane(threadIdx.x >> 6);
    if (threadIdx.x == 0) (void)xb_add(&bar[XB_XCNT(b.x)], 1u);
    return b;
}
__device__ __forceinline__ void xcd_barrier_complete(unsigned* bar, unsigned x, unsigned& nloc, unsigned& nx) {
    const unsigned G = gridDim.x * gridDim.y * gridDim.z;
    unsigned sum, cnt, mine, sp = 0u;
    for (;;) {
        sum = 0u; cnt = 0u; mine = 0u;
#pragma unroll
        for (unsigned j = 0; j < 16; ++j) { const unsigned c = xb_ld(&bar[XB_XCNT(j)]); sum += c; cnt += (c > 0u) ? 1u : 0u; mine = (j == x) ? c : mine; }
        if (sum == G) break;
        __builtin_amdgcn_s_sleep(1);
        if ((++sp & 255u) == 0u) { if (xb_ld(&bar[XB_TMO])) break; if (sp > XB_SPIN_CAP) { atomicAdd(&bar[XB_TMO], 1u); break; } }
    }
    nloc = mine > 0u ? mine : 1u; nx = cnt > 0u ? cnt : 1u;
}
__device__ __forceinline__ void xcd_barrier(const XcdBarrier& b) {
    asm volatile("s_waitcnt vmcnt(0)" ::: "memory");
    __syncthreads();
    if (b.wave == 0 && lane_id() == 0) {
        unsigned* bar = b.bar;
        const unsigned bx = xb_xcc_id();
        __builtin_amdgcn_s_waitcnt(0);
        unsigned nloc = b.st[0], nx = b.st[1];
        if (nloc == 0u) { xcd_barrier_complete(bar, bx, nloc, nx); b.st[0] = nloc; b.st[1] = nx; }
        const unsigned old = xb_add(&bar[XB_XSUB(bx)], 1u);
        const unsigned gen = old / nloc;
        if (old + 1u == (gen + 1u) * nloc) {
            __builtin_amdgcn_fence(__ATOMIC_RELEASE, "agent");
            asm volatile("s_waitcnt vmcnt(0)" ::: "memory");
            const unsigned og = xb_add(&bar[XB_TOP], 1u);
            const unsigned tg = og / nx;
            if (og + 1u == (tg + 1u) * nx) xb_add(&bar[XB_TOPGEN], 1u);
            else XB_SPIN(xb_ld(&bar[XB_TOPGEN]) == tg, bar);
            __builtin_amdgcn_fence(__ATOMIC_ACQUIRE, "agent");
            xb_add(&bar[XB_XGEN(bx)], 1u);
            asm volatile("s_waitcnt vmcnt(0)" ::: "memory");
        } else {
            XB_SPIN(xb_ld(&bar[XB_XGEN(bx)]) == gen, bar);
            __builtin_amdgcn_fence(__ATOMIC_ACQUIRE, "agent");
            asm volatile("s_waitcnt vmcnt(0)" ::: "memory");
        }
    }
    __syncthreads();
}

#if SIMPLE_BAR
__device__ __forceinline__ void simple_barrier(unsigned* cnt, unsigned target) {
    asm volatile("s_waitcnt vmcnt(0)" ::: "memory");
    __syncthreads();
    if (threadIdx.x == 0) {
        __threadfence();
        asm volatile("s_waitcnt vmcnt(0)" ::: "memory");
        __hip_atomic_fetch_add(cnt, 1u, __ATOMIC_RELAXED, __HIP_MEMORY_SCOPE_AGENT);
        unsigned sp = 0;
        while (__hip_atomic_load(cnt, __ATOMIC_RELAXED, __HIP_MEMORY_SCOPE_AGENT) < target) { __builtin_amdgcn_s_sleep(2); if (++sp > (1u << 24)) break; }
        __threadfence();
        asm volatile("s_waitcnt vmcnt(0)" ::: "memory");
    }
    __syncthreads();
}
#endif
namespace pg8 {
constexpr int BM = 256, BK = 64, HALF = 128, HTB = HALF * BK * 2, STAGE_BYTES = 8 * HTB, NXCD = 8, WGM = 8;
__host__ __device__ __forceinline__ int lds_byte(int r, int c) { const int st = (r >> 4) * 2 + (c >> 5), rr = r & 15, cc = c & 31, ob = rr * 64 + cc * 2; return st * 1024 + (ob ^ (((ob >> 9) & 1) << 5)); }
__host__ __device__ __forceinline__ void stage_rc(int b, int& R, int& C) { const int st = b / 1024, sb = b % 1024, swz = sb ^ (((sb >> 9) & 1) << 5); R = (st >> 1) * 16 + swz / 64; C = (st & 1) * 32 + (swz % 64) / 2; }
__host__ __device__ __forceinline__ int perm32(int rho) { const int n = rho >> 4, i = rho & 15; return 8 * (i >> 2) + 4 * n + (i & 3); }

struct Unit { int pm, pn, ks, half; };
struct OrderBase {
    int nM, nN, nwg, G, c;
    __device__ void init(int nM_, int nN_, int G_, int c_) { nM = nM_; nN = nN_; nwg = nM * nN; G = G_; c = c_; }
    __device__ bool next(int i, Unit& u) const {
        long L = (long)i * G + c; u.half = 0;
#if TAIL2
        { const int R = nwg / G, rem = nwg - R * G;
          if (rem > 0 && 2 * rem <= G && i >= R) { if (i > R || c >= 2 * rem) return false; L = (long)R * G + (c >> 1); u.half = 1 + (c & 1); } }
#endif
        if (L >= nwg) return false;
        int wgid = (int)L; { const int q = nwg / NXCD, r = nwg % NXCD, xcd = wgid % NXCD, off = wgid / NXCD; wgid = (xcd < r ? xcd * (q + 1) : r * (q + 1) + (xcd - r) * q) + off; }
        const int nig = WGM * nN, gid = wgid / nig, fm = gid * WGM, gsz = (nM - fm) < WGM ? (nM - fm) : WGM;
        u.pm = fm + ((wgid % nig) % gsz); u.pn = (wgid % nig) / gsz; u.ks = 0; return true;
    }
};
struct PlainSched : OrderBase {
    const char* A; const char* Bt; size_t tstep; int swap_from = 1 << 30, swap_to = 0;
    __device__ __forceinline__ bool swapped(const Unit& u) const { return u.pn >= swap_from && u.pn < swap_to; }
    __device__ __forceinline__ const char* abase(const Unit& u) const { return swapped(u) ? Bt + (size_t)u.pn * tstep : A + (size_t)u.pm * tstep; }
    __device__ __forceinline__ const char* bbase(const Unit& u) const { return swapped(u) ? A + (size_t)u.pm * tstep : Bt + (size_t)u.pn * tstep; }
    __device__ __forceinline__ int brow(const Unit& u) const { return u.pn * 256; }
    __device__ __forceinline__ int arow(const Unit& u) const { return u.pm * 256; }
};
struct MoeSched : OrderBase {
    const char* A; const char* Bt; size_t tstep, estride; int ps1, ps2, ps3, ps4, ps5, ps6, ps7, erows;
    __device__ __forceinline__ int expert(int pm) const { return (pm >= ps1) + (pm >= ps2) + (pm >= ps3) + (pm >= ps4) + (pm >= ps5) + (pm >= ps6) + (pm >= ps7); }
    __device__ __forceinline__ bool swapped(const Unit&) const { return false; }
    int sparse, caprows;
    __device__ __forceinline__ int pstart(int pm) const { int p0 = 0; p0 = pm >= ps1 ? ps1 : p0; p0 = pm >= ps2 ? ps2 : p0; p0 = pm >= ps3 ? ps3 : p0; p0 = pm >= ps4 ? ps4 : p0; p0 = pm >= ps5 ? ps5 : p0; p0 = pm >= ps6 ? ps6 : p0; p0 = pm >= ps7 ? ps7 : p0; return p0; }
    __device__ __forceinline__ int arow(const Unit& u) const { return sparse ? expert(u.pm) * caprows + (u.pm - pstart(u.pm)) * 256 : u.pm * 256; }
    __device__ __forceinline__ const char* abase(const Unit& u) const { return A + (size_t)arow(u) * (tstep >> 8); }
    __device__ __forceinline__ const char* bbase(const Unit& u) const { return Bt + (size_t)expert(u.pm) * estride + (size_t)u.pn * tstep; }
    __device__ __forceinline__ int brow(const Unit& u) const { return expert(u.pm) * erows + u.pn * 256; }
};

struct CtxSplitSched {
    int nN, nS, G, c; const char* A; const char* Bt; size_t tstep; size_t kslice;
    __device__ bool next(int i, Unit& u) const { const int L = i * G + c; if (L >= 2 * nN * nS) return false; u.pm = 64 + (L & 1); u.pn = (L >> 1) % nN; u.ks = (L >> 1) / nN; u.half = 0; return true; }
    __device__ __forceinline__ const char* abase(const Unit& u) const { return A + (size_t)u.pm * tstep + (size_t)u.ks * kslice; }
    __device__ __forceinline__ const char* bbase(const Unit& u) const { return Bt + (size_t)u.pn * tstep + (size_t)u.ks * kslice; }
    __device__ __forceinline__ int brow(const Unit& u) const { return u.pn * 256; }
    __device__ __forceinline__ int arow(const Unit& u) const { return u.pm * 256; }
    __device__ __forceinline__ bool swapped(const Unit&) const { return false; }
};
template <class Epi, class Sched, bool ALIGN_EPI, bool SP2, int MODE = 0>
__device__ __forceinline__ void gemm_phase(LAS unsigned char* lds, const int K, const Sched& S, const Epi& E, const int wave, const int ktiles = 0, const int sc_w = 0x7F7F7F7F, const int sc_a = 0x7F7F7F7F,
                                           const float* rs = nullptr, const float* cs = nullptr) {
    constexpr bool F8 = (MODE == 1), I8 = (MODE == 2);
    const int tid = fresh_tid(wave); const int wid = __builtin_amdgcn_readfirstlane(tid >> 6), lane = tid & 63, wr = wid >> 2, wc = wid & 3, fr = lane & 15, fq = lane >> 4;
    const int nt = ktiles ? ktiles : K / BK;
    unsigned voffA[2];
#pragma unroll
    for (int i = 0; i < 2; ++i) { int R, C; stage_rc(tid * 16 + i * 8192, R, C); voffA[i] = (unsigned)(R * K + C) * 2u; }
#define voffB voffA
    const size_t kstep = (size_t)(BK * 2);
    const size_t hstep = (size_t)HALF * K * 2;
    const unsigned ldsw = (unsigned)wid * 1024u;
    const int aoff = lds_byte(wr * 64 + fr, fq * 8), boff = lds_byte(wc * 32 + fr, fq * 8);
#define PG8_SA(b, h) (((b) * 2 + (h)) * HTB)
#define PG8_SB(b, h) ((4 + (b) * 2 + (h)) * HTB)
#define PG8_STAGE(bufoff, gbase, voff) do { _Pragma("unroll") for (int _i = 0; _i < 2; ++_i) \
        __builtin_amdgcn_global_load_lds((const unsigned*)((const char*)(gbase) + (voff)[_i]), (LAS unsigned*)(lds + (bufoff) + ldsw + _i * 8192), 16, 0, 0); } while (0)
#define PG8_LDA(dst, b, h) do { if constexpr (F8) { _Pragma("unroll") for (int m = 0; m < 4; ++m) { \
            const v4i_ lo_ = *(const LAS v4i_*)(lds + PG8_SA(b, h) + aoff + m * 2048), hi_ = *(const LAS v4i_*)(lds + PG8_SA(b, h) + aoff + m * 2048 + 1024); \
            dst##8[m] = __builtin_shufflevector(lo_, hi_, 0, 1, 2, 3, 4, 5, 6, 7); } } \
        else { _Pragma("unroll") for (int m = 0; m < 4; ++m) _Pragma("unroll") for (int k = 0; k < 2; ++k) dst[m][k] = *(const LAS bf16x8*)(lds + PG8_SA(b, h) + aoff + m * 2048 + k * 1024); } } while (0)
#define PG8_LDB(dst, b, h) do { if constexpr (F8) { _Pragma("unroll") for (int n = 0; n < 2; ++n) { \
            const v4i_ lo_ = *(const LAS v4i_*)(lds + PG8_SB(b, h) + boff + n * 2048), hi_ = *(const LAS v4i_*)(lds + PG8_SB(b, h) + boff + n * 2048 + 1024); \
            dst##8[n] = __builtin_shufflevector(lo_, hi_, 0, 1, 2, 3, 4, 5, 6, 7); } } \
        else { _Pragma("unroll") for (int n = 0; n < 2; ++n) _Pragma("unroll") for (int k = 0; k < 2; ++k) dst[n][k] = *(const LAS bf16x8*)(lds + PG8_SB(b, h) + boff + n * 2048 + k * 1024); } } while (0)
#define PG8_MMA(ai, bj, At, Bt) do { __builtin_amdgcn_s_setprio(1); \
        if constexpr (F8) { _Pragma("unroll") for (int m = 0; m < 4; ++m) _Pragma("unroll") for (int n = 0; n < 2; ++n) \
            asm volatile("v_mfma_scale_f32_16x16x128_f8f6f4 %0, %1, %2, %0, %3, %4 op_sel_hi:[0,0,0]" : "+v"(acc[ai][bj][m][n]) : "v"(Bt##8[n]), "v"(At##8[m]), "v"(sc_w), "v"(sc_a)); } \
        else if constexpr (I8) { _Pragma("unroll") for (int m = 0; m < 4; ++m) _Pragma("unroll") for (int n = 0; n < 2; ++n) _Pragma("unroll") for (int k = 0; k < 2; ++k) \
            acc[ai][bj][m][n] = __builtin_bit_cast(f32x4, __builtin_amdgcn_mfma_i32_16x16x64_i8(__builtin_bit_cast(v4i_, Bt[n][k]), __builtin_bit_cast(v4i_, At[m][k]), __builtin_bit_cast(v4i_, acc[ai][bj][m][n]), 0, 0, 0)); } \
        else { _Pragma("unroll") for (int m = 0; m < 4; ++m) _Pragma("unroll") for (int n = 0; n < 2; ++n) _Pragma("unroll") for (int k = 0; k < 2; ++k) \
            acc[ai][bj][m][n] = __builtin_amdgcn_mfma_f32_16x16x32_bf16(Bt[n][k], At[m][k], acc[ai][bj][m][n], 0, 0, 0); } \
        __builtin_amdgcn_s_setprio(0); } while (0)
#define PG8_WAIT_V(n) asm volatile("s_waitcnt vmcnt(" #n ")" ::: "memory")
#define PG8_WAIT_L(n) asm volatile("s_waitcnt lgkmcnt(" #n ")" ::: "memory")
#define PG8_BAR __builtin_amdgcn_s_barrier()
#define PG8_SCHED __builtin_amdgcn_sched_barrier(0)
    Unit cur, nxt; int ui = 0;
    if (!S.next(0, cur)) return;
    f32x4 acc[2][2][4][2];
#pragma unroll
    for (int a = 0; a < 2; ++a)
#pragma unroll
        for (int b = 0; b < 2; ++b)
#pragma unroll
            for (int m = 0; m < 4; ++m)
#pragma unroll
                for (int n = 0; n < 2; ++n) acc[a][b][m][n] = (f32x4){0.f, 0.f, 0.f, 0.f};
    typedef int v8i_ __attribute__((ext_vector_type(8))); typedef int v4i_ __attribute__((ext_vector_type(4)));
    bf16x8 At[4][2], B0[2][2], B1[2][2]; v8i_ At8[4], B08[2], B18[2];
    const char* cA = S.abase(cur); const char* cB = S.bbase(cur);
    if constexpr (SP2) {
        PG8_STAGE(PG8_SB(0, 0), cB, voffB); PG8_STAGE(PG8_SB(0, 1), cB + hstep, voffB); PG8_STAGE(PG8_SA(0, 0), cA, voffA); PG8_STAGE(PG8_SA(0, 1), cA + hstep, voffA);
        if (wr == 1) PG8_BAR;
        PG8_WAIT_V(2); PG8_BAR;
        PG8_STAGE(PG8_SB(1, 0), cB + kstep, voffB); PG8_STAGE(PG8_SA(1, 0), cA + kstep, voffA); PG8_STAGE(PG8_SB(1, 1), cB + hstep + kstep, voffB);
        PG8_WAIT_V(6); PG8_BAR;
    } else {
        PG8_STAGE(PG8_SB(0, 0), cB, voffB); PG8_STAGE(PG8_SA(0, 0), cA, voffA); PG8_STAGE(PG8_SB(0, 1), cB + hstep, voffB); PG8_STAGE(PG8_SA(0, 1), cA + hstep, voffA);
        if (wr == 1) PG8_BAR;
        PG8_WAIT_V(4); PG8_BAR;
        PG8_STAGE(PG8_SB(1, 0), cB + kstep, voffB); PG8_STAGE(PG8_SA(1, 0), cA + kstep, voffA); PG8_STAGE(PG8_SB(1, 1), cB + hstep + kstep, voffB);
        PG8_WAIT_V(6); PG8_BAR;
    }
    for (;;) {
        const bool has_next = S.next(ui + 1, nxt);
        const char* nA = has_next ? S.abase(nxt) : cA; const char* nB = has_next ? S.bbase(nxt) : cB;
        for (int t = 0; t < nt; t += 2) {
            const bool last = (t == nt - 2);
            const char* a1 = cA + (size_t)(t + 1) * kstep;
            const char* a2 = last ? nA : cA + (size_t)(t + 2) * kstep; const char* b2 = last ? nB : cB + (size_t)(t + 2) * kstep;
            const char* a3 = a2 + kstep; const char* b3 = b2 + kstep;
            if constexpr (SP2) {
            PG8_LDB(B0, 0, 0); PG8_LDB(B1, 0, 1); PG8_SCHED; PG8_LDA(At, 0, 0); PG8_STAGE(PG8_SA(1, 1), a1 + hstep, voffA);
            PG8_WAIT_V(8); PG8_WAIT_L(0); PG8_BAR; if (!TAIL2 || cur.half != 2) { PG8_MMA(0, 0, At, B0); PG8_MMA(0, 1, At, B1); } PG8_BAR; PG8_SCHED;
            PG8_LDA(At, 0, 1); PG8_STAGE(PG8_SB(0, 0), b2, voffB); PG8_STAGE(PG8_SB(0, 1), b2 + hstep, voffB); PG8_STAGE(PG8_SA(0, 0), a2, voffA);
            PG8_WAIT_V(8); PG8_WAIT_L(0); PG8_BAR; if (!TAIL2 || cur.half != 1) { PG8_MMA(1, 0, At, B0); PG8_MMA(1, 1, At, B1); } PG8_BAR; PG8_SCHED;
            PG8_LDB(B0, 1, 0); PG8_LDB(B1, 1, 1); PG8_SCHED; PG8_LDA(At, 1, 0); PG8_STAGE(PG8_SA(0, 1), a2 + hstep, voffA);
            PG8_WAIT_V(8); PG8_WAIT_L(0); PG8_BAR; if (!TAIL2 || cur.half != 2) { PG8_MMA(0, 0, At, B0); PG8_MMA(0, 1, At, B1); } PG8_BAR; PG8_SCHED;
            PG8_LDA(At, 1, 1); PG8_STAGE(PG8_SB(1, 0), b3, voffB); PG8_STAGE(PG8_SB(1, 1), b3 + hstep, voffB); PG8_STAGE(PG8_SA(1, 0), a3, voffA);
            PG8_WAIT_V(8); PG8_WAIT_L(0); PG8_BAR; if (!TAIL2 || cur.half != 1) { PG8_MMA(1, 0, At, B0); PG8_MMA(1, 1, At, B1); } PG8_BAR; PG8_SCHED;
            } else {
            PG8_LDB(B0, 0, 0); PG8_SCHED; PG8_LDA(At, 0, 0); PG8_STAGE(PG8_SA(1, 1), a1 + hstep, voffA);
            PG8_WAIT_L(8); PG8_BAR; PG8_WAIT_L(0); PG8_MMA(0, 0, At, B0); PG8_BAR; PG8_SCHED;
            PG8_LDB(B1, 0, 1); PG8_STAGE(PG8_SB(0, 0), b2, voffB);
            PG8_BAR; PG8_WAIT_L(0); PG8_MMA(0, 1, At, B1); PG8_BAR;
            PG8_LDA(At, 0, 1); PG8_STAGE(PG8_SA(0, 0), a2, voffA);
            PG8_BAR; PG8_WAIT_L(0); PG8_MMA(1, 0, At, B0); PG8_BAR; PG8_SCHED;
            PG8_STAGE(PG8_SB(0, 1), b2 + hstep, voffB);
            PG8_WAIT_V(6); PG8_BAR; PG8_MMA(1, 1, At, B1); PG8_BAR;
            PG8_LDB(B0, 1, 0); PG8_SCHED; PG8_LDA(At, 1, 0); PG8_STAGE(PG8_SA(0, 1), a2 + hstep, voffA);
            PG8_WAIT_L(8); PG8_BAR; PG8_WAIT_L(0); PG8_MMA(0, 0, At, B0); PG8_BAR; PG8_SCHED;
            PG8_LDB(B1, 1, 1); PG8_STAGE(PG8_SB(1, 0), b3, voffB);
            PG8_BAR; PG8_WAIT_L(0); PG8_MMA(0, 1, At, B1); PG8_BAR;
            PG8_LDA(At, 1, 1); PG8_STAGE(PG8_SA(1, 0), a3, voffA);
            PG8_BAR; PG8_WAIT_L(0); PG8_MMA(1, 0, At, B0); PG8_BAR; PG8_SCHED;
            PG8_STAGE(PG8_SB(1, 1), b3 + hstep, voffB);
            PG8_WAIT_V(6); PG8_BAR; PG8_MMA(1, 1, At, B1); PG8_BAR;
            }
        }
        if constexpr (ALIGN_EPI) { if (wr == 0) PG8_BAR; }
        if constexpr (F8) asm volatile("s_nop 15\n\ts_nop 15" ::: "memory");
        if constexpr (I8) {
            const int l3_ = lane_id(); const int fr_ = l3_ & 15, fq_ = l3_ >> 4; const bool sw_ = S.swapped(cur);
            const float* rowS = sw_ ? cs + S.brow(cur) : rs + S.arow(cur); const float* colS = sw_ ? rs + S.arow(cur) : cs + S.brow(cur);
            f32x4 csv[2][2];
#pragma unroll
            for (int bj = 0; bj < 2; ++bj)
#pragma unroll
                for (int n = 0; n < 2; ++n) csv[bj][n] = *(const f32x4*)(colS + 128 * bj + 32 * wc + 16 * n + 4 * fq_);
#pragma unroll
            for (int ai = 0; ai < 2; ++ai)
#pragma unroll
                for (int m = 0; m < 4; ++m) { const float rsv = rowS[128 * ai + 64 * wr + 16 * m + fr_];
#pragma unroll
                    for (int bj = 0; bj < 2; ++bj)
#pragma unroll
                        for (int n = 0; n < 2; ++n)
#pragma unroll
                            for (int j = 0; j < 4; ++j) { const float t_ = acc[ai][bj][m][n][j];
                                acc[ai][bj][m][n][j] = (float)__float_as_int(t_) * (rsv * csv[bj][n][j]); } }
        }
        { const int l2_ = lane_id(); E(acc, cur, wr, wc, l2_ & 15, l2_ >> 4); }
        if (!has_next) break;
#pragma unroll
        for (int a = 0; a < 2; ++a)
#pragma unroll
            for (int b = 0; b < 2; ++b)
#pragma unroll
                for (int m = 0; m < 4; ++m)
#pragma unroll
                    for (int n = 0; n < 2; ++n) acc[a][b][m][n] = (f32x4){0.f, 0.f, 0.f, 0.f};
        cur = nxt; cA = nA; cB = nB; ++ui;
        if constexpr (ALIGN_EPI) { if (wr == 1) PG8_BAR; }
    }
    PG8_WAIT_V(0);
    if constexpr (!ALIGN_EPI) { if (wr == 0) PG8_BAR; }
    PG8_BAR;
#undef voffB
#undef PG8_SA
#undef PG8_SB
#undef PG8_STAGE
#undef PG8_LDA
#undef PG8_LDB
#undef PG8_MMA
#undef PG8_WAIT_V
#undef PG8_WAIT_L
#undef PG8_BAR
#undef PG8_SCHED
}
}
namespace pg8 {
__device__ __forceinline__ void st8(bf16* p, const f32x4& v0, const f32x4& v1) {
    v4u w; w.x = cvtpk(v0[0], v0[1]); w.y = cvtpk(v0[2], v0[3]); w.z = cvtpk(v1[0], v1[1]); w.w = cvtpk(v1[2], v1[3]);
    *(v4u*)p = w;
}
struct EpiIn {
    bf16 *convb, *zb, *qb, *xbcb, *kb, *vb; float* dtb; const float* ropec; const float* ropes; unsigned char* k8; unsigned char* v8;
    __device__ __forceinline__ void st_k8(int pm, int pn, int bj, int ai, int wr, int wc, int m, int fr, int fq, const f32x4& o1, const f32x4& o2) const {
        const int b = pm < 64 ? (pm >> 5) : (pm - 64), t = (pm < 64 ? CTXL / 64 + (pm & 31) * 4 : 0) + 2 * ai + wr, h = 2 * (pn - 16) + bj;
        const int chunk = (((wc >> 1) * 2 + (wc & 1)) * 2 + (fq >> 1)) * 64 + m * 16 + fr;
        const f32x4 lo = __builtin_elementwise_min(__builtin_elementwise_max(o1, (f32x4){-448.f, -448.f, -448.f, -448.f}), (f32x4){448.f, 448.f, 448.f, 448.f});
        const f32x4 hh = __builtin_elementwise_min(__builtin_elementwise_max(o2, (f32x4){-448.f, -448.f, -448.f, -448.f}), (f32x4){448.f, 448.f, 448.f, 448.f});
        v2u w;
        w.x = (unsigned)__builtin_amdgcn_cvt_pk_fp8_f32(lo[2], lo[3], __builtin_amdgcn_cvt_pk_fp8_f32(lo[0], lo[1], 0, false), true);
        w.y = (unsigned)__builtin_amdgcn_cvt_pk_fp8_f32(hh[2], hh[3], __builtin_amdgcn_cvt_pk_fp8_f32(hh[0], hh[1], 0, false), true);
        *(v2u*)(k8 + ((size_t)(b * (KVLEN / 64) + t) * 8 + h) * 8192 + chunk * 16 + 8 * (fq & 1)) = w;
    }
    __device__ __forceinline__ void st_q8(unsigned char* p, const f32x4& o1, const f32x4& o2) const {
        constexpr float C = 0.125f * 1.4426950408889634f * (ATT_Y8 ? 8.0f : 1.0f);
        const f32x4 lo = __builtin_elementwise_min(__builtin_elementwise_max(o1 * C, (f32x4){-448.f, -448.f, -448.f, -448.f}), (f32x4){448.f, 448.f, 448.f, 448.f});
        const f32x4 hh = __builtin_elementwise_min(__builtin_elementwise_max(o2 * C, (f32x4){-448.f, -448.f, -448.f, -448.f}), (f32x4){448.f, 448.f, 448.f, 448.f});
        v2u w;
        w.x = (unsigned)__builtin_amdgcn_cvt_pk_fp8_f32(lo[2], lo[3], __builtin_amdgcn_cvt_pk_fp8_f32(lo[0], lo[1], 0, false), true);
        w.y = (unsigned)__builtin_amdgcn_cvt_pk_fp8_f32(hh[2], hh[3], __builtin_amdgcn_cvt_pk_fp8_f32(hh[0], hh[1], 0, false), true);
        *(v2u*)p = w;
    }
    __device__ __forceinline__ void st_v8(const f32x4 (&acc)[2][2][4][2], int pm, int pn, int wr, int wc, int fr, int fq) const {
        const int b = pm < 64 ? (pm >> 5) : (pm - 64), t0 = (pm < 64 ? CTXL / 64 + (pm & 31) * 4 : 0) + (wc >> 1);
#pragma unroll
        for (int ai = 0; ai < 2; ++ai) { const int h = 2 * (pn - 20) + ai;
#pragma unroll
            for (int bj = 0; bj < 2; ++bj) { unsigned char* tile = v8 + ((size_t)(b * (KVLEN / 64) + t0 + 2 * bj) * 8 + h) * 8192;
#pragma unroll
                for (int m = 0; m < 4; ++m) {
                    unsigned Dw[2];
#pragma unroll
                    for (int n = 0; n < 2; ++n) { const f32x4 c = __builtin_elementwise_min(__builtin_elementwise_max(acc[ai][bj][m][n], (f32x4){-448.f, -448.f, -448.f, -448.f}), (f32x4){448.f, 448.f, 448.f, 448.f});
                        Dw[n] = (unsigned)__builtin_amdgcn_cvt_pk_fp8_f32(c[2], c[3], __builtin_amdgcn_cvt_pk_fp8_f32(c[0], c[1], 0, false), true); }
                    const int chunk = (((2 * wr + (m >> 1)) * 2 + (fq & 1)) * 2 + (wc & 1)) * 32 + 16 * (m & 1) + fr;
#if V8_NOSWAP
                    *(unsigned*)(tile + chunk * 16 + (fq >> 1) * 4) = Dw[0]; *(unsigned*)(tile + chunk * 16 + 8 + (fq >> 1) * 4) = Dw[1];
#else
                    swap32u(Dw[0], Dw[1]);
                    v2u w; w.x = Dw[0]; w.y = Dw[1];
                    *(v2u*)(tile + chunk * 16 + (fq >> 1) * 8) = w;
#endif
                } } }
    }
    __device__ __forceinline__ void operator()(const f32x4 (&acc)[2][2][4][2], const Unit& u, int wr, int wc, int fr, int fq) const {
        const int pn = u.pn, pm = u.pm;
        if (V8_DIRECT && pn >= 20 && pn < 24) { st_v8(acc, pm, pn, wr, wc, fr, fq); return; }
        if (CONV_U && pn >= 2 && pn < 6) {
            bf16* bu = convb + (size_t)pm * 256 * 1536 + 512 + 128 * (pn - 2) + wc * 32 + 8 * fq;
#pragma unroll
            for (int ai = 0; ai < 2; ++ai)
#pragma unroll
                for (int m = 0; m < 4; ++m) { const int rl = ai * 128 + wr * 64 + m * 16 + fr;
                    st8(bu + (size_t)rl * 1536, acc[ai][0][m][0] * acc[ai][0][m][1], acc[ai][1][m][0] * acc[ai][1][m][1]); }
            return;
        }
        if (pn == 24) {
            if (wc == 0) {
#pragma unroll
                for (int ai = 0; ai < 2; ++ai)
#pragma unroll
                    for (int m = 0; m < 4; ++m) { if (TAIL2 && u.half != 0 && u.half != ai + 1) continue; const int r = pm * 256 + ai * 128 + wr * 64 + m * 16 + fr; *(f32x4*)(dtb + (size_t)r * 16 + 4 * fq) = acc[ai][0][m][0]; }
            }
            return;
        }
        bf16* base; int ld, col0; bool rope = false, kv = false;
        if (pn < 6) { base = convb; ld = 1536; col0 = 256 * pn; }
        else if (pn < 8) { base = zb; ld = 512; col0 = 256 * (pn - 6); }
        else if (pn < 12) { base = qb; ld = 1024; col0 = 256 * (pn - 8); rope = pm < 64; }
        else if (pn < 16) { base = xbcb; ld = 1024; col0 = 256 * (pn - 12); }
        else if (pn < 20) { base = kb; ld = 1024; col0 = 256 * (pn - 16); rope = pm < 64; kv = true; }
        else { base = vb; ld = 1024; col0 = 256 * (pn - 20); kv = true; }
        const size_t rowbase = !kv ? (size_t)pm * 256 : (pm < 64 ? (size_t)(pm >> 5) * KVLEN + CTXL + (size_t)(pm & 31) * 256 : (size_t)(pm - 64) * KVLEN);
        bf16* bp = base + rowbase * ld + col0 + wc * 32 + 8 * fq;
        if (rope) {
#pragma unroll
            for (int ai = 0; ai < 2; ++ai)
#pragma unroll
                for (int m = 0; m < 4; ++m) { if (TAIL2 && u.half != 0 && u.half != ai + 1) continue;
                    const int rl = ai * 128 + wr * 64 + m * 16 + fr;
                    const int pos = (wc & 1) ? 128 + m * 16 + fr : 4 * (pm & 31) + 2 * ai + wr;
                    const f32x4 cs = *(const f32x4*)(ropec + pos * 16 + 4 * fq), sn = *(const f32x4*)(ropes + pos * 16 + 4 * fq);
#pragma unroll
                    for (int bj = 0; bj < 2; ++bj) {
                        const f32x4 a1 = acc[ai][bj][m][0], a2 = acc[ai][bj][m][1];
                        const f32x4 o1 = a1 * cs - a2 * sn, o2 = a2 * cs + a1 * sn;
                        if (K8_DIRECT && kv) st_k8(pm, pn, bj, ai, wr, wc, m, fr, fq, o1, o2);
                        else if (Q8_DIRECT && !kv) st_q8((unsigned char*)qb + (size_t)(pm * 16 + ai * 8 + wr * 4 + m) * 16384 + (size_t)(((col0 + bj * 128 + wc * 32) >> 3) + fq) * 128 + fr * 8, o1, o2);
                        else st8(bp + (size_t)rl * ld + bj * 128, o1, o2);
                    }
                }
        } else {
#pragma unroll
            for (int ai = 0; ai < 2; ++ai)
#pragma unroll
                for (int m = 0; m < 4; ++m) { if (TAIL2 && u.half != 0 && u.half != ai + 1) continue;
                    const int rl = ai * 128 + wr * 64 + m * 16 + fr;
#pragma unroll
                    for (int bj = 0; bj < 2; ++bj) { if (K8_DIRECT && kv && pn < 20) st_k8(pm, pn, bj, ai, wr, wc, m, fr, fq, acc[ai][bj][m][0], acc[ai][bj][m][1]);
                        else if (Q8_DIRECT && pn >= 8 && pn < 12) st_q8((unsigned char*)qb + (size_t)(pm * 16 + ai * 8 + wr * 4 + m) * 16384 + (size_t)(((col0 + bj * 128 + wc * 32) >> 3) + fq) * 128 + fr * 8, acc[ai][bj][m][0], acc[ai][bj][m][1]);
                        else st8(bp + (size_t)rl * ld + bj * 128, acc[ai][bj][m][0], acc[ai][bj][m][1]); }
                }
        }
    }
};
__device__ __forceinline__ void ld8b(const bf16* p, float (&o)[8]) { const v4u w = *(const v4u*)p; o[0] = bflo(w.x); o[1] = bfhi(w.x); o[2] = bflo(w.y); o[3] = bfhi(w.y); o[4] = bflo(w.z); o[5] = bfhi(w.z); o[6] = bflo(w.w); o[7] = bfhi(w.w); }
template <bool SRC16>
struct EpiResidT {
    const void* srcLat; const void* srcCtx; bf16* dst; const float* gate;
    __device__ __forceinline__ void operator()(const f32x4 (&acc)[2][2][4][2], const Unit& u, int wr, int wc, int fr, int fq) const {
        const int pm = u.pm; const int v = pm < 32 ? 0 : (pm < 64 ? 1 : 2);
        const float* gv = gate + (size_t)v * 6 * D;
        const size_t sro = pm < 64 ? (size_t)pm * 256 * D : (size_t)(pm - 64) * 256 * D;
        const float* s32 = (const float*)(pm < 64 ? srcLat : srcCtx) + sro; const bf16* s16 = (const bf16*)(pm < 64 ? srcLat : srcCtx) + sro;
        bf16* dp = dst + (size_t)pm * 256 * D;
#if PERM_OUT
        const int colb = u.pn * 256 + wc * 32 + 8 * fq;
        f32x4 g[2][2];
#pragma unroll
        for (int bj = 0; bj < 2; ++bj)
#pragma unroll
            for (int n = 0; n < 2; ++n) g[bj][n] = *(const f32x4*)(gv + colb + bj * 128 + n * 4);
#pragma unroll
        for (int ai = 0; ai < 2; ++ai)
#pragma unroll
            for (int m = 0; m < 4; ++m) { if (TAIL2 && u.half != 0 && u.half != ai + 1) continue;
                const size_t off = (size_t)(ai * 128 + wr * 64 + m * 16 + fr) * D + colb;
#pragma unroll
                for (int bj = 0; bj < 2; ++bj) { f32x4 s0, s1;
                    if (SRC16) { float t[8]; ld8b(s16 + off + bj * 128, t); s0 = (f32x4){t[0], t[1], t[2], t[3]}; s1 = (f32x4){t[4], t[5], t[6], t[7]}; }
                    else { s0 = ld4_f32(s32 + off + bj * 128); s1 = ld4_f32(s32 + off + bj * 128 + 4); }
                    st8(dp + off + bj * 128, s0 + g[bj][0] * acc[ai][bj][m][0], s1 + g[bj][1] * acc[ai][bj][m][1]); }
                asm volatile("" ::: "memory");
            }
#else
        const int colb = u.pn * 256 + wc * 32 + 4 * fq;
        f32x4 g[2][2];
#pragma unroll
        for (int bj = 0; bj < 2; ++bj)
#pragma unroll
            for (int n = 0; n < 2; ++n) g[bj][n] = *(const f32x4*)(gv + colb + bj * 128 + n * 16);
#pragma unroll
        for (int ai = 0; ai < 2; ++ai)
#pragma unroll
            for (int m = 0; m < 4; ++m) { if (TAIL2 && u.half != 0 && u.half != ai + 1) continue;
                const size_t off = (size_t)(ai * 128 + wr * 64 + m * 16 + fr) * D + colb;
#pragma unroll
                for (int bj = 0; bj < 2; ++bj)
#pragma unroll
                    for (int n = 0; n < 2; ++n) { const f32x4 s = SRC16 ? ld4_bf16(s16 + off + bj * 128 + n * 16) : ld4_f32(s32 + off + bj * 128 + n * 16);
                        st4_bf16(dp + off + bj * 128 + n * 16, s + g[bj][n] * acc[ai][bj][m][n]); }
                asm volatile("" ::: "memory");
            }
#endif
    }
};
struct EpiSwiGLU {
    bf16* act; int ld;
    __device__ __forceinline__ void operator()(const f32x4 (&acc)[2][2][4][2], const Unit& u, int wr, int wc, int fr, int fq) const {
        bf16* bp = act + (size_t)u.pm * 256 * ld + u.pn * 128 + wc * 32 + 8 * fq;
#pragma unroll
        for (int ai = 0; ai < 2; ++ai)
#pragma unroll
            for (int m = 0; m < 4; ++m) { if (TAIL2 && u.half != 0 && u.half != ai + 1) continue;
                const int rl = ai * 128 + wr * 64 + m * 16 + fr;
                f32x4 o[2];
#pragma unroll
                for (int bj = 0; bj < 2; ++bj) { const f32x4 g = acc[ai][bj][m][0], up = acc[ai][bj][m][1];
#pragma unroll
                    for (int j = 0; j < 4; ++j) o[bj][j] = silu_f(g[j]) * up[j]; }
                st8(bp + (size_t)rl * ld, o[0], o[1]);
            }
    }
};
constexpr float ACT_SCALE = 4.0f; constexpr int ACT_SC8 = 0x7D7D7D7D;
struct EpiSwiGLU8 {
    unsigned char* act; int ld;
    __device__ __forceinline__ void operator()(const f32x4 (&acc)[2][2][4][2], const Unit& u, int wr, int wc, int fr, int fq) const {
        unsigned char* bp = act + (size_t)u.pm * 256 * ld + u.pn * 128 + wc * 32 + 8 * fq;
#pragma unroll
        for (int ai = 0; ai < 2; ++ai)
#pragma unroll
            for (int m = 0; m < 4; ++m) { if (TAIL2 && u.half != 0 && u.half != ai + 1) continue;
                const int rl = ai * 128 + wr * 64 + m * 16 + fr;
                float o[8];
#pragma unroll
                for (int bj = 0; bj < 2; ++bj) { const f32x4 g = acc[ai][bj][m][0], up = acc[ai][bj][m][1];
#pragma unroll
                    for (int j = 0; j < 4; ++j) o[4 * bj + j] = fminf(fmaxf(silu_f(g[j]) * up[j] * ACT_SCALE, -448.f), 448.f); }
                v2u w;
                w.x = (unsigned)__builtin_amdgcn_cvt_pk_fp8_f32(o[2], o[3], __builtin_amdgcn_cvt_pk_fp8_f32(o[0], o[1], 0, false), true);
                w.y = (unsigned)__builtin_amdgcn_cvt_pk_fp8_f32(o[6], o[7], __builtin_amdgcn_cvt_pk_fp8_f32(o[4], o[5], 0, false), true);
                *(v2u*)(bp + (size_t)rl * ld) = w;
            }
    }
};
struct EpiBf16 {
    bf16* O; int ld;
    __device__ __forceinline__ void operator()(const f32x4 (&acc)[2][2][4][2], const Unit& u, int wr, int wc, int fr, int fq) const {
        bf16* bp = O + (size_t)u.pm * 256 * ld + u.pn * 256 + wc * 32 + 8 * fq;
#pragma unroll
        for (int ai = 0; ai < 2; ++ai)
#pragma unroll
            for (int m = 0; m < 4; ++m) { if (TAIL2 && u.half != 0 && u.half != ai + 1) continue;
                const int rl = ai * 128 + wr * 64 + m * 16 + fr;
#pragma unroll
                for (int bj = 0; bj < 2; ++bj) st8(bp + (size_t)rl * ld + bj * 128, acc[ai][bj][m][0], acc[ai][bj][m][1]);
                asm volatile("" ::: "memory");
            }
    }
};
struct EpiPartial {
    float* part;
    __device__ __forceinline__ void operator()(const f32x4 (&acc)[2][2][4][2], const Unit& u, int wr, int wc, int fr, int fq) const {
        float* dp = part + ((size_t)u.ks * NCTX + (size_t)(u.pm - 64) * 256) * D + u.pn * 256 + wc * 32 + (PERM_OUT ? 8 : 4) * fq;
#pragma unroll
        for (int ai = 0; ai < 2; ++ai)
#pragma unroll
            for (int m = 0; m < 4; ++m) { if (TAIL2 && u.half != 0 && u.half != ai + 1) continue;
                const size_t off = (size_t)(ai * 128 + wr * 64 + m * 16 + fr) * D;
#pragma unroll
                for (int bj = 0; bj < 2; ++bj)
#pragma unroll
                    for (int n = 0; n < 2; ++n) *(f32x4*)(dp + off + bj * 128 + n * (PERM_OUT ? 4 : 16)) = acc[ai][bj][m][n];
                asm volatile("" ::: "memory");
            }
    }
};
}
struct Params { const float* in[28]; float* out; unsigned char* ws; };
enum { I_X = 0, I_C, I_CTX, I_CCTX, I_WMOD, I_BMOD, I_GMIX, I_GFFN, I_WIN, I_CONVW, I_SCONVW, I_SCONVB, I_ALOG, I_DTB, I_SSDD, I_SNORM, I_LAMBDA, I_SUBLN, I_WOUT,
       I_FG, I_FU, I_FD, I_RW, I_RB, I_MG, I_MU, I_MD, I_GFIN };
struct Frame {
    LAS unsigned char* lds; volatile LAS unsigned* MISC; gu32* ctl;
    int wave, vcu, G;
};
struct Lane { int tid, lane; __device__ __forceinline__ Lane(int wave) { tid = fresh_tid(wave); lane = tid & 63; } };

#define g_nostore (*(volatile LAS int*)(unsigned)(MISC_OFF + 512))
__device__ __forceinline__ void tr_item(const float* colptr, int ld, bool perm, bf16* wt, int K, int k0, LAS float* scr, int lane) {
    const int j = lane & 31;
    float tv[32];
#pragma unroll
    for (int i = 0; i < 32; ++i) { const int kk = 2 * i + (lane >> 5); tv[i] = colptr[(size_t)(k0 + kk) * ld]; }
#pragma unroll
    for (int i = 0; i < 32; ++i) { const int kk = 2 * i + (lane >> 5); scr[kk * 33 + j] = tv[i]; }
    LDS_WAIT(); asm volatile("" ::: "memory");
    const int c = lane & 7;
#pragma unroll
    for (int jj = 0; jj < 4; ++jj) { const int n = (lane >> 3) + 8 * jj; const int slot = perm ? pg8::perm32(n) : n; const LAS float* s = scr + (8 * c) * 33 + slot;
        v4u o; o.x = pk2(s[0 * 33], s[1 * 33]); o.y = pk2(s[2 * 33], s[3 * 33]); o.z = pk2(s[4 * 33], s[5 * 33]); o.w = pk2(s[6 * 33], s[7 * 33]);
        if (NOSTORE_PROBE && g_nostore) { asm volatile("" :: "v"(o.x), "v"(o.y), "v"(o.z), "v"(o.w)); } else *(GAS v4u*)(wt + (size_t)n * K + k0 + 8 * c) = o; }
    LDS_WAIT(); asm volatile("" ::: "memory");
}
constexpr float W8_SCALE = 64.0f; constexpr int W8_SC8 = 0x79797979;
template <bool I8 = false, bool MAYNULL = false>
__device__ __forceinline__ void tr_item8(const float* colptr, int ld, bool perm, unsigned char* wt, int K, int k0, LAS float* scr, int lane, float mulA = 0.f, float mulB = 0.f) {
    const int j = lane & 31;
    float tv[32];
#pragma unroll
    for (int i = 0; i < 32; ++i) { const int kk = 2 * i + (lane >> 5); tv[i] = (!MAYNULL || colptr) ? colptr[(size_t)(k0 + kk) * ld] : 0.f; }
#pragma unroll
    for (int i = 0; i < 32; ++i) { const int kk = 2 * i + (lane >> 5); scr[kk * 33 + j] = tv[i]; }
    LDS_WAIT(); asm volatile("" ::: "memory");
    const int c = lane & 3;
#pragma unroll
    for (int jj = 0; jj < 2; ++jj) { const int n = (lane >> 2) + 16 * jj; const int slot = perm ? pg8::perm32(n) : n; const LAS float* s = scr + (16 * c) * 33 + slot;
        float v[16]; v4u o;
        if constexpr (I8) { const float mul = jj ? mulB : mulA;
#pragma unroll
            for (int i = 0; i < 16; ++i) v[i] = __builtin_amdgcn_fmed3f(s[i * 33] * mul, -127.f, 127.f);
            o.x = pk_i8(v[0], v[1], v[2], v[3]); o.y = pk_i8(v[4], v[5], v[6], v[7]); o.z = pk_i8(v[8], v[9], v[10], v[11]); o.w = pk_i8(v[12], v[13], v[14], v[15]);
        } else {
#pragma unroll
        for (int i = 0; i < 16; ++i) v[i] = fminf(fmaxf(s[i * 33] * W8_SCALE, -448.f), 448.f);
        o.x = (unsigned)__builtin_amdgcn_cvt_pk_fp8_f32(v[2], v[3], __builtin_amdgcn_cvt_pk_fp8_f32(v[0], v[1], 0, false), true);
        o.y = (unsigned)__builtin_amdgcn_cvt_pk_fp8_f32(v[6], v[7], __builtin_amdgcn_cvt_pk_fp8_f32(v[4], v[5], 0, false), true);
        o.z = (unsigned)__builtin_amdgcn_cvt_pk_fp8_f32(v[10], v[11], __builtin_amdgcn_cvt_pk_fp8_f32(v[8], v[9], 0, false), true);
        o.w = (unsigned)__builtin_amdgcn_cvt_pk_fp8_f32(v[14], v[15], __builtin_amdgcn_cvt_pk_fp8_f32(v[12], v[13], 0, false), true);
        }
        if (NOSTORE_PROBE && g_nostore) { asm volatile("" :: "v"(o.x), "v"(o.y), "v"(o.z), "v"(o.w)); } else *(GAS v4u*)(wt + (size_t)n * K + k0 + 16 * c) = o; }
    LDS_WAIT(); asm volatile("" ::: "memory");
}
template <bool I8, bool MAYNULL>
__device__ __forceinline__ void tr_pair8(const float* colptr, int ld, bool perm, unsigned char* wt, int K, int k0, LAS float* scr, int lane, float mulA = 0.f, float mulB = 0.f) {
    const int j = lane & 31;
#pragma unroll
    for (int hf = 0; hf < 2; ++hf) {
        float tv[32];
#pragma unroll
        for (int i = 0; i < 32; ++i) { const int kk = 64 * hf + 2 * i + (lane >> 5); tv[i] = (!MAYNULL || colptr) ? colptr[(size_t)(k0 + kk) * ld] : 0.f; }
#pragma unroll
        for (int i = 0; i < 32; ++i) { const int kk = 64 * hf + 2 * i + (lane >> 5); scr[kk * 32 + (j ^ (4 * (kk >> 4)))] = tv[i]; }
    }
    LDS_WAIT(); asm volatile("" ::: "memory");
    const int c = lane & 7;
#pragma unroll
    for (int jj = 0; jj < 4; ++jj) { const int n = (lane >> 3) + 8 * jj; const int slot = perm ? pg8::perm32(n) : n; const LAS float* s = scr + (16 * c) * 32 + (slot ^ (4 * c));
        float v[16]; v4u o;
        if constexpr (I8) { const float mul = jj >= 2 ? mulB : mulA;
#pragma unroll
            for (int i = 0; i < 16; ++i) v[i] = __builtin_amdgcn_fmed3f(s[i * 32] * mul, -127.f, 127.f);
            o.x = pk_i8(v[0], v[1], v[2], v[3]); o.y = pk_i8(v[4], v[5], v[6], v[7]); o.z = pk_i8(v[8], v[9], v[10], v[11]); o.w = pk_i8(v[12], v[13], v[14], v[15]);
        } else {
#pragma unroll
            for (int i = 0; i < 16; ++i) v[i] = fminf(fmaxf(s[i * 32] * W8_SCALE, -448.f), 448.f);
            o.x = (unsigned)__builtin_amdgcn_cvt_pk_fp8_f32(v[2], v[3], __builtin_amdgcn_cvt_pk_fp8_f32(v[0], v[1], 0, false), true);
            o.y = (unsigned)__builtin_amdgcn_cvt_pk_fp8_f32(v[6], v[7], __builtin_amdgcn_cvt_pk_fp8_f32(v[4], v[5], 0, false), true);
            o.z = (unsigned)__builtin_amdgcn_cvt_pk_fp8_f32(v[10], v[11], __builtin_amdgcn_cvt_pk_fp8_f32(v[8], v[9], 0, false), true);
            o.w = (unsigned)__builtin_amdgcn_cvt_pk_fp8_f32(v[14], v[15], __builtin_amdgcn_cvt_pk_fp8_f32(v[12], v[13], 0, false), true);
        }
        *(GAS v4u*)(wt + (size_t)n * K + k0 + 16 * c) = o; }
    LDS_WAIT(); asm volatile("" ::: "memory");
}
__device__ __forceinline__ const float* gu_colptr(const float* gate, const float* up, int nb, int j) {
    const int pn = nb >> 3, r = nb & 7, bj = r >> 2, wc = r & 3, n = j >> 4, i = j & 15, fq = i >> 2, jj = i & 3;
    return (n ? up : gate) + 128 * pn + 32 * wc + 8 * fq + 4 * bj + jj;
}

#if CV_PAIR
constexpr int CV_IN = 200 * 16, CV_OUT = 64 * 32, CV_GU = 352 * 16, CV_DN = 64 * 44, CV_MGU1 = 176 * 16, CV_MDN1 = 64 * 22;
#else
constexpr int CV_IN = 200 * 32, CV_OUT = 64 * 32, CV_GU = 352 * 32, CV_DN = 64 * 88, CV_MGU1 = 176 * 32, CV_MDN1 = 64 * 44;
#endif
constexpr int CV_NEARLY = CV_IN + CV_OUT + CV_GU + CV_DN, CV_NITEMS = 2 * CV_IN + 2 * CV_OUT + CV_GU + CV_DN + NE * CV_MGU1 + NE * CV_MDN1, CV_NDEF = CV_NITEMS - CV_NEARLY;
__device__ __forceinline__ void conv_item(Frame& F, const Params& P, int it) {
    unsigned char* ws = fresh_ws(P.ws);
    const LAS float* wsc = (const LAS float*)(F.lds + MISC_OFF + 256);
    float* csw = (float*)(ws + WS_CS);
    LAS float* scr = (LAS float*)(F.lds + F.wave * 16384);
    const int lane = lane_id(), j = lane & 31;
    int r = it, l = 0;
    if (r >= CV_NEARLY) { r -= CV_NEARLY; l = 1; }
    if (r < CV_IN) { const int nb = r % 200, kb = r / 200, n0 = 32 * nb;
        const float* w = P.in[I_WIN] + (size_t)l * D * IN_COLS; const float* cp; bool perm;
        if (CONV_U && n0 >= 512 && n0 < 1536) { cp = gu_colptr(w + 512, w + 1024, (n0 - 512) >> 5, j); perm = false; }
        else if (n0 < 4096) { cp = w + n0 + j; perm = !(n0 >= 2048 && n0 < 3072); }
        else if (n0 < 5120) { cp = w + COL_K + (n0 - 4096) + j; perm = false; }
        else if (n0 < 6144) { cp = w + COL_V + (n0 - 5120) + j; perm = !V8_DIRECT; }
        else if (n0 == 6144) { cp = j < 16 ? w + COL_DT + j : nullptr; perm = false; }
        else { cp = nullptr; perm = false; }
        const float st = wsc[l], inv = 1.0f / st;
        if (kb == 0 && lane < 32) csw[CS_WIN + l * 6400 + n0 + lane] = st;
        if (CV_PAIR) tr_pair8<true, true>(cp, IN_COLS, perm, ws + WS_WIN + l * SZ_WIN + (size_t)n0 * D, D, 128 * kb, scr, lane, inv, inv);
        else tr_item8<true, true>(cp, IN_COLS, perm, ws + WS_WIN + l * SZ_WIN + (size_t)n0 * D, D, 64 * kb, scr, lane, inv, inv);
        return; }
    r -= CV_IN;
    if (r < CV_OUT) { const int nb = r % 64, kb = r / 64, n0 = 32 * nb;
        tr_item(P.in[I_WOUT] + (size_t)l * D * D + n0 + j, D, PERM_OUT != 0, (bf16*)(ws + WS_WOUT + l * SZ_WOUT) + (size_t)n0 * D, D, 64 * kb, scr, lane); return; }
    r -= CV_OUT;
    if (l == 0) {
        if (r < CV_GU) { const int nb = r % 352, kb = r / 352;
            const float sg = wsc[2], su = wsc[3];
            if (kb == 0 && lane < 32) csw[CS_WGU + 32 * nb + lane] = lane < 16 ? sg : su;
            if (CV_PAIR) tr_pair8<true, false>(gu_colptr(P.in[I_FG], P.in[I_FU], nb, j), FFD, false, ws + WS_WGU + (size_t)(32 * nb) * D, D, 128 * kb, scr, lane, 1.0f / sg, 1.0f / su);
            else tr_item8<true>(gu_colptr(P.in[I_FG], P.in[I_FU], nb, j), FFD, false, ws + WS_WGU + (size_t)(32 * nb) * D, D, 64 * kb, scr, lane, 1.0f / sg, 1.0f / su);
            return; }
        r -= CV_GU;
        { const int nb = r % 64, kb = r / 64, n0 = 32 * nb;
          if (CV_PAIR) tr_pair8<false, false>(P.in[I_FD] + n0 + j, D, PERM_OUT != 0, ws + WS_WDN + (size_t)n0 * FFD, FFD, 128 * kb, scr, lane);
          else tr_item8(P.in[I_FD] + n0 + j, D, PERM_OUT != 0, ws + WS_WDN + (size_t)n0 * FFD, FFD, 64 * kb, scr, lane);
          return; }
    }
    if (r < NE * CV_MGU1) { const int e = r / CV_MGU1; r -= e * CV_MGU1; const int nb = r % 176, kb = r / 176;
        const float sg = wsc[4 + e], su = wsc[12 + e];
        if (kb == 0 && lane < 32) csw[CS_MGU + e * (2 * FFE) + 32 * nb + lane] = lane < 16 ? sg : su;
        if (CV_PAIR) tr_pair8<true, false>(gu_colptr(P.in[I_MG] + (size_t)e * D * FFE, P.in[I_MU] + (size_t)e * D * FFE, nb, j), FFE, false, ws + WS_MGU + e * (SZ_MGU / 2) + (size_t)(32 * nb) * D, D, 128 * kb, scr, lane, 1.0f / sg, 1.0f / su);
        else tr_item8<true>(gu_colptr(P.in[I_MG] + (size_t)e * D * FFE, P.in[I_MU] + (size_t)e * D * FFE, nb, j), FFE, false, ws + WS_MGU + e * (SZ_MGU / 2) + (size_t)(32 * nb) * D, D, 64 * kb, scr, lane, 1.0f / sg, 1.0f / su);
        return; }
    r -= NE * CV_MGU1;
    { const int e = r / CV_MDN1; r -= e * CV_MDN1; const int nb = r % 64, kb = r / 64, n0 = 32 * nb;
      if (CV_PAIR) tr_pair8<false, false>(P.in[I_MD] + (size_t)e * FFE * D + n0 + j, D, true, ws + WS_MDN + e * (SZ_MDN / 2) + (size_t)n0 * FFE, FFE, 128 * kb, scr, lane);
      else tr_item8(P.in[I_MD] + (size_t)e * FFE * D + n0 + j, D, true, ws + WS_MDN + e * (SZ_MDN / 2) + (size_t)n0 * FFE, FFE, 64 * kb, scr, lane); }
}
#define ITEM_NB(r, N, NKB, OLD) (ITEM_NBFAST == 2 ? (((r) >> 3) / (NKB)) * 8 + ((r) & 7) : ITEM_NBFAST == 1 ? (r) % (N) : (OLD))
#define ITEM_KB(r, N, NKB, OLD) (ITEM_NBFAST == 2 ? ((r) >> 3) % (NKB) : ITEM_NBFAST == 1 ? (r) / (N) : (OLD))
__device__ __forceinline__ void p0_prologue(Frame& F, const Params& P) {
    const Lane L(F.wave);
    unsigned char* ws = fresh_ws(P.ws);
    if (F.vcu < 192) {
      for (int rep_ = 0; rep_ <= DUP_MODV; ++rep_) {
        const int l = F.vcu / 96, cb = F.vcu % 96;
        LAS float* sv = (LAS float*)(F.lds);
        LAS float* red = (LAS float*)(F.lds + 32768);
        for (int i = L.tid; i < 3 * D; i += 512) { const int v = i / D, k = i % D; const float c = v < 2 ? P.in[I_C][v * D + k] : P.in[I_CCTX][k]; sv[i] = c / (1.0f + __expf(-c)); }
        __syncthreads();
        const float* W = P.in[I_WMOD] + (size_t)l * D * 12288 + cb * 128 + 2 * L.lane;
        f32x2 a0 = {0.f, 0.f}, a1 = {0.f, 0.f}, a2 = {0.f, 0.f};
        const int kb = F.wave * 256;
#pragma unroll 16
        for (int k = 0; k < 256; ++k) { const f32x2 w = *(const f32x2*)(W + (size_t)(kb + k) * 12288); a0 += w * sv[kb + k]; a1 += w * sv[D + kb + k]; a2 += w * sv[2 * D + kb + k]; }
        *(LAS f32x2*)(red + (F.wave * 3 + 0) * 128 + 2 * L.lane) = a0; *(LAS f32x2*)(red + (F.wave * 3 + 1) * 128 + 2 * L.lane) = a1; *(LAS f32x2*)(red + (F.wave * 3 + 2) * 128 + 2 * L.lane) = a2;
        __syncthreads();
        if (L.tid < 384) { const int v = L.tid >> 7, col = L.tid & 127; float s = P.in[I_BMOD][l * 12288 + cb * 128 + col];
#pragma unroll
            for (int w = 0; w < 8; ++w) s += red[(w * 3 + v) * 128 + col];
            ((float*)(ws + WS_MOD))[(size_t)(l * 3 + v) * 12288 + cb * 128 + col] = s; }
        __syncthreads();
      }
    } else if (F.vcu == 192) {
        float* rc = (float*)(ws + WS_ROPE); float* rs = rc + 192 * 16;
        for (int i = L.tid; i < 192 * 16; i += 512) { const int pos = i >> 4, f = i & 15; const float inv = exp2f(-(float)f * (13.287712379549449f / 16.0f)); const float ang = (float)(pos < 128 ? pos : pos - 128) * inv; rc[i] = cosf(ang); rs[i] = sinf(ang); }
    }
    LAS float* wsc = (LAS float*)(F.lds + MISC_OFF + 256);
    for (int t = F.wave; t < 20; t += NWAVES) {
        const float* tp = t < 2 ? P.in[I_WIN] + (size_t)t * D * IN_COLS : t == 2 ? P.in[I_FG] : t == 3 ? P.in[I_FU] : t < 12 ? P.in[I_MG] + (size_t)(t - 4) * D * FFE : P.in[I_MU] + (size_t)(t - 12) * D * FFE;
        float ss = 0.f;
#pragma unroll
        for (int i = 0; i < 16; ++i) { const f32x4 w = *(const f32x4*)(tp + 4 * (L.lane + 64 * i)); ss += (w[0] * w[0] + w[1] * w[1]) + (w[2] * w[2] + w[3] * w[3]); }
        ss = wave_sum(ss);
        if (L.lane == 0) wsc[t] = sqrtf(ss * (1.0f / 4096.0f)) * (I8_CLIP / 127.0f);
    }
    __syncthreads();
    float* csw = (float*)(ws + WS_CS);
    const int gw = F.vcu * NWAVES + F.wave, NGW = F.G * NWAVES;
    constexpr int NPRE = 63 * NWAVES * (CV_PAIR ? 4 : 7);
    const bool early = F.vcu > 192;
    const int nA = early ? NPRE : 0, sA = early ? (F.vcu - 193) * NWAVES + F.wave : 0, stA = 63 * NWAVES;
    for (int ph = 0; ph < 2; ++ph) {
      const int lo = ph == 0 ? sA : NPRE + gw, hi2 = ph == 0 ? nA : ((DEFER && F.G == 256) ? CV_NEARLY : CV_NITEMS), st = ph == 0 ? stA : NGW;
      for (int it = lo; it < hi2; it += st) conv_item(F, P, it);
    }
}
__device__ __forceinline__ void deferred_slot(Frame& F, const Params& P, int dpos, int k, int nIdle, int ipw) {
    const int w0 = k * NWAVES + F.wave, st = nIdle * NWAVES;
    for (int i = 0; i < ipw; ++i) { const int it = CV_NEARLY + dpos + w0 + i * st; if (it < CV_NITEMS) conv_item(F, P, it); }
}
__device__ __forceinline__ void deferred_rest(Frame& F, const Params& P, int dpos) {
    for (int it = CV_NEARLY + dpos + F.vcu * NWAVES + F.wave; it < CV_NITEMS; it += F.G * NWAVES) conv_item(F, P, it);
}

__device__ __forceinline__ void store_row_i8(unsigned char* hr, float* hs, int r, const f32x4 (&x)[8], int lane) {
    float am = 0.f;
#pragma unroll
    for (int jq = 0; jq < 8; ++jq) am = fmaxf(fmaxf(am, fmaxf(fabsf(x[jq][0]), fabsf(x[jq][1]))), fmaxf(fabsf(x[jq][2]), fabsf(x[jq][3])));
    am = fmaxf(wave_max(am), 1e-30f);
    const float inv = 127.0f / am;
#pragma unroll
    for (int jq = 0; jq < 8; ++jq) *(unsigned*)(hr + 4 * lane + 256 * jq) = pk_i8(x[jq][0] * inv, x[jq][1] * inv, x[jq][2] * inv, x[jq][3] * inv);
    if (lane == 0) hs[r] = am * (1.0f / 127.0f);
}
template <bool ROUTE, int OUT8 = 0, bool SL16 = false, bool SC16 = false>
__device__ __forceinline__ void norm_phase(Frame& F, const void* srcLatV, const void* srcCtxV, const float* gvec, const float* modl, int ishift, int iscale, bf16* h, int nrows,
                                           const float* wrouter, const float* brouter, int* tok_e, int* tok_slot, float* tok_p,
                                           const float* part = nullptr, int nsl = 0, const float* pgate = nullptr, bf16* wb = nullptr, float* hs = nullptr) {
    const Lane L(F.wave);
    LAS float* wrT = (LAS float*)F.lds;
    if (ROUTE) {
        for (int i = L.tid; i < D * NE; i += 512) { const int k = i >> 3, e = i & 7; wrT[e * D + k] = wrouter[i]; }
        __syncthreads();
    }
    const int gw = F.vcu * NWAVES + F.wave, NGW = F.G * NWAVES, lane = L.lane;
    const int nmain = part != nullptr ? NLAT / 8 : nrows / 8;
    for (int run = gw; run < nmain; run += NGW) {
        const int r0 = run * 8; const int v = r0 < SEQ ? 0 : (r0 < NLAT ? 1 : 2);
        const float* sh = modl + (size_t)(v * 6 + ishift) * D; const float* sc = modl + (size_t)(v * 6 + iscale) * D;
        f32x4 A[8], B[8];
#pragma unroll
        for (int jq = 0; jq < 8; ++jq) { const int c = 4 * lane + 256 * jq; const f32x4 g = *(const f32x4*)(gvec + c), s = *(const f32x4*)(sc + c); A[jq] = g * (s + 1.0f); B[jq] = *(const f32x4*)(sh + c); }
        for (int rr = 0; rr < 8; ++rr) {
            const int r = r0 + rr;
            f32x4 x[8]; float ss = 0.f;
            if (r < NLAT) {
#pragma unroll
                for (int jq = 0; jq < 8; ++jq) x[jq] = SL16 ? ld4_bf16((const bf16*)srcLatV + (size_t)r * D + 4 * lane + 256 * jq) : ld4_f32((const float*)srcLatV + (size_t)r * D + 4 * lane + 256 * jq);
            } else {
#pragma unroll
                for (int jq = 0; jq < 8; ++jq) x[jq] = SC16 ? ld4_bf16((const bf16*)srcCtxV + (size_t)(r - NLAT) * D + 4 * lane + 256 * jq) : ld4_f32((const float*)srcCtxV + (size_t)(r - NLAT) * D + 4 * lane + 256 * jq);
            }
#pragma unroll
            for (int jq = 0; jq < 8; ++jq) ss += (x[jq][0] * x[jq][0] + x[jq][1] * x[jq][1]) + (x[jq][2] * x[jq][2] + x[jq][3] * x[jq][3]);
            const float rstd = 1.0f / sqrtf(wave_sum(ss) * (1.0f / D) + NORM_EPS);
#pragma unroll
            for (int jq = 0; jq < 8; ++jq) x[jq] = (x[jq] * rstd) * A[jq] + B[jq];
            if constexpr (OUT8 == 2 && ROUTE && MOE_SPARSE) {   }
            else if constexpr (OUT8 == 2) store_row_i8((unsigned char*)h + (size_t)r * D, hs, r, x, lane);
            else if constexpr (OUT8 == 1) {
                unsigned char* hr8 = (unsigned char*)h + (size_t)r * D;
#pragma unroll
                for (int jq = 0; jq < 8; ++jq) { const f32x4 y = __builtin_elementwise_min(__builtin_elementwise_max(x[jq], (f32x4){-448.f, -448.f, -448.f, -448.f}), (f32x4){448.f, 448.f, 448.f, 448.f});
                    *(unsigned*)(hr8 + 4 * lane + 256 * jq) = (unsigned)__builtin_amdgcn_cvt_pk_fp8_f32(y[2], y[3], __builtin_amdgcn_cvt_pk_fp8_f32(y[0], y[1], 0, false), true); }
            } else {
            bf16* hr = h + (size_t)r * D;
#pragma unroll
            for (int jq = 0; jq < 8; ++jq) { v2u w; w.x = cvtpk(x[jq][0], x[jq][1]); w.y = cvtpk(x[jq][2], x[jq][3]); *(v2u*)(hr + 4 * lane + 256 * jq) = w; }
            }
            if (ROUTE) {
                float lg[NE];
#pragma unroll
                for (int e = 0; e < NE; ++e) { float p = 0.f;
#pragma unroll
                    for (int jq = 0; jq < 8; ++jq) { const f32x4 w = *(const LAS f32x4*)(wrT + e * D + 4 * lane + 256 * jq); p += (x[jq][0] * w[0] + x[jq][1] * w[1]) + (x[jq][2] * w[2] + x[jq][3] * w[3]); }
                    lg[e] = wave_sum(p) + brouter[e]; }
                int i0 = 0; float v0 = lg[0];
#pragma unroll
                for (int e = 1; e < NE; ++e) if (lg[e] > v0) { v0 = lg[e]; i0 = e; }
                int i1 = -1; float v1 = -3.0e38f;
#pragma unroll
                for (int e = 0; e < NE; ++e) if (e != i0 && lg[e] > v1) { v1 = lg[e]; i1 = e; }
                int s0 = 0, s1 = 0;
                if (lane == 0) {
                    const float p0 = 1.0f / (1.0f + __expf(v1 - v0));
                    s0 = (int)__hip_atomic_fetch_add(F.ctl + CW_CNT + 64 * i0, 1u, RLX_AGENT);
                    s1 = (int)__hip_atomic_fetch_add(F.ctl + CW_CNT + 64 * i1, 1u, RLX_AGENT);
                    tok_e[2 * r] = i0; tok_e[2 * r + 1] = i1; tok_slot[2 * r] = s0; tok_slot[2 * r + 1] = s1; tok_p[2 * r] = p0; tok_p[2 * r + 1] = 1.0f - p0;
                }
                if constexpr (OUT8 == 2 && MOE_SPARSE) {
                    s0 = __builtin_amdgcn_readfirstlane(s0); s1 = __builtin_amdgcn_readfirstlane(s1);
                    float am = 0.f;
#pragma unroll
                    for (int jq = 0; jq < 8; ++jq) am = fmaxf(fmaxf(am, fmaxf(fabsf(x[jq][0]), fabsf(x[jq][1]))), fmaxf(fabsf(x[jq][2]), fabsf(x[jq][3])));
                    am = fmaxf(wave_max(am), 1e-30f);
                    const float inv = 127.0f / am;
                    const size_t ra = (size_t)i0 * NLAT + s0, rb = (size_t)i1 * NLAT + s1;
                    unsigned char* d0 = (unsigned char*)h + ra * D; unsigned char* d1 = (unsigned char*)h + rb * D;
#pragma unroll
                    for (int jq = 0; jq < 8; ++jq) { const unsigned w = pk_i8(x[jq][0] * inv, x[jq][1] * inv, x[jq][2] * inv, x[jq][3] * inv);
                        *(unsigned*)(d0 + 4 * lane + 256 * jq) = w; *(unsigned*)(d1 + 4 * lane + 256 * jq) = w; }
                    if (lane == 0) { hs[ra] = am * (1.0f / 127.0f); hs[rb] = am * (1.0f / 127.0f); }
                }
            }
        }
    }
    if (part != nullptr) {
        const float* sh = modl + (size_t)(2 * 6 + ishift) * D; const float* sc = modl + (size_t)(2 * 6 + iscale) * D;
        for (int r = NLAT + gw; r < NLAT + NCTX; r += NGW) {
            f32x4 x[8]; float ss = 0.f;
#pragma unroll
            for (int jq = 0; jq < 8; ++jq) { const int c = 4 * lane + 256 * jq; f32x4 a = *(const f32x4*)(part + (size_t)(r - NLAT) * D + c);
                for (int s = 1; s < nsl; ++s) a += *(const f32x4*)(part + ((size_t)s * NCTX + (r - NLAT)) * D + c);
                const f32x4 xs = SC16 ? ld4_bf16((const bf16*)srcCtxV + (size_t)(r - NLAT) * D + c) : ld4_f32((const float*)srcCtxV + (size_t)(r - NLAT) * D + c);
                x[jq] = xs + *(const f32x4*)(pgate + c) * a;
                ss += (x[jq][0] * x[jq][0] + x[jq][1] * x[jq][1]) + (x[jq][2] * x[jq][2] + x[jq][3] * x[jq][3]); }
            if (wb) {
#pragma unroll
                for (int jq = 0; jq < 8; ++jq) st4_bf16(wb + (size_t)r * D + 4 * lane + 256 * jq, x[jq]);
            }
            const float rstd = 1.0f / sqrtf(wave_sum(ss) * (1.0f / D) + NORM_EPS);
            bf16* hr = h + (size_t)r * D;
            if constexpr (OUT8 == 2) {
#pragma unroll
                for (int jq = 0; jq < 8; ++jq) { const int c = 4 * lane + 256 * jq; const f32x4 g = *(const f32x4*)(gvec + c), s = *(const f32x4*)(sc + c), b = *(const f32x4*)(sh + c); x[jq] = (x[jq] * rstd) * (g * (s + 1.0f)) + b; }
                store_row_i8((unsigned char*)h + (size_t)r * D, hs, r, x, lane);
            } else
#pragma unroll
            for (int jq = 0; jq < 8; ++jq) { const int c = 4 * lane + 256 * jq; const f32x4 g = *(const f32x4*)(gvec + c), s = *(const f32x4*)(sc + c), b = *(const f32x4*)(sh + c);
                f32x4 y = (x[jq] * rstd) * (g * (s + 1.0f)) + b;
                if constexpr (OUT8 == 1) { y = __builtin_elementwise_min(__builtin_elementwise_max(y, (f32x4){-448.f, -448.f, -448.f, -448.f}), (f32x4){448.f, 448.f, 448.f, 448.f});
                    *(unsigned*)((unsigned char*)h + (size_t)r * D + c) = (unsigned)__builtin_amdgcn_cvt_pk_fp8_f32(y[2], y[3], __builtin_amdgcn_cvt_pk_fp8_f32(y[0], y[1], 0, false), true); }
                else { v2u w; w.x = cvtpk(y[0], y[1]); w.y = cvtpk(y[2], y[3]); *(v2u*)(hr + c) = w; } }
        }
    }
    if (ROUTE) __syncthreads();
}

__device__ __forceinline__ void ld8f(const bf16* p, float (&o)[8]) { const v4u w = *(const v4u*)p; o[0] = bflo(w.x); o[1] = bfhi(w.x); o[2] = bflo(w.y); o[3] = bfhi(w.y); o[4] = bflo(w.z); o[5] = bfhi(w.z); o[6] = bflo(w.w); o[7] = bfhi(w.w); }
__device__ __forceinline__ void st8f(bf16* p, const float (&o)[8]) { v4u w; w.x = cvtpk(o[0], o[1]); w.y = cvtpk(o[2], o[3]); w.z = cvtpk(o[4], o[5]); w.w = cvtpk(o[6], o[7]); *(v4u*)p = w; }
__device__ __forceinline__ void conv_phase(Frame& F, const bf16* convb, const bf16* xbcb, bf16* cat, bf16* xbcc, const float* cw  , const float* sw  , const float* sb  ) {
    const Lane L(F.wave);
    const int gt = F.vcu * 512 + L.tid, NT = F.G * 512;
    constexpr int NRUN = T / 16, NITEM = NRUN * 192;
    for (int it = gt; it < NITEM; it += NT) {
        const int cc = it % 192, run = it / 192, r0 = run * 16;
        const int tl = r0 < NLAT ? (r0 % SEQ) : ((r0 - NLAT) % CTXL); const int sl = r0 < NLAT ? SEQ : CTXL;
        const bool first = tl == 0, last = tl + 16 == sl;
        if (cc < 64) {
            const int c0 = 8 * cc; float w0[8], w1[8], w2[8];
#pragma unroll
            for (int j = 0; j < 8; ++j) { w0[j] = cw[c0 + j]; w1[j] = cw[512 + c0 + j]; w2[j] = cw[1024 + c0 + j]; }
            float up[8], uc[8], un[8], a[8], b[8];
            if (first) {
#pragma unroll
                for (int j = 0; j < 8; ++j) up[j] = 0.f;
            } else if (CONV_U) { ld8f(convb + (size_t)(r0 - 1) * 1536 + 512 + c0, up); }
            else { ld8f(convb + (size_t)(r0 - 1) * 1536 + 512 + c0, a); ld8f(convb + (size_t)(r0 - 1) * 1536 + 1024 + c0, b);
#pragma unroll
                for (int j = 0; j < 8; ++j) up[j] = a[j] * b[j]; }
            if (CONV_U) ld8f(convb + (size_t)r0 * 1536 + 512 + c0, uc);
            else { ld8f(convb + (size_t)r0 * 1536 + 512 + c0, a); ld8f(convb + (size_t)r0 * 1536 + 1024 + c0, b);
#pragma unroll
            for (int j = 0; j < 8; ++j) uc[j] = a[j] * b[j]; }
            for (int t = 0; t < 16; ++t) {
                const int r = r0 + t;
                if (t == 15 && last) {
#pragma unroll
                    for (int j = 0; j < 8; ++j) un[j] = 0.f;
                } else if (CONV_U) { ld8f(convb + (size_t)(r + 1) * 1536 + 512 + c0, un); }
                else { ld8f(convb + (size_t)(r + 1) * 1536 + 512 + c0, a); ld8f(convb + (size_t)(r + 1) * 1536 + 1024 + c0, b);
#pragma unroll
                    for (int j = 0; j < 8; ++j) un[j] = a[j] * b[j]; }
                float g[8], o[8]; ld8f(convb + (size_t)r * 1536 + c0, g);
#pragma unroll
                for (int j = 0; j < 8; ++j) { o[j] = g[j] * ((up[j] * w0[j] + uc[j] * w1[j]) + un[j] * w2[j]); up[j] = uc[j]; uc[j] = un[j]; }
                st8f(cat + (size_t)r * D + c0, o);
            }
        } else {
            const int c0 = 8 * (cc - 64); float w0[8], w1[8], w2[8], bb[8];
#pragma unroll
            for (int j = 0; j < 8; ++j) { w0[j] = sw[c0 + j]; w1[j] = sw[1024 + c0 + j]; w2[j] = sw[2048 + c0 + j]; bb[j] = sb[c0 + j]; }
            float up[8], uc[8], un[8];
            if (first) {
#pragma unroll
                for (int j = 0; j < 8; ++j) up[j] = 0.f;
            } else ld8f(xbcb + (size_t)(r0 - 1) * 1024 + c0, up);
            ld8f(xbcb + (size_t)r0 * 1024 + c0, uc);
            for (int t = 0; t < 16; ++t) {
                const int r = r0 + t;
                if (t == 15 && last) {
#pragma unroll
                    for (int j = 0; j < 8; ++j) un[j] = 0.f;
                } else ld8f(xbcb + (size_t)(r + 1) * 1024 + c0, un);
                float o[8];
#pragma unroll
                for (int j = 0; j < 8; ++j) { const float y = ((up[j] * w0[j] + uc[j] * w1[j]) + un[j] * w2[j]) + bb[j]; o[j] = silu_f(y); up[j] = uc[j]; uc[j] = un[j]; }
                st8f(xbcc + (size_t)r * 1024 + c0, o);
            }
        }
    }
}
__device__ __forceinline__ int chain_pos(int dir, int cn) { return dir == 0 ? cn : (cn < 2 ? 1 - cn : 67 - cn); }
__device__ __forceinline__ int crow(int r, int hi) { return (r & 3) + 8 * (r >> 2) + 4 * hi; }
__device__ __forceinline__ float softplus_f(float x) { return fmaxf(x, 0.f) + __logf(1.0f + __expf(-fabsf(x))); }
constexpr int TS = 136;

template <int SVAR = 0>
__device__ __forceinline__ void ssd_local_phase(Frame& F, const Params& P, int layer) {
    unsigned char* ws = fresh_ws(P.ws);
    const bf16* xbcc = (const bf16*)(ws + WS_XBCC); const float* dtb = (const float*)(ws + WS_DT);
    float* yd = (float*)(ws + WS_YD); float* cumb = (float*)(ws + WS_CUM); float* Sb = (float*)(ws + WS_SB); float* tot = (float*)(ws + WS_TOT);
    LAS bf16* Cs = (LAS bf16*)(F.lds); LAS bf16* Bs = (LAS bf16*)(F.lds + 34816); LAS bf16* XT = (LAS bf16*)(F.lds + 69632);
    LAS bf16* Gs = (LAS bf16*)(F.lds + 87040) + F.wave * 1280;
    LAS float* fa = (LAS float*)(F.lds + 107520);
    LAS float* daA = fa, *cumA = fa + 256, *dtA = fa + 512, *scA = fa + 768;
    const int wave = F.wave;
#if S1_PF
    v4u pfc[4], pfb[4], pfx[2]; float pfraw = 0.f;
#define S1_GLOAD(uid_) do { const int t_ = fresh_tid(F.wave); const int h_ = (uid_) & 7, b_ = ((uid_) >> 3) & 1, cn_ = (uid_) >> 4, g_ = h_ >> 2; \
        const int row0_ = cn_ < 2 ? NLAT + b_ * CTXL + 128 * cn_ : b_ * SEQ + 128 * (cn_ - 2); \
        _Pragma("unroll") for (int i = 0; i < 4; ++i) { const int q = t_ + 512 * i, s_ = q >> 4, c8 = (q & 15) * 8; \
            pfc[i] = *(const v4u*)(xbcc + (size_t)(row0_ + s_) * 1024 + 768 + g_ * 128 + c8); pfb[i] = *(const v4u*)(xbcc + (size_t)(row0_ + s_) * 1024 + 512 + g_ * 128 + c8); } \
        _Pragma("unroll") for (int i = 0; i < 2; ++i) { const int q = t_ + 512 * i, s_ = q & 127, p8 = (q >> 7) * 8; pfx[i] = *(const v4u*)(xbcc + (size_t)(row0_ + s_) * 1024 + h_ * 64 + p8); } \
        if (t_ < 256) { const int dir = t_ >> 7, s_ = t_ & 127; pfraw = dtb[(size_t)(row0_ + s_) * 16 + dir * 8 + h_] + P.in[I_DTB][layer * 16 + dir * 8 + h_]; } } while (0)
    if (F.vcu < NCH * NB * 8) S1_GLOAD(F.vcu);
#endif
    for (int uid = F.vcu; uid < NCH * NB * 8; uid += F.G) {
        const int tid = fresh_tid(F.wave), lane = tid & 63, r32 = lane & 31, hi = lane >> 5;
        const int h = uid & 7, b = (uid >> 3) & 1, cn = uid >> 4, g = h >> 2;
        const int row0 = cn < 2 ? NLAT + b * CTXL + 128 * cn : b * SEQ + 128 * (cn - 2);
#if S1_PF
#pragma unroll
        for (int i = 0; i < 4; ++i) { const int q = tid + 512 * i, s = q >> 4, c8 = (q & 15) * 8; *(LAS v4u*)(Cs + s * TS + c8) = pfc[i]; *(LAS v4u*)(Bs + s * TS + c8) = pfb[i]; }
#pragma unroll
        for (int i = 0; i < 2; ++i) { const int q = tid + 512 * i, s = q & 127, p8 = (q >> 7) * 8; const v4u w = pfx[i];
            XT[(p8 + 0) * TS + s] = (bf16)(w.x & 0xffff); XT[(p8 + 1) * TS + s] = (bf16)(w.x >> 16); XT[(p8 + 2) * TS + s] = (bf16)(w.y & 0xffff); XT[(p8 + 3) * TS + s] = (bf16)(w.y >> 16);
            XT[(p8 + 4) * TS + s] = (bf16)(w.z & 0xffff); XT[(p8 + 5) * TS + s] = (bf16)(w.z >> 16); XT[(p8 + 6) * TS + s] = (bf16)(w.w & 0xffff); XT[(p8 + 7) * TS + s] = (bf16)(w.w >> 16); }
        if (tid < 256) { const int dir = tid >> 7;
            const float dt = softplus_f(pfraw); const float A = -__expf(P.in[I_ALOG][layer * 16 + dir * 8 + h]);
            dtA[tid] = dt; daA[tid] = dt * A; }
        if (uid + F.G < NCH * NB * 8) S1_GLOAD(uid + F.G);
#else
#pragma unroll
        for (int i = 0; i < 4; ++i) { const int q = tid + 512 * i, s = q >> 4, c8 = (q & 15) * 8;
            *(LAS v4u*)(Cs + s * TS + c8) = *(const v4u*)(xbcc + (size_t)(row0 + s) * 1024 + 768 + g * 128 + c8);
            *(LAS v4u*)(Bs + s * TS + c8) = *(const v4u*)(xbcc + (size_t)(row0 + s) * 1024 + 512 + g * 128 + c8); }
#pragma unroll
        for (int i = 0; i < 2; ++i) { const int q = tid + 512 * i, s = q & 127, p8 = (q >> 7) * 8;
            const v4u w = *(const v4u*)(xbcc + (size_t)(row0 + s) * 1024 + h * 64 + p8);
            XT[(p8 + 0) * TS + s] = (bf16)(w.x & 0xffff); XT[(p8 + 1) * TS + s] = (bf16)(w.x >> 16); XT[(p8 + 2) * TS + s] = (bf16)(w.y & 0xffff); XT[(p8 + 3) * TS + s] = (bf16)(w.y >> 16);
            XT[(p8 + 4) * TS + s] = (bf16)(w.z & 0xffff); XT[(p8 + 5) * TS + s] = (bf16)(w.z >> 16); XT[(p8 + 6) * TS + s] = (bf16)(w.w & 0xffff); XT[(p8 + 7) * TS + s] = (bf16)(w.w >> 16); }
        if (tid < 256) { const int dir = tid >> 7, s = tid & 127;
            const float raw = dtb[(size_t)(row0 + s) * 16 + dir * 8 + h] + P.in[I_DTB][layer * 16 + dir * 8 + h];
            const float dt = softplus_f(raw); const float A = -__expf(P.in[I_ALOG][layer * 16 + dir * 8 + h]);
            dtA[tid] = dt; daA[tid] = dt * A; }
#endif
        __syncthreads();
        float cloc = 0.f;
        if (tid < 256) { const int dir = tid >> 7, s = tid & 127, b8 = s & ~7;
#pragma unroll
            for (int k = 0; k < 8; ++k) { const float a = daA[dir * 128 + b8 + k]; if (dir == 0 ? (b8 + k <= s) : (b8 + k >= s)) cloc += a; }
            if (dir == 0 ? ((s & 7) == 7) : ((s & 7) == 0)) scA[dir * 16 + (s >> 3)] = cloc; }
        __syncthreads();
        float cum = cloc, total = 0.f;
        if (tid < 256) { const int dir = tid >> 7, s = tid & 127, bi = s >> 3;
#pragma unroll
            for (int k = 0; k < 16; ++k) { const float a = scA[dir * 16 + k]; total += a; if (dir == 0 ? (k < bi) : (k > bi)) cum += a; } }
        __syncthreads();
        if (tid < 256) { const int dir = tid >> 7, s = tid & 127;
            cumA[tid] = cum; scA[tid] = __expf(total - cum) * dtA[tid];
            cumb[(size_t)(row0 + s) * 16 + dir * 8 + h] = cum;
            if (s == 0) tot[((dir * 2 + b) * 8 + h) * NCH + chain_pos(dir, cn)] = total; }
        __syncthreads();
        if (SVAR < 1 || SVAR == 4) {
            const int rb = wave >> 1, cb = wave & 1;
            f32x16 Y = {};
            float cl0[16], cl1[16];
#pragma unroll
            for (int r = 0; r < 16; ++r) { cl0[r] = cumA[32 * rb + crow(r, hi)]; cl1[r] = cumA[128 + 32 * rb + crow(r, hi)]; }
            for (int sb = 0; sb < 4; ++sb) {
                f32x16 CB = {};
#pragma unroll
                for (int ks = 0; ks < 8; ++ks) {
                    const bf16x8 a = *(const LAS bf16x8*)(Cs + (32 * rb + r32) * TS + 16 * ks + 8 * hi);
                    const bf16x8 bb = *(const LAS bf16x8*)(Bs + (32 * sb + r32) * TS + 16 * ks + 8 * hi);
                    CB = __builtin_amdgcn_mfma_f32_32x32x16_bf16(a, bb, CB, 0, 0, 0);
                }
                const int s = 32 * sb + r32; const float cs0 = cumA[s], cs1 = cumA[128 + s], d0 = dtA[s], d1 = dtA[128 + s];
#pragma unroll
                for (int r = 0; r < 16; ++r) { const int l = 32 * rb + crow(r, hi);
                    const float f0 = (s <= l) ? __expf(cl0[r] - cs0) * d0 : 0.f, f1 = (s >= l) ? __expf(cl1[r] - cs1) * d1 : 0.f;
                    Gs[crow(r, hi) * 40 + r32] = (bf16)f2bf(CB[r] * (f0 + f1)); }
                LDS_WAIT(); asm volatile("" ::: "memory");
#pragma unroll
                for (int k2 = 0; k2 < 2; ++k2) {
                    const bf16x8 ag = *(const LAS bf16x8*)(Gs + r32 * 40 + 16 * k2 + 8 * hi);
                    const bf16x8 bx = *(const LAS bf16x8*)(XT + (32 * cb + r32) * TS + 32 * sb + 16 * k2 + 8 * hi);
                    Y = __builtin_amdgcn_mfma_f32_32x32x16_bf16(ag, bx, Y, 0, 0, 0);
                }
                LDS_WAIT(); asm volatile("" ::: "memory");
            }
#if YD16
            {
                unsigned* yd16 = (unsigned*)yd; const int odd = r32 & 1;
#pragma unroll
                for (int r = 0; r < 16; r += 2) {
                    const float a = fminf(fmaxf(Y[r], -65504.f), 65504.f), bq = fminf(fmaxf(Y[r + 1], -65504.f), 65504.f);
                    const float pa = dpp_f(a, 0), pb = dpp_f(bq, 0);
                    const _Float16 lo = (_Float16)(odd ? pb : a), hh = (_Float16)(odd ? bq : pa);
                    const unsigned w = (unsigned)__builtin_bit_cast(unsigned short, lo) | ((unsigned)__builtin_bit_cast(unsigned short, hh) << 16);
                    yd16[((size_t)(row0 + 32 * rb + crow(r + odd, hi)) * 512 + h * 64 + 32 * cb + r32 - odd) >> 1] = w; }
            }
#else
#pragma unroll
            for (int r = 0; r < 16; ++r) yd[(size_t)(row0 + 32 * rb + crow(r, hi)) * 512 + h * 64 + 32 * cb + r32] = Y[r];
#endif
        }
        __syncthreads();
        LAS bf16* BT = Cs;
        if (SVAR < 2 || SVAR == 3) {
#pragma unroll
        for (int i = 0; i < 4; ++i) { const int q = tid + 512 * i, s = q & 127, n8 = (q >> 7) * 8; const v4u w = *(const LAS v4u*)(Bs + s * TS + n8);
            BT[(n8 + 0) * TS + s] = (bf16)(w.x & 0xffff); BT[(n8 + 1) * TS + s] = (bf16)(w.x >> 16); BT[(n8 + 2) * TS + s] = (bf16)(w.y & 0xffff); BT[(n8 + 3) * TS + s] = (bf16)(w.y >> 16);
            BT[(n8 + 4) * TS + s] = (bf16)(w.z & 0xffff); BT[(n8 + 5) * TS + s] = (bf16)(w.z >> 16); BT[(n8 + 6) * TS + s] = (bf16)(w.w & 0xffff); BT[(n8 + 7) * TS + s] = (bf16)(w.w >> 16); }
        __syncthreads();
        {
            const int dir = wave & 1, nb = wave >> 1;
            f32x16 S0 = {}, S1 = {};
#pragma unroll
            for (int ks = 0; ks < 8; ++ks) {
                const int s0 = 16 * ks + 8 * hi;
                const f32x4 sc0 = *(const LAS f32x4*)(scA + dir * 128 + s0), sc1 = *(const LAS f32x4*)(scA + dir * 128 + s0 + 4);
                const bf16x8 bb = *(const LAS bf16x8*)(BT + (32 * nb + r32) * TS + s0);
#pragma unroll
                for (int pb = 0; pb < 2; ++pb) {
                    const v4u xr = *(const LAS v4u*)(XT + (32 * pb + r32) * TS + s0);
                    v4u xs; xs.x = cvtpk(bflo(xr.x) * sc0[0], bfhi(xr.x) * sc0[1]); xs.y = cvtpk(bflo(xr.y) * sc0[2], bfhi(xr.y) * sc0[3]);
                    xs.z = cvtpk(bflo(xr.z) * sc1[0], bfhi(xr.z) * sc1[1]); xs.w = cvtpk(bflo(xr.w) * sc1[2], bfhi(xr.w) * sc1[3]);
                    const bf16x8 a = __builtin_bit_cast(bf16x8, xs);
                    if (pb == 0) S0 = __builtin_amdgcn_mfma_f32_32x32x16_bf16(a, bb, S0, 0, 0, 0); else S1 = __builtin_amdgcn_mfma_f32_32x32x16_bf16(a, bb, S1, 0, 0, 0);
                }
            }
#if S1_LDSST
            __syncthreads();
            LAS float* St = (LAS float*)F.lds;
#pragma unroll
            for (int r = 0; r < 16; ++r) { St[(dir * 64 + crow(r, hi)) * 128 + 32 * nb + r32] = S0[r]; St[(dir * 64 + 32 + crow(r, hi)) * 128 + 32 * nb + r32] = S1[r]; }
            __syncthreads();
            { const int tid3 = fresh_tid(F.wave);
#pragma unroll
              for (int i = 0; i < 8; ++i) { const int q = tid3 + 512 * i, d2 = q >> 11, e4 = (q & 2047) * 4;
                  float* sp2 = Sb + ((size_t)(((d2 * 2 + b) * 8 + h) * NCH + chain_pos(d2, cn))) * 8192;
                  *(f32x4*)(sp2 + e4) = *(const LAS f32x4*)(St + d2 * 8192 + e4); } }
#elif SB16
            { unsigned* sp16 = (unsigned*)Sb + ((size_t)(((dir * 2 + b) * 8 + h) * NCH + chain_pos(dir, cn))) * 4096;
              const int odd = r32 & 1;
#pragma unroll
              for (int r = 0; r < 16; ++r) {
                  const float p0 = dpp_f(S0[r], 0), p1 = dpp_f(S1[r], 0);
                  const unsigned w = odd ? cvtpk(p1, S1[r]) : cvtpk(S0[r], p0);
                  sp16[(size_t)((odd ? 32 : 0) + crow(r, hi)) * 64 + 16 * nb + (r32 >> 1)] = w; } }
#else
            float* sp = Sb + ((size_t)(((dir * 2 + b) * 8 + h) * NCH + chain_pos(dir, cn))) * 8192;
#pragma unroll
            for (int r = 0; r < 16; ++r) { if (SVAR == 3) { asm volatile("" :: "v"(S0[r]), "v"(S1[r])); } else if (S1_NT) { __builtin_nontemporal_store(S0[r], sp + (size_t)crow(r, hi) * 128 + 32 * nb + r32); __builtin_nontemporal_store(S1[r], sp + (size_t)(32 + crow(r, hi)) * 128 + 32 * nb + r32); } else { sp[(size_t)crow(r, hi) * 128 + 32 * nb + r32] = S0[r]; sp[(size_t)(32 + crow(r, hi)) * 128 + 32 * nb + r32] = S1[r]; } }
#endif
        }
        }
        __syncthreads();
    }
}

__device__ __forceinline__ void ssd_scan_phase(Frame& F, const Params& P) {
    unsigned char* ws = fresh_ws(P.ws);
    bf16* Hp = (bf16*)(ws + WS_HP); const float* tot = (const float*)(ws + WS_TOT);
    const Lane L(F.wave);
#if SB16
    const unsigned* Sb = (const unsigned*)(ws + WS_SB);
    for (int e = F.vcu * 512 + L.tid; e < 32 * 4096; e += F.G * 512) {
        const int chain = e >> 12, idx = e & 4095;
        const unsigned* sp = Sb + (size_t)chain * NCH * 4096 + idx; unsigned* hp = (unsigned*)Hp + (size_t)chain * NCH * 4096 + idx; const float* tp = tot + chain * NCH;
        float H0 = 0.f, H1 = 0.f;
        for (int i0 = 0; i0 < NCH; i0 += S2_DEPTH) {
            unsigned sv[S2_DEPTH]; float dv[S2_DEPTH];
#pragma unroll
            for (int q = 0; q < S2_DEPTH; ++q) { sv[q] = sp[(size_t)(i0 + q) * 4096]; dv[q] = __expf(tp[i0 + q]); }
#pragma unroll
            for (int q = 0; q < S2_DEPTH; ++q) { hp[(size_t)(i0 + q) * 4096] = cvtpk(H0, H1); H0 = dv[q] * H0 + bflo(sv[q]); H1 = dv[q] * H1 + bfhi(sv[q]); }
        }
    }
#else
    const float* Sb = (const float*)(ws + WS_SB);
    for (int e = F.vcu * 512 + L.tid; e < 32 * 8192; e += F.G * 512) {
        const int chain = e >> 13, idx = e & 8191;
        const float* sp = Sb + (size_t)chain * NCH * 8192 + idx; bf16* hp = Hp + (size_t)chain * NCH * 8192 + idx; const float* tp = tot + chain * NCH;
        float H = 0.f;
        for (int i0 = 0; i0 < NCH; i0 += 6) {
            float sv[6], dv[6];
#pragma unroll
            for (int q = 0; q < 6; ++q) { sv[q] = sp[(size_t)(i0 + q) * 8192]; dv[q] = __expf(tp[i0 + q]); }
#pragma unroll
            for (int q = 0; q < 6; ++q) { hp[(size_t)(i0 + q) * 8192] = (bf16)f2bf(H); H = dv[q] * H + sv[q]; }
        }
    }
#endif
}

__device__ __forceinline__ void ssd_out_phase(Frame& F, const Params& P, int layer) {
    unsigned char* ws = fresh_ws(P.ws);
    const bf16* xbcc = (const bf16*)(ws + WS_XBCC); const bf16* zb = (const bf16*)(ws + WS_Z); const float* yd = (const float*)(ws + WS_YD); const float* cumb = (const float*)(ws + WS_CUM);
    const bf16* Hp = (const bf16*)(ws + WS_HP); bf16* cat = (bf16*)(ws + WS_CAT);
    constexpr int YS = 260;
    LAS bf16* Cs = (LAS bf16*)(F.lds); LAS float* ec = (LAS float*)(F.lds + 34816); LAS float* Yl = (LAS float*)(F.lds + 34816 + 4096);
    const int wave = F.wave;
    for (int uid = (layer == 1 ? 8 : 0) + F.vcu; uid < NCH * NB * 2; uid += F.G) {
        const int tid = fresh_tid(F.wave), lane = tid & 63, r32 = lane & 31, hi = lane >> 5;
        const int g = uid & 1, b = (uid >> 1) & 1, cn = uid >> 2;
        const int row0 = cn < 2 ? NLAT + b * CTXL + 128 * cn : b * SEQ + 128 * (cn - 2);
#pragma unroll
        for (int i = 0; i < 4; ++i) { const int q = tid + 512 * i, s = q >> 4, c8 = (q & 15) * 8;
            *(LAS v4u*)(Cs + s * TS + c8) = *(const v4u*)(xbcc + (size_t)(row0 + s) * 1024 + 768 + g * 128 + c8); }
#pragma unroll
        for (int i = 0; i < 2; ++i) { const int idx = tid + 512 * i, hd = idx >> 7, s = idx & 127; ec[idx] = __expf(cumb[(size_t)(row0 + s) * 16 + (hd & 1) * 8 + 4 * g + (hd >> 1)]); }
        __syncthreads();
        const int hh = wave >> 1, cb = wave & 1, h = 4 * g + hh;
        f32x16 ys[4] = {};
        {
            bf16x8 Hf[2][8];
#pragma unroll
            for (int dir = 0; dir < 2; ++dir) {
                const bf16* hp = Hp + ((size_t)(((dir * 2 + b) * 8 + h) * NCH + chain_pos(dir, cn))) * 8192 + (size_t)(32 * cb + r32) * 128 + 8 * hi;
#pragma unroll
                for (int ks = 0; ks < 8; ++ks) Hf[dir][ks] = *(const bf16x8*)(hp + 16 * ks);
            }
#pragma unroll
            for (int rb = 0; rb < 4; ++rb) {
                bf16x8 af[8];
#pragma unroll
                for (int ks = 0; ks < 8; ++ks) af[ks] = *(const LAS bf16x8*)(Cs + (32 * rb + r32) * TS + 16 * ks + 8 * hi);
#pragma unroll
                for (int dir = 0; dir < 2; ++dir) {
                    f32x16 a0 = {};
#pragma unroll
                    for (int ks = 0; ks < 8; ++ks) a0 = __builtin_amdgcn_mfma_f32_32x32x16_bf16(af[ks], Hf[dir][ks], a0, 0, 0, 0);
#pragma unroll
                    for (int r = 0; r < 16; ++r) ys[rb][r] += a0[r] * ec[(hh * 2 + dir) * 128 + 32 * rb + crow(r, hi)];
                }
                asm volatile("" ::: "memory");
            }
        }
        const int lane2 = fresh_tid(F.wave) & 63;
        const float dsk = P.in[I_SSDD][layer * 8 + 4 * g + (lane2 >> 4)];
        const f32x4 ng = *(const f32x4*)(P.in[I_SNORM] + layer * 512 + g * 256 + 4 * lane2);
#pragma unroll
        for (int half = 0; half < 2; ++half) {
#pragma unroll
            for (int rb2 = 0; rb2 < 2; ++rb2)
#pragma unroll
                for (int r = 0; r < 16; ++r) Yl[(32 * rb2 + crow(r, hi)) * YS + hh * 64 + 32 * cb + r32] = ys[2 * half + rb2][r];
            __syncthreads();
#pragma unroll 2
            for (int q = 0; q < 8; ++q) {
                const int rl = 8 * wave + q, row = row0 + 64 * half + rl;
                const f32x4 yo = *(const LAS f32x4*)(Yl + rl * YS + 4 * lane2);
#if YD16
                f32x4 ydv; { const v2u yw = *(const v2u*)((const unsigned short*)yd + (size_t)row * 512 + g * 256 + 4 * lane2);
                  ydv[0] = (float)__builtin_bit_cast(_Float16, (unsigned short)(yw.x & 0xffff)); ydv[1] = (float)__builtin_bit_cast(_Float16, (unsigned short)(yw.x >> 16));
                  ydv[2] = (float)__builtin_bit_cast(_Float16, (unsigned short)(yw.y & 0xffff)); ydv[3] = (float)__builtin_bit_cast(_Float16, (unsigned short)(yw.y >> 16)); }
#else
                const f32x4 ydv = *(const f32x4*)(yd + (size_t)row * 512 + g * 256 + 4 * lane2);
#endif
                const v2u xv = *(const v2u*)(xbcc + (size_t)row * 1024 + g * 256 + 4 * lane2), zv = *(const v2u*)(zb + (size_t)row * 512 + g * 256 + 4 * lane2);
                f32x4 u;
                u[0] = (yo[0] + ydv[0] + dsk * bflo(xv.x)) * silu_f(bflo(zv.x)); u[1] = (yo[1] + ydv[1] + dsk * bfhi(xv.x)) * silu_f(bfhi(zv.x));
                u[2] = (yo[2] + ydv[2] + dsk * bflo(xv.y)) * silu_f(bflo(zv.y)); u[3] = (yo[3] + ydv[3] + dsk * bfhi(xv.y)) * silu_f(bfhi(zv.y));
                const float ss = wave_sum((u[0] * u[0] + u[1] * u[1]) + (u[2] * u[2] + u[3] * u[3]));
                const float rstd = 1.0f / sqrtf(ss * (1.0f / 256.0f) + NORM_EPS);
                v2u o; o.x = cvtpk(u[0] * rstd * ng[0], u[1] * rstd * ng[1]); o.y = cvtpk(u[2] * rstd * ng[2], u[3] * rstd * ng[3]);
                *(v2u*)(cat + (size_t)row * D + 512 + g * 256 + 4 * lane2) = o;
            }
            __syncthreads();
        }
    }
}
namespace att {
constexpr int KVBLK = 64, LDQ = 1024, LDK = 1024;
constexpr float SCALE = 0.125f;
constexpr float THR = 8.f;
constexpr size_t SHM_V = KVBLK * 128 * 2, SHM_K = KVBLK * 128 * 2;
#define KSWZ(row, colB) ((row) * 256 + ((colB) ^ (((row) & 7) << 4)))
#define SBAR() __builtin_amdgcn_sched_barrier(0)
constexpr float THRL = 11.5f;
#if ATT_FP8
constexpr float WLO = 0.5f, WHI = 7.5f, WMID = 4.0f;
#else
constexpr float WLO = -THRL, WHI = THRL, WMID = 0.f;
#endif
typedef int v8i __attribute__((ext_vector_type(8)));
__device__ __forceinline__ float max3f(float a, float b, float c) { return __builtin_fmaxf(__builtin_fmaxf(a, b), c); }
#if ATT_NEGM
typedef f32x16 mref_t;
#define MREF_INIT f32x16{}
__device__ __forceinline__ f32x16 mref_acc(const mref_t& m) { return m; }
#else
typedef float mref_t;
#define MREF_INIT 0.f
__device__ __forceinline__ f32x16 mref_acc(const mref_t&) { return f32x16{}; }
#endif
template <bool DOEXP = true>
__device__ __forceinline__ void partialSM(f32x16& p0, f32x16& p1, mref_t& mref, float& alpha) {
  float pmax = max3f(p0[0], p0[1], p0[2]);
#pragma unroll
  for (int r = 3; r < 15; r += 2) pmax = max3f(pmax, p0[r], p0[r + 1]);
  pmax = max3f(pmax, p0[15], p1[0]);
#pragma unroll
  for (int r = 1; r < 15; r += 2) pmax = max3f(pmax, p1[r], p1[r + 1]);
  pmax = fmaxf(pmax, p1[15]);
  pmax = cross_max(pmax);
#if ATT_NEGM
  if (__builtin_expect(__all(pmax >= WLO && pmax <= WHI), 1)) { alpha = 1.f; }
  else {
    const float d = (pmax < WLO || pmax > WHI) ? pmax - WMID : 0.f;
    alpha = __builtin_amdgcn_exp2f(-d);
#pragma unroll
    for (int r = 0; r < 16; ++r) { p0[r] -= d; p1[r] -= d; mref[r] -= d; }
  }
#else
  if (__builtin_expect(__all(fabsf(pmax - mref) <= THRL), 1)) { alpha = 1.f; }
  else { const float d = fabsf(pmax - mref) > THRL ? pmax - mref : 0.f; alpha = __builtin_amdgcn_exp2f(-d); mref += d; }
#pragma unroll
  for (int r = 0; r < 16; ++r) { p0[r] -= mref; p1[r] -= mref; }
#endif
  if constexpr (DOEXP) {
#pragma unroll
  for (int r = 0; r < 16; ++r) p0[r] = __builtin_amdgcn_exp2f(p0[r]);
  }
}
__device__ __forceinline__ void finishSM(f32x16& p0, f32x16& p1, float alpha, float& l_reg, bf16x8& pa0, bf16x8& pa1, bf16x8& pa2, bf16x8& pa3) {
#pragma unroll
  for (int r = 0; r < 16; ++r) p1[r] = __builtin_amdgcn_exp2f(p1[r]);
#if !ATT_LMFMA
  float ps = 0;
#pragma unroll
  for (int r = 0; r < 16; ++r) ps += p0[r];
#pragma unroll
  for (int r = 0; r < 16; ++r) ps += p1[r];
  ps = cross_sum(ps);
  l_reg = l_reg * alpha + ps;
#else
  (void)alpha; (void)l_reg;
#endif
#define PK4(P, BASE, OUT) do { unsigned a0 = cvtpk(P[BASE + 0], P[BASE + 1]), a1 = cvtpk(P[BASE + 2], P[BASE + 3]);   \
    unsigned b0 = cvtpk(P[BASE + 4], P[BASE + 5]), b1 = cvtpk(P[BASE + 6], P[BASE + 7]);                              \
    if (!ATT_NOSWAP) { swap32u(a0, b0); swap32u(a1, b1); } \
    v4u w = {a0, a1, b0, b1}; OUT = __builtin_bit_cast(bf16x8, w); } while (0)
  PK4(p0, 0, pa0); PK4(p0, 8, pa1); PK4(p1, 0, pa2); PK4(p1, 8, pa3);
#undef PK4
}

#if ATT_FP8
__device__ __forceinline__ void finishSM8(f32x16& p0, f32x16& p1, float alpha, float& l_reg, v8i& P8) {
#pragma unroll
  for (int r = 0; r < 16; ++r) p1[r] = __builtin_amdgcn_exp2f(p1[r]);
  float ps = 0;
#pragma unroll
  for (int r = 0; r < 16; ++r) ps += p0[r];
#pragma unroll
  for (int r = 0; r < 16; ++r) ps += p1[r];
  ps = cross_sum(ps);
  l_reg = l_reg * alpha + ps;
#pragma unroll
  for (int w = 0; w < 4; ++w) {
    P8[w]     = __builtin_amdgcn_cvt_pk_fp8_f32(p0[4 * w + 2], p0[4 * w + 3], __builtin_amdgcn_cvt_pk_fp8_f32(p0[4 * w], p0[4 * w + 1], 0, false), true);
    P8[4 + w] = __builtin_amdgcn_cvt_pk_fp8_f32(p1[4 * w + 2], p1[4 * w + 3], __builtin_amdgcn_cvt_pk_fp8_f32(p1[4 * w], p1[4 * w + 1], 0, false), true);
  }
}
__device__ __forceinline__ void pv8(f32x16* o, const LAS char* vb, const v8i& P8) {
  v4u lo[4], hh[4];
#pragma unroll
  for (int d0 = 0; d0 < 4; ++d0) { lo[d0] = *(const LAS v4u*)(vb + d0 * 2048); hh[d0] = *(const LAS v4u*)(vb + d0 * 2048 + 512); }
#pragma unroll
  for (int d0 = 0; d0 < 4; ++d0) {
    v8i B; B[0] = (int)lo[d0].x; B[1] = (int)lo[d0].y; B[2] = (int)lo[d0].z; B[3] = (int)lo[d0].w; B[4] = (int)hh[d0].x; B[5] = (int)hh[d0].y; B[6] = (int)hh[d0].z; B[7] = (int)hh[d0].w;
    o[d0] = __builtin_amdgcn_mfma_scale_f32_32x32x64_f8f6f4(P8, B, o[d0], 0, 0, 0, 0x7F7F7F7F, 0, 0x7F7F7F7F);
  }
}
__device__ __forceinline__ void pv8_exp(f32x16* o, const LAS char* vb, const v8i& P8, f32x16& pn) {
  v4u lo[4], hh[4];
#pragma unroll
  for (int d0 = 0; d0 < 4; ++d0) { lo[d0] = *(const LAS v4u*)(vb + d0 * 2048); hh[d0] = *(const LAS v4u*)(vb + d0 * 2048 + 512); }
  asm volatile("s_waitcnt lgkmcnt(0)" ::: "memory"); SBAR();
#pragma unroll
  for (int d0 = 0; d0 < 4; ++d0) {
    v8i B; B[0] = (int)lo[d0].x; B[1] = (int)lo[d0].y; B[2] = (int)lo[d0].z; B[3] = (int)lo[d0].w; B[4] = (int)hh[d0].x; B[5] = (int)hh[d0].y; B[6] = (int)hh[d0].z; B[7] = (int)hh[d0].w;
    o[d0] = __builtin_amdgcn_mfma_scale_f32_32x32x64_f8f6f4(P8, B, o[d0], 0, 0, 0, 0x7F7F7F7F, 0, 0x7F7F7F7F);
#pragma unroll
    for (int r = 0; r < 4; ++r) pn[4 * d0 + r] = __builtin_amdgcn_exp2f(pn[4 * d0 + r]);
  }
  asm volatile("" :: "v"(pn[0]), "v"(pn[1]), "v"(pn[2]), "v"(pn[3]), "v"(pn[4]), "v"(pn[5]), "v"(pn[6]), "v"(pn[7]), "v"(pn[8]), "v"(pn[9]), "v"(pn[10]), "v"(pn[11]), "v"(pn[12]), "v"(pn[13]), "v"(pn[14]), "v"(pn[15]));
#pragma unroll
  for (int d0 = 0; d0 < 4; ++d0) { __builtin_amdgcn_sched_group_barrier(0x008, 1, 0); __builtin_amdgcn_sched_group_barrier(PVX_MASK, 4, 0); }
  SBAR();
}

constexpr float YB = 56.0f + Y8_C, YLO = 8.0f * WLO + YB, YHI = 8.0f * WHI + YB, YMID = 8.0f * WMID + YB;
__device__ __forceinline__ void partialSMY(f32x16& p0, f32x16& p1, mref_t& mref, float& alpha) {
  float pmax = max3f(p0[0], p0[1], p0[2]);
#pragma unroll
  for (int r = 3; r < 15; r += 2) pmax = max3f(pmax, p0[r], p0[r + 1]);
  pmax = max3f(pmax, p0[15], p1[0]);
#pragma unroll
  for (int r = 1; r < 15; r += 2) pmax = max3f(pmax, p1[r], p1[r + 1]);
  pmax = fmaxf(pmax, p1[15]);
  pmax = cross_max(pmax);
  if (__builtin_expect(__all(pmax >= YLO && pmax <= YHI), 1)) { alpha = 1.f; }
  else {
    const float d = (pmax < YLO || pmax > YHI) ? 8.0f * __builtin_rintf((pmax - YMID) * 0.125f) : 0.f;
    alpha = __builtin_amdgcn_exp2f(-0.125f * d);
#pragma unroll
    for (int r = 0; r < 16; ++r) { p0[r] -= d; p1[r] -= d; mref[r] -= d; }
  }
}
__device__ __forceinline__ void finishSMY(const f32x16& p0, const f32x16& p1, v8i& P8) {
#pragma unroll
  for (int w = 0; w < 4; ++w) {
    unsigned a = 0u, b = 0u;
#pragma unroll
    for (int i = 0; i < 4; ++i) { a = __builtin_amdgcn_cvt_pk_u8_f32(p0[4 * w + i], (unsigned)i, a); b = __builtin_amdgcn_cvt_pk_u8_f32(p1[4 * w + i], (unsigned)i, b); }
    P8[w] = (int)a; P8[4 + w] = (int)b;
  }
}
__device__ __forceinline__ void pv8s(f32x16* o, f32x16& lacc, const LAS char* vb, const v8i& P8) {
  v4u lo[4], hh[4];
#pragma unroll
  for (int d0 = 0; d0 < 4; ++d0) { lo[d0] = *(const LAS v4u*)(vb + d0 * 2048); hh[d0] = *(const LAS v4u*)(vb + d0 * 2048 + 512); }
  if (ATT_PRIO) __builtin_amdgcn_s_setprio(1);
  { const v8i ones = {0x38383838, 0x38383838, 0x38383838, 0x38383838, 0x38383838, 0x38383838, 0x38383838, 0x38383838};
    lacc = __builtin_amdgcn_mfma_scale_f32_32x32x64_f8f6f4(P8, ones, lacc, 0, 0, 0, 0x7F7F7F7F, 0, 0x7F7F7F7F); }
#pragma unroll
  for (int d0 = 0; d0 < 4; ++d0) {
    v8i B; B[0] = (int)lo[d0].x; B[1] = (int)lo[d0].y; B[2] = (int)lo[d0].z; B[3] = (int)lo[d0].w; B[4] = (int)hh[d0].x; B[5] = (int)hh[d0].y; B[6] = (int)hh[d0].z; B[7] = (int)hh[d0].w;
    o[d0] = __builtin_amdgcn_mfma_scale_f32_32x32x64_f8f6f4(P8, B, o[d0], 0, 0, 0, 0x7F7F7F7F, 0, 0x7F7F7F7F);
  }
  if (ATT_PRIO) __builtin_amdgcn_s_setprio(0);
}
#endif
__device__ __forceinline__ void qkt(f32x16& p0, f32x16& p1, const LAS char* Ks, const bf16x8* qr, int r32, int hi, int map, const mref_t& negm) {
  p0 = mref_acc(negm); p1 = p0;
#pragma unroll
  for (int d0 = 0; d0 < 4; ++d0) { int cb = (map * 64 + d0 * 16 + hi * 8) * 2;
    bf16x8 b0 = *(const LAS bf16x8*)(Ks + KSWZ(r32, cb));
    bf16x8 b1 = *(const LAS bf16x8*)(Ks + KSWZ(32 + r32, cb));
    p0 = __builtin_amdgcn_mfma_f32_32x32x16_bf16(b0, qr[d0], p0, 0, 0, 0);
    p1 = __builtin_amdgcn_mfma_f32_32x32x16_bf16(b1, qr[d0], p1, 0, 0, 0); }
}
#if ATT_NOSWAP
__device__ __forceinline__ int v_st(int k, int c) { return ((k >> 3) * 4 + (c >> 5)) * 512 + ((k & 7) * 32 + (c & 31)) * 2; }
#else
__device__ __forceinline__ int v_st(int k, int c) { const int kk = (k & ~0xC) | ((k & 4) << 1) | ((k & 8) >> 1); return ((kk >> 3) * 4 + (c >> 5)) * 512 + ((kk & 7) * 32 + (c & 31)) * 2; }
#endif
__device__ __forceinline__ int v_rd_base(int lane) { return ((lane & 3) << 3) | (((lane >> 2) & 3) << 6) | (((lane >> 4) & 1) << 5) | (((lane >> 5) & 1) << 8); }
constexpr int v_rd_off(int d0, int ks, int half) { return d0 * 512 + ks * 4096 + half * 2048; }
template <int OFF> __device__ __forceinline__ s16x4 tr_read(int vb) {
  s16x4 r; asm volatile("ds_read_b64_tr_b16 %0, %1 offset:%2" : "=&v"(r) : "v"(vb), "i"(OFF) : "memory"); return r;
}
struct VG { s16x4 l0, h0, l1, h1, l2, h2, l3, h3; };
template <int D0> __device__ __forceinline__ void pv_load(VG& g, int vb) {
  g.l0 = tr_read<v_rd_off(D0, 0, 0)>(vb); g.h0 = tr_read<v_rd_off(D0, 0, 1)>(vb); g.l1 = tr_read<v_rd_off(D0, 1, 0)>(vb); g.h1 = tr_read<v_rd_off(D0, 1, 1)>(vb);
  g.l2 = tr_read<v_rd_off(D0, 2, 0)>(vb); g.h2 = tr_read<v_rd_off(D0, 2, 1)>(vb); g.l3 = tr_read<v_rd_off(D0, 3, 0)>(vb); g.h3 = tr_read<v_rd_off(D0, 3, 1)>(vb);
}
__device__ __forceinline__ void pv_mma(f32x16& od, const VG& g, bf16x8 pa0, bf16x8 pa1, bf16x8 pa2, bf16x8 pa3) {
#define PK(L, H) (bf16x8){L[0], L[1], L[2], L[3], H[0], H[1], H[2], H[3]}
  od = __builtin_amdgcn_mfma_f32_32x32x16_bf16(pa0, PK(g.l0, g.h0), od, 0, 0, 0);
  od = __builtin_amdgcn_mfma_f32_32x32x16_bf16(pa1, PK(g.l1, g.h1), od, 0, 0, 0);
  od = __builtin_amdgcn_mfma_f32_32x32x16_bf16(pa2, PK(g.l2, g.h2), od, 0, 0, 0);
  od = __builtin_amdgcn_mfma_f32_32x32x16_bf16(pa3, PK(g.l3, g.h3), od, 0, 0, 0);
#undef PK
}
__device__ __forceinline__ void pv_d0(f32x16* o, int vb, bf16x8 pa0, bf16x8 pa1, bf16x8 pa2, bf16x8 pa3, f32x16& lacc) {
#if ATT_LMFMA
  { const bf16x8 ones = {0x3F80, 0x3F80, 0x3F80, 0x3F80, 0x3F80, 0x3F80, 0x3F80, 0x3F80};
    lacc = __builtin_amdgcn_mfma_f32_32x32x16_bf16(pa0, ones, lacc, 0, 0, 0); lacc = __builtin_amdgcn_mfma_f32_32x32x16_bf16(pa1, ones, lacc, 0, 0, 0);
    lacc = __builtin_amdgcn_mfma_f32_32x32x16_bf16(pa2, ones, lacc, 0, 0, 0); lacc = __builtin_amdgcn_mfma_f32_32x32x16_bf16(pa3, ones, lacc, 0, 0, 0); }
#endif
#if ATT_PVPF
  VG ga, gb;
  pv_load<0>(ga, vb); pv_load<1>(gb, vb);
  asm volatile("s_waitcnt lgkmcnt(8)" ::: "memory"); SBAR(); pv_mma(o[0], ga, pa0, pa1, pa2, pa3);
  pv_load<2>(ga, vb);
  asm volatile("s_waitcnt lgkmcnt(8)" ::: "memory"); SBAR(); pv_mma(o[1], gb, pa0, pa1, pa2, pa3);
  pv_load<3>(gb, vb);
  asm volatile("s_waitcnt lgkmcnt(8)" ::: "memory"); SBAR(); pv_mma(o[2], ga, pa0, pa1, pa2, pa3);
  asm volatile("s_waitcnt lgkmcnt(0)" ::: "memory"); SBAR(); pv_mma(o[3], gb, pa0, pa1, pa2, pa3);
#else
  VG g;
  pv_load<0>(g, vb); asm volatile("s_waitcnt lgkmcnt(0)" ::: "memory"); SBAR(); pv_mma(o[0], g, pa0, pa1, pa2, pa3);
  pv_load<1>(g, vb); asm volatile("s_waitcnt lgkmcnt(0)" ::: "memory"); SBAR(); pv_mma(o[1], g, pa0, pa1, pa2, pa3);
  pv_load<2>(g, vb); asm volatile("s_waitcnt lgkmcnt(0)" ::: "memory"); SBAR(); pv_mma(o[2], g, pa0, pa1, pa2, pa3);
  pv_load<3>(g, vb); asm volatile("s_waitcnt lgkmcnt(0)" ::: "memory"); SBAR(); pv_mma(o[3], g, pa0, pa1, pa2, pa3);
#endif
}
template <int VAR>
__device__ __forceinline__ void diff_attn_unit(const bf16* __restrict__ Qb, const bf16* __restrict__ Kh, const bf16* __restrict__ Vh, bf16* __restrict__ Ob, int seq, LAS char* lds,
                                               float lam, const float* gsub, float oscale, const int wave, const unsigned char* V8h, const unsigned char* q8base = nullptr) {
  const int tid = fresh_tid(wave), wid = tid >> 6, lane = tid & 63, r32 = lane & 31, hi = lane >> 5, map = wid >> 2, wq = wid & 3;
  constexpr int BUFB = (int)(SHM_V + SHM_K), WSF_OFF = RING_BYTES + 1024;
  LAS float* wsf = (LAS float*)(lds + WSF_OFF) + wid * 64; LAS float* li_l = wsf; LAS float* al_l = wsf + 32;
  float l_reg = 0; f32x16 o[4], lacc; mref_t negm = MREF_INIT; bf16x8 qr[4];
  { float zf_ = 0.f; asm volatile("" : "+v"(zf_));
#pragma unroll
    for (int r = 0; r < 16; ++r) { lacc[r] = zf_; o[0][r] = zf_; o[1][r] = zf_; o[2][r] = zf_; o[3][r] = zf_; } }
  const bf16* Qw = Qb + (long)(wq * 32 + r32) * LDQ + map * 64 + hi * 8;
#pragma unroll
  for (int d0 = 0; d0 < 4; ++d0) { const v4u w = *reinterpret_cast<const v4u*>(Qw + d0 * 16); constexpr float C = SCALE * 1.4426950408889634f;
    v4u q; q.x = cvtpk(bflo(w.x) * C, bfhi(w.x) * C); q.y = cvtpk(bflo(w.y) * C, bfhi(w.y) * C); q.z = cvtpk(bflo(w.z) * C, bfhi(w.z) * C); q.w = cvtpk(bflo(w.w) * C, bfhi(w.w) * C);
    qr[d0] = __builtin_bit_cast(bf16x8, q); }
#if ATT_DMA && ATT_FP8 && ATT_QK8
  constexpr int TB = 16384, LEAD = ATT_LEAD, NBUF = LEAD > 2 ? 8 : 4;
  const unsigned pcoff = (unsigned)(wid * 1024 + lane * 16);
  const LAS char* vrd = lds + hi * 1024 + r32 * 16;
  const LAS char* krd = lds + 8192 + (map * 2 + hi) * 2048 + r32 * 16;
  v8i P8, Q8;
#if Q8_DIRECT
  {
    const unsigned char* q8b = (const unsigned char*)q8base; const long off_ = (const unsigned char*)Qb - q8b; const int row_ = (int)(off_ >> 10) + wq * 32 + r32, hcol_ = (int)(off_ & 1023) + map * 64 + hi * 32;
    const unsigned char* q8 = q8b + (size_t)(row_ >> 4) * 16384 + (size_t)(hcol_ >> 3) * 128 + (row_ & 15) * 8;
    const v2u a_ = *(const v2u*)q8, b_ = *(const v2u*)(q8 + 128), c_ = *(const v2u*)(q8 + 256), d_ = *(const v2u*)(q8 + 384);
    Q8 = (v8i){(int)a_.x, (int)a_.y, (int)b_.x, (int)b_.y, (int)c_.x, (int)c_.y, (int)d_.x, (int)d_.y}; }
#else
  { constexpr float C = SCALE * 1.4426950408889634f * (ATT_Y8 ? 8.0f : 1.0f); const bf16* qp = Qb + (long)(wq * 32 + r32) * LDQ + map * 64 + hi * 32;
#pragma unroll
    for (int w4 = 0; w4 < 4; ++w4) { float a[8]; ld8f(qp + 8 * w4, a);
      Q8[2 * w4]     = __builtin_amdgcn_cvt_pk_fp8_f32(a[2] * C, a[3] * C, __builtin_amdgcn_cvt_pk_fp8_f32(a[0] * C, a[1] * C, 0, false), true);
      Q8[2 * w4 + 1] = __builtin_amdgcn_cvt_pk_fp8_f32(a[6] * C, a[7] * C, __builtin_amdgcn_cvt_pk_fp8_f32(a[4] * C, a[5] * C, 0, false), true); } }
#endif
  const unsigned char* K8h = V8h + (WS_K8 - WS_V8);
#define DMA(t_) do { const int bo_ = ((t_) & (NBUF - 1)) * TB; \
    __builtin_amdgcn_global_load_lds((const unsigned*)(V8h + (size_t)(t_) * 65536 + pcoff), (LAS unsigned*)(lds + bo_ + wid * 1024), 16, 0, 0); \
    __builtin_amdgcn_global_load_lds((const unsigned*)(K8h + (size_t)(t_) * 65536 + pcoff), (LAS unsigned*)(lds + bo_ + 8192 + wid * 1024), 16, 0, 0); } while (0)
#define RESC(a) do { if (__any((a) != 1.f)) { if (hi == 0) al_l[r32] = (a); asm volatile("s_waitcnt lgkmcnt(0)" ::: "memory"); \
    _Pragma("unroll") for (int r = 0; r < 16; ++r) { const float a_ = al_l[crow(r, hi)]; lacc[r] *= a_; _Pragma("unroll") for (int d = 0; d < 4; ++d) o[d][r] *= a_; } } } while (0)
#define TBAR() do { asm volatile("s_waitcnt lgkmcnt(0)" ::: "memory"); __builtin_amdgcn_s_barrier(); asm volatile("" ::: "memory"); } while (0)
#if ATT_KPF || ATT_P2
  v8i kfa, kfb;
#define KLOAD(t_) do { const LAS char* kb_ = krd + ((t_) & (NBUF - 1)) * TB; \
    const v4u k0l = *(const LAS v4u*)(kb_), k0h = *(const LAS v4u*)(kb_ + 1024), k1l = *(const LAS v4u*)(kb_ + 512), k1h = *(const LAS v4u*)(kb_ + 1536); \
    kfa = (v8i){(int)k0l.x, (int)k0l.y, (int)k0l.z, (int)k0l.w, (int)k0h.x, (int)k0h.y, (int)k0h.z, (int)k0h.w}; kfb = (v8i){(int)k1l.x, (int)k1l.y, (int)k1l.z, (int)k1l.w, (int)k1h.x, (int)k1h.y, (int)k1h.z, (int)k1h.w}; } while (0)
#define QK8(P0, P1, t_) do { \
    P0 = __builtin_amdgcn_mfma_scale_f32_32x32x64_f8f6f4(kfa, Q8, mref_acc(negm), 0, 0, 0, 0x7F7F7F7F, 0, 0x7F7F7F7F); \
    P1 = __builtin_amdgcn_mfma_scale_f32_32x32x64_f8f6f4(kfb, Q8, mref_acc(negm), 0, 0, 0, 0x7F7F7F7F, 0, 0x7F7F7F7F); \
    SBAR(); if ((t_) + 1 < NT) KLOAD((t_) + 1); } while (0)
#else
#define KLOAD(t_) do {} while (0)
#define QK8(P0, P1, t_) do { const LAS char* kb_ = krd + ((t_) & (NBUF - 1)) * TB; \
    const v4u k0l = *(const LAS v4u*)(kb_), k0h = *(const LAS v4u*)(kb_ + 1024), k1l = *(const LAS v4u*)(kb_ + 512), k1h = *(const LAS v4u*)(kb_ + 1536); \
    v8i ka_ = {(int)k0l.x, (int)k0l.y, (int)k0l.z, (int)k0l.w, (int)k0h.x, (int)k0h.y, (int)k0h.z, (int)k0h.w}, kb2_ = {(int)k1l.x, (int)k1l.y, (int)k1l.z, (int)k1l.w, (int)k1h.x, (int)k1h.y, (int)k1h.z, (int)k1h.w}; \
    P0 = __builtin_amdgcn_mfma_scale_f32_32x32x64_f8f6f4(ka_, Q8, mref_acc(negm), 0, 0, 0, 0x7F7F7F7F, 0, 0x7F7F7F7F); \
    P1 = __builtin_amdgcn_mfma_scale_f32_32x32x64_f8f6f4(kb2_, Q8, mref_acc(negm), 0, 0, 0, 0x7F7F7F7F, 0, 0x7F7F7F7F); } while (0)
#endif
  f32x16 pA0, pA1, pB0, pB1; float alA, alB; const int NT = seq / KVBLK;
  (void)qr; (void)Qw;
#if ATT_Y8
  { float yb_ = YB; asm volatile("" : "+v"(yb_));
#pragma unroll
    for (int r = 0; r < 16; ++r) negm[r] = yb_; }
#define PSM(P0, P1, AL) partialSMY(P0, P1, negm, AL)
#else
#define PSM(P0, P1, AL) partialSM(P0, P1, negm, AL)
#endif
#define VMW(n) asm volatile("s_waitcnt vmcnt(%0)" :: "n"(n) : "memory")
#if ATT_Y8 && ATT_P2
  static_assert(LEAD == 5 && NBUF == 8, "pipeline v2");
  v8i vf[4]; float al2;
#define VLOAD(t_) do { const LAS char* vb_ = vrd + ((t_) & (NBUF - 1)) * TB; _Pragma("unroll") for (int d0 = 0; d0 < 4; ++d0) { const v4u l_ = *(const LAS v4u*)(vb_ + d0 * 2048), h_ = *(const LAS v4u*)(vb_ + d0 * 2048 + 512); \
    vf[d0] = (v8i){(int)l_.x, (int)l_.y, (int)l_.z, (int)l_.w, (int)h_.x, (int)h_.y, (int)h_.z, (int)h_.w}; } } while (0)
#define QKM() do { pA0 = __builtin_amdgcn_mfma_scale_f32_32x32x64_f8f6f4(kfa, Q8, mref_acc(negm), 0, 0, 0, 0x7F7F7F7F, 0, 0x7F7F7F7F); \
    pA1 = __builtin_amdgcn_mfma_scale_f32_32x32x64_f8f6f4(kfb, Q8, mref_acc(negm), 0, 0, 0, 0x7F7F7F7F, 0, 0x7F7F7F7F); } while (0)
#define PVM() do { { int on_ = 0x38383838; asm volatile("" : "+v"(on_)); const v8i ones_ = {on_, on_, on_, on_, on_, on_, on_, on_}; \
      lacc = __builtin_amdgcn_mfma_scale_f32_32x32x64_f8f6f4(P8, ones_, lacc, 0, 0, 0, 0x7F7F7F7F, 0, 0x7F7F7F7F); } \
    _Pragma("unroll") for (int d0 = 0; d0 < 4; ++d0) o[d0] = __builtin_amdgcn_mfma_scale_f32_32x32x64_f8f6f4(P8, vf[d0], o[d0], 0, 0, 0, 0x7F7F7F7F, 0, 0x7F7F7F7F); } while (0)
#define STEP(j) do { SBAR(); if (!P2_KPF) KLOAD(j); if (!P2_VPF) VLOAD((j) - 1); asm volatile("s_waitcnt lgkmcnt(0)" ::: "memory"); QKM(); PVM(); SBAR(); \
    if (P2_KPF) { if ((j) + 1 < NT) KLOAD((j) + 1); } if (P2_VPF) VLOAD(j); SBAR(); \
    partialSMY(pA0, pA1, negm, al2); RESC(al2); finishSMY(pA0, pA1, P8); } while (0)
#pragma unroll
  for (int t = 0; t <= LEAD; ++t) if (t < NT) DMA(t);
  if (LEAD < NT) VMW(2 * (LEAD - 1)); else VMW(0);
  TBAR();
#if P2_AB
  auto run_ = [&](auto G_) __attribute__((always_inline)) { constexpr int GRP = decltype(G_)::value;
  KLOAD(0); asm volatile("s_waitcnt lgkmcnt(0)" ::: "memory"); QKM(); SBAR();
  if constexpr (GRP == 0) { partialSMY(pA0, pA1, negm, al2); finishSMY(pA0, pA1, P8); }
  if (LEAD < NT) VMW(2 * (LEAD - 3)); else VMW(0);
  TBAR();
#define STEPB(j) do { SBAR(); partialSMY(pA0, pA1, negm, al2); RESC(al2); finishSMY(pA0, pA1, P8); SBAR(); \
    KLOAD(j); asm volatile("s_waitcnt lgkmcnt(0)" ::: "memory"); QKM(); SBAR(); VLOAD((j) - 1); asm volatile("s_waitcnt lgkmcnt(0)" ::: "memory"); PVM(); SBAR(); } while (0)
  if constexpr (GRP == 0) {
    for (int j = 1; j + 1 < NT; j += 2) {
      if (j + LEAD < NT) DMA(j + LEAD); if (j + LEAD + 1 < NT) DMA(j + LEAD + 1);
      STEP(j); STEP(j + 1);
      if (j + LEAD + 1 < NT) VMW(2 * (LEAD - 3)); else VMW(0); TBAR();
    }
    STEP(NT - 1);
  } else {
    for (int j = 1; j + 1 < NT; j += 2) {
      if (j + LEAD < NT) DMA(j + LEAD); if (j + LEAD + 1 < NT) DMA(j + LEAD + 1);
      STEPB(j); STEPB(j + 1);
      if (j + LEAD + 1 < NT) VMW(2 * (LEAD - 3)); else VMW(0); TBAR();
    }
    STEPB(NT - 1);
    partialSMY(pA0, pA1, negm, al2); RESC(al2); finishSMY(pA0, pA1, P8);
  }
  VLOAD(NT - 1);
  asm volatile("s_waitcnt lgkmcnt(0)" ::: "memory"); PVM();
#undef STEPB
#else
  KLOAD(0); asm volatile("s_waitcnt lgkmcnt(0)" ::: "memory"); QKM(); SBAR(); if (P2_KPF) KLOAD(1); if (P2_VPF) VLOAD(0); SBAR();
  partialSMY(pA0, pA1, negm, al2); finishSMY(pA0, pA1, P8);
  if (LEAD < NT) VMW(2 * (LEAD - 3)); else VMW(0);
  TBAR();
  for (int j = 1; j + 1 < NT; j += 2) {
    if (j + LEAD < NT) DMA(j + LEAD); if (j + LEAD + 1 < NT) DMA(j + LEAD + 1);
    STEP(j);
    STEP(j + 1);
    if (j + LEAD + 1 < NT) VMW(2 * (LEAD - 3)); else VMW(0); TBAR();
  }
  STEP(NT - 1);
  if (!P2_VPF) VLOAD(NT - 1);
  asm volatile("s_waitcnt lgkmcnt(0)" ::: "memory"); PVM();
#endif
  (void)pB0; (void)pB1; (void)alA; (void)alB;
#undef STEP
#undef PVM
#undef QKM
#undef VLOAD
#elif ATT_Y8 && ATT_AB
  static_assert(LEAD == 5 && NBUF == 8, "anti-phase schedule");
#pragma unroll
  for (int t = 0; t <= LEAD; ++t) if (t < NT) DMA(t);
  if (LEAD < NT) VMW(2 * LEAD); else VMW(0);
  TBAR();
  QK8(pA0, pA1, 0); PSM(pA0, pA1, alA);
  if (LEAD < NT) VMW(2 * (LEAD - 3)); else VMW(0);
  TBAR();
#define XCV(PO0, PO1, j) do { finishSMY(PO0, PO1, P8); SBAR(); pv8s(o, lacc, vrd + (((j) - 1) & (NBUF - 1)) * TB, P8); } while (0)
  if (map == 0) {
#define ITERA(j, PN0, PN1, ALN, PO0, PO1) do { SBAR(); QK8(PN0, PN1, j); XCV(PO0, PO1, j); partialSMY(PN0, PN1, negm, ALN); RESC(ALN); } while (0)
    for (int j = 1; j + 1 < NT; j += 2) {
      if (j + LEAD < NT) DMA(j + LEAD); if (j + LEAD + 1 < NT) DMA(j + LEAD + 1);
      ITERA(j, pB0, pB1, alB, pA0, pA1);
      ITERA(j + 1, pA0, pA1, alA, pB0, pB1);
      if (j + LEAD + 1 < NT) VMW(2 * (LEAD - 3)); else VMW(0); TBAR();
    }
    ITERA(NT - 1, pB0, pB1, alB, pA0, pA1);
#undef ITERA
  } else {
    QK8(pB0, pB1, 1);
#define ITERB(j, PN0, PN1, ALN, PO0, PO1) do { SBAR(); XCV(PO0, PO1, j); partialSMY(PN0, PN1, negm, ALN); RESC(ALN); SBAR(); if ((j) + 1 < NT) QK8(PO0, PO1, (j) + 1); } while (0)
    for (int j = 1; j + 1 < NT; j += 2) {
      if (j + LEAD < NT) DMA(j + LEAD); if (j + LEAD + 1 < NT) DMA(j + LEAD + 1);
      ITERB(j, pB0, pB1, alB, pA0, pA1);
      ITERB(j + 1, pA0, pA1, alA, pB0, pB1);
      if (j + LEAD + 1 < NT) VMW(2 * (LEAD - 3)); else VMW(0); TBAR();
    }
    ITERB(NT - 1, pB0, pB1, alB, pA0, pA1);
#undef ITERB
  }
  finishSMY(pB0, pB1, P8); SBAR();
  pv8s(o, lacc, vrd + ((NT - 1) & (NBUF - 1)) * TB, P8);
#undef XCV
#else
#pragma unroll
  for (int t = 0; t <= LEAD; ++t) if (t < NT) DMA(t);
  if (LEAD < NT) VMW(2 * (LEAD - ATT_KPF)); else VMW(0);
  TBAR();
  KLOAD(0);
  QK8(pA0, pA1, 0); PSM(pA0, pA1, alA);
  if (LEAD < NT) VMW(2 * (LEAD - 1 - ATT_BAR2 - ATT_KPF)); else VMW(0);
  TBAR();
#define ITER(j, PN0, PN1, ALN, PO0, PO1, ALO) do { \
    if (!ATT_BAR2) { if ((j) + LEAD < NT) DMA((j) + LEAD); } \
    SBAR(); if (!(ATT_STAG && map == 1)) QK8(PN0, PN1, j); \
    if (ATT_Y8) { if (VAR != 4) finishSMY(PO0, PO1, P8); SBAR(); \
        if (VAR == 2) { const LAS char* vb_ = vrd + (((j) - 1) & (NBUF - 1)) * TB; _Pragma("unroll") for (int d0 = 0; d0 < 4; ++d0) { const v4u l_ = *(const LAS v4u*)(vb_ + d0 * 2048), h_ = *(const LAS v4u*)(vb_ + d0 * 2048 + 512); asm volatile("" :: "v"(l_), "v"(h_)); } } \
        else if (VAR != 1) pv8s(o, lacc, vrd + (((j) - 1) & (NBUF - 1)) * TB, P8); \
        if (ATT_STAG && map == 1) { SBAR(); QK8(PN0, PN1, j); } \
        if (VAR != 5) partialSMY(PN0, PN1, negm, ALN); else ALN = 1.f; } \
    else { finishSM8(PO0, PO1, ALO, l_reg, P8); SBAR(); } \
    if (ATT_Y8) {} else if (ATT_PVX) { partialSM<false>(PN0, PN1, negm, ALN); SBAR(); pv8_exp(o, vrd + (((j) - 1) & (NBUF - 1)) * TB, P8, PN0); } \
    else { pv8(o, vrd + (((j) - 1) & (NBUF - 1)) * TB, P8); partialSM(PN0, PN1, negm, ALN); } \
    RESC(ALN); \
    if (!ATT_BAR2) { if ((j) + LEAD < NT) VMW(2 * (LEAD - 1)); else VMW(0); \
    TBAR(); } } while (0)
  for (int j = 1; j + 1 < NT; j += 2) {
    if (ATT_BAR2) { if (j + LEAD < NT) DMA(j + LEAD); if (j + LEAD + 1 < NT) DMA(j + LEAD + 1); }
    ITER(j, pB0, pB1, alB, pA0, pA1, alA);
    ITER(j + 1, pA0, pA1, alA, pB0, pB1, alB);
    if (ATT_BAR2) { if (j + LEAD + 1 < NT) VMW(2 * (LEAD - 2 - ATT_KPF)); else VMW(0); TBAR(); }
  }
  ITER(NT - 1, pB0, pB1, alB, pA0, pA1, alA);
#if ATT_Y8
  finishSMY(pB0, pB1, P8); SBAR();
  pv8s(o, lacc, vrd + ((NT - 1) & (NBUF - 1)) * TB, P8);
#else
  finishSM8(pB0, pB1, alB, l_reg, P8); SBAR();
  pv8(o, vrd + ((NT - 1) & (NBUF - 1)) * TB, P8);
#endif
#endif
#undef PSM
#undef VMW
#undef DMA
#undef TBAR
#undef QK8
#undef KLOAD
#undef ITER
#elif ATT_DMA && ATT_FP8
  const int vb0 = (int)(unsigned)(uintptr_t)lds + v_rd_base(lane);
  unsigned voffV[2], voffK[2];
#pragma unroll
  for (int t = 0; t < 2; ++t) { const int vi = wid * 2 + t, kg = vi >> 1, pair = vi & 1, sub = lane >> 5, row = (lane >> 2) & 7, chunk = lane & 3;
    voffV[t] = (unsigned)((8 * kg + row) * LDK + 32 * (2 * pair + sub) + 8 * chunk) * 2u;
    const int krow = 4 * vi + (lane >> 4), p = lane & 15;
    voffK[t] = (unsigned)(krow * LDK) * 2u + (unsigned)((p ^ (krow & 7)) * 16); }
  const int ldsw = wid * 2048; const unsigned v8off = (unsigned)(wid * 1024 + lane * 16); const LAS char* vrd = lds + hi * 1024 + r32 * 16; v8i P8;
  (void)voffV; (void)vb0;
#define DMA(t_) do { const char* vt_ = (const char*)(Vh + (size_t)(t_) * KVBLK * LDK); const char* kt_ = (const char*)(Kh + (size_t)(t_) * KVBLK * LDK); const int bo_ = ((t_) & 3) * BUFB; \
    _Pragma("unroll") for (int i_ = 0; i_ < 2; ++i_) { \
      __builtin_amdgcn_global_load_lds((const unsigned*)(kt_ + voffK[i_]), (LAS unsigned*)(lds + bo_ + (int)SHM_V + ldsw + i_ * 1024), 16, 0, 0); } \
    __builtin_amdgcn_global_load_lds((const unsigned*)(V8h + (size_t)(t_) * 65536 + v8off), (LAS unsigned*)(lds + bo_ + wid * 1024), 16, 0, 0); (void)vt_; } while (0)
#define RESC(a) do { if (__any((a) != 1.f)) { if (hi == 0) al_l[r32] = (a); asm volatile("s_waitcnt lgkmcnt(0)" ::: "memory"); \
    _Pragma("unroll") for (int r = 0; r < 16; ++r) { const float a_ = al_l[crow(r, hi)]; lacc[r] *= a_; _Pragma("unroll") for (int d = 0; d < 4; ++d) o[d][r] *= a_; } } } while (0)
#define TBAR() do { asm volatile("s_waitcnt lgkmcnt(0)" ::: "memory"); __builtin_amdgcn_s_barrier(); asm volatile("" ::: "memory"); } while (0)
#define KBUF(t_) (lds + ((t_) & 3) * BUFB + (int)SHM_V)
#define VBUF(t_) (vb0 + ((t_) & 3) * BUFB)
  f32x16 pA0, pA1, pB0, pB1; float alA, alB; bf16x8 pa0, pa1, pa2, pa3; const int NT = seq / KVBLK;
  DMA(0); DMA(1); if (2 < NT) DMA(2);
  if (2 < NT) asm volatile("s_waitcnt vmcnt(6)" ::: "memory"); else asm volatile("s_waitcnt vmcnt(3)" ::: "memory");
  TBAR();
  qkt(pA0, pA1, KBUF(0), qr, r32, hi, map, negm); partialSM(pA0, pA1, negm, alA);
  if (2 < NT) asm volatile("s_waitcnt vmcnt(3)" ::: "memory"); else asm volatile("s_waitcnt vmcnt(0)" ::: "memory");
  TBAR();
#define ITER(j, PN0, PN1, ALN, PO0, PO1, ALO) do { \
    if ((j) + 2 < NT) DMA((j) + 2); \
    SBAR(); qkt(PN0, PN1, KBUF(j), qr, r32, hi, map, negm); \
    finishSM8(PO0, PO1, ALO, l_reg, P8); SBAR(); \
    pv8(o, vrd + (((j) - 1) & 3) * BUFB, P8); partialSM(PN0, PN1, negm, ALN); \
    RESC(ALN); \
    if ((j) + 2 < NT) asm volatile("s_waitcnt vmcnt(3)" ::: "memory"); else asm volatile("s_waitcnt vmcnt(0)" ::: "memory"); \
    TBAR(); } while (0)
  for (int j = 1; j + 1 < NT; j += 2) {
    ITER(j, pB0, pB1, alB, pA0, pA1, alA);
    ITER(j + 1, pA0, pA1, alA, pB0, pB1, alB);
  }
  ITER(NT - 1, pB0, pB1, alB, pA0, pA1, alA);
  finishSM8(pB0, pB1, alB, l_reg, P8); SBAR();
  pv8(o, vrd + ((NT - 1) & 3) * BUFB, P8);
#undef DMA
#undef TBAR
#undef KBUF
#undef VBUF
#undef ITER
#elif ATT_DMA
  const int vb0 = (int)(unsigned)(uintptr_t)lds + v_rd_base(lane);
  unsigned voffV[2], voffK[2];
#pragma unroll
  for (int t = 0; t < 2; ++t) { const int vi = wid * 2 + t, kg = vi >> 1, pair = vi & 1, sub = lane >> 5, row = (lane >> 2) & 7, chunk = lane & 3;
    voffV[t] = (unsigned)((8 * kg + row) * LDK + 32 * (2 * pair + sub) + 8 * chunk) * 2u;
    const int krow = 4 * vi + (lane >> 4), p = lane & 15;
    voffK[t] = (unsigned)(krow * LDK) * 2u + (unsigned)((p ^ (krow & 7)) * 16); }
  const int ldsw = wid * 2048;
#define DMA(t_) do { const char* vt_ = (const char*)(Vh + (size_t)(t_) * KVBLK * LDK); const char* kt_ = (const char*)(Kh + (size_t)(t_) * KVBLK * LDK); const int bo_ = ((t_) & 3) * BUFB; \
    _Pragma("unroll") for (int i_ = 0; i_ < 2; ++i_) { \
      __builtin_amdgcn_global_load_lds((const unsigned*)(vt_ + voffV[i_]), (LAS unsigned*)(lds + bo_ + ldsw + i_ * 1024), 16, 0, 0); \
      __builtin_amdgcn_global_load_lds((const unsigned*)(kt_ + voffK[i_]), (LAS unsigned*)(lds + bo_ + (int)SHM_V + ldsw + i_ * 1024), 16, 0, 0); } } while (0)
#define RESC(a) do { if (__any((a) != 1.f)) { if (hi == 0) al_l[r32] = (a); asm volatile("s_waitcnt lgkmcnt(0)" ::: "memory"); \
    _Pragma("unroll") for (int r = 0; r < 16; ++r) { const float a_ = al_l[crow(r, hi)]; lacc[r] *= a_; _Pragma("unroll") for (int d = 0; d < 4; ++d) o[d][r] *= a_; } } } while (0)
#define TBAR() do { asm volatile("s_waitcnt lgkmcnt(0)" ::: "memory"); __builtin_amdgcn_s_barrier(); asm volatile("" ::: "memory"); } while (0)
#define KBUF(t_) (lds + ((t_) & 3) * BUFB + (int)SHM_V)
#define VBUF(t_) (vb0 + ((t_) & 3) * BUFB)
  f32x16 pA0, pA1, pB0, pB1; float alA, alB; bf16x8 pa0, pa1, pa2, pa3; const int NT = seq / KVBLK;
  DMA(0); DMA(1); if (2 < NT) DMA(2);
  if (2 < NT) asm volatile("s_waitcnt vmcnt(8)" ::: "memory"); else asm volatile("s_waitcnt vmcnt(4)" ::: "memory");
  TBAR();
  qkt(pA0, pA1, KBUF(0), qr, r32, hi, map, negm); partialSM(pA0, pA1, negm, alA);
  if (2 < NT) asm volatile("s_waitcnt vmcnt(4)" ::: "memory"); else asm volatile("s_waitcnt vmcnt(0)" ::: "memory");
  TBAR();
#define ITER(j, PN0, PN1, ALN, PO0, PO1, ALO) do { \
    if ((j) + 2 < NT) DMA((j) + 2); \
    SBAR(); qkt(PN0, PN1, KBUF(j), qr, r32, hi, map, negm); \
    finishSM(PO0, PO1, ALO, l_reg, pa0, pa1, pa2, pa3); SBAR(); \
    pv_d0(o, VBUF((j) - 1), pa0, pa1, pa2, pa3, lacc); partialSM(PN0, PN1, negm, ALN); \
    RESC(ALN); \
    if ((j) + 2 < NT) asm volatile("s_waitcnt vmcnt(4)" ::: "memory"); else asm volatile("s_waitcnt vmcnt(0)" ::: "memory"); \
    TBAR(); } while (0)
  for (int j = 1; j + 1 < NT; j += 2) {
    ITER(j, pB0, pB1, alB, pA0, pA1, alA);
    ITER(j + 1, pA0, pA1, alA, pB0, pB1, alB);
  }
  ITER(NT - 1, pB0, pB1, alB, pA0, pA1, alA);
  finishSM(pB0, pB1, alB, l_reg, pa0, pa1, pa2, pa3); SBAR();
  pv_d0(o, VBUF(NT - 1), pa0, pa1, pa2, pa3, lacc);
#undef DMA
#undef TBAR
#undef KBUF
#undef VBUF
#undef ITER
#else
  const int sr = tid >> 4, sc = (tid & 15) * 8, vst0 = v_st(sr, sc), vst1 = v_st(32 + sr, sc);
  const int vb0 = (int)(unsigned)(uintptr_t)lds + v_rd_base(lane);
  struct { bf16x8 vs0, vs1, ks0, ks1; } sr_[2];
  const unsigned goff = (unsigned)(sr * LDK + sc) * 2u;
#define SLOAD(i, k0) do { const char* vt_ = (const char*)(Vh + (size_t)(k0) * LDK); const char* kt_ = (const char*)(Kh + (size_t)(k0) * LDK); \
    sr_[i].vs0 = *(const bf16x8*)(vt_ + goff); sr_[i].vs1 = *(const bf16x8*)(vt_ + (size_t)32 * LDK * 2 + goff); sr_[i].ks0 = *(const bf16x8*)(kt_ + goff); sr_[i].ks1 = *(const bf16x8*)(kt_ + (size_t)32 * LDK * 2 + goff); } while (0)
#define SWRITE(b, i) do { *(LAS bf16x8*)(lds + (b) * BUFB + vst0) = sr_[i].vs0; *(LAS bf16x8*)(lds + (b) * BUFB + vst1) = sr_[i].vs1; const int kc = sc * 2; \
    *(LAS bf16x8*)(lds + (b) * BUFB + (int)SHM_V + KSWZ(sr, kc)) = sr_[i].ks0; *(LAS bf16x8*)(lds + (b) * BUFB + (int)SHM_V + KSWZ(32 + sr, kc)) = sr_[i].ks1; } while (0)
#define SWAIT() asm volatile("s_waitcnt vmcnt(4)" ::: "memory")
#define RESC(a) do { if (__any((a) != 1.f)) { if (hi == 0) al_l[r32] = (a); asm volatile("s_waitcnt lgkmcnt(0)" ::: "memory"); \
    _Pragma("unroll") for (int r = 0; r < 16; ++r) { const float a_ = al_l[crow(r, hi)]; lacc[r] *= a_; _Pragma("unroll") for (int d = 0; d < 4; ++d) o[d][r] *= a_; } } } while (0)
  f32x16 pA0, pA1, pB0, pB1; float alA, alB; bf16x8 pa0, pa1, pa2, pa3; const int NT = seq / KVBLK;
  constexpr int SE = 0, SO = 1;
  LAS char* K0 = lds + (int)SHM_V; LAS char* K1 = lds + BUFB + (int)SHM_V;
  SLOAD(SE, 0); asm volatile("s_waitcnt vmcnt(0)" ::: "memory"); SWRITE(0, SE); __syncthreads();
  qkt(pA0, pA1, K0, qr, r32, hi, map, negm); partialSM(pA0, pA1, negm, alA);
  SLOAD(SO, KVBLK); if (2 < NT) SLOAD(SE, 2 * KVBLK);
  SWAIT(); SWRITE(1, SO); __syncthreads();
#define XBAR() do { if (VAR != 1) __syncthreads(); } while (0)
#define XQK(P0, P1, KK) do { if (VAR != 5) qkt(P0, P1, KK, qr, r32, hi, map, negm); } while (0)
#define XFIN(P0, P1, AL) do { if (VAR != 2) finishSM(P0, P1, AL, l_reg, pa0, pa1, pa2, pa3); } while (0)
#define XPAR(P0, P1, AL) do { if (VAR != 2) partialSM(P0, P1, negm, AL); } while (0)
#define XPV(VB) do { if (VAR != 3) pv_d0(o, VB, pa0, pa1, pa2, pa3, lacc); } while (0)
#define XLOAD(i, k0) do { if (VAR != 4) SLOAD(i, k0); } while (0)
#define XWRITE(b, i) do { if (VAR != 4) { SWAIT(); SWRITE(b, i); } } while (0)
  if (VAR == 2) { pa0 = qr[0]; pa1 = qr[1]; pa2 = qr[2]; pa3 = qr[3]; alA = 1.f; alB = 1.f; }
  if (VAR == 5) { pA0 = f32x16{}; pA1 = pA0; pB0 = pA0; pB1 = pA0; }
  for (int j = 1; j + 1 < NT; j += 2) {
    SBAR(); XQK(pB0, pB1, K1);
    XFIN(pA0, pA1, alA); SBAR();
    XLOAD(SO, (j + 2) * KVBLK); SBAR();
    XPV(vb0); XPAR(pB0, pB1, alB);
    XBAR(); XWRITE(0, SE);
    RESC(alB); XBAR();
    SBAR(); XQK(pA0, pA1, K0);
    XFIN(pB0, pB1, alB); SBAR();
    if (j + 3 < NT) XLOAD(SE, (j + 3) * KVBLK); SBAR();
    XPV(vb0 + BUFB); XPAR(pA0, pA1, alA);
    XBAR(); XWRITE(1, SO);
    RESC(alA); XBAR();
  }
  SBAR(); qkt(pB0, pB1, K1, qr, r32, hi, map, negm);
  finishSM(pA0, pA1, alA, l_reg, pa0, pa1, pa2, pa3); SBAR();
  pv_d0(o, vb0, pa0, pa1, pa2, pa3, lacc); partialSM(pB0, pB1, negm, alB);
  __syncthreads(); RESC(alB);
  finishSM(pB0, pB1, alB, l_reg, pa0, pa1, pa2, pa3); SBAR();
  pv_d0(o, vb0 + BUFB, pa0, pa1, pa2, pa3, lacc);
#endif
  {
    const int tid2 = fresh_tid(wave), wid2 = tid2 >> 6, lane2 = tid2 & 63, r32b = lane2 & 31, hib = lane2 >> 5, mapb = wid2 >> 2, wqb = wid2 & 3;
    LAS float* li2 = (LAS float*)(lds + WSF_OFF) + wid2 * 64;
    float rli[16];
#if ATT_LMFMA || ATT_Y8
    (void)li2;
#pragma unroll
    for (int r = 0; r < 16; ++r) rli[r] = __builtin_amdgcn_rcpf(lacc[r]);
#else
    if (hib == 0) li2[r32b] = l_reg; asm volatile("s_waitcnt lgkmcnt(0)" ::: "memory");
#pragma unroll
    for (int r = 0; r < 16; ++r) rli[r] = __builtin_amdgcn_rcpf(li2[crow(r, hib)]);
#endif
    __syncthreads();
    LAS float* X = (LAS float*)lds + (wqb * 32 + 4 * hib) * 128 + r32b;
    if (mapb == 1) {
#pragma unroll
      for (int r = 0; r < 16; ++r)
#pragma unroll
        for (int d0 = 0; d0 < 4; ++d0) X[((r & 3) + 8 * (r >> 2)) * 128 + d0 * 32] = o[d0][r] * rli[r] * lam;
    }
    __syncthreads();
    if (mapb == 0) {
      float gs[4];
#pragma unroll
      for (int d0 = 0; d0 < 4; ++d0) gs[d0] = gsub[d0 * 32 + r32b] * oscale;
      bf16* Ow = Ob + (long)(wqb * 32 + 4 * hib) * D + r32b;
#pragma unroll
      for (int r = 0; r < 16; ++r) {
        float ss = 0.f;
#pragma unroll
        for (int d0 = 0; d0 < 4; ++d0) { const float v = o[d0][r] * rli[r] - X[((r & 3) + 8 * (r >> 2)) * 128 + d0 * 32]; o[d0][r] = v; ss += v * v; }
        ss = half_sum(ss);
        const float rs = 1.0f / sqrtf(ss * (1.0f / 128.0f) + NORM_EPS);
#pragma unroll
        for (int d0 = 0; d0 < 4; ++d0) Ow[(long)((r & 3) + 8 * (r >> 2)) * D + d0 * 32] = (bf16)f2bf(o[d0][r] * rs * gs[d0]);
      }
    }
    __syncthreads();
  }
#if ATT_DMA && ATT_FP8 && ATT_QK8 && ATT_Y8 && ATT_P2 && P2_AB
  };
  if (map == 0) run_(std::integral_constant<int, 0>{}); else run_(std::integral_constant<int, 1>{});
#endif
#if !ATT_DMA
#undef XBAR
#undef XQK
#undef XFIN
#undef XPAR
#undef XPV
#undef XLOAD
#undef XWRITE
#undef SLOAD
#undef SWRITE
#undef SWAIT
#endif
#undef RESC
}
#undef KSWZ
}


__device__ __forceinline__ void v8_phase(Frame& F, const Params& P) {
    unsigned char* ws = fresh_ws(P.ws);
    const bf16* vb = (const bf16*)(ws + WS_VB); unsigned char* v8 = ws + WS_V8;
    const Lane L(F.wave); const int gw = F.vcu * NWAVES + F.wave, NGW = F.G * NWAVES, lane = L.lane;
    for (int tile = gw; tile < NB * (KVLEN / 64) * 8; tile += NGW) {
        const int h = tile & 7, t = (tile >> 3) % (KVLEN / 64), b = (tile >> 3) / (KVLEN / 64);
        const bf16* src = vb + ((size_t)b * KVLEN + 64 * t) * 1024 + h * 128;
        v4u* dst = (v4u*)(v8 + (size_t)tile * 8192);
#pragma unroll 2
        for (int q = 0; q < 8; ++q) {
            const int c = lane + 64 * q, d = c & 31, half = (c >> 5) & 1, hi = (c >> 6) & 1, d0 = c >> 7;
            const bf16* col = src + 32 * d0 + d + (size_t)(4 * hi + 32 * half) * 1024;
            float v[16];
#pragma unroll
            for (int j = 0; j < 16; ++j) { const float x = bf2f(col[(size_t)((j & 3) + 8 * (j >> 2)) * 1024]); v[j] = fminf(fmaxf(x, -448.f), 448.f); }
            v4u w;
            w.x = (unsigned)__builtin_amdgcn_cvt_pk_fp8_f32(v[2], v[3], __builtin_amdgcn_cvt_pk_fp8_f32(v[0], v[1], 0, false), true);
            w.y = (unsigned)__builtin_amdgcn_cvt_pk_fp8_f32(v[6], v[7], __builtin_amdgcn_cvt_pk_fp8_f32(v[4], v[5], 0, false), true);
            w.z = (unsigned)__builtin_amdgcn_cvt_pk_fp8_f32(v[10], v[11], __builtin_amdgcn_cvt_pk_fp8_f32(v[8], v[9], 0, false), true);
            w.w = (unsigned)__builtin_amdgcn_cvt_pk_fp8_f32(v[14], v[15], __builtin_amdgcn_cvt_pk_fp8_f32(v[12], v[13], 0, false), true);
            dst[c] = w;
        }
#if ATT_QK8 && !K8_DIRECT
        const bf16* ksrc = (const bf16*)(ws + WS_KB) + ((size_t)b * KVLEN + 64 * t) * 1024 + h * 128;
        v4u* kdst = (v4u*)(ws + WS_K8 + (size_t)tile * 8192);
#pragma unroll 2
        for (int q = 0; q < 8; ++q) {
            const int c = lane + 64 * q, key = c & 63, half = (c >> 6) & 1, hi = (c >> 7) & 1, map = c >> 8;
            const bf16* p = ksrc + (size_t)key * 1024 + map * 64 + 32 * hi + 16 * half;
            float v[16]; { float a[8], bq[8]; ld8f(p, a); ld8f(p + 8, bq);
#pragma unroll
              for (int j = 0; j < 8; ++j) { v[j] = fminf(fmaxf(a[j], -448.f), 448.f); v[8 + j] = fminf(fmaxf(bq[j], -448.f), 448.f); } }
            v4u w;
            w.x = (unsigned)__builtin_amdgcn_cvt_pk_fp8_f32(v[2], v[3], __builtin_amdgcn_cvt_pk_fp8_f32(v[0], v[1], 0, false), true);
            w.y = (unsigned)__builtin_amdgcn_cvt_pk_fp8_f32(v[6], v[7], __builtin_amdgcn_cvt_pk_fp8_f32(v[4], v[5], 0, false), true);
            w.z = (unsigned)__builtin_amdgcn_cvt_pk_fp8_f32(v[10], v[11], __builtin_amdgcn_cvt_pk_fp8_f32(v[8], v[9], 0, false), true);
            w.w = (unsigned)__builtin_amdgcn_cvt_pk_fp8_f32(v[14], v[15], __builtin_amdgcn_cvt_pk_fp8_f32(v[12], v[13], 0, false), true);
            kdst[c] = w;
        }
#endif
    }
}
template <int VAR>
__device__ __forceinline__ void attn_phase(Frame& F, const Params& P, int layer, bool ctx_out, unsigned char* ldsg) {
    (void)ldsg;
    unsigned char* ws = fresh_ws(P.ws);
    const bf16* qb = (const bf16*)(ws + WS_Q); const bf16* kb = (const bf16*)(ws + WS_KB); const bf16* vb = (const bf16*)(ws + WS_VB); bf16* cat = (bf16*)(ws + (VAR == 0 ? WS_CAT : WS_H));
    const Lane L(F.wave);
    const float lam_init = __builtin_bit_cast(float, __builtin_amdgcn_readfirstlane(__builtin_bit_cast(int, 0.8f - 0.6f * expf(-0.3f * (float)layer))));
    const float* lv = P.in[I_LAMBDA] + layer * 256;
    const float d1 = wave_sum(lv[L.lane] * lv[64 + L.lane]), d2 = wave_sum(lv[128 + L.lane] * lv[192 + L.lane]);
    const float lam = __builtin_bit_cast(float, __builtin_amdgcn_readfirstlane(__builtin_bit_cast(int, expf(d1) - expf(d2) + lam_init)));
    const float* gsub = P.in[I_SUBLN] + layer * 128;
    const int nun = NB * 8 * 64 + (ctx_out ? NB * 8 * 2 : 0);
    for (int uid = F.vcu; uid < nun; uid += F.G) {
        int qt, h, b, seq; size_t qrow;
        if (uid < NB * 8 * 64) { qt = uid & 63; h = (uid >> 6) & 7; b = uid >> 9; qrow = (size_t)b * SEQ + 128 * qt; seq = KVLEN; }
        else { const int u2 = uid - NB * 8 * 64; qt = u2 & 1; h = (u2 >> 1) & 7; b = u2 >> 4; qrow = (size_t)NLAT + b * CTXL + 128 * qt; seq = CTXL; }
        att::diff_attn_unit<VAR>(Q8_DIRECT ? (const bf16*)((const unsigned char*)qb + qrow * 1024 + h * 128) : qb + qrow * 1024 + h * 128, kb + (size_t)b * KVLEN * 1024 + h * 128, vb + (size_t)b * KVLEN * 1024 + h * 128,
                            cat + qrow * D + 1024 + h * 128, seq, (LAS char*)F.lds, lam, gsub, 1.0f - lam_init, F.wave, ws + WS_V8 + ((size_t)b * (KVLEN / 64) * 8 + h) * 8192, (const unsigned char*)qb);
    }
}
struct MoePanels { int ps[9]; };
__device__ __forceinline__ MoePanels moe_panels(Frame& F) {
    MoePanels m; int acc = 0;
#pragma unroll
    for (int e = 0; e < NE; ++e) { m.ps[e] = acc; const int c = (int)__builtin_amdgcn_readfirstlane(__hip_atomic_load(F.ctl + CW_CNT + 64 * e, RLX_AGENT)); acc += (c + 255) >> 8; }
    m.ps[8] = acc; return m;
}
__device__ __forceinline__ void moe_gather_phase(Frame& F, const Params& P) {
    unsigned char* ws = fresh_ws(P.ws);
    const bf16* h = (const bf16*)(ws + WS_H); bf16* Ag = (bf16*)(ws + WS_AG);
    const int* tok_e = (const int*)(ws + WS_ROUTE); const int* tok_slot = tok_e + 2 * NLAT;
    const float* hs = (const float*)(ws + WS_HS); float* ags = (float*)(ws + WS_AGS);
    const MoePanels mp = moe_panels(F);
    const Lane L(F.wave); const int gw = F.vcu * NWAVES + F.wave, NGW = F.G * NWAVES, lane = L.lane;
    for (int a = gw; a < 2 * NLAT; a += NGW) {
        const int r = a >> 1, e = tok_e[a], slot = tok_slot[a];
        int pse = 0;
#pragma unroll
        for (int q = 0; q < NE; ++q) pse = (q == e) ? mp.ps[q] : pse;
        const v4u* src = (const v4u*)((const unsigned char*)h + (size_t)r * D) + lane; v4u* dst = (v4u*)((unsigned char*)Ag + ((size_t)pse * 256 + slot) * D) + lane;
#pragma unroll
        for (int j = 0; j < 2; ++j) dst[64 * j] = src[64 * j];
#if I8_GU
        if (lane == 0) ags[pse * 256 + slot] = hs[r];
#endif
    }
    for (int e = 0; e < NE; ++e) {
        const int c = (int)__builtin_amdgcn_readfirstlane(__hip_atomic_load(F.ctl + CW_CNT + 64 * e, RLX_AGENT));
        const int pad = ((c + 255) & ~255) - c;
        for (int q = gw; q < pad; q += NGW) { v4u* dst = (v4u*)((unsigned char*)Ag + ((size_t)mp.ps[e] * 256 + c + q) * D) + lane;
#pragma unroll
            for (int j = 0; j < 2; ++j) dst[64 * j] = (v4u){0u, 0u, 0u, 0u};
#if I8_GU
            if (lane == 0) ags[mp.ps[e] * 256 + c + q] = 0.f;
#endif
        }
    }
}
__device__ __forceinline__ void final_phase(Frame& F, const Params& P, const float* modl) {
    unsigned char* ws = fresh_ws(P.ws);
    const bf16* xl = (const bf16*)(ws + WS_XL); const bf16* yb = (const bf16*)(ws + WS_AG);
    const int* tok_e = (const int*)(ws + WS_ROUTE); const int* tok_slot = tok_e + 2 * NLAT; const float* tok_p = (const float*)(tok_slot + 2 * NLAT);
    const MoePanels mp = moe_panels(F);
    const Lane L(F.wave); const int gw = F.vcu * NWAVES + F.wave, NGW = F.G * NWAVES, lane = L.lane;
    const float* gf = P.in[I_GFIN];
    for (int r = gw; r < NLAT; r += NGW) {
        const int v = r < SEQ ? 0 : 1; const float* g5 = modl + (size_t)(v * 6 + 5) * D;
        const int e0 = tok_e[2 * r], e1 = tok_e[2 * r + 1];
        int p0s = 0, p1s = 0;
#pragma unroll
        for (int q = 0; q < NE; ++q) { p0s = (q == e0) ? mp.ps[q] : p0s; p1s = (q == e1) ? mp.ps[q] : p1s; }
        const bf16* y0 = yb + ((size_t)p0s * 256 + tok_slot[2 * r]) * D; const bf16* y1 = yb + ((size_t)p1s * 256 + tok_slot[2 * r + 1]) * D;
        const float w0 = tok_p[2 * r], w1 = tok_p[2 * r + 1];
        f32x4 x[8]; float ss = 0.f;
#pragma unroll
        for (int jq = 0; jq < 8; ++jq) { const int c = 4 * lane + 256 * jq;
            const v2u a = *(const v2u*)(y0 + c), bq = *(const v2u*)(y1 + c); const f32x4 g = *(const f32x4*)(g5 + c); const f32x4 xv = ld4_bf16(xl + (size_t)r * D + c);
            f32x4 y; y[0] = w0 * bflo(a.x) + w1 * bflo(bq.x); y[1] = w0 * bfhi(a.x) + w1 * bfhi(bq.x); y[2] = w0 * bflo(a.y) + w1 * bflo(bq.y); y[3] = w0 * bfhi(a.y) + w1 * bfhi(bq.y);
            x[jq] = xv + g * y; ss += (x[jq][0] * x[jq][0] + x[jq][1] * x[jq][1]) + (x[jq][2] * x[jq][2] + x[jq][3] * x[jq][3]); }
        const float rstd = 1.0f / sqrtf(wave_sum(ss) * (1.0f / D) + NORM_EPS);
#pragma unroll
        for (int jq = 0; jq < 8; ++jq) { const int c = 4 * lane + 256 * jq; const f32x4 ov_ = (x[jq] * rstd) * *(const f32x4*)(gf + c); if (FIN_NT) __builtin_nontemporal_store(ov_, (f32x4*)(P.out + (size_t)r * D + c)); else *(f32x4*)(P.out + (size_t)r * D + c) = ov_; }
    }
}
#if DBG == 1
constexpr size_t WS_DBG = 3 * MiB;
__device__ __forceinline__ void dbg_err(Frame& F, int k, float got, float want, float scale) {
    float e = fabsf(got - want) / scale; if (!(e == e)) e = 1e9f;
    atomicMax((unsigned*)(F.ctl + CW_DIAG + 64 * k), __float_as_uint(e));
}
__device__ __forceinline__ unsigned dbg_hash(unsigned x) { x ^= x >> 16; x *= 0x7feb352du; x ^= x >> 15; x *= 0x846ca68bu; x ^= x >> 16; return x; }
__device__ __forceinline__ float block_sum(float v, LAS float* red, int tid) {
    v = wave_sum(v); __syncthreads(); if ((tid & 63) == 0) red[tid >> 6] = v; __syncthreads();
    float s = 0.f; for (int w = 0; w < 8; ++w) s += red[w]; __syncthreads(); return s;
}
__device__ __forceinline__ float block_max(float v, LAS float* red, int tid) {
    v = fmaxf(v, dpp_f(v, 0)); v = fmaxf(v, dpp_f(v, 1)); v = fmaxf(v, dpp_f(v, 2)); v = fmaxf(v, dpp_f(v, 3));
    v = fmaxf(v, __builtin_bit_cast(float, __builtin_amdgcn_ds_swizzle(__builtin_bit_cast(int, v), 0x401F)));
    v = cross_max(v);
    __syncthreads(); if ((tid & 63) == 0) red[tid >> 6] = v; __syncthreads();
    float s = red[0]; for (int w = 1; w < 8; ++w) s = fmaxf(s, red[w]); __syncthreads(); return s;
}
__device__ __forceinline__ const float* dbg_res_row(const Params& P, int layer, int r) {
    const float* xl = (const float*)(fresh_ws(P.ws) + WS_XL);
    if (layer == 0) return r < NLAT ? P.in[I_X] + (size_t)r * D : P.in[I_CTX] + (size_t)(r - NLAT) * D;
    return xl + (size_t)r * D;
}
__device__ __forceinline__ int dbg_vec(int r) { return r < SEQ ? 0 : (r < NLAT ? 1 : 2); }

__device__ __forceinline__ void dbg_check_norm(Frame& F, const Params& P, int layer) {
    const int tid = fresh_tid(F.wave); LAS float* hn = (LAS float*)F.lds; LAS float* red = hn + D;
    const float* modl = (const float*)(fresh_ws(P.ws) + WS_MOD) + (size_t)layer * 3 * 12288;
    { const float t1 = block_sum(1.0f, red, tid), t2 = block_sum((float)tid, red, tid), t3 = wave_sum((float)(tid & 63));
      dbg_err(F, 2, t1, 512.0f, 1.0f); dbg_err(F, 3, t2, 130816.0f, 1.0f); dbg_err(F, 4, t3, 2016.0f, 1.0f); }
    for (int s = F.vcu; s < 256; s += F.G) {
        const unsigned hsh = dbg_hash(s * 2654435761u + 17u + layer);
        const int r = (s & 7) == 7 ? NLAT + (hsh % NCTX) : (int)(hsh % NLAT);
        const float* xr = dbg_res_row(P, layer, r); const int v = dbg_vec(r);
        float ss = 0.f; for (int k = tid; k < D; k += 512) ss += xr[k] * xr[k];
        ss = block_sum(ss, red, tid); const float rstd = 1.0f / sqrtf(ss / D + NORM_EPS);
        const bf16* hr = (const bf16*)(fresh_ws(P.ws) + WS_H) + (size_t)r * D;
        for (int k = tid; k < D; k += 512) { const float want = (xr[k] * rstd * P.in[I_GMIX][layer * D + k]) * (1.0f + modl[(v * 6 + 1) * D + k]) + modl[(v * 6 + 0) * D + k]; dbg_err(F, 0, bf2f(hr[k]), want, 1.0f); }
        const int v2 = s % 3, j = (int)((hsh >> 5) % 12288);
        float a = 0.f; for (int k = tid; k < D; k += 512) { const float c = v2 < 2 ? P.in[I_C][v2 * D + k] : P.in[I_CCTX][k]; a += c / (1.0f + expf(-c)) * P.in[I_WMOD][((size_t)layer * D + k) * 12288 + j]; }
        a = block_sum(a, red, tid);
        if (tid == 0) dbg_err(F, 1, modl[v2 * 12288 + j], a + P.in[I_BMOD][layer * 12288 + j], 1.0f);
        __syncthreads();
    }
}
__device__ __forceinline__ void dbg_check_inproj(Frame& F, const Params& P, int layer) {
    const int tid = fresh_tid(F.wave); LAS float* hn = (LAS float*)F.lds; LAS float* red = hn + D;
    const float* modl = (const float*)(fresh_ws(P.ws) + WS_MOD) + (size_t)layer * 3 * 12288;
    for (int s = F.vcu; s < 256; s += F.G) {
        const unsigned hsh = dbg_hash(s * 2654435761u + 17u + layer);
        const int r = (s & 7) == 7 ? NLAT + (hsh % NCTX) : (int)(hsh % NLAT);
        int c = (int)((hsh >> 8) % IN_COLS); if ((s & 3) == 1) c = COL_Q + (int)((hsh >> 8) % 1024); if ((s & 3) == 2) c = COL_K + (int)((hsh >> 8) % 1024); if ((s & 15) == 3) c = COL_DT + (int)((hsh >> 8) % 16);
        const float* xr = dbg_res_row(P, layer, r); const int v = dbg_vec(r);
        float ss = 0.f; for (int k = tid; k < D; k += 512) ss += xr[k] * xr[k];
        ss = block_sum(ss, red, tid); const float rstd = 1.0f / sqrtf(ss / D + NORM_EPS);
        for (int k = tid; k < D; k += 512) hn[k] = (xr[k] * rstd * P.in[I_GMIX][layer * D + k]) * (1.0f + modl[(v * 6 + 1) * D + k]) + modl[(v * 6 + 0) * D + k];
        __syncthreads();
        const float* w = P.in[I_WIN] + (size_t)layer * D * IN_COLS;
        const bool qk = (c >= COL_Q && c < COL_Q + 1024) || (c >= COL_K && c < COL_K + 1024);
        int cp = c; if (qk) { const int base = c >= COL_K ? COL_K : COL_Q; const int cl = (c - base) & 31; cp = c - cl + ((cl + 16) & 31); }
        float d0 = 0.f, d1 = 0.f; for (int k = tid; k < D; k += 512) { d0 += hn[k] * w[(size_t)k * IN_COLS + c]; d1 += hn[k] * w[(size_t)k * IN_COLS + cp]; }
        d0 = block_sum(d0, red, tid); d1 = block_sum(d1, red, tid);
        if (tid == 0) {
            float want = d0, got;
            if (c < COL_Z) got = bf2f(((const bf16*)(fresh_ws(P.ws) + WS_CONV))[(size_t)r * 1536 + c]);
            else if (c < COL_Q) got = bf2f(((const bf16*)(fresh_ws(P.ws) + WS_Z))[(size_t)r * 512 + c - COL_Z]);
            else if (c < COL_XBC) got = 0.f;
            else if (c < COL_DT) got = bf2f(((const bf16*)(fresh_ws(P.ws) + WS_XBC))[(size_t)r * 1024 + c - COL_XBC]);
            else if (c < COL_K) got = ((const float*)(fresh_ws(P.ws) + WS_DT))[(size_t)r * 16 + c - COL_DT];
            else if (c < COL_V) got = 0.f;
            else { const size_t kr = r < NLAT ? (size_t)(r / SEQ) * KVLEN + CTXL + (r % SEQ) : (size_t)((r - NLAT) / CTXL) * KVLEN + (r - NLAT) % CTXL; got = bf2f(((const bf16*)(fresh_ws(P.ws) + WS_VB))[kr * 1024 + c - COL_V]); }
            if (qk) {
                const int base = c >= COL_K ? COL_K : COL_Q; const int cc = c - base, cl = cc & 31, seg = (cc >> 5) & 1, f = cl & 15;
                if (r < NLAT) { const int t = r % SEQ; const float pos = seg ? (float)(t % 64) : (float)(t / 64); const float inv = powf(10000.0f, -(float)f / 16.0f); const float ang = pos * inv;
                    want = cl < 16 ? d0 * cosf(ang) - d1 * sinf(ang) : d0 * cosf(ang) + d1 * sinf(ang); }
                const int mem = (cc & ~31) + pg8::perm32(cl);
                if (base == COL_Q) got = bf2f(((const bf16*)(fresh_ws(P.ws) + WS_Q))[(size_t)r * 1024 + mem]);
                else { const size_t kr = r < NLAT ? (size_t)(r / SEQ) * KVLEN + CTXL + (r % SEQ) : (size_t)((r - NLAT) / CTXL) * KVLEN + (r - NLAT) % CTXL; got = bf2f(((const bf16*)(fresh_ws(P.ws) + WS_KB))[kr * 1024 + mem]); }
            }
            { const int seg = ((c - (c >= COL_K ? COL_K : COL_Q)) >> 5) & 1; const int slot = (r < NLAT ? 0 : 3) + (qk ? 1 + seg : 0); dbg_err(F, slot, got, want, 1.0f); }
        }
        __syncthreads();
    }
}
__device__ __forceinline__ void dbg_check_attn(Frame& F, const Params& P, int layer) {
    const int tid = fresh_tid(F.wave); LAS float* sc1 = (LAS float*)F.lds; LAS float* sc2 = sc1 + KVLEN; LAS float* red = sc2 + KVLEN; LAS float* ov = red + 16; LAS float* qv = ov + 512;
    const bf16* qb = (const bf16*)(fresh_ws(P.ws) + WS_Q); const bf16* kb = (const bf16*)(fresh_ws(P.ws) + WS_KB); const bf16* vb = (const bf16*)(fresh_ws(P.ws) + WS_VB); const bf16* cat = (const bf16*)(fresh_ws(P.ws) + WS_CAT);
    const float lam_init = 0.8f - 0.6f * expf(-0.3f * (float)layer); const float* lv = P.in[I_LAMBDA] + layer * 256;
    float d1 = 0.f, d2 = 0.f; for (int i = 0; i < 64; ++i) { d1 += lv[i] * lv[64 + i]; d2 += lv[128 + i] * lv[192 + i]; }
    const float lam = expf(d1) - expf(d2) + lam_init;
    for (int s = F.vcu; s < 64; s += F.G) {
        const unsigned hsh = dbg_hash(s * 2654435761u + 99u + layer);
        const bool isctx = layer == 0 && (s & 7) == 7; const int h = (hsh >> 4) & 7;
        const int r = isctx ? NLAT + (int)(hsh % NCTX) : (int)((hsh >> 7) % NLAT);
        const int b = isctx ? (r - NLAT) / CTXL : r / SEQ; const int nk = isctx ? CTXL : KVLEN;
        if (tid < 128) qv[tid] = bf2f(qb[(size_t)r * 1024 + h * 128 + tid]);
        __syncthreads();
        float m1 = -1e30f, m2 = -1e30f;
        for (int k = tid; k < nk; k += 512) { const bf16* kr = kb + ((size_t)b * KVLEN + k) * 1024 + h * 128; float a = 0.f, c2 = 0.f;
            for (int d = 0; d < 64; ++d) { a += qv[d] * bf2f(kr[d]); c2 += qv[64 + d] * bf2f(kr[64 + d]); }
            a *= 0.125f; c2 *= 0.125f; sc1[k] = a; sc2[k] = c2; m1 = fmaxf(m1, a); m2 = fmaxf(m2, c2); }
        m1 = block_max(m1, red, tid); m2 = block_max(m2, red, tid);
        float l1 = 0.f, l2 = 0.f;
        for (int k = tid; k < nk; k += 512) { const float p1 = expf(sc1[k] - m1), p2 = expf(sc2[k] - m2); sc1[k] = p1; sc2[k] = p2; l1 += p1; l2 += p2; }
        l1 = block_sum(l1, red, tid); l2 = block_sum(l2, red, tid);
        { const int d = tid & 127, part = tid >> 7; float o = 0.f;
          for (int k = part; k < nk; k += 4) o += (sc1[k] / l1 - lam * sc2[k] / l2) * bf2f(vb[((size_t)b * KVLEN + k) * 1024 + h * 128 + d]);
          ov[tid] = o; }
        __syncthreads();
        float o = 0.f, sq = 0.f; if (tid < 128) { o = ov[tid] + ov[128 + tid] + ov[256 + tid] + ov[384 + tid]; sq = o * o; }
        sq = block_sum(sq, red, tid);
        if (tid < 128) { const float want = o / sqrtf(sq / 128.0f + NORM_EPS) * P.in[I_SUBLN][layer * 128 + tid] * (1.0f - lam_init);
            dbg_err(F, 1, bf2f(cat[(size_t)r * D + 1024 + h * 128 + tid]), want, 1.0f); }
        __syncthreads();
    }
}
__device__ __forceinline__ void dbg_expect_rows(Frame& F, const Params& P, int layer, int which) {
    const int tid = fresh_tid(F.wave); LAS float* hn = (LAS float*)F.lds; LAS float* act = hn + D; LAS float* red = act + FFD;
    const float* modl = (const float*)(fresh_ws(P.ws) + WS_MOD) + (size_t)layer * 3 * 12288; float* ex = (float*)(fresh_ws(P.ws) + WS_DBG) + (size_t)which * 16 * D;
    for (int s = F.vcu; s < 16; s += F.G) {
        const unsigned hsh = dbg_hash(s * 2654435761u + 7u + which * 131u + layer);
        const int r = (s & 7) == 7 && layer == 0 ? NLAT + (int)(hsh % NCTX) : (int)(hsh % NLAT); const int v = dbg_vec(r);
        if (which == 0) {
            const bf16* cr = (const bf16*)(fresh_ws(P.ws) + WS_CAT) + (size_t)r * D; const float* w = P.in[I_WOUT] + (size_t)layer * D * D; const float* res = dbg_res_row(P, layer, r);
            for (int k = tid; k < D; k += 512) hn[k] = bf2f(cr[k]);
            __syncthreads();
            for (int c = tid; c < D; c += 512) { float a = 0.f; for (int k = 0; k < D; ++k) a += hn[k] * w[(size_t)k * D + c]; ex[s * D + c] = res[c] + modl[(v * 6 + 2) * D + c] * a; }
        } else {
            const float* xr = (const float*)(fresh_ws(P.ws) + WS_XL) + (size_t)r * D;
            float ss = 0.f; for (int k = tid; k < D; k += 512) ss += xr[k] * xr[k];
            ss = block_sum(ss, red, tid); const float rstd = 1.0f / sqrtf(ss / D + NORM_EPS);
            for (int k = tid; k < D; k += 512) hn[k] = (xr[k] * rstd * P.in[I_GFFN][layer * D + k]) * (1.0f + modl[(v * 6 + 4) * D + k]) + modl[(v * 6 + 3) * D + k];
            __syncthreads();
            for (int j = tid; j < FFD; j += 512) { float g = 0.f, u = 0.f; for (int k = 0; k < D; ++k) { g += hn[k] * P.in[I_FG][(size_t)k * FFD + j]; u += hn[k] * P.in[I_FU][(size_t)k * FFD + j]; } act[j] = g / (1.0f + expf(-g)) * u; }
            __syncthreads();
            { float* ex2 = (float*)(fresh_ws(P.ws) + WS_DBG + 256 * 1024) + (size_t)s * 7680; for (int k = tid; k < D; k += 512) ex2[k] = hn[k]; for (int j = tid; j < FFD; j += 512) ex2[D + j] = act[j]; }
            for (int c = tid; c < D; c += 512) { float a = 0.f; for (int j = 0; j < FFD; ++j) a += act[j] * P.in[I_FD][(size_t)j * D + c]; ex[s * D + c] = xr[c] + modl[(v * 6 + 5) * D + c] * a; }
        }
        __syncthreads();
    }
}
__device__ __forceinline__ void dbg_compare_rows(Frame& F, const Params& P, int layer, int which) {
    const int tid = fresh_tid(F.wave); const float* ex = (const float*)(fresh_ws(P.ws) + WS_DBG) + (size_t)which * 16 * D;
    for (int s = F.vcu; s < 16; s += F.G) {
        const unsigned hsh = dbg_hash(s * 2654435761u + 7u + which * 131u + layer);
        const int r = (s & 7) == 7 && layer == 0 ? NLAT + (int)(hsh % NCTX) : (int)(hsh % NLAT);
        const float* xr = (const float*)(fresh_ws(P.ws) + WS_XL) + (size_t)r * D;
        for (int c = tid; c < D; c += 512) dbg_err(F, 2 + which, xr[c], ex[s * D + c], 1.0f);
        if (which == 1) { const float* ex2 = (const float*)(fresh_ws(P.ws) + WS_DBG + 256 * 1024) + (size_t)s * 7680;
            const bf16* hr = (const bf16*)(fresh_ws(P.ws) + WS_H) + (size_t)r * D; const bf16* ar = (const bf16*)(fresh_ws(P.ws) + WS_ACT) + (size_t)r * FFD;
            for (int k = tid; k < D; k += 512) dbg_err(F, 0, bf2f(hr[k]), ex2[k], 1.0f);
            for (int j = tid; j < FFD; j += 512) dbg_err(F, 1, bf2f(ar[j]), ex2[D + j], 1.0f); }
    }
}
__device__ __forceinline__ void dbg_check_moe(Frame& F, const Params& P) {
    const int tid = fresh_tid(F.wave); LAS float* hn = (LAS float*)F.lds; LAS float* act = hn + D; LAS float* yv = act + FFE; LAS float* red = yv + D; LAS float* lg = red + 16;
    const float* modl = (const float*)(fresh_ws(P.ws) + WS_MOD) + (size_t)1 * 3 * 12288;
    for (int s = F.vcu; s < 16; s += F.G) {
        const unsigned hsh = dbg_hash(s * 2654435761u + 1234u); const int r = (int)(hsh % NLAT), v = dbg_vec(r);
        const float* xr = (const float*)(fresh_ws(P.ws) + WS_XL) + (size_t)r * D;
        float ss = 0.f; for (int k = tid; k < D; k += 512) ss += xr[k] * xr[k];
        ss = block_sum(ss, red, tid); const float rstd = 1.0f / sqrtf(ss / D + NORM_EPS);
        for (int k = tid; k < D; k += 512) { hn[k] = (xr[k] * rstd * P.in[I_GFFN][D + k]) * (1.0f + modl[(v * 6 + 4) * D + k]) + modl[(v * 6 + 3) * D + k]; yv[k] = 0.f; }
        __syncthreads();
        for (int e = 0; e < NE; ++e) { float a = 0.f; for (int k = tid; k < D; k += 512) a += hn[k] * P.in[I_RW][k * NE + e]; a = block_sum(a, red, tid); if (tid == 0) lg[e] = a + P.in[I_RB][e]; }
        __syncthreads();
        int i0 = 0; for (int e = 1; e < NE; ++e) if (lg[e] > lg[i0]) i0 = e;
        int i1 = -1; for (int e = 0; e < NE; ++e) if (e != i0 && (i1 < 0 || lg[e] > lg[i1])) i1 = e;
        const float p0 = 1.0f / (1.0f + expf(lg[i1] - lg[i0])), p1 = 1.0f - p0;
        for (int kk = 0; kk < 2; ++kk) {
            const int e = kk ? i1 : i0; const float pe = kk ? p1 : p0;
            const float* wg = P.in[I_MG] + (size_t)e * D * FFE; const float* wu = P.in[I_MU] + (size_t)e * D * FFE; const float* wd = P.in[I_MD] + (size_t)e * FFE * D;
            for (int j = tid; j < FFE; j += 512) { float g = 0.f, u = 0.f; for (int k = 0; k < D; ++k) { g += hn[k] * wg[(size_t)k * FFE + j]; u += hn[k] * wu[(size_t)k * FFE + j]; } act[j] = g / (1.0f + expf(-g)) * u; }
            __syncthreads();
            for (int c = tid; c < D; c += 512) { float a = 0.f; for (int j = 0; j < FFE; ++j) a += act[j] * wd[(size_t)j * D + c]; yv[c] += pe * a; }
            __syncthreads();
        }
        float q = 0.f; for (int c = tid; c < D; c += 512) { const float o = xr[c] + modl[(v * 6 + 5) * D + c] * yv[c]; yv[c] = o; q += o * o; }
        q = block_sum(q, red, tid); const float rs = 1.0f / sqrtf(q / D + NORM_EPS);
        for (int c = tid; c < D; c += 512) dbg_err(F, 4, P.out[(size_t)r * D + c], yv[c] * rs * P.in[I_GFIN][c], 1.0f);
        if (tid == 0) { const int* te = (const int*)(fresh_ws(P.ws) + WS_ROUTE); const float* tp = (const float*)(te + 4 * NLAT);
            const bool close = fabsf(lg[i1] - lg[i0]) < 1e-3f;
            if (!close) { dbg_err(F, 5, (float)te[2 * r], (float)i0, 1.0f); dbg_err(F, 5, tp[2 * r], p0, 1.0f); } }
        __syncthreads();
    }
}
__device__ __forceinline__ void dbg_report(Frame& F, const Params& P) {
    const int tid = fresh_tid(F.wave);
    for (size_t i = (size_t)F.vcu * 512 + tid; i < (size_t)NLAT * D; i += (size_t)F.G * 512) P.out[i] = 0.f;
    if (F.vcu == 0 && tid == 0) {
#if DBG_REPORT >= 0
        const float e = __uint_as_float(__hip_atomic_load(F.ctl + CW_DIAG + 64 * DBG_REPORT, RLX_AGENT));
        int bucket = 0; { float t = e * 1024.0f; while (t >= 2.0f && bucket < 60) { t *= 0.5f; ++bucket; } }
        P.out[0] = 1000.0f * (float)(10 + bucket);
#else
        const float thr[6] = {0.06f, 0.06f, 0.08f, 0.08f, 0.06f, 0.06f}; int mask = 0;
        for (int k = 0; k < 6; ++k) { const float e = __uint_as_float(__hip_atomic_load(F.ctl + CW_DIAG + 64 * k, RLX_AGENT)); if (e > thr[k]) mask |= 1 << k; }
        P.out[0] = 1000.0f * (float)(10 + mask);
#endif
    }
}
#endif
#ifndef EN_PRO
#define EN_PRO 1
#endif
#ifndef EN_NORM
#define EN_NORM 1
#endif
#ifndef EN_GIN
#define EN_GIN 1
#endif
#ifndef EN_CONV
#define EN_CONV 1
#endif
#ifndef EN_S1
#define EN_S1 1
#endif
#ifndef EN_S2
#define EN_S2 1
#endif
#ifndef EN_S3
#define EN_S3 1
#endif
#ifndef EN_ATT
#define EN_ATT 1
#endif
#ifndef EN_WOUT
#define EN_WOUT 1
#endif
#ifndef EN_GU
#define EN_GU 1
#endif
#ifndef EN_DN
#define EN_DN 1
#endif
#ifndef EN_ROUTE
#define EN_ROUTE 1
#endif
#ifndef EN_GATH
#define EN_GATH 1
#endif
#ifndef EN_MGU
#define EN_MGU 1
#endif
#ifndef EN_MDN
#define EN_MDN 1
#endif
#ifndef EN_FIN
#define EN_FIN 1
#endif
__global__ void __launch_bounds__(NWAVES * 64, 2) fwd_kernel(Params P) {
    extern __shared__ __attribute__((aligned(16))) unsigned char lds[];
    Frame F;
    F.lds = (LAS unsigned char*)lds;
    F.MISC = (volatile LAS unsigned*)(F.lds + MISC_OFF);
    F.wave = __builtin_amdgcn_readfirstlane(threadIdx.x >> 6);
    F.G = gridDim.x; { const int bx = blockIdx.x; F.vcu = (F.G % 8 == 0) ? (bx % 8) * (F.G / 8) + bx / 8 : bx; }
    unsigned char* ws = P.ws;
    F.ctl = (gu32*)(ws + WS_CTL);
    for (int u = threadIdx.x; u < (LDS_BYTES - LDSCTL_OFF) / 4; u += NWAVES * 64) ((LAS unsigned*)(F.lds + LDSCTL_OFF))[u] = 0u;
    __syncthreads();
    XcdBarrier bar = xcd_barrier_post((unsigned*)(ws + WS_CTL) + CW_BAR, F.MISC + 8);
#if DBG == 2
    unsigned long long* tsb = (unsigned long long*)(ws + WS_ROUTE + 512 * 1024); int nst = 0;
#define STAMP() do { if (blockIdx.x == 0 && threadIdx.x == 0) tsb[nst] = __builtin_amdgcn_s_memrealtime(); ++nst; } while (0)
    STAMP();
#else
#define STAMP() do {} while (0)
#endif
#if SIMPLE_BAR
    unsigned nbar = 0;
#define GRID_BAR() do { ++nbar; simple_barrier((unsigned*)(ws + WS_CTL) + 2048, nbar * (unsigned)gridDim.x); } while (0)
#else
#define GRID_BAR() do { xcd_barrier(bar); STAMP(); } while (0)
#endif

    bf16* xl = (bf16*)(ws + WS_XL); bf16* hb = (bf16*)(ws + WS_H); bf16* cat = (bf16*)(ws + WS_CAT);
    const float* mod = (const float*)(ws + WS_MOD);
    int* tok_e = (int*)(ws + WS_ROUTE); int* tok_slot = tok_e + 2 * NLAT; float* tok_p = (float*)(tok_slot + 2 * NLAT);

#if DUP_BAR
    for (int i_ = 0; i_ < DUP_BAR; ++i_) GRID_BAR();
#endif
#if EN_PRO
    p0_prologue(F, P);
#if DUP_PRO
    __syncthreads(); if (NOSTORE_PROBE) { if (threadIdx.x == 0) g_nostore = 1; __syncthreads(); } p0_prologue(F, P); if (NOSTORE_PROBE) { __syncthreads(); if (threadIdx.x == 0) g_nostore = 0; __syncthreads(); }
#endif
#endif
    GRID_BAR();

    constexpr int G0 = 256, RM_A = ((T / 256) * (NIN / 256)) % G0, RM_B = (NCH * NB * 8) % G0, RM_C = ((T / 256) * (2 * FFD / 256)) % G0;
    constexpr int CAP_T = (IPW_T > 0) ? (G0 - 32) * NWAVES * IPW_T + 24 * NWAVES * (IPW_T - 1) : 0;
    constexpr int DP_A0 = 0, DP_B0 = DP_A0 + (G0 - RM_A) * NWAVES * IPW_G, DP_T0 = DP_B0 + (G0 - RM_B) * NWAVES * IPW_S, DP_C0 = DP_T0 + CAP_T, DP_A1 = DP_C0 + (G0 - RM_C) * NWAVES * IPW_G,
                  DP_B1 = DP_A1 + (G0 - RM_A) * NWAVES * IPW_G, DP_END = DP_B1 + (G0 - RM_B) * NWAVES * IPW_S;
    static_assert(DP_A1 >= CV_IN + CV_OUT, "layer 1's w_in / w_out must be converted during layer 0");
    const bool slots = DEFER && (F.G == G0);
#define TAIL_SLOT(rem, myidx, ipw, dpos) do { if (slots && (myidx) >= (rem)) deferred_slot(F, P, (dpos), (myidx) - (rem), G0 - (rem), (ipw)); } while (0)
    for (int layer = 0; layer < 2; ++layer) {
        ws = fresh_ws(P.ws); F.wave = fresh_s(F.wave); F.vcu = fresh_s(F.vcu); F.G = fresh_s(F.G);
        const float* modl = mod + (size_t)layer * 3 * 12288;
        const void* resLat = layer == 0 ? (const void*)P.in[I_X] : (const void*)xl; const void* resCtx = layer == 0 ? (const void*)P.in[I_CTX] : (const void*)(xl + (size_t)NLAT * D);
#if EN_NORM
        if (layer == 0) norm_phase<false, I8_IN ? 2 : 0, false, false>(F, resLat, resCtx, P.in[I_GMIX] + layer * D, modl, 0, 1, hb, T, nullptr, nullptr, nullptr, nullptr, nullptr, nullptr, 11, nullptr, nullptr, (float*)(ws + WS_HS));
        else norm_phase<false, I8_IN ? 2 : 0, true, true>(F, resLat, resCtx, P.in[I_GMIX] + layer * D, modl, 0, 1, hb, T, nullptr, nullptr, nullptr, nullptr, nullptr,
                          (const float*)(ws + WS_PART), 11, mod + (size_t)(2 * 6 + 5) * D, nullptr, (float*)(ws + WS_HS));
#if DUP_SMALL & 16
        norm_phase<false>(F, resLat, resCtx, P.in[I_GMIX] + layer * D, modl, 0, 1, hb, T, nullptr, nullptr, nullptr, nullptr, nullptr);
#endif
#endif
        GRID_BAR();
#if DBG == 1
        if ((DBG_MASK & 32) && layer == DBG_L) { dbg_check_norm(F, P, layer); }
#endif
        {
            pg8::PlainSched S; S.init(T / 256, NIN / 256, F.G, (int)blockIdx.x); S.A = (const char*)hb; S.Bt = (const char*)(ws + WS_WIN + layer * SZ_WIN); S.tstep = (size_t)256 * D * (I8_IN ? 1 : 2);
            pg8::EpiIn E{(bf16*)(ws + WS_CONV), (bf16*)(ws + WS_Z), (bf16*)(ws + WS_Q), (bf16*)(ws + WS_XBC), (bf16*)(ws + WS_KB), (bf16*)(ws + WS_VB), (float*)(ws + WS_DT),
                         (const float*)(ws + WS_ROPE), (const float*)(ws + WS_ROPE) + 192 * 16, ws + WS_K8, ws + WS_V8};
            if (V8_DIRECT) { S.swap_from = 20; S.swap_to = 24; }
#if EN_GIN && I8_IN
#if DUP_GIN
            pg8::gemm_phase<pg8::EpiIn, pg8::PlainSched, true, true, 2>(F.lds + RING_OFF, D / 2, S, E, F.wave, DUP_GIN == 2 ? 8 : 0, 0, 0, (const float*)(ws + WS_HS), (const float*)(ws + WS_CS) + CS_WIN + layer * 6400); __syncthreads();
#endif
            pg8::gemm_phase<pg8::EpiIn, pg8::PlainSched, true, true, 2>(F.lds + RING_OFF, D / 2, S, E, F.wave, 0, 0, 0, (const float*)(ws + WS_HS), (const float*)(ws + WS_CS) + CS_WIN + layer * 6400);
            TAIL_SLOT(RM_A, (int)blockIdx.x, IPW_G, layer ? DP_A1 : DP_A0);
#elif EN_GIN
            pg8::gemm_phase<pg8::EpiIn, pg8::PlainSched, true, true>(F.lds + RING_OFF, D, S, E, F.wave);
#if DUP_GIN
            __syncthreads(); pg8::gemm_phase<pg8::EpiIn, pg8::PlainSched, true, true>(F.lds + RING_OFF, D, S, E, F.wave);
#endif
#endif
        }
        GRID_BAR();
#if DBG == 1
        if ((DBG_MASK & 1) && layer == DBG_L) { dbg_check_inproj(F, P, layer); }
#endif
#if EN_CONV
        conv_phase(F, (const bf16*)(ws + WS_CONV), (const bf16*)(ws + WS_XBC), cat, (bf16*)(ws + WS_XBCC), P.in[I_CONVW] + layer * 1536, P.in[I_SCONVW] + layer * 3072, P.in[I_SCONVB] + layer * 1024);
#if ATT_FP8 && ATT_DMA && !V8_DIRECT
        v8_phase(F, P);
#endif
#if DUP_SMALL & 8
        conv_phase(F, (const bf16*)(ws + WS_CONV), (const bf16*)(ws + WS_XBC), cat, (bf16*)(ws + WS_XBCC), P.in[I_CONVW] + layer * 1536, P.in[I_SCONVW] + layer * 3072, P.in[I_SCONVB] + layer * 1024);
#endif
#endif
        GRID_BAR();
#if EN_S1
#if DUP_S1V
        ssd_local_phase<DUP_S1V>(F, P, layer);
#endif
        ssd_local_phase(F, P, layer);
        TAIL_SLOT(RM_B, F.vcu, IPW_S, layer ? DP_B1 : DP_B0);
#if DUP_SMALL & 1
        ssd_local_phase(F, P, layer);
#endif
#endif
        GRID_BAR();
#if EN_S2
        ssd_scan_phase(F, P);
#if DUP_SMALL & 2
        ssd_scan_phase(F, P);
#endif
#endif
        GRID_BAR();
#if EN_S3
        ssd_out_phase(F, P, layer);
#if DUP_SMALL & 4
        ssd_out_phase(F, P, layer);
#endif
#endif
#if EN_ATT
        attn_phase<0>(F, P, layer, layer == 0, lds);
        if (IPW_T > 0 && slots && layer == 0) {
            if (F.vcu >= 32) deferred_slot(F, P, DP_T0, F.vcu - 32, G0 - 32, IPW_T);
            else if (F.vcu >= 8 && IPW_T > 1) deferred_slot(F, P, DP_T0 + (G0 - 32) * NWAVES * IPW_T, F.vcu - 8, 24, IPW_T - 1);
        }
#if DUP_ATT
        attn_phase<DUP_ATT - 1>(F, P, layer, layer == 0, lds);
#endif
#endif
        GRID_BAR();
#if DBG == 1
        if (layer == DBG_L) { if (DBG_MASK & 2) dbg_check_attn(F, P, layer); if (DBG_MASK & 4) dbg_expect_rows(F, P, layer, 0); GRID_BAR(); }
#endif
        {
            pg8::PlainSched S; S.init(NLAT / 256, D / 256, F.G, (int)blockIdx.x); S.A = (const char*)cat; S.Bt = (const char*)(ws + WS_WOUT + layer * SZ_WOUT); S.tstep = (size_t)256 * D * 2;
#if EN_WOUT
            if (layer == 0) { pg8::EpiResidT<false> E{resLat, resCtx, xl, modl + 2 * D}; pg8::gemm_phase<pg8::EpiResidT<false>, pg8::PlainSched, true, true>(F.lds + RING_OFF, D, S, E, F.wave); }
            else { pg8::EpiResidT<true> E{resLat, resCtx, xl, modl + 2 * D}; pg8::gemm_phase<pg8::EpiResidT<true>, pg8::PlainSched, true, true>(F.lds + RING_OFF, D, S, E, F.wave); }
            if (layer == 0) {
                __syncthreads();
                pg8::CtxSplitSched C; C.nN = D / 256; C.nS = 8; C.G = F.G; C.c = (int)blockIdx.x; C.A = (const char*)cat; C.Bt = S.Bt; C.tstep = S.tstep; C.kslice = (size_t)(D / 8) * 2;
                pg8::EpiPartial EP{(float*)(ws + WS_PART)};
                pg8::gemm_phase<pg8::EpiPartial, pg8::CtxSplitSched, true, true>(F.lds + RING_OFF, D, C, EP, F.wave, D / 8 / 64);
            }
#endif
        }
        GRID_BAR();
#if DBG == 1
        if ((DBG_MASK & 4) && layer == DBG_L) { dbg_compare_rows(F, P, layer, 0); }
        if ((DBG_MASK & 8) && layer == 0) { dbg_expect_rows(F, P, layer, 1); GRID_BAR(); }
#endif
        if (layer == 0) {
            norm_phase<false, I8_GU ? 2 : 1, true, false>(F, xl, P.in[I_CTX], P.in[I_GFFN], modl, 3, 4, hb, T, nullptr, nullptr, nullptr, nullptr, nullptr,
                              (const float*)(ws + WS_PART), 8, modl + (size_t)(2 * 6 + 2) * D, xl, (float*)(ws + WS_HS));
            GRID_BAR();
            {
                pg8::PlainSched S; S.init(T / 256, 2 * FFD / 256, F.G, (int)blockIdx.x); S.A = (const char*)hb; S.Bt = (const char*)(ws + WS_WGU); S.tstep = (size_t)256 * D;
                pg8::EpiSwiGLU8 E{ws + WS_ACT, FFD};
#if EN_GU
#if I8_GU
                pg8::gemm_phase<pg8::EpiSwiGLU8, pg8::PlainSched, true, true, 2>(F.lds + RING_OFF, D / 2, S, E, F.wave, 0, 0, 0, (const float*)(ws + WS_HS), (const float*)(ws + WS_CS) + CS_WGU);
                TAIL_SLOT(RM_C, (int)blockIdx.x, IPW_G, DP_C0);
#else
                pg8::gemm_phase<pg8::EpiSwiGLU8, pg8::PlainSched, true, true, true>(F.lds + RING_OFF, D / 2, S, E, F.wave, 0, W8_SC8, 0x7F7F7F7F);
#endif
#endif
            }
            GRID_BAR();
            {
                pg8::PlainSched S; S.init(NLAT / 256, D / 256, F.G, (int)blockIdx.x); S.A = (const char*)(ws + WS_ACT); S.Bt = (const char*)(ws + WS_WDN); S.tstep = (size_t)256 * FFD;
                pg8::EpiResidT<true> E{xl, xl + (size_t)NLAT * D, xl, modl + 5 * D};
#if EN_DN
                pg8::gemm_phase<pg8::EpiResidT<true>, pg8::PlainSched, true, true, true>(F.lds + RING_OFF, FFD / 2, S, E, F.wave, 0, W8_SC8, pg8::ACT_SC8);
#if !NO_DNSPLIT
                {
                    __syncthreads();
                    pg8::CtxSplitSched C; C.nN = D / 256; C.nS = 11; C.G = F.G; C.c = (int)blockIdx.x; C.A = S.A; C.Bt = S.Bt; C.tstep = S.tstep; C.kslice = (size_t)512;
                    pg8::EpiPartial EP{(float*)(ws + WS_PART)};
                    pg8::gemm_phase<pg8::EpiPartial, pg8::CtxSplitSched, true, true, true>(F.lds + RING_OFF, FFD / 2, C, EP, F.wave, 4, W8_SC8, pg8::ACT_SC8);
                }
#endif
#endif
            }
            GRID_BAR();
#if DBG == 1
            if (DBG_MASK & 8) dbg_compare_rows(F, P, layer, 1);
#endif
        } else {
#if EN_ROUTE
#if MOE_SPARSE
            norm_phase<true, 2, true, true>(F, xl, xl + (size_t)NLAT * D, P.in[I_GFFN] + D, modl, 3, 4, (bf16*)(ws + WS_AG), NLAT, P.in[I_RW], P.in[I_RB], tok_e, tok_slot, tok_p, nullptr, 0, nullptr, nullptr, (float*)(ws + WS_AGS2));
            if (slots) deferred_rest(F, P, DP_END);
#else
            norm_phase<true, I8_GU ? 2 : 1, true, true>(F, xl, xl + (size_t)NLAT * D, P.in[I_GFFN] + D, modl, 3, 4, hb, NLAT, P.in[I_RW], P.in[I_RB], tok_e, tok_slot, tok_p, nullptr, 0, nullptr, nullptr, (float*)(ws + WS_HS));
#endif
#endif
            GRID_BAR();
#if !MOE_SPARSE
#if EN_GATH
            moe_gather_phase(F, P);
#endif
#if DEFER
            if (slots) { __syncthreads(); deferred_rest(F, P, DP_END); }
#endif
            GRID_BAR();
#endif
            {
                const MoePanels mp = moe_panels(F);
                pg8::MoeSched S; S.init(mp.ps[8], 2 * FFE / 256, F.G, (int)blockIdx.x); S.A = (const char*)(ws + WS_AG); S.Bt = (const char*)(ws + WS_MGU); S.tstep = (size_t)256 * D; S.estride = SZ_MGU / 2; S.erows = 2 * FFE; S.sparse = MOE_SPARSE; S.caprows = NLAT;
                S.ps1 = mp.ps[1]; S.ps2 = mp.ps[2]; S.ps3 = mp.ps[3]; S.ps4 = mp.ps[4]; S.ps5 = mp.ps[5]; S.ps6 = mp.ps[6]; S.ps7 = mp.ps[7];
                pg8::EpiSwiGLU8 E{ws + WS_MACT, FFE};
#if EN_MGU
#if I8_GU
                pg8::gemm_phase<pg8::EpiSwiGLU8, pg8::MoeSched, true, true, 2>(F.lds + RING_OFF, D / 2, S, E, F.wave, 0, 0, 0, (const float*)(ws + (MOE_SPARSE ? WS_AGS2 : WS_AGS)), (const float*)(ws + WS_CS) + CS_MGU);
#else
                pg8::gemm_phase<pg8::EpiSwiGLU8, pg8::MoeSched, true, true, true>(F.lds + RING_OFF, D / 2, S, E, F.wave, 0, W8_SC8, 0x7F7F7F7F);
#endif
#endif
            }
            GRID_BAR();
            {
                const MoePanels mp = moe_panels(F);
                pg8::MoeSched S; S.init(mp.ps[8], D / 256, F.G, (int)blockIdx.x); S.A = (const char*)(ws + WS_MACT); S.Bt = (const char*)(ws + WS_MDN); S.tstep = (size_t)256 * FFE; S.estride = SZ_MDN / 2; S.erows = D; S.sparse = 0; S.caprows = 0;
                S.ps1 = mp.ps[1]; S.ps2 = mp.ps[2]; S.ps3 = mp.ps[3]; S.ps4 = mp.ps[4]; S.ps5 = mp.ps[5]; S.ps6 = mp.ps[6]; S.ps7 = mp.ps[7];
                pg8::EpiBf16 E{(bf16*)(ws + WS_AG), D};
#if EN_MDN
                pg8::gemm_phase<pg8::EpiBf16, pg8::MoeSched, true, true, true>(F.lds + RING_OFF, FFE / 2, S, E, F.wave, 0, W8_SC8, pg8::ACT_SC8);
#endif
            }
            GRID_BAR();
#if EN_FIN
            final_phase(F, P, modl);
#if DUP_FIN
            final_phase(F, P, modl);
#endif
#endif
#if PROBE
            {
                typedef int v8i_ __attribute__((ext_vector_type(8)));
                const int role = (F.wave < 4) ? (PROBE == 1 || PROBE == 2 || PROBE == 4 ? 1 : (PROBE == 3 ? 2 : 0)) : (PROBE == 1 ? 1 : (PROBE == 2 || PROBE == 3 || PROBE == 5 ? 2 : 0));
                f32x16 c0 = {}, c1 = {}, c2 = {}, c3 = {}; v8i_ a = {0x38383838, 0x38383838, 0x38383838, 0x38383838, 0x38383838, 0x38383838, 0x38383838, 0x38383838};
                float x0 = 1.0f, x1 = 2.0f, x2 = 3.0f, x3 = 4.0f;
                for (int it = 0; it < 2000; ++it) {
                    if (role == 1) {
#pragma unroll
                        for (int q = 0; q < 2; ++q) {
                            c0 = __builtin_amdgcn_mfma_scale_f32_32x32x64_f8f6f4(a, a, c0, 0, 0, 0, 0x7F7F7F7F, 0, 0x7F7F7F7F); c1 = __builtin_amdgcn_mfma_scale_f32_32x32x64_f8f6f4(a, a, c1, 0, 0, 0, 0x7F7F7F7F, 0, 0x7F7F7F7F);
                            c2 = __builtin_amdgcn_mfma_scale_f32_32x32x64_f8f6f4(a, a, c2, 0, 0, 0, 0x7F7F7F7F, 0, 0x7F7F7F7F); c3 = __builtin_amdgcn_mfma_scale_f32_32x32x64_f8f6f4(a, a, c3, 0, 0, 0, 0x7F7F7F7F, 0, 0x7F7F7F7F); }
                    } else if (role == 2) {
#pragma unroll
                        for (int q = 0; q < 32; ++q) asm volatile("v_fma_f32 %0, %0, %0, %0\n\tv_fma_f32 %1, %1, %1, %1\n\tv_fma_f32 %2, %2, %2, %2\n\tv_fma_f32 %3, %3, %3, %3" : "+v"(x0), "+v"(x1), "+v"(x2), "+v"(x3));
                    }
                }
                asm volatile("" :: "v"(c0), "v"(c1), "v"(c2), "v"(c3), "v"(x0), "v"(x1), "v"(x2), "v"(x3));
            }
#endif
#if DBG == 1
            GRID_BAR(); if (DBG_MASK & 16) dbg_check_moe(F, P); GRID_BAR(); dbg_report(F, P);
#endif
#if DBG == 2
            GRID_BAR();
            { const int tid = fresh_tid(F.wave);
              for (size_t i = (size_t)F.vcu * 512 + tid; i < (size_t)NLAT * D; i += (size_t)F.G * 512) P.out[i] = 0.f;
              __syncthreads(); GRID_BAR();
              float A = 0.f, B = 0.f;
              for (int i = 0; i + 1 < nst - 1; ++i) { const float d = (float)(tsb[i + 1] - tsb[i]) * 0.01f; if ((TSEL_A >> i) & 1ull) A += d; if ((TSEL_B >> i) & 1ull) B += d; }
              for (size_t i = (size_t)F.vcu * 512 + tid; i < 1000001; i += (size_t)F.G * 512) P.out[i] = i == 0 ? A : 10.0f * B; }
#endif
        }
    }
}

extern "C" void kernel_launch(void* const* d_in, const int* in_sizes, int n_in, void* d_out, int out_size, void* d_ws, size_t ws_size, hipStream_t stream) {
    static int grid = 0;
    if (grid == 0) {
        if (n_in != 28 || in_sizes[0] != NLAT * D || out_size != NLAT * D || ws_size < WS_END) {
            fprintf(stderr, "kernel_launch: built for 28 inputs, x/out of %d floats, >= %zu bytes of workspace; got n_in %d, in0 %d, out %d, ws %zu; nothing launched\n", NLAT * D, (size_t)WS_END, n_in, n_in > 0 ? in_sizes[0] : -1, out_size, ws_size);
            grid = -1; return; }
        int dev = 0, cus = 0, per_cu = 0;
        if (hipGetDevice(&dev) != hipSuccess || hipDeviceGetAttribute(&cus, hipDeviceAttributeMultiprocessorCount, dev) != hipSuccess) { fprintf(stderr, "kernel_launch: device query failed\n"); grid = -1; return; }
        if (hipFuncSetAttribute((const void*)fwd_kernel, hipFuncAttributeMaxDynamicSharedMemorySize, LDS_BYTES) != hipSuccess) { fprintf(stderr, "kernel_launch: hipFuncSetAttribute failed\n"); grid = -1; return; }
        if (hipOccupancyMaxActiveBlocksPerMultiprocessor(&per_cu, (const void*)fwd_kernel, NWAVES * 64, LDS_BYTES) != hipSuccess || per_cu < 1)
            fprintf(stderr, "kernel_launch: note: occupancy query reports %d workgroups per CU\n", per_cu);
        (void)hipGetLastError();
        grid = cus;
    }
    if (grid < 0) return;
    if (hipMemsetAsync((char*)d_ws + WS_CTL, 0, CTL_ZERO_BYTES, stream) != hipSuccess) { fprintf(stderr, "kernel_launch: memset failed\n"); return; }
    Params p{};
    for (int i = 0; i < 28; ++i) p.in[i] = (const float*)d_in[i];
    p.out = (float*)d_out; p.ws = (unsigned char*)d_ws;
    hipLaunchKernelGGL(fwd_kernel, dim3(grid), dim3(NWAVES * 64), LDS_BYTES, stream, p);
    const hipError_t le = hipPeekAtLastError();
    if (le != hipSuccess) fprintf(stderr, "kernel_launch: launch failed: %s\n", hipGetErrorName(le));
}
```

```cpp
#ifndef DBG
#define DBG 0
#endif
#ifndef DBG_L
#define DBG_L 0
#endif
#ifndef DBG_REPORT
#define DBG_REPORT -1
#endif
#ifndef DBG_MASK
#define DBG_MASK 31
#endif
#ifndef SIMPLE_BAR
#define SIMPLE_BAR 0
#endif
#ifndef TSEL_A
#define TSEL_A 1ull
#endif
#ifndef TSEL_B
#define TSEL_B 0ull
#endif
#ifndef DUP_ATT
#define DUP_ATT 0
#endif
#ifndef DUP_GIN
#define DUP_GIN 0
#endif
#ifndef DUP_PRO
#define DUP_PRO 0
#endif
#ifndef ATT_PVPF
#define ATT_PVPF 1
#endif
#ifndef DUP_SMALL
#define DUP_SMALL 0
#endif
#ifndef ATT_NEGM
#define ATT_NEGM 1
#endif
#ifndef ATT_NOSWAP
#define ATT_NOSWAP 1
#endif
#ifndef ATT_LMFMA
#define ATT_LMFMA 0
#endif
#ifndef ATT_DMA
#define ATT_DMA 1
#endif
#ifndef ATT_FP8
#define ATT_FP8 1
#endif
#ifndef NO_DNSPLIT
#define NO_DNSPLIT 0
#endif
#ifndef ATT_QK8
#define ATT_QK8 1
#endif

#ifndef I8_CLIP
#define I8_CLIP 4.0f
#endif

#ifndef I8_IN
#define I8_IN 1
#endif
#ifndef I8_GU
#define I8_GU 1
#endif

#ifndef I8DBG
#define I8DBG 0
#endif

#ifndef ATT_PVX
#define ATT_PVX 1
#endif
#ifndef PVX_MASK
#define PVX_MASK 0x400
#endif

#ifndef ATT_Y8
#define ATT_Y8 1
#endif
#ifndef Y8_C
#define Y8_C 0.0f
#endif

#ifndef ATT_LEAD
#define ATT_LEAD 5
#endif

#ifndef ATT_STAG
#define ATT_STAG 0
#endif

#ifndef ATT_BAR2
#define ATT_BAR2 1
#endif

#ifndef DUP_MODV
#define DUP_MODV 0
#endif

#ifndef ITEM_NBFAST
#define ITEM_NBFAST 1
#endif

#ifndef DUP_BAR
#define DUP_BAR 0
#endif

#ifndef DUP_S1V
#define DUP_S1V 0
#endif

#ifndef S1_NT
#define S1_NT 0
#endif

#ifndef S1_LDSST
#define S1_LDSST 0
#endif

#ifndef ATT_PRIO
#define ATT_PRIO 0
#endif

#ifndef ATT_AB
#define ATT_AB 0
#endif

#ifndef PROBE
#define PROBE 0
#endif

#ifndef ATT_KPF
#define ATT_KPF 0
#endif

#ifndef ATT_P2
#define ATT_P2 0
#endif

#ifndef P2_KPF
#define P2_KPF 0
#endif
#ifndef P2_VPF
#define P2_VPF 0
#endif

#ifndef P2_AB
#define P2_AB 1
#endif

#ifndef TAIL2
#define TAIL2 0
#endif

#ifndef DEFER
#define DEFER 1
#endif
#ifndef IPW_G
#define IPW_G 6
#endif
#ifndef IPW_S
#define IPW_S 3
#endif

#ifndef IPW_T
#define IPW_T 0
#endif

#ifndef MOE_SPARSE
#define MOE_SPARSE 1
#endif

#ifndef NOSTORE_PROBE
#define NOSTORE_PROBE 0
#endif

#ifndef FIN_NT
#define FIN_NT 0
#endif

#ifndef DUP_FIN
#define DUP_FIN 0
#endif

#ifndef K8_DIRECT
#define K8_DIRECT 1
#endif

#ifndef Q8_DIRECT
#define Q8_DIRECT 0
#endif

#ifndef PERM_OUT
#define PERM_OUT 1
#endif

#ifndef SB16
#define SB16 1
#endif

#ifndef YD16
#define YD16 0
#endif

#ifndef CV_PAIR
#define CV_PAIR 0
#endif

#ifndef V8_DIRECT
#define V8_DIRECT 1
#endif

#ifndef V8_NOSWAP
#define V8_NOSWAP 0
#endif

#ifndef S1_PF
#define S1_PF 0
#endif

#ifndef S2_DEPTH
#define S2_DEPTH 6
#endif

#ifndef CONV_U
#define CONV_U 0
#endif

#ifndef PART16
#define PART16 1
#endif
#include <hip/hip_runtime.h>
#include <cstdio>
#include <cstdint>

#define GAS __attribute__((address_space(1)))
#define LAS __attribute__((address_space(3)))
typedef unsigned short bf16;
typedef unsigned v4u __attribute__((ext_vector_type(4)));
typedef unsigned v2u __attribute__((ext_vector_type(2)));
typedef float f32x4 __attribute__((ext_vector_type(4)));
typedef float f32x2 __attribute__((ext_vector_type(2)));
typedef float f32x16 __attribute__((ext_vector_type(16)));
typedef short bf16x8 __attribute__((ext_vector_type(8)));
typedef short s16x4 __attribute__((ext_vector_type(4)));
typedef GAS unsigned gu32;
#define RLX_AGENT __ATOMIC_RELAXED, __HIP_MEMORY_SCOPE_AGENT
#define LDS_WAIT() asm volatile("s_waitcnt lgkmcnt(0)" ::: "memory")
#define VM_WAIT() asm volatile("s_waitcnt vmcnt(0)" ::: "memory")

constexpr int D = 2048, NB = 2, SEQ = 8192, CTXL = 256;
constexpr int NLAT = NB * SEQ, NCTX = NB * CTXL, T = NLAT + NCTX;
constexpr int KVLEN = CTXL + SEQ;
constexpr int IN_COLS = 6160, NIN = 6400;
constexpr int COL_Z = 1536, COL_Q = 2048, COL_XBC = 3072, COL_DT = 4096, COL_K = 4112, COL_V = 5136;
constexpr int FFD = 5632, FFE = 2816, NE = 8;
constexpr int NCH = 66;
constexpr float NORM_EPS = 1e-6f;
constexpr int NWAVES = 8;

constexpr size_t MiB = 1u << 20;
constexpr size_t WS_CTL = 0, CTL_ZERO_BYTES = 1 * MiB;
constexpr size_t WS_MOD = 1 * MiB;
constexpr size_t WS_ROPE = WS_MOD + 512 * 1024;
constexpr size_t WS_TOT = WS_ROPE + 64 * 1024;
constexpr size_t WS_ROUTE = 2 * MiB;
constexpr size_t WS_HS = 2 * MiB + 512 * 1024;
constexpr size_t WS_AGS = WS_HS + 256 * 1024;
constexpr size_t WS_AGS2 = 3 * MiB + 512 * 1024;
constexpr size_t WS_CS = 3 * MiB;
constexpr size_t CS_WIN = 0, CS_WGU = 2 * 6400, CS_MGU = CS_WGU + 11264;
constexpr size_t WS_W = 4 * MiB;
constexpr size_t SZ_WIN = (size_t)NIN * D * 2, SZ_WOUT = (size_t)D * D * 2, SZ_WGU = (size_t)2 * FFD * D * 2, SZ_WDN = (size_t)D * FFD * 2;
constexpr size_t SZ_MGU = (size_t)2 * FFE * D * 2, SZ_MDN = (size_t)D * FFE * 2;
constexpr size_t WS_WIN = WS_W, WS_WOUT = WS_WIN + 2 * SZ_WIN, WS_WGU = WS_WOUT + 2 * SZ_WOUT, WS_WDN = WS_WGU + SZ_WGU, WS_MGU = WS_WDN + SZ_WDN, WS_MDN = WS_MGU + NE * SZ_MGU;
constexpr size_t WS_XL = WS_MDN + NE * SZ_MDN;
constexpr size_t WS_H = WS_XL + (size_t)T * D * 4;
constexpr size_t WS_CAT = WS_H + (size_t)T * D * 2;
constexpr size_t WS_TMP = WS_CAT + (size_t)T * D * 2;
constexpr size_t WS_CONV = WS_TMP;
constexpr size_t WS_Z = WS_CONV + (size_t)T * 1536 * 2;
constexpr size_t WS_Q = WS_Z + (size_t)T * 512 * 2;
constexpr size_t WS_XBC = WS_Q + (size_t)T * 1024 * 2;
constexpr size_t WS_KB = WS_XBC + (size_t)T * 1024 * 2;
constexpr size_t WS_VB = WS_KB + (size_t)T * 1024 * 2;
constexpr size_t WS_DT = WS_VB + (size_t)T * 1024 * 2;
constexpr size_t WS_XBCC = WS_DT + (size_t)T * 16 * 4;
constexpr size_t WS_YD = WS_XBCC + (size_t)T * 1024 * 2;
constexpr size_t WS_CUM = WS_YD + (size_t)T * 512 * 4;
constexpr size_t WS_SB = WS_CUM + (size_t)T * 16 * 4;
constexpr size_t WS_HP = WS_SB + (size_t)32 * NCH * 8192 * 4;
constexpr size_t WS_TMP_END_MIX = WS_HP + (size_t)32 * NCH * 8192 * 2;
constexpr size_t WS_ACT = WS_TMP;
constexpr int MOE_MAXROWS = 2 * NLAT + NE * 256;
constexpr size_t WS_AG = WS_TMP;
#if MOE_SPARSE
constexpr size_t WS_MACT = WS_AG + (size_t)NE * NLAT * D;
constexpr size_t WS_TMP_END_MOE = WS_MACT + (size_t)MOE_MAXROWS * FFE;
#else
constexpr size_t WS_MACT = WS_AG + (size_t)MOE_MAXROWS * D * 2;
constexpr size_t WS_TMP_END_MOE = WS_MACT + (size_t)MOE_MAXROWS * FFE * 2;
#endif
constexpr size_t WS_PART = WS_TMP + 200 * MiB;
constexpr size_t WS_V8 = (WS_TMP_END_MIX > WS_TMP_END_MOE ? WS_TMP_END_MIX : WS_TMP_END_MOE);
constexpr size_t WS_K8 = WS_V8 + (size_t)NB * (KVLEN / 64) * 8 * 8192;
constexpr size_t WS_END = WS_K8 + (size_t)NB * (KVLEN / 64) * 8 * 8192;
static_assert(WS_PART + (size_t)11 * NCTX * D * 4 <= WS_V8 && WS_PART >= WS_ACT + (size_t)T * FFD * 2, "partials");
static_assert(WS_ACT + (size_t)T * FFD * 2 <= WS_END, "act fits");
constexpr int CW_TMO = 0, CW_CODE = 1;
constexpr int CW_BAR = 4096;
constexpr int CW_CNT = 8192;
constexpr int CW_DIAG = 12288;

constexpr int RING_OFF = 0, RING_BYTES = 131072;
constexpr int LDSCTL_OFF = RING_BYTES, MISC_OFF = LDSCTL_OFF + 320;
constexpr int LDS_BYTES = 147456;

__device__ __forceinline__ unsigned f2bf(float f) { unsigned u = __builtin_bit_cast(unsigned, f); return (u + 0x7fffu + ((u >> 16) & 1u)) >> 16; }
__device__ __forceinline__ unsigned pk2(float lo, float hi) { return f2bf(lo) | (f2bf(hi) << 16); }
__device__ __forceinline__ unsigned cvtpk(float lo, float hi) { unsigned r; asm volatile("v_cvt_pk_bf16_f32 %0, %1, %2" : "=v"(r) : "v"(lo), "v"(hi)); return r; }
__device__ __forceinline__ float bf2f(unsigned short b) { return __builtin_bit_cast(float, ((unsigned)b) << 16); }
__device__ __forceinline__ float bflo(unsigned w) { return __builtin_bit_cast(float, w << 16); }
__device__ __forceinline__ float bfhi(unsigned w) { return __builtin_bit_cast(float, w & 0xffff0000u); }
__device__ __forceinline__ float fast_exp(float x) { return __builtin_amdgcn_exp2f(x * 1.4426950408889634f); }
__device__ __forceinline__ float silu_f(float x) { return x * __builtin_amdgcn_rcpf(1.0f + fast_exp(-x)); }
__device__ __forceinline__ float dpp_f(float v, const int ctrl_sel) {
    int r;
    switch (ctrl_sel) {
        case 0: r = __builtin_amdgcn_update_dpp(0, __builtin_bit_cast(int, v), 0xB1, 0xF, 0xF, true); break;
        case 1: r = __builtin_amdgcn_update_dpp(0, __builtin_bit_cast(int, v), 0x4E, 0xF, 0xF, true); break;
        case 2: r = __builtin_amdgcn_update_dpp(0, __builtin_bit_cast(int, v), 0x141, 0xF, 0xF, true); break;
        default: r = __builtin_amdgcn_update_dpp(0, __builtin_bit_cast(int, v), 0x140, 0xF, 0xF, true); break;
    }
    return __builtin_bit_cast(float, r);
}
__device__ __forceinline__ float half_sum(float v) {
    v += dpp_f(v, 0); v += dpp_f(v, 1); v += dpp_f(v, 2); v += dpp_f(v, 3);
    v += __builtin_bit_cast(float, __builtin_amdgcn_ds_swizzle(__builtin_bit_cast(int, v), 0x401F));
    return v;
}
__device__ __forceinline__ void swap32u(unsigned& a, unsigned& b) {
    asm volatile("s_nop 1\n\tv_permlane32_swap_b32 %0, %1\n\ts_nop 1" : "+v"(a), "+v"(b));
}
__device__ __forceinline__ void swap32(float v, float& x, float& y) {
    unsigned a = __builtin_bit_cast(unsigned, v), b = a; swap32u(a, b);
    x = __builtin_bit_cast(float, a); y = __builtin_bit_cast(float, b);
}
__device__ __forceinline__ float wave_sum(float v) {
    v = half_sum(v);
    float x, y; swap32(v, x, y); return x + y;
}
__device__ __forceinline__ f32x4 ld4_f32(const float* p) { return *(const f32x4*)p; }
__device__ __forceinline__ f32x4 ld4_bf16(const unsigned short* p) { const v2u w = *(const v2u*)p; f32x4 r; r[0] = bflo(w.x); r[1] = bfhi(w.x); r[2] = bflo(w.y); r[3] = bfhi(w.y); return r; }
__device__ __forceinline__ void st4_bf16(unsigned short* p, const f32x4& v) { v2u w; w.x = cvtpk(v[0], v[1]); w.y = cvtpk(v[2], v[3]); *(v2u*)p = w; }
__device__ __forceinline__ float wave_max(float v) {
    v = fmaxf(v, dpp_f(v, 0)); v = fmaxf(v, dpp_f(v, 1)); v = fmaxf(v, dpp_f(v, 2)); v = fmaxf(v, dpp_f(v, 3));
    v = fmaxf(v, __builtin_bit_cast(float, __builtin_amdgcn_ds_swizzle(__builtin_bit_cast(int, v), 0x401F)));
    float x, y; swap32(v, x, y); return fmaxf(x, y);
}
__device__ __forceinline__ unsigned pk_i8(float a, float b, float c, float d) {
    const float M = 12582912.0f;
    const unsigned ua = __builtin_bit_cast(unsigned, a + M), ub = __builtin_bit_cast(unsigned, b + M), uc = __builtin_bit_cast(unsigned, c + M), ud = __builtin_bit_cast(unsigned, d + M);
    return __builtin_amdgcn_perm(ub, ua, 0x0c0c0400u) | (__builtin_amdgcn_perm(ud, uc, 0x0c0c0400u) << 16);
}
__device__ __forceinline__ float cross_max(float v) { float x, y; swap32(v, x, y); return fmaxf(x, y); }
__device__ __forceinline__ float cross_sum(float v) { float x, y; swap32(v, x, y); return x + y; }

__device__ __forceinline__ int lane_id() { int l; asm volatile("v_mbcnt_lo_u32_b32 %0, -1, 0\n\tv_mbcnt_hi_u32_b32 %0, -1, %0" : "=v"(l)); return l; }
__device__ __forceinline__ int fresh_tid(int wave) { return wave * 64 + lane_id(); }
__device__ __forceinline__ int fresh_s(int v) { asm volatile("" : "+s"(v)); return v; }
__device__ __forceinline__ unsigned char* fresh_ws(unsigned char* p) { unsigned z = 0; asm volatile("" : "+s"(z)); return p + z; }
#define XB_TMO      128
#define XB_XCNT(j)  (256  + 64 * (j))
#define XB_XSUB(j)  (1280 + 64 * (j))
#define XB_XGEN(j)  (2304 + 64 * (j))
#define XB_TOP      3328
#define XB_TOPGEN   3392
#define XCD_BAR_WORDS 3456
#define XB_SPIN_CAP (1u << 22)

__device__ __forceinline__ unsigned xb_ld(unsigned* p)              { return __hip_atomic_load(p, __ATOMIC_RELAXED, __HIP_MEMORY_SCOPE_AGENT); }
__device__ __forceinline__ unsigned xb_add(unsigned* p, unsigned v) { return __hip_atomic_fetch_add(p, v, __ATOMIC_RELAXED, __HIP_MEMORY_SCOPE_AGENT); }
__device__ __forceinline__ unsigned xb_xcc_id() { return (unsigned)__builtin_amdgcn_s_getreg((3 << 11) | 20) & 0xFu; }
#define XB_SPIN(cond, bar) do { unsigned _sp = 0; while (cond) { __builtin_amdgcn_s_sleep(1); \
    if ((++_sp & 255u) == 0u) { if (xb_ld(&(bar)[XB_TMO])) break; if (_sp > XB_SPIN_CAP) { atomicAdd(&(bar)[XB_TMO], 1u); break; } } } } while (0)

struct XcdBarrier { unsigned* bar; unsigned x; volatile LAS unsigned* st; int wave; };

__device__ __forceinline__ XcdBarrier xcd_barrier_post(unsigned* bar, volatile LAS unsigned* st) {
    XcdBarrier b; b.bar = bar; b.x = xb_xcc_id(); b.st = st; b.wave = __builtin_amdgcn_readfirstlane(threadIdx.x >> 6);
    if (threadIdx.x == 0) (void)xb_add(&bar[XB_XCNT(b.x)], 1u);
    return b;
}
__device__ __forceinline__ void xcd_barrier_complete(unsigned* bar, unsigned x, unsigned& nloc, unsigned& nx) {
    const unsigned G = gridDim.x * gridDim.y * gridDim.z;
    unsigned sum, cnt, mine, sp = 0u;
    for (;;) {
        sum = 0u; cnt = 0u; mine = 0u;
#pragma unroll
        for (unsigned j = 0; j < 16; ++j) { const unsigned c = xb_ld(&bar[XB_XCNT(j)]); sum += c; cnt += (c > 0u) ? 1u : 0u; mine = (j == x) ? c : mine; }
        if (sum == G) break;
        __builtin_amdgcn_s_sleep(1);
        if ((++sp & 255u) == 0u) { if (xb_ld(&bar[XB_TMO])) break; if (sp > XB_SPIN_CAP) { atomicAdd(&bar[XB_TMO], 1u); break; } }
    }
    nloc = mine > 0u ? mine : 1u; nx = cnt > 0u ? cnt : 1u;
}
__device__ __forceinline__ void xcd_barrier(const XcdBarrier& b) {
    asm volatile("s_waitcnt vmcnt(0)" ::: "memory");
    __syncthreads();
    if (b.wave == 0 && lane_id() == 0) {
        unsigned* bar = b.bar;
        const unsigned bx = xb_xcc_id();
        __builtin_amdgcn_s_waitcnt(0);
        unsigned nloc = b.st[0], nx = b.st[1];
        if (nloc == 0u) { xcd_barrier_complete(bar, bx, nloc, nx); b.st[0] = nloc; b.st[1] = nx; }
        const unsigned old = xb_add(&bar[XB_XSUB(bx)], 1u);
        const unsigned gen = old / nloc;
        if (old + 1u == (gen + 1u) * nloc) {
            __builtin_amdgcn_fence(__ATOMIC_RELEASE, "agent");
            asm volatile("s_waitcnt vmcnt(0)" ::: "memory");
            const unsigned og = xb_add(&bar[XB_TOP], 1u);
            const unsigned tg = og / nx;
            if (og + 1u == (tg + 1u) * nx) xb_add(&bar[XB_TOPGEN], 1u);
            else XB_SPIN(xb_ld(&bar[XB_TOPGEN]) == tg, bar);
            __builtin_amdgcn_fence(__ATOMIC_ACQUIRE, "agent");
            xb_add(&bar[XB_XGEN(bx)], 1u);
            asm volatile("s_waitcnt vmcnt(0)" ::: "memory");
        } else {
            XB_SPIN(xb_ld(&bar[XB_XGEN(bx)]) == gen, bar);
            __builtin_amdgcn_fence(__ATOMIC_ACQUIRE, "agent");
            asm volatile("s_waitcnt vmcnt(0)" ::: "memory");
        }
    }
    __syncthreads();
}

#if SIMPLE_BAR
__device__ __forceinline__ void simple_barrier(unsigned* cnt, unsigned target) {
    asm volatile("s_waitcnt vmcnt(0)" ::: "memory");
    __syncthreads();
    if (threadIdx.x == 0) {
        __threadfence();
        asm volatile("s_waitcnt vmcnt(0)" ::: "memory");
        __hip_atomic_fetch_add(cnt, 1u, __ATOMIC_RELAXED, __HIP_MEMORY_SCOPE_AGENT);
        unsigned sp = 0;
        while (__hip_atomic_load(cnt, __ATOMIC_RELAXED, __HIP_MEMORY_SCOPE_AGENT) < target) { __builtin_amdgcn_s_sleep(2); if (++sp > (1u << 24)) break; }
        __threadfence();
        asm volatile("s_waitcnt vmcnt(0)" ::: "memory");
    }
    __syncthreads();
}
#endif
namespace pg8 {
constexpr int BM = 256, BK = 64, HALF = 128, HTB = HALF * BK * 2, STAGE_BYTES = 8 * HTB, NXCD = 8, WGM = 8;
__host__ __device__ __forceinline__ int lds_byte(int r, int c) { const int st = (r >> 4) * 2 + (c >> 5), rr = r & 15, cc = c & 31, ob = rr * 64 + cc * 2; return st * 1024 + (ob ^ (((ob >> 9) & 1) << 5)); }
__host__ __device__ __forceinline__ void stage_rc(int b, int& R, int& C) { const int st = b / 1024, sb = b % 1024, swz = sb ^ (((sb >> 9) & 1) << 5); R = (st >> 1) * 16 + swz / 64; C = (st & 1) * 32 + (swz % 64) / 2; }
__host__ __device__ __forceinline__ int perm32(int rho) { const int n = rho >> 4, i = rho & 15; return 8 * (i >> 2) + 4 * n + (i & 3); }

struct Unit { int pm, pn, ks, half; };
struct OrderBase {
    int nM, nN, nwg, G, c;
    __device__ void init(int nM_, int nN_, int G_, int c_) { nM = nM_; nN = nN_; nwg = nM * nN; G = G_; c = c_; }
    __device__ bool next(int i, Unit& u) const {
        long L = (long)i * G + c; u.half = 0;
#if TAIL2
        { const int R = nwg / G, rem = nwg - R * G;
          if (rem > 0 && 2 * rem <= G && i >= R) { if (i > R || c >= 2 * rem) return false; L = (long)R * G + (c >> 1); u.half = 1 + (c & 1); } }
#endif
        if (L >= nwg) return false;
        int wgid = (int)L; { const int q = nwg / NXCD, r = nwg % NXCD, xcd = wgid % NXCD, off = wgid / NXCD; wgid = (xcd < r ? xcd * (q + 1) : r * (q + 1) + (xcd - r) * q) + off; }
        const int nig = WGM * nN, gid = wgid / nig, fm = gid * WGM, gsz = (nM - fm) < WGM ? (nM - fm) : WGM;
        u.pm = fm + ((wgid % nig) % gsz); u.pn = (wgid % nig) / gsz; u.ks = 0; return true;
    }
};
struct PlainSched : OrderBase {
    const char* A; const char* Bt; size_t tstep; int swap_from = 1 << 30, swap_to = 0;
    __device__ __forceinline__ bool swapped(const Unit& u) const { return u.pn >= swap_from && u.pn < swap_to; }
    __device__ __forceinline__ const char* abase(const Unit& u) const { return swapped(u) ? Bt + (size_t)u.pn * tstep : A + (size_t)u.pm * tstep; }
    __device__ __forceinline__ const char* bbase(const Unit& u) const { return swapped(u) ? A + (size_t)u.pm * tstep : Bt + (size_t)u.pn * tstep; }
    __device__ __forceinline__ int brow(const Unit& u) const { return u.pn * 256; }
    __device__ __forceinline__ int arow(const Unit& u) const { return u.pm * 256; }
};
struct MoeSched : OrderBase {
    const char* A; const char* Bt; size_t tstep, estride; int ps1, ps2, ps3, ps4, ps5, ps6, ps7, erows;
    __device__ __forceinline__ int expert(int pm) const { return (pm >= ps1) + (pm >= ps2) + (pm >= ps3) + (pm >= ps4) + (pm >= ps5) + (pm >= ps6) + (pm >= ps7); }
    __device__ __forceinline__ bool swapped(const Unit&) const { return false; }
    int sparse, caprows;
    __device__ __forceinline__ int pstart(int pm) const { int p0 = 0; p0 = pm >= ps1 ? ps1 : p0; p0 = pm >= ps2 ? ps2 : p0; p0 = pm >= ps3 ? ps3 : p0; p0 = pm >= ps4 ? ps4 : p0; p0 = pm >= ps5 ? ps5 : p0; p0 = pm >= ps6 ? ps6 : p0; p0 = pm >= ps7 ? ps7 : p0; return p0; }
    __device__ __forceinline__ int arow(const Unit& u) const { return sparse ? expert(u.pm) * caprows + (u.pm - pstart(u.pm)) * 256 : u.pm * 256; }
    __device__ __forceinline__ const char* abase(const Unit& u) const { return A + (size_t)arow(u) * (tstep >> 8); }
    __device__ __forceinline__ const char* bbase(const Unit& u) const { return Bt + (size_t)expert(u.pm) * estride + (size_t)u.pn * tstep; }
    __device__ __forceinline__ int brow(const Unit& u) const { return expert(u.pm) * erows + u.pn * 256; }
};

struct CtxSplitSched {
    int nN, nS, G, c; const char* A; const char* Bt; size_t tstep; size_t kslice;
    __device__ bool next(int i, Unit& u) const { const int L = i * G + c; if (L >= 2 * nN * nS) return false; u.pm = 64 + (L & 1); u.pn = (L >> 1) % nN; u.ks = (L >> 1) / nN; u.half = 0; return true; }
    __device__ __forceinline__ const char* abase(const Unit& u) const { return A + (size_t)u.pm * tstep + (size_t)u.ks * kslice; }
    __device__ __forceinline__ const char* bbase(const Unit& u) const { return Bt + (size_t)u.pn * tstep + (size_t)u.ks * kslice; }
    __device__ __forceinline__ int brow(const Unit& u) const { return u.pn * 256; }
    __device__ __forceinline__ int arow(const Unit& u) const { return u.pm * 256; }
    __device__ __forceinline__ bool swapped(const Unit&) const { return false; }
};
template <class Epi, class Sched, bool ALIGN_EPI, bool SP2, int MODE = 0>
__device__ __forceinline__ void gemm_phase(LAS unsigned char* lds, const int K, const Sched& S, const Epi& E, const int wave, const int ktiles = 0, const int sc_w = 0x7F7F7F7F, const int sc_a = 0x7F7F7F7F,
                                           const float* rs = nullptr, const float* cs = nullptr) {
    constexpr bool F8 = (MODE == 1), I8 = (MODE == 2);
    const int tid = fresh_tid(wave); const int wid = __builtin_amdgcn_readfirstlane(tid >> 6), lane = tid & 63, wr = wid >> 2, wc = wid & 3, fr = lane & 15, fq = lane >> 4;
    const int nt = ktiles ? ktiles : K / BK;
    unsigned voffA[2];
#pragma unroll
    for (int i = 0; i < 2; ++i) { int R, C; stage_rc(tid * 16 + i * 8192, R, C); voffA[i] = (unsigned)(R * K + C) * 2u; }
#define voffB voffA
    const size_t kstep = (size_t)(BK * 2);
    const size_t hstep = (size_t)HALF * K * 2;
    const unsigned ldsw = (unsigned)wid * 1024u;
    const int aoff = lds_byte(wr * 64 + fr, fq * 8), boff = lds_byte(wc * 32 + fr, fq * 8);
#define PG8_SA(b, h) (((b) * 2 + (h)) * HTB)
#define PG8_SB(b, h) ((4 + (b) * 2 + (h)) * HTB)
#define PG8_STAGE(bufoff, gbase, voff) do { _Pragma("unroll") for (int _i = 0; _i < 2; ++_i) \
        __builtin_amdgcn_global_load_lds((const unsigned*)((const char*)(gbase) + (voff)[_i]), (LAS unsigned*)(lds + (bufoff) + ldsw + _i * 8192), 16, 0, 0); } while (0)
#define PG8_LDA(dst, b, h) do { if constexpr (F8) { _Pragma("unroll") for (int m = 0; m < 4; ++m) { \
            const v4i_ lo_ = *(const LAS v4i_*)(lds + PG8_SA(b, h) + aoff + m * 2048), hi_ = *(const LAS v4i_*)(lds + PG8_SA(b, h) + aoff + m * 2048 + 1024); \
            dst##8[m] = __builtin_shufflevector(lo_, hi_, 0, 1, 2, 3, 4, 5, 6, 7); } } \
        else { _Pragma("unroll") for (int m = 0; m < 4; ++m) _Pragma("unroll") for (int k = 0; k < 2; ++k) dst[m][k] = *(const LAS bf16x8*)(lds + PG8_SA(b, h) + aoff + m * 2048 + k * 1024); } } while (0)
#define PG8_LDB(dst, b, h) do { if constexpr (F8) { _Pragma("unroll") for (int n = 0; n < 2; ++n) { \
            const v4i_ lo_ = *(const LAS v4i_*)(lds + PG8_SB(b, h) + boff + n * 2048), hi_ = *(const LAS v4i_*)(lds + PG8_SB(b, h) + boff + n * 2048 + 1024); \
            dst##8[n] = __builtin_shufflevector(lo_, hi_, 0, 1, 2, 3, 4, 5, 6, 7); } } \
        else { _Pragma("unroll") for (int n = 0; n < 2; ++n) _Pragma("unroll") for (int k = 0; k < 2; ++k) dst[n][k] = *(const LAS bf16x8*)(lds + PG8_SB(b, h) + boff + n * 2048 + k * 1024); } } while (0)
#define PG8_MMA(ai, bj, At, Bt) do { __builtin_amdgcn_s_setprio(1); \
        if constexpr (F8) { _Pragma("unroll") for (int m = 0; m < 4; ++m) _Pragma("unroll") for (int n = 0; n < 2; ++n) \
            asm volatile("v_mfma_scale_f32_16x16x128_f8f6f4 %0, %1, %2, %0, %3, %4 op_sel_hi:[0,0,0]" : "+v"(acc[ai][bj][m][n]) : "v"(Bt##8[n]), "v"(At##8[m]), "v"(sc_w), "v"(sc_a)); } \
        else if constexpr (I8) { _Pragma("unroll") for (int m = 0; m < 4; ++m) _Pragma("unroll") for (int n = 0; n < 2; ++n) _Pragma("unroll") for (int k = 0; k < 2; ++k) \
            acc[ai][bj][m][n] = __builtin_bit_cast(f32x4, __builtin_amdgcn_mfma_i32_16x16x64_i8(__builtin_bit_cast(v4i_, Bt[n][k]), __builtin_bit_cast(v4i_, At[m][k]), __builtin_bit_cast(v4i_, acc[ai][bj][m][n]), 0, 0, 0)); } \
        else { _Pragma("unroll") for (int m = 0; m < 4; ++m) _Pragma("unroll") for (int n = 0; n < 2; ++n) _Pragma("unroll") for (int k = 0; k < 2; ++k) \
            acc[ai][bj][m][n] = __builtin_amdgcn_mfma_f32_16x16x32_bf16(Bt[n][k], At[m][k], acc[ai][bj][m][n], 0, 0, 0); } \
        __builtin_amdgcn_s_setprio(0); } while (0)
#define PG8_WAIT_V(n) asm volatile("s_waitcnt vmcnt(" #n ")" ::: "memory")
#define PG8_WAIT_L(n) asm volatile("s_waitcnt lgkmcnt(" #n ")" ::: "memory")
#define PG8_BAR __builtin_amdgcn_s_barrier()
#define PG8_SCHED __builtin_amdgcn_sched_barrier(0)
    Unit cur, nxt; int ui = 0;
    if (!S.next(0, cur)) return;
    f32x4 acc[2][2][4][2];
#pragma unroll
    for (int a = 0; a < 2; ++a)
#pragma unroll
        for (int b = 0; b < 2; ++b)
#pragma unroll
            for (int m = 0; m < 4; ++m)
#pragma unroll
                for (int n = 0; n < 2; ++n) acc[a][b][m][n] = (f32x4){0.f, 0.f, 0.f, 0.f};
    typedef int v8i_ __attribute__((ext_vector_type(8))); typedef int v4i_ __attribute__((ext_vector_type(4)));
    bf16x8 At[4][2], B0[2][2], B1[2][2]; v8i_ At8[4], B08[2], B18[2];
    const char* cA = S.abase(cur); const char* cB = S.bbase(cur);
    if constexpr (SP2) {
        PG8_STAGE(PG8_SB(0, 0), cB, voffB); PG8_STAGE(PG8_SB(0, 1), cB + hstep, voffB); PG8_STAGE(PG8_SA(0, 0), cA, voffA); PG8_STAGE(PG8_SA(0, 1), cA + hstep, voffA);
        if (wr == 1) PG8_BAR;
        PG8_WAIT_V(2); PG8_BAR;
        PG8_STAGE(PG8_SB(1, 0), cB + kstep, voffB); PG8_STAGE(PG8_SA(1, 0), cA + kstep, voffA); PG8_STAGE(PG8_SB(1, 1), cB + hstep + kstep, voffB);
        PG8_WAIT_V(6); PG8_BAR;
    } else {
        PG8_STAGE(PG8_SB(0, 0), cB, voffB); PG8_STAGE(PG8_SA(0, 0), cA, voffA); PG8_STAGE(PG8_SB(0, 1), cB + hstep, voffB); PG8_STAGE(PG8_SA(0, 1), cA + hstep, voffA);
        if (wr == 1) PG8_BAR;
        PG8_WAIT_V(4); PG8_BAR;
        PG8_STAGE(PG8_SB(1, 0), cB + kstep, voffB); PG8_STAGE(PG8_SA(1, 0), cA + kstep, voffA); PG8_STAGE(PG8_SB(1, 1), cB + hstep + kstep, voffB);
        PG8_WAIT_V(6); PG8_BAR;
    }
    for (;;) {
        const bool has_next = S.next(ui + 1, nxt);
        const char* nA = has_next ? S.abase(nxt) : cA; const char* nB = has_next ? S.bbase(nxt) : cB;
        for (int t = 0; t < nt; t += 2) {
            const bool last = (t == nt - 2);
            const char* a1 = cA + (size_t)(t + 1) * kstep;
            const char* a2 = last ? nA : cA + (size_t)(t + 2) * kstep; const char* b2 = last ? nB : cB + (size_t)(t + 2) * kstep;
            const char* a3 = a2 + kstep; const char* b3 = b2 + kstep;
            if constexpr (SP2) {
            PG8_LDB(B0, 0, 0); PG8_LDB(B1, 0, 1); PG8_SCHED; PG8_LDA(At, 0, 0); PG8_STAGE(PG8_SA(1, 1), a1 + hstep, voffA);
            PG8_WAIT_V(8); PG8_WAIT_L(0); PG8_BAR; if (!TAIL2 || cur.half != 2) { PG8_MMA(0, 0, At, B0); PG8_MMA(0, 1, At, B1); } PG8_BAR; PG8_SCHED;
            PG8_LDA(At, 0, 1); PG8_STAGE(PG8_SB(0, 0), b2, voffB); PG8_STAGE(PG8_SB(0, 1), b2 + hstep, voffB); PG8_STAGE(PG8_SA(0, 0), a2, voffA);
            PG8_WAIT_V(8); PG8_WAIT_L(0); PG8_BAR; if (!TAIL2 || cur.half != 1) { PG8_MMA(1, 0, At, B0); PG8_MMA(1, 1, At, B1); } PG8_BAR; PG8_SCHED;
            PG8_LDB(B0, 1, 0); PG8_LDB(B1, 1, 1); PG8_SCHED; PG8_LDA(At, 1, 0); PG8_STAGE(PG8_SA(0, 1), a2 + hstep, voffA);
            PG8_WAIT_V(8); PG8_WAIT_L(0); PG8_BAR; if (!TAIL2 || cur.half != 2) { PG8_MMA(0, 0, At, B0); PG8_MMA(0, 1, At, B1); } PG8_BAR; PG8_SCHED;
            PG8_LDA(At, 1, 1); PG8_STAGE(PG8_SB(1, 0), b3, voffB); PG8_STAGE(PG8_SB(1, 1), b3 + hstep, voffB); PG8_STAGE(PG8_SA(1, 0), a3, voffA);
            PG8_WAIT_V(8); PG8_WAIT_L(0); PG8_BAR; if (!TAIL2 || cur.half != 1) { PG8_MMA(1, 0, At, B0); PG8_MMA(1, 1, At, B1); } PG8_BAR; PG8_SCHED;
            } else {
            PG8_LDB(B0, 0, 0); PG8_SCHED; PG8_LDA(At, 0, 0); PG8_STAGE(PG8_SA(1, 1), a1 + hstep, voffA);
            PG8_WAIT_L(8); PG8_BAR; PG8_WAIT_L(0); PG8_MMA(0, 0, At, B0); PG8_BAR; PG8_SCHED;
            PG8_LDB(B1, 0, 1); PG8_STAGE(PG8_SB(0, 0), b2, voffB);
            PG8_BAR; PG8_WAIT_L(0); PG8_MMA(0, 1, At, B1); PG8_BAR;
            PG8_LDA(At, 0, 1); PG8_STAGE(PG8_SA(0, 0), a2, voffA);
            PG8_BAR; PG8_WAIT_L(0); PG8_MMA(1, 0, At, B0); PG8_BAR; PG8_SCHED;
            PG8_STAGE(PG8_SB(0, 1), b2 + hstep, voffB);
            PG8_WAIT_V(6); PG8_BAR; PG8_MMA(1, 1, At, B1); PG8_BAR;
            PG8_LDB(B0, 1, 0); PG8_SCHED; PG8_LDA(At, 1, 0); PG8_STAGE(PG8_SA(0, 1), a2 + hstep, voffA);
            PG8_WAIT_L(8); PG8_BAR; PG8_WAIT_L(0); PG8_MMA(0, 0, At, B0); PG8_BAR; PG8_SCHED;
            PG8_LDB(B1, 1, 1); PG8_STAGE(PG8_SB(1, 0), b3, voffB);
            PG8_BAR; PG8_WAIT_L(0); PG8_MMA(0, 1, At, B1); PG8_BAR;
            PG8_LDA(At, 1, 1); PG8_STAGE(PG8_SA(1, 0), a3, voffA);
            PG8_BAR; PG8_WAIT_L(0); PG8_MMA(1, 0, At, B0); PG8_BAR; PG8_SCHED;
            PG8_STAGE(PG8_SB(1, 1), b3 + hstep, voffB);
            PG8_WAIT_V(6); PG8_BAR; PG8_MMA(1, 1, At, B1); PG8_BAR;
            }
        }
        if constexpr (ALIGN_EPI) { if (wr == 0) PG8_BAR; }
        if constexpr (F8) asm volatile("s_nop 15\n\ts_nop 15" ::: "memory");
        if constexpr (I8) {
            const int l3_ = lane_id(); const int fr_ = l3_ & 15, fq_ = l3_ >> 4; const bool sw_ = S.swapped(cur);
            const float* rowS = sw_ ? cs + S.brow(cur) : rs + S.arow(cur); const float* colS = sw_ ? rs + S.arow(cur) : cs + S.brow(cur);
            f32x4 csv[2][2];
#pragma unroll
            for (int bj = 0; bj < 2; ++bj)
#pragma unroll
                for (int n = 0; n < 2; ++n) csv[bj][n] = *(const f32x4*)(colS + 128 * bj + 32 * wc + 16 * n + 4 * fq_);
#pragma unroll
            for (int ai = 0; ai < 2; ++ai)
#pragma unroll
                for (int m = 0; m < 4; ++m) { const float rsv = rowS[128 * ai + 64 * wr + 16 * m + fr_];
#pragma unroll
                    for (int bj = 0; bj < 2; ++bj)
#pragma unroll
                        for (int n = 0; n < 2; ++n)
#pragma unroll
                            for (int j = 0; j < 4; ++j) { const float t_ = acc[ai][bj][m][n][j];
                                acc[ai][bj][m][n][j] = (float)__float_as_int(t_) * (rsv * csv[bj][n][j]); } }
        }
        { const int l2_ = lane_id(); E(acc, cur, wr, wc, l2_ & 15, l2_ >> 4); }
        if (!has_next) break;
#pragma unroll
        for (int a = 0; a < 2; ++a)
#pragma unroll
            for (int b = 0; b < 2; ++b)
#pragma unroll
                for (int m = 0; m < 4; ++m)
#pragma unroll
                    for (int n = 0; n < 2; ++n) acc[a][b][m][n] = (f32x4){0.f, 0.f, 0.f, 0.f};
        cur = nxt; cA = nA; cB = nB; ++ui;
        if constexpr (ALIGN_EPI) { if (wr == 1) PG8_BAR; }
    }
    PG8_WAIT_V(0);
    if constexpr (!ALIGN_EPI) { if (wr == 0) PG8_BAR; }
    PG8_BAR;
#undef voffB
#undef PG8_SA
#undef PG8_SB
#undef PG8_STAGE
#undef PG8_LDA
#undef PG8_LDB
#undef PG8_MMA
#undef PG8_WAIT_V
#undef PG8_WAIT_L
#undef PG8_BAR
#undef PG8_SCHED
}
}
namespace pg8 {
__device__ __forceinline__ void st8(bf16* p, const f32x4& v0, const f32x4& v1) {
    v4u w; w.x = cvtpk(v0[0], v0[1]); w.y = cvtpk(v0[2], v0[3]); w.z = cvtpk(v1[0], v1[1]); w.w = cvtpk(v1[2], v1[3]);
    *(v4u*)p = w;
}
struct EpiIn {
    bf16 *convb, *zb, *qb, *xbcb, *kb, *vb; float* dtb; const float* ropec; const float* ropes; unsigned char* k8; unsigned char* v8;
    __device__ __forceinline__ void st_k8(int pm, int pn, int bj, int ai, int wr, int wc, int m, int fr, int fq, const f32x4& o1, const f32x4& o2) const {
        const int b = pm < 64 ? (pm >> 5) : (pm - 64), t = (pm < 64 ? CTXL / 64 + (pm & 31) * 4 : 0) + 2 * ai + wr, h = 2 * (pn - 16) + bj;
        const int chunk = (((wc >> 1) * 2 + (wc & 1)) * 2 + (fq >> 1)) * 64 + m * 16 + fr;
        const f32x4 lo = __builtin_elementwise_min(__builtin_elementwise_max(o1, (f32x4){-448.f, -448.f, -448.f, -448.f}), (f32x4){448.f, 448.f, 448.f, 448.f});
        const f32x4 hh = __builtin_elementwise_min(__builtin_elementwise_max(o2, (f32x4){-448.f, -448.f, -448.f, -448.f}), (f32x4){448.f, 448.f, 448.f, 448.f});
        v2u w;
        w.x = (unsigned)__builtin_amdgcn_cvt_pk_fp8_f32(lo[2], lo[3], __builtin_amdgcn_cvt_pk_fp8_f32(lo[0], lo[1], 0, false), true);
        w.y = (unsigned)__builtin_amdgcn_cvt_pk_fp8_f32(hh[2], hh[3], __builtin_amdgcn_cvt_pk_fp8_f32(hh[0], hh[1], 0, false), true);
        *(v2u*)(k8 + ((size_t)(b * (KVLEN / 64) + t) * 8 + h) * 8192 + chunk * 16 + 8 * (fq & 1)) = w;
    }
    __device__ __forceinline__ void st_q8(unsigned char* p, const f32x4& o1, const f32x4& o2) const {
        constexpr float C = 0.125f * 1.4426950408889634f * (ATT_Y8 ? 8.0f : 1.0f);
        const f32x4 lo = __builtin_elementwise_min(__builtin_elementwise_max(o1 * C, (f32x4){-448.f, -448.f, -448.f, -448.f}), (f32x4){448.f, 448.f, 448.f, 448.f});
        const f32x4 hh = __builtin_elementwise_min(__builtin_elementwise_max(o2 * C, (f32x4){-448.f, -448.f, -448.f, -448.f}), (f32x4){448.f, 448.f, 448.f, 448.f});
        v2u w;
        w.x = (unsigned)__builtin_amdgcn_cvt_pk_fp8_f32(lo[2], lo[3], __builtin_amdgcn_cvt_pk_fp8_f32(lo[0], lo[1], 0, false), true);
        w.y = (unsigned)__builtin_amdgcn_cvt_pk_fp8_f32(hh[2], hh[3], __builtin_amdgcn_cvt_pk_fp8_f32(hh[0], hh[1], 0, false), true);
        *(v2u*)p = w;
    }
    __device__ __forceinline__ void st_v8(const f32x4 (&acc)[2][2][4][2], int pm, int pn, int wr, int wc, int fr, int fq) const {
        const int b = pm < 64 ? (pm >> 5) : (pm - 64), t0 = (pm < 64 ? CTXL / 64 + (pm & 31) * 4 : 0) + (wc >> 1);
#pragma unroll
        for (int ai = 0; ai < 2; ++ai) { const int h = 2 * (pn - 20) + ai;
#pragma unroll
            for (int bj = 0; bj < 2; ++bj) { unsigned char* tile = v8 + ((size_t)(b * (KVLEN / 64) + t0 + 2 * bj) * 8 + h) * 8192;
#pragma unroll
                for (int m = 0; m < 4; ++m) {
                    unsigned Dw[2];
#pragma unroll
                    for (int n = 0; n < 2; ++n) { const f32x4 c = __builtin_elementwise_min(__builtin_elementwise_max(acc[ai][bj][m][n], (f32x4){-448.f, -448.f, -448.f, -448.f}), (f32x4){448.f, 448.f, 448.f, 448.f});
                        Dw[n] = (unsigned)__builtin_amdgcn_cvt_pk_fp8_f32(c[2], c[3], __builtin_amdgcn_cvt_pk_fp8_f32(c[0], c[1], 0, false), true); }
                    const int chunk = (((2 * wr + (m >> 1)) * 2 + (fq & 1)) * 2 + (wc & 1)) * 32 + 16 * (m & 1) + fr;
#if V8_NOSWAP
                    *(unsigned*)(tile + chunk * 16 + (fq >> 1) * 4) = Dw[0]; *(unsigned*)(tile + chunk * 16 + 8 + (fq >> 1) * 4) = Dw[1];
#else
                    swap32u(Dw[0], Dw[1]);
                    v2u w; w.x = Dw[0]; w.y = Dw[1];
                    *(v2u*)(tile + chunk * 16 + (fq >> 1) * 8) = w;
#endif
                } } }
    }
    __device__ __forceinline__ void operator()(const f32x4 (&acc)[2][2][4][2], const Unit& u, int wr, int wc, int fr, int fq) const {
        const int pn = u.pn, pm = u.pm;
        if (V8_DIRECT && pn >= 20 && pn < 24) { st_v8(acc, pm, pn, wr, wc, fr, fq); return; }
        if (CONV_U && pn >= 2 && pn < 6) {
            bf16* bu = convb + (size_t)pm * 256 * 1536 + 512 + 128 * (pn - 2) + wc * 32 + 8 * fq;
#pragma unroll
            for (int ai = 0; ai < 2; ++ai)
#pragma unroll
                for (int m = 0; m < 4; ++m) { const int rl = ai * 128 + wr * 64 + m * 16 + fr;
                    st8(bu + (size_t)rl * 1536, acc[ai][0][m][0] * acc[ai][0][m][1], acc[ai][1][m][0] * acc[ai][1][m][1]); }
            return;
        }
        if (pn == 24) {
            if (wc == 0) {
#pragma unroll
                for (int ai = 0; ai < 2; ++ai)
#pragma unroll
                    for (int m = 0; m < 4; ++m) { if (TAIL2 && u.half != 0 && u.half != ai + 1) continue; const int r = pm * 256 + ai * 128 + wr * 64 + m * 16 + fr; *(f32x4*)(dtb + (size_t)r * 16 + 4 * fq) = acc[ai][0][m][0]; }
            }
            return;
        }
        bf16* base; int ld, col0; bool rope = false, kv = false;
        if (pn < 6) { base = convb; ld = 1536; col0 = 256 * pn; }
        else if (pn < 8) { base = zb; ld = 512; col0 = 256 * (pn - 6); }
        else if (pn < 12) { base = qb; ld = 1024; col0 = 256 * (pn - 8); rope = pm < 64; }
        else if (pn < 16) { base = xbcb; ld = 1024; col0 = 256 * (pn - 12); }
        else if (pn < 20) { base = kb; ld = 1024; col0 = 256 * (pn - 16); rope = pm < 64; kv = true; }
        else { base = vb; ld = 1024; col0 = 256 * (pn - 20); kv = true; }
        const size_t rowbase = !kv ? (size_t)pm * 256 : (pm < 64 ? (size_t)(pm >> 5) * KVLEN + CTXL + (size_t)(pm & 31) * 256 : (size_t)(pm - 64) * KVLEN);
        bf16* bp = base + rowbase * ld + col0 + wc * 32 + 8 * fq;
        if (rope) {
#pragma unroll
            for (int ai = 0; ai < 2; ++ai)
#pragma unroll
                for (int m = 0; m < 4; ++m) { if (TAIL2 && u.half != 0 && u.half != ai + 1) continue;
                    const int rl = ai * 128 + wr * 64 + m * 16 + fr;
                    const int pos = (wc & 1) ? 128 + m * 16 + fr : 4 * (pm & 31) + 2 * ai + wr;
                    const f32x4 cs = *(const f32x4*)(ropec + pos * 16 + 4 * fq), sn = *(const f32x4*)(ropes + pos * 16 + 4 * fq);
#pragma unroll
                    for (int bj = 0; bj < 2; ++bj) {
                        const f32x4 a1 = acc[ai][bj][m][0], a2 = acc[ai][bj][m][1];
                        const f32x4 o1 = a1 * cs - a2 * sn, o2 = a2 * cs + a1 * sn;
                        if (K8_DIRECT && kv) st_k8(pm, pn, bj, ai, wr, wc, m, fr, fq, o1, o2);
                        else if (Q8_DIRECT && !kv) st_q8((unsigned char*)qb + (size_t)(pm * 16 + ai * 8 + wr * 4 + m) * 16384 + (size_t)(((col0 + bj * 128 + wc * 32) >> 3) + fq) * 128 + fr * 8, o1, o2);
                        else st8(bp + (size_t)rl * ld + bj * 128, o1, o2);
                    }
                }
        } else {
#pragma unroll
            for (int ai = 0; ai < 2; ++ai)
#pragma unroll
                for (int m = 0; m < 4; ++m) { if (TAIL2 && u.half != 0 && u.half != ai + 1) continue;
                    const int rl = ai * 128 + wr * 64 + m * 16 + fr;
#pragma unroll
                    for (int bj = 0; bj < 2; ++bj) { if (K8_DIRECT && kv && pn < 20) st_k8(pm, pn, bj, ai, wr, wc, m, fr, fq, acc[ai][bj][m][0], acc[ai][bj][m][1]);
                        else if (Q8_DIRECT && pn >= 8 && pn < 12) st_q8((unsigned char*)qb + (size_t)(pm * 16 + ai * 8 + wr * 4 + m) * 16384 + (size_t)(((col0 + bj * 128 + wc * 32) >> 3) + fq) * 128 + fr * 8, acc[ai][bj][m][0], acc[ai][bj][m][1]);
                        else st8(bp + (size_t)rl * ld + bj * 128, acc[ai][bj][m][0], acc[ai][bj][m][1]); }
                }
        }
    }
};
__device__ __forceinline__ void ld8b(const bf16* p, float (&o)[8]) { const v4u w = *(const v4u*)p; o[0] = bflo(w.x); o[1] = bfhi(w.x); o[2] = bflo(w.y); o[3] = bfhi(w.y); o[4] = bflo(w.z); o[5] = bfhi(w.z); o[6] = bflo(w.w); o[7] = bfhi(w.w); }
template <bool SRC16>
struct EpiResidT {
    const void* srcLat; const void* srcCtx; bf16* dst; const float* gate;
    __device__ __forceinline__ void operator()(const f32x4 (&acc)[2][2][4][2], const Unit& u, int wr, int wc, int fr, int fq) const {
        const int pm = u.pm; const int v = pm < 32 ? 0 : (pm < 64 ? 1 : 2);
        const float* gv = gate + (size_t)v * 6 * D;
        const size_t sro = pm < 64 ? (size_t)pm * 256 * D : (size_t)(pm - 64) * 256 * D;
        const float* s32 = (const float*)(pm < 64 ? srcLat : srcCtx) + sro; const bf16* s16 = (const bf16*)(pm < 64 ? srcLat : srcCtx) + sro;
        bf16* dp = dst + (size_t)pm * 256 * D;
#if PERM_OUT
        const int colb = u.pn * 256 + wc * 32 + 8 * fq;
        f32x4 g[2][2];
#pragma unroll
        for (int bj = 0; bj < 2; ++bj)
#pragma unroll
            for (int n = 0; n < 2; ++n) g[bj][n] = *(const f32x4*)(gv + colb + bj * 128 + n * 4);
#pragma unroll
        for (int ai = 0; ai < 2; ++ai)
#pragma unroll
            for (int m = 0; m < 4; ++m) { if (TAIL2 && u.half != 0 && u.half != ai + 1) continue;
                const size_t off = (size_t)(ai * 128 + wr * 64 + m * 16 + fr) * D + colb;
#pragma unroll
                for (int bj = 0; bj < 2; ++bj) { f32x4 s0, s1;
                    if (SRC16) { float t[8]; ld8b(s16 + off + bj * 128, t); s0 = (f32x4){t[0], t[1], t[2], t[3]}; s1 = (f32x4){t[4], t[5], t[6], t[7]}; }
                    else { s0 = ld4_f32(s32 + off + bj * 128); s1 = ld4_f32(s32 + off + bj * 128 + 4); }
                    st8(dp + off + bj * 128, s0 + g[bj][0] * acc[ai][bj][m][0], s1 + g[bj][1] * acc[ai][bj][m][1]); }
                asm volatile("" ::: "memory");
            }
#else
        const int colb = u.pn * 256 + wc * 32 + 4 * fq;
        f32x4 g[2][2];
#pragma unroll
        for (int bj = 0; bj < 2; ++bj)
#pragma unroll
            for (int n = 0; n < 2; ++n) g[bj][n] = *(const f32x4*)(gv + colb + bj * 128 + n * 16);
#pragma unroll
        for (int ai = 0; ai < 2; ++ai)
#pragma unroll
            for (int m = 0; m < 4; ++m) { if (TAIL2 && u.half != 0 && u.half != ai + 1) continue;
                const size_t off = (size_t)(ai * 128 + wr * 64 + m * 16 + fr) * D + colb;
#pragma unroll
                for (int bj = 0; bj < 2; ++bj)
#pragma unroll
                    for (int n = 0; n < 2; ++n) { const f32x4 s = SRC16 ? ld4_bf16(s16 + off + bj * 128 + n * 16) : ld4_f32(s32 + off + bj * 128 + n * 16);
                        st4_bf16(dp + off + bj * 128 + n * 16, s + g[bj][n] * acc[ai][bj][m][n]); }
                asm volatile("" ::: "memory");
            }
#endif
    }
};
struct EpiSwiGLU {
    bf16* act; int ld;
    __device__ __forceinline__ void operator()(const f32x4 (&acc)[2][2][4][2], const Unit& u, int wr, int wc, int fr, int fq) const {
        bf16* bp = act + (size_t)u.pm * 256 * ld + u.pn * 128 + wc * 32 + 8 * fq;
#pragma unroll
        for (int ai = 0; ai < 2; ++ai)
#pragma unroll
            for (int m = 0; m < 4; ++m) { if (TAIL2 && u.half != 0 && u.half != ai + 1) continue;
                const int rl = ai * 128 + wr * 64 + m * 16 + fr;
                f32x4 o[2];
#pragma unroll
                for (int bj = 0; bj < 2; ++bj) { const f32x4 g = acc[ai][bj][m][0], up = acc[ai][bj][m][1];
#pragma unroll
                    for (int j = 0; j < 4; ++j) o[bj][j] = silu_f(g[j]) * up[j]; }
                st8(bp + (size_t)rl * ld, o[0], o[1]);
            }
    }
};
constexpr float ACT_SCALE = 4.0f; constexpr int ACT_SC8 = 0x7D7D7D7D;
struct EpiSwiGLU8 {
    unsigned char* act; int ld;
    __device__ __forceinline__ void operator()(const f32x4 (&acc)[2][2][4][2], const Unit& u, int wr, int wc, int fr, int fq) const {
        unsigned char* bp = act + (size_t)u.pm * 256 * ld + u.pn * 128 + wc * 32 + 8 * fq;
#pragma unroll
        for (int ai = 0; ai < 2; ++ai)
#pragma unroll
            for (int m = 0; m < 4; ++m) { if (TAIL2 && u.half != 0 && u.half != ai + 1) continue;
                const int rl = ai * 128 + wr * 64 + m * 16 + fr;
                float o[8];
#pragma unroll
                for (int bj = 0; bj < 2; ++bj) { const f32x4 g = acc[ai][bj][m][0], up = acc[ai][bj][m][1];
#pragma unroll
                    for (int j = 0; j < 4; ++j) o[4 * bj + j] = fminf(fmaxf(silu_f(g[j]) * up[j] * ACT_SCALE, -448.f), 448.f); }
                v2u w;
                w.x = (unsigned)__builtin_amdgcn_cvt_pk_fp8_f32(o[2], o[3], __builtin_amdgcn_cvt_pk_fp8_f32(o[0], o[1], 0, false), true);
                w.y = (unsigned)__builtin_amdgcn_cvt_pk_fp8_f32(o[6], o[7], __builtin_amdgcn_cvt_pk_fp8_f32(o[4], o[5], 0, false), true);
                *(v2u*)(bp + (size_t)rl * ld) = w;
            }
    }
};
struct EpiBf16 {
    bf16* O; int ld;
    __device__ __forceinline__ void operator()(const f32x4 (&acc)[2][2][4][2], const Unit& u, int wr, int wc, int fr, int fq) const {
        bf16* bp = O + (size_t)u.pm * 256 * ld + u.pn * 256 + wc * 32 + 8 * fq;
#pragma unroll
        for (int ai = 0; ai < 2; ++ai)
#pragma unroll
            for (int m = 0; m < 4; ++m) { if (TAIL2 && u.half != 0 && u.half != ai + 1) continue;
                const int rl = ai * 128 + wr * 64 + m * 16 + fr;
#pragma unroll
                for (int bj = 0; bj < 2; ++bj) st8(bp + (size_t)rl * ld + bj * 128, acc[ai][bj][m][0], acc[ai][bj][m][1]);
                asm volatile("" ::: "memory");
            }
    }
};
struct EpiPartial {
    float* part;
    __device__ __forceinline__ void operator()(const f32x4 (&acc)[2][2][4][2], const Unit& u, int wr, int wc, int fr, int fq) const {
#if PART16 && PERM_OUT
        bf16* dp = (bf16*)part + ((size_t)u.ks * NCTX + (size_t)(u.pm - 64) * 256) * D + u.pn * 256 + wc * 32 + 8 * fq;
#pragma unroll
        for (int ai = 0; ai < 2; ++ai)
#pragma unroll
            for (int m = 0; m < 4; ++m) { if (TAIL2 && u.half != 0 && u.half != ai + 1) continue;
                const size_t off = (size_t)(ai * 128 + wr * 64 + m * 16 + fr) * D;
#pragma unroll
                for (int bj = 0; bj < 2; ++bj) st8(dp + off + bj * 128, acc[ai][bj][m][0], acc[ai][bj][m][1]);
                asm volatile("" ::: "memory");
            }
#else
        float* dp = part + ((size_t)u.ks * NCTX + (size_t)(u.pm - 64) * 256) * D + u.pn * 256 + wc * 32 + (PERM_OUT ? 8 : 4) * fq;
#pragma unroll
        for (int ai = 0; ai < 2; ++ai)
#pragma unroll
            for (int m = 0; m < 4; ++m) { if (TAIL2 && u.half != 0 && u.half != ai + 1) continue;
                const size_t off = (size_t)(ai * 128 + wr * 64 + m * 16 + fr) * D;
#pragma unroll
                for (int bj = 0; bj < 2; ++bj)
#pragma unroll
                    for (int n = 0; n < 2; ++n) *(f32x4*)(dp + off + bj * 128 + n * (PERM_OUT ? 4 : 16)) = acc[ai][bj][m][n];
                asm volatile("" ::: "memory");
            }
#endif
    }
};
}
struct Params { const float* in[28]; float* out; unsigned char* ws; };
enum { I_X = 0, I_C, I_CTX, I_CCTX, I_WMOD, I_BMOD, I_GMIX, I_GFFN, I_WIN, I_CONVW, I_SCONVW, I_SCONVB, I_ALOG, I_DTB, I_SSDD, I_SNORM, I_LAMBDA, I_SUBLN, I_WOUT,
       I_FG, I_FU, I_FD, I_RW, I_RB, I_MG, I_MU, I_MD, I_GFIN };
struct Frame {
    LAS unsigned char* lds; volatile LAS unsigned* MISC; gu32* ctl;
    int wave, vcu, G;
};
struct Lane { int tid, lane; __device__ __forceinline__ Lane(int wave) { tid = fresh_tid(wave); lane = tid & 63; } };

#define g_nostore (*(volatile LAS int*)(unsigned)(MISC_OFF + 512))
__device__ __forceinline__ void tr_item(const float* colptr, int ld, bool perm, bf16* wt, int K, int k0, LAS float* scr, int lane) {
    const int j = lane & 31;
    float tv[32];
#pragma unroll
    for (int i = 0; i < 32; ++i) { const int kk = 2 * i + (lane >> 5); tv[i] = colptr[(size_t)(k0 + kk) * ld]; }
#pragma unroll
    for (int i = 0; i < 32; ++i) { const int kk = 2 * i + (lane >> 5); scr[kk * 33 + j] = tv[i]; }
    LDS_WAIT(); asm volatile("" ::: "memory");
    const int c = lane & 7;
#pragma unroll
    for (int jj = 0; jj < 4; ++jj) { const int n = (lane >> 3) + 8 * jj; const int slot = perm ? pg8::perm32(n) : n; const LAS float* s = scr + (8 * c) * 33 + slot;
        v4u o; o.x = pk2(s[0 * 33], s[1 * 33]); o.y = pk2(s[2 * 33], s[3 * 33]); o.z = pk2(s[4 * 33], s[5 * 33]); o.w = pk2(s[6 * 33], s[7 * 33]);
        if (NOSTORE_PROBE && g_nostore) { asm volatile("" :: "v"(o.x), "v"(o.y), "v"(o.z), "v"(o.w)); } else *(GAS v4u*)(wt + (size_t)n * K + k0 + 8 * c) = o; }
    LDS_WAIT(); asm volatile("" ::: "memory");
}
constexpr float W8_SCALE = 64.0f; constexpr int W8_SC8 = 0x79797979;
template <bool I8 = false, bool MAYNULL = false>
__device__ __forceinline__ void tr_item8(const float* colptr, int ld, bool perm, unsigned char* wt, int K, int k0, LAS float* scr, int lane, float mulA = 0.f, float mulB = 0.f) {
    const int j = lane & 31;
    float tv[32];
#pragma unroll
    for (int i = 0; i < 32; ++i) { const int kk = 2 * i + (lane >> 5); tv[i] = (!MAYNULL || colptr) ? colptr[(size_t)(k0 + kk) * ld] : 0.f; }
#pragma unroll
    for (int i = 0; i < 32; ++i) { const int kk = 2 * i + (lane >> 5); scr[kk * 33 + j] = tv[i]; }
    LDS_WAIT(); asm volatile("" ::: "memory");
    const int c = lane & 3;
#pragma unroll
    for (int jj = 0; jj < 2; ++jj) { const int n = (lane >> 2) + 16 * jj; const int slot = perm ? pg8::perm32(n) : n; const LAS float* s = scr + (16 * c) * 33 + slot;
        float v[16]; v4u o;
        if constexpr (I8) { const float mul = jj ? mulB : mulA;
#pragma unroll
            for (int i = 0; i < 16; ++i) v[i] = __builtin_amdgcn_fmed3f(s[i * 33] * mul, -127.f, 127.f);
            o.x = pk_i8(v[0], v[1], v[2], v[3]); o.y = pk_i8(v[4], v[5], v[6], v[7]); o.z = pk_i8(v[8], v[9], v[10], v[11]); o.w = pk_i8(v[12], v[13], v[14], v[15]);
        } else {
#pragma unroll
        for (int i = 0; i < 16; ++i) v[i] = fminf(fmaxf(s[i * 33] * W8_SCALE, -448.f), 448.f);
        o.x = (unsigned)__builtin_amdgcn_cvt_pk_fp8_f32(v[2], v[3], __builtin_amdgcn_cvt_pk_fp8_f32(v[0], v[1], 0, false), true);
        o.y = (unsigned)__builtin_amdgcn_cvt_pk_fp8_f32(v[6], v[7], __builtin_amdgcn_cvt_pk_fp8_f32(v[4], v[5], 0, false), true);
        o.z = (unsigned)__builtin_amdgcn_cvt_pk_fp8_f32(v[10], v[11], __builtin_amdgcn_cvt_pk_fp8_f32(v[8], v[9], 0, false), true);
        o.w = (unsigned)__builtin_amdgcn_cvt_pk_fp8_f32(v[14], v[15], __builtin_amdgcn_cvt_pk_fp8_f32(v[12], v[13], 0, false), true);
        }
        if (NOSTORE_PROBE && g_nostore) { asm volatile("" :: "v"(o.x), "v"(o.y), "v"(o.z), "v"(o.w)); } else *(GAS v4u*)(wt + (size_t)n * K + k0 + 16 * c) = o; }
    LDS_WAIT(); asm volatile("" ::: "memory");
}
template <bool I8, bool MAYNULL>
__device__ __forceinline__ void tr_pair8(const float* colptr, int ld, bool perm, unsigned char* wt, int K, int k0, LAS float* scr, int lane, float mulA = 0.f, float mulB = 0.f) {
    const int j = lane & 31;
#pragma unroll
    for (int hf = 0; hf < 2; ++hf) {
        float tv[32];
#pragma unroll
        for (int i = 0; i < 32; ++i) { const int kk = 64 * hf + 2 * i + (lane >> 5); tv[i] = (!MAYNULL || colptr) ? colptr[(size_t)(k0 + kk) * ld] : 0.f; }
#pragma unroll
        for (int i = 0; i < 32; ++i) { const int kk = 64 * hf + 2 * i + (lane >> 5); scr[kk * 32 + (j ^ (4 * (kk >> 4)))] = tv[i]; }
    }
    LDS_WAIT(); asm volatile("" ::: "memory");
    const int c = lane & 7;
#pragma unroll
    for (int jj = 0; jj < 4; ++jj) { const int n = (lane >> 3) + 8 * jj; const int slot = perm ? pg8::perm32(n) : n; const LAS float* s = scr + (16 * c) * 32 + (slot ^ (4 * c));
        float v[16]; v4u o;
        if constexpr (I8) { const float mul = jj >= 2 ? mulB : mulA;
#pragma unroll
            for (int i = 0; i < 16; ++i) v[i] = __builtin_amdgcn_fmed3f(s[i * 32] * mul, -127.f, 127.f);
            o.x = pk_i8(v[0], v[1], v[2], v[3]); o.y = pk_i8(v[4], v[5], v[6], v[7]); o.z = pk_i8(v[8], v[9], v[10], v[11]); o.w = pk_i8(v[12], v[13], v[14], v[15]);
        } else {
#pragma unroll
            for (int i = 0; i < 16; ++i) v[i] = fminf(fmaxf(s[i * 32] * W8_SCALE, -448.f), 448.f);
            o.x = (unsigned)__builtin_amdgcn_cvt_pk_fp8_f32(v[2], v[3], __builtin_amdgcn_cvt_pk_fp8_f32(v[0], v[1], 0, false), true);
            o.y = (unsigned)__builtin_amdgcn_cvt_pk_fp8_f32(v[6], v[7], __builtin_amdgcn_cvt_pk_fp8_f32(v[4], v[5], 0, false), true);
            o.z = (unsigned)__builtin_amdgcn_cvt_pk_fp8_f32(v[10], v[11], __builtin_amdgcn_cvt_pk_fp8_f32(v[8], v[9], 0, false), true);
            o.w = (unsigned)__builtin_amdgcn_cvt_pk_fp8_f32(v[14], v[15], __builtin_amdgcn_cvt_pk_fp8_f32(v[12], v[13], 0, false), true);
        }
        *(GAS v4u*)(wt + (size_t)n * K + k0 + 16 * c) = o; }
    LDS_WAIT(); asm volatile("" ::: "memory");
}
__device__ __forceinline__ const float* gu_colptr(const float* gate, const float* up, int nb, int j) {
    const int pn = nb >> 3, r = nb & 7, bj = r >> 2, wc = r & 3, n = j >> 4, i = j & 15, fq = i >> 2, jj = i & 3;
    return (n ? up : gate) + 128 * pn + 32 * wc + 8 * fq + 4 * bj + jj;
}

#if CV_PAIR
constexpr int CV_IN = 200 * 16, CV_OUT = 64 * 32, CV_GU = 352 * 16, CV_DN = 64 * 44, CV_MGU1 = 176 * 16, CV_MDN1 = 64 * 22;
#else
constexpr int CV_IN = 200 * 32, CV_OUT = 64 * 32, CV_GU = 352 * 32, CV_DN = 64 * 88, CV_MGU1 = 176 * 32, CV_MDN1 = 64 * 44;
#endif
constexpr int CV_NEARLY = CV_IN + CV_OUT + CV_GU + CV_DN, CV_NITEMS = 2 * CV_IN + 2 * CV_OUT + CV_GU + CV_DN + NE * CV_MGU1 + NE * CV_MDN1, CV_NDEF = CV_NITEMS - CV_NEARLY;
__device__ __forceinline__ void conv_item(Frame& F, const Params& P, int it) {
    unsigned char* ws = fresh_ws(P.ws);
    const LAS float* wsc = (const LAS float*)(F.lds + MISC_OFF + 256);
    float* csw = (float*)(ws + WS_CS);
    LAS float* scr = (LAS float*)(F.lds + F.wave * 16384);
    const int lane = lane_id(), j = lane & 31;
    int r = it, l = 0;
    if (r >= CV_NEARLY) { r -= CV_NEARLY; l = 1; }
    if (r < CV_IN) { const int nb = r % 200, kb = r / 200, n0 = 32 * nb;
        const float* w = P.in[I_WIN] + (size_t)l * D * IN_COLS; const float* cp; bool perm;
        if (CONV_U && n0 >= 512 && n0 < 1536) { cp = gu_colptr(w + 512, w + 1024, (n0 - 512) >> 5, j); perm = false; }
        else if (n0 < 4096) { cp = w + n0 + j; perm = !(n0 >= 2048 && n0 < 3072); }
        else if (n0 < 5120) { cp = w + COL_K + (n0 - 4096) + j; perm = false; }
        else if (n0 < 6144) { cp = w + COL_V + (n0 - 5120) + j; perm = !V8_DIRECT; }
        else if (n0 == 6144) { cp = j < 16 ? w + COL_DT + j : nullptr; perm = false; }
        else { cp = nullptr; perm = false; }
        const float st = wsc[l], inv = 1.0f / st;
        if (kb == 0 && lane < 32) csw[CS_WIN + l * 6400 + n0 + lane] = st;
        if (CV_PAIR) tr_pair8<true, true>(cp, IN_COLS, perm, ws + WS_WIN + l * SZ_WIN + (size_t)n0 * D, D, 128 * kb, scr, lane, inv, inv);
        else tr_item8<true, true>(cp, IN_COLS, perm, ws + WS_WIN + l * SZ_WIN + (size_t)n0 * D, D, 64 * kb, scr, lane, inv, inv);
        return; }
    r -= CV_IN;
    if (r < CV_OUT) { const int nb = r % 64, kb = r / 64, n0 = 32 * nb;
        tr_item(P.in[I_WOUT] + (size_t)l * D * D + n0 + j, D, PERM_OUT != 0, (bf16*)(ws + WS_WOUT + l * SZ_WOUT) + (size_t)n0 * D, D, 64 * kb, scr, lane); return; }
    r -= CV_OUT;
    if (l == 0) {
        if (r < CV_GU) { const int nb = r % 352, kb = r / 352;
            const float sg = wsc[2], su = wsc[3];
            if (kb == 0 && lane < 32) csw[CS_WGU + 32 * nb + lane] = lane < 16 ? sg : su;
            if (CV_PAIR) tr_pair8<true, false>(gu_colptr(P.in[I_FG], P.in[I_FU], nb, j), FFD, false, ws + WS_WGU + (size_t)(32 * nb) * D, D, 128 * kb, scr, lane, 1.0f / sg, 1.0f / su);
            else tr_item8<true>(gu_colptr(P.in[I_FG], P.in[I_FU], nb, j), FFD, false, ws + WS_WGU + (size_t)(32 * nb) * D, D, 64 * kb, scr, lane, 1.0f / sg, 1.0f / su);
            return; }
        r -= CV_GU;
        { const int nb = r % 64, kb = r / 64, n0 = 32 * nb;
          if (CV_PAIR) tr_pair8<false, false>(P.in[I_FD] + n0 + j, D, PERM_OUT != 0, ws + WS_WDN + (size_t)n0 * FFD, FFD, 128 * kb, scr, lane);
          else tr_item8(P.in[I_FD] + n0 + j, D, PERM_OUT != 0, ws + WS_WDN + (size_t)n0 * FFD, FFD, 64 * kb, scr, lane);
          return; }
    }
    if (r < NE * CV_MGU1) { const int e = r / CV_MGU1; r -= e * CV_MGU1; const int nb = r % 176, kb = r / 176;
        const float sg = wsc[4 + e], su = wsc[12 + e];
        if (kb == 0 && lane < 32) csw[CS_MGU + e * (2 * FFE) + 32 * nb + lane] = lane < 16 ? sg : su;
        if (CV_PAIR) tr_pair8<true, false>(gu_colptr(P.in[I_MG] + (size_t)e * D * FFE, P.in[I_MU] + (size_t)e * D * FFE, nb, j), FFE, false, ws + WS_MGU + e * (SZ_MGU / 2) + (size_t)(32 * nb) * D, D, 128 * kb, scr, lane, 1.0f / sg, 1.0f / su);
        else tr_item8<true>(gu_colptr(P.in[I_MG] + (size_t)e * D * FFE, P.in[I_MU] + (size_t)e * D * FFE, nb, j), FFE, false, ws + WS_MGU + e * (SZ_MGU / 2) + (size_t)(32 * nb) * D, D, 64 * kb, scr, lane, 1.0f / sg, 1.0f / su);
        return; }
    r -= NE * CV_MGU1;
    { const int e = r / CV_MDN1; r -= e * CV_MDN1; const int nb = r % 64, kb = r / 64, n0 = 32 * nb;
      if (CV_PAIR) tr_pair8<false, false>(P.in[I_MD] + (size_t)e * FFE * D + n0 + j, D, true, ws + WS_MDN + e * (SZ_MDN / 2) + (size_t)n0 * FFE, FFE, 128 * kb, scr, lane);
      else tr_item8(P.in[I_MD] + (size_t)e * FFE * D + n0 + j, D, true, ws + WS_MDN + e * (SZ_MDN / 2) + (size_t)n0 * FFE, FFE, 64 * kb, scr, lane); }
}
#define ITEM_NB(r, N, NKB, OLD) (ITEM_NBFAST == 2 ? (((r) >> 3) / (NKB)) * 8 + ((r) & 7) : ITEM_NBFAST == 1 ? (r) % (N) : (OLD))
#define ITEM_KB(r, N, NKB, OLD) (ITEM_NBFAST == 2 ? ((r) >> 3) % (NKB) : ITEM_NBFAST == 1 ? (r) / (N) : (OLD))
__device__ __forceinline__ void p0_prologue(Frame& F, const Params& P) {
    const Lane L(F.wave);
    unsigned char* ws = fresh_ws(P.ws);
    if (F.vcu < 192) {
      for (int rep_ = 0; rep_ <= DUP_MODV; ++rep_) {
        const int l = F.vcu / 96, cb = F.vcu % 96;
        LAS float* sv = (LAS float*)(F.lds);
        LAS float* red = (LAS float*)(F.lds + 32768);
        for (int i = L.tid; i < 3 * D; i += 512) { const int v = i / D, k = i % D; const float c = v < 2 ? P.in[I_C][v * D + k] : P.in[I_CCTX][k]; sv[i] = c / (1.0f + __expf(-c)); }
        __syncthreads();
        const float* W = P.in[I_WMOD] + (size_t)l * D * 12288 + cb * 128 + 2 * L.lane;
        f32x2 a0 = {0.f, 0.f}, a1 = {0.f, 0.f}, a2 = {0.f, 0.f};
        const int kb = F.wave * 256;
#pragma unroll 16
        for (int k = 0; k < 256; ++k) { const f32x2 w = *(const f32x2*)(W + (size_t)(kb + k) * 12288); a0 += w * sv[kb + k]; a1 += w * sv[D + kb + k]; a2 += w * sv[2 * D + kb + k]; }
        *(LAS f32x2*)(red + (F.wave * 3 + 0) * 128 + 2 * L.lane) = a0; *(LAS f32x2*)(red + (F.wave * 3 + 1) * 128 + 2 * L.lane) = a1; *(LAS f32x2*)(red + (F.wave * 3 + 2) * 128 + 2 * L.lane) = a2;
        __syncthreads();
        if (L.tid < 384) { const int v = L.tid >> 7, col = L.tid & 127; float s = P.in[I_BMOD][l * 12288 + cb * 128 + col];
#pragma unroll
            for (int w = 0; w < 8; ++w) s += red[(w * 3 + v) * 128 + col];
            ((float*)(ws + WS_MOD))[(size_t)(l * 3 + v) * 12288 + cb * 128 + col] = s; }
        __syncthreads();
      }
    } else if (F.vcu == 192) {
        float* rc = (float*)(ws + WS_ROPE); float* rs = rc + 192 * 16;
        for (int i = L.tid; i < 192 * 16; i += 512) { const int pos = i >> 4, f = i & 15; const float inv = exp2f(-(float)f * (13.287712379549449f / 16.0f)); const float ang = (float)(pos < 128 ? pos : pos - 128) * inv; rc[i] = cosf(ang); rs[i] = sinf(ang); }
    }
    LAS float* wsc = (LAS float*)(F.lds + MISC_OFF + 256);
    for (int t = F.wave; t < 20; t += NWAVES) {
        const float* tp = t < 2 ? P.in[I_WIN] + (size_t)t * D * IN_COLS : t == 2 ? P.in[I_FG] : t == 3 ? P.in[I_FU] : t < 12 ? P.in[I_MG] + (size_t)(t - 4) * D * FFE : P.in[I_MU] + (size_t)(t - 12) * D * FFE;
        float ss = 0.f;
#pragma unroll
        for (int i = 0; i < 16; ++i) { const f32x4 w = *(const f32x4*)(tp + 4 * (L.lane + 64 * i)); ss += (w[0] * w[0] + w[1] * w[1]) + (w[2] * w[2] + w[3] * w[3]); }
        ss = wave_sum(ss);
        if (L.lane == 0) wsc[t] = sqrtf(ss * (1.0f / 4096.0f)) * (I8_CLIP / 127.0f);
    }
    __syncthreads();
    float* csw = (float*)(ws + WS_CS);
    const int gw = F.vcu * NWAVES + F.wave, NGW = F.G * NWAVES;
    constexpr int NPRE = 63 * NWAVES * (CV_PAIR ? 4 : 7);
    const bool early = F.vcu > 192;
    const int nA = early ? NPRE : 0, sA = early ? (F.vcu - 193) * NWAVES + F.wave : 0, stA = 63 * NWAVES;
    for (int ph = 0; ph < 2; ++ph) {
      const int lo = ph == 0 ? sA : NPRE + gw, hi2 = ph == 0 ? nA : ((DEFER && F.G == 256) ? CV_NEARLY : CV_NITEMS), st = ph == 0 ? stA : NGW;
      for (int it = lo; it < hi2; it += st) conv_item(F, P, it);
    }
}
__device__ __forceinline__ void deferred_slot(Frame& F, const Params& P, int dpos, int k, int nIdle, int ipw) {
    const int w0 = k * NWAVES + F.wave, st = nIdle * NWAVES;
    for (int i = 0; i < ipw; ++i) { const int it = CV_NEARLY + dpos + w0 + i * st; if (it < CV_NITEMS) conv_item(F, P, it); }
}
__device__ __forceinline__ void deferred_rest(Frame& F, const Params& P, int dpos) {
    for (int it = CV_NEARLY + dpos + F.vcu * NWAVES + F.wave; it < CV_NITEMS; it += F.G * NWAVES) conv_item(F, P, it);
}

__device__ __forceinline__ void store_row_i8(unsigned char* hr, float* hs, int r, const f32x4 (&x)[8], int lane) {
    float am = 0.f;
#pragma unroll
    for (int jq = 0; jq < 8; ++jq) am = fmaxf(fmaxf(am, fmaxf(fabsf(x[jq][0]), fabsf(x[jq][1]))), fmaxf(fabsf(x[jq][2]), fabsf(x[jq][3])));
    am = fmaxf(wave_max(am), 1e-30f);
    const float inv = 127.0f / am;
#pragma unroll
    for (int jq = 0; jq < 8; ++jq) *(unsigned*)(hr + 4 * lane + 256 * jq) = pk_i8(x[jq][0] * inv, x[jq][1] * inv, x[jq][2] * inv, x[jq][3] * inv);
    if (lane == 0) hs[r] = am * (1.0f / 127.0f);
}
template <bool ROUTE, int OUT8 = 0, bool SL16 = false, bool SC16 = false>
__device__ __forceinline__ void norm_phase(Frame& F, const void* srcLatV, const void* srcCtxV, const float* gvec, const float* modl, int ishift, int iscale, bf16* h, int nrows,
                                           const float* wrouter, const float* brouter, int* tok_e, int* tok_slot, float* tok_p,
                                           const float* part = nullptr, int nsl = 0, const float* pgate = nullptr, bf16* wb = nullptr, float* hs = nullptr) {
    const Lane L(F.wave);
    LAS float* wrT = (LAS float*)F.lds;
    if (ROUTE) {
        for (int i = L.tid; i < D * NE; i += 512) { const int k = i >> 3, e = i & 7; wrT[e * D + k] = wrouter[i]; }
        __syncthreads();
    }
    const int gw = F.vcu * NWAVES + F.wave, NGW = F.G * NWAVES, lane = L.lane;
    const int nmain = part != nullptr ? NLAT / 8 : nrows / 8;
    for (int run = gw; run < nmain; run += NGW) {
        const int r0 = run * 8; const int v = r0 < SEQ ? 0 : (r0 < NLAT ? 1 : 2);
        const float* sh = modl + (size_t)(v * 6 + ishift) * D; const float* sc = modl + (size_t)(v * 6 + iscale) * D;
        f32x4 A[8], B[8];
#pragma unroll
        for (int jq = 0; jq < 8; ++jq) { const int c = 4 * lane + 256 * jq; const f32x4 g = *(const f32x4*)(gvec + c), s = *(const f32x4*)(sc + c); A[jq] = g * (s + 1.0f); B[jq] = *(const f32x4*)(sh + c); }
        for (int rr = 0; rr < 8; ++rr) {
            const int r = r0 + rr;
            f32x4 x[8]; float ss = 0.f;
            if (r < NLAT) {
#pragma unroll
                for (int jq = 0; jq < 8; ++jq) x[jq] = SL16 ? ld4_bf16((const bf16*)srcLatV + (size_t)r * D + 4 * lane + 256 * jq) : ld4_f32((const float*)srcLatV + (size_t)r * D + 4 * lane + 256 * jq);
            } else {
#pragma unroll
                for (int jq = 0; jq < 8; ++jq) x[jq] = SC16 ? ld4_bf16((const bf16*)srcCtxV + (size_t)(r - NLAT) * D + 4 * lane + 256 * jq) : ld4_f32((const float*)srcCtxV + (size_t)(r - NLAT) * D + 4 * lane + 256 * jq);
            }
#pragma unroll
            for (int jq = 0; jq < 8; ++jq) ss += (x[jq][0] * x[jq][0] + x[jq][1] * x[jq][1]) + (x[jq][2] * x[jq][2] + x[jq][3] * x[jq][3]);
            const float rstd = 1.0f / sqrtf(wave_sum(ss) * (1.0f / D) + NORM_EPS);
#pragma unroll
            for (int jq = 0; jq < 8; ++jq) x[jq] = (x[jq] * rstd) * A[jq] + B[jq];
            if constexpr (OUT8 == 2 && ROUTE && MOE_SPARSE) {   }
            else if constexpr (OUT8 == 2) store_row_i8((unsigned char*)h + (size_t)r * D, hs, r, x, lane);
            else if constexpr (OUT8 == 1) {
                unsigned char* hr8 = (unsigned char*)h + (size_t)r * D;
#pragma unroll
                for (int jq = 0; jq < 8; ++jq) { const f32x4 y = __builtin_elementwise_min(__builtin_elementwise_max(x[jq], (f32x4){-448.f, -448.f, -448.f, -448.f}), (f32x4){448.f, 448.f, 448.f, 448.f});
                    *(unsigned*)(hr8 + 4 * lane + 256 * jq) = (unsigned)__builtin_amdgcn_cvt_pk_fp8_f32(y[2], y[3], __builtin_amdgcn_cvt_pk_fp8_f32(y[0], y[1], 0, false), true); }
            } else {
            bf16* hr = h + (size_t)r * D;
#pragma unroll
            for (int jq = 0; jq < 8; ++jq) { v2u w; w.x = cvtpk(x[jq][0], x[jq][1]); w.y = cvtpk(x[jq][2], x[jq][3]); *(v2u*)(hr + 4 * lane + 256 * jq) = w; }
            }
            if (ROUTE) {
                float lg[NE];
#pragma unroll
                for (int e = 0; e < NE; ++e) { float p = 0.f;
#pragma unroll
                    for (int jq = 0; jq < 8; ++jq) { const f32x4 w = *(const LAS f32x4*)(wrT + e * D + 4 * lane + 256 * jq); p += (x[jq][0] * w[0] + x[jq][1] * w[1]) + (x[jq][2] * w[2] + x[jq][3] * w[3]); }
                    lg[e] = wave_sum(p) + brouter[e]; }
                int i0 = 0; float v0 = lg[0];
#pragma unroll
                for (int e = 1; e < NE; ++e) if (lg[e] > v0) { v0 = lg[e]; i0 = e; }
                int i1 = -1; float v1 = -3.0e38f;
#pragma unroll
                for (int e = 0; e < NE; ++e) if (e != i0 && lg[e] > v1) { v1 = lg[e]; i1 = e; }
                int s0 = 0, s1 = 0;
                if (lane == 0) {
                    const float p0 = 1.0f / (1.0f + __expf(v1 - v0));
                    s0 = (int)__hip_atomic_fetch_add(F.ctl + CW_CNT + 64 * i0, 1u, RLX_AGENT);
                    s1 = (int)__hip_atomic_fetch_add(F.ctl + CW_CNT + 64 * i1, 1u, RLX_AGENT);
                    tok_e[2 * r] = i0; tok_e[2 * r + 1] = i1; tok_slot[2 * r] = s0; tok_slot[2 * r + 1] = s1; tok_p[2 * r] = p0; tok_p[2 * r + 1] = 1.0f - p0;
                }
                if constexpr (OUT8 == 2 && MOE_SPARSE) {
                    s0 = __builtin_amdgcn_readfirstlane(s0); s1 = __builtin_amdgcn_readfirstlane(s1);
                    float am = 0.f;
#pragma unroll
                    for (int jq = 0; jq < 8; ++jq) am = fmaxf(fmaxf(am, fmaxf(fabsf(x[jq][0]), fabsf(x[jq][1]))), fmaxf(fabsf(x[jq][2]), fabsf(x[jq][3])));
                    am = fmaxf(wave_max(am), 1e-30f);
                    const float inv = 127.0f / am;
                    const size_t ra = (size_t)i0 * NLAT + s0, rb = (size_t)i1 * NLAT + s1;
                    unsigned char* d0 = (unsigned char*)h + ra * D; unsigned char* d1 = (unsigned char*)h + rb * D;
#pragma unroll
                    for (int jq = 0; jq < 8; ++jq) { const unsigned w = pk_i8(x[jq][0] * inv, x[jq][1] * inv, x[jq][2] * inv, x[jq][3] * inv);
                        *(unsigned*)(d0 + 4 * lane + 256 * jq) = w; *(unsigned*)(d1 + 4 * lane + 256 * jq) = w; }
                    if (lane == 0) { hs[ra] = am * (1.0f / 127.0f); hs[rb] = am * (1.0f / 127.0f); }
                }
            }
        }
    }
    if (part != nullptr) {
        const float* sh = modl + (size_t)(2 * 6 + ishift) * D; const float* sc = modl + (size_t)(2 * 6 + iscale) * D;
        for (int r = NLAT + gw; r < NLAT + NCTX; r += NGW) {
            f32x4 x[8]; float ss = 0.f;
#pragma unroll
#if PART16 && PERM_OUT
            for (int jq = 0; jq < 8; ++jq) { const int c = 4 * lane + 256 * jq; f32x4 a = ld4_bf16((const bf16*)part + (size_t)(r - NLAT) * D + c);
                for (int s = 1; s < nsl; ++s) a += ld4_bf16((const bf16*)part + ((size_t)s * NCTX + (r - NLAT)) * D + c);
#else
            for (int jq = 0; jq < 8; ++jq) { const int c = 4 * lane + 256 * jq; f32x4 a = *(const f32x4*)(part + (size_t)(r - NLAT) * D + c);
                for (int s = 1; s < nsl; ++s) a += *(const f32x4*)(part + ((size_t)s * NCTX + (r - NLAT)) * D + c);
#endif
                const f32x4 xs = SC16 ? ld4_bf16((const bf16*)srcCtxV + (size_t)(r - NLAT) * D + c) : ld4_f32((const float*)srcCtxV + (size_t)(r - NLAT) * D + c);
                x[jq] = xs + *(const f32x4*)(pgate + c) * a;
                ss += (x[jq][0] * x[jq][0] + x[jq][1] * x[jq][1]) + (x[jq][2] * x[jq][2] + x[jq][3] * x[jq][3]); }
            if (wb) {
#pragma unroll
                for (int jq = 0; jq < 8; ++jq) st4_bf16(wb + (size_t)r * D + 4 * lane + 256 * jq, x[jq]);
            }
            const float rstd = 1.0f / sqrtf(wave_sum(ss) * (1.0f / D) + NORM_EPS);
            bf16* hr = h + (size_t)r * D;
            if constexpr (OUT8 == 2) {
#pragma unroll
                for (int jq = 0; jq < 8; ++jq) { const int c = 4 * lane + 256 * jq; const f32x4 g = *(const f32x4*)(gvec + c), s = *(const f32x4*)(sc + c), b = *(const f32x4*)(sh + c); x[jq] = (x[jq] * rstd) * (g * (s + 1.0f)) + b; }
                store_row_i8((unsigned char*)h + (size_t)r * D, hs, r, x, lane);
            } else
#pragma unroll
            for (int jq = 0; jq < 8; ++jq) { const int c = 4 * lane + 256 * jq; const f32x4 g = *(const f32x4*)(gvec + c), s = *(const f32x4*)(sc + c), b = *(const f32x4*)(sh + c);
                f32x4 y = (x[jq] * rstd) * (g * (s + 1.0f)) + b;
                if constexpr (OUT8 == 1) { y = __builtin_elementwise_min(__builtin_elementwise_max(y, (f32x4){-448.f, -448.f, -448.f, -448.f}), (f32x4){448.f, 448.f, 448.f, 448.f});
                    *(unsigned*)((unsigned char*)h + (size_t)r * D + c) = (unsigned)__builtin_amdgcn_cvt_pk_fp8_f32(y[2], y[3], __builtin_amdgcn_cvt_pk_fp8_f32(y[0], y[1], 0, false), true); }
                else { v2u w; w.x = cvtpk(y[0], y[1]); w.y = cvtpk(y[2], y[3]); *(v2u*)(hr + c) = w; } }
        }
    }
    if (ROUTE) __syncthreads();
}

__device__ __forceinline__ void ld8f(const bf16* p, float (&o)[8]) { const v4u w = *(const v4u*)p; o[0] = bflo(w.x); o[1] = bfhi(w.x); o[2] = bflo(w.y); o[3] = bfhi(w.y); o[4] = bflo(w.z); o[5] = bfhi(w.z); o[6] = bflo(w.w); o[7] = bfhi(w.w); }
__device__ __forceinline__ void st8f(bf16* p, const float (&o)[8]) { v4u w; w.x = cvtpk(o[0], o[1]); w.y = cvtpk(o[2], o[3]); w.z = cvtpk(o[4], o[5]); w.w = cvtpk(o[6], o[7]); *(v4u*)p = w; }
__device__ __forceinline__ void conv_phase(Frame& F, const bf16* convb, const bf16* xbcb, bf16* cat, bf16* xbcc, const float* cw  , const float* sw  , const float* sb  ) {
    const Lane L(F.wave);
    const int gt = F.vcu * 512 + L.tid, NT = F.G * 512;
    constexpr int NRUN = T / 16, NITEM = NRUN * 192;
    for (int it = gt; it < NITEM; it += NT) {
        const int cc = it % 192, run = it / 192, r0 = run * 16;
        const int tl = r0 < NLAT ? (r0 % SEQ) : ((r0 - NLAT) % CTXL); const int sl = r0 < NLAT ? SEQ : CTXL;
        const bool first = tl == 0, last = tl + 16 == sl;
        if (cc < 64) {
            const int c0 = 8 * cc; float w0[8], w1[8], w2[8];
#pragma unroll
            for (int j = 0; j < 8; ++j) { w0[j] = cw[c0 + j]; w1[j] = cw[512 + c0 + j]; w2[j] = cw[1024 + c0 + j]; }
            float up[8], uc[8], un[8], a[8], b[8];
            if (first) {
#pragma unroll
                for (int j = 0; j < 8; ++j) up[j] = 0.f;
            } else if (CONV_U) { ld8f(convb + (size_t)(r0 - 1) * 1536 + 512 + c0, up); }
            else { ld8f(convb + (size_t)(r0 - 1) * 1536 + 512 + c0, a); ld8f(convb + (size_t)(r0 - 1) * 1536 + 1024 + c0, b);
#pragma unroll
                for (int j = 0; j < 8; ++j) up[j] = a[j] * b[j]; }
            if (CONV_U) ld8f(convb + (size_t)r0 * 1536 + 512 + c0, uc);
            else { ld8f(convb + (size_t)r0 * 1536 + 512 + c0, a); ld8f(convb + (size_t)r0 * 1536 + 1024 + c0, b);
#pragma unroll
            for (int j = 0; j < 8; ++j) uc[j] = a[j] * b[j]; }
            for (int t = 0; t < 16; ++t) {
                const int r = r0 + t;
                if (t == 15 && last) {
#pragma unroll
                    for (int j = 0; j < 8; ++j) un[j] = 0.f;
                } else if (CONV_U) { ld8f(convb + (size_t)(r + 1) * 1536 + 512 + c0, un); }
                else { ld8f(convb + (size_t)(r + 1) * 1536 + 512 + c0, a); ld8f(convb + (size_t)(r + 1) * 1536 + 1024 + c0, b);
#pragma unroll
                    for (int j = 0; j < 8; ++j) un[j] = a[j] * b[j]; }
                float g[8], o[8]; ld8f(convb + (size_t)r * 1536 + c0, g);
#pragma unroll
                for (int j = 0; j < 8; ++j) { o[j] = g[j] * ((up[j] * w0[j] + uc[j] * w1[j]) + un[j] * w2[j]); up[j] = uc[j]; uc[j] = un[j]; }
                st8f(cat + (size_t)r * D + c0, o);
            }
        } else {
            const int c0 = 8 * (cc - 64); float w0[8], w1[8], w2[8], bb[8];
#pragma unroll
            for (int j = 0; j < 8; ++j) { w0[j] = sw[c0 + j]; w1[j] = sw[1024 + c0 + j]; w2[j] = sw[2048 + c0 + j]; bb[j] = sb[c0 + j]; }
            float up[8], uc[8], un[8];
            if (first) {
#pragma unroll
                for (int j = 0; j < 8; ++j) up[j] = 0.f;
            } else ld8f(xbcb + (size_t)(r0 - 1) * 1024 + c0, up);
            ld8f(xbcb + (size_t)r0 * 1024 + c0, uc);
            for (int t = 0; t < 16; ++t) {
                const int r = r0 + t;
                if (t == 15 && last) {
#pragma unroll
                    for (int j = 0; j < 8; ++j) un[j] = 0.f;
                } else ld8f(xbcb + (size_t)(r + 1) * 1024 + c0, un);
                float o[8];
#pragma unroll
                for (int j = 0; j < 8; ++j) { const float y = ((up[j] * w0[j] + uc[j] * w1[j]) + un[j] * w2[j]) + bb[j]; o[j] = silu_f(y); up[j] = uc[j]; uc[j] = un[j]; }
                st8f(xbcc + (size_t)r * 1024 + c0, o);
            }
        }
    }
}
__device__ __forceinline__ int chain_pos(int dir, int cn) { return dir == 0 ? cn : (cn < 2 ? 1 - cn : 67 - cn); }
__device__ __forceinline__ int crow(int r, int hi) { return (r & 3) + 8 * (r >> 2) + 4 * hi; }
__device__ __forceinline__ float softplus_f(float x) { return fmaxf(x, 0.f) + __logf(1.0f + __expf(-fabsf(x))); }
constexpr int TS = 136;

template <int SVAR = 0>
__device__ __forceinline__ void ssd_local_phase(Frame& F, const Params& P, int layer) {
    unsigned char* ws = fresh_ws(P.ws);
    const bf16* xbcc = (const bf16*)(ws + WS_XBCC); const float* dtb = (const float*)(ws + WS_DT);
    float* yd = (float*)(ws + WS_YD); float* cumb = (float*)(ws + WS_CUM); float* Sb = (float*)(ws + WS_SB); float* tot = (float*)(ws + WS_TOT);
    LAS bf16* Cs = (LAS bf16*)(F.lds); LAS bf16* Bs = (LAS bf16*)(F.lds + 34816); LAS bf16* XT = (LAS bf16*)(F.lds + 69632);
    LAS bf16* Gs = (LAS bf16*)(F.lds + 87040) + F.wave * 1280;
    LAS float* fa = (LAS float*)(F.lds + 107520);
    LAS float* daA = fa, *cumA = fa + 256, *dtA = fa + 512, *scA = fa + 768;
    const int wave = F.wave;
#if S1_PF
    v4u pfc[4], pfb[4], pfx[2]; float pfraw = 0.f;
#define S1_GLOAD(uid_) do { const int t_ = fresh_tid(F.wave); const int h_ = (uid_) & 7, b_ = ((uid_) >> 3) & 1, cn_ = (uid_) >> 4, g_ = h_ >> 2; \
        const int row0_ = cn_ < 2 ? NLAT + b_ * CTXL + 128 * cn_ : b_ * SEQ + 128 * (cn_ - 2); \
        _Pragma("unroll") for (int i = 0; i < 4; ++i) { const int q = t_ + 512 * i, s_ = q >> 4, c8 = (q & 15) * 8; \
            pfc[i] = *(const v4u*)(xbcc + (size_t)(row0_ + s_) * 1024 + 768 + g_ * 128 + c8); pfb[i] = *(const v4u*)(xbcc + (size_t)(row0_ + s_) * 1024 + 512 + g_ * 128 + c8); } \
        _Pragma("unroll") for (int i = 0; i < 2; ++i) { const int q = t_ + 512 * i, s_ = q & 127, p8 = (q >> 7) * 8; pfx[i] = *(const v4u*)(xbcc + (size_t)(row0_ + s_) * 1024 + h_ * 64 + p8); } \
        if (t_ < 256) { const int dir = t_ >> 7, s_ = t_ & 127; pfraw = dtb[(size_t)(row0_ + s_) * 16 + dir * 8 + h_] + P.in[I_DTB][layer * 16 + dir * 8 + h_]; } } while (0)
    if (F.vcu < NCH * NB * 8) S1_GLOAD(F.vcu);
#endif
    for (int uid = F.vcu; uid < NCH * NB * 8; uid += F.G) {
        const int tid = fresh_tid(F.wave), lane = tid & 63, r32 = lane & 31, hi = lane >> 5;
        const int h = uid & 7, b = (uid >> 3) & 1, cn = uid >> 4, g = h >> 2;
        const int row0 = cn < 2 ? NLAT + b * CTXL + 128 * cn : b * SEQ + 128 * (cn - 2);
#if S1_PF
#pragma unroll
        for (int i = 0; i < 4; ++i) { const int q = tid + 512 * i, s = q >> 4, c8 = (q & 15) * 8; *(LAS v4u*)(Cs + s * TS + c8) = pfc[i]; *(LAS v4u*)(Bs + s * TS + c8) = pfb[i]; }
#pragma unroll
        for (int i = 0; i < 2; ++i) { const int q = tid + 512 * i, s = q & 127, p8 = (q >> 7) * 8; const v4u w = pfx[i];
            XT[(p8 + 0) * TS + s] = (bf16)(w.x & 0xffff); XT[(p8 + 1) * TS + s] = (bf16)(w.x >> 16); XT[(p8 + 2) * TS + s] = (bf16)(w.y & 0xffff); XT[(p8 + 3) * TS + s] = (bf16)(w.y >> 16);
            XT[(p8 + 4) * TS + s] = (bf16)(w.z & 0xffff); XT[(p8 + 5) * TS + s] = (bf16)(w.z >> 16); XT[(p8 + 6) * TS + s] = (bf16)(w.w & 0xffff); XT[(p8 + 7) * TS + s] = (bf16)(w.w >> 16); }
        if (tid < 256) { const int dir = tid >> 7;
            const float dt = softplus_f(pfraw); const float A = -__expf(P.in[I_ALOG][layer * 16 + dir * 8 + h]);
            dtA[tid] = dt; daA[tid] = dt * A; }
        if (uid + F.G < NCH * NB * 8) S1_GLOAD(uid + F.G);
#else
#pragma unroll
        for (int i = 0; i < 4; ++i) { const int q = tid + 512 * i, s = q >> 4, c8 = (q & 15) * 8;
            *(LAS v4u*)(Cs + s * TS + c8) = *(const v4u*)(xbcc + (size_t)(row0 + s) * 1024 + 768 + g * 128 + c8);
            *(LAS v4u*)(Bs + s * TS + c8) = *(const v4u*)(xbcc + (size_t)(row0 + s) * 1024 + 512 + g * 128 + c8); }
#pragma unroll
        for (int i = 0; i < 2; ++i) { const int q = tid + 512 * i, s = q & 127, p8 = (q >> 7) * 8;
            const v4u w = *(const v4u*)(xbcc + (size_t)(row0 + s) * 1024 + h * 64 + p8);
            XT[(p8 + 0) * TS + s] = (bf16)(w.x & 0xffff); XT[(p8 + 1) * TS + s] = (bf16)(w.x >> 16); XT[(p8 + 2) * TS + s] = (bf16)(w.y & 0xffff); XT[(p8 + 3) * TS + s] = (bf16)(w.y >> 16);
            XT[(p8 + 4) * TS + s] = (bf16)(w.z & 0xffff); XT[(p8 + 5) * TS + s] = (bf16)(w.z >> 16); XT[(p8 + 6) * TS + s] = (bf16)(w.w & 0xffff); XT[(p8 + 7) * TS + s] = (bf16)(w.w >> 16); }
        if (tid < 256) { const int dir = tid >> 7, s = tid & 127;
            const float raw = dtb[(size_t)(row0 + s) * 16 + dir * 8 + h] + P.in[I_DTB][layer * 16 + dir * 8 + h];
            const float dt = softplus_f(raw); const float A = -__expf(P.in[I_ALOG][layer * 16 + dir * 8 + h]);
            dtA[tid] = dt; daA[tid] = dt * A; }
#endif
        __syncthreads();
        float cloc = 0.f;
        if (tid < 256) { const int dir = tid >> 7, s = tid & 127, b8 = s & ~7;
#pragma unroll
            for (int k = 0; k < 8; ++k) { const float a = daA[dir * 128 + b8 + k]; if (dir == 0 ? (b8 + k <= s) : (b8 + k >= s)) cloc += a; }
            if (dir == 0 ? ((s & 7) == 7) : ((s & 7) == 0)) scA[dir * 16 + (s >> 3)] = cloc; }
        __syncthreads();
        float cum = cloc, total = 0.f;
        if (tid < 256) { const int dir = tid >> 7, s = tid & 127, bi = s >> 3;
#pragma unroll
            for (int k = 0; k < 16; ++k) { const float a = scA[dir * 16 + k]; total += a; if (dir == 0 ? (k < bi) : (k > bi)) cum += a; } }
        __syncthreads();
        if (tid < 256) { const int dir = tid >> 7, s = tid & 127;
            cumA[tid] = cum; scA[tid] = __expf(total - cum) * dtA[tid];
            cumb[(size_t)(row0 + s) * 16 + dir * 8 + h] = cum;
            if (s == 0) tot[((dir * 2 + b) * 8 + h) * NCH + chain_pos(dir, cn)] = total; }
        __syncthreads();
        if (SVAR < 1 || SVAR == 4) {
            const int rb = wave >> 1, cb = wave & 1;
            f32x16 Y = {};
            float cl0[16], cl1[16];
#pragma unroll
            for (int r = 0; r < 16; ++r) { cl0[r] = cumA[32 * rb + crow(r, hi)]; cl1[r] = cumA[128 + 32 * rb + crow(r, hi)]; }
            for (int sb = 0; sb < 4; ++sb) {
                f32x16 CB = {};
#pragma unroll
                for (int ks = 0; ks < 8; ++ks) {
                    const bf16x8 a = *(const LAS bf16x8*)(Cs + (32 * rb + r32) * TS + 16 * ks + 8 * hi);
                    const bf16x8 bb = *(const LAS bf16x8*)(Bs + (32 * sb + r32) * TS + 16 * ks + 8 * hi);
                    CB = __builtin_amdgcn_mfma_f32_32x32x16_bf16(a, bb, CB, 0, 0, 0);
                }
                const int s = 32 * sb + r32; const float cs0 = cumA[s], cs1 = cumA[128 + s], d0 = dtA[s], d1 = dtA[128 + s];
#pragma unroll
                for (int r = 0; r < 16; ++r) { const int l = 32 * rb + crow(r, hi);
                    const float f0 = (s <= l) ? __expf(cl0[r] - cs0) * d0 : 0.f, f1 = (s >= l) ? __expf(cl1[r] - cs1) * d1 : 0.f;
                    Gs[crow(r, hi) * 40 + r32] = (bf16)f2bf(CB[r] * (f0 + f1)); }
                LDS_WAIT(); asm volatile("" ::: "memory");
#pragma unroll
                for (int k2 = 0; k2 < 2; ++k2) {
                    const bf16x8 ag = *(const LAS bf16x8*)(Gs + r32 * 40 + 16 * k2 + 8 * hi);
                    const bf16x8 bx = *(const LAS bf16x8*)(XT + (32 * cb + r32) * TS + 32 * sb + 16 * k2 + 8 * hi);
                    Y = __builtin_amdgcn_mfma_f32_32x32x16_bf16(ag, bx, Y, 0, 0, 0);
                }
                LDS_WAIT(); asm volatile("" ::: "memory");
            }
#if YD16
            {
                unsigned* yd16 = (unsigned*)yd; const int odd = r32 & 1;
#pragma unroll
                for (int r = 0; r < 16; r += 2) {
                    const float a = fminf(fmaxf(Y[r], -65504.f), 65504.f), bq = fminf(fmaxf(Y[r + 1], -65504.f), 65504.f);
                    const float pa = dpp_f(a, 0), pb = dpp_f(bq, 0);
                    const _Float16 lo = (_Float16)(odd ? pb : a), hh = (_Float16)(odd ? bq : pa);
                    const unsigned w = (unsigned)__builtin_bit_cast(unsigned short, lo) | ((unsigned)__builtin_bit_cast(unsigned short, hh) << 16);
                    yd16[((size_t)(row0 + 32 * rb + crow(r + odd, hi)) * 512 + h * 64 + 32 * cb + r32 - odd) >> 1] = w; }
            }
#else
#pragma unroll
            for (int r = 0; r < 16; ++r) yd[(size_t)(row0 + 32 * rb + crow(r, hi)) * 512 + h * 64 + 32 * cb + r32] = Y[r];
#endif
        }
        __syncthreads();
        LAS bf16* BT = Cs;
        if (SVAR < 2 || SVAR == 3) {
#pragma unroll
        for (int i = 0; i < 4; ++i) { const int q = tid + 512 * i, s = q & 127, n8 = (q >> 7) * 8; const v4u w = *(const LAS v4u*)(Bs + s * TS + n8);
            BT[(n8 + 0) * TS + s] = (bf16)(w.x & 0xffff); BT[(n8 + 1) * TS + s] = (bf16)(w.x >> 16); BT[(n8 + 2) * TS + s] = (bf16)(w.y & 0xffff); BT[(n8 + 3) * TS + s] = (bf16)(w.y >> 16);
            BT[(n8 + 4) * TS + s] = (bf16)(w.z & 0xffff); BT[(n8 + 5) * TS + s] = (bf16)(w.z >> 16); BT[(n8 + 6) * TS + s] = (bf16)(w.w & 0xffff); BT[(n8 + 7) * TS + s] = (bf16)(w.w >> 16); }
        __syncthreads();
        {
            const int dir = wave & 1, nb = wave >> 1;
            f32x16 S0 = {}, S1 = {};
#pragma unroll
            for (int ks = 0; ks < 8; ++ks) {
                const int s0 = 16 * ks + 8 * hi;
                const f32x4 sc0 = *(const LAS f32x4*)(scA + dir * 128 + s0), sc1 = *(const LAS f32x4*)(scA + dir * 128 + s0 + 4);
                const bf16x8 bb = *(const LAS bf16x8*)(BT + (32 * nb + r32) * TS + s0);
#pragma unroll
                for (int pb = 0; pb < 2; ++pb) {
                    const v4u xr = *(const LAS v4u*)(XT + (32 * pb + r32) * TS + s0);
                    v4u xs; xs.x = cvtpk(bflo(xr.x) * sc0[0], bfhi(xr.x) * sc0[1]); xs.y = cvtpk(bflo(xr.y) * sc0[2], bfhi(xr.y) * sc0[3]);
                    xs.z = cvtpk(bflo(xr.z) * sc1[0], bfhi(xr.z) * sc1[1]); xs.w = cvtpk(bflo(xr.w) * sc1[2], bfhi(xr.w) * sc1[3]);
                    const bf16x8 a = __builtin_bit_cast(bf16x8, xs);
                    if (pb == 0) S0 = __builtin_amdgcn_mfma_f32_32x32x16_bf16(a, bb, S0, 0, 0, 0); else S1 = __builtin_amdgcn_mfma_f32_32x32x16_bf16(a, bb, S1, 0, 0, 0);
                }
            }
#if S1_LDSST
            __syncthreads();
            LAS float* St = (LAS float*)F.lds;
#pragma unroll
            for (int r = 0; r < 16; ++r) { St[(dir * 64 + crow(r, hi)) * 128 + 32 * nb + r32] = S0[r]; St[(dir * 64 + 32 + crow(r, hi)) * 128 + 32 * nb + r32] = S1[r]; }
            __syncthreads();
            { const int tid3 = fresh_tid(F.wave);
#pragma unroll
              for (int i = 0; i < 8; ++i) { const int q = tid3 + 512 * i, d2 = q >> 11, e4 = (q & 2047) * 4;
                  float* sp2 = Sb + ((size_t)(((d2 * 2 + b) * 8 + h) * NCH + chain_pos(d2, cn))) * 8192;
                  *(f32x4*)(sp2 + e4) = *(const LAS f32x4*)(St + d2 * 8192 + e4); } }
#elif SB16
            { unsigned* sp16 = (unsigned*)Sb + ((size_t)(((dir * 2 + b) * 8 + h) * NCH + chain_pos(dir, cn))) * 4096;
              const int odd = r32 & 1;
#pragma unroll
              for (int r = 0; r < 16; ++r) {
                  const float p0 = dpp_f(S0[r], 0), p1 = dpp_f(S1[r], 0);
                  const unsigned w = odd ? cvtpk(p1, S1[r]) : cvtpk(S0[r], p0);
                  sp16[(size_t)((odd ? 32 : 0) + crow(r, hi)) * 64 + 16 * nb + (r32 >> 1)] = w; } }
#else
            float* sp = Sb + ((size_t)(((dir * 2 + b) * 8 + h) * NCH + chain_pos(dir, cn))) * 8192;
#pragma unroll
            for (int r = 0; r < 16; ++r) { if (SVAR == 3) { asm volatile("" :: "v"(S0[r]), "v"(S1[r])); } else if (S1_NT) { __builtin_nontemporal_store(S0[r], sp + (size_t)crow(r, hi) * 128 + 32 * nb + r32); __builtin_nontemporal_store(S1[r], sp + (size_t)(32 + crow(r, hi)) * 128 + 32 * nb + r32); } else { sp[(size_t)crow(r, hi) * 128 + 32 * nb + r32] = S0[r]; sp[(size_t)(32 + crow(r, hi)) * 128 + 32 * nb + r32] = S1[r]; } }
#endif
        }
        }
        __syncthreads();
    }
}

__device__ __forceinline__ void ssd_scan_phase(Frame& F, const Params& P) {
    unsigned char* ws = fresh_ws(P.ws);
    bf16* Hp = (bf16*)(ws + WS_HP); const float* tot = (const float*)(ws + WS_TOT);
    const Lane L(F.wave);
#if SB16
    const unsigned* Sb = (const unsigned*)(ws + WS_SB);
    for (int e = F.vcu * 512 + L.tid; e < 32 * 4096; e += F.G * 512) {
        const int chain = e >> 12, idx = e & 4095;
        const unsigned* sp = Sb + (size_t)chain * NCH * 4096 + idx; unsigned* hp = (unsigned*)Hp + (size_t)chain * NCH * 4096 + idx; const float* tp = tot + chain * NCH;
        float H0 = 0.f, H1 = 0.f;
        for (int i0 = 0; i0 < NCH; i0 += S2_DEPTH) {
            unsigned sv[S2_DEPTH]; float dv[S2_DEPTH];
#pragma unroll
            for (int q = 0; q < S2_DEPTH; ++q) { sv[q] = sp[(size_t)(i0 + q) * 4096]; dv[q] = __expf(tp[i0 + q]); }
#pragma unroll
            for (int q = 0; q < S2_DEPTH; ++q) { hp[(size_t)(i0 + q) * 4096] = cvtpk(H0, H1); H0 = dv[q] * H0 + bflo(sv[q]); H1 = dv[q] * H1 + bfhi(sv[q]); }
        }
    }
#else
    const float* Sb = (const float*)(ws + WS_SB);
    for (int e = F.vcu * 512 + L.tid; e < 32 * 8192; e += F.G * 512) {
        const int chain = e >> 13, idx = e & 8191;
        const float* sp = Sb + (size_t)chain * NCH * 8192 + idx; bf16* hp = Hp + (size_t)chain * NCH * 8192 + idx; const float* tp = tot + chain * NCH;
        float H = 0.f;
        for (int i0 = 0; i0 < NCH; i0 += 6) {
            float sv[6], dv[6];
#pragma unroll
            for (int q = 0; q < 6; ++q) { sv[q] = sp[(size_t)(i0 + q) * 8192]; dv[q] = __expf(tp[i0 + q]); }
#pragma unroll
            for (int q = 0; q < 6; ++q) { hp[(size_t)(i0 + q) * 8192] = (bf16)f2bf(H); H = dv[q] * H + sv[q]; }
        }
    }
#endif
}

__device__ __forceinline__ void ssd_out_phase(Frame& F, const Params& P, int layer) {
    unsigned char* ws = fresh_ws(P.ws);
    const bf16* xbcc = (const bf16*)(ws + WS_XBCC); const bf16* zb = (const bf16*)(ws + WS_Z); const float* yd = (const float*)(ws + WS_YD); const float* cumb = (const float*)(ws + WS_CUM);
    const bf16* Hp = (const bf16*)(ws + WS_HP); bf16* cat = (bf16*)(ws + WS_CAT);
    constexpr int YS = 260;
    LAS bf16* Cs = (LAS bf16*)(F.lds); LAS float* ec = (LAS float*)(F.lds + 34816); LAS float* Yl = (LAS float*)(F.lds + 34816 + 4096);
    const int wave = F.wave;
    for (int uid = (layer == 1 ? 8 : 0) + F.vcu; uid < NCH * NB * 2; uid += F.G) {
        const int tid = fresh_tid(F.wave), lane = tid & 63, r32 = lane & 31, hi = lane >> 5;
        const int g = uid & 1, b = (uid >> 1) & 1, cn = uid >> 2;
        const int row0 = cn < 2 ? NLAT + b * CTXL + 128 * cn : b * SEQ + 128 * (cn - 2);
#pragma unroll
        for (int i = 0; i < 4; ++i) { const int q = tid + 512 * i, s = q >> 4, c8 = (q & 15) * 8;
            *(LAS v4u*)(Cs + s * TS + c8) = *(const v4u*)(xbcc + (size_t)(row0 + s) * 1024 + 768 + g * 128 + c8); }
#pragma unroll
        for (int i = 0; i < 2; ++i) { const int idx = tid + 512 * i, hd = idx >> 7, s = idx & 127; ec[idx] = __expf(cumb[(size_t)(row0 + s) * 16 + (hd & 1) * 8 + 4 * g + (hd >> 1)]); }
        __syncthreads();
        const int hh = wave >> 1, cb = wave & 1, h = 4 * g + hh;
        f32x16 ys[4] = {};
        {
            bf16x8 Hf[2][8];
#pragma unroll
            for (int dir = 0; dir < 2; ++dir) {
                const bf16* hp = Hp + ((size_t)(((dir * 2 + b) * 8 + h) * NCH + chain_pos(dir, cn))) * 8192 + (size_t)(32 * cb + r32) * 128 + 8 * hi;
#pragma unroll
                for (int ks = 0; ks < 8; ++ks) Hf[dir][ks] = *(const bf16x8*)(hp + 16 * ks);
            }
#pragma unroll
            for (int rb = 0; rb < 4; ++rb) {
                bf16x8 af[8];
#pragma unroll
                for (int ks = 0; ks < 8; ++ks) af[ks] = *(const LAS bf16x8*)(Cs + (32 * rb + r32) * TS + 16 * ks + 8 * hi);
#pragma unroll
                for (int dir = 0; dir < 2; ++dir) {
                    f32x16 a0 = {};
#pragma unroll
                    for (int ks = 0; ks < 8; ++ks) a0 = __builtin_amdgcn_mfma_f32_32x32x16_bf16(af[ks], Hf[dir][ks], a0, 0, 0, 0);
#pragma unroll
                    for (int r = 0; r < 16; ++r) ys[rb][r] += a0[r] * ec[(hh * 2 + dir) * 128 + 32 * rb + crow(r, hi)];
                }
                asm volatile("" ::: "memory");
            }
        }
        const int lane2 = fresh_tid(F.wave) & 63;
        const float dsk = P.in[I_SSDD][layer * 8 + 4 * g + (lane2 >> 4)];
        const f32x4 ng = *(const f32x4*)(P.in[I_SNORM] + layer * 512 + g * 256 + 4 * lane2);
#pragma unroll
        for (int half = 0; half < 2; ++half) {
#pragma unroll
            for (int rb2 = 0; rb2 < 2; ++rb2)
#pragma unroll
                for (int r = 0; r < 16; ++r) Yl[(32 * rb2 + crow(r, hi)) * YS + hh * 64 + 32 * cb + r32] = ys[2 * half + rb2][r];
            __syncthreads();
#pragma unroll 2
            for (int q = 0; q < 8; ++q) {
                const int rl = 8 * wave + q, row = row0 + 64 * half + rl;
                const f32x4 yo = *(const LAS f32x4*)(Yl + rl * YS + 4 * lane2);
#if YD16
                f32x4 ydv; { const v2u yw = *(const v2u*)((const unsigned short*)yd + (size_t)row * 512 + g * 256 + 4 * lane2);
                  ydv[0] = (float)__builtin_bit_cast(_Float16, (unsigned short)(yw.x & 0xffff)); ydv[1] = (float)__builtin_bit_cast(_Float16, (unsigned short)(yw.x >> 16));
                  ydv[2] = (float)__builtin_bit_cast(_Float16, (unsigned short)(yw.y & 0xffff)); ydv[3] = (float)__builtin_bit_cast(_Float16, (unsigned short)(yw.y >> 16)); }
#else
                const f32x4 ydv = *(const f32x4*)(yd + (size_t)row * 512 + g * 256 + 4 * lane2);
#endif
                const v2u xv = *(const v2u*)(xbcc + (size_t)row * 1024 + g * 256 + 4 * lane2), zv = *(const v2u*)(zb + (size_t)row * 512 + g * 256 + 4 * lane2);
                f32x4 u;
                u[0] = (yo[0] + ydv[0] + dsk * bflo(xv.x)) * silu_f(bflo(zv.x)); u[1] = (yo[1] + ydv[1] + dsk * bfhi(xv.x)) * silu_f(bfhi(zv.x));
                u[2] = (yo[2] + ydv[2] + dsk * bflo(xv.y)) * silu_f(bflo(zv.y)); u[3] = (yo[3] + ydv[3] + dsk * bfhi(xv.y)) * silu_f(bfhi(zv.y));
                const float ss = wave_sum((u[0] * u[0] + u[1] * u[1]) + (u[2] * u[2] + u[3] * u[3]));
                const float rstd = 1.0f / sqrtf(ss * (1.0f / 256.0f) + NORM_EPS);
                v2u o; o.x = cvtpk(u[0] * rstd * ng[0], u[1] * rstd * ng[1]); o.y = cvtpk(u[2] * rstd * ng[2], u[3] * rstd * ng[3]);
                *(v2u*)(cat + (size_t)row * D + 512 + g * 256 + 4 * lane2) = o;
            }
            __syncthreads();
        }
    }
}
namespace att {
constexpr int KVBLK = 64, LDQ = 1024, LDK = 1024;
constexpr float SCALE = 0.125f;
constexpr float THR = 8.f;
constexpr size_t SHM_V = KVBLK * 128 * 2, SHM_K = KVBLK * 128 * 2;
#define KSWZ(row, colB) ((row) * 256 + ((colB) ^ (((row) & 7) << 4)))
#define SBAR() __builtin_amdgcn_sched_barrier(0)
constexpr float THRL = 11.5f;
#if ATT_FP8
constexpr float WLO = 0.5f, WHI = 7.5f, WMID = 4.0f;
#else
constexpr float WLO = -THRL, WHI = THRL, WMID = 0.f;
#endif
typedef int v8i __attribute__((ext_vector_type(8)));
__device__ __forceinline__ float max3f(float a, float b, float c) { return __builtin_fmaxf(__builtin_fmaxf(a, b), c); }
#if ATT_NEGM
typedef f32x16 mref_t;
#define MREF_INIT f32x16{}
__device__ __forceinline__ f32x16 mref_acc(const mref_t& m) { return m; }
#else
typedef float mref_t;
#define MREF_INIT 0.f
__device__ __forceinline__ f32x16 mref_acc(const mref_t&) { return f32x16{}; }
#endif
template <bool DOEXP = true>
__device__ __forceinline__ void partialSM(f32x16& p0, f32x16& p1, mref_t& mref, float& alpha) {
  float pmax = max3f(p0[0], p0[1], p0[2]);
#pragma unroll
  for (int r = 3; r < 15; r += 2) pmax = max3f(pmax, p0[r], p0[r + 1]);
  pmax = max3f(pmax, p0[15], p1[0]);
#pragma unroll
  for (int r = 1; r < 15; r += 2) pmax = max3f(pmax, p1[r], p1[r + 1]);
  pmax = fmaxf(pmax, p1[15]);
  pmax = cross_max(pmax);
#if ATT_NEGM
  if (__builtin_expect(__all(pmax >= WLO && pmax <= WHI), 1)) { alpha = 1.f; }
  else {
    const float d = (pmax < WLO || pmax > WHI) ? pmax - WMID : 0.f;
    alpha = __builtin_amdgcn_exp2f(-d);
#pragma unroll
    for (int r = 0; r < 16; ++r) { p0[r] -= d; p1[r] -= d; mref[r] -= d; }
  }
#else
  if (__builtin_expect(__all(fabsf(pmax - mref) <= THRL), 1)) { alpha = 1.f; }
  else { const float d = fabsf(pmax - mref) > THRL ? pmax - mref : 0.f; alpha = __builtin_amdgcn_exp2f(-d); mref += d; }
#pragma unroll
  for (int r = 0; r < 16; ++r) { p0[r] -= mref; p1[r] -= mref; }
#endif
  if constexpr (DOEXP) {
#pragma unroll
  for (int r = 0; r < 16; ++r) p0[r] = __builtin_amdgcn_exp2f(p0[r]);
  }
}
__device__ __forceinline__ void finishSM(f32x16& p0, f32x16& p1, float alpha, float& l_reg, bf16x8& pa0, bf16x8& pa1, bf16x8& pa2, bf16x8& pa3) {
#pragma unroll
  for (int r = 0; r < 16; ++r) p1[r] = __builtin_amdgcn_exp2f(p1[r]);
#if !ATT_LMFMA
  float ps = 0;
#pragma unroll
  for (int r = 0; r < 16; ++r) ps += p0[r];
#pragma unroll
  for (int r = 0; r < 16; ++r) ps += p1[r];
  ps = cross_sum(ps);
  l_reg = l_reg * alpha + ps;
#else
  (void)alpha; (void)l_reg;
#endif
#define PK4(P, BASE, OUT) do { unsigned a0 = cvtpk(P[BASE + 0], P[BASE + 1]), a1 = cvtpk(P[BASE + 2], P[BASE + 3]);   \
    unsigned b0 = cvtpk(P[BASE + 4], P[BASE + 5]), b1 = cvtpk(P[BASE + 6], P[BASE + 7]);                              \
    if (!ATT_NOSWAP) { swap32u(a0, b0); swap32u(a1, b1); } \
    v4u w = {a0, a1, b0, b1}; OUT = __builtin_bit_cast(bf16x8, w); } while (0)
  PK4(p0, 0, pa0); PK4(p0, 8, pa1); PK4(p1, 0, pa2); PK4(p1, 8, pa3);
#undef PK4
}

#if ATT_FP8
__device__ __forceinline__ void finishSM8(f32x16& p0, f32x16& p1, float alpha, float& l_reg, v8i& P8) {
#pragma unroll
  for (int r = 0; r < 16; ++r) p1[r] = __builtin_amdgcn_exp2f(p1[r]);
  float ps = 0;
#pragma unroll
  for (int r = 0; r < 16; ++r) ps += p0[r];
#pragma unroll
  for (int r = 0; r < 16; ++r) ps += p1[r];
  ps = cross_sum(ps);
  l_reg = l_reg * alpha + ps;
#pragma unroll
  for (int w = 0; w < 4; ++w) {
    P8[w]     = __builtin_amdgcn_cvt_pk_fp8_f32(p0[4 * w + 2], p0[4 * w + 3], __builtin_amdgcn_cvt_pk_fp8_f32(p0[4 * w], p0[4 * w + 1], 0, false), true);
    P8[4 + w] = __builtin_amdgcn_cvt_pk_fp8_f32(p1[4 * w + 2], p1[4 * w + 3], __builtin_amdgcn_cvt_pk_fp8_f32(p1[4 * w], p1[4 * w + 1], 0, false), true);
  }
}
__device__ __forceinline__ void pv8(f32x16* o, const LAS char* vb, const v8i& P8) {
  v4u lo[4], hh[4];
#pragma unroll
  for (int d0 = 0; d0 < 4; ++d0) { lo[d0] = *(const LAS v4u*)(vb + d0 * 2048); hh[d0] = *(const LAS v4u*)(vb + d0 * 2048 + 512); }
#pragma unroll
  for (int d0 = 0; d0 < 4; ++d0) {
    v8i B; B[0] = (int)lo[d0].x; B[1] = (int)lo[d0].y; B[2] = (int)lo[d0].z; B[3] = (int)lo[d0].w; B[4] = (int)hh[d0].x; B[5] = (int)hh[d0].y; B[6] = (int)hh[d0].z; B[7] = (int)hh[d0].w;
    o[d0] = __builtin_amdgcn_mfma_scale_f32_32x32x64_f8f6f4(P8, B, o[d0], 0, 0, 0, 0x7F7F7F7F, 0, 0x7F7F7F7F);
  }
}
__device__ __forceinline__ void pv8_exp(f32x16* o, const LAS char* vb, const v8i& P8, f32x16& pn) {
  v4u lo[4], hh[4];
#pragma unroll
  for (int d0 = 0; d0 < 4; ++d0) { lo[d0] = *(const LAS v4u*)(vb + d0 * 2048); hh[d0] = *(const LAS v4u*)(vb + d0 * 2048 + 512); }
  asm volatile("s_waitcnt lgkmcnt(0)" ::: "memory"); SBAR();
#pragma unroll
  for (int d0 = 0; d0 < 4; ++d0) {
    v8i B; B[0] = (int)lo[d0].x; B[1] = (int)lo[d0].y; B[2] = (int)lo[d0].z; B[3] = (int)lo[d0].w; B[4] = (int)hh[d0].x; B[5] = (int)hh[d0].y; B[6] = (int)hh[d0].z; B[7] = (int)hh[d0].w;
    o[d0] = __builtin_amdgcn_mfma_scale_f32_32x32x64_f8f6f4(P8, B, o[d0], 0, 0, 0, 0x7F7F7F7F, 0, 0x7F7F7F7F);
#pragma unroll
    for (int r = 0; r < 4; ++r) pn[4 * d0 + r] = __builtin_amdgcn_exp2f(pn[4 * d0 + r]);
  }
  asm volatile("" :: "v"(pn[0]), "v"(pn[1]), "v"(pn[2]), "v"(pn[3]), "v"(pn[4]), "v"(pn[5]), "v"(pn[6]), "v"(pn[7]), "v"(pn[8]), "v"(pn[9]), "v"(pn[10]), "v"(pn[11]), "v"(pn[12]), "v"(pn[13]), "v"(pn[14]), "v"(pn[15]));
#pragma unroll
  for (int d0 = 0; d0 < 4; ++d0) { __builtin_amdgcn_sched_group_barrier(0x008, 1, 0); __builtin_amdgcn_sched_group_barrier(PVX_MASK, 4, 0); }
  SBAR();
}

constexpr float YB = 56.0f + Y8_C, YLO = 8.0f * WLO + YB, YHI = 8.0f * WHI + YB, YMID = 8.0f * WMID + YB;
__device__ __forceinline__ void partialSMY(f32x16& p0, f32x16& p1, mref_t& mref, float& alpha) {
  float pmax = max3f(p0[0], p0[1], p0[2]);
#pragma unroll
  for (int r = 3; r < 15; r += 2) pmax = max3f(pmax, p0[r], p0[r + 1]);
  pmax = max3f(pmax, p0[15], p1[0]);
#pragma unroll
  for (int r = 1; r < 15; r += 2) pmax = max3f(pmax, p1[r], p1[r + 1]);
  pmax = fmaxf(pmax, p1[15]);
  pmax = cross_max(pmax);
  if (__builtin_expect(__all(pmax >= YLO && pmax <= YHI), 1)) { alpha = 1.f; }
  else {
    const float d = (pmax < YLO || pmax > YHI) ? 8.0f * __builtin_rintf((pmax - YMID) * 0.125f) : 0.f;
    alpha = __builtin_amdgcn_exp2f(-0.125f * d);
#pragma unroll
    for (int r = 0; r < 16; ++r) { p0[r] -= d; p1[r] -= d; mref[r] -= d; }
  }
}
__device__ __forceinline__ void finishSMY(const f32x16& p0, const f32x16& p1, v8i& P8) {
#pragma unroll
  for (int w = 0; w < 4; ++w) {
    unsigned a = 0u, b = 0u;
#pragma unroll
    for (int i = 0; i < 4; ++i) { a = __builtin_amdgcn_cvt_pk_u8_f32(p0[4 * w + i], (unsigned)i, a); b = __builtin_amdgcn_cvt_pk_u8_f32(p1[4 * w + i], (unsigned)i, b); }
    P8[w] = (int)a; P8[4 + w] = (int)b;
  }
}
__device__ __forceinline__ void pv8s(f32x16* o, f32x16& lacc, const LAS char* vb, const v8i& P8) {
  v4u lo[4], hh[4];
#pragma unroll
  for (int d0 = 0; d0 < 4; ++d0) { lo[d0] = *(const LAS v4u*)(vb + d0 * 2048); hh[d0] = *(const LAS v4u*)(vb + d0 * 2048 + 512); }
  if (ATT_PRIO) __builtin_amdgcn_s_setprio(1);
  { const v8i ones = {0x38383838, 0x38383838, 0x38383838, 0x38383838, 0x38383838, 0x38383838, 0x38383838, 0x38383838};
    lacc = __builtin_amdgcn_mfma_scale_f32_32x32x64_f8f6f4(P8, ones, lacc, 0, 0, 0, 0x7F7F7F7F, 0, 0x7F7F7F7F); }
#pragma unroll
  for (int d0 = 0; d0 < 4; ++d0) {
    v8i B; B[0] = (int)lo[d0].x; B[1] = (int)lo[d0].y; B[2] = (int)lo[d0].z; B[3] = (int)lo[d0].w; B[4] = (int)hh[d0].x; B[5] = (int)hh[d0].y; B[6] = (int)hh[d0].z; B[7] = (int)hh[d0].w;
    o[d0] = __builtin_amdgcn_mfma_scale_f32_32x32x64_f8f6f4(P8, B, o[d0], 0, 0, 0, 0x7F7F7F7F, 0, 0x7F7F7F7F);
  }
  if (ATT_PRIO) __builtin_amdgcn_s_setprio(0);
}
#endif
__device__ __forceinline__ void qkt(f32x16& p0, f32x16& p1, const LAS char* Ks, const bf16x8* qr, int r32, int hi, int map, const mref_t& negm) {
  p0 = mref_acc(negm); p1 = p0;
#pragma unroll
  for (int d0 = 0; d0 < 4; ++d0) { int cb = (map * 64 + d0 * 16 + hi * 8) * 2;
    bf16x8 b0 = *(const LAS bf16x8*)(Ks + KSWZ(r32, cb));
    bf16x8 b1 = *(const LAS bf16x8*)(Ks + KSWZ(32 + r32, cb));
    p0 = __builtin_amdgcn_mfma_f32_32x32x16_bf16(b0, qr[d0], p0, 0, 0, 0);
    p1 = __builtin_amdgcn_mfma_f32_32x32x16_bf16(b1, qr[d0], p1, 0, 0, 0); }
}
#if ATT_NOSWAP
__device__ __forceinline__ int v_st(int k, int c) { return ((k >> 3) * 4 + (c >> 5)) * 512 + ((k & 7) * 32 + (c & 31)) * 2; }
#else
__device__ __forceinline__ int v_st(int k, int c) { const int kk = (k & ~0xC) | ((k & 4) << 1) | ((k & 8) >> 1); return ((kk >> 3) * 4 + (c >> 5)) * 512 + ((kk & 7) * 32 + (c & 31)) * 2; }
#endif
__device__ __forceinline__ int v_rd_base(int lane) { return ((lane & 3) << 3) | (((lane >> 2) & 3) << 6) | (((lane >> 4) & 1) << 5) | (((lane >> 5) & 1) << 8); }
constexpr int v_rd_off(int d0, int ks, int half) { return d0 * 512 + ks * 4096 + half * 2048; }
template <int OFF> __device__ __forceinline__ s16x4 tr_read(int vb) {
  s16x4 r; asm volatile("ds_read_b64_tr_b16 %0, %1 offset:%2" : "=&v"(r) : "v"(vb), "i"(OFF) : "memory"); return r;
}
struct VG { s16x4 l0, h0, l1, h1, l2, h2, l3, h3; };
template <int D0> __device__ __forceinline__ void pv_load(VG& g, int vb) {
  g.l0 = tr_read<v_rd_off(D0, 0, 0)>(vb); g.h0 = tr_read<v_rd_off(D0, 0, 1)>(vb); g.l1 = tr_read<v_rd_off(D0, 1, 0)>(vb); g.h1 = tr_read<v_rd_off(D0, 1, 1)>(vb);
  g.l2 = tr_read<v_rd_off(D0, 2, 0)>(vb); g.h2 = tr_read<v_rd_off(D0, 2, 1)>(vb); g.l3 = tr_read<v_rd_off(D0, 3, 0)>(vb); g.h3 = tr_read<v_rd_off(D0, 3, 1)>(vb);
}
__device__ __forceinline__ void pv_mma(f32x16& od, const VG& g, bf16x8 pa0, bf16x8 pa1, bf16x8 pa2, bf16x8 pa3) {
#define PK(L, H) (bf16x8){L[0], L[1], L[2], L[3], H[0], H[1], H[2], H[3]}
  od = __builtin_amdgcn_mfma_f32_32x32x16_bf16(pa0, PK(g.l0, g.h0), od, 0, 0, 0);
  od = __builtin_amdgcn_mfma_f32_32x32x16_bf16(pa1, PK(g.l1, g.h1), od, 0, 0, 0);
  od = __builtin_amdgcn_mfma_f32_32x32x16_bf16(pa2, PK(g.l2, g.h2), od, 0, 0, 0);
  od = __builtin_amdgcn_mfma_f32_32x32x16_bf16(pa3, PK(g.l3, g.h3), od, 0, 0, 0);
#undef PK
}
__device__ __forceinline__ void pv_d0(f32x16* o, int vb, bf16x8 pa0, bf16x8 pa1, bf16x8 pa2, bf16x8 pa3, f32x16& lacc) {
#if ATT_LMFMA
  { const bf16x8 ones = {0x3F80, 0x3F80, 0x3F80, 0x3F80, 0x3F80, 0x3F80, 0x3F80, 0x3F80};
    lacc = __builtin_amdgcn_mfma_f32_32x32x16_bf16(pa0, ones, lacc, 0, 0, 0); lacc = __builtin_amdgcn_mfma_f32_32x32x16_bf16(pa1, ones, lacc, 0, 0, 0);
    lacc = __builtin_amdgcn_mfma_f32_32x32x16_bf16(pa2, ones, lacc, 0, 0, 0); lacc = __builtin_amdgcn_mfma_f32_32x32x16_bf16(pa3, ones, lacc, 0, 0, 0); }
#endif
#if ATT_PVPF
  VG ga, gb;
  pv_load<0>(ga, vb); pv_load<1>(gb, vb);
  asm volatile("s_waitcnt lgkmcnt(8)" ::: "memory"); SBAR(); pv_mma(o[0], ga, pa0, pa1, pa2, pa3);
  pv_load<2>(ga, vb);
  asm volatile("s_waitcnt lgkmcnt(8)" ::: "memory"); SBAR(); pv_mma(o[1], gb, pa0, pa1, pa2, pa3);
  pv_load<3>(gb, vb);
  asm volatile("s_waitcnt lgkmcnt(8)" ::: "memory"); SBAR(); pv_mma(o[2], ga, pa0, pa1, pa2, pa3);
  asm volatile("s_waitcnt lgkmcnt(0)" ::: "memory"); SBAR(); pv_mma(o[3], gb, pa0, pa1, pa2, pa3);
#else
  VG g;
  pv_load<0>(g, vb); asm volatile("s_waitcnt lgkmcnt(0)" ::: "memory"); SBAR(); pv_mma(o[0], g, pa0, pa1, pa2, pa3);
  pv_load<1>(g, vb); asm volatile("s_waitcnt lgkmcnt(0)" ::: "memory"); SBAR(); pv_mma(o[1], g, pa0, pa1, pa2, pa3);
  pv_load<2>(g, vb); asm volatile("s_waitcnt lgkmcnt(0)" ::: "memory"); SBAR(); pv_mma(o[2], g, pa0, pa1, pa2, pa3);
  pv_load<3>(g, vb); asm volatile("s_waitcnt lgkmcnt(0)" ::: "memory"); SBAR(); pv_mma(o[3], g, pa0, pa1, pa2, pa3);
#endif
}
template <int VAR>
__device__ __forceinline__ void diff_attn_unit(const bf16* __restrict__ Qb, const bf16* __restrict__ Kh, const bf16* __restrict__ Vh, bf16* __restrict__ Ob, int seq, LAS char* lds,
                                               float lam, const float* gsub, float oscale, const int wave, const unsigned char* V8h, const unsigned char* q8base = nullptr) {
  const int tid = fresh_tid(wave), wid = tid >> 6, lane = tid & 63, r32 = lane & 31, hi = lane >> 5, map = wid >> 2, wq = wid & 3;
  constexpr int BUFB = (int)(SHM_V + SHM_K), WSF_OFF = RING_BYTES + 1024;
  LAS float* wsf = (LAS float*)(lds + WSF_OFF) + wid * 64; LAS float* li_l = wsf; LAS float* al_l = wsf + 32;
  float l_reg = 0; f32x16 o[4], lacc; mref_t negm = MREF_INIT; bf16x8 qr[4];
  { float zf_ = 0.f; asm volatile("" : "+v"(zf_));
#pragma unroll
    for (int r = 0; r < 16; ++r) { lacc[r] = zf_; o[0][r] = zf_; o[1][r] = zf_; o[2][r] = zf_; o[3][r] = zf_; } }
  const bf16* Qw = Qb + (long)(wq * 32 + r32) * LDQ + map * 64 + hi * 8;
#pragma unroll
  for (int d0 = 0; d0 < 4; ++d0) { const v4u w = *reinterpret_cast<const v4u*>(Qw + d0 * 16); constexpr float C = SCALE * 1.4426950408889634f;
    v4u q; q.x = cvtpk(bflo(w.x) * C, bfhi(w.x) * C); q.y = cvtpk(bflo(w.y) * C, bfhi(w.y) * C); q.z = cvtpk(bflo(w.z) * C, bfhi(w.z) * C); q.w = cvtpk(bflo(w.w) * C, bfhi(w.w) * C);
    qr[d0] = __builtin_bit_cast(bf16x8, q); }
#if ATT_DMA && ATT_FP8 && ATT_QK8
  constexpr int TB = 16384, LEAD = ATT_LEAD, NBUF = LEAD > 2 ? 8 : 4;
  const unsigned pcoff = (unsigned)(wid * 1024 + lane * 16);
  const LAS char* vrd = lds + hi * 1024 + r32 * 16;
  const LAS char* krd = lds + 8192 + (map * 2 + hi) * 2048 + r32 * 16;
  v8i P8, Q8;
#if Q8_DIRECT
  {
    const unsigned char* q8b = (const unsigned char*)q8base; const long off_ = (const unsigned char*)Qb - q8b; const int row_ = (int)(off_ >> 10) + wq * 32 + r32, hcol_ = (int)(off_ & 1023) + map * 64 + hi * 32;
    const unsigned char* q8 = q8b + (size_t)(row_ >> 4) * 16384 + (size_t)(hcol_ >> 3) * 128 + (row_ & 15) * 8;
    const v2u a_ = *(const v2u*)q8, b_ = *(const v2u*)(q8 + 128), c_ = *(const v2u*)(q8 + 256), d_ = *(const v2u*)(q8 + 384);
    Q8 = (v8i){(int)a_.x, (int)a_.y, (int)b_.x, (int)b_.y, (int)c_.x, (int)c_.y, (int)d_.x, (int)d_.y}; }
#else
  { constexpr float C = SCALE * 1.4426950408889634f * (ATT_Y8 ? 8.0f : 1.0f); const bf16* qp = Qb + (long)(wq * 32 + r32) * LDQ + map * 64 + hi * 32;
#pragma unroll
    for (int w4 = 0; w4 < 4; ++w4) { float a[8]; ld8f(qp + 8 * w4, a);
      Q8[2 * w4]     = __builtin_amdgcn_cvt_pk_fp8_f32(a[2] * C, a[3] * C, __builtin_amdgcn_cvt_pk_fp8_f32(a[0] * C, a[1] * C, 0, false), true);
      Q8[2 * w4 + 1] = __builtin_amdgcn_cvt_pk_fp8_f32(a[6] * C, a[7] * C, __builtin_amdgcn_cvt_pk_fp8_f32(a[4] * C, a[5] * C, 0, false), true); } }
#endif
  const unsigned char* K8h = V8h + (WS_K8 - WS_V8);
#define DMA(t_) do { const int bo_ = ((t_) & (NBUF - 1)) * TB; \
    __builtin_amdgcn_global_load_lds((const unsigned*)(V8h + (size_t)(t_) * 65536 + pcoff), (LAS unsigned*)(lds + bo_ + wid * 1024), 16, 0, 0); \
    __builtin_amdgcn_global_load_lds((const unsigned*)(K8h + (size_t)(t_) * 65536 + pcoff), (LAS unsigned*)(lds + bo_ + 8192 + wid * 1024), 16, 0, 0); } while (0)
#define RESC(a) do { if (__any((a) != 1.f)) { if (hi == 0) al_l[r32] = (a); asm volatile("s_waitcnt lgkmcnt(0)" ::: "memory"); \
    _Pragma("unroll") for (int r = 0; r < 16; ++r) { const float a_ = al_l[crow(r, hi)]; lacc[r] *= a_; _Pragma("unroll") for (int d = 0; d < 4; ++d) o[d][r] *= a_; } } } while (0)
#define TBAR() do { asm volatile("s_waitcnt lgkmcnt(0)" ::: "memory"); __builtin_amdgcn_s_barrier(); asm volatile("" ::: "memory"); } while (0)
#if ATT_KPF || ATT_P2
  v8i kfa, kfb;
#define KLOAD(t_) do { const LAS char* kb_ = krd + ((t_) & (NBUF - 1)) * TB; \
    const v4u k0l = *(const LAS v4u*)(kb_), k0h = *(const LAS v4u*)(kb_ + 1024), k1l = *(const LAS v4u*)(kb_ + 512), k1h = *(const LAS v4u*)(kb_ + 1536); \
    kfa = (v8i){(int)k0l.x, (int)k0l.y, (int)k0l.z, (int)k0l.w, (int)k0h.x, (int)k0h.y, (int)k0h.z, (int)k0h.w}; kfb = (v8i){(int)k1l.x, (int)k1l.y, (int)k1l.z, (int)k1l.w, (int)k1h.x, (int)k1h.y, (int)k1h.z, (int)k1h.w}; } while (0)
#define QK8(P0, P1, t_) do { \
    P0 = __builtin_amdgcn_mfma_scale_f32_32x32x64_f8f6f4(kfa, Q8, mref_acc(negm), 0, 0, 0, 0x7F7F7F7F, 0, 0x7F7F7F7F); \
    P1 = __builtin_amdgcn_mfma_scale_f32_32x32x64_f8f6f4(kfb, Q8, mref_acc(negm), 0, 0, 0, 0x7F7F7F7F, 0, 0x7F7F7F7F); \
    SBAR(); if ((t_) + 1 < NT) KLOAD((t_) + 1); } while (0)
#else
#define KLOAD(t_) do {} while (0)
#define QK8(P0, P1, t_) do { const LAS char* kb_ = krd + ((t_) & (NBUF - 1)) * TB; \
    const v4u k0l = *(const LAS v4u*)(kb_), k0h = *(const LAS v4u*)(kb_ + 1024), k1l = *(const LAS v4u*)(kb_ + 512), k1h = *(const LAS v4u*)(kb_ + 1536); \
    v8i ka_ = {(int)k0l.x, (int)k0l.y, (int)k0l.z, (int)k0l.w, (int)k0h.x, (int)k0h.y, (int)k0h.z, (int)k0h.w}, kb2_ = {(int)k1l.x, (int)k1l.y, (int)k1l.z, (int)k1l.w, (int)k1h.x, (int)k1h.y, (int)k1h.z, (int)k1h.w}; \
    P0 = __builtin_amdgcn_mfma_scale_f32_32x32x64_f8f6f4(ka_, Q8, mref_acc(negm), 0, 0, 0, 0x7F7F7F7F, 0, 0x7F7F7F7F); \
    P1 = __builtin_amdgcn_mfma_scale_f32_32x32x64_f8f6f4(kb2_, Q8, mref_acc(negm), 0, 0, 0, 0x7F7F7F7F, 0, 0x7F7F7F7F); } while (0)
#endif
  f32x16 pA0, pA1, pB0, pB1; float alA, alB; const int NT = seq / KVBLK;
  (void)qr; (void)Qw;
#if ATT_Y8
  { float yb_ = YB; asm volatile("" : "+v"(yb_));
#pragma unroll
    for (int r = 0; r < 16; ++r) negm[r] = yb_; }
#define PSM(P0, P1, AL) partialSMY(P0, P1, negm, AL)
#else
#define PSM(P0, P1, AL) partialSM(P0, P1, negm, AL)
#endif
#define VMW(n) asm volatile("s_waitcnt vmcnt(%0)" :: "n"(n) : "memory")
#if ATT_Y8 && ATT_P2
  static_assert(LEAD == 5 && NBUF == 8, "pipeline v2");
  v8i vf[4]; float al2;
#define VLOAD(t_) do { const LAS char* vb_ = vrd + ((t_) & (NBUF - 1)) * TB; _Pragma("unroll") for (int d0 = 0; d0 < 4; ++d0) { const v4u l_ = *(const LAS v4u*)(vb_ + d0 * 2048), h_ = *(const LAS v4u*)(vb_ + d0 * 2048 + 512); \
    vf[d0] = (v8i){(int)l_.x, (int)l_.y, (int)l_.z, (int)l_.w, (int)h_.x, (int)h_.y, (int)h_.z, (int)h_.w}; } } while (0)
#define QKM() do { pA0 = __builtin_amdgcn_mfma_scale_f32_32x32x64_f8f6f4(kfa, Q8, mref_acc(negm), 0, 0, 0, 0x7F7F7F7F, 0, 0x7F7F7F7F); \
    pA1 = __builtin_amdgcn_mfma_scale_f32_32x32x64_f8f6f4(kfb, Q8, mref_acc(negm), 0, 0, 0, 0x7F7F7F7F, 0, 0x7F7F7F7F); } while (0)
#define PVM() do { { int on_ = 0x38383838; asm volatile("" : "+v"(on_)); const v8i ones_ = {on_, on_, on_, on_, on_, on_, on_, on_}; \
      lacc = __builtin_amdgcn_mfma_scale_f32_32x32x64_f8f6f4(P8, ones_, lacc, 0, 0, 0, 0x7F7F7F7F, 0, 0x7F7F7F7F); } \
    _Pragma("unroll") for (int d0 = 0; d0 < 4; ++d0) o[d0] = __builtin_amdgcn_mfma_scale_f32_32x32x64_f8f6f4(P8, vf[d0], o[d0], 0, 0, 0, 0x7F7F7F7F, 0, 0x7F7F7F7F); } while (0)
#define STEP(j) do { SBAR(); if (!P2_KPF) KLOAD(j); if (!P2_VPF) VLOAD((j) - 1); asm volatile("s_waitcnt lgkmcnt(0)" ::: "memory"); QKM(); PVM(); SBAR(); \
    if (P2_KPF) { if ((j) + 1 < NT) KLOAD((j) + 1); } if (P2_VPF) VLOAD(j); SBAR(); \
    partialSMY(pA0, pA1, negm, al2); RESC(al2); finishSMY(pA0, pA1, P8); } while (0)
#pragma unroll
  for (int t = 0; t <= LEAD; ++t) if (t < NT) DMA(t);
  if (LEAD < NT) VMW(2 * (LEAD - 1)); else VMW(0);
  TBAR();
#if P2_AB
  auto run_ = [&](auto G_) __attribute__((always_inline)) { constexpr int GRP = decltype(G_)::value;
  KLOAD(0); asm volatile("s_waitcnt lgkmcnt(0)" ::: "memory"); QKM(); SBAR();
  if constexpr (GRP == 0) { partialSMY(pA0, pA1, negm, al2); finishSMY(pA0, pA1, P8); }
  if (LEAD < NT) VMW(2 * (LEAD - 3)); else VMW(0);
  TBAR();
#define STEPB(j) do { SBAR(); partialSMY(pA0, pA1, negm, al2); RESC(al2); finishSMY(pA0, pA1, P8); SBAR(); \
    KLOAD(j); asm volatile("s_waitcnt lgkmcnt(0)" ::: "memory"); QKM(); SBAR(); VLOAD((j) - 1); asm volatile("s_waitcnt lgkmcnt(0)" ::: "memory"); PVM(); SBAR(); } while (0)
  if constexpr (GRP == 0) {
    for (int j = 1; j + 1 < NT; j += 2) {
      if (j + LEAD < NT) DMA(j + LEAD); if (j + LEAD + 1 < NT) DMA(j + LEAD + 1);
      STEP(j); STEP(j + 1);
      if (j + LEAD + 1 < NT) VMW(2 * (LEAD - 3)); else VMW(0); TBAR();
    }
    STEP(NT - 1);
  } else {
    for (int j = 1; j + 1 < NT; j += 2) {
      if (j + LEAD < NT) DMA(j + LEAD); if (j + LEAD + 1 < NT) DMA(j + LEAD + 1);
      STEPB(j); STEPB(j + 1);
      if (j + LEAD + 1 < NT) VMW(2 * (LEAD - 3)); else VMW(0); TBAR();
    }
    STEPB(NT - 1);
    partialSMY(pA0, pA1, negm, al2); RESC(al2); finishSMY(pA0, pA1, P8);
  }
  VLOAD(NT - 1);
  asm volatile("s_waitcnt lgkmcnt(0)" ::: "memory"); PVM();
#undef STEPB
#else
  KLOAD(0); asm volatile("s_waitcnt lgkmcnt(0)" ::: "memory"); QKM(); SBAR(); if (P2_KPF) KLOAD(1); if (P2_VPF) VLOAD(0); SBAR();
  partialSMY(pA0, pA1, negm, al2); finishSMY(pA0, pA1, P8);
  if (LEAD < NT) VMW(2 * (LEAD - 3)); else VMW(0);
  TBAR();
  for (int j = 1; j + 1 < NT; j += 2) {
    if (j + LEAD < NT) DMA(j + LEAD); if (j + LEAD + 1 < NT) DMA(j + LEAD + 1);
    STEP(j);
    STEP(j + 1);
    if (j + LEAD + 1 < NT) VMW(2 * (LEAD - 3)); else VMW(0); TBAR();
  }
  STEP(NT - 1);
  if (!P2_VPF) VLOAD(NT - 1);
  asm volatile("s_waitcnt lgkmcnt(0)" ::: "memory"); PVM();
#endif
  (void)pB0; (void)pB1; (void)alA; (void)alB;
#undef STEP
#undef PVM
#undef QKM
#undef VLOAD
#elif ATT_Y8 && ATT_AB
  static_assert(LEAD == 5 && NBUF == 8, "anti-phase schedule");
#pragma unroll
  for (int t = 0; t <= LEAD; ++t) if (t < NT) DMA(t);
  if (LEAD < NT) VMW(2 * LEAD); else VMW(0);
  TBAR();
  QK8(pA0, pA1, 0); PSM(pA0, pA1, alA);
  if (LEAD < NT) VMW(2 * (LEAD - 3)); else VMW(0);
  TBAR();
#define XCV(PO0, PO1, j) do { finishSMY(PO0, PO1, P8); SBAR(); pv8s(o, lacc, vrd + (((j) - 1) & (NBUF - 1)) * TB, P8); } while (0)
  if (map == 0) {
#define ITERA(j, PN0, PN1, ALN, PO0, PO1) do { SBAR(); QK8(PN0, PN1, j); XCV(PO0, PO1, j); partialSMY(PN0, PN1, negm, ALN); RESC(ALN); } while (0)
    for (int j = 1; j + 1 < NT; j += 2) {
      if (j + LEAD < NT) DMA(j + LEAD); if (j + LEAD + 1 < NT) DMA(j + LEAD + 1);
      ITERA(j, pB0, pB1, alB, pA0, pA1);
      ITERA(j + 1, pA0, pA1, alA, pB0, pB1);
      if (j + LEAD + 1 < NT) VMW(2 * (LEAD - 3)); else VMW(0); TBAR();
    }
    ITERA(NT - 1, pB0, pB1, alB, pA0, pA1);
#undef ITERA
  } else {
    QK8(pB0, pB1, 1);
#define ITERB(j, PN0, PN1, ALN, PO0, PO1) do { SBAR(); XCV(PO0, PO1, j); partialSMY(PN0, PN1, negm, ALN); RESC(ALN); SBAR(); if ((j) + 1 < NT) QK8(PO0, PO1, (j) + 1); } while (0)
    for (int j = 1; j + 1 < NT; j += 2) {
      if (j + LEAD < NT) DMA(j + LEAD); if (j + LEAD + 1 < NT) DMA(j + LEAD + 1);
      ITERB(j, pB0, pB1, alB, pA0, pA1);
      ITERB(j + 1, pA0, pA1, alA, pB0, pB1);
      if (j + LEAD + 1 < NT) VMW(2 * (LEAD - 3)); else VMW(0); TBAR();
    }
    ITERB(NT - 1, pB0, pB1, alB, pA0, pA1);
#undef ITERB
  }
  finishSMY(pB0, pB1, P8); SBAR();
  pv8s(o, lacc, vrd + ((NT - 1) & (NBUF - 1)) * TB, P8);
#undef XCV
#else
#pragma unroll
  for (int t = 0; t <= LEAD; ++t) if (t < NT) DMA(t);
  if (LEAD < NT) VMW(2 * (LEAD - ATT_KPF)); else VMW(0);
  TBAR();
  KLOAD(0);
  QK8(pA0, pA1, 0); PSM(pA0, pA1, alA);
  if (LEAD < NT) VMW(2 * (LEAD - 1 - ATT_BAR2 - ATT_KPF)); else VMW(0);
  TBAR();
#define ITER(j, PN0, PN1, ALN, PO0, PO1, ALO) do { \
    if (!ATT_BAR2) { if ((j) + LEAD < NT) DMA((j) + LEAD); } \
    SBAR(); if (!(ATT_STAG && map == 1)) QK8(PN0, PN1, j); \
    if (ATT_Y8) { if (VAR != 4) finishSMY(PO0, PO1, P8); SBAR(); \
        if (VAR == 2) { const LAS char* vb_ = vrd + (((j) - 1) & (NBUF - 1)) * TB; _Pragma("unroll") for (int d0 = 0; d0 < 4; ++d0) { const v4u l_ = *(const LAS v4u*)(vb_ + d0 * 2048), h_ = *(const LAS v4u*)(vb_ + d0 * 2048 + 512); asm volatile("" :: "v"(l_), "v"(h_)); } } \
        else if (VAR != 1) pv8s(o, lacc, vrd + (((j) - 1) & (NBUF - 1)) * TB, P8); \
        if (ATT_STAG && map == 1) { SBAR(); QK8(PN0, PN1, j); } \
        if (VAR != 5) partialSMY(PN0, PN1, negm, ALN); else ALN = 1.f; } \
    else { finishSM8(PO0, PO1, ALO, l_reg, P8); SBAR(); } \
    if (ATT_Y8) {} else if (ATT_PVX) { partialSM<false>(PN0, PN1, negm, ALN); SBAR(); pv8_exp(o, vrd + (((j) - 1) & (NBUF - 1)) * TB, P8, PN0); } \
    else { pv8(o, vrd + (((j) - 1) & (NBUF - 1)) * TB, P8); partialSM(PN0, PN1, negm, ALN); } \
    RESC(ALN); \
    if (!ATT_BAR2) { if ((j) + LEAD < NT) VMW(2 * (LEAD - 1)); else VMW(0); \
    TBAR(); } } while (0)
  for (int j = 1; j + 1 < NT; j += 2) {
    if (ATT_BAR2) { if (j + LEAD < NT) DMA(j + LEAD); if (j + LEAD + 1 < NT) DMA(j + LEAD + 1); }
    ITER(j, pB0, pB1, alB, pA0, pA1, alA);
    ITER(j + 1, pA0, pA1, alA, pB0, pB1, alB);
    if (ATT_BAR2) { if (j + LEAD + 1 < NT) VMW(2 * (LEAD - 2 - ATT_KPF)); else VMW(0); TBAR(); }
  }
  ITER(NT - 1, pB0, pB1, alB, pA0, pA1, alA);
#if ATT_Y8
  finishSMY(pB0, pB1, P8); SBAR();
  pv8s(o, lacc, vrd + ((NT - 1) & (NBUF - 1)) * TB, P8);
#else
  finishSM8(pB0, pB1, alB, l_reg, P8); SBAR();
  pv8(o, vrd + ((NT - 1) & (NBUF - 1)) * TB, P8);
#endif
#endif
#undef PSM
#undef VMW
#undef DMA
#undef TBAR
#undef QK8
#undef KLOAD
#undef ITER
#elif ATT_DMA && ATT_FP8
  const int vb0 = (int)(unsigned)(uintptr_t)lds + v_rd_base(lane);
  unsigned voffV[2], voffK[2];
#pragma unroll
  for (int t = 0; t < 2; ++t) { const int vi = wid * 2 + t, kg = vi >> 1, pair = vi & 1, sub = lane >> 5, row = (lane >> 2) & 7, chunk = lane & 3;
    voffV[t] = (unsigned)((8 * kg + row) * LDK + 32 * (2 * pair + sub) + 8 * chunk) * 2u;
    const int krow = 4 * vi + (lane >> 4), p = lane & 15;
    voffK[t] = (unsigned)(krow * LDK) * 2u + (unsigned)((p ^ (krow & 7)) * 16); }
  const int ldsw = wid * 2048; const unsigned v8off = (unsigned)(wid * 1024 + lane * 16); const LAS char* vrd = lds + hi * 1024 + r32 * 16; v8i P8;
  (void)voffV; (void)vb0;
#define DMA(t_) do { const char* vt_ = (const char*)(Vh + (size_t)(t_) * KVBLK * LDK); const char* kt_ = (const char*)(Kh + (size_t)(t_) * KVBLK * LDK); const int bo_ = ((t_) & 3) * BUFB; \
    _Pragma("unroll") for (int i_ = 0; i_ < 2; ++i_) { \
      __builtin_amdgcn_global_load_lds((const unsigned*)(kt_ + voffK[i_]), (LAS unsigned*)(lds + bo_ + (int)SHM_V + ldsw + i_ * 1024), 16, 0, 0); } \
    __builtin_amdgcn_global_load_lds((const unsigned*)(V8h + (size_t)(t_) * 65536 + v8off), (LAS unsigned*)(lds + bo_ + wid * 1024), 16, 0, 0); (void)vt_; } while (0)
#define RESC(a) do { if (__any((a) != 1.f)) { if (hi == 0) al_l[r32] = (a); asm volatile("s_waitcnt lgkmcnt(0)" ::: "memory"); \
    _Pragma("unroll") for (int r = 0; r < 16; ++r) { const float a_ = al_l[crow(r, hi)]; lacc[r] *= a_; _Pragma("unroll") for (int d = 0; d < 4; ++d) o[d][r] *= a_; } } } while (0)
#define TBAR() do { asm volatile("s_waitcnt lgkmcnt(0)" ::: "memory"); __builtin_amdgcn_s_barrier(); asm volatile("" ::: "memory"); } while (0)
#define KBUF(t_) (lds + ((t_) & 3) * BUFB + (int)SHM_V)
#define VBUF(t_) (vb0 + ((t_) & 3) * BUFB)
  f32x16 pA0, pA1, pB0, pB1; float alA, alB; bf16x8 pa0, pa1, pa2, pa3; const int NT = seq / KVBLK;
  DMA(0); DMA(1); if (2 < NT) DMA(2);
  if (2 < NT) asm volatile("s_waitcnt vmcnt(6)" ::: "memory"); else asm volatile("s_waitcnt vmcnt(3)" ::: "memory");
  TBAR();
  qkt(pA0, pA1, KBUF(0), qr, r32, hi, map, negm); partialSM(pA0, pA1, negm, alA);
  if (2 < NT) asm volatile("s_waitcnt vmcnt(3)" ::: "memory"); else asm volatile("s_waitcnt vmcnt(0)" ::: "memory");
  TBAR();
#define ITER(j, PN0, PN1, ALN, PO0, PO1, ALO) do { \
    if ((j) + 2 < NT) DMA((j) + 2); \
    SBAR(); qkt(PN0, PN1, KBUF(j), qr, r32, hi, map, negm); \
    finishSM8(PO0, PO1, ALO, l_reg, P8); SBAR(); \
    pv8(o, vrd + (((j) - 1) & 3) * BUFB, P8); partialSM(PN0, PN1, negm, ALN); \
    RESC(ALN); \
    if ((j) + 2 < NT) asm volatile("s_waitcnt vmcnt(3)" ::: "memory"); else asm volatile("s_waitcnt vmcnt(0)" ::: "memory"); \
    TBAR(); } while (0)
  for (int j = 1; j + 1 < NT; j += 2) {
    ITER(j, pB0, pB1, alB, pA0, pA1, alA);
    ITER(j + 1, pA0, pA1, alA, pB0, pB1, alB);
  }
  ITER(NT - 1, pB0, pB1, alB, pA0, pA1, alA);
  finishSM8(pB0, pB1, alB, l_reg, P8); SBAR();
  pv8(o, vrd + ((NT - 1) & 3) * BUFB, P8);
#undef DMA
#undef TBAR
#undef KBUF
#undef VBUF
#undef ITER
#elif ATT_DMA
  const int vb0 = (int)(unsigned)(uintptr_t)lds + v_rd_base(lane);
  unsigned voffV[2], voffK[2];
#pragma unroll
  for (int t = 0; t < 2; ++t) { const int vi = wid * 2 + t, kg = vi >> 1, pair = vi & 1, sub = lane >> 5, row = (lane >> 2) & 7, chunk = lane & 3;
    voffV[t] = (unsigned)((8 * kg + row) * LDK + 32 * (2 * pair + sub) + 8 * chunk) * 2u;
    const int krow = 4 * vi + (lane >> 4), p = lane & 15;
    voffK[t] = (unsigned)(krow * LDK) * 2u + (unsigned)((p ^ (krow & 7)) * 16); }
  const int ldsw = wid * 2048;
#define DMA(t_) do { const char* vt_ = (const char*)(Vh + (size_t)(t_) * KVBLK * LDK); const char* kt_ = (const char*)(Kh + (size_t)(t_) * KVBLK * LDK); const int bo_ = ((t_) & 3) * BUFB; \
    _Pragma("unroll") for (int i_ = 0; i_ < 2; ++i_) { \
      __builtin_amdgcn_global_load_lds((const unsigned*)(vt_ + voffV[i_]), (LAS unsigned*)(lds + bo_ + ldsw + i_ * 1024), 16, 0, 0); \
      __builtin_amdgcn_global_load_lds((const unsigned*)(kt_ + voffK[i_]), (LAS unsigned*)(lds + bo_ + (int)SHM_V + ldsw + i_ * 1024), 16, 0, 0); } } while (0)
#define RESC(a) do { if (__any((a) != 1.f)) { if (hi == 0) al_l[r32] = (a); asm volatile("s_waitcnt lgkmcnt(0)" ::: "memory"); \
    _Pragma("unroll") for (int r = 0; r < 16; ++r) { const float a_ = al_l[crow(r, hi)]; lacc[r] *= a_; _Pragma("unroll") for (int d = 0; d < 4; ++d) o[d][r] *= a_; } } } while (0)
#define TBAR() do { asm volatile("s_waitcnt lgkmcnt(0)" ::: "memory"); __builtin_amdgcn_s_barrier(); asm volatile("" ::: "memory"); } while (0)
#define KBUF(t_) (lds + ((t_) & 3) * BUFB + (int)SHM_V)
#define VBUF(t_) (vb0 + ((t_) & 3) * BUFB)
  f32x16 pA0, pA1, pB0, pB1; float alA, alB; bf16x8 pa0, pa1, pa2, pa3; const int NT = seq / KVBLK;
  DMA(0); DMA(1); if (2 < NT) DMA(2);
  if (2 < NT) asm volatile("s_waitcnt vmcnt(8)" ::: "memory"); else asm volatile("s_waitcnt vmcnt(4)" ::: "memory");
  TBAR();
  qkt(pA0, pA1, KBUF(0), qr, r32, hi, map, negm); partialSM(pA0, pA1, negm, alA);
  if (2 < NT) asm volatile("s_waitcnt vmcnt(4)" ::: "memory"); else asm volatile("s_waitcnt vmcnt(0)" ::: "memory");
  TBAR();
#define ITER(j, PN0, PN1, ALN, PO0, PO1, ALO) do { \
    if ((j) + 2 < NT) DMA((j) + 2); \
    SBAR(); qkt(PN0, PN1, KBUF(j), qr, r32, hi, map, negm); \
    finishSM(PO0, PO1, ALO, l_reg, pa0, pa1, pa2, pa3); SBAR(); \
    pv_d0(o, VBUF((j) - 1), pa0, pa1, pa2, pa3, lacc); partialSM(PN0, PN1, negm, ALN); \
    RESC(ALN); \
    if ((j) + 2 < NT) asm volatile("s_waitcnt vmcnt(4)" ::: "memory"); else asm volatile("s_waitcnt vmcnt(0)" ::: "memory"); \
    TBAR(); } while (0)
  for (int j = 1; j + 1 < NT; j += 2) {
    ITER(j, pB0, pB1, alB, pA0, pA1, alA);
    ITER(j + 1, pA0, pA1, alA, pB0, pB1, alB);
  }
  ITER(NT - 1, pB0, pB1, alB, pA0, pA1, alA);
  finishSM(pB0, pB1, alB, l_reg, pa0, pa1, pa2, pa3); SBAR();
  pv_d0(o, VBUF(NT - 1), pa0, pa1, pa2, pa3, lacc);
#undef DMA
#undef TBAR
#undef KBUF
#undef VBUF
#undef ITER
#else
  const int sr = tid >> 4, sc = (tid & 15) * 8, vst0 = v_st(sr, sc), vst1 = v_st(32 + sr, sc);
  const int vb0 = (int)(unsigned)(uintptr_t)lds + v_rd_base(lane);
  struct { bf16x8 vs0, vs1, ks0, ks1; } sr_[2];
  const unsigned goff = (unsigned)(sr * LDK + sc) * 2u;
#define SLOAD(i, k0) do { const char* vt_ = (const char*)(Vh + (size_t)(k0) * LDK); const char* kt_ = (const char*)(Kh + (size_t)(k0) * LDK); \
    sr_[i].vs0 = *(const bf16x8*)(vt_ + goff); sr_[i].vs1 = *(const bf16x8*)(vt_ + (size_t)32 * LDK * 2 + goff); sr_[i].ks0 = *(const bf16x8*)(kt_ + goff); sr_[i].ks1 = *(const bf16x8*)(kt_ + (size_t)32 * LDK * 2 + goff); } while (0)
#define SWRITE(b, i) do { *(LAS bf16x8*)(lds + (b) * BUFB + vst0) = sr_[i].vs0; *(LAS bf16x8*)(lds + (b) * BUFB + vst1) = sr_[i].vs1; const int kc = sc * 2; \
    *(LAS bf16x8*)(lds + (b) * BUFB + (int)SHM_V + KSWZ(sr, kc)) = sr_[i].ks0; *(LAS bf16x8*)(lds + (b) * BUFB + (int)SHM_V + KSWZ(32 + sr, kc)) = sr_[i].ks1; } while (0)
#define SWAIT() asm volatile("s_waitcnt vmcnt(4)" ::: "memory")
#define RESC(a) do { if (__any((a) != 1.f)) { if (hi == 0) al_l[r32] = (a); asm volatile("s_waitcnt lgkmcnt(0)" ::: "memory"); \
    _Pragma("unroll") for (int r = 0; r < 16; ++r) { const float a_ = al_l[crow(r, hi)]; lacc[r] *= a_; _Pragma("unroll") for (int d = 0; d < 4; ++d) o[d][r] *= a_; } } } while (0)
  f32x16 pA0, pA1, pB0, pB1; float alA, alB; bf16x8 pa0, pa1, pa2, pa3; const int NT = seq / KVBLK;
  constexpr int SE = 0, SO = 1;
  LAS char* K0 = lds + (int)SHM_V; LAS char* K1 = lds + BUFB + (int)SHM_V;
  SLOAD(SE, 0); asm volatile("s_waitcnt vmcnt(0)" ::: "memory"); SWRITE(0, SE); __syncthreads();
  qkt(pA0, pA1, K0, qr, r32, hi, map, negm); partialSM(pA0, pA1, negm, alA);
  SLOAD(SO, KVBLK); if (2 < NT) SLOAD(SE, 2 * KVBLK);
  SWAIT(); SWRITE(1, SO); __syncthreads();
#define XBAR() do { if (VAR != 1) __syncthreads(); } while (0)
#define XQK(P0, P1, KK) do { if (VAR != 5) qkt(P0, P1, KK, qr, r32, hi, map, negm); } while (0)
#define XFIN(P0, P1, AL) do { if (VAR != 2) finishSM(P0, P1, AL, l_reg, pa0, pa1, pa2, pa3); } while (0)
#define XPAR(P0, P1, AL) do { if (VAR != 2) partialSM(P0, P1, negm, AL); } while (0)
#define XPV(VB) do { if (VAR != 3) pv_d0(o, VB, pa0, pa1, pa2, pa3, lacc); } while (0)
#define XLOAD(i, k0) do { if (VAR != 4) SLOAD(i, k0); } while (0)
#define XWRITE(b, i) do { if (VAR != 4) { SWAIT(); SWRITE(b, i); } } while (0)
  if (VAR == 2) { pa0 = qr[0]; pa1 = qr[1]; pa2 = qr[2]; pa3 = qr[3]; alA = 1.f; alB = 1.f; }
  if (VAR == 5) { pA0 = f32x16{}; pA1 = pA0; pB0 = pA0; pB1 = pA0; }
  for (int j = 1; j + 1 < NT; j += 2) {
    SBAR(); XQK(pB0, pB1, K1);
    XFIN(pA0, pA1, alA); SBAR();
    XLOAD(SO, (j + 2) * KVBLK); SBAR();
    XPV(vb0); XPAR(pB0, pB1, alB);
    XBAR(); XWRITE(0, SE);
    RESC(alB); XBAR();
    SBAR(); XQK(pA0, pA1, K0);
    XFIN(pB0, pB1, alB); SBAR();
    if (j + 3 < NT) XLOAD(SE, (j + 3) * KVBLK); SBAR();
    XPV(vb0 + BUFB); XPAR(pA0, pA1, alA);
    XBAR(); XWRITE(1, SO);
    RESC(alA); XBAR();
  }
  SBAR(); qkt(pB0, pB1, K1, qr, r32, hi, map, negm);
  finishSM(pA0, pA1, alA, l_reg, pa0, pa1, pa2, pa3); SBAR();
  pv_d0(o, vb0, pa0, pa1, pa2, pa3, lacc); partialSM(pB0, pB1, negm, alB);
  __syncthreads(); RESC(alB);
  finishSM(pB0, pB1, alB, l_reg, pa0, pa1, pa2, pa3); SBAR();
  pv_d0(o, vb0 + BUFB, pa0, pa1, pa2, pa3, lacc);
#endif
  {
    const int tid2 = fresh_tid(wave), wid2 = tid2 >> 6, lane2 = tid2 & 63, r32b = lane2 & 31, hib = lane2 >> 5, mapb = wid2 >> 2, wqb = wid2 & 3;
    LAS float* li2 = (LAS float*)(lds + WSF_OFF) + wid2 * 64;
    float rli[16];
#if ATT_LMFMA || ATT_Y8
    (void)li2;
#pragma unroll
    for (int r = 0; r < 16; ++r) rli[r] = __builtin_amdgcn_rcpf(lacc[r]);
#else
    if (hib == 0) li2[r32b] = l_reg; asm volatile("s_waitcnt lgkmcnt(0)" ::: "memory");
#pragma unroll
    for (int r = 0; r < 16; ++r) rli[r] = __builtin_amdgcn_rcpf(li2[crow(r, hib)]);
#endif
    __syncthreads();
    LAS float* X = (LAS float*)lds + (wqb * 32 + 4 * hib) * 128 + r32b;
    if (mapb == 1) {
#pragma unroll
      for (int r = 0; r < 16; ++r)
#pragma unroll
        for (int d0 = 0; d0 < 4; ++d0) X[((r & 3) + 8 * (r >> 2)) * 128 + d0 * 32] = o[d0][r] * rli[r] * lam;
    }
    __syncthreads();
    if (mapb == 0) {
      float gs[4];
#pragma unroll
      for (int d0 = 0; d0 < 4; ++d0) gs[d0] = gsub[d0 * 32 + r32b] * oscale;
      bf16* Ow = Ob + (long)(wqb * 32 + 4 * hib) * D + r32b;
#pragma unroll
      for (int r = 0; r < 16; ++r) {
        float ss = 0.f;
#pragma unroll
        for (int d0 = 0; d0 < 4; ++d0) { const float v = o[d0][r] * rli[r] - X[((r & 3) + 8 * (r >> 2)) * 128 + d0 * 32]; o[d0][r] = v; ss += v * v; }
        ss = half_sum(ss);
        const float rs = 1.0f / sqrtf(ss * (1.0f / 128.0f) + NORM_EPS);
#pragma unroll
        for (int d0 = 0; d0 < 4; ++d0) Ow[(long)((r & 3) + 8 * (r >> 2)) * D + d0 * 32] = (bf16)f2bf(o[d0][r] * rs * gs[d0]);
      }
    }
    __syncthreads();
  }
#if ATT_DMA && ATT_FP8 && ATT_QK8 && ATT_Y8 && ATT_P2 && P2_AB
  };
  if (map == 0) run_(std::integral_constant<int, 0>{}); else run_(std::integral_constant<int, 1>{});
#endif
#if !ATT_DMA
#undef XBAR
#undef XQK
#undef XFIN
#undef XPAR
#undef XPV
#undef XLOAD
#undef XWRITE
#undef SLOAD
#undef SWRITE
#undef SWAIT
#endif
#undef RESC
}
#undef KSWZ
}


__device__ __forceinline__ void v8_phase(Frame& F, const Params& P) {
    unsigned char* ws = fresh_ws(P.ws);
    const bf16* vb = (const bf16*)(ws + WS_VB); unsigned char* v8 = ws + WS_V8;
    const Lane L(F.wave); const int gw = F.vcu * NWAVES + F.wave, NGW = F.G * NWAVES, lane = L.lane;
    for (int tile = gw; tile < NB * (KVLEN / 64) * 8; tile += NGW) {
        const int h = tile & 7, t = (tile >> 3) % (KVLEN / 64), b = (tile >> 3) / (KVLEN / 64);
        const bf16* src = vb + ((size_t)b * KVLEN + 64 * t) * 1024 + h * 128;
        v4u* dst = (v4u*)(v8 + (size_t)tile * 8192);
#pragma unroll 2
        for (int q = 0; q < 8; ++q) {
            const int c = lane + 64 * q, d = c & 31, half = (c >> 5) & 1, hi = (c >> 6) & 1, d0 = c >> 7;
            const bf16* col = src + 32 * d0 + d + (size_t)(4 * hi + 32 * half) * 1024;
            float v[16];
#pragma unroll
            for (int j = 0; j < 16; ++j) { const float x = bf2f(col[(size_t)((j & 3) + 8 * (j >> 2)) * 1024]); v[j] = fminf(fmaxf(x, -448.f), 448.f); }
            v4u w;
            w.x = (unsigned)__builtin_amdgcn_cvt_pk_fp8_f32(v[2], v[3], __builtin_amdgcn_cvt_pk_fp8_f32(v[0], v[1], 0, false), true);
            w.y = (unsigned)__builtin_amdgcn_cvt_pk_fp8_f32(v[6], v[7], __builtin_amdgcn_cvt_pk_fp8_f32(v[4], v[5], 0, false), true);
            w.z = (unsigned)__builtin_amdgcn_cvt_pk_fp8_f32(v[10], v[11], __builtin_amdgcn_cvt_pk_fp8_f32(v[8], v[9], 0, false), true);
            w.w = (unsigned)__builtin_amdgcn_cvt_pk_fp8_f32(v[14], v[15], __builtin_amdgcn_cvt_pk_fp8_f32(v[12], v[13], 0, false), true);
            dst[c] = w;
        }
#if ATT_QK8 && !K8_DIRECT
        const bf16* ksrc = (const bf16*)(ws + WS_KB) + ((size_t)b * KVLEN + 64 * t) * 1024 + h * 128;
        v4u* kdst = (v4u*)(ws + WS_K8 + (size_t)tile * 8192);
#pragma unroll 2
        for (int q = 0; q < 8; ++q) {
            const int c = lane + 64 * q, key = c & 63, half = (c >> 6) & 1, hi = (c >> 7) & 1, map = c >> 8;
            const bf16* p = ksrc + (size_t)key * 1024 + map * 64 + 32 * hi + 16 * half;
            float v[16]; { float a[8], bq[8]; ld8f(p, a); ld8f(p + 8, bq);
#pragma unroll
              for (int j = 0; j < 8; ++j) { v[j] = fminf(fmaxf(a[j], -448.f), 448.f); v[8 + j] = fminf(fmaxf(bq[j], -448.f), 448.f); } }
            v4u w;
            w.x = (unsigned)__builtin_amdgcn_cvt_pk_fp8_f32(v[2], v[3], __builtin_amdgcn_cvt_pk_fp8_f32(v[0], v[1], 0, false), true);
            w.y = (unsigned)__builtin_amdgcn_cvt_pk_fp8_f32(v[6], v[7], __builtin_amdgcn_cvt_pk_fp8_f32(v[4], v[5], 0, false), true);
            w.z = (unsigned)__builtin_amdgcn_cvt_pk_fp8_f32(v[10], v[11], __builtin_amdgcn_cvt_pk_fp8_f32(v[8], v[9], 0, false), true);
            w.w = (unsigned)__builtin_amdgcn_cvt_pk_fp8_f32(v[14], v[15], __builtin_amdgcn_cvt_pk_fp8_f32(v[12], v[13], 0, false), true);
            kdst[c] = w;
        }
#endif
    }
}
template <int VAR>
__device__ __forceinline__ void attn_phase(Frame& F, const Params& P, int layer, bool ctx_out, unsigned char* ldsg) {
    (void)ldsg;
    unsigned char* ws = fresh_ws(P.ws);
    const bf16* qb = (const bf16*)(ws + WS_Q); const bf16* kb = (const bf16*)(ws + WS_KB); const bf16* vb = (const bf16*)(ws + WS_VB); bf16* cat = (bf16*)(ws + (VAR == 0 ? WS_CAT : WS_H));
    const Lane L(F.wave);
    const float lam_init = __builtin_bit_cast(float, __builtin_amdgcn_readfirstlane(__builtin_bit_cast(int, 0.8f - 0.6f * expf(-0.3f * (float)layer))));
    const float* lv = P.in[I_LAMBDA] + layer * 256;
    const float d1 = wave_sum(lv[L.lane] * lv[64 + L.lane]), d2 = wave_sum(lv[128 + L.lane] * lv[192 + L.lane]);
    const float lam = __builtin_bit_cast(float, __builtin_amdgcn_readfirstlane(__builtin_bit_cast(int, expf(d1) - expf(d2) + lam_init)));
    const float* gsub = P.in[I_SUBLN] + layer * 128;
    const int nun = NB * 8 * 64 + (ctx_out ? NB * 8 * 2 : 0);
    for (int uid = F.vcu; uid < nun; uid += F.G) {
        int qt, h, b, seq; size_t qrow;
        if (uid < NB * 8 * 64) { qt = uid & 63; h = (uid >> 6) & 7; b = uid >> 9; qrow = (size_t)b * SEQ + 128 * qt; seq = KVLEN; }
        else { const int u2 = uid - NB * 8 * 64; qt = u2 & 1; h = (u2 >> 1) & 7; b = u2 >> 4; qrow = (size_t)NLAT + b * CTXL + 128 * qt; seq = CTXL; }
        att::diff_attn_unit<VAR>(Q8_DIRECT ? (const bf16*)((const unsigned char*)qb + qrow * 1024 + h * 128) : qb + qrow * 1024 + h * 128, kb + (size_t)b * KVLEN * 1024 + h * 128, vb + (size_t)b * KVLEN * 1024 + h * 128,
                            cat + qrow * D + 1024 + h * 128, seq, (LAS char*)F.lds, lam, gsub, 1.0f - lam_init, F.wave, ws + WS_V8 + ((size_t)b * (KVLEN / 64) * 8 + h) * 8192, (const unsigned char*)qb);
    }
}
struct MoePanels { int ps[9]; };
__device__ __forceinline__ MoePanels moe_panels(Frame& F) {
    MoePanels m; int acc = 0;
#pragma unroll
    for (int e = 0; e < NE; ++e) { m.ps[e] = acc; const int c = (int)__builtin_amdgcn_readfirstlane(__hip_atomic_load(F.ctl + CW_CNT + 64 * e, RLX_AGENT)); acc += (c + 255) >> 8; }
    m.ps[8] = acc; return m;
}
__device__ __forceinline__ void moe_gather_phase(Frame& F, const Params& P) {
    unsigned char* ws = fresh_ws(P.ws);
    const bf16* h = (const bf16*)(ws + WS_H); bf16* Ag = (bf16*)(ws + WS_AG);
    const int* tok_e = (const int*)(ws + WS_ROUTE); const int* tok_slot = tok_e + 2 * NLAT;
    const float* hs = (const float*)(ws + WS_HS); float* ags = (float*)(ws + WS_AGS);
    const MoePanels mp = moe_panels(F);
    const Lane L(F.wave); const int gw = F.vcu * NWAVES + F.wave, NGW = F.G * NWAVES, lane = L.lane;
    for (int a = gw; a < 2 * NLAT; a += NGW) {
        const int r = a >> 1, e = tok_e[a], slot = tok_slot[a];
        int pse = 0;
#pragma unroll
        for (int q = 0; q < NE; ++q) pse = (q == e) ? mp.ps[q] : pse;
        const v4u* src = (const v4u*)((const unsigned char*)h + (size_t)r * D) + lane; v4u* dst = (v4u*)((unsigned char*)Ag + ((size_t)pse * 256 + slot) * D) + lane;
#pragma unroll
        for (int j = 0; j < 2; ++j) dst[64 * j] = src[64 * j];
#if I8_GU
        if (lane == 0) ags[pse * 256 + slot] = hs[r];
#endif
    }
    for (int e = 0; e < NE; ++e) {
        const int c = (int)__builtin_amdgcn_readfirstlane(__hip_atomic_load(F.ctl + CW_CNT + 64 * e, RLX_AGENT));
        const int pad = ((c + 255) & ~255) - c;
        for (int q = gw; q < pad; q += NGW) { v4u* dst = (v4u*)((unsigned char*)Ag + ((size_t)mp.ps[e] * 256 + c + q) * D) + lane;
#pragma unroll
            for (int j = 0; j < 2; ++j) dst[64 * j] = (v4u){0u, 0u, 0u, 0u};
#if I8_GU
            if (lane == 0) ags[mp.ps[e] * 256 + c + q] = 0.f;
#endif
        }
    }
}
__device__ __forceinline__ void final_phase(Frame& F, const Params& P, const float* modl) {
    unsigned char* ws = fresh_ws(P.ws);
    const bf16* xl = (const bf16*)(ws + WS_XL); const bf16* yb = (const bf16*)(ws + WS_AG);
    const int* tok_e = (const int*)(ws + WS_ROUTE); const int* tok_slot = tok_e + 2 * NLAT; const float* tok_p = (const float*)(tok_slot + 2 * NLAT);
    const MoePanels mp = moe_panels(F);
    const Lane L(F.wave); const int gw = F.vcu * NWAVES + F.wave, NGW = F.G * NWAVES, lane = L.lane;
    const float* gf = P.in[I_GFIN];
    for (int r = gw; r < NLAT; r += NGW) {
        const int v = r < SEQ ? 0 : 1; const float* g5 = modl + (size_t)(v * 6 + 5) * D;
        const int e0 = tok_e[2 * r], e1 = tok_e[2 * r + 1];
        int p0s = 0, p1s = 0;
#pragma unroll
        for (int q = 0; q < NE; ++q) { p0s = (q == e0) ? mp.ps[q] : p0s; p1s = (q == e1) ? mp.ps[q] : p1s; }
        const bf16* y0 = yb + ((size_t)p0s * 256 + tok_slot[2 * r]) * D; const bf16* y1 = yb + ((size_t)p1s * 256 + tok_slot[2 * r + 1]) * D;
        const float w0 = tok_p[2 * r], w1 = tok_p[2 * r + 1];
        f32x4 x[8]; float ss = 0.f;
#pragma unroll
        for (int jq = 0; jq < 8; ++jq) { const int c = 4 * lane + 256 * jq;
            const v2u a = *(const v2u*)(y0 + c), bq = *(const v2u*)(y1 + c); const f32x4 g = *(const f32x4*)(g5 + c); const f32x4 xv = ld4_bf16(xl + (size_t)r * D + c);
            f32x4 y; y[0] = w0 * bflo(a.x) + w1 * bflo(bq.x); y[1] = w0 * bfhi(a.x) + w1 * bfhi(bq.x); y[2] = w0 * bflo(a.y) + w1 * bflo(bq.y); y[3] = w0 * bfhi(a.y) + w1 * bfhi(bq.y);
            x[jq] = xv + g * y; ss += (x[jq][0] * x[jq][0] + x[jq][1] * x[jq][1]) + (x[jq][2] * x[jq][2] + x[jq][3] * x[jq][3]); }
        const float rstd = 1.0f / sqrtf(wave_sum(ss) * (1.0f / D) + NORM_EPS);
#pragma unroll
        for (int jq = 0; jq < 8; ++jq) { const int c = 4 * lane + 256 * jq; const f32x4 ov_ = (x[jq] * rstd) * *(const f32x4*)(gf + c); if (FIN_NT) __builtin_nontemporal_store(ov_, (f32x4*)(P.out + (size_t)r * D + c)); else *(f32x4*)(P.out + (size_t)r * D + c) = ov_; }
    }
}
#if DBG == 1
constexpr size_t WS_DBG = 3 * MiB;
__device__ __forceinline__ void dbg_err(Frame& F, int k, float got, float want, float scale) {
    float e = fabsf(got - want) / scale; if (!(e == e)) e = 1e9f;
    atomicMax((unsigned*)(F.ctl + CW_DIAG + 64 * k), __float_as_uint(e));
}
__device__ __forceinline__ unsigned dbg_hash(unsigned x) { x ^= x >> 16; x *= 0x7feb352du; x ^= x >> 15; x *= 0x846ca68bu; x ^= x >> 16; return x; }
__device__ __forceinline__ float block_sum(float v, LAS float* red, int tid) {
    v = wave_sum(v); __syncthreads(); if ((tid & 63) == 0) red[tid >> 6] = v; __syncthreads();
    float s = 0.f; for (int w = 0; w < 8; ++w) s += red[w]; __syncthreads(); return s;
}
__device__ __forceinline__ float block_max(float v, LAS float* red, int tid) {
    v = fmaxf(v, dpp_f(v, 0)); v = fmaxf(v, dpp_f(v, 1)); v = fmaxf(v, dpp_f(v, 2)); v = fmaxf(v, dpp_f(v, 3));
    v = fmaxf(v, __builtin_bit_cast(float, __builtin_amdgcn_ds_swizzle(__builtin_bit_cast(int, v), 0x401F)));
    v = cross_max(v);
    __syncthreads(); if ((tid & 63) == 0) red[tid >> 6] = v; __syncthreads();
    float s = red[0]; for (int w = 1; w < 8; ++w) s = fmaxf(s, red[w]); __syncthreads(); return s;
}
__device__ __forceinline__ const float* dbg_res_row(const Params& P, int layer, int r) {
    const float* xl = (const float*)(fresh_ws(P.ws) + WS_XL);
    if (layer == 0) return r < NLAT ? P.in[I_X] + (size_t)r * D : P.in[I_CTX] + (size_t)(r - NLAT) * D;
    return xl + (size_t)r * D;
}
__device__ __forceinline__ int dbg_vec(int r) { return r < SEQ ? 0 : (r < NLAT ? 1 : 2); }

__device__ __forceinline__ void dbg_check_norm(Frame& F, const Params& P, int layer) {
    const int tid = fresh_tid(F.wave); LAS float* hn = (LAS float*)F.lds; LAS float* red = hn + D;
    const float* modl = (const float*)(fresh_ws(P.ws) + WS_MOD) + (size_t)layer * 3 * 12288;
    { const float t1 = block_sum(1.0f, red, tid), t2 = block_sum((float)tid, red, tid), t3 = wave_sum((float)(tid & 63));
      dbg_err(F, 2, t1, 512.0f, 1.0f); dbg_err(F, 3, t2, 130816.0f, 1.0f); dbg_err(F, 4, t3, 2016.0f, 1.0f); }
    for (int s = F.vcu; s < 256; s += F.G) {
        const unsigned hsh = dbg_hash(s * 2654435761u + 17u + layer);
        const int r = (s & 7) == 7 ? NLAT + (hsh % NCTX) : (int)(hsh % NLAT);
        const float* xr = dbg_res_row(P, layer, r); const int v = dbg_vec(r);
        float ss = 0.f; for (int k = tid; k < D; k += 512) ss += xr[k] * xr[k];
        ss = block_sum(ss, red, tid); const float rstd = 1.0f / sqrtf(ss / D + NORM_EPS);
        const bf16* hr = (const bf16*)(fresh_ws(P.ws) + WS_H) + (size_t)r * D;
        for (int k = tid; k < D; k += 512) { const float want = (xr[k] * rstd * P.in[I_GMIX][layer * D + k]) * (1.0f + modl[(v * 6 + 1) * D + k]) + modl[(v * 6 + 0) * D + k]; dbg_err(F, 0, bf2f(hr[k]), want, 1.0f); }
        const int v2 = s % 3, j = (int)((hsh >> 5) % 12288);
        float a = 0.f; for (int k = tid; k < D; k += 512) { const float c = v2 < 2 ? P.in[I_C][v2 * D + k] : P.in[I_CCTX][k]; a += c / (1.0f + expf(-c)) * P.in[I_WMOD][((size_t)layer * D + k) * 12288 + j]; }
        a = block_sum(a, red, tid);
        if (tid == 0) dbg_err(F, 1, modl[v2 * 12288 + j], a + P.in[I_BMOD][layer * 12288 + j], 1.0f);
        __syncthreads();
    }
}
__device__ __forceinline__ void dbg_check_inproj(Frame& F, const Params& P, int layer) {
    const int tid = fresh_tid(F.wave); LAS float* hn = (LAS float*)F.lds; LAS float* red = hn + D;
    const float* modl = (const float*)(fresh_ws(P.ws) + WS_MOD) + (size_t)layer * 3 * 12288;
    for (int s = F.vcu; s < 256; s += F.G) {
        const unsigned hsh = dbg_hash(s * 2654435761u + 17u + layer);
        const int r = (s & 7) == 7 ? NLAT + (hsh % NCTX) : (int)(hsh % NLAT);
        int c = (int)((hsh >> 8) % IN_COLS); if ((s & 3) == 1) c = COL_Q + (int)((hsh >> 8) % 1024); if ((s & 3) == 2) c = COL_K + (int)((hsh >> 8) % 1024); if ((s & 15) == 3) c = COL_DT + (int)((hsh >> 8) % 16);
        const float* xr = dbg_res_row(P, layer, r); const int v = dbg_vec(r);
        float ss = 0.f; for (int k = tid; k < D; k += 512) ss += xr[k] * xr[k];
        ss = block_sum(ss, red, tid); const float rstd = 1.0f / sqrtf(ss / D + NORM_EPS);
        for (int k = tid; k < D; k += 512) hn[k] = (xr[k] * rstd * P.in[I_GMIX][layer * D + k]) * (1.0f + modl[(v * 6 + 1) * D + k]) + modl[(v * 6 + 0) * D + k];
        __syncthreads();
        const float* w = P.in[I_WIN] + (size_t)layer * D * IN_COLS;
        const bool qk = (c >= COL_Q && c < COL_Q + 1024) || (c >= COL_K && c < COL_K + 1024);
        int cp = c; if (qk) { const int base = c >= COL_K ? COL_K : COL_Q; const int cl = (c - base) & 31; cp = c - cl + ((cl + 16) & 31); }
        float d0 = 0.f, d1 = 0.f; for (int k = tid; k < D; k += 512) { d0 += hn[k] * w[(size_t)k * IN_COLS + c]; d1 += hn[k] * w[(size_t)k * IN_COLS + cp]; }
        d0 = block_sum(d0, red, tid); d1 = block_sum(d1, red, tid);
        if (tid == 0) {
            float want = d0, got;
            if (c < COL_Z) got = bf2f(((const bf16*)(fresh_ws(P.ws) + WS_CONV))[(size_t)r * 1536 + c]);
            else if (c < COL_Q) got = bf2f(((const bf16*)(fresh_ws(P.ws) + WS_Z))[(size_t)r * 512 + c - COL_Z]);
            else if (c < COL_XBC) got = 0.f;
            else if (c < COL_DT) got = bf2f(((const bf16*)(fresh_ws(P.ws) + WS_XBC))[(size_t)r * 1024 + c - COL_XBC]);
            else if (c < COL_K) got = ((const float*)(fresh_ws(P.ws) + WS_DT))[(size_t)r * 16 + c - COL_DT];
            else if (c < COL_V) got = 0.f;
            else { const size_t kr = r < NLAT ? (size_t)(r / SEQ) * KVLEN + CTXL + (r % SEQ) : (size_t)((r - NLAT) / CTXL) * KVLEN + (r - NLAT) % CTXL; got = bf2f(((const bf16*)(fresh_ws(P.ws) + WS_VB))[kr * 1024 + c - COL_V]); }
            if (qk) {
                const int base = c >= COL_K ? COL_K : COL_Q; const int cc = c - base, cl = cc & 31, seg = (cc >> 5) & 1, f = cl & 15;
                if (r < NLAT) { const int t = r % SEQ; const float pos = seg ? (float)(t % 64) : (float)(t / 64); const float inv = powf(10000.0f, -(float)f / 16.0f); const float ang = pos * inv;
                    want = cl < 16 ? d0 * cosf(ang) - d1 * sinf(ang) : d0 * cosf(ang) + d1 * sinf(ang); }
                const int mem = (cc & ~31) + pg8::perm32(cl);
                if (base == COL_Q) got = bf2f(((const bf16*)(fresh_ws(P.ws) + WS_Q))[(size_t)r * 1024 + mem]);
                else { const size_t kr = r < NLAT ? (size_t)(r / SEQ) * KVLEN + CTXL + (r % SEQ) : (size_t)((r - NLAT) / CTXL) * KVLEN + (r - NLAT) % CTXL; got = bf2f(((const bf16*)(fresh_ws(P.ws) + WS_KB))[kr * 1024 + mem]); }
            }
            { const int seg = ((c - (c >= COL_K ? COL_K : COL_Q)) >> 5) & 1; const int slot = (r < NLAT ? 0 : 3) + (qk ? 1 + seg : 0); dbg_err(F, slot, got, want, 1.0f); }
        }
        __syncthreads();
    }
}
__device__ __forceinline__ void dbg_check_attn(Frame& F, const Params& P, int layer) {
    const int tid = fresh_tid(F.wave); LAS float* sc1 = (LAS float*)F.lds; LAS float* sc2 = sc1 + KVLEN; LAS float* red = sc2 + KVLEN; LAS float* ov = red + 16; LAS float* qv = ov + 512;
    const bf16* qb = (const bf16*)(fresh_ws(P.ws) + WS_Q); const bf16* kb = (const bf16*)(fresh_ws(P.ws) + WS_KB); const bf16* vb = (const bf16*)(fresh_ws(P.ws) + WS_VB); const bf16* cat = (const bf16*)(fresh_ws(P.ws) + WS_CAT);
    const float lam_init = 0.8f - 0.6f * expf(-0.3f * (float)layer); const float* lv = P.in[I_LAMBDA] + layer * 256;
    float d1 = 0.f, d2 = 0.f; for (int i = 0; i < 64; ++i) { d1 += lv[i] * lv[64 + i]; d2 += lv[128 + i] * lv[192 + i]; }
    const float lam = expf(d1) - expf(d2) + lam_init;
    for (int s = F.vcu; s < 64; s += F.G) {
        const unsigned hsh = dbg_hash(s * 2654435761u + 99u + layer);
        const bool isctx = layer == 0 && (s & 7) == 7; const int h = (hsh >> 4) & 7;
        const int r = isctx ? NLAT + (int)(hsh % NCTX) : (int)((hsh >> 7) % NLAT);
        const int b = isctx ? (r - NLAT) / CTXL : r / SEQ; const int nk = isctx ? CTXL : KVLEN;
        if (tid < 128) qv[tid] = bf2f(qb[(size_t)r * 1024 + h * 128 + tid]);
        __syncthreads();
        float m1 = -1e30f, m2 = -1e30f;
        for (int k = tid; k < nk; k += 512) { const bf16* kr = kb + ((size_t)b * KVLEN + k) * 1024 + h * 128; float a = 0.f, c2 = 0.f;
            for (int d = 0; d < 64; ++d) { a += qv[d] * bf2f(kr[d]); c2 += qv[64 + d] * bf2f(kr[64 + d]); }
            a *= 0.125f; c2 *= 0.125f; sc1[k] = a; sc2[k] = c2; m1 = fmaxf(m1, a); m2 = fmaxf(m2, c2); }
        m1 = block_max(m1, red, tid); m2 = block_max(m2, red, tid);
        float l1 = 0.f, l2 = 0.f;
        for (int k = tid; k < nk; k += 512) { const float p1 = expf(sc1[k] - m1), p2 = expf(sc2[k] - m2); sc1[k] = p1; sc2[k] = p2; l1 += p1; l2 += p2; }
        l1 = block_sum(l1, red, tid); l2 = block_sum(l2, red, tid);
        { const int d = tid & 127, part = tid >> 7; float o = 0.f;
          for (int k = part; k < nk; k += 4) o += (sc1[k] / l1 - lam * sc2[k] / l2) * bf2f(vb[((size_t)b * KVLEN + k) * 1024 + h * 128 + d]);
          ov[tid] = o; }
        __syncthreads();
        float o = 0.f, sq = 0.f; if (tid < 128) { o = ov[tid] + ov[128 + tid] + ov[256 + tid] + ov[384 + tid]; sq = o * o; }
        sq = block_sum(sq, red, tid);
        if (tid < 128) { const float want = o / sqrtf(sq / 128.0f + NORM_EPS) * P.in[I_SUBLN][layer * 128 + tid] * (1.0f - lam_init);
            dbg_err(F, 1, bf2f(cat[(size_t)r * D + 1024 + h * 128 + tid]), want, 1.0f); }
        __syncthreads();
    }
}
__device__ __forceinline__ void dbg_expect_rows(Frame& F, const Params& P, int layer, int which) {
    const int tid = fresh_tid(F.wave); LAS float* hn = (LAS float*)F.lds; LAS float* act = hn + D; LAS float* red = act + FFD;
    const float* modl = (const float*)(fresh_ws(P.ws) + WS_MOD) + (size_t)layer * 3 * 12288; float* ex = (float*)(fresh_ws(P.ws) + WS_DBG) + (size_t)which * 16 * D;
    for (int s = F.vcu; s < 16; s += F.G) {
        const unsigned hsh = dbg_hash(s * 2654435761u + 7u + which * 131u + layer);
        const int r = (s & 7) == 7 && layer == 0 ? NLAT + (int)(hsh % NCTX) : (int)(hsh % NLAT); const int v = dbg_vec(r);
        if (which == 0) {
            const bf16* cr = (const bf16*)(fresh_ws(P.ws) + WS_CAT) + (size_t)r * D; const float* w = P.in[I_WOUT] + (size_t)layer * D * D; const float* res = dbg_res_row(P, layer, r);
            for (int k = tid; k < D; k += 512) hn[k] = bf2f(cr[k]);
            __syncthreads();
            for (int c = tid; c < D; c += 512) { float a = 0.f; for (int k = 0; k < D; ++k) a += hn[k] * w[(size_t)k * D + c]; ex[s * D + c] = res[c] + modl[(v * 6 + 2) * D + c] * a; }
        } else {
            const float* xr = (const float*)(fresh_ws(P.ws) + WS_XL) + (size_t)r * D;
            float ss = 0.f; for (int k = tid; k < D; k += 512) ss += xr[k] * xr[k];
            ss = block_sum(ss, red, tid); const float rstd = 1.0f / sqrtf(ss / D + NORM_EPS);
            for (int k = tid; k < D; k += 512) hn[k] = (xr[k] * rstd * P.in[I_GFFN][layer * D + k]) * (1.0f + modl[(v * 6 + 4) * D + k]) + modl[(v * 6 + 3) * D + k];
            __syncthreads();
            for (int j = tid; j < FFD; j += 512) { float g = 0.f, u = 0.f; for (int k = 0; k < D; ++k) { g += hn[k] * P.in[I_FG][(size_t)k * FFD + j]; u += hn[k] * P.in[I_FU][(size_t)k * FFD + j]; } act[j] = g / (1.0f + expf(-g)) * u; }
            __syncthreads();
            { float* ex2 = (float*)(fresh_ws(P.ws) + WS_DBG + 256 * 1024) + (size_t)s * 7680; for (int k = tid; k < D; k += 512) ex2[k] = hn[k]; for (int j = tid; j < FFD; j += 512) ex2[D + j] = act[j]; }
            for (int c = tid; c < D; c += 512) { float a = 0.f; for (int j = 0; j < FFD; ++j) a += act[j] * P.in[I_FD][(size_t)j * D + c]; ex[s * D + c] = xr[c] + modl[(v * 6 + 5) * D + c] * a; }
        }
        __syncthreads();
    }
}
__device__ __forceinline__ void dbg_compare_rows(Frame& F, const Params& P, int layer, int which) {
    const int tid = fresh_tid(F.wave); const float* ex = (const float*)(fresh_ws(P.ws) + WS_DBG) + (size_t)which * 16 * D;
    for (int s = F.vcu; s < 16; s += F.G) {
        const unsigned hsh = dbg_hash(s * 2654435761u + 7u + which * 131u + layer);
        const int r = (s & 7) == 7 && layer == 0 ? NLAT + (int)(hsh % NCTX) : (int)(hsh % NLAT);
        const float* xr = (const float*)(fresh_ws(P.ws) + WS_XL) + (size_t)r * D;
        for (int c = tid; c < D; c += 512) dbg_err(F, 2 + which, xr[c], ex[s * D + c], 1.0f);
        if (which == 1) { const float* ex2 = (const float*)(fresh_ws(P.ws) + WS_DBG + 256 * 1024) + (size_t)s * 7680;
            const bf16* hr = (const bf16*)(fresh_ws(P.ws) + WS_H) + (size_t)r * D; const bf16* ar = (const bf16*)(fresh_ws(P.ws) + WS_ACT) + (size_t)r * FFD;
            for (int k = tid; k < D; k += 512) dbg_err(F, 0, bf2f(hr[k]), ex2[k], 1.0f);
            for (int j = tid; j < FFD; j += 512) dbg_err(F, 1, bf2f(ar[j]), ex2[D + j], 1.0f); }
    }
}
__device__ __forceinline__ void dbg_check_moe(Frame& F, const Params& P) {
    const int tid = fresh_tid(F.wave); LAS float* hn = (LAS float*)F.lds; LAS float* act = hn + D; LAS float* yv = act + FFE; LAS float* red = yv + D; LAS float* lg = red + 16;
    const float* modl = (const float*)(fresh_ws(P.ws) + WS_MOD) + (size_t)1 * 3 * 12288;
    for (int s = F.vcu; s < 16; s += F.G) {
        const unsigned hsh = dbg_hash(s * 2654435761u + 1234u); const int r = (int)(hsh % NLAT), v = dbg_vec(r);
        const float* xr = (const float*)(fresh_ws(P.ws) + WS_XL) + (size_t)r * D;
        float ss = 0.f; for (int k = tid; k < D; k += 512) ss += xr[k] * xr[k];
        ss = block_sum(ss, red, tid); const float rstd = 1.0f / sqrtf(ss / D + NORM_EPS);
        for (int k = tid; k < D; k += 512) { hn[k] = (xr[k] * rstd * P.in[I_GFFN][D + k]) * (1.0f + modl[(v * 6 + 4) * D + k]) + modl[(v * 6 + 3) * D + k]; yv[k] = 0.f; }
        __syncthreads();
        for (int e = 0; e < NE; ++e) { float a = 0.f; for (int k = tid; k < D; k += 512) a += hn[k] * P.in[I_RW][k * NE + e]; a = block_sum(a, red, tid); if (tid == 0) lg[e] = a + P.in[I_RB][e]; }
        __syncthreads();
        int i0 = 0; for (int e = 1; e < NE; ++e) if (lg[e] > lg[i0]) i0 = e;
        int i1 = -1; for (int e = 0; e < NE; ++e) if (e != i0 && (i1 < 0 || lg[e] > lg[i1])) i1 = e;
        const float p0 = 1.0f / (1.0f + expf(lg[i1] - lg[i0])), p1 = 1.0f - p0;
        for (int kk = 0; kk < 2; ++kk) {
            const int e = kk ? i1 : i0; const float pe = kk ? p1 : p0;
            const float* wg = P.in[I_MG] + (size_t)e * D * FFE; const float* wu = P.in[I_MU] + (size_t)e * D * FFE; const float* wd = P.in[I_MD] + (size_t)e * FFE * D;
            for (int j = tid; j < FFE; j += 512) { float g = 0.f, u = 0.f; for (int k = 0; k < D; ++k) { g += hn[k] * wg[(size_t)k * FFE + j]; u += hn[k] * wu[(size_t)k * FFE + j]; } act[j] = g / (1.0f + expf(-g)) * u; }
            __syncthreads();
            for (int c = tid; c < D; c += 512) { float a = 0.f; for (int j = 0; j < FFE; ++j) a += act[j] * wd[(size_t)j * D + c]; yv[c] += pe * a; }
            __syncthreads();
        }
        float q = 0.f; for (int c = tid; c < D; c += 512) { const float o = xr[c] + modl[(v * 6 + 5) * D + c] * yv[c]; yv[c] = o; q += o * o; }
        q = block_sum(q, red, tid); const float rs = 1.0f / sqrtf(q / D + NORM_EPS);
        for (int c = tid; c < D; c += 512) dbg_err(F, 4, P.out[(size_t)r * D + c], yv[c] * rs * P.in[I_GFIN][c], 1.0f);
        if (tid == 0) { const int* te = (const int*)(fresh_ws(P.ws) + WS_ROUTE); const float* tp = (const float*)(te + 4 * NLAT);
            const bool close = fabsf(lg[i1] - lg[i0]) < 1e-3f;
            if (!close) { dbg_err(F, 5, (float)te[2 * r], (float)i0, 1.0f); dbg_err(F, 5, tp[2 * r], p0, 1.0f); } }
        __syncthreads();
    }
}
__device__ __forceinline__ void dbg_report(Frame& F, const Params& P) {
    const int tid = fresh_tid(F.wave);
    for (size_t i = (size_t)F.vcu * 512 + tid; i < (size_t)NLAT * D; i += (size_t)F.G * 512) P.out[i] = 0.f;
    if (F.vcu == 0 && tid == 0) {
#if DBG_REPORT >= 0
        const float e = __uint_as_float(__hip_atomic_load(F.ctl + CW_DIAG + 64 * DBG_REPORT, RLX_AGENT));
        int bucket = 0; { float t = e * 1024.0f; while (t >= 2.0f && bucket < 60) { t *= 0.5f; ++bucket; } }
        P.out[0] = 1000.0f * (float)(10 + bucket);
#else
        const float thr[6] = {0.06f, 0.06f, 0.08f, 0.08f, 0.06f, 0.06f}; int mask = 0;
        for (int k = 0; k < 6; ++k) { const float e = __uint_as_float(__hip_atomic_load(F.ctl + CW_DIAG + 64 * k, RLX_AGENT)); if (e > thr[k]) mask |= 1 << k; }
        P.out[0] = 1000.0f * (float)(10 + mask);
#endif
    }
}
#endif
#ifndef EN_PRO
#define EN_PRO 1
#endif
#ifndef EN_NORM
#define EN_NORM 1
#endif
#ifndef EN_GIN
#define EN_GIN 1
#endif
#ifndef EN_CONV
#define EN_CONV 1
#endif
#ifndef EN_S1
#define EN_S1 1
#endif
#ifndef EN_S2
#define EN_S2 1
#endif
#ifndef EN_S3
#define EN_S3 1
#endif
#ifndef EN_ATT
#define EN_ATT 1
#endif
#ifndef EN_WOUT
#define EN_WOUT 1
#endif
#ifndef EN_GU
#define EN_GU 1
#endif
#ifndef EN_DN
#define EN_DN 1
#endif
#ifndef EN_ROUTE
#define EN_ROUTE 1
#endif
#ifndef EN_GATH
#define EN_GATH 1
#endif
#ifndef EN_MGU
#define EN_MGU 1
#endif
#ifndef EN_MDN
#define EN_MDN 1
#endif
#ifndef EN_FIN
#define EN_FIN 1
#endif
__global__ void __launch_bounds__(NWAVES * 64, 2) fwd_kernel(Params P) {
    extern __shared__ __attribute__((aligned(16))) unsigned char lds[];
    Frame F;
    F.lds = (LAS unsigned char*)lds;
    F.MISC = (volatile LAS unsigned*)(F.lds + MISC_OFF);
    F.wave = __builtin_amdgcn_readfirstlane(threadIdx.x >> 6);
    F.G = gridDim.x; { const int bx = blockIdx.x; F.vcu = (F.G % 8 == 0) ? (bx % 8) * (F.G / 8) + bx / 8 : bx; }
    unsigned char* ws = P.ws;
    F.ctl = (gu32*)(ws + WS_CTL);
    for (int u = threadIdx.x; u < (LDS_BYTES - LDSCTL_OFF) / 4; u += NWAVES * 64) ((LAS unsigned*)(F.lds + LDSCTL_OFF))[u] = 0u;
    __syncthreads();
    XcdBarrier bar = xcd_barrier_post((unsigned*)(ws + WS_CTL) + CW_BAR, F.MISC + 8);
#if DBG == 2
    unsigned long long* tsb = (unsigned long long*)(ws + WS_ROUTE + 512 * 1024); int nst = 0;
#define STAMP() do { if (blockIdx.x == 0 && threadIdx.x == 0) tsb[nst] = __builtin_amdgcn_s_memrealtime(); ++nst; } while (0)
    STAMP();
#else
#define STAMP() do {} while (0)
#endif
#if SIMPLE_BAR
    unsigned nbar = 0;
#define GRID_BAR() do { ++nbar; simple_barrier((unsigned*)(ws + WS_CTL) + 2048, nbar * (unsigned)gridDim.x); } while (0)
#else
#define GRID_BAR() do { xcd_barrier(bar); STAMP(); } while (0)
#endif

    bf16* xl = (bf16*)(ws + WS_XL); bf16* hb = (bf16*)(ws + WS_H); bf16* cat = (bf16*)(ws + WS_CAT);
    const float* mod = (const float*)(ws + WS_MOD);
    int* tok_e = (int*)(ws + WS_ROUTE); int* tok_slot = tok_e + 2 * NLAT; float* tok_p = (float*)(tok_slot + 2 * NLAT);

#if DUP_BAR
    for (int i_ = 0; i_ < DUP_BAR; ++i_) GRID_BAR();
#endif
#if EN_PRO
    p0_prologue(F, P);
#if DUP_PRO
    __syncthreads(); if (NOSTORE_PROBE) { if (threadIdx.x == 0) g_nostore = 1; __syncthreads(); } p0_prologue(F, P); if (NOSTORE_PROBE) { __syncthreads(); if (threadIdx.x == 0) g_nostore = 0; __syncthreads(); }
#endif
#endif
    GRID_BAR();

    constexpr int G0 = 256, RM_A = ((T / 256) * (NIN / 256)) % G0, RM_B = (NCH * NB * 8) % G0, RM_C = ((T / 256) * (2 * FFD / 256)) % G0;
    constexpr int CAP_T = (IPW_T > 0) ? (G0 - 32) * NWAVES * IPW_T + 24 * NWAVES * (IPW_T - 1) : 0;
    constexpr int DP_A0 = 0, DP_B0 = DP_A0 + (G0 - RM_A) * NWAVES * IPW_G, DP_T0 = DP_B0 + (G0 - RM_B) * NWAVES * IPW_S, DP_C0 = DP_T0 + CAP_T, DP_A1 = DP_C0 + (G0 - RM_C) * NWAVES * IPW_G,
                  DP_B1 = DP_A1 + (G0 - RM_A) * NWAVES * IPW_G, DP_END = DP_B1 + (G0 - RM_B) * NWAVES * IPW_S;
    static_assert(DP_A1 >= CV_IN + CV_OUT, "layer 1's w_in / w_out must be converted during layer 0");
    const bool slots = DEFER && (F.G == G0);
#define TAIL_SLOT(rem, myidx, ipw, dpos) do { if (slots && (myidx) >= (rem)) deferred_slot(F, P, (dpos), (myidx) - (rem), G0 - (rem), (ipw)); } while (0)
    for (int layer = 0; layer < 2; ++layer) {
        ws = fresh_ws(P.ws); F.wave = fresh_s(F.wave); F.vcu = fresh_s(F.vcu); F.G = fresh_s(F.G);
        const float* modl = mod + (size_t)layer * 3 * 12288;
        const void* resLat = layer == 0 ? (const void*)P.in[I_X] : (const void*)xl; const void* resCtx = layer == 0 ? (const void*)P.in[I_CTX] : (const void*)(xl + (size_t)NLAT * D);
#if EN_NORM
        if (layer == 0) norm_phase<false, I8_IN ? 2 : 0, false, false>(F, resLat, resCtx, P.in[I_GMIX] + layer * D, modl, 0, 1, hb, T, nullptr, nullptr, nullptr, nullptr, nullptr, nullptr, 11, nullptr, nullptr, (float*)(ws + WS_HS));
        else norm_phase<false, I8_IN ? 2 : 0, true, true>(F, resLat, resCtx, P.in[I_GMIX] + layer * D, modl, 0, 1, hb, T, nullptr, nullptr, nullptr, nullptr, nullptr,
                          (const float*)(ws + WS_PART), 11, mod + (size_t)(2 * 6 + 5) * D, nullptr, (float*)(ws + WS_HS));
#if DUP_SMALL & 16
        norm_phase<false>(F, resLat, resCtx, P.in[I_GMIX] + layer * D, modl, 0, 1, hb, T, nullptr, nullptr, nullptr, nullptr, nullptr);
#endif
#endif
        GRID_BAR();
#if DBG == 1
        if ((DBG_MASK & 32) && layer == DBG_L) { dbg_check_norm(F, P, layer); }
#endif
        {
            pg8::PlainSched S; S.init(T / 256, NIN / 256, F.G, (int)blockIdx.x); S.A = (const char*)hb; S.Bt = (const char*)(ws + WS_WIN + layer * SZ_WIN); S.tstep = (size_t)256 * D * (I8_IN ? 1 : 2);
            pg8::EpiIn E{(bf16*)(ws + WS_CONV), (bf16*)(ws + WS_Z), (bf16*)(ws + WS_Q), (bf16*)(ws + WS_XBC), (bf16*)(ws + WS_KB), (bf16*)(ws + WS_VB), (float*)(ws + WS_DT),
                         (const float*)(ws + WS_ROPE), (const float*)(ws + WS_ROPE) + 192 * 16, ws + WS_K8, ws + WS_V8};
            if (V8_DIRECT) { S.swap_from = 20; S.swap_to = 24; }
#if EN_GIN && I8_IN
#if DUP_GIN
            pg8::gemm_phase<pg8::EpiIn, pg8::PlainSched, true, true, 2>(F.lds + RING_OFF, D / 2, S, E, F.wave, DUP_GIN == 2 ? 8 : 0, 0, 0, (const float*)(ws + WS_HS), (const float*)(ws + WS_CS) + CS_WIN + layer * 6400); __syncthreads();
#endif
            pg8::gemm_phase<pg8::EpiIn, pg8::PlainSched, true, true, 2>(F.lds + RING_OFF, D / 2, S, E, F.wave, 0, 0, 0, (const float*)(ws + WS_HS), (const float*)(ws + WS_CS) + CS_WIN + layer * 6400);
            TAIL_SLOT(RM_A, (int)blockIdx.x, IPW_G, layer ? DP_A1 : DP_A0);
#elif EN_GIN
            pg8::gemm_phase<pg8::EpiIn, pg8::PlainSched, true, true>(F.lds + RING_OFF, D, S, E, F.wave);
#if DUP_GIN
            __syncthreads(); pg8::gemm_phase<pg8::EpiIn, pg8::PlainSched, true, true>(F.lds + RING_OFF, D, S, E, F.wave);
#endif
#endif
        }
        GRID_BAR();
#if DBG == 1
        if ((DBG_MASK & 1) && layer == DBG_L) { dbg_check_inproj(F, P, layer); }
#endif
#if EN_CONV
        conv_phase(F, (const bf16*)(ws + WS_CONV), (const bf16*)(ws + WS_XBC), cat, (bf16*)(ws + WS_XBCC), P.in[I_CONVW] + layer * 1536, P.in[I_SCONVW] + layer * 3072, P.in[I_SCONVB] + layer * 1024);
#if ATT_FP8 && ATT_DMA && !V8_DIRECT
        v8_phase(F, P);
#endif
#if DUP_SMALL & 8
        conv_phase(F, (const bf16*)(ws + WS_CONV), (const bf16*)(ws + WS_XBC), cat, (bf16*)(ws + WS_XBCC), P.in[I_CONVW] + layer * 1536, P.in[I_SCONVW] + layer * 3072, P.in[I_SCONVB] + layer * 1024);
#endif
#endif
        GRID_BAR();
#if EN_S1
#if DUP_S1V
        ssd_local_phase<DUP_S1V>(F, P, layer);
#endif
        ssd_local_phase(F, P, layer);
        TAIL_SLOT(RM_B, F.vcu, IPW_S, layer ? DP_B1 : DP_B0);
#if DUP_SMALL & 1
        ssd_local_phase(F, P, layer);
#endif
#endif
        GRID_BAR();
#if EN_S2
        ssd_scan_phase(F, P);
#if DUP_SMALL & 2
        ssd_scan_phase(F, P);
#endif
#endif
        GRID_BAR();
#if EN_S3
        ssd_out_phase(F, P, layer);
#if DUP_SMALL & 4
        ssd_out_phase(F, P, layer);
#endif
#endif
#if EN_ATT
        attn_phase<0>(F, P, layer, layer == 0, lds);
        if (IPW_T > 0 && slots && layer == 0) {
            if (F.vcu >= 32) deferred_slot(F, P, DP_T0, F.vcu - 32, G0 - 32, IPW_T);
            else if (F.vcu >= 8 && IPW_T > 1) deferred_slot(F, P, DP_T0 + (G0 - 32) * NWAVES * IPW_T, F.vcu - 8, 24, IPW_T - 1);
        }
#if DUP_ATT
        attn_phase<DUP_ATT - 1>(F, P, layer, layer == 0, lds);
#endif
#endif
        GRID_BAR();
#if DBG == 1
        if (layer == DBG_L) { if (DBG_MASK & 2) dbg_check_attn(F, P, layer); if (DBG_MASK & 4) dbg_expect_rows(F, P, layer, 0); GRID_BAR(); }
#endif
        {
            pg8::PlainSched S; S.init(NLAT / 256, D / 256, F.G, (int)blockIdx.x); S.A = (const char*)cat; S.Bt = (const char*)(ws + WS_WOUT + layer * SZ_WOUT); S.tstep = (size_t)256 * D * 2;
#if EN_WOUT
            if (layer == 0) { pg8::EpiResidT<false> E{resLat, resCtx, xl, modl + 2 * D}; pg8::gemm_phase<pg8::EpiResidT<false>, pg8::PlainSched, true, true>(F.lds + RING_OFF, D, S, E, F.wave); }
            else { pg8::EpiResidT<true> E{resLat, resCtx, xl, modl + 2 * D}; pg8::gemm_phase<pg8::EpiResidT<true>, pg8::PlainSched, true, true>(F.lds + RING_OFF, D, S, E, F.wave); }
            if (layer == 0) {
                __syncthreads();
                pg8::CtxSplitSched C; C.nN = D / 256; C.nS = 8; C.G = F.G; C.c = (int)blockIdx.x; C.A = (const char*)cat; C.Bt = S.Bt; C.tstep = S.tstep; C.kslice = (size_t)(D / 8) * 2;
                pg8::EpiPartial EP{(float*)(ws + WS_PART)};
                pg8::gemm_phase<pg8::EpiPartial, pg8::CtxSplitSched, true, true>(F.lds + RING_OFF, D, C, EP, F.wave, D / 8 / 64);
            }
#endif
        }
        GRID_BAR();
#if DBG == 1
        if ((DBG_MASK & 4) && layer == DBG_L) { dbg_compare_rows(F, P, layer, 0); }
        if ((DBG_MASK & 8) && layer == 0) { dbg_expect_rows(F, P, layer, 1); GRID_BAR(); }
#endif
        if (layer == 0) {
            norm_phase<false, I8_GU ? 2 : 1, true, false>(F, xl, P.in[I_CTX], P.in[I_GFFN], modl, 3, 4, hb, T, nullptr, nullptr, nullptr, nullptr, nullptr,
                              (const float*)(ws + WS_PART), 8, modl + (size_t)(2 * 6 + 2) * D, xl, (float*)(ws + WS_HS));
            GRID_BAR();
            {
                pg8::PlainSched S; S.init(T / 256, 2 * FFD / 256, F.G, (int)blockIdx.x); S.A = (const char*)hb; S.Bt = (const char*)(ws + WS_WGU); S.tstep = (size_t)256 * D;
                pg8::EpiSwiGLU8 E{ws + WS_ACT, FFD};
#if EN_GU
#if I8_GU
                pg8::gemm_phase<pg8::EpiSwiGLU8, pg8::PlainSched, true, true, 2>(F.lds + RING_OFF, D / 2, S, E, F.wave, 0, 0, 0, (const float*)(ws + WS_HS), (const float*)(ws + WS_CS) + CS_WGU);
                TAIL_SLOT(RM_C, (int)blockIdx.x, IPW_G, DP_C0);
#else
                pg8::gemm_phase<pg8::EpiSwiGLU8, pg8::PlainSched, true, true, true>(F.lds + RING_OFF, D / 2, S, E, F.wave, 0, W8_SC8, 0x7F7F7F7F);
#endif
#endif
            }
            GRID_BAR();
            {
                pg8::PlainSched S; S.init(NLAT / 256, D / 256, F.G, (int)blockIdx.x); S.A = (const char*)(ws + WS_ACT); S.Bt = (const char*)(ws + WS_WDN); S.tstep = (size_t)256 * FFD;
                pg8::EpiResidT<true> E{xl, xl + (size_t)NLAT * D, xl, modl + 5 * D};
#if EN_DN
                pg8::gemm_phase<pg8::EpiResidT<true>, pg8::PlainSched, true, true, true>(F.lds + RING_OFF, FFD / 2, S, E, F.wave, 0, W8_SC8, pg8::ACT_SC8);
#if !NO_DNSPLIT
                {
                    __syncthreads();
                    pg8::CtxSplitSched C; C.nN = D / 256; C.nS = 11; C.G = F.G; C.c = (int)blockIdx.x; C.A = S.A; C.Bt = S.Bt; C.tstep = S.tstep; C.kslice = (size_t)512;
                    pg8::EpiPartial EP{(float*)(ws + WS_PART)};
                    pg8::gemm_phase<pg8::EpiPartial, pg8::CtxSplitSched, true, true, true>(F.lds + RING_OFF, FFD / 2, C, EP, F.wave, 4, W8_SC8, pg8::ACT_SC8);
                }
#endif
#endif
            }
            GRID_BAR();
#if DBG == 1
            if (DBG_MASK & 8) dbg_compare_rows(F, P, layer, 1);
#endif
        } else {
#if EN_ROUTE
#if MOE_SPARSE
            norm_phase<true, 2, true, true>(F, xl, xl + (size_t)NLAT * D, P.in[I_GFFN] + D, modl, 3, 4, (bf16*)(ws + WS_AG), NLAT, P.in[I_RW], P.in[I_RB], tok_e, tok_slot, tok_p, nullptr, 0, nullptr, nullptr, (float*)(ws + WS_AGS2));
            if (slots) deferred_rest(F, P, DP_END);
#else
            norm_phase<true, I8_GU ? 2 : 1, true, true>(F, xl, xl + (size_t)NLAT * D, P.in[I_GFFN] + D, modl, 3, 4, hb, NLAT, P.in[I_RW], P.in[I_RB], tok_e, tok_slot, tok_p, nullptr, 0, nullptr, nullptr, (float*)(ws + WS_HS));
#endif
#endif
            GRID_BAR();
#if !MOE_SPARSE
#if EN_GATH
            moe_gather_phase(F, P);
#endif
#if DEFER
            if (slots) { __syncthreads(); deferred_rest(F, P, DP_END); }
#endif
            GRID_BAR();
#endif
            {
                const MoePanels mp = moe_panels(F);
                pg8::MoeSched S; S.init(mp.ps[8], 2 * FFE / 256, F.G, (int)blockIdx.x); S.A = (const char*)(ws + WS_AG); S.Bt = (const char*)(ws + WS_MGU); S.tstep = (size_t)256 * D; S.estride = SZ_MGU / 2; S.erows = 2 * FFE; S.sparse = MOE_SPARSE; S.caprows = NLAT;
                S.ps1 = mp.ps[1]; S.ps2 = mp.ps[2]; S.ps3 = mp.ps[3]; S.ps4 = mp.ps[4]; S.ps5 = mp.ps[5]; S.ps6 = mp.ps[6]; S.ps7 = mp.ps[7];
                pg8::EpiSwiGLU8 E{ws + WS_MACT, FFE};
#if EN_MGU
#if I8_GU
                pg8::gemm_phase<pg8::EpiSwiGLU8, pg8::MoeSched, true, true, 2>(F.lds + RING_OFF, D / 2, S, E, F.wave, 0, 0, 0, (const float*)(ws + (MOE_SPARSE ? WS_AGS2 : WS_AGS)), (const float*)(ws + WS_CS) + CS_MGU);
#else
                pg8::gemm_phase<pg8::EpiSwiGLU8, pg8::MoeSched, true, true, true>(F.lds + RING_OFF, D / 2, S, E, F.wave, 0, W8_SC8, 0x7F7F7F7F);
#endif
#endif
            }
            GRID_BAR();
            {
                const MoePanels mp = moe_panels(F);
                pg8::MoeSched S; S.init(mp.ps[8], D / 256, F.G, (int)blockIdx.x); S.A = (const char*)(ws + WS_MACT); S.Bt = (const char*)(ws + WS_MDN); S.tstep = (size_t)256 * FFE; S.estride = SZ_MDN / 2; S.erows = D; S.sparse = 0; S.caprows = 0;
                S.ps1 = mp.ps[1]; S.ps2 = mp.ps[2]; S.ps3 = mp.ps[3]; S.ps4 = mp.ps[4]; S.ps5 = mp.ps[5]; S.ps6 = mp.ps[6]; S.ps7 = mp.ps[7];
                pg8::EpiBf16 E{(bf16*)(ws + WS_AG), D};
#if EN_MDN
                pg8::gemm_phase<pg8::EpiBf16, pg8::MoeSched, true, true, true>(F.lds + RING_OFF, FFE / 2, S, E, F.wave, 0, W8_SC8, pg8::ACT_SC8);
#endif
            }
            GRID_BAR();
#if EN_FIN
            final_phase(F, P, modl);
#if DUP_FIN
            final_phase(F, P, modl);
#endif
#endif
#if PROBE
            {
                typedef int v8i_ __attribute__((ext_vector_type(8)));
                const int role = (F.wave < 4) ? (PROBE == 1 || PROBE == 2 || PROBE == 4 ? 1 : (PROBE == 3 ? 2 : 0)) : (PROBE == 1 ? 1 : (PROBE == 2 || PROBE == 3 || PROBE == 5 ? 2 : 0));
                f32x16 c0 = {}, c1 = {}, c2 = {}, c3 = {}; v8i_ a = {0x38383838, 0x38383838, 0x38383838, 0x38383838, 0x38383838, 0x38383838, 0x38383838, 0x38383838};
                float x0 = 1.0f, x1 = 2.0f, x2 = 3.0f, x3 = 4.0f;
                for (int it = 0; it < 2000; ++it) {
                    if (role == 1) {
#pragma unroll
                        for (int q = 0; q < 2; ++q) {
                            c0 = __builtin_amdgcn_mfma_scale_f32_32x32x64_f8f6f4(a, a, c0, 0, 0, 0, 0x7F7F7F7F, 0, 0x7F7F7F7F); c1 = __builtin_amdgcn_mfma_scale_f32_32x32x64_f8f6f4(a, a, c1, 0, 0, 0, 0x7F7F7F7F, 0, 0x7F7F7F7F);
                            c2 = __builtin_amdgcn_mfma_scale_f32_32x32x64_f8f6f4(a, a, c2, 0, 0, 0, 0x7F7F7F7F, 0, 0x7F7F7F7F); c3 = __builtin_amdgcn_mfma_scale_f32_32x32x64_f8f6f4(a, a, c3, 0, 0, 0, 0x7F7F7F7F, 0, 0x7F7F7F7F); }
                    } else if (role == 2) {
#pragma unroll
                        for (int q = 0; q < 32; ++q) asm volatile("v_fma_f32 %0, %0, %0, %0\n\tv_fma_f32 %1, %1, %1, %1\n\tv_fma_f32 %2, %2, %2, %2\n\tv_fma_f32 %3, %3, %3, %3" : "+v"(x0), "+v"(x1), "+v"(x2), "+v"(x3));
                    }
                }
                asm volatile("" :: "v"(c0), "v"(c1), "v"(c2), "v"(c3), "v"(x0), "v"(x1), "v"(x2), "v"(x3));
            }
#endif
#if DBG == 1
            GRID_BAR(); if (DBG_MASK & 16) dbg_check_moe(F, P); GRID_BAR(); dbg_report(F, P);
#endif
#if DBG == 2
            GRID_BAR();
            { const int tid = fresh_tid(F.wave);
              for (size_t i = (size_t)F.vcu * 512 + tid; i < (size_t)NLAT * D; i += (size_t)F.G * 512) P.out[i] = 0.f;
              __syncthreads(); GRID_BAR();
              float A = 0.f, B = 0.f;
              for (int i = 0; i + 1 < nst - 1; ++i) { const float d = (float)(tsb[i + 1] - tsb[i]) * 0.01f; if ((TSEL_A >> i) & 1ull) A += d; if ((TSEL_B >> i) & 1ull) B += d; }
              for (size_t i = (size_t)F.vcu * 512 + tid; i < 1000001; i += (size_t)F.G * 512) P.out[i] = i == 0 ? A : 10.0f * B; }
#endif
        }
    }
}

extern "C" void kernel_launch(void* const* d_in, const int* in_sizes, int n_in, void* d_out, int out_size, void* d_ws, size_t ws_size, hipStream_t stream) {
    static int grid = 0;
    if (grid == 0) {
        if (n_in != 28 || in_sizes[0] != NLAT * D || out_size != NLAT * D || ws_size < WS_END) {
            fprintf(stderr, "kernel_launch: built for 28 inputs, x/out of %d floats, >= %zu bytes of workspace; got n_in %d, in0 %d, out %d, ws %zu; nothing launched\n", NLAT * D, (size_t)WS_END, n_in, n_in > 0 ? in_sizes[0] : -1, out_size, ws_size);
            grid = -1; return; }
        int dev = 0, cus = 0, per_cu = 0;
        if (hipGetDevice(&dev) != hipSuccess || hipDeviceGetAttribute(&cus, hipDeviceAttributeMultiprocessorCount, dev) != hipSuccess) { fprintf(stderr, "kernel_launch: device query failed\n"); grid = -1; return; }
        if (hipFuncSetAttribute((const void*)fwd_kernel, hipFuncAttributeMaxDynamicSharedMemorySize, LDS_BYTES) != hipSuccess) { fprintf(stderr, "kernel_launch: hipFuncSetAttribute failed\n"); grid = -1; return; }
        if (hipOccupancyMaxActiveBlocksPerMultiprocessor(&per_cu, (const void*)fwd_kernel, NWAVES * 64, LDS_BYTES) != hipSuccess || per_cu < 1)
            fprintf(stderr, "kernel_launch: note: occupancy query reports %d workgroups per CU\n", per_cu);
        (void)hipGetLastError();
        grid = cus;
    }
    if (grid < 0) return;
    if (hipMemsetAsync((char*)d_ws + WS_CTL, 0, CTL_ZERO_BYTES, stream) != hipSuccess) { fprintf(stderr, "kernel_launch: memset failed\n"); return; }
    Params p{};
    for (int i = 0; i < 28; ++i) p.in[i] = (const float*)d_in[i];
    p.out = (float*)d_out; p.ws = (unsigned char*)d_ws;
    hipLaunchKernelGGL(fwd_kernel, dim3(grid), dim3(NWAVES * 64), LDS_BYTES, stream, p);
    const hipError_t le = hipPeekAtLastError();
    if (le != hipSuccess) fprintf(stderr, "kernel_launch: launch failed: %s\n", hipGetErrorName(le));
}
```

```cpp
#define CONV_U 1
#define S2_DEPTH 22
#ifndef DBG
#define DBG 0
#endif
#ifndef DBG_L
#define DBG_L 0
#endif
#ifndef DBG_REPORT
#define DBG_REPORT -1
#endif
#ifndef DBG_MASK
#define DBG_MASK 31
#endif
#ifndef SIMPLE_BAR
#define SIMPLE_BAR 0
#endif
#ifndef TSEL_A
#define TSEL_A 1ull
#endif
#ifndef TSEL_B
#define TSEL_B 0ull
#endif
#ifndef DUP_ATT
#define DUP_ATT 0
#endif
#ifndef DUP_GIN
#define DUP_GIN 0
#endif
#ifndef DUP_PRO
#define DUP_PRO 0
#endif
#ifndef ATT_PVPF
#define ATT_PVPF 1
#endif
#ifndef DUP_SMALL
#define DUP_SMALL 0
#endif
#ifndef ATT_NEGM
#define ATT_NEGM 1
#endif
#ifndef ATT_NOSWAP
#define ATT_NOSWAP 1
#endif
#ifndef ATT_LMFMA
#define ATT_LMFMA 0
#endif
#ifndef ATT_DMA
#define ATT_DMA 1
#endif
#ifndef ATT_FP8
#define ATT_FP8 1
#endif
#ifndef NO_DNSPLIT
#define NO_DNSPLIT 0
#endif
#ifndef ATT_QK8
#define ATT_QK8 1
#endif

#ifndef I8_CLIP
#define I8_CLIP 4.0f
#endif

#ifndef I8_IN
#define I8_IN 1
#endif
#ifndef I8_GU
#define I8_GU 1
#endif

#ifndef I8DBG
#define I8DBG 0
#endif

#ifndef ATT_PVX
#define ATT_PVX 1
#endif
#ifndef PVX_MASK
#define PVX_MASK 0x400
#endif

#ifndef ATT_Y8
#define ATT_Y8 1
#endif
#ifndef Y8_C
#define Y8_C 0.0f
#endif

#ifndef ATT_LEAD
#define ATT_LEAD 5
#endif

#ifndef ATT_STAG
#define ATT_STAG 0
#endif

#ifndef ATT_BAR2
#define ATT_BAR2 1
#endif

#ifndef DUP_MODV
#define DUP_MODV 0
#endif

#ifndef ITEM_NBFAST
#define ITEM_NBFAST 1
#endif

#ifndef DUP_BAR
#define DUP_BAR 0
#endif

#ifndef DUP_S1V
#define DUP_S1V 0
#endif

#ifndef S1_NT
#define S1_NT 0
#endif

#ifndef S1_LDSST
#define S1_LDSST 0
#endif

#ifndef ATT_PRIO
#define ATT_PRIO 0
#endif

#ifndef ATT_AB
#define ATT_AB 0
#endif

#ifndef PROBE
#define PROBE 0
#endif

#ifndef ATT_KPF
#define ATT_KPF 0
#endif

#ifndef ATT_P2
#define ATT_P2 0
#endif

#ifndef P2_KPF
#define P2_KPF 0
#endif
#ifndef P2_VPF
#define P2_VPF 0
#endif

#ifndef P2_AB
#define P2_AB 1
#endif

#ifndef TAIL2
#define TAIL2 0
#endif

#ifndef DEFER
#define DEFER 1
#endif
#ifndef IPW_G
#define IPW_G 6
#endif
#ifndef IPW_S
#define IPW_S 3
#endif

#ifndef IPW_T
#define IPW_T 0
#endif

#ifndef MOE_SPARSE
#define MOE_SPARSE 1
#endif

#ifndef NOSTORE_PROBE
#define NOSTORE_PROBE 0
#endif

#ifndef FIN_NT
#define FIN_NT 0
#endif

#ifndef DUP_FIN
#define DUP_FIN 0
#endif

#ifndef K8_DIRECT
#define K8_DIRECT 1
#endif

#ifndef Q8_DIRECT
#define Q8_DIRECT 0
#endif

#ifndef PERM_OUT
#define PERM_OUT 1
#endif

#ifndef SB16
#define SB16 1
#endif

#ifndef YD16
#define YD16 0
#endif

#ifndef CV_PAIR
#define CV_PAIR 0
#endif

#ifndef V8_DIRECT
#define V8_DIRECT 1
#endif

#ifndef V8_NOSWAP
#define V8_NOSWAP 0
#endif

#ifndef S1_PF
#define S1_PF 0
#endif

#ifndef S2_DEPTH
#define S2_DEPTH 6
#endif

#ifndef CONV_U
#define CONV_U 0
#endif

#ifndef PART16
#define PART16 1
#endif
#include <hip/hip_runtime.h>
#include <cstdio>
#include <cstdint>

#define GAS __attribute__((address_space(1)))
#define LAS __attribute__((address_space(3)))
typedef unsigned short bf16;
typedef unsigned v4u __attribute__((ext_vector_type(4)));
typedef unsigned v2u __attribute__((ext_vector_type(2)));
typedef float f32x4 __attribute__((ext_vector_type(4)));
typedef float f32x2 __attribute__((ext_vector_type(2)));
typedef float f32x16 __attribute__((ext_vector_type(16)));
typedef short bf16x8 __attribute__((ext_vector_type(8)));
typedef short s16x4 __attribute__((ext_vector_type(4)));
typedef GAS unsigned gu32;
#define RLX_AGENT __ATOMIC_RELAXED, __HIP_MEMORY_SCOPE_AGENT
#define LDS_WAIT() asm volatile("s_waitcnt lgkmcnt(0)" ::: "memory")
#define VM_WAIT() asm volatile("s_waitcnt vmcnt(0)" ::: "memory")

constexpr int D = 2048, NB = 2, SEQ = 8192, CTXL = 256;
constexpr int NLAT = NB * SEQ, NCTX = NB * CTXL, T = NLAT + NCTX;
constexpr int KVLEN = CTXL + SEQ;
constexpr int IN_COLS = 6160, NIN = 6400;
constexpr int COL_Z = 1536, COL_Q = 2048, COL_XBC = 3072, COL_DT = 4096, COL_K = 4112, COL_V = 5136;
constexpr int FFD = 5632, FFE = 2816, NE = 8;
constexpr int NCH = 66;
constexpr float NORM_EPS = 1e-6f;
constexpr int NWAVES = 8;

constexpr size_t MiB = 1u << 20;
constexpr size_t WS_CTL = 0, CTL_ZERO_BYTES = 1 * MiB;
constexpr size_t WS_MOD = 1 * MiB;
constexpr size_t WS_ROPE = WS_MOD + 512 * 1024;
constexpr size_t WS_TOT = WS_ROPE + 64 * 1024;
constexpr size_t WS_ROUTE = 2 * MiB;
constexpr size_t WS_HS = 2 * MiB + 512 * 1024;
constexpr size_t WS_AGS = WS_HS + 256 * 1024;
constexpr size_t WS_AGS2 = 3 * MiB + 512 * 1024;
constexpr size_t WS_CS = 3 * MiB;
constexpr size_t CS_WIN = 0, CS_WGU = 2 * 6400, CS_MGU = CS_WGU + 11264;
constexpr size_t WS_W = 4 * MiB;
constexpr size_t SZ_WIN = (size_t)NIN * D * 2, SZ_WOUT = (size_t)D * D * 2, SZ_WGU = (size_t)2 * FFD * D * 2, SZ_WDN = (size_t)D * FFD * 2;
constexpr size_t SZ_MGU = (size_t)2 * FFE * D * 2, SZ_MDN = (size_t)D * FFE * 2;
constexpr size_t WS_WIN = WS_W, WS_WOUT = WS_WIN + 2 * SZ_WIN, WS_WGU = WS_WOUT + 2 * SZ_WOUT, WS_WDN = WS_WGU + SZ_WGU, WS_MGU = WS_WDN + SZ_WDN, WS_MDN = WS_MGU + NE * SZ_MGU;
constexpr size_t WS_XL = WS_MDN + NE * SZ_MDN;
constexpr size_t WS_H = WS_XL + (size_t)T * D * 4;
constexpr size_t WS_CAT = WS_H + (size_t)T * D * 2;
constexpr size_t WS_TMP = WS_CAT + (size_t)T * D * 2;
constexpr size_t WS_CONV = WS_TMP;
constexpr size_t WS_Z = WS_CONV + (size_t)T * 1536 * 2;
constexpr size_t WS_Q = WS_Z + (size_t)T * 512 * 2;
constexpr size_t WS_XBC = WS_Q + (size_t)T * 1024 * 2;
constexpr size_t WS_KB = WS_XBC + (size_t)T * 1024 * 2;
constexpr size_t WS_VB = WS_KB + (size_t)T * 1024 * 2;
constexpr size_t WS_DT = WS_VB + (size_t)T * 1024 * 2;
constexpr size_t WS_XBCC = WS_DT + (size_t)T * 16 * 4;
constexpr size_t WS_YD = WS_XBCC + (size_t)T * 1024 * 2;
constexpr size_t WS_CUM = WS_YD + (size_t)T * 512 * 4;
constexpr size_t WS_SB = WS_CUM + (size_t)T * 16 * 4;
constexpr size_t WS_HP = WS_SB + (size_t)32 * NCH * 8192 * 4;
constexpr size_t WS_TMP_END_MIX = WS_HP + (size_t)32 * NCH * 8192 * 2;
constexpr size_t WS_ACT = WS_TMP;
constexpr int MOE_MAXROWS = 2 * NLAT + NE * 256;
constexpr size_t WS_AG = WS_TMP;
#if MOE_SPARSE
constexpr size_t WS_MACT = WS_AG + (size_t)NE * NLAT * D;
constexpr size_t WS_TMP_END_MOE = WS_MACT + (size_t)MOE_MAXROWS * FFE;
#else
constexpr size_t WS_MACT = WS_AG + (size_t)MOE_MAXROWS * D * 2;
constexpr size_t WS_TMP_END_MOE = WS_MACT + (size_t)MOE_MAXROWS * FFE * 2;
#endif
constexpr size_t WS_PART = WS_TMP + 200 * MiB;
constexpr size_t WS_V8 = (WS_TMP_END_MIX > WS_TMP_END_MOE ? WS_TMP_END_MIX : WS_TMP_END_MOE);
constexpr size_t WS_K8 = WS_V8 + (size_t)NB * (KVLEN / 64) * 8 * 8192;
constexpr size_t WS_END = WS_K8 + (size_t)NB * (KVLEN / 64) * 8 * 8192;
static_assert(WS_PART + (size_t)11 * NCTX * D * 4 <= WS_V8 && WS_PART >= WS_ACT + (size_t)T * FFD * 2, "partials");
static_assert(WS_ACT + (size_t)T * FFD * 2 <= WS_END, "act fits");
constexpr int CW_TMO = 0, CW_CODE = 1;
constexpr int CW_BAR = 4096;
constexpr int CW_CNT = 8192;
constexpr int CW_DIAG = 12288;

constexpr int RING_OFF = 0, RING_BYTES = 131072;
constexpr int LDSCTL_OFF = RING_BYTES, MISC_OFF = LDSCTL_OFF + 320;
constexpr int LDS_BYTES = 147456;

__device__ __forceinline__ unsigned f2bf(float f) { unsigned u = __builtin_bit_cast(unsigned, f); return (u + 0x7fffu + ((u >> 16) & 1u)) >> 16; }
__device__ __forceinline__ unsigned pk2(float lo, float hi) { return f2bf(lo) | (f2bf(hi) << 16); }
__device__ __forceinline__ unsigned cvtpk(float lo, float hi) { unsigned r; asm volatile("v_cvt_pk_bf16_f32 %0, %1, %2" : "=v"(r) : "v"(lo), "v"(hi)); return r; }
__device__ __forceinline__ float bf2f(unsigned short b) { return __builtin_bit_cast(float, ((unsigned)b) << 16); }
__device__ __forceinline__ float bflo(unsigned w) { return __builtin_bit_cast(float, w << 16); }
__device__ __forceinline__ float bfhi(unsigned w) { return __builtin_bit_cast(float, w & 0xffff0000u); }
__device__ __forceinline__ float fast_exp(float x) { return __builtin_amdgcn_exp2f(x * 1.4426950408889634f); }
__device__ __forceinline__ float silu_f(float x) { return x * __builtin_amdgcn_rcpf(1.0f + fast_exp(-x)); }
__device__ __forceinline__ float dpp_f(float v, const int ctrl_sel) {
    int r;
    switch (ctrl_sel) {
        case 0: r = __builtin_amdgcn_update_dpp(0, __builtin_bit_cast(int, v), 0xB1, 0xF, 0xF, true); break;
        case 1: r = __builtin_amdgcn_update_dpp(0, __builtin_bit_cast(int, v), 0x4E, 0xF, 0xF, true); break;
        case 2: r = __builtin_amdgcn_update_dpp(0, __builtin_bit_cast(int, v), 0x141, 0xF, 0xF, true); break;
        default: r = __builtin_amdgcn_update_dpp(0, __builtin_bit_cast(int, v), 0x140, 0xF, 0xF, true); break;
    }
    return __builtin_bit_cast(float, r);
}
__device__ __forceinline__ float half_sum(float v) {
    v += dpp_f(v, 0); v += dpp_f(v, 1); v += dpp_f(v, 2); v += dpp_f(v, 3);
    v += __builtin_bit_cast(float, __builtin_amdgcn_ds_swizzle(__builtin_bit_cast(int, v), 0x401F));
    return v;
}
__device__ __forceinline__ void swap32u(unsigned& a, unsigned& b) {
    asm volatile("s_nop 1\n\tv_permlane32_swap_b32 %0, %1\n\ts_nop 1" : "+v"(a), "+v"(b));
}
__device__ __forceinline__ void swap32(float v, float& x, float& y) {
    unsigned a = __builtin_bit_cast(unsigned, v), b = a; swap32u(a, b);
    x = __builtin_bit_cast(float, a); y = __builtin_bit_cast(float, b);
}
__device__ __forceinline__ float wave_sum(float v) {
    v = half_sum(v);
    float x, y; swap32(v, x, y); return x + y;
}
__device__ __forceinline__ f32x4 ld4_f32(const float* p) { return *(const f32x4*)p; }
__device__ __forceinline__ f32x4 ld4_bf16(const unsigned short* p) { const v2u w = *(const v2u*)p; f32x4 r; r[0] = bflo(w.x); r[1] = bfhi(w.x); r[2] = bflo(w.y); r[3] = bfhi(w.y); return r; }
__device__ __forceinline__ void st4_bf16(unsigned short* p, const f32x4& v) { v2u w; w.x = cvtpk(v[0], v[1]); w.y = cvtpk(v[2], v[3]); *(v2u*)p = w; }
__device__ __forceinline__ float wave_max(float v) {
    v = fmaxf(v, dpp_f(v, 0)); v = fmaxf(v, dpp_f(v, 1)); v = fmaxf(v, dpp_f(v, 2)); v = fmaxf(v, dpp_f(v, 3));
    v = fmaxf(v, __builtin_bit_cast(float, __builtin_amdgcn_ds_swizzle(__builtin_bit_cast(int, v), 0x401F)));
    float x, y; swap32(v, x, y); return fmaxf(x, y);
}
__device__ __forceinline__ unsigned pk_i8(float a, float b, float c, float d) {
    const float M = 12582912.0f;
    const unsigned ua = __builtin_bit_cast(unsigned, a + M), ub = __builtin_bit_cast(unsigned, b + M), uc = __builtin_bit_cast(unsigned, c + M), ud = __builtin_bit_cast(unsigned, d + M);
    return __builtin_amdgcn_perm(ub, ua, 0x0c0c0400u) | (__builtin_amdgcn_perm(ud, uc, 0x0c0c0400u) << 16);
}
__device__ __forceinline__ float cross_max(float v) { float x, y; swap32(v, x, y); return fmaxf(x, y); }
__device__ __forceinline__ float cross_sum(float v) { float x, y; swap32(v, x, y); return x + y; }

__device__ __forceinline__ int lane_id() { int l; asm volatile("v_mbcnt_lo_u32_b32 %0, -1, 0\n\tv_mbcnt_hi_u32_b32 %0, -1, %0" : "=v"(l)); return l; }
__device__ __forceinline__ int fresh_tid(int wave) { return wave * 64 + lane_id(); }
__device__ __forceinline__ int fresh_s(int v) { asm volatile("" : "+s"(v)); return v; }
__device__ __forceinline__ unsigned char* fresh_ws(unsigned char* p) { unsigned z = 0; asm volatile("" : "+s"(z)); return p + z; }
#define XB_TMO      128
#define XB_XCNT(j)  (256  + 64 * (j))
#define XB_XSUB(j)  (1280 + 64 * (j))
#define XB_XGEN(j)  (2304 + 64 * (j))
#define XB_TOP      3328
#define XB_TOPGEN   3392
#define XCD_BAR_WORDS 3456
#define XB_SPIN_CAP (1u << 22)

__device__ __forceinline__ unsigned xb_ld(unsigned* p)              { return __hip_atomic_load(p, __ATOMIC_RELAXED, __HIP_MEMORY_SCOPE_AGENT); }
__device__ __forceinline__ unsigned xb_add(unsigned* p, unsigned v) { return __hip_atomic_fetch_add(p, v, __ATOMIC_RELAXED, __HIP_MEMORY_SCOPE_AGENT); }
__device__ __forceinline__ unsigned xb_xcc_id() { return (unsigned)__builtin_amdgcn_s_getreg((3 << 11) | 20) & 0xFu; }
#define XB_SPIN(cond, bar) do { unsigned _sp = 0; while (cond) { __builtin_amdgcn_s_sleep(1); \
    if ((++_sp & 255u) == 0u) { if (xb_ld(&(bar)[XB_TMO])) break; if (_sp > XB_SPIN_CAP) { atomicAdd(&(bar)[XB_TMO], 1u); break; } } } } while (0)

struct XcdBarrier { unsigned* bar; unsigned x; volatile LAS unsigned* st; int wave; };

__device__ __forceinline__ XcdBarrier xcd_barrier_post(unsigned* bar, volatile LAS unsigned* st) {
    XcdBarrier b; b.bar = bar; b.x = xb_xcc_id(); b.st = st; b.wave = __builtin_amdgcn_readfirstlane(threadIdx.x >> 6);
    if (threadIdx.x == 0) (void)xb_add(&bar[XB_XCNT(b.x)], 1u);
    return b;
}
__device__ __forceinline__ void xcd_barrier_complete(unsigned* bar, unsigned x, unsigned& nloc, unsigned& nx) {
    const unsigned G = gridDim.x * gridDim.y * gridDim.z;
    unsigned sum, cnt, mine, sp = 0u;
    for (;;) {
        sum = 0u; cnt = 0u; mine = 0u;
#pragma unroll
        for (unsigned j = 0; j < 16; ++j) { const unsigned c = xb_ld(&bar[XB_XCNT(j)]); sum += c; cnt += (c > 0u) ? 1u : 0u; mine = (j == x) ? c : mine; }
        if (sum == G) break;
        __builtin_amdgcn_s_sleep(1);
        if ((++sp & 255u) == 0u) { if (xb_ld(&bar[XB_TMO])) break; if (sp > XB_SPIN_CAP) { atomicAdd(&bar[XB_TMO], 1u); break; } }
    }
    nloc = mine > 0u ? mine : 1u; nx = cnt > 0u ? cnt : 1u;
}
__device__ __forceinline__ void xcd_barrier(const XcdBarrier& b) {
    asm volatile("s_waitcnt vmcnt(0)" ::: "memory");
    __syncthreads();
    if (b.wave == 0 && lane_id() == 0) {
        unsigned* bar = b.bar;
        const unsigned bx = xb_xcc_id();
        __builtin_amdgcn_s_waitcnt(0);
        unsigned nloc = b.st[0], nx = b.st[1];
        if (nloc == 0u) { xcd_barrier_complete(bar, bx, nloc, nx); b.st[0] = nloc; b.st[1] = nx; }
        const unsigned old = xb_add(&bar[XB_XSUB(bx)], 1u);
        const unsigned gen = old / nloc;
        if (old + 1u == (gen + 1u) * nloc) {
            __builtin_amdgcn_fence(__ATOMIC_RELEASE, "agent");
            asm volatile("s_waitcnt vmcnt(0)" ::: "memory");
            const unsigned og = xb_add(&bar[XB_TOP], 1u);
            const unsigned tg = og / nx;
            if (og + 1u == (tg + 1u) * nx) xb_add(&bar[XB_TOPGEN], 1u);
            else XB_SPIN(xb_ld(&bar[XB_TOPGEN]) == tg, bar);
            __builtin_amdgcn_fence(__ATOMIC_ACQUIRE, "agent");
            xb_add(&bar[XB_XGEN(bx)], 1u);
            asm volatile("s_waitcnt vmcnt(0)" ::: "memory");
        } else {
            XB_SPIN(xb_ld(&bar[XB_XGEN(bx)]) == gen, bar);
            __builtin_amdgcn_fence(__ATOMIC_ACQUIRE, "agent");
            asm volatile("s_waitcnt vmcnt(0)" ::: "memory");
        }
    }
    __syncthreads();
}

#if SIMPLE_BAR
__device__ __forceinline__ void simple_barrier(unsigned* cnt, unsigned target) {
    asm volatile("s_waitcnt vmcnt(0)" ::: "memory");
    __syncthreads();
    if (threadIdx.x == 0) {
        __threadfence();
        asm volatile("s_waitcnt vmcnt(0)" ::: "memory");
        __hip_atomic_fetch_add(cnt, 1u, __ATOMIC_RELAXED, __HIP_MEMORY_SCOPE_AGENT);
        unsigned sp = 0;
        while (__hip_atomic_load(cnt, __ATOMIC_RELAXED, __HIP_MEMORY_SCOPE_AGENT) < target) { __builtin_amdgcn_s_sleep(2); if (++sp > (1u << 24)) break; }
        __threadfence();
        asm volatile("s_waitcnt vmcnt(0)" ::: "memory");
    }
    __syncthreads();
}
#endif
namespace pg8 {
constexpr int BM = 256, BK = 64, HALF = 128, HTB = HALF * BK * 2, STAGE_BYTES = 8 * HTB, NXCD = 8, WGM = 8;
__host__ __device__ __forceinline__ int lds_byte(int r, int c) { const int st = (r >> 4) * 2 + (c >> 5), rr = r & 15, cc = c & 31, ob = rr * 64 + cc * 2; return st * 1024 + (ob ^ (((ob >> 9) & 1) << 5)); }
__host__ __device__ __forceinline__ void stage_rc(int b, int& R, int& C) { const int st = b / 1024, sb = b % 1024, swz = sb ^ (((sb >> 9) & 1) << 5); R = (st >> 1) * 16 + swz / 64; C = (st & 1) * 32 + (swz % 64) / 2; }
__host__ __device__ __forceinline__ int perm32(int rho) { const int n = rho >> 4, i = rho & 15; return 8 * (i >> 2) + 4 * n + (i & 3); }

struct Unit { int pm, pn, ks, half; };
struct OrderBase {
    int nM, nN, nwg, G, c;
    __device__ void init(int nM_, int nN_, int G_, int c_) { nM = nM_; nN = nN_; nwg = nM * nN; G = G_; c = c_; }
    __device__ bool next(int i, Unit& u) const {
        long L = (long)i * G + c; u.half = 0;
#if TAIL2
        { const int R = nwg / G, rem = nwg - R * G;
          if (rem > 0 && 2 * rem <= G && i >= R) { if (i > R || c >= 2 * rem) return false; L = (long)R * G + (c >> 1); u.half = 1 + (c & 1); } }
#endif
        if (L >= nwg) return false;
        int wgid = (int)L; { const int q = nwg / NXCD, r = nwg % NXCD, xcd = wgid % NXCD, off = wgid / NXCD; wgid = (xcd < r ? xcd * (q + 1) : r * (q + 1) + (xcd - r) * q) + off; }
        const int nig = WGM * nN, gid = wgid / nig, fm = gid * WGM, gsz = (nM - fm) < WGM ? (nM - fm) : WGM;
        u.pm = fm + ((wgid % nig) % gsz); u.pn = (wgid % nig) / gsz; u.ks = 0; return true;
    }
};
struct PlainSched : OrderBase {
    const char* A; const char* Bt; size_t tstep; int swap_from = 1 << 30, swap_to = 0;
    __device__ __forceinline__ bool swapped(const Unit& u) const { return u.pn >= swap_from && u.pn < swap_to; }
    __device__ __forceinline__ const char* abase(const Unit& u) const { return swapped(u) ? Bt + (size_t)u.pn * tstep : A + (size_t)u.pm * tstep; }
    __device__ __forceinline__ const char* bbase(const Unit& u) const { return swapped(u) ? A + (size_t)u.pm * tstep : Bt + (size_t)u.pn * tstep; }
    __device__ __forceinline__ int brow(const Unit& u) const { return u.pn * 256; }
    __device__ __forceinline__ int arow(const Unit& u) const { return u.pm * 256; }
};
struct MoeSched : OrderBase {
    const char* A; const char* Bt; size_t tstep, estride; int ps1, ps2, ps3, ps4, ps5, ps6, ps7, erows;
    __device__ __forceinline__ int expert(int pm) const { return (pm >= ps1) + (pm >= ps2) + (pm >= ps3) + (pm >= ps4) + (pm >= ps5) + (pm >= ps6) + (pm >= ps7); }
    __device__ __forceinline__ bool swapped(const Unit&) const { return false; }
    int sparse, caprows;
    __device__ __forceinline__ int pstart(int pm) const { int p0 = 0; p0 = pm >= ps1 ? ps1 : p0; p0 = pm >= ps2 ? ps2 : p0; p0 = pm >= ps3 ? ps3 : p0; p0 = pm >= ps4 ? ps4 : p0; p0 = pm >= ps5 ? ps5 : p0; p0 = pm >= ps6 ? ps6 : p0; p0 = pm >= ps7 ? ps7 : p0; return p0; }
    __device__ __forceinline__ int arow(const Unit& u) const { return sparse ? expert(u.pm) * caprows + (u.pm - pstart(u.pm)) * 256 : u.pm * 256; }
    __device__ __forceinline__ const char* abase(const Unit& u) const { return A + (size_t)arow(u) * (tstep >> 8); }
    __device__ __forceinline__ const char* bbase(const Unit& u) const { return Bt + (size_t)expert(u.pm) * estride + (size_t)u.pn * tstep; }
    __device__ __forceinline__ int brow(const Unit& u) const { return expert(u.pm) * erows + u.pn * 256; }
};

struct CtxSplitSched {
    int nN, nS, G, c; const char* A; const char* Bt; size_t tstep; size_t kslice;
    __device__ bool next(int i, Unit& u) const { const int L = i * G + c; if (L >= 2 * nN * nS) return false; u.pm = 64 + (L & 1); u.pn = (L >> 1) % nN; u.ks = (L >> 1) / nN; u.half = 0; return true; }
    __device__ __forceinline__ const char* abase(const Unit& u) const { return A + (size_t)u.pm * tstep + (size_t)u.ks * kslice; }
    __device__ __forceinline__ const char* bbase(const Unit& u) const { return Bt + (size_t)u.pn * tstep + (size_t)u.ks * kslice; }
    __device__ __forceinline__ int brow(const Unit& u) const { return u.pn * 256; }
    __device__ __forceinline__ int arow(const Unit& u) const { return u.pm * 256; }
    __device__ __forceinline__ bool swapped(const Unit&) const { return false; }
};
template <class Epi, class Sched, bool ALIGN_EPI, bool SP2, int MODE = 0>
__device__ __forceinline__ void gemm_phase(LAS unsigned char* lds, const int K, const Sched& S, const Epi& E, const int wave, const int ktiles = 0, const int sc_w = 0x7F7F7F7F, const int sc_a = 0x7F7F7F7F,
                                           const float* rs = nullptr, const float* cs = nullptr) {
    constexpr bool F8 = (MODE == 1), I8 = (MODE == 2);
    const int tid = fresh_tid(wave); const int wid = __builtin_amdgcn_readfirstlane(tid >> 6), lane = tid & 63, wr = wid >> 2, wc = wid & 3, fr = lane & 15, fq = lane >> 4;
    const int nt = ktiles ? ktiles : K / BK;
    unsigned voffA[2];
#pragma unroll
    for (int i = 0; i < 2; ++i) { int R, C; stage_rc(tid * 16 + i * 8192, R, C); voffA[i] = (unsigned)(R * K + C) * 2u; }
#define voffB voffA
    const size_t kstep = (size_t)(BK * 2);
    const size_t hstep = (size_t)HALF * K * 2;
    const unsigned ldsw = (unsigned)wid * 1024u;
    const int aoff = lds_byte(wr * 64 + fr, fq * 8), boff = lds_byte(wc * 32 + fr, fq * 8);
#define PG8_SA(b, h) (((b) * 2 + (h)) * HTB)
#define PG8_SB(b, h) ((4 + (b) * 2 + (h)) * HTB)
#define PG8_STAGE(bufoff, gbase, voff) do { _Pragma("unroll") for (int _i = 0; _i < 2; ++_i) \
        __builtin_amdgcn_global_load_lds((const unsigned*)((const char*)(gbase) + (voff)[_i]), (LAS unsigned*)(lds + (bufoff) + ldsw + _i * 8192), 16, 0, 0); } while (0)
#define PG8_LDA(dst, b, h) do { if constexpr (F8) { _Pragma("unroll") for (int m = 0; m < 4; ++m) { \
            const v4i_ lo_ = *(const LAS v4i_*)(lds + PG8_SA(b, h) + aoff + m * 2048), hi_ = *(const LAS v4i_*)(lds + PG8_SA(b, h) + aoff + m * 2048 + 1024); \
            dst##8[m] = __builtin_shufflevector(lo_, hi_, 0, 1, 2, 3, 4, 5, 6, 7); } } \
        else { _Pragma("unroll") for (int m = 0; m < 4; ++m) _Pragma("unroll") for (int k = 0; k < 2; ++k) dst[m][k] = *(const LAS bf16x8*)(lds + PG8_SA(b, h) + aoff + m * 2048 + k * 1024); } } while (0)
#define PG8_LDB(dst, b, h) do { if constexpr (F8) { _Pragma("unroll") for (int n = 0; n < 2; ++n) { \
            const v4i_ lo_ = *(const LAS v4i_*)(lds + PG8_SB(b, h) + boff + n * 2048), hi_ = *(const LAS v4i_*)(lds + PG8_SB(b, h) + boff + n * 2048 + 1024); \
            dst##8[n] = __builtin_shufflevector(lo_, hi_, 0, 1, 2, 3, 4, 5, 6, 7); } } \
        else { _Pragma("unroll") for (int n = 0; n < 2; ++n) _Pragma("unroll") for (int k = 0; k < 2; ++k) dst[n][k] = *(const LAS bf16x8*)(lds + PG8_SB(b, h) + boff + n * 2048 + k * 1024); } } while (0)
#define PG8_MMA(ai, bj, At, Bt) do { __builtin_amdgcn_s_setprio(1); \
        if constexpr (F8) { _Pragma("unroll") for (int m = 0; m < 4; ++m) _Pragma("unroll") for (int n = 0; n < 2; ++n) \
            asm volatile("v_mfma_scale_f32_16x16x128_f8f6f4 %0, %1, %2, %0, %3, %4 op_sel_hi:[0,0,0]" : "+v"(acc[ai][bj][m][n]) : "v"(Bt##8[n]), "v"(At##8[m]), "v"(sc_w), "v"(sc_a)); } \
        else if constexpr (I8) { _Pragma("unroll") for (int m = 0; m < 4; ++m) _Pragma("unroll") for (int n = 0; n < 2; ++n) _Pragma("unroll") for (int k = 0; k < 2; ++k) \
            acc[ai][bj][m][n] = __builtin_bit_cast(f32x4, __builtin_amdgcn_mfma_i32_16x16x64_i8(__builtin_bit_cast(v4i_, Bt[n][k]), __builtin_bit_cast(v4i_, At[m][k]), __builtin_bit_cast(v4i_, acc[ai][bj][m][n]), 0, 0, 0)); } \
        else { _Pragma("unroll") for (int m = 0; m < 4; ++m) _Pragma("unroll") for (int n = 0; n < 2; ++n) _Pragma("unroll") for (int k = 0; k < 2; ++k) \
            acc[ai][bj][m][n] = __builtin_amdgcn_mfma_f32_16x16x32_bf16(Bt[n][k], At[m][k], acc[ai][bj][m][n], 0, 0, 0); } \
        __builtin_amdgcn_s_setprio(0); } while (0)
#define PG8_WAIT_V(n) asm volatile("s_waitcnt vmcnt(" #n ")" ::: "memory")
#define PG8_WAIT_L(n) asm volatile("s_waitcnt lgkmcnt(" #n ")" ::: "memory")
#define PG8_BAR __builtin_amdgcn_s_barrier()
#define PG8_SCHED __builtin_amdgcn_sched_barrier(0)
    Unit cur, nxt; int ui = 0;
    if (!S.next(0, cur)) return;
    f32x4 acc[2][2][4][2];
#pragma unroll
    for (int a = 0; a < 2; ++a)
#pragma unroll
        for (int b = 0; b < 2; ++b)
#pragma unroll
            for (int m = 0; m < 4; ++m)
#pragma unroll
                for (int n = 0; n < 2; ++n) acc[a][b][m][n] = (f32x4){0.f, 0.f, 0.f, 0.f};
    typedef int v8i_ __attribute__((ext_vector_type(8))); typedef int v4i_ __attribute__((ext_vector_type(4)));
    bf16x8 At[4][2], B0[2][2], B1[2][2]; v8i_ At8[4], B08[2], B18[2];
    const char* cA = S.abase(cur); const char* cB = S.bbase(cur);
    if constexpr (SP2) {
        PG8_STAGE(PG8_SB(0, 0), cB, voffB); PG8_STAGE(PG8_SB(0, 1), cB + hstep, voffB); PG8_STAGE(PG8_SA(0, 0), cA, voffA); PG8_STAGE(PG8_SA(0, 1), cA + hstep, voffA);
        if (wr == 1) PG8_BAR;
        PG8_WAIT_V(2); PG8_BAR;
        PG8_STAGE(PG8_SB(1, 0), cB + kstep, voffB); PG8_STAGE(PG8_SA(1, 0), cA + kstep, voffA); PG8_STAGE(PG8_SB(1, 1), cB + hstep + kstep, voffB);
        PG8_WAIT_V(6); PG8_BAR;
    } else {
        PG8_STAGE(PG8_SB(0, 0), cB, voffB); PG8_STAGE(PG8_SA(0, 0), cA, voffA); PG8_STAGE(PG8_SB(0, 1), cB + hstep, voffB); PG8_STAGE(PG8_SA(0, 1), cA + hstep, voffA);
        if (wr == 1) PG8_BAR;
        PG8_WAIT_V(4); PG8_BAR;
        PG8_STAGE(PG8_SB(1, 0), cB + kstep, voffB); PG8_STAGE(PG8_SA(1, 0), cA + kstep, voffA); PG8_STAGE(PG8_SB(1, 1), cB + hstep + kstep, voffB);
        PG8_WAIT_V(6); PG8_BAR;
    }
    for (;;) {
        const bool has_next = S.next(ui + 1, nxt);
        const char* nA = has_next ? S.abase(nxt) : cA; const char* nB = has_next ? S.bbase(nxt) : cB;
        for (int t = 0; t < nt; t += 2) {
            const bool last = (t == nt - 2);
            const char* a1 = cA + (size_t)(t + 1) * kstep;
            const char* a2 = last ? nA : cA + (size_t)(t + 2) * kstep; const char* b2 = last ? nB : cB + (size_t)(t + 2) * kstep;
            const char* a3 = a2 + kstep; const char* b3 = b2 + kstep;
            if constexpr (SP2) {
            PG8_LDB(B0, 0, 0); PG8_LDB(B1, 0, 1); PG8_SCHED; PG8_LDA(At, 0, 0); PG8_STAGE(PG8_SA(1, 1), a1 + hstep, voffA);
            PG8_WAIT_V(8); PG8_WAIT_L(0); PG8_BAR; if (!TAIL2 || cur.half != 2) { PG8_MMA(0, 0, At, B0); PG8_MMA(0, 1, At, B1); } PG8_BAR; PG8_SCHED;
            PG8_LDA(At, 0, 1); PG8_STAGE(PG8_SB(0, 0), b2, voffB); PG8_STAGE(PG8_SB(0, 1), b2 + hstep, voffB); PG8_STAGE(PG8_SA(0, 0), a2, voffA);
            PG8_WAIT_V(8); PG8_WAIT_L(0); PG8_BAR; if (!TAIL2 || cur.half != 1) { PG8_MMA(1, 0, At, B0); PG8_MMA(1, 1, At, B1); } PG8_BAR; PG8_SCHED;
            PG8_LDB(B0, 1, 0); PG8_LDB(B1, 1, 1); PG8_SCHED; PG8_LDA(At, 1, 0); PG8_STAGE(PG8_SA(0, 1), a2 + hstep, voffA);
            PG8_WAIT_V(8); PG8_WAIT_L(0); PG8_BAR; if (!TAIL2 || cur.half != 2) { PG8_MMA(0, 0, At, B0); PG8_MMA(0, 1, At, B1); } PG8_BAR; PG8_SCHED;
            PG8_LDA(At, 1, 1); PG8_STAGE(PG8_SB(1, 0), b3, voffB); PG8_STAGE(PG8_SB(1, 1), b3 + hstep, voffB); PG8_STAGE(PG8_SA(1, 0), a3, voffA);
            PG8_WAIT_V(8); PG8_WAIT_L(0); PG8_BAR; if (!TAIL2 || cur.half != 1) { PG8_MMA(1, 0, At, B0); PG8_MMA(1, 1, At, B1); } PG8_BAR; PG8_SCHED;
            } else {
            PG8_LDB(B0, 0, 0); PG8_SCHED; PG8_LDA(At, 0, 0); PG8_STAGE(PG8_SA(1, 1), a1 + hstep, voffA);
            PG8_WAIT_L(8); PG8_BAR; PG8_WAIT_L(0); PG8_MMA(0, 0, At, B0); PG8_BAR; PG8_SCHED;
            PG8_LDB(B1, 0, 1); PG8_STAGE(PG8_SB(0, 0), b2, voffB);
            PG8_BAR; PG8_WAIT_L(0); PG8_MMA(0, 1, At, B1); PG8_BAR;
            PG8_LDA(At, 0, 1); PG8_STAGE(PG8_SA(0, 0), a2, voffA);
            PG8_BAR; PG8_WAIT_L(0); PG8_MMA(1, 0, At, B0); PG8_BAR; PG8_SCHED;
            PG8_STAGE(PG8_SB(0, 1), b2 + hstep, voffB);
            PG8_WAIT_V(6); PG8_BAR; PG8_MMA(1, 1, At, B1); PG8_BAR;
            PG8_LDB(B0, 1, 0); PG8_SCHED; PG8_LDA(At, 1, 0); PG8_STAGE(PG8_SA(0, 1), a2 + hstep, voffA);
            PG8_WAIT_L(8); PG8_BAR; PG8_WAIT_L(0); PG8_MMA(0, 0, At, B0); PG8_BAR; PG8_SCHED;
            PG8_LDB(B1, 1, 1); PG8_STAGE(PG8_SB(1, 0), b3, voffB);
            PG8_BAR; PG8_WAIT_L(0); PG8_MMA(0, 1, At, B1); PG8_BAR;
            PG8_LDA(At, 1, 1); PG8_STAGE(PG8_SA(1, 0), a3, voffA);
            PG8_BAR; PG8_WAIT_L(0); PG8_MMA(1, 0, At, B0); PG8_BAR; PG8_SCHED;
            PG8_STAGE(PG8_SB(1, 1), b3 + hstep, voffB);
            PG8_WAIT_V(6); PG8_BAR; PG8_MMA(1, 1, At, B1); PG8_BAR;
            }
        }
        if constexpr (ALIGN_EPI) { if (wr == 0) PG8_BAR; }
        if constexpr (F8) asm volatile("s_nop 15\n\ts_nop 15" ::: "memory");
        if constexpr (I8) {
            const int l3_ = lane_id(); const int fr_ = l3_ & 15, fq_ = l3_ >> 4; const bool sw_ = S.swapped(cur);
            const float* rowS = sw_ ? cs + S.brow(cur) : rs + S.arow(cur); const float* colS = sw_ ? rs + S.arow(cur) : cs + S.brow(cur);
            f32x4 csv[2][2];
#pragma unroll
            for (int bj = 0; bj < 2; ++bj)
#pragma unroll
                for (int n = 0; n < 2; ++n) csv[bj][n] = *(const f32x4*)(colS + 128 * bj + 32 * wc + 16 * n + 4 * fq_);
#pragma unroll
            for (int ai = 0; ai < 2; ++ai)
#pragma unroll
                for (int m = 0; m < 4; ++m) { const float rsv = rowS[128 * ai + 64 * wr + 16 * m + fr_];
#pragma unroll
                    for (int bj = 0; bj < 2; ++bj)
#pragma unroll
                        for (int n = 0; n < 2; ++n)
#pragma unroll
                            for (int j = 0; j < 4; ++j) { const float t_ = acc[ai][bj][m][n][j];
                                acc[ai][bj][m][n][j] = (float)__float_as_int(t_) * (rsv * csv[bj][n][j]); } }
        }
        { const int l2_ = lane_id(); E(acc, cur, wr, wc, l2_ & 15, l2_ >> 4); }
        if (!has_next) break;
#pragma unroll
        for (int a = 0; a < 2; ++a)
#pragma unroll
            for (int b = 0; b < 2; ++b)
#pragma unroll
                for (int m = 0; m < 4; ++m)
#pragma unroll
                    for (int n = 0; n < 2; ++n) acc[a][b][m][n] = (f32x4){0.f, 0.f, 0.f, 0.f};
        cur = nxt; cA = nA; cB = nB; ++ui;
        if constexpr (ALIGN_EPI) { if (wr == 1) PG8_BAR; }
    }
    PG8_WAIT_V(0);
    if constexpr (!ALIGN_EPI) { if (wr == 0) PG8_BAR; }
    PG8_BAR;
#undef voffB
#undef PG8_SA
#undef PG8_SB
#undef PG8_STAGE
#undef PG8_LDA
#undef PG8_LDB
#undef PG8_MMA
#undef PG8_WAIT_V
#undef PG8_WAIT_L
#undef PG8_BAR
#undef PG8_SCHED
}
}
namespace pg8 {
__device__ __forceinline__ void st8(bf16* p, const f32x4& v0, const f32x4& v1) {
    v4u w; w.x = cvtpk(v0[0], v0[1]); w.y = cvtpk(v0[2], v0[3]); w.z = cvtpk(v1[0], v1[1]); w.w = cvtpk(v1[2], v1[3]);
    *(v4u*)p = w;
}
struct EpiIn {
    bf16 *convb, *zb, *qb, *xbcb, *kb, *vb; float* dtb; const float* ropec; const float* ropes; unsigned char* k8; unsigned char* v8;
    __device__ __forceinline__ void st_k8(int pm, int pn, int bj, int ai, int wr, int wc, int m, int fr, int fq, const f32x4& o1, const f32x4& o2) const {
        const int b = pm < 64 ? (pm >> 5) : (pm - 64), t = (pm < 64 ? CTXL / 64 + (pm & 31) * 4 : 0) + 2 * ai + wr, h = 2 * (pn - 16) + bj;
        const int chunk = (((wc >> 1) * 2 + (wc & 1)) * 2 + (fq >> 1)) * 64 + m * 16 + fr;
        const f32x4 lo = __builtin_elementwise_min(__builtin_elementwise_max(o1, (f32x4){-448.f, -448.f, -448.f, -448.f}), (f32x4){448.f, 448.f, 448.f, 448.f});
        const f32x4 hh = __builtin_elementwise_min(__builtin_elementwise_max(o2, (f32x4){-448.f, -448.f, -448.f, -448.f}), (f32x4){448.f, 448.f, 448.f, 448.f});
        v2u w;
        w.x = (unsigned)__builtin_amdgcn_cvt_pk_fp8_f32(lo[2], lo[3], __builtin_amdgcn_cvt_pk_fp8_f32(lo[0], lo[1], 0, false), true);
        w.y = (unsigned)__builtin_amdgcn_cvt_pk_fp8_f32(hh[2], hh[3], __builtin_amdgcn_cvt_pk_fp8_f32(hh[0], hh[1], 0, false), true);
        *(v2u*)(k8 + ((size_t)(b * (KVLEN / 64) + t) * 8 + h) * 8192 + chunk * 16 + 8 * (fq & 1)) = w;
    }
    __device__ __forceinline__ void st_q8(unsigned char* p, const f32x4& o1, const f32x4& o2) const {
        constexpr float C = 0.125f * 1.4426950408889634f * (ATT_Y8 ? 8.0f : 1.0f);
        const f32x4 lo = __builtin_elementwise_min(__builtin_elementwise_max(o1 * C, (f32x4){-448.f, -448.f, -448.f, -448.f}), (f32x4){448.f, 448.f, 448.f, 448.f});
        const f32x4 hh = __builtin_elementwise_min(__builtin_elementwise_max(o2 * C, (f32x4){-448.f, -448.f, -448.f, -448.f}), (f32x4){448.f, 448.f, 448.f, 448.f});
        v2u w;
        w.x = (unsigned)__builtin_amdgcn_cvt_pk_fp8_f32(lo[2], lo[3], __builtin_amdgcn_cvt_pk_fp8_f32(lo[0], lo[1], 0, false), true);
        w.y = (unsigned)__builtin_amdgcn_cvt_pk_fp8_f32(hh[2], hh[3], __builtin_amdgcn_cvt_pk_fp8_f32(hh[0], hh[1], 0, false), true);
        *(v2u*)p = w;
    }
    __device__ __forceinline__ void st_v8(const f32x4 (&acc)[2][2][4][2], int pm, int pn, int wr, int wc, int fr, int fq) const {
        const int b = pm < 64 ? (pm >> 5) : (pm - 64), t0 = (pm < 64 ? CTXL / 64 + (pm & 31) * 4 : 0) + (wc >> 1);
#pragma unroll
        for (int ai = 0; ai < 2; ++ai) { const int h = 2 * (pn - 20) + ai;
#pragma unroll
            for (int bj = 0; bj < 2; ++bj) { unsigned char* tile = v8 + ((size_t)(b * (KVLEN / 64) + t0 + 2 * bj) * 8 + h) * 8192;
#pragma unroll
                for (int m = 0; m < 4; ++m) {
                    unsigned Dw[2];
#pragma unroll
                    for (int n = 0; n < 2; ++n) { const f32x4 c = __builtin_elementwise_min(__builtin_elementwise_max(acc[ai][bj][m][n], (f32x4){-448.f, -448.f, -448.f, -448.f}), (f32x4){448.f, 448.f, 448.f, 448.f});
                        Dw[n] = (unsigned)__builtin_amdgcn_cvt_pk_fp8_f32(c[2], c[3], __builtin_amdgcn_cvt_pk_fp8_f32(c[0], c[1], 0, false), true); }
                    const int chunk = (((2 * wr + (m >> 1)) * 2 + (fq & 1)) * 2 + (wc & 1)) * 32 + 16 * (m & 1) + fr;
#if V8_NOSWAP
                    *(unsigned*)(tile + chunk * 16 + (fq >> 1) * 4) = Dw[0]; *(unsigned*)(tile + chunk * 16 + 8 + (fq >> 1) * 4) = Dw[1];
#else
                    swap32u(Dw[0], Dw[1]);
                    v2u w; w.x = Dw[0]; w.y = Dw[1];
                    *(v2u*)(tile + chunk * 16 + (fq >> 1) * 8) = w;
#endif
                } } }
    }
    __device__ __forceinline__ void operator()(const f32x4 (&acc)[2][2][4][2], const Unit& u, int wr, int wc, int fr, int fq) const {
        const int pn = u.pn, pm = u.pm;
        if (V8_DIRECT && pn >= 20 && pn < 24) { st_v8(acc, pm, pn, wr, wc, fr, fq); return; }
        if (CONV_U && pn >= 2 && pn < 6) {
            bf16* bu = convb + (size_t)pm * 256 * 1536 + 512 + 128 * (pn - 2) + wc * 32 + 8 * fq;
#pragma unroll
            for (int ai = 0; ai < 2; ++ai)
#pragma unroll
                for (int m = 0; m < 4; ++m) { const int rl = ai * 128 + wr * 64 + m * 16 + fr;
                    st8(bu + (size_t)rl * 1536, acc[ai][0][m][0] * acc[ai][0][m][1], acc[ai][1][m][0] * acc[ai][1][m][1]); }
            return;
        }
        if (pn == 24) {
            if (wc == 0) {
#pragma unroll
                for (int ai = 0; ai < 2; ++ai)
#pragma unroll
                    for (int m = 0; m < 4; ++m) { if (TAIL2 && u.half != 0 && u.half != ai + 1) continue; const int r = pm * 256 + ai * 128 + wr * 64 + m * 16 + fr; *(f32x4*)(dtb + (size_t)r * 16 + 4 * fq) = acc[ai][0][m][0]; }
            }
            return;
        }
        bf16* base; int ld, col0; bool rope = false, kv = false;
        if (pn < 6) { base = convb; ld = 1536; col0 = 256 * pn; }
        else if (pn < 8) { base = zb; ld = 512; col0 = 256 * (pn - 6); }
        else if (pn < 12) { base = qb; ld = 1024; col0 = 256 * (pn - 8); rope = pm < 64; }
        else if (pn < 16) { base = xbcb; ld = 1024; col0 = 256 * (pn - 12); }
        else if (pn < 20) { base = kb; ld = 1024; col0 = 256 * (pn - 16); rope = pm < 64; kv = true; }
        else { base = vb; ld = 1024; col0 = 256 * (pn - 20); kv = true; }
        const size_t rowbase = !kv ? (size_t)pm * 256 : (pm < 64 ? (size_t)(pm >> 5) * KVLEN + CTXL + (size_t)(pm & 31) * 256 : (size_t)(pm - 64) * KVLEN);
        bf16* bp = base + rowbase * ld + col0 + wc * 32 + 8 * fq;
        if (rope) {
#pragma unroll
            for (int ai = 0; ai < 2; ++ai)
#pragma unroll
                for (int m = 0; m < 4; ++m) { if (TAIL2 && u.half != 0 && u.half != ai + 1) continue;
                    const int rl = ai * 128 + wr * 64 + m * 16 + fr;
                    const int pos = (wc & 1) ? 128 + m * 16 + fr : 4 * (pm & 31) + 2 * ai + wr;
                    const f32x4 cs = *(const f32x4*)(ropec + pos * 16 + 4 * fq), sn = *(const f32x4*)(ropes + pos * 16 + 4 * fq);
#pragma unroll
                    for (int bj = 0; bj < 2; ++bj) {
                        const f32x4 a1 = acc[ai][bj][m][0], a2 = acc[ai][bj][m][1];
                        const f32x4 o1 = a1 * cs - a2 * sn, o2 = a2 * cs + a1 * sn;
                        if (K8_DIRECT && kv) st_k8(pm, pn, bj, ai, wr, wc, m, fr, fq, o1, o2);
                        else if (Q8_DIRECT && !kv) st_q8((unsigned char*)qb + (size_t)(pm * 16 + ai * 8 + wr * 4 + m) * 16384 + (size_t)(((col0 + bj * 128 + wc * 32) >> 3) + fq) * 128 + fr * 8, o1, o2);
                        else st8(bp + (size_t)rl * ld + bj * 128, o1, o2);
                    }
                }
        } else {
#pragma unroll
            for (int ai = 0; ai < 2; ++ai)
#pragma unroll
                for (int m = 0; m < 4; ++m) { if (TAIL2 && u.half != 0 && u.half != ai + 1) continue;
                    const int rl = ai * 128 + wr * 64 + m * 16 + fr;
#pragma unroll
                    for (int bj = 0; bj < 2; ++bj) { if (K8_DIRECT && kv && pn < 20) st_k8(pm, pn, bj, ai, wr, wc, m, fr, fq, acc[ai][bj][m][0], acc[ai][bj][m][1]);
                        else if (Q8_DIRECT && pn >= 8 && pn < 12) st_q8((unsigned char*)qb + (size_t)(pm * 16 + ai * 8 + wr * 4 + m) * 16384 + (size_t)(((col0 + bj * 128 + wc * 32) >> 3) + fq) * 128 + fr * 8, acc[ai][bj][m][0], acc[ai][bj][m][1]);
                        else st8(bp + (size_t)rl * ld + bj * 128, acc[ai][bj][m][0], acc[ai][bj][m][1]); }
                }
        }
    }
};
__device__ __forceinline__ void ld8b(const bf16* p, float (&o)[8]) { const v4u w = *(const v4u*)p; o[0] = bflo(w.x); o[1] = bfhi(w.x); o[2] = bflo(w.y); o[3] = bfhi(w.y); o[4] = bflo(w.z); o[5] = bfhi(w.z); o[6] = bflo(w.w); o[7] = bfhi(w.w); }
template <bool SRC16>
struct EpiResidT {
    const void* srcLat; const void* srcCtx; bf16* dst; const float* gate;
    __device__ __forceinline__ void operator()(const f32x4 (&acc)[2][2][4][2], const Unit& u, int wr, int wc, int fr, int fq) const {
        const int pm = u.pm; const int v = pm < 32 ? 0 : (pm < 64 ? 1 : 2);
        const float* gv = gate + (size_t)v * 6 * D;
        const size_t sro = pm < 64 ? (size_t)pm * 256 * D : (size_t)(pm - 64) * 256 * D;
        const float* s32 = (const float*)(pm < 64 ? srcLat : srcCtx) + sro; const bf16* s16 = (const bf16*)(pm < 64 ? srcLat : srcCtx) + sro;
        bf16* dp = dst + (size_t)pm * 256 * D;
#if PERM_OUT
        const int colb = u.pn * 256 + wc * 32 + 8 * fq;
        f32x4 g[2][2];
#pragma unroll
        for (int bj = 0; bj < 2; ++bj)
#pragma unroll
            for (int n = 0; n < 2; ++n) g[bj][n] = *(const f32x4*)(gv + colb + bj * 128 + n * 4);
#pragma unroll
        for (int ai = 0; ai < 2; ++ai)
#pragma unroll
            for (int m = 0; m < 4; ++m) { if (TAIL2 && u.half != 0 && u.half != ai + 1) continue;
                const size_t off = (size_t)(ai * 128 + wr * 64 + m * 16 + fr) * D + colb;
#pragma unroll
                for (int bj = 0; bj < 2; ++bj) { f32x4 s0, s1;
                    if (SRC16) { float t[8]; ld8b(s16 + off + bj * 128, t); s0 = (f32x4){t[0], t[1], t[2], t[3]}; s1 = (f32x4){t[4], t[5], t[6], t[7]}; }
                    else { s0 = ld4_f32(s32 + off + bj * 128); s1 = ld4_f32(s32 + off + bj * 128 + 4); }
                    st8(dp + off + bj * 128, s0 + g[bj][0] * acc[ai][bj][m][0], s1 + g[bj][1] * acc[ai][bj][m][1]); }
                asm volatile("" ::: "memory");
            }
#else
        const int colb = u.pn * 256 + wc * 32 + 4 * fq;
        f32x4 g[2][2];
#pragma unroll
        for (int bj = 0; bj < 2; ++bj)
#pragma unroll
            for (int n = 0; n < 2; ++n) g[bj][n] = *(const f32x4*)(gv + colb + bj * 128 + n * 16);
#pragma unroll
        for (int ai = 0; ai < 2; ++ai)
#pragma unroll
            for (int m = 0; m < 4; ++m) { if (TAIL2 && u.half != 0 && u.half != ai + 1) continue;
                const size_t off = (size_t)(ai * 128 + wr * 64 + m * 16 + fr) * D + colb;
#pragma unroll
                for (int bj = 0; bj < 2; ++bj)
#pragma unroll
                    for (int n = 0; n < 2; ++n) { const f32x4 s = SRC16 ? ld4_bf16(s16 + off + bj * 128 + n * 16) : ld4_f32(s32 + off + bj * 128 + n * 16);
                        st4_bf16(dp + off + bj * 128 + n * 16, s + g[bj][n] * acc[ai][bj][m][n]); }
                asm volatile("" ::: "memory");
            }
#endif
    }
};
struct EpiSwiGLU {
    bf16* act; int ld;
    __device__ __forceinline__ void operator()(const f32x4 (&acc)[2][2][4][2], const Unit& u, int wr, int wc, int fr, int fq) const {
        bf16* bp = act + (size_t)u.pm * 256 * ld + u.pn * 128 + wc * 32 + 8 * fq;
#pragma unroll
        for (int ai = 0; ai < 2; ++ai)
#pragma unroll
            for (int m = 0; m < 4; ++m) { if (TAIL2 && u.half != 0 && u.half != ai + 1) continue;
                const int rl = ai * 128 + wr * 64 + m * 16 + fr;
                f32x4 o[2];
#pragma unroll
                for (int bj = 0; bj < 2; ++bj) { const f32x4 g = acc[ai][bj][m][0], up = acc[ai][bj][m][1];
#pragma unroll
                    for (int j = 0; j < 4; ++j) o[bj][j] = silu_f(g[j]) * up[j]; }
                st8(bp + (size_t)rl * ld, o[0], o[1]);
            }
    }
};
constexpr float ACT_SCALE = 4.0f; constexpr int ACT_SC8 = 0x7D7D7D7D;
struct EpiSwiGLU8 {
    unsigned char* act; int ld;
    __device__ __forceinline__ void operator()(const f32x4 (&acc)[2][2][4][2], const Unit& u, int wr, int wc, int fr, int fq) const {
        unsigned char* bp = act + (size_t)u.pm * 256 * ld + u.pn * 128 + wc * 32 + 8 * fq;
#pragma unroll
        for (int ai = 0; ai < 2; ++ai)
#pragma unroll
            for (int m = 0; m < 4; ++m) { if (TAIL2 && u.half != 0 && u.half != ai + 1) continue;
                const int rl = ai * 128 + wr * 64 + m * 16 + fr;
                float o[8];
#pragma unroll
                for (int bj = 0; bj < 2; ++bj) { const f32x4 g = acc[ai][bj][m][0], up = acc[ai][bj][m][1];
#pragma unroll
                    for (int j = 0; j < 4; ++j) o[4 * bj + j] = fminf(fmaxf(silu_f(g[j]) * up[j] * ACT_SCALE, -448.f), 448.f); }
                v2u w;
                w.x = (unsigned)__builtin_amdgcn_cvt_pk_fp8_f32(o[2], o[3], __builtin_amdgcn_cvt_pk_fp8_f32(o[0], o[1], 0, false), true);
                w.y = (unsigned)__builtin_amdgcn_cvt_pk_fp8_f32(o[6], o[7], __builtin_amdgcn_cvt_pk_fp8_f32(o[4], o[5], 0, false), true);
                *(v2u*)(bp + (size_t)rl * ld) = w;
            }
    }
};
struct EpiBf16 {
    bf16* O; int ld;
    __device__ __forceinline__ void operator()(const f32x4 (&acc)[2][2][4][2], const Unit& u, int wr, int wc, int fr, int fq) const {
        bf16* bp = O + (size_t)u.pm * 256 * ld + u.pn * 256 + wc * 32 + 8 * fq;
#pragma unroll
        for (int ai = 0; ai < 2; ++ai)
#pragma unroll
            for (int m = 0; m < 4; ++m) { if (TAIL2 && u.half != 0 && u.half != ai + 1) continue;
                const int rl = ai * 128 + wr * 64 + m * 16 + fr;
#pragma unroll
                for (int bj = 0; bj < 2; ++bj) st8(bp + (size_t)rl * ld + bj * 128, acc[ai][bj][m][0], acc[ai][bj][m][1]);
                asm volatile("" ::: "memory");
            }
    }
};
struct EpiPartial {
    float* part;
    __device__ __forceinline__ void operator()(const f32x4 (&acc)[2][2][4][2], const Unit& u, int wr, int wc, int fr, int fq) const {
#if PART16 && PERM_OUT
        bf16* dp = (bf16*)part + ((size_t)u.ks * NCTX + (size_t)(u.pm - 64) * 256) * D + u.pn * 256 + wc * 32 + 8 * fq;
#pragma unroll
        for (int ai = 0; ai < 2; ++ai)
#pragma unroll
            for (int m = 0; m < 4; ++m) { if (TAIL2 && u.half != 0 && u.half != ai + 1) continue;
                const size_t off = (size_t)(ai * 128 + wr * 64 + m * 16 + fr) * D;
#pragma unroll
                for (int bj = 0; bj < 2; ++bj) st8(dp + off + bj * 128, acc[ai][bj][m][0], acc[ai][bj][m][1]);
                asm volatile("" ::: "memory");
            }
#else
        float* dp = part + ((size_t)u.ks * NCTX + (size_t)(u.pm - 64) * 256) * D + u.pn * 256 + wc * 32 + (PERM_OUT ? 8 : 4) * fq;
#pragma unroll
        for (int ai = 0; ai < 2; ++ai)
#pragma unroll
            for (int m = 0; m < 4; ++m) { if (TAIL2 && u.half != 0 && u.half != ai + 1) continue;
                const size_t off = (size_t)(ai * 128 + wr * 64 + m * 16 + fr) * D;
#pragma unroll
                for (int bj = 0; bj < 2; ++bj)
#pragma unroll
                    for (int n = 0; n < 2; ++n) *(f32x4*)(dp + off + bj * 128 + n * (PERM_OUT ? 4 : 16)) = acc[ai][bj][m][n];
                asm volatile("" ::: "memory");
            }
#endif
    }
};
}
struct Params { const float* in[28]; float* out; unsigned char* ws; };
enum { I_X = 0, I_C, I_CTX, I_CCTX, I_WMOD, I_BMOD, I_GMIX, I_GFFN, I_WIN, I_CONVW, I_SCONVW, I_SCONVB, I_ALOG, I_DTB, I_SSDD, I_SNORM, I_LAMBDA, I_SUBLN, I_WOUT,
       I_FG, I_FU, I_FD, I_RW, I_RB, I_MG, I_MU, I_MD, I_GFIN };
struct Frame {
    LAS unsigned char* lds; volatile LAS unsigned* MISC; gu32* ctl;
    int wave, vcu, G;
};
struct Lane { int tid, lane; __device__ __forceinline__ Lane(int wave) { tid = fresh_tid(wave); lane = tid & 63; } };

#define g_nostore (*(volatile LAS int*)(unsigned)(MISC_OFF + 512))
__device__ __forceinline__ void tr_item(const float* colptr, int ld, bool perm, bf16* wt, int K, int k0, LAS float* scr, int lane) {
    const int j = lane & 31;
    float tv[32];
#pragma unroll
    for (int i = 0; i < 32; ++i) { const int kk = 2 * i + (lane >> 5); tv[i] = colptr[(size_t)(k0 + kk) * ld]; }
#pragma unroll
    for (int i = 0; i < 32; ++i) { const int kk = 2 * i + (lane >> 5); scr[kk * 33 + j] = tv[i]; }
    LDS_WAIT(); asm volatile("" ::: "memory");
    const int c = lane & 7;
#pragma unroll
    for (int jj = 0; jj < 4; ++jj) { const int n = (lane >> 3) + 8 * jj; const int slot = perm ? pg8::perm32(n) : n; const LAS float* s = scr + (8 * c) * 33 + slot;
        v4u o; o.x = pk2(s[0 * 33], s[1 * 33]); o.y = pk2(s[2 * 33], s[3 * 33]); o.z = pk2(s[4 * 33], s[5 * 33]); o.w = pk2(s[6 * 33], s[7 * 33]);
        if (NOSTORE_PROBE && g_nostore) { asm volatile("" :: "v"(o.x), "v"(o.y), "v"(o.z), "v"(o.w)); } else *(GAS v4u*)(wt + (size_t)n * K + k0 + 8 * c) = o; }
    LDS_WAIT(); asm volatile("" ::: "memory");
}
constexpr float W8_SCALE = 64.0f; constexpr int W8_SC8 = 0x79797979;
template <bool I8 = false, bool MAYNULL = false>
__device__ __forceinline__ void tr_item8(const float* colptr, int ld, bool perm, unsigned char* wt, int K, int k0, LAS float* scr, int lane, float mulA = 0.f, float mulB = 0.f) {
    const int j = lane & 31;
    float tv[32];
#pragma unroll
    for (int i = 0; i < 32; ++i) { const int kk = 2 * i + (lane >> 5); tv[i] = (!MAYNULL || colptr) ? colptr[(size_t)(k0 + kk) * ld] : 0.f; }
#pragma unroll
    for (int i = 0; i < 32; ++i) { const int kk = 2 * i + (lane >> 5); scr[kk * 33 + j] = tv[i]; }
    LDS_WAIT(); asm volatile("" ::: "memory");
    const int c = lane & 3;
#pragma unroll
    for (int jj = 0; jj < 2; ++jj) { const int n = (lane >> 2) + 16 * jj; const int slot = perm ? pg8::perm32(n) : n; const LAS float* s = scr + (16 * c) * 33 + slot;
        float v[16]; v4u o;
        if constexpr (I8) { const float mul = jj ? mulB : mulA;
#pragma unroll
            for (int i = 0; i < 16; ++i) v[i] = __builtin_amdgcn_fmed3f(s[i * 33] * mul, -127.f, 127.f);
            o.x = pk_i8(v[0], v[1], v[2], v[3]); o.y = pk_i8(v[4], v[5], v[6], v[7]); o.z = pk_i8(v[8], v[9], v[10], v[11]); o.w = pk_i8(v[12], v[13], v[14], v[15]);
        } else {
#pragma unroll
        for (int i = 0; i < 16; ++i) v[i] = fminf(fmaxf(s[i * 33] * W8_SCALE, -448.f), 448.f);
        o.x = (unsigned)__builtin_amdgcn_cvt_pk_fp8_f32(v[2], v[3], __builtin_amdgcn_cvt_pk_fp8_f32(v[0], v[1], 0, false), true);
        o.y = (unsigned)__builtin_amdgcn_cvt_pk_fp8_f32(v[6], v[7], __builtin_amdgcn_cvt_pk_fp8_f32(v[4], v[5], 0, false), true);
        o.z = (unsigned)__builtin_amdgcn_cvt_pk_fp8_f32(v[10], v[11], __builtin_amdgcn_cvt_pk_fp8_f32(v[8], v[9], 0, false), true);
        o.w = (unsigned)__builtin_amdgcn_cvt_pk_fp8_f32(v[14], v[15], __builtin_amdgcn_cvt_pk_fp8_f32(v[12], v[13], 0, false), true);
        }
        if (NOSTORE_PROBE && g_nostore) { asm volatile("" :: "v"(o.x), "v"(o.y), "v"(o.z), "v"(o.w)); } else *(GAS v4u*)(wt + (size_t)n * K + k0 + 16 * c) = o; }
    LDS_WAIT(); asm volatile("" ::: "memory");
}
template <bool I8, bool MAYNULL>
__device__ __forceinline__ void tr_pair8(const float* colptr, int ld, bool perm, unsigned char* wt, int K, int k0, LAS float* scr, int lane, float mulA = 0.f, float mulB = 0.f) {
    const int j = lane & 31;
#pragma unroll
    for (int hf = 0; hf < 2; ++hf) {
        float tv[32];
#pragma unroll
        for (int i = 0; i < 32; ++i) { const int kk = 64 * hf + 2 * i + (lane >> 5); tv[i] = (!MAYNULL || colptr) ? colptr[(size_t)(k0 + kk) * ld] : 0.f; }
#pragma unroll
        for (int i = 0; i < 32; ++i) { const int kk = 64 * hf + 2 * i + (lane >> 5); scr[kk * 32 + (j ^ (4 * (kk >> 4)))] = tv[i]; }
    }
    LDS_WAIT(); asm volatile("" ::: "memory");
    const int c = lane & 7;
#pragma unroll
    for (int jj = 0; jj < 4; ++jj) { const int n = (lane >> 3) + 8 * jj; const int slot = perm ? pg8::perm32(n) : n; const LAS float* s = scr + (16 * c) * 32 + (slot ^ (4 * c));
        float v[16]; v4u o;
        if constexpr (I8) { const float mul = jj >= 2 ? mulB : mulA;
#pragma unroll
            for (int i = 0; i < 16; ++i) v[i] = __builtin_amdgcn_fmed3f(s[i * 32] * mul, -127.f, 127.f);
            o.x = pk_i8(v[0], v[1], v[2], v[3]); o.y = pk_i8(v[4], v[5], v[6], v[7]); o.z = pk_i8(v[8], v[9], v[10], v[11]); o.w = pk_i8(v[12], v[13], v[14], v[15]);
        } else {
#pragma unroll
            for (int i = 0; i < 16; ++i) v[i] = fminf(fmaxf(s[i * 32] * W8_SCALE, -448.f), 448.f);
            o.x = (unsigned)__builtin_amdgcn_cvt_pk_fp8_f32(v[2], v[3], __builtin_amdgcn_cvt_pk_fp8_f32(v[0], v[1], 0, false), true);
            o.y = (unsigned)__builtin_amdgcn_cvt_pk_fp8_f32(v[6], v[7], __builtin_amdgcn_cvt_pk_fp8_f32(v[4], v[5], 0, false), true);
            o.z = (unsigned)__builtin_amdgcn_cvt_pk_fp8_f32(v[10], v[11], __builtin_amdgcn_cvt_pk_fp8_f32(v[8], v[9], 0, false), true);
            o.w = (unsigned)__builtin_amdgcn_cvt_pk_fp8_f32(v[14], v[15], __builtin_amdgcn_cvt_pk_fp8_f32(v[12], v[13], 0, false), true);
        }
        *(GAS v4u*)(wt + (size_t)n * K + k0 + 16 * c) = o; }
    LDS_WAIT(); asm volatile("" ::: "memory");
}
__device__ __forceinline__ const float* gu_colptr(const float* gate, const float* up, int nb, int j) {
    const int pn = nb >> 3, r = nb & 7, bj = r >> 2, wc = r & 3, n = j >> 4, i = j & 15, fq = i >> 2, jj = i & 3;
    return (n ? up : gate) + 128 * pn + 32 * wc + 8 * fq + 4 * bj + jj;
}

#if CV_PAIR
constexpr int CV_IN = 200 * 16, CV_OUT = 64 * 32, CV_GU = 352 * 16, CV_DN = 64 * 44, CV_MGU1 = 176 * 16, CV_MDN1 = 64 * 22;
#else
constexpr int CV_IN = 200 * 32, CV_OUT = 64 * 32, CV_GU = 352 * 32, CV_DN = 64 * 88, CV_MGU1 = 176 * 32, CV_MDN1 = 64 * 44;
#endif
constexpr int CV_NEARLY = CV_IN + CV_OUT + CV_GU + CV_DN, CV_NITEMS = 2 * CV_IN + 2 * CV_OUT + CV_GU + CV_DN + NE * CV_MGU1 + NE * CV_MDN1, CV_NDEF = CV_NITEMS - CV_NEARLY;
__device__ __forceinline__ void conv_item(Frame& F, const Params& P, int it) {
    unsigned char* ws = fresh_ws(P.ws);
    const LAS float* wsc = (const LAS float*)(F.lds + MISC_OFF + 256);
    float* csw = (float*)(ws + WS_CS);
    LAS float* scr = (LAS float*)(F.lds + F.wave * 16384);
    const int lane = lane_id(), j = lane & 31;
    int r = it, l = 0;
    if (r >= CV_NEARLY) { r -= CV_NEARLY; l = 1; }
    if (r < CV_IN) { const int nb = r % 200, kb = r / 200, n0 = 32 * nb;
        const float* w = P.in[I_WIN] + (size_t)l * D * IN_COLS; const float* cp; bool perm;
        if (CONV_U && n0 >= 512 && n0 < 1536) { cp = gu_colptr(w + 512, w + 1024, (n0 - 512) >> 5, j); perm = false; }
        else if (n0 < 4096) { cp = w + n0 + j; perm = !(n0 >= 2048 && n0 < 3072); }
        else if (n0 < 5120) { cp = w + COL_K + (n0 - 4096) + j; perm = false; }
        else if (n0 < 6144) { cp = w + COL_V + (n0 - 5120) + j; perm = !V8_DIRECT; }
        else if (n0 == 6144) { cp = j < 16 ? w + COL_DT + j : nullptr; perm = false; }
        else { cp = nullptr; perm = false; }
        const float st = wsc[l], inv = 1.0f / st;
        if (kb == 0 && lane < 32) csw[CS_WIN + l * 6400 + n0 + lane] = st;
        if (CV_PAIR) tr_pair8<true, true>(cp, IN_COLS, perm, ws + WS_WIN + l * SZ_WIN + (size_t)n0 * D, D, 128 * kb, scr, lane, inv, inv);
        else tr_item8<true, true>(cp, IN_COLS, perm, ws + WS_WIN + l * SZ_WIN + (size_t)n0 * D, D, 64 * kb, scr, lane, inv, inv);
        return; }
    r -= CV_IN;
    if (r < CV_OUT) { const int nb = r % 64, kb = r / 64, n0 = 32 * nb;
        tr_item(P.in[I_WOUT] + (size_t)l * D * D + n0 + j, D, PERM_OUT != 0, (bf16*)(ws + WS_WOUT + l * SZ_WOUT) + (size_t)n0 * D, D, 64 * kb, scr, lane); return; }
    r -= CV_OUT;
    if (l == 0) {
        if (r < CV_GU) { const int nb = r % 352, kb = r / 352;
            const float sg = wsc[2], su = wsc[3];
            if (kb == 0 && lane < 32) csw[CS_WGU + 32 * nb + lane] = lane < 16 ? sg : su;
            if (CV_PAIR) tr_pair8<true, false>(gu_colptr(P.in[I_FG], P.in[I_FU], nb, j), FFD, false, ws + WS_WGU + (size_t)(32 * nb) * D, D, 128 * kb, scr, lane, 1.0f / sg, 1.0f / su);
            else tr_item8<true>(gu_colptr(P.in[I_FG], P.in[I_FU], nb, j), FFD, false, ws + WS_WGU + (size_t)(32 * nb) * D, D, 64 * kb, scr, lane, 1.0f / sg, 1.0f / su);
            return; }
        r -= CV_GU;
        { const int nb = r % 64, kb = r / 64, n0 = 32 * nb;
          if (CV_PAIR) tr_pair8<false, false>(P.in[I_FD] + n0 + j, D, PERM_OUT != 0, ws + WS_WDN + (size_t)n0 * FFD, FFD, 128 * kb, scr, lane);
          else tr_item8(P.in[I_FD] + n0 + j, D, PERM_OUT != 0, ws + WS_WDN + (size_t)n0 * FFD, FFD, 64 * kb, scr, lane);
          return; }
    }
    if (r < NE * CV_MGU1) { const int e = r / CV_MGU1; r -= e * CV_MGU1; const int nb = r % 176, kb = r / 176;
        const float sg = wsc[4 + e], su = wsc[12 + e];
        if (kb == 0 && lane < 32) csw[CS_MGU + e * (2 * FFE) + 32 * nb + lane] = lane < 16 ? sg : su;
        if (CV_PAIR) tr_pair8<true, false>(gu_colptr(P.in[I_MG] + (size_t)e * D * FFE, P.in[I_MU] + (size_t)e * D * FFE, nb, j), FFE, false, ws + WS_MGU + e * (SZ_MGU / 2) + (size_t)(32 * nb) * D, D, 128 * kb, scr, lane, 1.0f / sg, 1.0f / su);
        else tr_item8<true>(gu_colptr(P.in[I_MG] + (size_t)e * D * FFE, P.in[I_MU] + (size_t)e * D * FFE, nb, j), FFE, false, ws + WS_MGU + e * (SZ_MGU / 2) + (size_t)(32 * nb) * D, D, 64 * kb, scr, lane, 1.0f / sg, 1.0f / su);
        return; }
    r -= NE * CV_MGU1;
    { const int e = r / CV_MDN1; r -= e * CV_MDN1; const int nb = r % 64, kb = r / 64, n0 = 32 * nb;
      if (CV_PAIR) tr_pair8<false, false>(P.in[I_MD] + (size_t)e * FFE * D + n0 + j, D, true, ws + WS_MDN + e * (SZ_MDN / 2) + (size_t)n0 * FFE, FFE, 128 * kb, scr, lane);
      else tr_item8(P.in[I_MD] + (size_t)e * FFE * D + n0 + j, D, true, ws + WS_MDN + e * (SZ_MDN / 2) + (size_t)n0 * FFE, FFE, 64 * kb, scr, lane); }
}
#define ITEM_NB(r, N, NKB, OLD) (ITEM_NBFAST == 2 ? (((r) >> 3) / (NKB)) * 8 + ((r) & 7) : ITEM_NBFAST == 1 ? (r) % (N) : (OLD))
#define ITEM_KB(r, N, NKB, OLD) (ITEM_NBFAST == 2 ? ((r) >> 3) % (NKB) : ITEM_NBFAST == 1 ? (r) / (N) : (OLD))
__device__ __forceinline__ void p0_prologue(Frame& F, const Params& P) {
    const Lane L(F.wave);
    unsigned char* ws = fresh_ws(P.ws);
    if (F.vcu < 192) {
      for (int rep_ = 0; rep_ <= DUP_MODV; ++rep_) {
        const int l = F.vcu / 96, cb = F.vcu % 96;
        LAS float* sv = (LAS float*)(F.lds);
        LAS float* red = (LAS float*)(F.lds + 32768);
        for (int i = L.tid; i < 3 * D; i += 512) { const int v = i / D, k = i % D; const float c = v < 2 ? P.in[I_C][v * D + k] : P.in[I_CCTX][k]; sv[i] = c / (1.0f + __expf(-c)); }
        __syncthreads();
        const float* W = P.in[I_WMOD] + (size_t)l * D * 12288 + cb * 128 + 2 * L.lane;
        f32x2 a0 = {0.f, 0.f}, a1 = {0.f, 0.f}, a2 = {0.f, 0.f};
        const int kb = F.wave * 256;
#pragma unroll 16
        for (int k = 0; k < 256; ++k) { const f32x2 w = *(const f32x2*)(W + (size_t)(kb + k) * 12288); a0 += w * sv[kb + k]; a1 += w * sv[D + kb + k]; a2 += w * sv[2 * D + kb + k]; }
        *(LAS f32x2*)(red + (F.wave * 3 + 0) * 128 + 2 * L.lane) = a0; *(LAS f32x2*)(red + (F.wave * 3 + 1) * 128 + 2 * L.lane) = a1; *(LAS f32x2*)(red + (F.wave * 3 + 2) * 128 + 2 * L.lane) = a2;
        __syncthreads();
        if (L.tid < 384) { const int v = L.tid >> 7, col = L.tid & 127; float s = P.in[I_BMOD][l * 12288 + cb * 128 + col];
#pragma unroll
            for (int w = 0; w < 8; ++w) s += red[(w * 3 + v) * 128 + col];
            ((float*)(ws + WS_MOD))[(size_t)(l * 3 + v) * 12288 + cb * 128 + col] = s; }
        __syncthreads();
      }
    } else if (F.vcu == 192) {
        float* rc = (float*)(ws + WS_ROPE); float* rs = rc + 192 * 16;
        for (int i = L.tid; i < 192 * 16; i += 512) { const int pos = i >> 4, f = i & 15; const float inv = exp2f(-(float)f * (13.287712379549449f / 16.0f)); const float ang = (float)(pos < 128 ? pos : pos - 128) * inv; rc[i] = cosf(ang); rs[i] = sinf(ang); }
    }
    LAS float* wsc = (LAS float*)(F.lds + MISC_OFF + 256);
    for (int t = F.wave; t < 20; t += NWAVES) {
        const float* tp = t < 2 ? P.in[I_WIN] + (size_t)t * D * IN_COLS : t == 2 ? P.in[I_FG] : t == 3 ? P.in[I_FU] : t < 12 ? P.in[I_MG] + (size_t)(t - 4) * D * FFE : P.in[I_MU] + (size_t)(t - 12) * D * FFE;
        float ss = 0.f;
#pragma unroll
        for (int i = 0; i < 16; ++i) { const f32x4 w = *(const f32x4*)(tp + 4 * (L.lane + 64 * i)); ss += (w[0] * w[0] + w[1] * w[1]) + (w[2] * w[2] + w[3] * w[3]); }
        ss = wave_sum(ss);
        if (L.lane == 0) wsc[t] = sqrtf(ss * (1.0f / 4096.0f)) * (I8_CLIP / 127.0f);
    }
    __syncthreads();
    float* csw = (float*)(ws + WS_CS);
    const int gw = F.vcu * NWAVES + F.wave, NGW = F.G * NWAVES;
    constexpr int NPRE = 63 * NWAVES * (CV_PAIR ? 4 : 7);
    const bool early = F.vcu > 192;
    const int nA = early ? NPRE : 0, sA = early ? (F.vcu - 193) * NWAVES + F.wave : 0, stA = 63 * NWAVES;
    for (int ph = 0; ph < 2; ++ph) {
      const int lo = ph == 0 ? sA : NPRE + gw, hi2 = ph == 0 ? nA : ((DEFER && F.G == 256) ? CV_NEARLY : CV_NITEMS), st = ph == 0 ? stA : NGW;
      for (int it = lo; it < hi2; it += st) conv_item(F, P, it);
    }
}
__device__ __forceinline__ void deferred_slot(Frame& F, const Params& P, int dpos, int k, int nIdle, int ipw) {
    const int w0 = k * NWAVES + F.wave, st = nIdle * NWAVES;
    for (int i = 0; i < ipw; ++i) { const int it = CV_NEARLY + dpos + w0 + i * st; if (it < CV_NITEMS) conv_item(F, P, it); }
}
__device__ __forceinline__ void deferred_rest(Frame& F, const Params& P, int dpos) {
    for (int it = CV_NEARLY + dpos + F.vcu * NWAVES + F.wave; it < CV_NITEMS; it += F.G * NWAVES) conv_item(F, P, it);
}

__device__ __forceinline__ void store_row_i8(unsigned char* hr, float* hs, int r, const f32x4 (&x)[8], int lane) {
    float am = 0.f;
#pragma unroll
    for (int jq = 0; jq < 8; ++jq) am = fmaxf(fmaxf(am, fmaxf(fabsf(x[jq][0]), fabsf(x[jq][1]))), fmaxf(fabsf(x[jq][2]), fabsf(x[jq][3])));
    am = fmaxf(wave_max(am), 1e-30f);
    const float inv = 127.0f / am;
#pragma unroll
    for (int jq = 0; jq < 8; ++jq) *(unsigned*)(hr + 4 * lane + 256 * jq) = pk_i8(x[jq][0] * inv, x[jq][1] * inv, x[jq][2] * inv, x[jq][3] * inv);
    if (lane == 0) hs[r] = am * (1.0f / 127.0f);
}
template <bool ROUTE, int OUT8 = 0, bool SL16 = false, bool SC16 = false>
__device__ __forceinline__ void norm_phase(Frame& F, const void* srcLatV, const void* srcCtxV, const float* gvec, const float* modl, int ishift, int iscale, bf16* h, int nrows,
                                           const float* wrouter, const float* brouter, int* tok_e, int* tok_slot, float* tok_p,
                                           const float* part = nullptr, int nsl = 0, const float* pgate = nullptr, bf16* wb = nullptr, float* hs = nullptr) {
    const Lane L(F.wave);
    LAS float* wrT = (LAS float*)F.lds;
    if (ROUTE) {
        for (int i = L.tid; i < D * NE; i += 512) { const int k = i >> 3, e = i & 7; wrT[e * D + k] = wrouter[i]; }
        __syncthreads();
    }
    const int gw = F.vcu * NWAVES + F.wave, NGW = F.G * NWAVES, lane = L.lane;
    const int nmain = part != nullptr ? NLAT / 8 : nrows / 8;
    for (int run = gw; run < nmain; run += NGW) {
        const int r0 = run * 8; const int v = r0 < SEQ ? 0 : (r0 < NLAT ? 1 : 2);
        const float* sh = modl + (size_t)(v * 6 + ishift) * D; const float* sc = modl + (size_t)(v * 6 + iscale) * D;
        f32x4 A[8], B[8];
#pragma unroll
        for (int jq = 0; jq < 8; ++jq) { const int c = 4 * lane + 256 * jq; const f32x4 g = *(const f32x4*)(gvec + c), s = *(const f32x4*)(sc + c); A[jq] = g * (s + 1.0f); B[jq] = *(const f32x4*)(sh + c); }
        for (int rr = 0; rr < 8; ++rr) {
            const int r = r0 + rr;
            f32x4 x[8]; float ss = 0.f;
            if (r < NLAT) {
#pragma unroll
                for (int jq = 0; jq < 8; ++jq) x[jq] = SL16 ? ld4_bf16((const bf16*)srcLatV + (size_t)r * D + 4 * lane + 256 * jq) : ld4_f32((const float*)srcLatV + (size_t)r * D + 4 * lane + 256 * jq);
            } else {
#pragma unroll
                for (int jq = 0; jq < 8; ++jq) x[jq] = SC16 ? ld4_bf16((const bf16*)srcCtxV + (size_t)(r - NLAT) * D + 4 * lane + 256 * jq) : ld4_f32((const float*)srcCtxV + (size_t)(r - NLAT) * D + 4 * lane + 256 * jq);
            }
#pragma unroll
            for (int jq = 0; jq < 8; ++jq) ss += (x[jq][0] * x[jq][0] + x[jq][1] * x[jq][1]) + (x[jq][2] * x[jq][2] + x[jq][3] * x[jq][3]);
            const float rstd = 1.0f / sqrtf(wave_sum(ss) * (1.0f / D) + NORM_EPS);
#pragma unroll
            for (int jq = 0; jq < 8; ++jq) x[jq] = (x[jq] * rstd) * A[jq] + B[jq];
            if constexpr (OUT8 == 2 && ROUTE && MOE_SPARSE) {   }
            else if constexpr (OUT8 == 2) store_row_i8((unsigned char*)h + (size_t)r * D, hs, r, x, lane);
            else if constexpr (OUT8 == 1) {
                unsigned char* hr8 = (unsigned char*)h + (size_t)r * D;
#pragma unroll
                for (int jq = 0; jq < 8; ++jq) { const f32x4 y = __builtin_elementwise_min(__builtin_elementwise_max(x[jq], (f32x4){-448.f, -448.f, -448.f, -448.f}), (f32x4){448.f, 448.f, 448.f, 448.f});
                    *(unsigned*)(hr8 + 4 * lane + 256 * jq) = (unsigned)__builtin_amdgcn_cvt_pk_fp8_f32(y[2], y[3], __builtin_amdgcn_cvt_pk_fp8_f32(y[0], y[1], 0, false), true); }
            } else {
            bf16* hr = h + (size_t)r * D;
#pragma unroll
            for (int jq = 0; jq < 8; ++jq) { v2u w; w.x = cvtpk(x[jq][0], x[jq][1]); w.y = cvtpk(x[jq][2], x[jq][3]); *(v2u*)(hr + 4 * lane + 256 * jq) = w; }
            }
            if (ROUTE) {
                float lg[NE];
#pragma unroll
                for (int e = 0; e < NE; ++e) { float p = 0.f;
#pragma unroll
                    for (int jq = 0; jq < 8; ++jq) { const f32x4 w = *(const LAS f32x4*)(wrT + e * D + 4 * lane + 256 * jq); p += (x[jq][0] * w[0] + x[jq][1] * w[1]) + (x[jq][2] * w[2] + x[jq][3] * w[3]); }
                    lg[e] = wave_sum(p) + brouter[e]; }
                int i0 = 0; float v0 = lg[0];
#pragma unroll
                for (int e = 1; e < NE; ++e) if (lg[e] > v0) { v0 = lg[e]; i0 = e; }
                int i1 = -1; float v1 = -3.0e38f;
#pragma unroll
                for (int e = 0; e < NE; ++e) if (e != i0 && lg[e] > v1) { v1 = lg[e]; i1 = e; }
                int s0 = 0, s1 = 0;
                if (lane == 0) {
                    const float p0 = 1.0f / (1.0f + __expf(v1 - v0));
                    s0 = (int)__hip_atomic_fetch_add(F.ctl + CW_CNT + 64 * i0, 1u, RLX_AGENT);
                    s1 = (int)__hip_atomic_fetch_add(F.ctl + CW_CNT + 64 * i1, 1u, RLX_AGENT);
                    tok_e[2 * r] = i0; tok_e[2 * r + 1] = i1; tok_slot[2 * r] = s0; tok_slot[2 * r + 1] = s1; tok_p[2 * r] = p0; tok_p[2 * r + 1] = 1.0f - p0;
                }
                if constexpr (OUT8 == 2 && MOE_SPARSE) {
                    s0 = __builtin_amdgcn_readfirstlane(s0); s1 = __builtin_amdgcn_readfirstlane(s1);
                    float am = 0.f;
#pragma unroll
                    for (int jq = 0; jq < 8; ++jq) am = fmaxf(fmaxf(am, fmaxf(fabsf(x[jq][0]), fabsf(x[jq][1]))), fmaxf(fabsf(x[jq][2]), fabsf(x[jq][3])));
                    am = fmaxf(wave_max(am), 1e-30f);
                    const float inv = 127.0f / am;
                    const size_t ra = (size_t)i0 * NLAT + s0, rb = (size_t)i1 * NLAT + s1;
                    unsigned char* d0 = (unsigned char*)h + ra * D; unsigned char* d1 = (unsigned char*)h + rb * D;
#pragma unroll
                    for (int jq = 0; jq < 8; ++jq) { const unsigned w = pk_i8(x[jq][0] * inv, x[jq][1] * inv, x[jq][2] * inv, x[jq][3] * inv);
                        *(unsigned*)(d0 + 4 * lane + 256 * jq) = w; *(unsigned*)(d1 + 4 * lane + 256 * jq) = w; }
                    if (lane == 0) { hs[ra] = am * (1.0f / 127.0f); hs[rb] = am * (1.0f / 127.0f); }
                }
            }
        }
    }
    if (part != nullptr) {
        const float* sh = modl + (size_t)(2 * 6 + ishift) * D; const float* sc = modl + (size_t)(2 * 6 + iscale) * D;
        for (int r = NLAT + gw; r < NLAT + NCTX; r += NGW) {
            f32x4 x[8]; float ss = 0.f;
#pragma unroll
#if PART16 && PERM_OUT
            for (int jq = 0; jq < 8; ++jq) { const int c = 4 * lane + 256 * jq; f32x4 a = ld4_bf16((const bf16*)part + (size_t)(r - NLAT) * D + c);
                for (int s = 1; s < nsl; ++s) a += ld4_bf16((const bf16*)part + ((size_t)s * NCTX + (r - NLAT)) * D + c);
#else
            for (int jq = 0; jq < 8; ++jq) { const int c = 4 * lane + 256 * jq; f32x4 a = *(const f32x4*)(part + (size_t)(r - NLAT) * D + c);
                for (int s = 1; s < nsl; ++s) a += *(const f32x4*)(part + ((size_t)s * NCTX + (r - NLAT)) * D + c);
#endif
                const f32x4 xs = SC16 ? ld4_bf16((const bf16*)srcCtxV + (size_t)(r - NLAT) * D + c) : ld4_f32((const float*)srcCtxV + (size_t)(r - NLAT) * D + c);
                x[jq] = xs + *(const f32x4*)(pgate + c) * a;
                ss += (x[jq][0] * x[jq][0] + x[jq][1] * x[jq][1]) + (x[jq][2] * x[jq][2] + x[jq][3] * x[jq][3]); }
            if (wb) {
#pragma unroll
                for (int jq = 0; jq < 8; ++jq) st4_bf16(wb + (size_t)r * D + 4 * lane + 256 * jq, x[jq]);
            }
            const float rstd = 1.0f / sqrtf(wave_sum(ss) * (1.0f / D) + NORM_EPS);
            bf16* hr = h + (size_t)r * D;
            if constexpr (OUT8 == 2) {
#pragma unroll
                for (int jq = 0; jq < 8; ++jq) { const int c = 4 * lane + 256 * jq; const f32x4 g = *(const f32x4*)(gvec + c), s = *(const f32x4*)(sc + c), b = *(const f32x4*)(sh + c); x[jq] = (x[jq] * rstd) * (g * (s + 1.0f)) + b; }
                store_row_i8((unsigned char*)h + (size_t)r * D, hs, r, x, lane);
            } else
#pragma unroll
            for (int jq = 0; jq < 8; ++jq) { const int c = 4 * lane + 256 * jq; const f32x4 g = *(const f32x4*)(gvec + c), s = *(const f32x4*)(sc + c), b = *(const f32x4*)(sh + c);
                f32x4 y = (x[jq] * rstd) * (g * (s + 1.0f)) + b;
                if constexpr (OUT8 == 1) { y = __builtin_elementwise_min(__builtin_elementwise_max(y, (f32x4){-448.f, -448.f, -448.f, -448.f}), (f32x4){448.f, 448.f, 448.f, 448.f});
                    *(unsigned*)((unsigned char*)h + (size_t)r * D + c) = (unsigned)__builtin_amdgcn_cvt_pk_fp8_f32(y[2], y[3], __builtin_amdgcn_cvt_pk_fp8_f32(y[0], y[1], 0, false), true); }
                else { v2u w; w.x = cvtpk(y[0], y[1]); w.y = cvtpk(y[2], y[3]); *(v2u*)(hr + c) = w; } }
        }
    }
    if (ROUTE) __syncthreads();
}

__device__ __forceinline__ void ld8f(const bf16* p, float (&o)[8]) { const v4u w = *(const v4u*)p; o[0] = bflo(w.x); o[1] = bfhi(w.x); o[2] = bflo(w.y); o[3] = bfhi(w.y); o[4] = bflo(w.z); o[5] = bfhi(w.z); o[6] = bflo(w.w); o[7] = bfhi(w.w); }
__device__ __forceinline__ void st8f(bf16* p, const float (&o)[8]) { v4u w; w.x = cvtpk(o[0], o[1]); w.y = cvtpk(o[2], o[3]); w.z = cvtpk(o[4], o[5]); w.w = cvtpk(o[6], o[7]); *(v4u*)p = w; }
__device__ __forceinline__ void conv_phase(Frame& F, const bf16* convb, const bf16* xbcb, bf16* cat, bf16* xbcc, const float* cw  , const float* sw  , const float* sb  ) {
    const Lane L(F.wave);
    const int gt = F.vcu * 512 + L.tid, NT = F.G * 512;
    constexpr int NRUN = T / 16, NITEM = NRUN * 192;
    for (int it = gt; it < NITEM; it += NT) {
        const int cc = it % 192, run = it / 192, r0 = run * 16;
        const int tl = r0 < NLAT ? (r0 % SEQ) : ((r0 - NLAT) % CTXL); const int sl = r0 < NLAT ? SEQ : CTXL;
        const bool first = tl == 0, last = tl + 16 == sl;
        if (cc < 64) {
            const int c0 = 8 * cc; float w0[8], w1[8], w2[8];
#pragma unroll
            for (int j = 0; j < 8; ++j) { w0[j] = cw[c0 + j]; w1[j] = cw[512 + c0 + j]; w2[j] = cw[1024 + c0 + j]; }
            float up[8], uc[8], un[8], a[8], b[8];
            if (first) {
#pragma unroll
                for (int j = 0; j < 8; ++j) up[j] = 0.f;
            } else if (CONV_U) { ld8f(convb + (size_t)(r0 - 1) * 1536 + 512 + c0, up); }
            else { ld8f(convb + (size_t)(r0 - 1) * 1536 + 512 + c0, a); ld8f(convb + (size_t)(r0 - 1) * 1536 + 1024 + c0, b);
#pragma unroll
                for (int j = 0; j < 8; ++j) up[j] = a[j] * b[j]; }
            if (CONV_U) ld8f(convb + (size_t)r0 * 1536 + 512 + c0, uc);
            else { ld8f(convb + (size_t)r0 * 1536 + 512 + c0, a); ld8f(convb + (size_t)r0 * 1536 + 1024 + c0, b);
#pragma unroll
            for (int j = 0; j < 8; ++j) uc[j] = a[j] * b[j]; }
            for (int t = 0; t < 16; ++t) {
                const int r = r0 + t;
                if (t == 15 && last) {
#pragma unroll
                    for (int j = 0; j < 8; ++j) un[j] = 0.f;
                } else if (CONV_U) { ld8f(convb + (size_t)(r + 1) * 1536 + 512 + c0, un); }
                else { ld8f(convb + (size_t)(r + 1) * 1536 + 512 + c0, a); ld8f(convb + (size_t)(r + 1) * 1536 + 1024 + c0, b);
#pragma unroll
                    for (int j = 0; j < 8; ++j) un[j] = a[j] * b[j]; }
                float g[8], o[8]; ld8f(convb + (size_t)r * 1536 + c0, g);
#pragma unroll
                for (int j = 0; j < 8; ++j) { o[j] = g[j] * ((up[j] * w0[j] + uc[j] * w1[j]) + un[j] * w2[j]); up[j] = uc[j]; uc[j] = un[j]; }
                st8f(cat + (size_t)r * D + c0, o);
            }
        } else {
            const int c0 = 8 * (cc - 64); float w0[8], w1[8], w2[8], bb[8];
#pragma unroll
            for (int j = 0; j < 8; ++j) { w0[j] = sw[c0 + j]; w1[j] = sw[1024 + c0 + j]; w2[j] = sw[2048 + c0 + j]; bb[j] = sb[c0 + j]; }
            float up[8], uc[8], un[8];
            if (first) {
#pragma unroll
                for (int j = 0; j < 8; ++j) up[j] = 0.f;
            } else ld8f(xbcb + (size_t)(r0 - 1) * 1024 + c0, up);
            ld8f(xbcb + (size_t)r0 * 1024 + c0, uc);
            for (int t = 0; t < 16; ++t) {
                const int r = r0 + t;
                if (t == 15 && last) {
#pragma unroll
                    for (int j = 0; j < 8; ++j) un[j] = 0.f;
                } else ld8f(xbcb + (size_t)(r + 1) * 1024 + c0, un);
                float o[8];
#pragma unroll
                for (int j = 0; j < 8; ++j) { const float y = ((up[j] * w0[j] + uc[j] * w1[j]) + un[j] * w2[j]) + bb[j]; o[j] = silu_f(y); up[j] = uc[j]; uc[j] = un[j]; }
                st8f(xbcc + (size_t)r * 1024 + c0, o);
            }
        }
    }
}
__device__ __forceinline__ int chain_pos(int dir, int cn) { return dir == 0 ? cn : (cn < 2 ? 1 - cn : 67 - cn); }
__device__ __forceinline__ int crow(int r, int hi) { return (r & 3) + 8 * (r >> 2) + 4 * hi; }
__device__ __forceinline__ float softplus_f(float x) { return fmaxf(x, 0.f) + __logf(1.0f + __expf(-fabsf(x))); }
constexpr int TS = 136;

template <int SVAR = 0>
__device__ __forceinline__ void ssd_local_phase(Frame& F, const Params& P, int layer) {
    unsigned char* ws = fresh_ws(P.ws);
    const bf16* xbcc = (const bf16*)(ws + WS_XBCC); const float* dtb = (const float*)(ws + WS_DT);
    float* yd = (float*)(ws + WS_YD); float* cumb = (float*)(ws + WS_CUM); float* Sb = (float*)(ws + WS_SB); float* tot = (float*)(ws + WS_TOT);
    LAS bf16* Cs = (LAS bf16*)(F.lds); LAS bf16* Bs = (LAS bf16*)(F.lds + 34816); LAS bf16* XT = (LAS bf16*)(F.lds + 69632);
    LAS bf16* Gs = (LAS bf16*)(F.lds + 87040) + F.wave * 1280;
    LAS float* fa = (LAS float*)(F.lds + 107520);
    LAS float* daA = fa, *cumA = fa + 256, *dtA = fa + 512, *scA = fa + 768;
    const int wave = F.wave;
#if S1_PF
    v4u pfc[4], pfb[4], pfx[2]; float pfraw = 0.f;
#define S1_GLOAD(uid_) do { const int t_ = fresh_tid(F.wave); const int h_ = (uid_) & 7, b_ = ((uid_) >> 3) & 1, cn_ = (uid_) >> 4, g_ = h_ >> 2; \
        const int row0_ = cn_ < 2 ? NLAT + b_ * CTXL + 128 * cn_ : b_ * SEQ + 128 * (cn_ - 2); \
        _Pragma("unroll") for (int i = 0; i < 4; ++i) { const int q = t_ + 512 * i, s_ = q >> 4, c8 = (q & 15) * 8; \
            pfc[i] = *(const v4u*)(xbcc + (size_t)(row0_ + s_) * 1024 + 768 + g_ * 128 + c8); pfb[i] = *(const v4u*)(xbcc + (size_t)(row0_ + s_) * 1024 + 512 + g_ * 128 + c8); } \
        _Pragma("unroll") for (int i = 0; i < 2; ++i) { const int q = t_ + 512 * i, s_ = q & 127, p8 = (q >> 7) * 8; pfx[i] = *(const v4u*)(xbcc + (size_t)(row0_ + s_) * 1024 + h_ * 64 + p8); } \
        if (t_ < 256) { const int dir = t_ >> 7, s_ = t_ & 127; pfraw = dtb[(size_t)(row0_ + s_) * 16 + dir * 8 + h_] + P.in[I_DTB][layer * 16 + dir * 8 + h_]; } } while (0)
    if (F.vcu < NCH * NB * 8) S1_GLOAD(F.vcu);
#endif
    for (int uid = F.vcu; uid < NCH * NB * 8; uid += F.G) {
        const int tid = fresh_tid(F.wave), lane = tid & 63, r32 = lane & 31, hi = lane >> 5;
        const int h = uid & 7, b = (uid >> 3) & 1, cn = uid >> 4, g = h >> 2;
        const int row0 = cn < 2 ? NLAT + b * CTXL + 128 * cn : b * SEQ + 128 * (cn - 2);
#if S1_PF
#pragma unroll
        for (int i = 0; i < 4; ++i) { const int q = tid + 512 * i, s = q >> 4, c8 = (q & 15) * 8; *(LAS v4u*)(Cs + s * TS + c8) = pfc[i]; *(LAS v4u*)(Bs + s * TS + c8) = pfb[i]; }
#pragma unroll
        for (int i = 0; i < 2; ++i) { const int q = tid + 512 * i, s = q & 127, p8 = (q >> 7) * 8; const v4u w = pfx[i];
            XT[(p8 + 0) * TS + s] = (bf16)(w.x & 0xffff); XT[(p8 + 1) * TS + s] = (bf16)(w.x >> 16); XT[(p8 + 2) * TS + s] = (bf16)(w.y & 0xffff); XT[(p8 + 3) * TS + s] = (bf16)(w.y >> 16);
            XT[(p8 + 4) * TS + s] = (bf16)(w.z & 0xffff); XT[(p8 + 5) * TS + s] = (bf16)(w.z >> 16); XT[(p8 + 6) * TS + s] = (bf16)(w.w & 0xffff); XT[(p8 + 7) * TS + s] = (bf16)(w.w >> 16); }
        if (tid < 256) { const int dir = tid >> 7;
            const float dt = softplus_f(pfraw); const float A = -__expf(P.in[I_ALOG][layer * 16 + dir * 8 + h]);
            dtA[tid] = dt; daA[tid] = dt * A; }
        if (uid + F.G < NCH * NB * 8) S1_GLOAD(uid + F.G);
#else
#pragma unroll
        for (int i = 0; i < 4; ++i) { const int q = tid + 512 * i, s = q >> 4, c8 = (q & 15) * 8;
            *(LAS v4u*)(Cs + s * TS + c8) = *(const v4u*)(xbcc + (size_t)(row0 + s) * 1024 + 768 + g * 128 + c8);
            *(LAS v4u*)(Bs + s * TS + c8) = *(const v4u*)(xbcc + (size_t)(row0 + s) * 1024 + 512 + g * 128 + c8); }
#pragma unroll
        for (int i = 0; i < 2; ++i) { const int q = tid + 512 * i, s = q & 127, p8 = (q >> 7) * 8;
            const v4u w = *(const v4u*)(xbcc + (size_t)(row0 + s) * 1024 + h * 64 + p8);
            XT[(p8 + 0) * TS + s] = (bf16)(w.x & 0xffff); XT[(p8 + 1) * TS + s] = (bf16)(w.x >> 16); XT[(p8 + 2) * TS + s] = (bf16)(w.y & 0xffff); XT[(p8 + 3) * TS + s] = (bf16)(w.y >> 16);
            XT[(p8 + 4) * TS + s] = (bf16)(w.z & 0xffff); XT[(p8 + 5) * TS + s] = (bf16)(w.z >> 16); XT[(p8 + 6) * TS + s] = (bf16)(w.w & 0xffff); XT[(p8 + 7) * TS + s] = (bf16)(w.w >> 16); }
        if (tid < 256) { const int dir = tid >> 7, s = tid & 127;
            const float raw = dtb[(size_t)(row0 + s) * 16 + dir * 8 + h] + P.in[I_DTB][layer * 16 + dir * 8 + h];
            const float dt = softplus_f(raw); const float A = -__expf(P.in[I_ALOG][layer * 16 + dir * 8 + h]);
            dtA[tid] = dt; daA[tid] = dt * A; }
#endif
        __syncthreads();
        float cloc = 0.f;
        if (tid < 256) { const int dir = tid >> 7, s = tid & 127, b8 = s & ~7;
#pragma unroll
            for (int k = 0; k < 8; ++k) { const float a = daA[dir * 128 + b8 + k]; if (dir == 0 ? (b8 + k <= s) : (b8 + k >= s)) cloc += a; }
            if (dir == 0 ? ((s & 7) == 7) : ((s & 7) == 0)) scA[dir * 16 + (s >> 3)] = cloc; }
        __syncthreads();
        float cum = cloc, total = 0.f;
        if (tid < 256) { const int dir = tid >> 7, s = tid & 127, bi = s >> 3;
#pragma unroll
            for (int k = 0; k < 16; ++k) { const float a = scA[dir * 16 + k]; total += a; if (dir == 0 ? (k < bi) : (k > bi)) cum += a; } }
        __syncthreads();
        if (tid < 256) { const int dir = tid >> 7, s = tid & 127;
            cumA[tid] = cum; scA[tid] = __expf(total - cum) * dtA[tid];
            cumb[(size_t)(row0 + s) * 16 + dir * 8 + h] = cum;
            if (s == 0) tot[((dir * 2 + b) * 8 + h) * NCH + chain_pos(dir, cn)] = total; }
        __syncthreads();
        if (SVAR < 1 || SVAR == 4) {
            const int rb = wave >> 1, cb = wave & 1;
            f32x16 Y = {};
            float cl0[16], cl1[16];
#pragma unroll
            for (int r = 0; r < 16; ++r) { cl0[r] = cumA[32 * rb + crow(r, hi)]; cl1[r] = cumA[128 + 32 * rb + crow(r, hi)]; }
            for (int sb = 0; sb < 4; ++sb) {
                f32x16 CB = {};
#pragma unroll
                for (int ks = 0; ks < 8; ++ks) {
                    const bf16x8 a = *(const LAS bf16x8*)(Cs + (32 * rb + r32) * TS + 16 * ks + 8 * hi);
                    const bf16x8 bb = *(const LAS bf16x8*)(Bs + (32 * sb + r32) * TS + 16 * ks + 8 * hi);
                    CB = __builtin_amdgcn_mfma_f32_32x32x16_bf16(a, bb, CB, 0, 0, 0);
                }
                const int s = 32 * sb + r32; const float cs0 = cumA[s], cs1 = cumA[128 + s], d0 = dtA[s], d1 = dtA[128 + s];
#pragma unroll
                for (int r = 0; r < 16; ++r) { const int l = 32 * rb + crow(r, hi);
                    const float f0 = (s <= l) ? __expf(cl0[r] - cs0) * d0 : 0.f, f1 = (s >= l) ? __expf(cl1[r] - cs1) * d1 : 0.f;
                    Gs[crow(r, hi) * 40 + r32] = (bf16)f2bf(CB[r] * (f0 + f1)); }
                LDS_WAIT(); asm volatile("" ::: "memory");
#pragma unroll
                for (int k2 = 0; k2 < 2; ++k2) {
                    const bf16x8 ag = *(const LAS bf16x8*)(Gs + r32 * 40 + 16 * k2 + 8 * hi);
                    const bf16x8 bx = *(const LAS bf16x8*)(XT + (32 * cb + r32) * TS + 32 * sb + 16 * k2 + 8 * hi);
                    Y = __builtin_amdgcn_mfma_f32_32x32x16_bf16(ag, bx, Y, 0, 0, 0);
                }
                LDS_WAIT(); asm volatile("" ::: "memory");
            }
#if YD16
            {
                unsigned* yd16 = (unsigned*)yd; const int odd = r32 & 1;
#pragma unroll
                for (int r = 0; r < 16; r += 2) {
                    const float a = fminf(fmaxf(Y[r], -65504.f), 65504.f), bq = fminf(fmaxf(Y[r + 1], -65504.f), 65504.f);
                    const float pa = dpp_f(a, 0), pb = dpp_f(bq, 0);
                    const _Float16 lo = (_Float16)(odd ? pb : a), hh = (_Float16)(odd ? bq : pa);
                    const unsigned w = (unsigned)__builtin_bit_cast(unsigned short, lo) | ((unsigned)__builtin_bit_cast(unsigned short, hh) << 16);
                    yd16[((size_t)(row0 + 32 * rb + crow(r + odd, hi)) * 512 + h * 64 + 32 * cb + r32 - odd) >> 1] = w; }
            }
#else
#pragma unroll
            for (int r = 0; r < 16; ++r) yd[(size_t)(row0 + 32 * rb + crow(r, hi)) * 512 + h * 64 + 32 * cb + r32] = Y[r];
#endif
        }
        __syncthreads();
        LAS bf16* BT = Cs;
        if (SVAR < 2 || SVAR == 3) {
#pragma unroll
        for (int i = 0; i < 4; ++i) { const int q = tid + 512 * i, s = q & 127, n8 = (q >> 7) * 8; const v4u w = *(const LAS v4u*)(Bs + s * TS + n8);
            BT[(n8 + 0) * TS + s] = (bf16)(w.x & 0xffff); BT[(n8 + 1) * TS + s] = (bf16)(w.x >> 16); BT[(n8 + 2) * TS + s] = (bf16)(w.y & 0xffff); BT[(n8 + 3) * TS + s] = (bf16)(w.y >> 16);
            BT[(n8 + 4) * TS + s] = (bf16)(w.z & 0xffff); BT[(n8 + 5) * TS + s] = (bf16)(w.z >> 16); BT[(n8 + 6) * TS + s] = (bf16)(w.w & 0xffff); BT[(n8 + 7) * TS + s] = (bf16)(w.w >> 16); }
        __syncthreads();
        {
            const int dir = wave & 1, nb = wave >> 1;
            f32x16 S0 = {}, S1 = {};
#pragma unroll
            for (int ks = 0; ks < 8; ++ks) {
                const int s0 = 16 * ks + 8 * hi;
                const f32x4 sc0 = *(const LAS f32x4*)(scA + dir * 128 + s0), sc1 = *(const LAS f32x4*)(scA + dir * 128 + s0 + 4);
                const bf16x8 bb = *(const LAS bf16x8*)(BT + (32 * nb + r32) * TS + s0);
#pragma unroll
                for (int pb = 0; pb < 2; ++pb) {
                    const v4u xr = *(const LAS v4u*)(XT + (32 * pb + r32) * TS + s0);
                    v4u xs; xs.x = cvtpk(bflo(xr.x) * sc0[0], bfhi(xr.x) * sc0[1]); xs.y = cvtpk(bflo(xr.y) * sc0[2], bfhi(xr.y) * sc0[3]);
                    xs.z = cvtpk(bflo(xr.z) * sc1[0], bfhi(xr.z) * sc1[1]); xs.w = cvtpk(bflo(xr.w) * sc1[2], bfhi(xr.w) * sc1[3]);
                    const bf16x8 a = __builtin_bit_cast(bf16x8, xs);
                    if (pb == 0) S0 = __builtin_amdgcn_mfma_f32_32x32x16_bf16(a, bb, S0, 0, 0, 0); else S1 = __builtin_amdgcn_mfma_f32_32x32x16_bf16(a, bb, S1, 0, 0, 0);
                }
            }
#if S1_LDSST
            __syncthreads();
            LAS float* St = (LAS float*)F.lds;
#pragma unroll
            for (int r = 0; r < 16; ++r) { St[(dir * 64 + crow(r, hi)) * 128 + 32 * nb + r32] = S0[r]; St[(dir * 64 + 32 + crow(r, hi)) * 128 + 32 * nb + r32] = S1[r]; }
            __syncthreads();
            { const int tid3 = fresh_tid(F.wave);
#pragma unroll
              for (int i = 0; i < 8; ++i) { const int q = tid3 + 512 * i, d2 = q >> 11, e4 = (q & 2047) * 4;
                  float* sp2 = Sb + ((size_t)(((d2 * 2 + b) * 8 + h) * NCH + chain_pos(d2, cn))) * 8192;
                  *(f32x4*)(sp2 + e4) = *(const LAS f32x4*)(St + d2 * 8192 + e4); } }
#elif SB16
            { unsigned* sp16 = (unsigned*)Sb + ((size_t)(((dir * 2 + b) * 8 + h) * NCH + chain_pos(dir, cn))) * 4096;
              const int odd = r32 & 1;
#pragma unroll
              for (int r = 0; r < 16; ++r) {
                  const float p0 = dpp_f(S0[r], 0), p1 = dpp_f(S1[r], 0);
                  const unsigned w = odd ? cvtpk(p1, S1[r]) : cvtpk(S0[r], p0);
                  sp16[(size_t)((odd ? 32 : 0) + crow(r, hi)) * 64 + 16 * nb + (r32 >> 1)] = w; } }
#else
            float* sp = Sb + ((size_t)(((dir * 2 + b) * 8 + h) * NCH + chain_pos(dir, cn))) * 8192;
#pragma unroll
            for (int r = 0; r < 16; ++r) { if (SVAR == 3) { asm volatile("" :: "v"(S0[r]), "v"(S1[r])); } else if (S1_NT) { __builtin_nontemporal_store(S0[r], sp + (size_t)crow(r, hi) * 128 + 32 * nb + r32); __builtin_nontemporal_store(S1[r], sp + (size_t)(32 + crow(r, hi)) * 128 + 32 * nb + r32); } else { sp[(size_t)crow(r, hi) * 128 + 32 * nb + r32] = S0[r]; sp[(size_t)(32 + crow(r, hi)) * 128 + 32 * nb + r32] = S1[r]; } }
#endif
        }
        }
        __syncthreads();
    }
}

__device__ __forceinline__ void ssd_scan_phase(Frame& F, const Params& P) {
    unsigned char* ws = fresh_ws(P.ws);
    bf16* Hp = (bf16*)(ws + WS_HP); const float* tot = (const float*)(ws + WS_TOT);
    const Lane L(F.wave);
#if SB16
    const unsigned* Sb = (const unsigned*)(ws + WS_SB);
    for (int e = F.vcu * 512 + L.tid; e < 32 * 4096; e += F.G * 512) {
        const int chain = e >> 12, idx = e & 4095;
        const unsigned* sp = Sb + (size_t)chain * NCH * 4096 + idx; unsigned* hp = (unsigned*)Hp + (size_t)chain * NCH * 4096 + idx; const float* tp = tot + chain * NCH;
        float H0 = 0.f, H1 = 0.f;
        for (int i0 = 0; i0 < NCH; i0 += S2_DEPTH) {
            unsigned sv[S2_DEPTH]; float dv[S2_DEPTH];
#pragma unroll
            for (int q = 0; q < S2_DEPTH; ++q) { sv[q] = sp[(size_t)(i0 + q) * 4096]; dv[q] = __expf(tp[i0 + q]); }
#pragma unroll
            for (int q = 0; q < S2_DEPTH; ++q) { hp[(size_t)(i0 + q) * 4096] = cvtpk(H0, H1); H0 = dv[q] * H0 + bflo(sv[q]); H1 = dv[q] * H1 + bfhi(sv[q]); }
        }
    }
#else
    const float* Sb = (const float*)(ws + WS_SB);
    for (int e = F.vcu * 512 + L.tid; e < 32 * 8192; e += F.G * 512) {
        const int chain = e >> 13, idx = e & 8191;
        const float* sp = Sb + (size_t)chain * NCH * 8192 + idx; bf16* hp = Hp + (size_t)chain * NCH * 8192 + idx; const float* tp = tot + chain * NCH;
        float H = 0.f;
        for (int i0 = 0; i0 < NCH; i0 += 6) {
            float sv[6], dv[6];
#pragma unroll
            for (int q = 0; q < 6; ++q) { sv[q] = sp[(size_t)(i0 + q) * 8192]; dv[q] = __expf(tp[i0 + q]); }
#pragma unroll
            for (int q = 0; q < 6; ++q) { hp[(size_t)(i0 + q) * 8192] = (bf16)f2bf(H); H = dv[q] * H + sv[q]; }
        }
    }
#endif
}

__device__ __forceinline__ void ssd_out_phase(Frame& F, const Params& P, int layer) {
    unsigned char* ws = fresh_ws(P.ws);
    const bf16* xbcc = (const bf16*)(ws + WS_XBCC); const bf16* zb = (const bf16*)(ws + WS_Z); const float* yd = (const float*)(ws + WS_YD); const float* cumb = (const float*)(ws + WS_CUM);
    const bf16* Hp = (const bf16*)(ws + WS_HP); bf16* cat = (bf16*)(ws + WS_CAT);
    constexpr int YS = 260;
    LAS bf16* Cs = (LAS bf16*)(F.lds); LAS float* ec = (LAS float*)(F.lds + 34816); LAS float* Yl = (LAS float*)(F.lds + 34816 + 4096);
    const int wave = F.wave;
    for (int uid = (layer == 1 ? 8 : 0) + F.vcu; uid < NCH * NB * 2; uid += F.G) {
        const int tid = fresh_tid(F.wave), lane = tid & 63, r32 = lane & 31, hi = lane >> 5;
        const int g = uid & 1, b = (uid >> 1) & 1, cn = uid >> 2;
        const int row0 = cn < 2 ? NLAT + b * CTXL + 128 * cn : b * SEQ + 128 * (cn - 2);
#pragma unroll
        for (int i = 0; i < 4; ++i) { const int q = tid + 512 * i, s = q >> 4, c8 = (q & 15) * 8;
            *(LAS v4u*)(Cs + s * TS + c8) = *(const v4u*)(xbcc + (size_t)(row0 + s) * 1024 + 768 + g * 128 + c8); }
#pragma unroll
        for (int i = 0; i < 2; ++i) { const int idx = tid + 512 * i, hd = idx >> 7, s = idx & 127; ec[idx] = __expf(cumb[(size_t)(row0 + s) * 16 + (hd & 1) * 8 + 4 * g + (hd >> 1)]); }
        __syncthreads();
        const int hh = wave >> 1, cb = wave & 1, h = 4 * g + hh;
        f32x16 ys[4] = {};
        {
            bf16x8 Hf[2][8];
#pragma unroll
            for (int dir = 0; dir < 2; ++dir) {
                const bf16* hp = Hp + ((size_t)(((dir * 2 + b) * 8 + h) * NCH + chain_pos(dir, cn))) * 8192 + (size_t)(32 * cb + r32) * 128 + 8 * hi;
#pragma unroll
                for (int ks = 0; ks < 8; ++ks) Hf[dir][ks] = *(const bf16x8*)(hp + 16 * ks);
            }
#pragma unroll
            for (int rb = 0; rb < 4; ++rb) {
                bf16x8 af[8];
#pragma unroll
                for (int ks = 0; ks < 8; ++ks) af[ks] = *(const LAS bf16x8*)(Cs + (32 * rb + r32) * TS + 16 * ks + 8 * hi);
#pragma unroll
                for (int dir = 0; dir < 2; ++dir) {
                    f32x16 a0 = {};
#pragma unroll
                    for (int ks = 0; ks < 8; ++ks) a0 = __builtin_amdgcn_mfma_f32_32x32x16_bf16(af[ks], Hf[dir][ks], a0, 0, 0, 0);
#pragma unroll
                    for (int r = 0; r < 16; ++r) ys[rb][r] += a0[r] * ec[(hh * 2 + dir) * 128 + 32 * rb + crow(r, hi)];
                }
                asm volatile("" ::: "memory");
            }
        }
        const int lane2 = fresh_tid(F.wave) & 63;
        const float dsk = P.in[I_SSDD][layer * 8 + 4 * g + (lane2 >> 4)];
        const f32x4 ng = *(const f32x4*)(P.in[I_SNORM] + layer * 512 + g * 256 + 4 * lane2);
#pragma unroll
        for (int half = 0; half < 2; ++half) {
#pragma unroll
            for (int rb2 = 0; rb2 < 2; ++rb2)
#pragma unroll
                for (int r = 0; r < 16; ++r) Yl[(32 * rb2 + crow(r, hi)) * YS + hh * 64 + 32 * cb + r32] = ys[2 * half + rb2][r];
            __syncthreads();
#pragma unroll 2
            for (int q = 0; q < 8; ++q) {
                const int rl = 8 * wave + q, row = row0 + 64 * half + rl;
                const f32x4 yo = *(const LAS f32x4*)(Yl + rl * YS + 4 * lane2);
#if YD16
                f32x4 ydv; { const v2u yw = *(const v2u*)((const unsigned short*)yd + (size_t)row * 512 + g * 256 + 4 * lane2);
                  ydv[0] = (float)__builtin_bit_cast(_Float16, (unsigned short)(yw.x & 0xffff)); ydv[1] = (float)__builtin_bit_cast(_Float16, (unsigned short)(yw.x >> 16));
                  ydv[2] = (float)__builtin_bit_cast(_Float16, (unsigned short)(yw.y & 0xffff)); ydv[3] = (float)__builtin_bit_cast(_Float16, (unsigned short)(yw.y >> 16)); }
#else
                const f32x4 ydv = *(const f32x4*)(yd + (size_t)row * 512 + g * 256 + 4 * lane2);
#endif
                const v2u xv = *(const v2u*)(xbcc + (size_t)row * 1024 + g * 256 + 4 * lane2), zv = *(const v2u*)(zb + (size_t)row * 512 + g * 256 + 4 * lane2);
                f32x4 u;
                u[0] = (yo[0] + ydv[0] + dsk * bflo(xv.x)) * silu_f(bflo(zv.x)); u[1] = (yo[1] + ydv[1] + dsk * bfhi(xv.x)) * silu_f(bfhi(zv.x));
                u[2] = (yo[2] + ydv[2] + dsk * bflo(xv.y)) * silu_f(bflo(zv.y)); u[3] = (yo[3] + ydv[3] + dsk * bfhi(xv.y)) * silu_f(bfhi(zv.y));
                const float ss = wave_sum((u[0] * u[0] + u[1] * u[1]) + (u[2] * u[2] + u[3] * u[3]));
                const float rstd = 1.0f / sqrtf(ss * (1.0f / 256.0f) + NORM_EPS);
                v2u o; o.x = cvtpk(u[0] * rstd * ng[0], u[1] * rstd * ng[1]); o.y = cvtpk(u[2] * rstd * ng[2], u[3] * rstd * ng[3]);
                *(v2u*)(cat + (size_t)row * D + 512 + g * 256 + 4 * lane2) = o;
            }
            __syncthreads();
        }
    }
}
namespace att {
constexpr int KVBLK = 64, LDQ = 1024, LDK = 1024;
constexpr float SCALE = 0.125f;
constexpr float THR = 8.f;
constexpr size_t SHM_V = KVBLK * 128 * 2, SHM_K = KVBLK * 128 * 2;
#define KSWZ(row, colB) ((row) * 256 + ((colB) ^ (((row) & 7) << 4)))
#define SBAR() __builtin_amdgcn_sched_barrier(0)
constexpr float THRL = 11.5f;
#if ATT_FP8
constexpr float WLO = 0.5f, WHI = 7.5f, WMID = 4.0f;
#else
constexpr float WLO = -THRL, WHI = THRL, WMID = 0.f;
#endif
typedef int v8i __attribute__((ext_vector_type(8)));
__device__ __forceinline__ float max3f(float a, float b, float c) { return __builtin_fmaxf(__builtin_fmaxf(a, b), c); }
#if ATT_NEGM
typedef f32x16 mref_t;
#define MREF_INIT f32x16{}
__device__ __forceinline__ f32x16 mref_acc(const mref_t& m) { return m; }
#else
typedef float mref_t;
#define MREF_INIT 0.f
__device__ __forceinline__ f32x16 mref_acc(const mref_t&) { return f32x16{}; }
#endif
template <bool DOEXP = true>
__device__ __forceinline__ void partialSM(f32x16& p0, f32x16& p1, mref_t& mref, float& alpha) {
  float pmax = max3f(p0[0], p0[1], p0[2]);
#pragma unroll
  for (int r = 3; r < 15; r += 2) pmax = max3f(pmax, p0[r], p0[r + 1]);
  pmax = max3f(pmax, p0[15], p1[0]);
#pragma unroll
  for (int r = 1; r < 15; r += 2) pmax = max3f(pmax, p1[r], p1[r + 1]);
  pmax = fmaxf(pmax, p1[15]);
  pmax = cross_max(pmax);
#if ATT_NEGM
  if (__builtin_expect(__all(pmax >= WLO && pmax <= WHI), 1)) { alpha = 1.f; }
  else {
    const float d = (pmax < WLO || pmax > WHI) ? pmax - WMID : 0.f;
    alpha = __builtin_amdgcn_exp2f(-d);
#pragma unroll
    for (int r = 0; r < 16; ++r) { p0[r] -= d; p1[r] -= d; mref[r] -= d; }
  }
#else
  if (__builtin_expect(__all(fabsf(pmax - mref) <= THRL), 1)) { alpha = 1.f; }
  else { const float d = fabsf(pmax - mref) > THRL ? pmax - mref : 0.f; alpha = __builtin_amdgcn_exp2f(-d); mref += d; }
#pragma unroll
  for (int r = 0; r < 16; ++r) { p0[r] -= mref; p1[r] -= mref; }
#endif
  if constexpr (DOEXP) {
#pragma unroll
  for (int r = 0; r < 16; ++r) p0[r] = __builtin_amdgcn_exp2f(p0[r]);
  }
}
__device__ __forceinline__ void finishSM(f32x16& p0, f32x16& p1, float alpha, float& l_reg, bf16x8& pa0, bf16x8& pa1, bf16x8& pa2, bf16x8& pa3) {
#pragma unroll
  for (int r = 0; r < 16; ++r) p1[r] = __builtin_amdgcn_exp2f(p1[r]);
#if !ATT_LMFMA
  float ps = 0;
#pragma unroll
  for (int r = 0; r < 16; ++r) ps += p0[r];
#pragma unroll
  for (int r = 0; r < 16; ++r) ps += p1[r];
  ps = cross_sum(ps);
  l_reg = l_reg * alpha + ps;
#else
  (void)alpha; (void)l_reg;
#endif
#define PK4(P, BASE, OUT) do { unsigned a0 = cvtpk(P[BASE + 0], P[BASE + 1]), a1 = cvtpk(P[BASE + 2], P[BASE + 3]);   \
    unsigned b0 = cvtpk(P[BASE + 4], P[BASE + 5]), b1 = cvtpk(P[BASE + 6], P[BASE + 7]);                              \
    if (!ATT_NOSWAP) { swap32u(a0, b0); swap32u(a1, b1); } \
    v4u w = {a0, a1, b0, b1}; OUT = __builtin_bit_cast(bf16x8, w); } while (0)
  PK4(p0, 0, pa0); PK4(p0, 8, pa1); PK4(p1, 0, pa2); PK4(p1, 8, pa3);
#undef PK4
}

#if ATT_FP8
__device__ __forceinline__ void finishSM8(f32x16& p0, f32x16& p1, float alpha, float& l_reg, v8i& P8) {
#pragma unroll
  for (int r = 0; r < 16; ++r) p1[r] = __builtin_amdgcn_exp2f(p1[r]);
  float ps = 0;
#pragma unroll
  for (int r = 0; r < 16; ++r) ps += p0[r];
#pragma unroll
  for (int r = 0; r < 16; ++r) ps += p1[r];
  ps = cross_sum(ps);
  l_reg = l_reg * alpha + ps;
#pragma unroll
  for (int w = 0; w < 4; ++w) {
    P8[w]     = __builtin_amdgcn_cvt_pk_fp8_f32(p0[4 * w + 2], p0[4 * w + 3], __builtin_amdgcn_cvt_pk_fp8_f32(p0[4 * w], p0[4 * w + 1], 0, false), true);
    P8[4 + w] = __builtin_amdgcn_cvt_pk_fp8_f32(p1[4 * w + 2], p1[4 * w + 3], __builtin_amdgcn_cvt_pk_fp8_f32(p1[4 * w], p1[4 * w + 1], 0, false), true);
  }
}
__device__ __forceinline__ void pv8(f32x16* o, const LAS char* vb, const v8i& P8) {
  v4u lo[4], hh[4];
#pragma unroll
  for (int d0 = 0; d0 < 4; ++d0) { lo[d0] = *(const LAS v4u*)(vb + d0 * 2048); hh[d0] = *(const LAS v4u*)(vb + d0 * 2048 + 512); }
#pragma unroll
  for (int d0 = 0; d0 < 4; ++d0) {
    v8i B; B[0] = (int)lo[d0].x; B[1] = (int)lo[d0].y; B[2] = (int)lo[d0].z; B[3] = (int)lo[d0].w; B[4] = (int)hh[d0].x; B[5] = (int)hh[d0].y; B[6] = (int)hh[d0].z; B[7] = (int)hh[d0].w;
    o[d0] = __builtin_amdgcn_mfma_scale_f32_32x32x64_f8f6f4(P8, B, o[d0], 0, 0, 0, 0x7F7F7F7F, 0, 0x7F7F7F7F);
  }
}
__device__ __forceinline__ void pv8_exp(f32x16* o, const LAS char* vb, const v8i& P8, f32x16& pn) {
  v4u lo[4], hh[4];
#pragma unroll
  for (int d0 = 0; d0 < 4; ++d0) { lo[d0] = *(const LAS v4u*)(vb + d0 * 2048); hh[d0] = *(const LAS v4u*)(vb + d0 * 2048 + 512); }
  asm volatile("s_waitcnt lgkmcnt(0)" ::: "memory"); SBAR();
#pragma unroll
  for (int d0 = 0; d0 < 4; ++d0) {
    v8i B; B[0] = (int)lo[d0].x; B[1] = (int)lo[d0].y; B[2] = (int)lo[d0].z; B[3] = (int)lo[d0].w; B[4] = (int)hh[d0].x; B[5] = (int)hh[d0].y; B[6] = (int)hh[d0].z; B[7] = (int)hh[d0].w;
    o[d0] = __builtin_amdgcn_mfma_scale_f32_32x32x64_f8f6f4(P8, B, o[d0], 0, 0, 0, 0x7F7F7F7F, 0, 0x7F7F7F7F);
#pragma unroll
    for (int r = 0; r < 4; ++r) pn[4 * d0 + r] = __builtin_amdgcn_exp2f(pn[4 * d0 + r]);
  }
  asm volatile("" :: "v"(pn[0]), "v"(pn[1]), "v"(pn[2]), "v"(pn[3]), "v"(pn[4]), "v"(pn[5]), "v"(pn[6]), "v"(pn[7]), "v"(pn[8]), "v"(pn[9]), "v"(pn[10]), "v"(pn[11]), "v"(pn[12]), "v"(pn[13]), "v"(pn[14]), "v"(pn[15]));
#pragma unroll
  for (int d0 = 0; d0 < 4; ++d0) { __builtin_amdgcn_sched_group_barrier(0x008, 1, 0); __builtin_amdgcn_sched_group_barrier(PVX_MASK, 4, 0); }
  SBAR();
}

constexpr float YB = 56.0f + Y8_C, YLO = 8.0f * WLO + YB, YHI = 8.0f * WHI + YB, YMID = 8.0f * WMID + YB;
__device__ __forceinline__ void partialSMY(f32x16& p0, f32x16& p1, mref_t& mref, float& alpha) {
  float pmax = max3f(p0[0], p0[1], p0[2]);
#pragma unroll
  for (int r = 3; r < 15; r += 2) pmax = max3f(pmax, p0[r], p0[r + 1]);
  pmax = max3f(pmax, p0[15], p1[0]);
#pragma unroll
  for (int r = 1; r < 15; r += 2) pmax = max3f(pmax, p1[r], p1[r + 1]);
  pmax = fmaxf(pmax, p1[15]);
  pmax = cross_max(pmax);
  if (__builtin_expect(__all(pmax >= YLO && pmax <= YHI), 1)) { alpha = 1.f; }
  else {
    const float d = (pmax < YLO || pmax > YHI) ? 8.0f * __builtin_rintf((pmax - YMID) * 0.125f) : 0.f;
    alpha = __builtin_amdgcn_exp2f(-0.125f * d);
#pragma unroll
    for (int r = 0; r < 16; ++r) { p0[r] -= d; p1[r] -= d; mref[r] -= d; }
  }
}
__device__ __forceinline__ void finishSMY(const f32x16& p0, const f32x16& p1, v8i& P8) {
#pragma unroll
  for (int w = 0; w < 4; ++w) {
    unsigned a = 0u, b = 0u;
#pragma unroll
    for (int i = 0; i < 4; ++i) { a = __builtin_amdgcn_cvt_pk_u8_f32(p0[4 * w + i], (unsigned)i, a); b = __builtin_amdgcn_cvt_pk_u8_f32(p1[4 * w + i], (unsigned)i, b); }
    P8[w] = (int)a; P8[4 + w] = (int)b;
  }
}
__device__ __forceinline__ void pv8s(f32x16* o, f32x16& lacc, const LAS char* vb, const v8i& P8) {
  v4u lo[4], hh[4];
#pragma unroll
  for (int d0 = 0; d0 < 4; ++d0) { lo[d0] = *(const LAS v4u*)(vb + d0 * 2048); hh[d0] = *(const LAS v4u*)(vb + d0 * 2048 + 512); }
  if (ATT_PRIO) __builtin_amdgcn_s_setprio(1);
  { const v8i ones = {0x38383838, 0x38383838, 0x38383838, 0x38383838, 0x38383838, 0x38383838, 0x38383838, 0x38383838};
    lacc = __builtin_amdgcn_mfma_scale_f32_32x32x64_f8f6f4(P8, ones, lacc, 0, 0, 0, 0x7F7F7F7F, 0, 0x7F7F7F7F); }
#pragma unroll
  for (int d0 = 0; d0 < 4; ++d0) {
    v8i B; B[0] = (int)lo[d0].x; B[1] = (int)lo[d0].y; B[2] = (int)lo[d0].z; B[3] = (int)lo[d0].w; B[4] = (int)hh[d0].x; B[5] = (int)hh[d0].y; B[6] = (int)hh[d0].z; B[7] = (int)hh[d0].w;
    o[d0] = __builtin_amdgcn_mfma_scale_f32_32x32x64_f8f6f4(P8, B, o[d0], 0, 0, 0, 0x7F7F7F7F, 0, 0x7F7F7F7F);
  }
  if (ATT_PRIO) __builtin_amdgcn_s_setprio(0);
}
#endif
__device__ __forceinline__ void qkt(f32x16& p0, f32x16& p1, const LAS char* Ks, const bf16x8* qr, int r32, int hi, int map, const mref_t& negm) {
  p0 = mref_acc(negm); p1 = p0;
#pragma unroll
  for (int d0 = 0; d0 < 4; ++d0) { int cb = (map * 64 + d0 * 16 + hi * 8) * 2;
    bf16x8 b0 = *(const LAS bf16x8*)(Ks + KSWZ(r32, cb));
    bf16x8 b1 = *(const LAS bf16x8*)(Ks + KSWZ(32 + r32, cb));
    p0 = __builtin_amdgcn_mfma_f32_32x32x16_bf16(b0, qr[d0], p0, 0, 0, 0);
    p1 = __builtin_amdgcn_mfma_f32_32x32x16_bf16(b1, qr[d0], p1, 0, 0, 0); }
}
#if ATT_NOSWAP
__device__ __forceinline__ int v_st(int k, int c) { return ((k >> 3) * 4 + (c >> 5)) * 512 + ((k & 7) * 32 + (c & 31)) * 2; }
#else
__device__ __forceinline__ int v_st(int k, int c) { const int kk = (k & ~0xC) | ((k & 4) << 1) | ((k & 8) >> 1); return ((kk >> 3) * 4 + (c >> 5)) * 512 + ((kk & 7) * 32 + (c & 31)) * 2; }
#endif
__device__ __forceinline__ int v_rd_base(int lane) { return ((lane & 3) << 3) | (((lane >> 2) & 3) << 6) | (((lane >> 4) & 1) << 5) | (((lane >> 5) & 1) << 8); }
constexpr int v_rd_off(int d0, int ks, int half) { return d0 * 512 + ks * 4096 + half * 2048; }
template <int OFF> __device__ __forceinline__ s16x4 tr_read(int vb) {
  s16x4 r; asm volatile("ds_read_b64_tr_b16 %0, %1 offset:%2" : "=&v"(r) : "v"(vb), "i"(OFF) : "memory"); return r;
}
struct VG { s16x4 l0, h0, l1, h1, l2, h2, l3, h3; };
template <int D0> __device__ __forceinline__ void pv_load(VG& g, int vb) {
  g.l0 = tr_read<v_rd_off(D0, 0, 0)>(vb); g.h0 = tr_read<v_rd_off(D0, 0, 1)>(vb); g.l1 = tr_read<v_rd_off(D0, 1, 0)>(vb); g.h1 = tr_read<v_rd_off(D0, 1, 1)>(vb);
  g.l2 = tr_read<v_rd_off(D0, 2, 0)>(vb); g.h2 = tr_read<v_rd_off(D0, 2, 1)>(vb); g.l3 = tr_read<v_rd_off(D0, 3, 0)>(vb); g.h3 = tr_read<v_rd_off(D0, 3, 1)>(vb);
}
__device__ __forceinline__ void pv_mma(f32x16& od, const VG& g, bf16x8 pa0, bf16x8 pa1, bf16x8 pa2, bf16x8 pa3) {
#define PK(L, H) (bf16x8){L[0], L[1], L[2], L[3], H[0], H[1], H[2], H[3]}
  od = __builtin_amdgcn_mfma_f32_32x32x16_bf16(pa0, PK(g.l0, g.h0), od, 0, 0, 0);
  od = __builtin_amdgcn_mfma_f32_32x32x16_bf16(pa1, PK(g.l1, g.h1), od, 0, 0, 0);
  od = __builtin_amdgcn_mfma_f32_32x32x16_bf16(pa2, PK(g.l2, g.h2), od, 0, 0, 0);
  od = __builtin_amdgcn_mfma_f32_32x32x16_bf16(pa3, PK(g.l3, g.h3), od, 0, 0, 0);
#undef PK
}
__device__ __forceinline__ void pv_d0(f32x16* o, int vb, bf16x8 pa0, bf16x8 pa1, bf16x8 pa2, bf16x8 pa3, f32x16& lacc) {
#if ATT_LMFMA
  { const bf16x8 ones = {0x3F80, 0x3F80, 0x3F80, 0x3F80, 0x3F80, 0x3F80, 0x3F80, 0x3F80};
    lacc = __builtin_amdgcn_mfma_f32_32x32x16_bf16(pa0, ones, lacc, 0, 0, 0); lacc = __builtin_amdgcn_mfma_f32_32x32x16_bf16(pa1, ones, lacc, 0, 0, 0);
    lacc = __builtin_amdgcn_mfma_f32_32x32x16_bf16(pa2, ones, lacc, 0, 0, 0); lacc = __builtin_amdgcn_mfma_f32_32x32x16_bf16(pa3, ones, lacc, 0, 0, 0); }
#endif
#if ATT_PVPF
  VG ga, gb;
  pv_load<0>(ga, vb); pv_load<1>(gb, vb);
  asm volatile("s_waitcnt lgkmcnt(8)" ::: "memory"); SBAR(); pv_mma(o[0], ga, pa0, pa1, pa2, pa3);
  pv_load<2>(ga, vb);
  asm volatile("s_waitcnt lgkmcnt(8)" ::: "memory"); SBAR(); pv_mma(o[1], gb, pa0, pa1, pa2, pa3);
  pv_load<3>(gb, vb);
  asm volatile("s_waitcnt lgkmcnt(8)" ::: "memory"); SBAR(); pv_mma(o[2], ga, pa0, pa1, pa2, pa3);
  asm volatile("s_waitcnt lgkmcnt(0)" ::: "memory"); SBAR(); pv_mma(o[3], gb, pa0, pa1, pa2, pa3);
#else
  VG g;
  pv_load<0>(g, vb); asm volatile("s_waitcnt lgkmcnt(0)" ::: "memory"); SBAR(); pv_mma(o[0], g, pa0, pa1, pa2, pa3);
  pv_load<1>(g, vb); asm volatile("s_waitcnt lgkmcnt(0)" ::: "memory"); SBAR(); pv_mma(o[1], g, pa0, pa1, pa2, pa3);
  pv_load<2>(g, vb); asm volatile("s_waitcnt lgkmcnt(0)" ::: "memory"); SBAR(); pv_mma(o[2], g, pa0, pa1, pa2, pa3);
  pv_load<3>(g, vb); asm volatile("s_waitcnt lgkmcnt(0)" ::: "memory"); SBAR(); pv_mma(o[3], g, pa0, pa1, pa2, pa3);
#endif
}
template <int VAR>
__device__ __forceinline__ void diff_attn_unit(const bf16* __restrict__ Qb, const bf16* __restrict__ Kh, const bf16* __restrict__ Vh, bf16* __restrict__ Ob, int seq, LAS char* lds,
                                               float lam, const float* gsub, float oscale, const int wave, const unsigned char* V8h, const unsigned char* q8base = nullptr) {
  const int tid = fresh_tid(wave), wid = tid >> 6, lane = tid & 63, r32 = lane & 31, hi = lane >> 5, map = wid >> 2, wq = wid & 3;
  constexpr int BUFB = (int)(SHM_V + SHM_K), WSF_OFF = RING_BYTES + 1024;
  LAS float* wsf = (LAS float*)(lds + WSF_OFF) + wid * 64; LAS float* li_l = wsf; LAS float* al_l = wsf + 32;
  float l_reg = 0; f32x16 o[4], lacc; mref_t negm = MREF_INIT; bf16x8 qr[4];
  { float zf_ = 0.f; asm volatile("" : "+v"(zf_));
#pragma unroll
    for (int r = 0; r < 16; ++r) { lacc[r] = zf_; o[0][r] = zf_; o[1][r] = zf_; o[2][r] = zf_; o[3][r] = zf_; } }
  const bf16* Qw = Qb + (long)(wq * 32 + r32) * LDQ + map * 64 + hi * 8;
#pragma unroll
  for (int d0 = 0; d0 < 4; ++d0) { const v4u w = *reinterpret_cast<const v4u*>(Qw + d0 * 16); constexpr float C = SCALE * 1.4426950408889634f;
    v4u q; q.x = cvtpk(bflo(w.x) * C, bfhi(w.x) * C); q.y = cvtpk(bflo(w.y) * C, bfhi(w.y) * C); q.z = cvtpk(bflo(w.z) * C, bfhi(w.z) * C); q.w = cvtpk(bflo(w.w) * C, bfhi(w.w) * C);
    qr[d0] = __builtin_bit_cast(bf16x8, q); }
#if ATT_DMA && ATT_FP8 && ATT_QK8
  constexpr int TB = 16384, LEAD = ATT_LEAD, NBUF = LEAD > 2 ? 8 : 4;
  const unsigned pcoff = (unsigned)(wid * 1024 + lane * 16);
  const LAS char* vrd = lds + hi * 1024 + r32 * 16;
  const LAS char* krd = lds + 8192 + (map * 2 + hi) * 2048 + r32 * 16;
  v8i P8, Q8;
#if Q8_DIRECT
  {
    const unsigned char* q8b = (const unsigned char*)q8base; const long off_ = (const unsigned char*)Qb - q8b; const int row_ = (int)(off_ >> 10) + wq * 32 + r32, hcol_ = (int)(off_ & 1023) + map * 64 + hi * 32;
    const unsigned char* q8 = q8b + (size_t)(row_ >> 4) * 16384 + (size_t)(hcol_ >> 3) * 128 + (row_ & 15) * 8;
    const v2u a_ = *(const v2u*)q8, b_ = *(const v2u*)(q8 + 128), c_ = *(const v2u*)(q8 + 256), d_ = *(const v2u*)(q8 + 384);
    Q8 = (v8i){(int)a_.x, (int)a_.y, (int)b_.x, (int)b_.y, (int)c_.x, (int)c_.y, (int)d_.x, (int)d_.y}; }
#else
  { constexpr float C = SCALE * 1.4426950408889634f * (ATT_Y8 ? 8.0f : 1.0f); const bf16* qp = Qb + (long)(wq * 32 + r32) * LDQ + map * 64 + hi * 32;
#pragma unroll
    for (int w4 = 0; w4 < 4; ++w4) { float a[8]; ld8f(qp + 8 * w4, a);
      Q8[2 * w4]     = __builtin_amdgcn_cvt_pk_fp8_f32(a[2] * C, a[3] * C, __builtin_amdgcn_cvt_pk_fp8_f32(a[0] * C, a[1] * C, 0, false), true);
      Q8[2 * w4 + 1] = __builtin_amdgcn_cvt_pk_fp8_f32(a[6] * C, a[7] * C, __builtin_amdgcn_cvt_pk_fp8_f32(a[4] * C, a[5] * C, 0, false), true); } }
#endif
  const unsigned char* K8h = V8h + (WS_K8 - WS_V8);
#define DMA(t_) do { const int bo_ = ((t_) & (NBUF - 1)) * TB; \
    __builtin_amdgcn_global_load_lds((const unsigned*)(V8h + (size_t)(t_) * 65536 + pcoff), (LAS unsigned*)(lds + bo_ + wid * 1024), 16, 0, 0); \
    __builtin_amdgcn_global_load_lds((const unsigned*)(K8h + (size_t)(t_) * 65536 + pcoff), (LAS unsigned*)(lds + bo_ + 8192 + wid * 1024), 16, 0, 0); } while (0)
#define RESC(a) do { if (__any((a) != 1.f)) { if (hi == 0) al_l[r32] = (a); asm volatile("s_waitcnt lgkmcnt(0)" ::: "memory"); \
    _Pragma("unroll") for (int r = 0; r < 16; ++r) { const float a_ = al_l[crow(r, hi)]; lacc[r] *= a_; _Pragma("unroll") for (int d = 0; d < 4; ++d) o[d][r] *= a_; } } } while (0)
#define TBAR() do { asm volatile("s_waitcnt lgkmcnt(0)" ::: "memory"); __builtin_amdgcn_s_barrier(); asm volatile("" ::: "memory"); } while (0)
#if ATT_KPF || ATT_P2
  v8i kfa, kfb;
#define KLOAD(t_) do { const LAS char* kb_ = krd + ((t_) & (NBUF - 1)) * TB; \
    const v4u k0l = *(const LAS v4u*)(kb_), k0h = *(const LAS v4u*)(kb_ + 1024), k1l = *(const LAS v4u*)(kb_ + 512), k1h = *(const LAS v4u*)(kb_ + 1536); \
    kfa = (v8i){(int)k0l.x, (int)k0l.y, (int)k0l.z, (int)k0l.w, (int)k0h.x, (int)k0h.y, (int)k0h.z, (int)k0h.w}; kfb = (v8i){(int)k1l.x, (int)k1l.y, (int)k1l.z, (int)k1l.w, (int)k1h.x, (int)k1h.y, (int)k1h.z, (int)k1h.w}; } while (0)
#define QK8(P0, P1, t_) do { \
    P0 = __builtin_amdgcn_mfma_scale_f32_32x32x64_f8f6f4(kfa, Q8, mref_acc(negm), 0, 0, 0, 0x7F7F7F7F, 0, 0x7F7F7F7F); \
    P1 = __builtin_amdgcn_mfma_scale_f32_32x32x64_f8f6f4(kfb, Q8, mref_acc(negm), 0, 0, 0, 0x7F7F7F7F, 0, 0x7F7F7F7F); \
    SBAR(); if ((t_) + 1 < NT) KLOAD((t_) + 1); } while (0)
#else
#define KLOAD(t_) do {} while (0)
#define QK8(P0, P1, t_) do { const LAS char* kb_ = krd + ((t_) & (NBUF - 1)) * TB; \
    const v4u k0l = *(const LAS v4u*)(kb_), k0h = *(const LAS v4u*)(kb_ + 1024), k1l = *(const LAS v4u*)(kb_ + 512), k1h = *(const LAS v4u*)(kb_ + 1536); \
    v8i ka_ = {(int)k0l.x, (int)k0l.y, (int)k0l.z, (int)k0l.w, (int)k0h.x, (int)k0h.y, (int)k0h.z, (int)k0h.w}, kb2_ = {(int)k1l.x, (int)k1l.y, (int)k1l.z, (int)k1l.w, (int)k1h.x, (int)k1h.y, (int)k1h.z, (int)k1h.w}; \
    P0 = __builtin_amdgcn_mfma_scale_f32_32x32x64_f8f6f4(ka_, Q8, mref_acc(negm), 0, 0, 0, 0x7F7F7F7F, 0, 0x7F7F7F7F); \
    P1 = __builtin_amdgcn_mfma_scale_f32_32x32x64_f8f6f4(kb2_, Q8, mref_acc(negm), 0, 0, 0, 0x7F7F7F7F, 0, 0x7F7F7F7F); } while (0)
#endif
  f32x16 pA0, pA1, pB0, pB1; float alA, alB; const int NT = seq / KVBLK;
  (void)qr; (void)Qw;
#if ATT_Y8
  { float yb_ = YB; asm volatile("" : "+v"(yb_));
#pragma unroll
    for (int r = 0; r < 16; ++r) negm[r] = yb_; }
#define PSM(P0, P1, AL) partialSMY(P0, P1, negm, AL)
#else
#define PSM(P0, P1, AL) partialSM(P0, P1, negm, AL)
#endif
#define VMW(n) asm volatile("s_waitcnt vmcnt(%0)" :: "n"(n) : "memory")
#if ATT_Y8 && ATT_P2
  static_assert(LEAD == 5 && NBUF == 8, "pipeline v2");
  v8i vf[4]; float al2;
#define VLOAD(t_) do { const LAS char* vb_ = vrd + ((t_) & (NBUF - 1)) * TB; _Pragma("unroll") for (int d0 = 0; d0 < 4; ++d0) { const v4u l_ = *(const LAS v4u*)(vb_ + d0 * 2048), h_ = *(const LAS v4u*)(vb_ + d0 * 2048 + 512); \
    vf[d0] = (v8i){(int)l_.x, (int)l_.y, (int)l_.z, (int)l_.w, (int)h_.x, (int)h_.y, (int)h_.z, (int)h_.w}; } } while (0)
#define QKM() do { pA0 = __builtin_amdgcn_mfma_scale_f32_32x32x64_f8f6f4(kfa, Q8, mref_acc(negm), 0, 0, 0, 0x7F7F7F7F, 0, 0x7F7F7F7F); \
    pA1 = __builtin_amdgcn_mfma_scale_f32_32x32x64_f8f6f4(kfb, Q8, mref_acc(negm), 0, 0, 0, 0x7F7F7F7F, 0, 0x7F7F7F7F); } while (0)
#define PVM() do { { int on_ = 0x38383838; asm volatile("" : "+v"(on_)); const v8i ones_ = {on_, on_, on_, on_, on_, on_, on_, on_}; \
      lacc = __builtin_amdgcn_mfma_scale_f32_32x32x64_f8f6f4(P8, ones_, lacc, 0, 0, 0, 0x7F7F7F7F, 0, 0x7F7F7F7F); } \
    _Pragma("unroll") for (int d0 = 0; d0 < 4; ++d0) o[d0] = __builtin_amdgcn_mfma_scale_f32_32x32x64_f8f6f4(P8, vf[d0], o[d0], 0, 0, 0, 0x7F7F7F7F, 0, 0x7F7F7F7F); } while (0)
#define STEP(j) do { SBAR(); if (!P2_KPF) KLOAD(j); if (!P2_VPF) VLOAD((j) - 1); asm volatile("s_waitcnt lgkmcnt(0)" ::: "memory"); QKM(); PVM(); SBAR(); \
    if (P2_KPF) { if ((j) + 1 < NT) KLOAD((j) + 1); } if (P2_VPF) VLOAD(j); SBAR(); \
    partialSMY(pA0, pA1, negm, al2); RESC(al2); finishSMY(pA0, pA1, P8); } while (0)
#pragma unroll
  for (int t = 0; t <= LEAD; ++t) if (t < NT) DMA(t);
  if (LEAD < NT) VMW(2 * (LEAD - 1)); else VMW(0);
  TBAR();
#if P2_AB
  auto run_ = [&](auto G_) __attribute__((always_inline)) { constexpr int GRP = decltype(G_)::value;
  KLOAD(0); asm volatile("s_waitcnt lgkmcnt(0)" ::: "memory"); QKM(); SBAR();
  if constexpr (GRP == 0) { partialSMY(pA0, pA1, negm, al2); finishSMY(pA0, pA1, P8); }
  if (LEAD < NT) VMW(2 * (LEAD - 3)); else VMW(0);
  TBAR();
#define STEPB(j) do { SBAR(); partialSMY(pA0, pA1, negm, al2); RESC(al2); finishSMY(pA0, pA1, P8); SBAR(); \
    KLOAD(j); asm volatile("s_waitcnt lgkmcnt(0)" ::: "memory"); QKM(); SBAR(); VLOAD((j) - 1); asm volatile("s_waitcnt lgkmcnt(0)" ::: "memory"); PVM(); SBAR(); } while (0)
  if constexpr (GRP == 0) {
    for (int j = 1; j + 1 < NT; j += 2) {
      if (j + LEAD < NT) DMA(j + LEAD); if (j + LEAD + 1 < NT) DMA(j + LEAD + 1);
      STEP(j); STEP(j + 1);
      if (j + LEAD + 1 < NT) VMW(2 * (LEAD - 3)); else VMW(0); TBAR();
    }
    STEP(NT - 1);
  } else {
    for (int j = 1; j + 1 < NT; j += 2) {
      if (j + LEAD < NT) DMA(j + LEAD); if (j + LEAD + 1 < NT) DMA(j + LEAD + 1);
      STEPB(j); STEPB(j + 1);
      if (j + LEAD + 1 < NT) VMW(2 * (LEAD - 3)); else VMW(0); TBAR();
    }
    STEPB(NT - 1);
    partialSMY(pA0, pA1, negm, al2); RESC(al2); finishSMY(pA0, pA1, P8);
  }
  VLOAD(NT - 1);
  asm volatile("s_waitcnt lgkmcnt(0)" ::: "memory"); PVM();
#undef STEPB
#else
  KLOAD(0); asm volatile("s_waitcnt lgkmcnt(0)" ::: "memory"); QKM(); SBAR(); if (P2_KPF) KLOAD(1); if (P2_VPF) VLOAD(0); SBAR();
  partialSMY(pA0, pA1, negm, al2); finishSMY(pA0, pA1, P8);
  if (LEAD < NT) VMW(2 * (LEAD - 3)); else VMW(0);
  TBAR();
  for (int j = 1; j + 1 < NT; j += 2) {
    if (j + LEAD < NT) DMA(j + LEAD); if (j + LEAD + 1 < NT) DMA(j + LEAD + 1);
    STEP(j);
    STEP(j + 1);
    if (j + LEAD + 1 < NT) VMW(2 * (LEAD - 3)); else VMW(0); TBAR();
  }
  STEP(NT - 1);
  if (!P2_VPF) VLOAD(NT - 1);
  asm volatile("s_waitcnt lgkmcnt(0)" ::: "memory"); PVM();
#endif
  (void)pB0; (void)pB1; (void)alA; (void)alB;
#undef STEP
#undef PVM
#undef QKM
#undef VLOAD
#elif ATT_Y8 && ATT_AB
  static_assert(LEAD == 5 && NBUF == 8, "anti-phase schedule");
#pragma unroll
  for (int t = 0; t <= LEAD; ++t) if (t < NT) DMA(t);
  if (LEAD < NT) VMW(2 * LEAD); else VMW(0);
  TBAR();
  QK8(pA0, pA1, 0); PSM(pA0, pA1, alA);
  if (LEAD < NT) VMW(2 * (LEAD - 3)); else VMW(0);
  TBAR();
#define XCV(PO0, PO1, j) do { finishSMY(PO0, PO1, P8); SBAR(); pv8s(o, lacc, vrd + (((j) - 1) & (NBUF - 1)) * TB, P8); } while (0)
  if (map == 0) {
#define ITERA(j, PN0, PN1, ALN, PO0, PO1) do { SBAR(); QK8(PN0, PN1, j); XCV(PO0, PO1, j); partialSMY(PN0, PN1, negm, ALN); RESC(ALN); } while (0)
    for (int j = 1; j + 1 < NT; j += 2) {
      if (j + LEAD < NT) DMA(j + LEAD); if (j + LEAD + 1 < NT) DMA(j + LEAD + 1);
      ITERA(j, pB0, pB1, alB, pA0, pA1);
      ITERA(j + 1, pA0, pA1, alA, pB0, pB1);
      if (j + LEAD + 1 < NT) VMW(2 * (LEAD - 3)); else VMW(0); TBAR();
    }
    ITERA(NT - 1, pB0, pB1, alB, pA0, pA1);
#undef ITERA
  } else {
    QK8(pB0, pB1, 1);
#define ITERB(j, PN0, PN1, ALN, PO0, PO1) do { SBAR(); XCV(PO0, PO1, j); partialSMY(PN0, PN1, negm, ALN); RESC(ALN); SBAR(); if ((j) + 1 < NT) QK8(PO0, PO1, (j) + 1); } while (0)
    for (int j = 1; j + 1 < NT; j += 2) {
      if (j + LEAD < NT) DMA(j + LEAD); if (j + LEAD + 1 < NT) DMA(j + LEAD + 1);
      ITERB(j, pB0, pB1, alB, pA0, pA1);
      ITERB(j + 1, pA0, pA1, alA, pB0, pB1);
      if (j + LEAD + 1 < NT) VMW(2 * (LEAD - 3)); else VMW(0); TBAR();
    }
    ITERB(NT - 1, pB0, pB1, alB, pA0, pA1);
#undef ITERB
  }
  finishSMY(pB0, pB1, P8); SBAR();
  pv8s(o, lacc, vrd + ((NT - 1) & (NBUF - 1)) * TB, P8);
#undef XCV
#else
#pragma unroll
  for (int t = 0; t <= LEAD; ++t) if (t < NT) DMA(t);
  if (LEAD < NT) VMW(2 * (LEAD - ATT_KPF)); else VMW(0);
  TBAR();
  KLOAD(0);
  QK8(pA0, pA1, 0); PSM(pA0, pA1, alA);
  if (LEAD < NT) VMW(2 * (LEAD - 1 - ATT_BAR2 - ATT_KPF)); else VMW(0);
  TBAR();
#define ITER(j, PN0, PN1, ALN, PO0, PO1, ALO) do { \
    if (!ATT_BAR2) { if ((j) + LEAD < NT) DMA((j) + LEAD); } \
    SBAR(); if (!(ATT_STAG && map == 1)) QK8(PN0, PN1, j); \
    if (ATT_Y8) { if (VAR != 4) finishSMY(PO0, PO1, P8); SBAR(); \
        if (VAR == 2) { const LAS char* vb_ = vrd + (((j) - 1) & (NBUF - 1)) * TB; _Pragma("unroll") for (int d0 = 0; d0 < 4; ++d0) { const v4u l_ = *(const LAS v4u*)(vb_ + d0 * 2048), h_ = *(const LAS v4u*)(vb_ + d0 * 2048 + 512); asm volatile("" :: "v"(l_), "v"(h_)); } } \
        else if (VAR != 1) pv8s(o, lacc, vrd + (((j) - 1) & (NBUF - 1)) * TB, P8); \
        if (ATT_STAG && map == 1) { SBAR(); QK8(PN0, PN1, j); } \
        if (VAR != 5) partialSMY(PN0, PN1, negm, ALN); else ALN = 1.f; } \
    else { finishSM8(PO0, PO1, ALO, l_reg, P8); SBAR(); } \
    if (ATT_Y8) {} else if (ATT_PVX) { partialSM<false>(PN0, PN1, negm, ALN); SBAR(); pv8_exp(o, vrd + (((j) - 1) & (NBUF - 1)) * TB, P8, PN0); } \
    else { pv8(o, vrd + (((j) - 1) & (NBUF - 1)) * TB, P8); partialSM(PN0, PN1, negm, ALN); } \
    RESC(ALN); \
    if (!ATT_BAR2) { if ((j) + LEAD < NT) VMW(2 * (LEAD - 1)); else VMW(0); \
    TBAR(); } } while (0)
  for (int j = 1; j + 1 < NT; j += 2) {
    if (ATT_BAR2) { if (j + LEAD < NT) DMA(j + LEAD); if (j + LEAD + 1 < NT) DMA(j + LEAD + 1); }
    ITER(j, pB0, pB1, alB, pA0, pA1, alA);
    ITER(j + 1, pA0, pA1, alA, pB0, pB1, alB);
    if (ATT_BAR2) { if (j + LEAD + 1 < NT) VMW(2 * (LEAD - 2 - ATT_KPF)); else VMW(0); TBAR(); }
  }
  ITER(NT - 1, pB0, pB1, alB, pA0, pA1, alA);
#if ATT_Y8
  finishSMY(pB0, pB1, P8); SBAR();
  pv8s(o, lacc, vrd + ((NT - 1) & (NBUF - 1)) * TB, P8);
#else
  finishSM8(pB0, pB1, alB, l_reg, P8); SBAR();
  pv8(o, vrd + ((NT - 1) & (NBUF - 1)) * TB, P8);
#endif
#endif
#undef PSM
#undef VMW
#undef DMA
#undef TBAR
#undef QK8
#undef KLOAD
#undef ITER
#elif ATT_DMA && ATT_FP8
  const int vb0 = (int)(unsigned)(uintptr_t)lds + v_rd_base(lane);
  unsigned voffV[2], voffK[2];
#pragma unroll
  for (int t = 0; t < 2; ++t) { const int vi = wid * 2 + t, kg = vi >> 1, pair = vi & 1, sub = lane >> 5, row = (lane >> 2) & 7, chunk = lane & 3;
    voffV[t] = (unsigned)((8 * kg + row) * LDK + 32 * (2 * pair + sub) + 8 * chunk) * 2u;
    const int krow = 4 * vi + (lane >> 4), p = lane & 15;
    voffK[t] = (unsigned)(krow * LDK) * 2u + (unsigned)((p ^ (krow & 7)) * 16); }
  const int ldsw = wid * 2048; const unsigned v8off = (unsigned)(wid * 1024 + lane * 16); const LAS char* vrd = lds + hi * 1024 + r32 * 16; v8i P8;
  (void)voffV; (void)vb0;
#define DMA(t_) do { const char* vt_ = (const char*)(Vh + (size_t)(t_) * KVBLK * LDK); const char* kt_ = (const char*)(Kh + (size_t)(t_) * KVBLK * LDK); const int bo_ = ((t_) & 3) * BUFB; \
    _Pragma("unroll") for (int i_ = 0; i_ < 2; ++i_) { \
      __builtin_amdgcn_global_load_lds((const unsigned*)(kt_ + voffK[i_]), (LAS unsigned*)(lds + bo_ + (int)SHM_V + ldsw + i_ * 1024), 16, 0, 0); } \
    __builtin_amdgcn_global_load_lds((const unsigned*)(V8h + (size_t)(t_) * 65536 + v8off), (LAS unsigned*)(lds + bo_ + wid * 1024), 16, 0, 0); (void)vt_; } while (0)
#define RESC(a) do { if (__any((a) != 1.f)) { if (hi == 0) al_l[r32] = (a); asm volatile("s_waitcnt lgkmcnt(0)" ::: "memory"); \
    _Pragma("unroll") for (int r = 0; r < 16; ++r) { const float a_ = al_l[crow(r, hi)]; lacc[r] *= a_; _Pragma("unroll") for (int d = 0; d < 4; ++d) o[d][r] *= a_; } } } while (0)
#define TBAR() do { asm volatile("s_waitcnt lgkmcnt(0)" ::: "memory"); __builtin_amdgcn_s_barrier(); asm volatile("" ::: "memory"); } while (0)
#define KBUF(t_) (lds + ((t_) & 3) * BUFB + (int)SHM_V)
#define VBUF(t_) (vb0 + ((t_) & 3) * BUFB)
  f32x16 pA0, pA1, pB0, pB1; float alA, alB; bf16x8 pa0, pa1, pa2, pa3; const int NT = seq / KVBLK;
  DMA(0); DMA(1); if (2 < NT) DMA(2);
  if (2 < NT) asm volatile("s_waitcnt vmcnt(6)" ::: "memory"); else asm volatile("s_waitcnt vmcnt(3)" ::: "memory");
  TBAR();
  qkt(pA0, pA1, KBUF(0), qr, r32, hi, map, negm); partialSM(pA0, pA1, negm, alA);
  if (2 < NT) asm volatile("s_waitcnt vmcnt(3)" ::: "memory"); else asm volatile("s_waitcnt vmcnt(0)" ::: "memory");
  TBAR();
#define ITER(j, PN0, PN1, ALN, PO0, PO1, ALO) do { \
    if ((j) + 2 < NT) DMA((j) + 2); \
    SBAR(); qkt(PN0, PN1, KBUF(j), qr, r32, hi, map, negm); \
    finishSM8(PO0, PO1, ALO, l_reg, P8); SBAR(); \
    pv8(o, vrd + (((j) - 1) & 3) * BUFB, P8); partialSM(PN0, PN1, negm, ALN); \
    RESC(ALN); \
    if ((j) + 2 < NT) asm volatile("s_waitcnt vmcnt(3)" ::: "memory"); else asm volatile("s_waitcnt vmcnt(0)" ::: "memory"); \
    TBAR(); } while (0)
  for (int j = 1; j + 1 < NT; j += 2) {
    ITER(j, pB0, pB1, alB, pA0, pA1, alA);
    ITER(j + 1, pA0, pA1, alA, pB0, pB1, alB);
  }
  ITER(NT - 1, pB0, pB1, alB, pA0, pA1, alA);
  finishSM8(pB0, pB1, alB, l_reg, P8); SBAR();
  pv8(o, vrd + ((NT - 1) & 3) * BUFB, P8);
#undef DMA
#undef TBAR
#undef KBUF
#undef VBUF
#undef ITER
#elif ATT_DMA
  const int vb0 = (int)(unsigned)(uintptr_t)lds + v_rd_base(lane);
  unsigned voffV[2], voffK[2];
#pragma unroll
  for (int t = 0; t < 2; ++t) { const int vi = wid * 2 + t, kg = vi >> 1, pair = vi & 1, sub = lane >> 5, row = (lane >> 2) & 7, chunk = lane & 3;
    voffV[t] = (unsigned)((8 * kg + row) * LDK + 32 * (2 * pair + sub) + 8 * chunk) * 2u;
    const int krow = 4 * vi + (lane >> 4), p = lane & 15;
    voffK[t] = (unsigned)(krow * LDK) * 2u + (unsigned)((p ^ (krow & 7)) * 16); }
  const int ldsw = wid * 2048;
#define DMA(t_) do { const char* vt_ = (const char*)(Vh + (size_t)(t_) * KVBLK * LDK); const char* kt_ = (const char*)(Kh + (size_t)(t_) * KVBLK * LDK); const int bo_ = ((t_) & 3) * BUFB; \
    _Pragma("unroll") for (int i_ = 0; i_ < 2; ++i_) { \
      __builtin_amdgcn_global_load_lds((const unsigned*)(vt_ + voffV[i_]), (LAS unsigned*)(lds + bo_ + ldsw + i_ * 1024), 16, 0, 0); \
      __builtin_amdgcn_global_load_lds((const unsigned*)(kt_ + voffK[i_]), (LAS unsigned*)(lds + bo_ + (int)SHM_V + ldsw + i_ * 1024), 16, 0, 0); } } while (0)
#define RESC(a) do { if (__any((a) != 1.f)) { if (hi == 0) al_l[r32] = (a); asm volatile("s_waitcnt lgkmcnt(0)" ::: "memory"); \
    _Pragma("unroll") for (int r = 0; r < 16; ++r) { const float a_ = al_l[crow(r, hi)]; lacc[r] *= a_; _Pragma("unroll") for (int d = 0; d < 4; ++d) o[d][r] *= a_; } } } while (0)
#define TBAR() do { asm volatile("s_waitcnt lgkmcnt(0)" ::: "memory"); __builtin_amdgcn_s_barrier(); asm volatile("" ::: "memory"); } while (0)
#define KBUF(t_) (lds + ((t_) & 3) * BUFB + (int)SHM_V)
#define VBUF(t_) (vb0 + ((t_) & 3) * BUFB)
  f32x16 pA0, pA1, pB0, pB1; float alA, alB; bf16x8 pa0, pa1, pa2, pa3; const int NT = seq / KVBLK;
  DMA(0); DMA(1); if (2 < NT) DMA(2);
  if (2 < NT) asm volatile("s_waitcnt vmcnt(8)" ::: "memory"); else asm volatile("s_waitcnt vmcnt(4)" ::: "memory");
  TBAR();
  qkt(pA0, pA1, KBUF(0), qr, r32, hi, map, negm); partialSM(pA0, pA1, negm, alA);
  if (2 < NT) asm volatile("s_waitcnt vmcnt(4)" ::: "memory"); else asm volatile("s_waitcnt vmcnt(0)" ::: "memory");
  TBAR();
#define ITER(j, PN0, PN1, ALN, PO0, PO1, ALO) do { \
    if ((j) + 2 < NT) DMA((j) + 2); \
    SBAR(); qkt(PN0, PN1, KBUF(j), qr, r32, hi, map, negm); \
    finishSM(PO0, PO1, ALO, l_reg, pa0, pa1, pa2, pa3); SBAR(); \
    pv_d0(o, VBUF((j) - 1), pa0, pa1, pa2, pa3, lacc); partialSM(PN0, PN1, negm, ALN); \
    RESC(ALN); \
    if ((j) + 2 < NT) asm volatile("s_waitcnt vmcnt(4)" ::: "memory"); else asm volatile("s_waitcnt vmcnt(0)" ::: "memory"); \
    TBAR(); } while (0)
  for (int j = 1; j + 1 < NT; j += 2) {
    ITER(j, pB0, pB1, alB, pA0, pA1, alA);
    ITER(j + 1, pA0, pA1, alA, pB0, pB1, alB);
  }
  ITER(NT - 1, pB0, pB1, alB, pA0, pA1, alA);
  finishSM(pB0, pB1, alB, l_reg, pa0, pa1, pa2, pa3); SBAR();
  pv_d0(o, VBUF(NT - 1), pa0, pa1, pa2, pa3, lacc);
#undef DMA
#undef TBAR
#undef KBUF
#undef VBUF
#undef ITER
#else
  const int sr = tid >> 4, sc = (tid & 15) * 8, vst0 = v_st(sr, sc), vst1 = v_st(32 + sr, sc);
  const int vb0 = (int)(unsigned)(uintptr_t)lds + v_rd_base(lane);
  struct { bf16x8 vs0, vs1, ks0, ks1; } sr_[2];
  const unsigned goff = (unsigned)(sr * LDK + sc) * 2u;
#define SLOAD(i, k0) do { const char* vt_ = (const char*)(Vh + (size_t)(k0) * LDK); const char* kt_ = (const char*)(Kh + (size_t)(k0) * LDK); \
    sr_[i].vs0 = *(const bf16x8*)(vt_ + goff); sr_[i].vs1 = *(const bf16x8*)(vt_ + (size_t)32 * LDK * 2 + goff); sr_[i].ks0 = *(const bf16x8*)(kt_ + goff); sr_[i].ks1 = *(const bf16x8*)(kt_ + (size_t)32 * LDK * 2 + goff); } while (0)
#define SWRITE(b, i) do { *(LAS bf16x8*)(lds + (b) * BUFB + vst0) = sr_[i].vs0; *(LAS bf16x8*)(lds + (b) * BUFB + vst1) = sr_[i].vs1; const int kc = sc * 2; \
    *(LAS bf16x8*)(lds + (b) * BUFB + (int)SHM_V + KSWZ(sr, kc)) = sr_[i].ks0; *(LAS bf16x8*)(lds + (b) * BUFB + (int)SHM_V + KSWZ(32 + sr, kc)) = sr_[i].ks1; } while (0)
#define SWAIT() asm volatile("s_waitcnt vmcnt(4)" ::: "memory")
#define RESC(a) do { if (__any((a) != 1.f)) { if (hi == 0) al_l[r32] = (a); asm volatile("s_waitcnt lgkmcnt(0)" ::: "memory"); \
    _Pragma("unroll") for (int r = 0; r < 16; ++r) { const float a_ = al_l[crow(r, hi)]; lacc[r] *= a_; _Pragma("unroll") for (int d = 0; d < 4; ++d) o[d][r] *= a_; } } } while (0)
  f32x16 pA0, pA1, pB0, pB1; float alA, alB; bf16x8 pa0, pa1, pa2, pa3; const int NT = seq / KVBLK;
  constexpr int SE = 0, SO = 1;
  LAS char* K0 = lds + (int)SHM_V; LAS char* K1 = lds + BUFB + (int)SHM_V;
  SLOAD(SE, 0); asm volatile("s_waitcnt vmcnt(0)" ::: "memory"); SWRITE(0, SE); __syncthreads();
  qkt(pA0, pA1, K0, qr, r32, hi, map, negm); partialSM(pA0, pA1, negm, alA);
  SLOAD(SO, KVBLK); if (2 < NT) SLOAD(SE, 2 * KVBLK);
  SWAIT(); SWRITE(1, SO); __syncthreads();
#define XBAR() do { if (VAR != 1) __syncthreads(); } while (0)
#define XQK(P0, P1, KK) do { if (VAR != 5) qkt(P0, P1, KK, qr, r32, hi, map, negm); } while (0)
#define XFIN(P0, P1, AL) do { if (VAR != 2) finishSM(P0, P1, AL, l_reg, pa0, pa1, pa2, pa3); } while (0)
#define XPAR(P0, P1, AL) do { if (VAR != 2) partialSM(P0, P1, negm, AL); } while (0)
#define XPV(VB) do { if (VAR != 3) pv_d0(o, VB, pa0, pa1, pa2, pa3, lacc); } while (0)
#define XLOAD(i, k0) do { if (VAR != 4) SLOAD(i, k0); } while (0)
#define XWRITE(b, i) do { if (VAR != 4) { SWAIT(); SWRITE(b, i); } } while (0)
  if (VAR == 2) { pa0 = qr[0]; pa1 = qr[1]; pa2 = qr[2]; pa3 = qr[3]; alA = 1.f; alB = 1.f; }
  if (VAR == 5) { pA0 = f32x16{}; pA1 = pA0; pB0 = pA0; pB1 = pA0; }
  for (int j = 1; j + 1 < NT; j += 2) {
    SBAR(); XQK(pB0, pB1, K1);
    XFIN(pA0, pA1, alA); SBAR();
    XLOAD(SO, (j + 2) * KVBLK); SBAR();
    XPV(vb0); XPAR(pB0, pB1, alB);
    XBAR(); XWRITE(0, SE);
    RESC(alB); XBAR();
    SBAR(); XQK(pA0, pA1, K0);
    XFIN(pB0, pB1, alB); SBAR();
    if (j + 3 < NT) XLOAD(SE, (j + 3) * KVBLK); SBAR();
    XPV(vb0 + BUFB); XPAR(pA0, pA1, alA);
    XBAR(); XWRITE(1, SO);
    RESC(alA); XBAR();
  }
  SBAR(); qkt(pB0, pB1, K1, qr, r32, hi, map, negm);
  finishSM(pA0, pA1, alA, l_reg, pa0, pa1, pa2, pa3); SBAR();
  pv_d0(o, vb0, pa0, pa1, pa2, pa3, lacc); partialSM(pB0, pB1, negm, alB);
  __syncthreads(); RESC(alB);
  finishSM(pB0, pB1, alB, l_reg, pa0, pa1, pa2, pa3); SBAR();
  pv_d0(o, vb0 + BUFB, pa0, pa1, pa2, pa3, lacc);
#endif
  {
    const int tid2 = fresh_tid(wave), wid2 = tid2 >> 6, lane2 = tid2 & 63, r32b = lane2 & 31, hib = lane2 >> 5, mapb = wid2 >> 2, wqb = wid2 & 3;
    LAS float* li2 = (LAS float*)(lds + WSF_OFF) + wid2 * 64;
    float rli[16];
#if ATT_LMFMA || ATT_Y8
    (void)li2;
#pragma unroll
    for (int r = 0; r < 16; ++r) rli[r] = __builtin_amdgcn_rcpf(lacc[r]);
#else
    if (hib == 0) li2[r32b] = l_reg; asm volatile("s_waitcnt lgkmcnt(0)" ::: "memory");
#pragma unroll
    for (int r = 0; r < 16; ++r) rli[r] = __builtin_amdgcn_rcpf(li2[crow(r, hib)]);
#endif
    __syncthreads();
    LAS float* X = (LAS float*)lds + (wqb * 32 + 4 * hib) * 128 + r32b;
    if (mapb == 1) {
#pragma unroll
      for (int r = 0; r < 16; ++r)
#pragma unroll
        for (int d0 = 0; d0 < 4; ++d0) X[((r & 3) + 8 * (r >> 2)) * 128 + d0 * 32] = o[d0][r] * rli[r] * lam;
    }
    __syncthreads();
    if (mapb == 0) {
      float gs[4];
#pragma unroll
      for (int d0 = 0; d0 < 4; ++d0) gs[d0] = gsub[d0 * 32 + r32b] * oscale;
      bf16* Ow = Ob + (long)(wqb * 32 + 4 * hib) * D + r32b;
#pragma unroll
      for (int r = 0; r < 16; ++r) {
        float ss = 0.f;
#pragma unroll
        for (int d0 = 0; d0 < 4; ++d0) { const float v = o[d0][r] * rli[r] - X[((r & 3) + 8 * (r >> 2)) * 128 + d0 * 32]; o[d0][r] = v; ss += v * v; }
        ss = half_sum(ss);
        const float rs = 1.0f / sqrtf(ss * (1.0f / 128.0f) + NORM_EPS);
#pragma unroll
        for (int d0 = 0; d0 < 4; ++d0) Ow[(long)((r & 3) + 8 * (r >> 2)) * D + d0 * 32] = (bf16)f2bf(o[d0][r] * rs * gs[d0]);
      }
    }
    __syncthreads();
  }
#if ATT_DMA && ATT_FP8 && ATT_QK8 && ATT_Y8 && ATT_P2 && P2_AB
  };
  if (map == 0) run_(std::integral_constant<int, 0>{}); else run_(std::integral_constant<int, 1>{});
#endif
#if !ATT_DMA
#undef XBAR
#undef XQK
#undef XFIN
#undef XPAR
#undef XPV
#undef XLOAD
#undef XWRITE
#undef SLOAD
#undef SWRITE
#undef SWAIT
#endif
#undef RESC
}
#undef KSWZ
}


__device__ __forceinline__ void v8_phase(Frame& F, const Params& P) {
    unsigned char* ws = fresh_ws(P.ws);
    const bf16* vb = (const bf16*)(ws + WS_VB); unsigned char* v8 = ws + WS_V8;
    const Lane L(F.wave); const int gw = F.vcu * NWAVES + F.wave, NGW = F.G * NWAVES, lane = L.lane;
    for (int tile = gw; tile < NB * (KVLEN / 64) * 8; tile += NGW) {
        const int h = tile & 7, t = (tile >> 3) % (KVLEN / 64), b = (tile >> 3) / (KVLEN / 64);
        const bf16* src = vb + ((size_t)b * KVLEN + 64 * t) * 1024 + h * 128;
        v4u* dst = (v4u*)(v8 + (size_t)tile * 8192);
#pragma unroll 2
        for (int q = 0; q < 8; ++q) {
            const int c = lane + 64 * q, d = c & 31, half = (c >> 5) & 1, hi = (c >> 6) & 1, d0 = c >> 7;
            const bf16* col = src + 32 * d0 + d + (size_t)(4 * hi + 32 * half) * 1024;
            float v[16];
#pragma unroll
            for (int j = 0; j < 16; ++j) { const float x = bf2f(col[(size_t)((j & 3) + 8 * (j >> 2)) * 1024]); v[j] = fminf(fmaxf(x, -448.f), 448.f); }
            v4u w;
            w.x = (unsigned)__builtin_amdgcn_cvt_pk_fp8_f32(v[2], v[3], __builtin_amdgcn_cvt_pk_fp8_f32(v[0], v[1], 0, false), true);
            w.y = (unsigned)__builtin_amdgcn_cvt_pk_fp8_f32(v[6], v[7], __builtin_amdgcn_cvt_pk_fp8_f32(v[4], v[5], 0, false), true);
            w.z = (unsigned)__builtin_amdgcn_cvt_pk_fp8_f32(v[10], v[11], __builtin_amdgcn_cvt_pk_fp8_f32(v[8], v[9], 0, false), true);
            w.w = (unsigned)__builtin_amdgcn_cvt_pk_fp8_f32(v[14], v[15], __builtin_amdgcn_cvt_pk_fp8_f32(v[12], v[13], 0, false), true);
            dst[c] = w;
        }
#if ATT_QK8 && !K8_DIRECT
        const bf16* ksrc = (const bf16*)(ws + WS_KB) + ((size_t)b * KVLEN + 64 * t) * 1024 + h * 128;
        v4u* kdst = (v4u*)(ws + WS_K8 + (size_t)tile * 8192);
#pragma unroll 2
        for (int q = 0; q < 8; ++q) {
            const int c = lane + 64 * q, key = c & 63, half = (c >> 6) & 1, hi = (c >> 7) & 1, map = c >> 8;
            const bf16* p = ksrc + (size_t)key * 1024 + map * 64 + 32 * hi + 16 * half;
            float v[16]; { float a[8], bq[8]; ld8f(p, a); ld8f(p + 8, bq);
#pragma unroll
              for (int j = 0; j < 8; ++j) { v[j] = fminf(fmaxf(a[j], -448.f), 448.f); v[8 + j] = fminf(fmaxf(bq[j], -448.f), 448.f); } }
            v4u w;
            w.x = (unsigned)__builtin_amdgcn_cvt_pk_fp8_f32(v[2], v[3], __builtin_amdgcn_cvt_pk_fp8_f32(v[0], v[1], 0, false), true);
            w.y = (unsigned)__builtin_amdgcn_cvt_pk_fp8_f32(v[6], v[7], __builtin_amdgcn_cvt_pk_fp8_f32(v[4], v[5], 0, false), true);
            w.z = (unsigned)__builtin_amdgcn_cvt_pk_fp8_f32(v[10], v[11], __builtin_amdgcn_cvt_pk_fp8_f32(v[8], v[9], 0, false), true);
            w.w = (unsigned)__builtin_amdgcn_cvt_pk_fp8_f32(v[14], v[15], __builtin_amdgcn_cvt_pk_fp8_f32(v[12], v[13], 0, false), true);
            kdst[c] = w;
        }
#endif
    }
}
template <int VAR>
__device__ __forceinline__ void attn_phase(Frame& F, const Params& P, int layer, bool ctx_out, unsigned char* ldsg) {
    (void)ldsg;
    unsigned char* ws = fresh_ws(P.ws);
    const bf16* qb = (const bf16*)(ws + WS_Q); const bf16* kb = (const bf16*)(ws + WS_KB); const bf16* vb = (const bf16*)(ws + WS_VB); bf16* cat = (bf16*)(ws + (VAR == 0 ? WS_CAT : WS_H));
    const Lane L(F.wave);
    const float lam_init = __builtin_bit_cast(float, __builtin_amdgcn_readfirstlane(__builtin_bit_cast(int, 0.8f - 0.6f * expf(-0.3f * (float)layer))));
    const float* lv = P.in[I_LAMBDA] + layer * 256;
    const float d1 = wave_sum(lv[L.lane] * lv[64 + L.lane]), d2 = wave_sum(lv[128 + L.lane] * lv[192 + L.lane]);
    const float lam = __builtin_bit_cast(float, __builtin_amdgcn_readfirstlane(__builtin_bit_cast(int, expf(d1) - expf(d2) + lam_init)));
    const float* gsub = P.in[I_SUBLN] + layer * 128;
    const int nun = NB * 8 * 64 + (ctx_out ? NB * 8 * 2 : 0);
    for (int uid = F.vcu; uid < nun; uid += F.G) {
        int qt, h, b, seq; size_t qrow;
        if (uid < NB * 8 * 64) { qt = uid & 63; h = (uid >> 6) & 7; b = uid >> 9; qrow = (size_t)b * SEQ + 128 * qt; seq = KVLEN; }
        else { const int u2 = uid - NB * 8 * 64; qt = u2 & 1; h = (u2 >> 1) & 7; b = u2 >> 4; qrow = (size_t)NLAT + b * CTXL + 128 * qt; seq = CTXL; }
        att::diff_attn_unit<VAR>(Q8_DIRECT ? (const bf16*)((const unsigned char*)qb + qrow * 1024 + h * 128) : qb + qrow * 1024 + h * 128, kb + (size_t)b * KVLEN * 1024 + h * 128, vb + (size_t)b * KVLEN * 1024 + h * 128,
                            cat + qrow * D + 1024 + h * 128, seq, (LAS char*)F.lds, lam, gsub, 1.0f - lam_init, F.wave, ws + WS_V8 + ((size_t)b * (KVLEN / 64) * 8 + h) * 8192, (const unsigned char*)qb);
    }
}
struct MoePanels { int ps[9]; };
__device__ __forceinline__ MoePanels moe_panels(Frame& F) {
    MoePanels m; int acc = 0;
#pragma unroll
    for (int e = 0; e < NE; ++e) { m.ps[e] = acc; const int c = (int)__builtin_amdgcn_readfirstlane(__hip_atomic_load(F.ctl + CW_CNT + 64 * e, RLX_AGENT)); acc += (c + 255) >> 8; }
    m.ps[8] = acc; return m;
}
__device__ __forceinline__ void moe_gather_phase(Frame& F, const Params& P) {
    unsigned char* ws = fresh_ws(P.ws);
    const bf16* h = (const bf16*)(ws + WS_H); bf16* Ag = (bf16*)(ws + WS_AG);
    const int* tok_e = (const int*)(ws + WS_ROUTE); const int* tok_slot = tok_e + 2 * NLAT;
    const float* hs = (const float*)(ws + WS_HS); float* ags = (float*)(ws + WS_AGS);
    const MoePanels mp = moe_panels(F);
    const Lane L(F.wave); const int gw = F.vcu * NWAVES + F.wave, NGW = F.G * NWAVES, lane = L.lane;
    for (int a = gw; a < 2 * NLAT; a += NGW) {
        const int r = a >> 1, e = tok_e[a], slot = tok_slot[a];
        int pse = 0;
#pragma unroll
        for (int q = 0; q < NE; ++q) pse = (q == e) ? mp.ps[q] : pse;
        const v4u* src = (const v4u*)((const unsigned char*)h + (size_t)r * D) + lane; v4u* dst = (v4u*)((unsigned char*)Ag + ((size_t)pse * 256 + slot) * D) + lane;
#pragma unroll
        for (int j = 0; j < 2; ++j) dst[64 * j] = src[64 * j];
#if I8_GU
        if (lane == 0) ags[pse * 256 + slot] = hs[r];
#endif
    }
    for (int e = 0; e < NE; ++e) {
        const int c = (int)__builtin_amdgcn_readfirstlane(__hip_atomic_load(F.ctl + CW_CNT + 64 * e, RLX_AGENT));
        const int pad = ((c + 255) & ~255) - c;
        for (int q = gw; q < pad; q += NGW) { v4u* dst = (v4u*)((unsigned char*)Ag + ((size_t)mp.ps[e] * 256 + c + q) * D) + lane;
#pragma unroll
            for (int j = 0; j < 2; ++j) dst[64 * j] = (v4u){0u, 0u, 0u, 0u};
#if I8_GU
            if (lane == 0) ags[mp.ps[e] * 256 + c + q] = 0.f;
#endif
        }
    }
}
__device__ __forceinline__ void final_phase(Frame& F, const Params& P, const float* modl) {
    unsigned char* ws = fresh_ws(P.ws);
    const bf16* xl = (const bf16*)(ws + WS_XL); const bf16* yb = (const bf16*)(ws + WS_AG);
    const int* tok_e = (const int*)(ws + WS_ROUTE); const int* tok_slot = tok_e + 2 * NLAT; const float* tok_p = (const float*)(tok_slot + 2 * NLAT);
    const MoePanels mp = moe_panels(F);
    const Lane L(F.wave); const int gw = F.vcu * NWAVES + F.wave, NGW = F.G * NWAVES, lane = L.lane;
    const float* gf = P.in[I_GFIN];
    for (int r = gw; r < NLAT; r += NGW) {
        const int v = r < SEQ ? 0 : 1; const float* g5 = modl + (size_t)(v * 6 + 5) * D;
        const int e0 = tok_e[2 * r], e1 = tok_e[2 * r + 1];
        int p0s = 0, p1s = 0;
#pragma unroll
        for (int q = 0; q < NE; ++q) { p0s = (q == e0) ? mp.ps[q] : p0s; p1s = (q == e1) ? mp.ps[q] : p1s; }
        const bf16* y0 = yb + ((size_t)p0s * 256 + tok_slot[2 * r]) * D; const bf16* y1 = yb + ((size_t)p1s * 256 + tok_slot[2 * r + 1]) * D;
        const float w0 = tok_p[2 * r], w1 = tok_p[2 * r + 1];
        f32x4 x[8]; float ss = 0.f;
#pragma unroll
        for (int jq = 0; jq < 8; ++jq) { const int c = 4 * lane + 256 * jq;
            const v2u a = *(const v2u*)(y0 + c), bq = *(const v2u*)(y1 + c); const f32x4 g = *(const f32x4*)(g5 + c); const f32x4 xv = ld4_bf16(xl + (size_t)r * D + c);
            f32x4 y; y[0] = w0 * bflo(a.x) + w1 * bflo(bq.x); y[1] = w0 * bfhi(a.x) + w1 * bfhi(bq.x); y[2] = w0 * bflo(a.y) + w1 * bflo(bq.y); y[3] = w0 * bfhi(a.y) + w1 * bfhi(bq.y);
            x[jq] = xv + g * y; ss += (x[jq][0] * x[jq][0] + x[jq][1] * x[jq][1]) + (x[jq][2] * x[jq][2] + x[jq][3] * x[jq][3]); }
        const float rstd = 1.0f / sqrtf(wave_sum(ss) * (1.0f / D) + NORM_EPS);
#pragma unroll
        for (int jq = 0; jq < 8; ++jq) { const int c = 4 * lane + 256 * jq; const f32x4 ov_ = (x[jq] * rstd) * *(const f32x4*)(gf + c); if (FIN_NT) __builtin_nontemporal_store(ov_, (f32x4*)(P.out + (size_t)r * D + c)); else *(f32x4*)(P.out + (size_t)r * D + c) = ov_; }
    }
}
#if DBG == 1
constexpr size_t WS_DBG = 3 * MiB;
__device__ __forceinline__ void dbg_err(Frame& F, int k, float got, float want, float scale) {
    float e = fabsf(got - want) / scale; if (!(e == e)) e = 1e9f;
    atomicMax((unsigned*)(F.ctl + CW_DIAG + 64 * k), __float_as_uint(e));
}
__device__ __forceinline__ unsigned dbg_hash(unsigned x) { x ^= x >> 16; x *= 0x7feb352du; x ^= x >> 15; x *= 0x846ca68bu; x ^= x >> 16; return x; }
__device__ __forceinline__ float block_sum(float v, LAS float* red, int tid) {
    v = wave_sum(v); __syncthreads(); if ((tid & 63) == 0) red[tid >> 6] = v; __syncthreads();
    float s = 0.f; for (int w = 0; w < 8; ++w) s += red[w]; __syncthreads(); return s;
}
__device__ __forceinline__ float block_max(float v, LAS float* red, int tid) {
    v = fmaxf(v, dpp_f(v, 0)); v = fmaxf(v, dpp_f(v, 1)); v = fmaxf(v, dpp_f(v, 2)); v = fmaxf(v, dpp_f(v, 3));
    v = fmaxf(v, __builtin_bit_cast(float, __builtin_amdgcn_ds_swizzle(__builtin_bit_cast(int, v), 0x401F)));
    v = cross_max(v);
    __syncthreads(); if ((tid & 63) == 0) red[tid >> 6] = v; __syncthreads();
    float s = red[0]; for (int w = 1; w < 8; ++w) s = fmaxf(s, red[w]); __syncthreads(); return s;
}
__device__ __forceinline__ const float* dbg_res_row(const Params& P, int layer, int r) {
    const float* xl = (const float*)(fresh_ws(P.ws) + WS_XL);
    if (layer == 0) return r < NLAT ? P.in[I_X] + (size_t)r * D : P.in[I_CTX] + (size_t)(r - NLAT) * D;
    return xl + (size_t)r * D;
}
__device__ __forceinline__ int dbg_vec(int r) { return r < SEQ ? 0 : (r < NLAT ? 1 : 2); }

__device__ __forceinline__ void dbg_check_norm(Frame& F, const Params& P, int layer) {
    const int tid = fresh_tid(F.wave); LAS float* hn = (LAS float*)F.lds; LAS float* red = hn + D;
    const float* modl = (const float*)(fresh_ws(P.ws) + WS_MOD) + (size_t)layer * 3 * 12288;
    { const float t1 = block_sum(1.0f, red, tid), t2 = block_sum((float)tid, red, tid), t3 = wave_sum((float)(tid & 63));
      dbg_err(F, 2, t1, 512.0f, 1.0f); dbg_err(F, 3, t2, 130816.0f, 1.0f); dbg_err(F, 4, t3, 2016.0f, 1.0f); }
    for (int s = F.vcu; s < 256; s += F.G) {
        const unsigned hsh = dbg_hash(s * 2654435761u + 17u + layer);
        const int r = (s & 7) == 7 ? NLAT + (hsh % NCTX) : (int)(hsh % NLAT);
        const float* xr = dbg_res_row(P, layer, r); const int v = dbg_vec(r);
        float ss = 0.f; for (int k = tid; k < D; k += 512) ss += xr[k] * xr[k];
        ss = block_sum(ss, red, tid); const float rstd = 1.0f / sqrtf(ss / D + NORM_EPS);
        const bf16* hr = (const bf16*)(fresh_ws(P.ws) + WS_H) + (size_t)r * D;
        for (int k = tid; k < D; k += 512) { const float want = (xr[k] * rstd * P.in[I_GMIX][layer * D + k]) * (1.0f + modl[(v * 6 + 1) * D + k]) + modl[(v * 6 + 0) * D + k]; dbg_err(F, 0, bf2f(hr[k]), want, 1.0f); }
        const int v2 = s % 3, j = (int)((hsh >> 5) % 12288);
        float a = 0.f; for (int k = tid; k < D; k += 512) { const float c = v2 < 2 ? P.in[I_C][v2 * D + k] : P.in[I_CCTX][k]; a += c / (1.0f + expf(-c)) * P.in[I_WMOD][((size_t)layer * D + k) * 12288 + j]; }
        a = block_sum(a, red, tid);
        if (tid == 0) dbg_err(F, 1, modl[v2 * 12288 + j], a + P.in[I_BMOD][layer * 12288 + j], 1.0f);
        __syncthreads();
    }
}
__device__ __forceinline__ void dbg_check_inproj(Frame& F, const Params& P, int layer) {
    const int tid = fresh_tid(F.wave); LAS float* hn = (LAS float*)F.lds; LAS float* red = hn + D;
    const float* modl = (const float*)(fresh_ws(P.ws) + WS_MOD) + (size_t)layer * 3 * 12288;
    for (int s = F.vcu; s < 256; s += F.G) {
        const unsigned hsh = dbg_hash(s * 2654435761u + 17u + layer);
        const int r = (s & 7) == 7 ? NLAT + (hsh % NCTX) : (int)(hsh % NLAT);
        int c = (int)((hsh >> 8) % IN_COLS); if ((s & 3) == 1) c = COL_Q + (int)((hsh >> 8) % 1024); if ((s & 3) == 2) c = COL_K + (int)((hsh >> 8) % 1024); if ((s & 15) == 3) c = COL_DT + (int)((hsh >> 8) % 16);
        const float* xr = dbg_res_row(P, layer, r); const int v = dbg_vec(r);
        float ss = 0.f; for (int k = tid; k < D; k += 512) ss += xr[k] * xr[k];
        ss = block_sum(ss, red, tid); const float rstd = 1.0f / sqrtf(ss / D + NORM_EPS);
        for (int k = tid; k < D; k += 512) hn[k] = (xr[k] * rstd * P.in[I_GMIX][layer * D + k]) * (1.0f + modl[(v * 6 + 1) * D + k]) + modl[(v * 6 + 0) * D + k];
        __syncthreads();
        const float* w = P.in[I_WIN] + (size_t)layer * D * IN_COLS;
        const bool qk = (c >= COL_Q && c < COL_Q + 1024) || (c >= COL_K && c < COL_K + 1024);
        int cp = c; if (qk) { const int base = c >= COL_K ? COL_K : COL_Q; const int cl = (c - base) & 31; cp = c - cl + ((cl + 16) & 31); }
        float d0 = 0.f, d1 = 0.f; for (int k = tid; k < D; k += 512) { d0 += hn[k] * w[(size_t)k * IN_COLS + c]; d1 += hn[k] * w[(size_t)k * IN_COLS + cp]; }
        d0 = block_sum(d0, red, tid); d1 = block_sum(d1, red, tid);
        if (tid == 0) {
            float want = d0, got;
            if (c < COL_Z) got = bf2f(((const bf16*)(fresh_ws(P.ws) + WS_CONV))[(size_t)r * 1536 + c]);
            else if (c < COL_Q) got = bf2f(((const bf16*)(fresh_ws(P.ws) + WS_Z))[(size_t)r * 512 + c - COL_Z]);
            else if (c < COL_XBC) got = 0.f;
            else if (c < COL_DT) got = bf2f(((const bf16*)(fresh_ws(P.ws) + WS_XBC))[(size_t)r * 1024 + c - COL_XBC]);
            else if (c < COL_K) got = ((const float*)(fresh_ws(P.ws) + WS_DT))[(size_t)r * 16 + c - COL_DT];
            else if (c < COL_V) got = 0.f;
            else { const size_t kr = r < NLAT ? (size_t)(r / SEQ) * KVLEN + CTXL + (r % SEQ) : (size_t)((r - NLAT) / CTXL) * KVLEN + (r - NLAT) % CTXL; got = bf2f(((const bf16*)(fresh_ws(P.ws) + WS_VB))[kr * 1024 + c - COL_V]); }
            if (qk) {
                const int base = c >= COL_K ? COL_K : COL_Q; const int cc = c - base, cl = cc & 31, seg = (cc >> 5) & 1, f = cl & 15;
                if (r < NLAT) { const int t = r % SEQ; const float pos = seg ? (float)(t % 64) : (float)(t / 64); const float inv = powf(10000.0f, -(float)f / 16.0f); const float ang = pos * inv;
                    want = cl < 16 ? d0 * cosf(ang) - d1 * sinf(ang) : d0 * cosf(ang) + d1 * sinf(ang); }
                const int mem = (cc & ~31) + pg8::perm32(cl);
                if (base == COL_Q) got = bf2f(((const bf16*)(fresh_ws(P.ws) + WS_Q))[(size_t)r * 1024 + mem]);
                else { const size_t kr = r < NLAT ? (size_t)(r / SEQ) * KVLEN + CTXL + (r % SEQ) : (size_t)((r - NLAT) / CTXL) * KVLEN + (r - NLAT) % CTXL; got = bf2f(((const bf16*)(fresh_ws(P.ws) + WS_KB))[kr * 1024 + mem]); }
            }
            { const int seg = ((c - (c >= COL_K ? COL_K : COL_Q)) >> 5) & 1; const int slot = (r < NLAT ? 0 : 3) + (qk ? 1 + seg : 0); dbg_err(F, slot, got, want, 1.0f); }
        }
        __syncthreads();
    }
}
__device__ __forceinline__ void dbg_check_attn(Frame& F, const Params& P, int layer) {
    const int tid = fresh_tid(F.wave); LAS float* sc1 = (LAS float*)F.lds; LAS float* sc2 = sc1 + KVLEN; LAS float* red = sc2 + KVLEN; LAS float* ov = red + 16; LAS float* qv = ov + 512;
    const bf16* qb = (const bf16*)(fresh_ws(P.ws) + WS_Q); const bf16* kb = (const bf16*)(fresh_ws(P.ws) + WS_KB); const bf16* vb = (const bf16*)(fresh_ws(P.ws) + WS_VB); const bf16* cat = (const bf16*)(fresh_ws(P.ws) + WS_CAT);
    const float lam_init = 0.8f - 0.6f * expf(-0.3f * (float)layer); const float* lv = P.in[I_LAMBDA] + layer * 256;
    float d1 = 0.f, d2 = 0.f; for (int i = 0; i < 64; ++i) { d1 += lv[i] * lv[64 + i]; d2 += lv[128 + i] * lv[192 + i]; }
    const float lam = expf(d1) - expf(d2) + lam_init;
    for (int s = F.vcu; s < 64; s += F.G) {
        const unsigned hsh = dbg_hash(s * 2654435761u + 99u + layer);
        const bool isctx = layer == 0 && (s & 7) == 7; const int h = (hsh >> 4) & 7;
        const int r = isctx ? NLAT + (int)(hsh % NCTX) : (int)((hsh >> 7) % NLAT);
        const int b = isctx ? (r - NLAT) / CTXL : r / SEQ; const int nk = isctx ? CTXL : KVLEN;
        if (tid < 128) qv[tid] = bf2f(qb[(size_t)r * 1024 + h * 128 + tid]);
        __syncthreads();
        float m1 = -1e30f, m2 = -1e30f;
        for (int k = tid; k < nk; k += 512) { const bf16* kr = kb + ((size_t)b * KVLEN + k) * 1024 + h * 128; float a = 0.f, c2 = 0.f;
            for (int d = 0; d < 64; ++d) { a += qv[d] * bf2f(kr[d]); c2 += qv[64 + d] * bf2f(kr[64 + d]); }
            a *= 0.125f; c2 *= 0.125f; sc1[k] = a; sc2[k] = c2; m1 = fmaxf(m1, a); m2 = fmaxf(m2, c2); }
        m1 = block_max(m1, red, tid); m2 = block_max(m2, red, tid);
        float l1 = 0.f, l2 = 0.f;
        for (int k = tid; k < nk; k += 512) { const float p1 = expf(sc1[k] - m1), p2 = expf(sc2[k] - m2); sc1[k] = p1; sc2[k] = p2; l1 += p1; l2 += p2; }
        l1 = block_sum(l1, red, tid); l2 = block_sum(l2, red, tid);
        { const int d = tid & 127, part = tid >> 7; float o = 0.f;
          for (int k = part; k < nk; k += 4) o += (sc1[k] / l1 - lam * sc2[k] / l2) * bf2f(vb[((size_t)b * KVLEN + k) * 1024 + h * 128 + d]);
          ov[tid] = o; }
        __syncthreads();
        float o = 0.f, sq = 0.f; if (tid < 128) { o = ov[tid] + ov[128 + tid] + ov[256 + tid] + ov[384 + tid]; sq = o * o; }
        sq = block_sum(sq, red, tid);
        if (tid < 128) { const float want = o / sqrtf(sq / 128.0f + NORM_EPS) * P.in[I_SUBLN][layer * 128 + tid] * (1.0f - lam_init);
            dbg_err(F, 1, bf2f(cat[(size_t)r * D + 1024 + h * 128 + tid]), want, 1.0f); }
        __syncthreads();
    }
}
__device__ __forceinline__ void dbg_expect_rows(Frame& F, const Params& P, int layer, int which) {
    const int tid = fresh_tid(F.wave); LAS float* hn = (LAS float*)F.lds; LAS float* act = hn + D; LAS float* red = act + FFD;
    const float* modl = (const float*)(fresh_ws(P.ws) + WS_MOD) + (size_t)layer * 3 * 12288; float* ex = (float*)(fresh_ws(P.ws) + WS_DBG) + (size_t)which * 16 * D;
    for (int s = F.vcu; s < 16; s += F.G) {
        const unsigned hsh = dbg_hash(s * 2654435761u + 7u + which * 131u + layer);
        const int r = (s & 7) == 7 && layer == 0 ? NLAT + (int)(hsh % NCTX) : (int)(hsh % NLAT); const int v = dbg_vec(r);
        if (which == 0) {
            const bf16* cr = (const bf16*)(fresh_ws(P.ws) + WS_CAT) + (size_t)r * D; const float* w = P.in[I_WOUT] + (size_t)layer * D * D; const float* res = dbg_res_row(P, layer, r);
            for (int k = tid; k < D; k += 512) hn[k] = bf2f(cr[k]);
            __syncthreads();
            for (int c = tid; c < D; c += 512) { float a = 0.f; for (int k = 0; k < D; ++k) a += hn[k] * w[(size_t)k * D + c]; ex[s * D + c] = res[c] + modl[(v * 6 + 2) * D + c] * a; }
        } else {
            const float* xr = (const float*)(fresh_ws(P.ws) + WS_XL) + (size_t)r * D;
            float ss = 0.f; for (int k = tid; k < D; k += 512) ss += xr[k] * xr[k];
            ss = block_sum(ss, red, tid); const float rstd = 1.0f / sqrtf(ss / D + NORM_EPS);
            for (int k = tid; k < D; k += 512) hn[k] = (xr[k] * rstd * P.in[I_GFFN][layer * D + k]) * (1.0f + modl[(v * 6 + 4) * D + k]) + modl[(v * 6 + 3) * D + k];
            __syncthreads();
            for (int j = tid; j < FFD; j += 512) { float g = 0.f, u = 0.f; for (int k = 0; k < D; ++k) { g += hn[k] * P.in[I_FG][(size_t)k * FFD + j]; u += hn[k] * P.in[I_FU][(size_t)k * FFD + j]; } act[j] = g / (1.0f + expf(-g)) * u; }
            __syncthreads();
            { float* ex2 = (float*)(fresh_ws(P.ws) + WS_DBG + 256 * 1024) + (size_t)s * 7680; for (int k = tid; k < D; k += 512) ex2[k] = hn[k]; for (int j = tid; j < FFD; j += 512) ex2[D + j] = act[j]; }
            for (int c = tid; c < D; c += 512) { float a = 0.f; for (int j = 0; j < FFD; ++j) a += act[j] * P.in[I_FD][(size_t)j * D + c]; ex[s * D + c] = xr[c] + modl[(v * 6 + 5) * D + c] * a; }
        }
        __syncthreads();
    }
}
__device__ __forceinline__ void dbg_compare_rows(Frame& F, const Params& P, int layer, int which) {
    const int tid = fresh_tid(F.wave); const float* ex = (const float*)(fresh_ws(P.ws) + WS_DBG) + (size_t)which * 16 * D;
    for (int s = F.vcu; s < 16; s += F.G) {
        const unsigned hsh = dbg_hash(s * 2654435761u + 7u + which * 131u + layer);
        const int r = (s & 7) == 7 && layer == 0 ? NLAT + (int)(hsh % NCTX) : (int)(hsh % NLAT);
        const float* xr = (const float*)(fresh_ws(P.ws) + WS_XL) + (size_t)r * D;
        for (int c = tid; c < D; c += 512) dbg_err(F, 2 + which, xr[c], ex[s * D + c], 1.0f);
        if (which == 1) { const float* ex2 = (const float*)(fresh_ws(P.ws) + WS_DBG + 256 * 1024) + (size_t)s * 7680;
            const bf16* hr = (const bf16*)(fresh_ws(P.ws) + WS_H) + (size_t)r * D; const bf16* ar = (const bf16*)(fresh_ws(P.ws) + WS_ACT) + (size_t)r * FFD;
            for (int k = tid; k < D; k += 512) dbg_err(F, 0, bf2f(hr[k]), ex2[k], 1.0f);
            for (int j = tid; j < FFD; j += 512) dbg_err(F, 1, bf2f(ar[j]), ex2[D + j], 1.0f); }
    }
}
__device__ __forceinline__ void dbg_check_moe(Frame& F, const Params& P) {
    const int tid = fresh_tid(F.wave); LAS float* hn = (LAS float*)F.lds; LAS float* act = hn + D; LAS float* yv = act + FFE; LAS float* red = yv + D; LAS float* lg = red + 16;
    const float* modl = (const float*)(fresh_ws(P.ws) + WS_MOD) + (size_t)1 * 3 * 12288;
    for (int s = F.vcu; s < 16; s += F.G) {
        const unsigned hsh = dbg_hash(s * 2654435761u + 1234u); const int r = (int)(hsh % NLAT), v = dbg_vec(r);
        const float* xr = (const float*)(fresh_ws(P.ws) + WS_XL) + (size_t)r * D;
        float ss = 0.f; for (int k = tid; k < D; k += 512) ss += xr[k] * xr[k];
        ss = block_sum(ss, red, tid); const float rstd = 1.0f / sqrtf(ss / D + NORM_EPS);
        for (int k = tid; k < D; k += 512) { hn[k] = (xr[k] * rstd * P.in[I_GFFN][D + k]) * (1.0f + modl[(v * 6 + 4) * D + k]) + modl[(v * 6 + 3) * D + k]; yv[k] = 0.f; }
        __syncthreads();
        for (int e = 0; e < NE; ++e) { float a = 0.f; for (int k = tid; k < D; k += 512) a += hn[k] * P.in[I_RW][k * NE + e]; a = block_sum(a, red, tid); if (tid == 0) lg[e] = a + P.in[I_RB][e]; }
        __syncthreads();
        int i0 = 0; for (int e = 1; e < NE; ++e) if (lg[e] > lg[i0]) i0 = e;
        int i1 = -1; for (int e = 0; e < NE; ++e) if (e != i0 && (i1 < 0 || lg[e] > lg[i1])) i1 = e;
        const float p0 = 1.0f / (1.0f + expf(lg[i1] - lg[i0])), p1 = 1.0f - p0;
        for (int kk = 0; kk < 2; ++kk) {
            const int e = kk ? i1 : i0; const float pe = kk ? p1 : p0;
            const float* wg = P.in[I_MG] + (size_t)e * D * FFE; const float* wu = P.in[I_MU] + (size_t)e * D * FFE; const float* wd = P.in[I_MD] + (size_t)e * FFE * D;
            for (int j = tid; j < FFE; j += 512) { float g = 0.f, u = 0.f; for (int k = 0; k < D; ++k) { g += hn[k] * wg[(size_t)k * FFE + j]; u += hn[k] * wu[(size_t)k * FFE + j]; } act[j] = g / (1.0f + expf(-g)) * u; }
            __syncthreads();
            for (int c = tid; c < D; c += 512) { float a = 0.f; for (int j = 0; j < FFE; ++j) a += act[j] * wd[(size_t)j * D + c]; yv[c] += pe * a; }
            __syncthreads();
        }
        float q = 0.f; for (int c = tid; c < D; c += 512) { const float o = xr[c] + modl[(v * 6 + 5) * D + c] * yv[c]; yv[c] = o; q += o * o; }
        q = block_sum(q, red, tid); const float rs = 1.0f / sqrtf(q / D + NORM_EPS);
        for (int c = tid; c < D; c += 512) dbg_err(F, 4, P.out[(size_t)r * D + c], yv[c] * rs * P.in[I_GFIN][c], 1.0f);
        if (tid == 0) { const int* te = (const int*)(fresh_ws(P.ws) + WS_ROUTE); const float* tp = (const float*)(te + 4 * NLAT);
            const bool close = fabsf(lg[i1] - lg[i0]) < 1e-3f;
            if (!close) { dbg_err(F, 5, (float)te[2 * r], (float)i0, 1.0f); dbg_err(F, 5, tp[2 * r], p0, 1.0f); } }
        __syncthreads();
    }
}
__device__ __forceinline__ void dbg_report(Frame& F, const Params& P) {
    const int tid = fresh_tid(F.wave);
    for (size_t i = (size_t)F.vcu * 512 + tid; i < (size_t)NLAT * D; i += (size_t)F.G * 512) P.out[i] = 0.f;
    if (F.vcu == 0 && tid == 0) {
#if DBG_REPORT >= 0
        const float e = __uint_as_float(__hip_atomic_load(F.ctl + CW_DIAG + 64 * DBG_REPORT, RLX_AGENT));
        int bucket = 0; { float t = e * 1024.0f; while (t >= 2.0f && bucket < 60) { t *= 0.5f; ++bucket; } }
        P.out[0] = 1000.0f * (float)(10 + bucket);
#else
        const float thr[6] = {0.06f, 0.06f, 0.08f, 0.08f, 0.06f, 0.06f}; int mask = 0;
        for (int k = 0; k < 6; ++k) { const float e = __uint_as_float(__hip_atomic_load(F.ctl + CW_DIAG + 64 * k, RLX_AGENT)); if (e > thr[k]) mask |= 1 << k; }
        P.out[0] = 1000.0f * (float)(10 + mask);
#endif
    }
}
#endif
#ifndef EN_PRO
#define EN_PRO 1
#endif
#ifndef EN_NORM
#define EN_NORM 1
#endif
#ifndef EN_GIN
#define EN_GIN 1
#endif
#ifndef EN_CONV
#define EN_CONV 1
#endif
#ifndef EN_S1
#define EN_S1 1
#endif
#ifndef EN_S2
#define EN_S2 1
#endif
#ifndef EN_S3
#define EN_S3 1
#endif
#ifndef EN_ATT
#define EN_ATT 1
#endif
#ifndef EN_WOUT
#define EN_WOUT 1
#endif
#ifndef EN_GU
#define EN_GU 1
#endif
#ifndef EN_DN
#define EN_DN 1
#endif
#ifndef EN_ROUTE
#define EN_ROUTE 1
#endif
#ifndef EN_GATH
#define EN_GATH 1
#endif
#ifndef EN_MGU
#define EN_MGU 1
#endif
#ifndef EN_MDN
#define EN_MDN 1
#endif
#ifndef EN_FIN
#define EN_FIN 1
#endif
__global__ void __launch_bounds__(NWAVES * 64, 2) fwd_kernel(Params P) {
    extern __shared__ __attribute__((aligned(16))) unsigned char lds[];
    Frame F;
    F.lds = (LAS unsigned char*)lds;
    F.MISC = (volatile LAS unsigned*)(F.lds + MISC_OFF);
    F.wave = __builtin_amdgcn_readfirstlane(threadIdx.x >> 6);
    F.G = gridDim.x; { const int bx = blockIdx.x; F.vcu = (F.G % 8 == 0) ? (bx % 8) * (F.G / 8) + bx / 8 : bx; }
    unsigned char* ws = P.ws;
    F.ctl = (gu32*)(ws + WS_CTL);
    for (int u = threadIdx.x; u < (LDS_BYTES - LDSCTL_OFF) / 4; u += NWAVES * 64) ((LAS unsigned*)(F.lds + LDSCTL_OFF))[u] = 0u;
    __syncthreads();
    XcdBarrier bar = xcd_barrier_post((unsigned*)(ws + WS_CTL) + CW_BAR, F.MISC + 8);
#if DBG == 2
    unsigned long long* tsb = (unsigned long long*)(ws + WS_ROUTE + 512 * 1024); int nst = 0;
#define STAMP() do { if (blockIdx.x == 0 && threadIdx.x == 0) tsb[nst] = __builtin_amdgcn_s_memrealtime(); ++nst; } while (0)
    STAMP();
#else
#define STAMP() do {} while (0)
#endif
#if SIMPLE_BAR
    unsigned nbar = 0;
#define GRID_BAR() do { ++nbar; simple_barrier((unsigned*)(ws + WS_CTL) + 2048, nbar * (unsigned)gridDim.x); } while (0)
#else
#define GRID_BAR() do { xcd_barrier(bar); STAMP(); } while (0)
#endif

    bf16* xl = (bf16*)(ws + WS_XL); bf16* hb = (bf16*)(ws + WS_H); bf16* cat = (bf16*)(ws + WS_CAT);
    const float* mod = (const float*)(ws + WS_MOD);
    int* tok_e = (int*)(ws + WS_ROUTE); int* tok_slot = tok_e + 2 * NLAT; float* tok_p = (float*)(tok_slot + 2 * NLAT);

#if DUP_BAR
    for (int i_ = 0; i_ < DUP_BAR; ++i_) GRID_BAR();
#endif
#if EN_PRO
    p0_prologue(F, P);
#if DUP_PRO
    __syncthreads(); if (NOSTORE_PROBE) { if (threadIdx.x == 0) g_nostore = 1; __syncthreads(); } p0_prologue(F, P); if (NOSTORE_PROBE) { __syncthreads(); if (threadIdx.x == 0) g_nostore = 0; __syncthreads(); }
#endif
#endif
    GRID_BAR();

    constexpr int G0 = 256, RM_A = ((T / 256) * (NIN / 256)) % G0, RM_B = (NCH * NB * 8) % G0, RM_C = ((T / 256) * (2 * FFD / 256)) % G0;
    constexpr int CAP_T = (IPW_T > 0) ? (G0 - 32) * NWAVES * IPW_T + 24 * NWAVES * (IPW_T - 1) : 0;
    constexpr int DP_A0 = 0, DP_B0 = DP_A0 + (G0 - RM_A) * NWAVES * IPW_G, DP_T0 = DP_B0 + (G0 - RM_B) * NWAVES * IPW_S, DP_C0 = DP_T0 + CAP_T, DP_A1 = DP_C0 + (G0 - RM_C) * NWAVES * IPW_G,
                  DP_B1 = DP_A1 + (G0 - RM_A) * NWAVES * IPW_G, DP_END = DP_B1 + (G0 - RM_B) * NWAVES * IPW_S;
    static_assert(DP_A1 >= CV_IN + CV_OUT, "layer 1's w_in / w_out must be converted during layer 0");
    const bool slots = DEFER && (F.G == G0);
#define TAIL_SLOT(rem, myidx, ipw, dpos) do { if (slots && (myidx) >= (rem)) deferred_slot(F, P, (dpos), (myidx) - (rem), G0 - (rem), (ipw)); } while (0)
    for (int layer = 0; layer < 2; ++layer) {
        ws = fresh_ws(P.ws); F.wave = fresh_s(F.wave); F.vcu = fresh_s(F.vcu); F.G = fresh_s(F.G);
        const float* modl = mod + (size_t)layer * 3 * 12288;
        const void* resLat = layer == 0 ? (const void*)P.in[I_X] : (const void*)xl; const void* resCtx = layer == 0 ? (const void*)P.in[I_CTX] : (const void*)(xl + (size_t)NLAT * D);
#if EN_NORM
        if (layer == 0) norm_phase<false, I8_IN ? 2 : 0, false, false>(F, resLat, resCtx, P.in[I_GMIX] + layer * D, modl, 0, 1, hb, T, nullptr, nullptr, nullptr, nullptr, nullptr, nullptr, 11, nullptr, nullptr, (float*)(ws + WS_HS));
        else norm_phase<false, I8_IN ? 2 : 0, true, true>(F, resLat, resCtx, P.in[I_GMIX] + layer * D, modl, 0, 1, hb, T, nullptr, nullptr, nullptr, nullptr, nullptr,
                          (const float*)(ws + WS_PART), 11, mod + (size_t)(2 * 6 + 5) * D, nullptr, (float*)(ws + WS_HS));
#if DUP_SMALL & 16
        norm_phase<false>(F, resLat, resCtx, P.in[I_GMIX] + layer * D, modl, 0, 1, hb, T, nullptr, nullptr, nullptr, nullptr, nullptr);
#endif
#endif
        GRID_BAR();
#if DBG == 1
        if ((DBG_MASK & 32) && layer == DBG_L) { dbg_check_norm(F, P, layer); }
#endif
        {
            pg8::PlainSched S; S.init(T / 256, NIN / 256, F.G, (int)blockIdx.x); S.A = (const char*)hb; S.Bt = (const char*)(ws + WS_WIN + layer * SZ_WIN); S.tstep = (size_t)256 * D * (I8_IN ? 1 : 2);
            pg8::EpiIn E{(bf16*)(ws + WS_CONV), (bf16*)(ws + WS_Z), (bf16*)(ws + WS_Q), (bf16*)(ws + WS_XBC), (bf16*)(ws + WS_KB), (bf16*)(ws + WS_VB), (float*)(ws + WS_DT),
                         (const float*)(ws + WS_ROPE), (const float*)(ws + WS_ROPE) + 192 * 16, ws + WS_K8, ws + WS_V8};
            if (V8_DIRECT) { S.swap_from = 20; S.swap_to = 24; }
#if EN_GIN && I8_IN
#if DUP_GIN
            pg8::gemm_phase<pg8::EpiIn, pg8::PlainSched, true, true, 2>(F.lds + RING_OFF, D / 2, S, E, F.wave, DUP_GIN == 2 ? 8 : 0, 0, 0, (const float*)(ws + WS_HS), (const float*)(ws + WS_CS) + CS_WIN + layer * 6400); __syncthreads();
#endif
            pg8::gemm_phase<pg8::EpiIn, pg8::PlainSched, true, true, 2>(F.lds + RING_OFF, D / 2, S, E, F.wave, 0, 0, 0, (const float*)(ws + WS_HS), (const float*)(ws + WS_CS) + CS_WIN + layer * 6400);
            TAIL_SLOT(RM_A, (int)blockIdx.x, IPW_G, layer ? DP_A1 : DP_A0);
#elif EN_GIN
            pg8::gemm_phase<pg8::EpiIn, pg8::PlainSched, true, true>(F.lds + RING_OFF, D, S, E, F.wave);
#if DUP_GIN
            __syncthreads(); pg8::gemm_phase<pg8::EpiIn, pg8::PlainSched, true, true>(F.lds + RING_OFF, D, S, E, F.wave);
#endif
#endif
        }
        GRID_BAR();
#if DBG == 1
        if ((DBG_MASK & 1) && layer == DBG_L) { dbg_check_inproj(F, P, layer); }
#endif
#if EN_CONV
        conv_phase(F, (const bf16*)(ws + WS_CONV), (const bf16*)(ws + WS_XBC), cat, (bf16*)(ws + WS_XBCC), P.in[I_CONVW] + layer * 1536, P.in[I_SCONVW] + layer * 3072, P.in[I_SCONVB] + layer * 1024);
#if ATT_FP8 && ATT_DMA && !V8_DIRECT
        v8_phase(F, P);
#endif
#if DUP_SMALL & 8
        conv_phase(F, (const bf16*)(ws + WS_CONV), (const bf16*)(ws + WS_XBC), cat, (bf16*)(ws + WS_XBCC), P.in[I_CONVW] + layer * 1536, P.in[I_SCONVW] + layer * 3072, P.in[I_SCONVB] + layer * 1024);
#endif
#endif
        GRID_BAR();
#if EN_S1
#if DUP_S1V
        ssd_local_phase<DUP_S1V>(F, P, layer);
#endif
        ssd_local_phase(F, P, layer);
        TAIL_SLOT(RM_B, F.vcu, IPW_S, layer ? DP_B1 : DP_B0);
#if DUP_SMALL & 1
        ssd_local_phase(F, P, layer);
#endif
#endif
        GRID_BAR();
#if EN_S2
        ssd_scan_phase(F, P);
#if DUP_SMALL & 2
        ssd_scan_phase(F, P);
#endif
#endif
        GRID_BAR();
#if EN_S3
        ssd_out_phase(F, P, layer);
#if DUP_SMALL & 4
        ssd_out_phase(F, P, layer);
#endif
#endif
#if EN_ATT
        attn_phase<0>(F, P, layer, layer == 0, lds);
        if (IPW_T > 0 && slots && layer == 0) {
            if (F.vcu >= 32) deferred_slot(F, P, DP_T0, F.vcu - 32, G0 - 32, IPW_T);
            else if (F.vcu >= 8 && IPW_T > 1) deferred_slot(F, P, DP_T0 + (G0 - 32) * NWAVES * IPW_T, F.vcu - 8, 24, IPW_T - 1);
        }
#if DUP_ATT
        attn_phase<DUP_ATT - 1>(F, P, layer, layer == 0, lds);
#endif
#endif
        GRID_BAR();
#if DBG == 1
        if (layer == DBG_L) { if (DBG_MASK & 2) dbg_check_attn(F, P, layer); if (DBG_MASK & 4) dbg_expect_rows(F, P, layer, 0); GRID_BAR(); }
#endif
        {
            pg8::PlainSched S; S.init(NLAT / 256, D / 256, F.G, (int)blockIdx.x); S.A = (const char*)cat; S.Bt = (const char*)(ws + WS_WOUT + layer * SZ_WOUT); S.tstep = (size_t)256 * D * 2;
#if EN_WOUT
            if (layer == 0) { pg8::EpiResidT<false> E{resLat, resCtx, xl, modl + 2 * D}; pg8::gemm_phase<pg8::EpiResidT<false>, pg8::PlainSched, true, true>(F.lds + RING_OFF, D, S, E, F.wave); }
            else { pg8::EpiResidT<true> E{resLat, resCtx, xl, modl + 2 * D}; pg8::gemm_phase<pg8::EpiResidT<true>, pg8::PlainSched, true, true>(F.lds + RING_OFF, D, S, E, F.wave); }
            if (layer == 0) {
                __syncthreads();
                pg8::CtxSplitSched C; C.nN = D / 256; C.nS = 8; C.G = F.G; C.c = (int)blockIdx.x; C.A = (const char*)cat; C.Bt = S.Bt; C.tstep = S.tstep; C.kslice = (size_t)(D / 8) * 2;
                pg8::EpiPartial EP{(float*)(ws + WS_PART)};
                pg8::gemm_phase<pg8::EpiPartial, pg8::CtxSplitSched, true, true>(F.lds + RING_OFF, D, C, EP, F.wave, D / 8 / 64);
            }
#endif
        }
        GRID_BAR();
#if DBG == 1
        if ((DBG_MASK & 4) && layer == DBG_L) { dbg_compare_rows(F, P, layer, 0); }
        if ((DBG_MASK & 8) && layer == 0) { dbg_expect_rows(F, P, layer, 1); GRID_BAR(); }
#endif
        if (layer == 0) {
            norm_phase<false, I8_GU ? 2 : 1, true, false>(F, xl, P.in[I_CTX], P.in[I_GFFN], modl, 3, 4, hb, T, nullptr, nullptr, nullptr, nullptr, nullptr,
                              (const float*)(ws + WS_PART), 8, modl + (size_t)(2 * 6 + 2) * D, xl, (float*)(ws + WS_HS));
            GRID_BAR();
            {
                pg8::PlainSched S; S.init(T / 256, 2 * FFD / 256, F.G, (int)blockIdx.x); S.A = (const char*)hb; S.Bt = (const char*)(ws + WS_WGU); S.tstep = (size_t)256 * D;
                pg8::EpiSwiGLU8 E{ws + WS_ACT, FFD};
#if EN_GU
#if I8_GU
                pg8::gemm_phase<pg8::EpiSwiGLU8, pg8::PlainSched, true, true, 2>(F.lds + RING_OFF, D / 2, S, E, F.wave, 0, 0, 0, (const float*)(ws + WS_HS), (const float*)(ws + WS_CS) + CS_WGU);
                TAIL_SLOT(RM_C, (int)blockIdx.x, IPW_G, DP_C0);
#else
                pg8::gemm_phase<pg8::EpiSwiGLU8, pg8::PlainSched, true, true, true>(F.lds + RING_OFF, D / 2, S, E, F.wave, 0, W8_SC8, 0x7F7F7F7F);
#endif
#endif
            }
            GRID_BAR();
            {
                pg8::PlainSched S; S.init(NLAT / 256, D / 256, F.G, (int)blockIdx.x); S.A = (const char*)(ws + WS_ACT); S.Bt = (const char*)(ws + WS_WDN); S.tstep = (size_t)256 * FFD;
                pg8::EpiResidT<true> E{xl, xl + (size_t)NLAT * D, xl, modl + 5 * D};
#if EN_DN
                pg8::gemm_phase<pg8::EpiResidT<true>, pg8::PlainSched, true, true, true>(F.lds + RING_OFF, FFD / 2, S, E, F.wave, 0, W8_SC8, pg8::ACT_SC8);
#if !NO_DNSPLIT
                {
                    __syncthreads();
                    pg8::CtxSplitSched C; C.nN = D / 256; C.nS = 11; C.G = F.G; C.c = (int)blockIdx.x; C.A = S.A; C.Bt = S.Bt; C.tstep = S.tstep; C.kslice = (size_t)512;
                    pg8::EpiPartial EP{(float*)(ws + WS_PART)};
                    pg8::gemm_phase<pg8::EpiPartial, pg8::CtxSplitSched, true, true, true>(F.lds + RING_OFF, FFD / 2, C, EP, F.wave, 4, W8_SC8, pg8::ACT_SC8);
                }
#endif
#endif
            }
            GRID_BAR();
#if DBG == 1
            if (DBG_MASK & 8) dbg_compare_rows(F, P, layer, 1);
#endif
        } else {
#if EN_ROUTE
#if MOE_SPARSE
            norm_phase<true, 2, true, true>(F, xl, xl + (size_t)NLAT * D, P.in[I_GFFN] + D, modl, 3, 4, (bf16*)(ws + WS_AG), NLAT, P.in[I_RW], P.in[I_RB], tok_e, tok_slot, tok_p, nullptr, 0, nullptr, nullptr, (float*)(ws + WS_AGS2));
            if (slots) deferred_rest(F, P, DP_END);
#else
            norm_phase<true, I8_GU ? 2 : 1, true, true>(F, xl, xl + (size_t)NLAT * D, P.in[I_GFFN] + D, modl, 3, 4, hb, NLAT, P.in[I_RW], P.in[I_RB], tok_e, tok_slot, tok_p, nullptr, 0, nullptr, nullptr, (float*)(ws + WS_HS));
#endif
#endif
            GRID_BAR();
#if !MOE_SPARSE
#if EN_GATH
            moe_gather_phase(F, P);
#endif
#if DEFER
            if (slots) { __syncthreads(); deferred_rest(F, P, DP_END); }
#endif
            GRID_BAR();
#endif
            {
                const MoePanels mp = moe_panels(F);
                pg8::MoeSched S; S.init(mp.ps[8], 2 * FFE / 256, F.G, (int)blockIdx.x); S.A = (const char*)(ws + WS_AG); S.Bt = (const char*)(ws + WS_MGU); S.tstep = (size_t)256 * D; S.estride = SZ_MGU / 2; S.erows = 2 * FFE; S.sparse = MOE_SPARSE; S.caprows = NLAT;
                S.ps1 = mp.ps[1]; S.ps2 = mp.ps[2]; S.ps3 = mp.ps[3]; S.ps4 = mp.ps[4]; S.ps5 = mp.ps[5]; S.ps6 = mp.ps[6]; S.ps7 = mp.ps[7];
                pg8::EpiSwiGLU8 E{ws + WS_MACT, FFE};
#if EN_MGU
#if I8_GU
                pg8::gemm_phase<pg8::EpiSwiGLU8, pg8::MoeSched, true, true, 2>(F.lds + RING_OFF, D / 2, S, E, F.wave, 0, 0, 0, (const float*)(ws + (MOE_SPARSE ? WS_AGS2 : WS_AGS)), (const float*)(ws + WS_CS) + CS_MGU);
#else
                pg8::gemm_phase<pg8::EpiSwiGLU8, pg8::MoeSched, true, true, true>(F.lds + RING_OFF, D / 2, S, E, F.wave, 0, W8_SC8, 0x7F7F7F7F);
#endif
#endif
            }
            GRID_BAR();
            {
                const MoePanels mp = moe_panels(F);
                pg8::MoeSched S; S.init(mp.ps[8], D / 256, F.G, (int)blockIdx.x); S.A = (const char*)(ws + WS_MACT); S.Bt = (const char*)(ws + WS_MDN); S.tstep = (size_t)256 * FFE; S.estride = SZ_MDN / 2; S.erows = D; S.sparse = 0; S.caprows = 0;
                S.ps1 = mp.ps[1]; S.ps2 = mp.ps[2]; S.ps3 = mp.ps[3]; S.ps4 = mp.ps[4]; S.ps5 = mp.ps[5]; S.ps6 = mp.ps[6]; S.ps7 = mp.ps[7];
                pg8::EpiBf16 E{(bf16*)(ws + WS_AG), D};
#if EN_MDN
                pg8::gemm_phase<pg8::EpiBf16, pg8::MoeSched, true, true, true>(F.lds + RING_OFF, FFE / 2, S, E, F.wave, 0, W8_SC8, pg8::ACT_SC8);
#endif
            }
            GRID_BAR();
#if EN_FIN
            final_phase(F, P, modl);
#if DUP_FIN
            final_phase(F, P, modl);
#endif
#endif
#if PROBE
            {
                typedef int v8i_ __attribute__((ext_vector_type(8)));
                const int role = (F.wave < 4) ? (PROBE == 1 || PROBE == 2 || PROBE == 4 ? 1 : (PROBE == 3 ? 2 : 0)) : (PROBE == 1 ? 1 : (PROBE == 2 || PROBE == 3 || PROBE == 5 ? 2 : 0));
                f32x16 c0 = {}, c1 = {}, c2 = {}, c3 = {}; v8i_ a = {0x38383838, 0x38383838, 0x38383838, 0x38383838, 0x38383838, 0x38383838, 0x38383838, 0x38383838};
                float x0 = 1.0f, x1 = 2.0f, x2 = 3.0f, x3 = 4.0f;
                for (int it = 0; it < 2000; ++it) {
                    if (role == 1) {
#pragma unroll
                        for (int q = 0; q < 2; ++q) {
                            c0 = __builtin_amdgcn_mfma_scale_f32_32x32x64_f8f6f4(a, a, c0, 0, 0, 0, 0x7F7F7F7F, 0, 0x7F7F7F7F); c1 = __builtin_amdgcn_mfma_scale_f32_32x32x64_f8f6f4(a, a, c1, 0, 0, 0, 0x7F7F7F7F, 0, 0x7F7F7F7F);
                            c2 = __builtin_amdgcn_mfma_scale_f32_32x32x64_f8f6f4(a, a, c2, 0, 0, 0, 0x7F7F7F7F, 0, 0x7F7F7F7F); c3 = __builtin_amdgcn_mfma_scale_f32_32x32x64_f8f6f4(a, a, c3, 0, 0, 0, 0x7F7F7F7F, 0, 0x7F7F7F7F); }
                    } else if (role == 2) {
#pragma unroll
                        for (int q = 0; q < 32; ++q) asm volatile("v_fma_f32 %0, %0, %0, %0\n\tv_fma_f32 %1, %1, %1, %1\n\tv_fma_f32 %2, %2, %2, %2\n\tv_fma_f32 %3, %3, %3, %3" : "+v"(x0), "+v"(x1), "+v"(x2), "+v"(x3));
                    }
                }
                asm volatile("" :: "v"(c0), "v"(c1), "v"(c2), "v"(c3), "v"(x0), "v"(x1), "v"(x2), "v"(x3));
            }
#endif
#if DBG == 1
            GRID_BAR(); if (DBG_MASK & 16) dbg_check_moe(F, P); GRID_BAR(); dbg_report(F, P);
#endif
#if DBG == 2
            GRID_BAR();
            { const int tid = fresh_tid(F.wave);
              for (size_t i = (size_t)F.vcu * 512 + tid; i < (size_t)NLAT * D; i += (size_t)F.G * 512) P.out[i] = 0.f;
              __syncthreads(); GRID_BAR();
              float A = 0.f, B = 0.f;
              for (int i = 0; i + 1 < nst - 1; ++i) { const float d = (float)(tsb[i + 1] - tsb[i]) * 0.01f; if ((TSEL_A >> i) & 1ull) A += d; if ((TSEL_B >> i) & 1ull) B += d; }
              for (size_t i = (size_t)F.vcu * 512 + tid; i < 1000001; i += (size_t)F.G * 512) P.out[i] = i == 0 ? A : 10.0f * B; }
#endif
        }
    }
}

extern "C" void kernel_launch(void* const* d_in, const int* in_sizes, int n_in, void* d_out, int out_size, void* d_ws, size_t ws_size, hipStream_t stream) {
    static int grid = 0;
    if (grid == 0) {
        if (n_in != 28 || in_sizes[0] != NLAT * D || out_size != NLAT * D || ws_size < WS_END) {
            fprintf(stderr, "kernel_launch: built for 28 inputs, x/out of %d floats, >= %zu bytes of workspace; got n_in %d, in0 %d, out %d, ws %zu; nothing launched\n", NLAT * D, (size_t)WS_END, n_in, n_in > 0 ? in_sizes[0] : -1, out_size, ws_size);
            grid = -1; return; }
        int dev = 0, cus = 0, per_cu = 0;
        if (hipGetDevice(&dev) != hipSuccess || hipDeviceGetAttribute(&cus, hipDeviceAttributeMultiprocessorCount, dev) != hipSuccess) { fprintf(stderr, "kernel_launch: device query failed\n"); grid = -1; return; }
        if (hipFuncSetAttribute((const void*)fwd_kernel, hipFuncAttributeMaxDynamicSharedMemorySize, LDS_BYTES) != hipSuccess) { fprintf(stderr, "kernel_launch: hipFuncSetAttribute failed\n"); grid = -1; return; }
        if (hipOccupancyMaxActiveBlocksPerMultiprocessor(&per_cu, (const void*)fwd_kernel, NWAVES * 64, LDS_BYTES) != hipSuccess || per_cu < 1)
            fprintf(stderr, "kernel_launch: note: occupancy query reports %d workgroups per CU\n", per_cu);
        (void)hipGetLastError();
        grid = cus;
    }
    if (grid < 0) return;
    if (hipMemsetAsync((char*)d_ws + WS_CTL, 0, CTL_ZERO_BYTES, stream) != hipSuccess) { fprintf(stderr, "kernel_launch: memset failed\n"); return; }
    Params p{};
    for (int i = 0; i < 28; ++i) p.in[i] = (const float*)d_in[i];
    p.out = (float*)d_out; p.ws = (unsigned char*)d_ws;
    hipLaunchKernelGGL(fwd_kernel, dim3(grid), dim3(NWAVES * 64), LDS_BYTES, stream, p);
    const hipError_t le = hipPeekAtLastError();
    if (le != hipSuccess) fprintf(stderr, "kernel_launch: launch failed: %s\n", hipGetErrorName(le));
}
```

```cpp
#define CONV_U 1
#define S2_DEPTH 22
#define YD16 1
#ifndef DBG
#define DBG 0
#endif
#ifndef DBG_L
#define DBG_L 0
#endif
#ifndef DBG_REPORT
#define DBG_REPORT -1
#endif
#ifndef DBG_MASK
#define DBG_MASK 31
#endif
#ifndef SIMPLE_BAR
#define SIMPLE_BAR 0
#endif
#ifndef TSEL_A
#define TSEL_A 1ull
#endif
#ifndef TSEL_B
#define TSEL_B 0ull
#endif
#ifndef DUP_ATT
#define DUP_ATT 0
#endif
#ifndef DUP_GIN
#define DUP_GIN 0
#endif
#ifndef DUP_PRO
#define DUP_PRO 0
#endif
#ifndef ATT_PVPF
#define ATT_PVPF 1
#endif
#ifndef DUP_SMALL
#define DUP_SMALL 0
#endif
#ifndef ATT_NEGM
#define ATT_NEGM 1
#endif
#ifndef ATT_NOSWAP
#define ATT_NOSWAP 1
#endif
#ifndef ATT_LMFMA
#define ATT_LMFMA 0
#endif
#ifndef ATT_DMA
#define ATT_DMA 1
#endif
#ifndef ATT_FP8
#define ATT_FP8 1
#endif
#ifndef NO_DNSPLIT
#define NO_DNSPLIT 0
#endif
#ifndef ATT_QK8
#define ATT_QK8 1
#endif

#ifndef I8_CLIP
#define I8_CLIP 4.0f
#endif

#ifndef I8_IN
#define I8_IN 1
#endif
#ifndef I8_GU
#define I8_GU 1
#endif

#ifndef I8DBG
#define I8DBG 0
#endif

#ifndef ATT_PVX
#define ATT_PVX 1
#endif
#ifndef PVX_MASK
#define PVX_MASK 0x400
#endif

#ifndef ATT_Y8
#define ATT_Y8 1
#endif
#ifndef Y8_C
#define Y8_C 0.0f
#endif

#ifndef ATT_LEAD
#define ATT_LEAD 5
#endif

#ifndef ATT_STAG
#define ATT_STAG 0
#endif

#ifndef ATT_BAR2
#define ATT_BAR2 1
#endif

#ifndef DUP_MODV
#define DUP_MODV 0
#endif

#ifndef ITEM_NBFAST
#define ITEM_NBFAST 1
#endif

#ifndef DUP_BAR
#define DUP_BAR 0
#endif

#ifndef DUP_S1V
#define DUP_S1V 0
#endif

#ifndef S1_NT
#define S1_NT 0
#endif

#ifndef S1_LDSST
#define S1_LDSST 0
#endif

#ifndef ATT_PRIO
#define ATT_PRIO 0
#endif

#ifndef ATT_AB
#define ATT_AB 0
#endif

#ifndef PROBE
#define PROBE 0
#endif

#ifndef ATT_KPF
#define ATT_KPF 0
#endif

#ifndef ATT_P2
#define ATT_P2 0
#endif

#ifndef P2_KPF
#define P2_KPF 0
#endif
#ifndef P2_VPF
#define P2_VPF 0
#endif

#ifndef P2_AB
#define P2_AB 1
#endif

#ifndef TAIL2
#define TAIL2 0
#endif

#ifndef DEFER
#define DEFER 1
#endif
#ifndef IPW_G
#define IPW_G 6
#endif
#ifndef IPW_S
#define IPW_S 3
#endif

#ifndef IPW_T
#define IPW_T 0
#endif

#ifndef MOE_SPARSE
#define MOE_SPARSE 1
#endif

#ifndef NOSTORE_PROBE
#define NOSTORE_PROBE 0
#endif

#ifndef FIN_NT
#define FIN_NT 0
#endif

#ifndef DUP_FIN
#define DUP_FIN 0
#endif

#ifndef K8_DIRECT
#define K8_DIRECT 1
#endif

#ifndef Q8_DIRECT
#define Q8_DIRECT 0
#endif

#ifndef PERM_OUT
#define PERM_OUT 1
#endif

#ifndef SB16
#define SB16 1
#endif

#ifndef YD16
#define YD16 0
#endif

#ifndef CV_PAIR
#define CV_PAIR 0
#endif

#ifndef V8_DIRECT
#define V8_DIRECT 1
#endif

#ifndef V8_NOSWAP
#define V8_NOSWAP 0
#endif

#ifndef S1_PF
#define S1_PF 0
#endif

#ifndef S2_DEPTH
#define S2_DEPTH 6
#endif

#ifndef CONV_U
#define CONV_U 0
#endif

#ifndef PART16
#define PART16 1
#endif

#ifndef GEMM_AE
#define GEMM_AE true
#endif
#ifndef GEMM_SP2
#define GEMM_SP2 true
#endif

#ifndef XB_SLEEP
#define XB_SLEEP 1
#endif

#ifndef GEMM_WGM
#define GEMM_WGM 8
#endif
#include <hip/hip_runtime.h>
#include <cstdio>
#include <cstdint>

#define GAS __attribute__((address_space(1)))
#define LAS __attribute__((address_space(3)))
typedef unsigned short bf16;
typedef unsigned v4u __attribute__((ext_vector_type(4)));
typedef unsigned v2u __attribute__((ext_vector_type(2)));
typedef float f32x4 __attribute__((ext_vector_type(4)));
typedef float f32x2 __attribute__((ext_vector_type(2)));
typedef float f32x16 __attribute__((ext_vector_type(16)));
typedef short bf16x8 __attribute__((ext_vector_type(8)));
typedef short s16x4 __attribute__((ext_vector_type(4)));
typedef GAS unsigned gu32;
#define RLX_AGENT __ATOMIC_RELAXED, __HIP_MEMORY_SCOPE_AGENT
#define LDS_WAIT() asm volatile("s_waitcnt lgkmcnt(0)" ::: "memory")
#define VM_WAIT() asm volatile("s_waitcnt vmcnt(0)" ::: "memory")

constexpr int D = 2048, NB = 2, SEQ = 8192, CTXL = 256;
constexpr int NLAT = NB * SEQ, NCTX = NB * CTXL, T = NLAT + NCTX;
constexpr int KVLEN = CTXL + SEQ;
constexpr int IN_COLS = 6160, NIN = 6400;
constexpr int COL_Z = 1536, COL_Q = 2048, COL_XBC = 3072, COL_DT = 4096, COL_K = 4112, COL_V = 5136;
constexpr int FFD = 5632, FFE = 2816, NE = 8;
constexpr int NCH = 66;
constexpr float NORM_EPS = 1e-6f;
constexpr int NWAVES = 8;

constexpr size_t MiB = 1u << 20;
constexpr size_t WS_CTL = 0, CTL_ZERO_BYTES = 1 * MiB;
constexpr size_t WS_MOD = 1 * MiB;
constexpr size_t WS_ROPE = WS_MOD + 512 * 1024;
constexpr size_t WS_TOT = WS_ROPE + 64 * 1024;
constexpr size_t WS_ROUTE = 2 * MiB;
constexpr size_t WS_HS = 2 * MiB + 512 * 1024;
constexpr size_t WS_AGS = WS_HS + 256 * 1024;
constexpr size_t WS_AGS2 = 3 * MiB + 512 * 1024;
constexpr size_t WS_CS = 3 * MiB;
constexpr size_t CS_WIN = 0, CS_WGU = 2 * 6400, CS_MGU = CS_WGU + 11264;
constexpr size_t WS_W = 4 * MiB;
constexpr size_t SZ_WIN = (size_t)NIN * D * 2, SZ_WOUT = (size_t)D * D * 2, SZ_WGU = (size_t)2 * FFD * D * 2, SZ_WDN = (size_t)D * FFD * 2;
constexpr size_t SZ_MGU = (size_t)2 * FFE * D * 2, SZ_MDN = (size_t)D * FFE * 2;
constexpr size_t WS_WIN = WS_W, WS_WOUT = WS_WIN + 2 * SZ_WIN, WS_WGU = WS_WOUT + 2 * SZ_WOUT, WS_WDN = WS_WGU + SZ_WGU, WS_MGU = WS_WDN + SZ_WDN, WS_MDN = WS_MGU + NE * SZ_MGU;
constexpr size_t WS_XL = WS_MDN + NE * SZ_MDN;
constexpr size_t WS_H = WS_XL + (size_t)T * D * 4;
constexpr size_t WS_CAT = WS_H + (size_t)T * D * 2;
constexpr size_t WS_TMP = WS_CAT + (size_t)T * D * 2;
constexpr size_t WS_CONV = WS_TMP;
constexpr size_t WS_Z = WS_CONV + (size_t)T * 1536 * 2;
constexpr size_t WS_Q = WS_Z + (size_t)T * 512 * 2;
constexpr size_t WS_XBC = WS_Q + (size_t)T * 1024 * 2;
constexpr size_t WS_KB = WS_XBC + (size_t)T * 1024 * 2;
constexpr size_t WS_VB = WS_KB + (size_t)T * 1024 * 2;
constexpr size_t WS_DT = WS_VB + (size_t)T * 1024 * 2;
constexpr size_t WS_XBCC = WS_DT + (size_t)T * 16 * 4;
constexpr size_t WS_YD = WS_XBCC + (size_t)T * 1024 * 2;
constexpr size_t WS_CUM = WS_YD + (size_t)T * 512 * 4;
constexpr size_t WS_SB = WS_CUM + (size_t)T * 16 * 4;
constexpr size_t WS_HP = WS_SB + (size_t)32 * NCH * 8192 * 4;
constexpr size_t WS_TMP_END_MIX = WS_HP + (size_t)32 * NCH * 8192 * 2;
constexpr size_t WS_ACT = WS_TMP;
constexpr int MOE_MAXROWS = 2 * NLAT + NE * 256;
constexpr size_t WS_AG = WS_TMP;
#if MOE_SPARSE
constexpr size_t WS_MACT = WS_AG + (size_t)NE * NLAT * D;
constexpr size_t WS_TMP_END_MOE = WS_MACT + (size_t)MOE_MAXROWS * FFE;
#else
constexpr size_t WS_MACT = WS_AG + (size_t)MOE_MAXROWS * D * 2;
constexpr size_t WS_TMP_END_MOE = WS_MACT + (size_t)MOE_MAXROWS * FFE * 2;
#endif
constexpr size_t WS_PART = WS_TMP + 200 * MiB;
constexpr size_t WS_V8 = (WS_TMP_END_MIX > WS_TMP_END_MOE ? WS_TMP_END_MIX : WS_TMP_END_MOE);
constexpr size_t WS_K8 = WS_V8 + (size_t)NB * (KVLEN / 64) * 8 * 8192;
constexpr size_t WS_END = WS_K8 + (size_t)NB * (KVLEN / 64) * 8 * 8192;
static_assert(WS_PART + (size_t)11 * NCTX * D * 4 <= WS_V8 && WS_PART >= WS_ACT + (size_t)T * FFD * 2, "partials");
static_assert(WS_ACT + (size_t)T * FFD * 2 <= WS_END, "act fits");
constexpr int CW_TMO = 0, CW_CODE = 1;
constexpr int CW_BAR = 4096;
constexpr int CW_CNT = 8192;
constexpr int CW_DIAG = 12288;

constexpr int RING_OFF = 0, RING_BYTES = 131072;
constexpr int LDSCTL_OFF = RING_BYTES, MISC_OFF = LDSCTL_OFF + 320;
constexpr int LDS_BYTES = 147456;

__device__ __forceinline__ unsigned f2bf(float f) { unsigned u = __builtin_bit_cast(unsigned, f); return (u + 0x7fffu + ((u >> 16) & 1u)) >> 16; }
__device__ __forceinline__ unsigned pk2(float lo, float hi) { return f2bf(lo) | (f2bf(hi) << 16); }
__device__ __forceinline__ unsigned cvtpk(float lo, float hi) { unsigned r; asm volatile("v_cvt_pk_bf16_f32 %0, %1, %2" : "=v"(r) : "v"(lo), "v"(hi)); return r; }
__device__ __forceinline__ float bf2f(unsigned short b) { return __builtin_bit_cast(float, ((unsigned)b) << 16); }
__device__ __forceinline__ float bflo(unsigned w) { return __builtin_bit_cast(float, w << 16); }
__device__ __forceinline__ float bfhi(unsigned w) { return __builtin_bit_cast(float, w & 0xffff0000u); }
__device__ __forceinline__ float fast_exp(float x) { return __builtin_amdgcn_exp2f(x * 1.4426950408889634f); }
__device__ __forceinline__ float silu_f(float x) { return x * __builtin_amdgcn_rcpf(1.0f + fast_exp(-x)); }
__device__ __forceinline__ float dpp_f(float v, const int ctrl_sel) {
    int r;
    switch (ctrl_sel) {
        case 0: r = __builtin_amdgcn_update_dpp(0, __builtin_bit_cast(int, v), 0xB1, 0xF, 0xF, true); break;
        case 1: r = __builtin_amdgcn_update_dpp(0, __builtin_bit_cast(int, v), 0x4E, 0xF, 0xF, true); break;
        case 2: r = __builtin_amdgcn_update_dpp(0, __builtin_bit_cast(int, v), 0x141, 0xF, 0xF, true); break;
        default: r = __builtin_amdgcn_update_dpp(0, __builtin_bit_cast(int, v), 0x140, 0xF, 0xF, true); break;
    }
    return __builtin_bit_cast(float, r);
}
__device__ __forceinline__ float half_sum(float v) {
    v += dpp_f(v, 0); v += dpp_f(v, 1); v += dpp_f(v, 2); v += dpp_f(v, 3);
    v += __builtin_bit_cast(float, __builtin_amdgcn_ds_swizzle(__builtin_bit_cast(int, v), 0x401F));
    return v;
}
__device__ __forceinline__ void swap32u(unsigned& a, unsigned& b) {
    asm volatile("s_nop 1\n\tv_permlane32_swap_b32 %0, %1\n\ts_nop 1" : "+v"(a), "+v"(b));
}
__device__ __forceinline__ void swap32(float v, float& x, float& y) {
    unsigned a = __builtin_bit_cast(unsigned, v), b = a; swap32u(a, b);
    x = __builtin_bit_cast(float, a); y = __builtin_bit_cast(float, b);
}
__device__ __forceinline__ float wave_sum(float v) {
    v = half_sum(v);
    float x, y; swap32(v, x, y); return x + y;
}
__device__ __forceinline__ f32x4 ld4_f32(const float* p) { return *(const f32x4*)p; }
__device__ __forceinline__ f32x4 ld4_bf16(const unsigned short* p) { const v2u w = *(const v2u*)p; f32x4 r; r[0] = bflo(w.x); r[1] = bfhi(w.x); r[2] = bflo(w.y); r[3] = bfhi(w.y); return r; }
__device__ __forceinline__ void st4_bf16(unsigned short* p, const f32x4& v) { v2u w; w.x = cvtpk(v[0], v[1]); w.y = cvtpk(v[2], v[3]); *(v2u*)p = w; }
__device__ __forceinline__ float wave_max(float v) {
    v = fmaxf(v, dpp_f(v, 0)); v = fmaxf(v, dpp_f(v, 1)); v = fmaxf(v, dpp_f(v, 2)); v = fmaxf(v, dpp_f(v, 3));
    v = fmaxf(v, __builtin_bit_cast(float, __builtin_amdgcn_ds_swizzle(__builtin_bit_cast(int, v), 0x401F)));
    float x, y; swap32(v, x, y); return fmaxf(x, y);
}
__device__ __forceinline__ unsigned pk_i8(float a, float b, float c, float d) {
    const float M = 12582912.0f;
    const unsigned ua = __builtin_bit_cast(unsigned, a + M), ub = __builtin_bit_cast(unsigned, b + M), uc = __builtin_bit_cast(unsigned, c + M), ud = __builtin_bit_cast(unsigned, d + M);
    return __builtin_amdgcn_perm(ub, ua, 0x0c0c0400u) | (__builtin_amdgcn_perm(ud, uc, 0x0c0c0400u) << 16);
}
__device__ __forceinline__ float cross_max(float v) { float x, y; swap32(v, x, y); return fmaxf(x, y); }
__device__ __forceinline__ float cross_sum(float v) { float x, y; swap32(v, x, y); return x + y; }

__device__ __forceinline__ int lane_id() { int l; asm volatile("v_mbcnt_lo_u32_b32 %0, -1, 0\n\tv_mbcnt_hi_u32_b32 %0, -1, %0" : "=v"(l)); return l; }
__device__ __forceinline__ int fresh_tid(int wave) { return wave * 64 + lane_id(); }
__device__ __forceinline__ int fresh_s(int v) { asm volatile("" : "+s"(v)); return v; }
__device__ __forceinline__ unsigned char* fresh_ws(unsigned char* p) { unsigned z = 0; asm volatile("" : "+s"(z)); return p + z; }
#define XB_TMO      128
#define XB_XCNT(j)  (256  + 64 * (j))
#define XB_XSUB(j)  (1280 + 64 * (j))
#define XB_XGEN(j)  (2304 + 64 * (j))
#define XB_TOP      3328
#define XB_TOPGEN   3392
#define XCD_BAR_WORDS 3456
#define XB_SPIN_CAP (1u << 22)

__device__ __forceinline__ unsigned xb_ld(unsigned* p)              { return __hip_atomic_load(p, __ATOMIC_RELAXED, __HIP_MEMORY_SCOPE_AGENT); }
__device__ __forceinline__ unsigned xb_add(unsigned* p, unsigned v) { return __hip_atomic_fetch_add(p, v, __ATOMIC_RELAXED, __HIP_MEMORY_SCOPE_AGENT); }
__device__ __forceinline__ unsigned xb_xcc_id() { return (unsigned)__builtin_amdgcn_s_getreg((3 << 11) | 20) & 0xFu; }
#define XB_SPIN(cond, bar) do { unsigned _sp = 0; while (cond) { if (XB_SLEEP) __builtin_amdgcn_s_sleep(XB_SLEEP); \
    if ((++_sp & 255u) == 0u) { if (xb_ld(&(bar)[XB_TMO])) break; if (_sp > XB_SPIN_CAP) { atomicAdd(&(bar)[XB_TMO], 1u); break; } } } } while (0)

struct XcdBarrier { unsigned* bar; unsigned x; volatile LAS unsigned* st; int wave; };

__device__ __forceinline__ XcdBarrier xcd_barrier_post(unsigned* bar, volatile LAS unsigned* st) {
    XcdBarrier b; b.bar = bar; b.x = xb_xcc_id(); b.st = st; b.wave = __builtin_amdgcn_readfirstlane(threadIdx.x >> 6);
    if (threadIdx.x == 0) (void)xb_add(&bar[XB_XCNT(b.x)], 1u);
    return b;
}
__device__ __forceinline__ void xcd_barrier_complete(unsigned* bar, unsigned x, unsigned& nloc, unsigned& nx) {
    const unsigned G = gridDim.x * gridDim.y * gridDim.z;
    unsigned sum, cnt, mine, sp = 0u;
    for (;;) {
        sum = 0u; cnt = 0u; mine = 0u;
#pragma unroll
        for (unsigned j = 0; j < 16; ++j) { const unsigned c = xb_ld(&bar[XB_XCNT(j)]); sum += c; cnt += (c > 0u) ? 1u : 0u; mine = (j == x) ? c : mine; }
        if (sum == G) break;
        __builtin_amdgcn_s_sleep(1);
        if ((++sp & 255u) == 0u) { if (xb_ld(&bar[XB_TMO])) break; if (sp > XB_SPIN_CAP) { atomicAdd(&bar[XB_TMO], 1u); break; } }
    }
    nloc = mine > 0u ? mine : 1u; nx = cnt > 0u ? cnt : 1u;
}
__device__ __forceinline__ void xcd_barrier(const XcdBarrier& b) {
    asm volatile("s_waitcnt vmcnt(0)" ::: "memory");
    __syncthreads();
    if (b.wave == 0 && lane_id() == 0) {
        unsigned* bar = b.bar;
        const unsigned bx = xb_xcc_id();
        __builtin_amdgcn_s_waitcnt(0);
        unsigned nloc = b.st[0], nx = b.st[1];
        if (nloc == 0u) { xcd_barrier_complete(bar, bx, nloc, nx); b.st[0] = nloc; b.st[1] = nx; }
        const unsigned old = xb_add(&bar[XB_XSUB(bx)], 1u);
        const unsigned gen = old / nloc;
        if (old + 1u == (gen + 1u) * nloc) {
            __builtin_amdgcn_fence(__ATOMIC_RELEASE, "agent");
            asm volatile("s_waitcnt vmcnt(0)" ::: "memory");
            const unsigned og = xb_add(&bar[XB_TOP], 1u);
            const unsigned tg = og / nx;
            if (og + 1u == (tg + 1u) * nx) xb_add(&bar[XB_TOPGEN], 1u);
            else XB_SPIN(xb_ld(&bar[XB_TOPGEN]) == tg, bar);
            __builtin_amdgcn_fence(__ATOMIC_ACQUIRE, "agent");
            xb_add(&bar[XB_XGEN(bx)], 1u);
            asm volatile("s_waitcnt vmcnt(0)" ::: "memory");
        } else {
            XB_SPIN(xb_ld(&bar[XB_XGEN(bx)]) == gen, bar);
            __builtin_amdgcn_fence(__ATOMIC_ACQUIRE, "agent");
            asm volatile("s_waitcnt vmcnt(0)" ::: "memory");
        }
    }
    __syncthreads();
}

#if SIMPLE_BAR
__device__ __forceinline__ void simple_barrier(unsigned* cnt, unsigned target) {
    asm volatile("s_waitcnt vmcnt(0)" ::: "memory");
    __syncthreads();
    if (threadIdx.x == 0) {
        __threadfence();
        asm volatile("s_waitcnt vmcnt(0)" ::: "memory");
        __hip_atomic_fetch_add(cnt, 1u, __ATOMIC_RELAXED, __HIP_MEMORY_SCOPE_AGENT);
        unsigned sp = 0;
        while (__hip_atomic_load(cnt, __ATOMIC_RELAXED, __HIP_MEMORY_SCOPE_AGENT) < target) { __builtin_amdgcn_s_sleep(2); if (++sp > (1u << 24)) break; }
        __threadfence();
        asm volatile("s_waitcnt vmcnt(0)" ::: "memory");
    }
    __syncthreads();
}
#endif
namespace pg8 {
constexpr int BM = 256, BK = 64, HALF = 128, HTB = HALF * BK * 2, STAGE_BYTES = 8 * HTB, NXCD = 8, WGM = GEMM_WGM;
__host__ __device__ __forceinline__ int lds_byte(int r, int c) { const int st = (r >> 4) * 2 + (c >> 5), rr = r & 15, cc = c & 31, ob = rr * 64 + cc * 2; return st * 1024 + (ob ^ (((ob >> 9) & 1) << 5)); }
__host__ __device__ __forceinline__ void stage_rc(int b, int& R, int& C) { const int st = b / 1024, sb = b % 1024, swz = sb ^ (((sb >> 9) & 1) << 5); R = (st >> 1) * 16 + swz / 64; C = (st & 1) * 32 + (swz % 64) / 2; }
__host__ __device__ __forceinline__ int perm32(int rho) { const int n = rho >> 4, i = rho & 15; return 8 * (i >> 2) + 4 * n + (i & 3); }

struct Unit { int pm, pn, ks, half; };
struct OrderBase {
    int nM, nN, nwg, G, c;
    __device__ void init(int nM_, int nN_, int G_, int c_) { nM = nM_; nN = nN_; nwg = nM * nN; G = G_; c = c_; }
    __device__ bool next(int i, Unit& u) const {
        long L = (long)i * G + c; u.half = 0;
#if TAIL2
        { const int R = nwg / G, rem = nwg - R * G;
          if (rem > 0 && 2 * rem <= G && i >= R) { if (i > R || c >= 2 * rem) return false; L = (long)R * G + (c >> 1); u.half = 1 + (c & 1); } }
#endif
        if (L >= nwg) return false;
        int wgid = (int)L; { const int q = nwg / NXCD, r = nwg % NXCD, xcd = wgid % NXCD, off = wgid / NXCD; wgid = (xcd < r ? xcd * (q + 1) : r * (q + 1) + (xcd - r) * q) + off; }
        const int nig = WGM * nN, gid = wgid / nig, fm = gid * WGM, gsz = (nM - fm) < WGM ? (nM - fm) : WGM;
        u.pm = fm + ((wgid % nig) % gsz); u.pn = (wgid % nig) / gsz; u.ks = 0; return true;
    }
};
struct PlainSched : OrderBase {
    const char* A; const char* Bt; size_t tstep; int swap_from = 1 << 30, swap_to = 0;
    __device__ __forceinline__ bool swapped(const Unit& u) const { return u.pn >= swap_from && u.pn < swap_to; }
    __device__ __forceinline__ const char* abase(const Unit& u) const { return swapped(u) ? Bt + (size_t)u.pn * tstep : A + (size_t)u.pm * tstep; }
    __device__ __forceinline__ const char* bbase(const Unit& u) const { return swapped(u) ? A + (size_t)u.pm * tstep : Bt + (size_t)u.pn * tstep; }
    __device__ __forceinline__ int brow(const Unit& u) const { return u.pn * 256; }
    __device__ __forceinline__ int arow(const Unit& u) const { return u.pm * 256; }
};
struct MoeSched : OrderBase {
    const char* A; const char* Bt; size_t tstep, estride; int ps1, ps2, ps3, ps4, ps5, ps6, ps7, erows;
    __device__ __forceinline__ int expert(int pm) const { return (pm >= ps1) + (pm >= ps2) + (pm >= ps3) + (pm >= ps4) + (pm >= ps5) + (pm >= ps6) + (pm >= ps7); }
    __device__ __forceinline__ bool swapped(const Unit&) const { return false; }
    int sparse, caprows;
    __device__ __forceinline__ int pstart(int pm) const { int p0 = 0; p0 = pm >= ps1 ? ps1 : p0; p0 = pm >= ps2 ? ps2 : p0; p0 = pm >= ps3 ? ps3 : p0; p0 = pm >= ps4 ? ps4 : p0; p0 = pm >= ps5 ? ps5 : p0; p0 = pm >= ps6 ? ps6 : p0; p0 = pm >= ps7 ? ps7 : p0; return p0; }
    __device__ __forceinline__ int arow(const Unit& u) const { return sparse ? expert(u.pm) * caprows + (u.pm - pstart(u.pm)) * 256 : u.pm * 256; }
    __device__ __forceinline__ const char* abase(const Unit& u) const { return A + (size_t)arow(u) * (tstep >> 8); }
    __device__ __forceinline__ const char* bbase(const Unit& u) const { return Bt + (size_t)expert(u.pm) * estride + (size_t)u.pn * tstep; }
    __device__ __forceinline__ int brow(const Unit& u) const { return expert(u.pm) * erows + u.pn * 256; }
};

struct CtxSplitSched {
    int nN, nS, G, c; const char* A; const char* Bt; size_t tstep; size_t kslice;
    __device__ bool next(int i, Unit& u) const { const int L = i * G + c; if (L >= 2 * nN * nS) return false; u.pm = 64 + (L & 1); u.pn = (L >> 1) % nN; u.ks = (L >> 1) / nN; u.half = 0; return true; }
    __device__ __forceinline__ const char* abase(const Unit& u) const { return A + (size_t)u.pm * tstep + (size_t)u.ks * kslice; }
    __device__ __forceinline__ const char* bbase(const Unit& u) const { return Bt + (size_t)u.pn * tstep + (size_t)u.ks * kslice; }
    __device__ __forceinline__ int brow(const Unit& u) const { return u.pn * 256; }
    __device__ __forceinline__ int arow(const Unit& u) const { return u.pm * 256; }
    __device__ __forceinline__ bool swapped(const Unit&) const { return false; }
};
template <class Epi, class Sched, bool ALIGN_EPI, bool SP2, int MODE = 0>
__device__ __forceinline__ void gemm_phase(LAS unsigned char* lds, const int K, const Sched& S, const Epi& E, const int wave, const int ktiles = 0, const int sc_w = 0x7F7F7F7F, const int sc_a = 0x7F7F7F7F,
                                           const float* rs = nullptr, const float* cs = nullptr) {
    constexpr bool F8 = (MODE == 1), I8 = (MODE == 2);
    const int tid = fresh_tid(wave); const int wid = __builtin_amdgcn_readfirstlane(tid >> 6), lane = tid & 63, wr = wid >> 2, wc = wid & 3, fr = lane & 15, fq = lane >> 4;
    const int nt = ktiles ? ktiles : K / BK;
    unsigned voffA[2];
#pragma unroll
    for (int i = 0; i < 2; ++i) { int R, C; stage_rc(tid * 16 + i * 8192, R, C); voffA[i] = (unsigned)(R * K + C) * 2u; }
#define voffB voffA
    const size_t kstep = (size_t)(BK * 2);
    const size_t hstep = (size_t)HALF * K * 2;
    const unsigned ldsw = (unsigned)wid * 1024u;
    const int aoff = lds_byte(wr * 64 + fr, fq * 8), boff = lds_byte(wc * 32 + fr, fq * 8);
#define PG8_SA(b, h) (((b) * 2 + (h)) * HTB)
#define PG8_SB(b, h) ((4 + (b) * 2 + (h)) * HTB)
#define PG8_STAGE(bufoff, gbase, voff) do { _Pragma("unroll") for (int _i = 0; _i < 2; ++_i) \
        __builtin_amdgcn_global_load_lds((const unsigned*)((const char*)(gbase) + (voff)[_i]), (LAS unsigned*)(lds + (bufoff) + ldsw + _i * 8192), 16, 0, 0); } while (0)
#define PG8_LDA(dst, b, h) do { if constexpr (F8) { _Pragma("unroll") for (int m = 0; m < 4; ++m) { \
            const v4i_ lo_ = *(const LAS v4i_*)(lds + PG8_SA(b, h) + aoff + m * 2048), hi_ = *(const LAS v4i_*)(lds + PG8_SA(b, h) + aoff + m * 2048 + 1024); \
            dst##8[m] = __builtin_shufflevector(lo_, hi_, 0, 1, 2, 3, 4, 5, 6, 7); } } \
        else { _Pragma("unroll") for (int m = 0; m < 4; ++m) _Pragma("unroll") for (int k = 0; k < 2; ++k) dst[m][k] = *(const LAS bf16x8*)(lds + PG8_SA(b, h) + aoff + m * 2048 + k * 1024); } } while (0)
#define PG8_LDB(dst, b, h) do { if constexpr (F8) { _Pragma("unroll") for (int n = 0; n < 2; ++n) { \
            const v4i_ lo_ = *(const LAS v4i_*)(lds + PG8_SB(b, h) + boff + n * 2048), hi_ = *(const LAS v4i_*)(lds + PG8_SB(b, h) + boff + n * 2048 + 1024); \
            dst##8[n] = __builtin_shufflevector(lo_, hi_, 0, 1, 2, 3, 4, 5, 6, 7); } } \
        else { _Pragma("unroll") for (int n = 0; n < 2; ++n) _Pragma("unroll") for (int k = 0; k < 2; ++k) dst[n][k] = *(const LAS bf16x8*)(lds + PG8_SB(b, h) + boff + n * 2048 + k * 1024); } } while (0)
#define PG8_MMA(ai, bj, At, Bt) do { __builtin_amdgcn_s_setprio(1); \
        if constexpr (F8) { _Pragma("unroll") for (int m = 0; m < 4; ++m) _Pragma("unroll") for (int n = 0; n < 2; ++n) \
            asm volatile("v_mfma_scale_f32_16x16x128_f8f6f4 %0, %1, %2, %0, %3, %4 op_sel_hi:[0,0,0]" : "+v"(acc[ai][bj][m][n]) : "v"(Bt##8[n]), "v"(At##8[m]), "v"(sc_w), "v"(sc_a)); } \
        else if constexpr (I8) { _Pragma("unroll") for (int m = 0; m < 4; ++m) _Pragma("unroll") for (int n = 0; n < 2; ++n) _Pragma("unroll") for (int k = 0; k < 2; ++k) \
            acc[ai][bj][m][n] = __builtin_bit_cast(f32x4, __builtin_amdgcn_mfma_i32_16x16x64_i8(__builtin_bit_cast(v4i_, Bt[n][k]), __builtin_bit_cast(v4i_, At[m][k]), __builtin_bit_cast(v4i_, acc[ai][bj][m][n]), 0, 0, 0)); } \
        else { _Pragma("unroll") for (int m = 0; m < 4; ++m) _Pragma("unroll") for (int n = 0; n < 2; ++n) _Pragma("unroll") for (int k = 0; k < 2; ++k) \
            acc[ai][bj][m][n] = __builtin_amdgcn_mfma_f32_16x16x32_bf16(Bt[n][k], At[m][k], acc[ai][bj][m][n], 0, 0, 0); } \
        __builtin_amdgcn_s_setprio(0); } while (0)
#define PG8_WAIT_V(n) asm volatile("s_waitcnt vmcnt(" #n ")" ::: "memory")
#define PG8_WAIT_L(n) asm volatile("s_waitcnt lgkmcnt(" #n ")" ::: "memory")
#define PG8_BAR __builtin_amdgcn_s_barrier()
#define PG8_SCHED __builtin_amdgcn_sched_barrier(0)
    Unit cur, nxt; int ui = 0;
    if (!S.next(0, cur)) return;
    f32x4 acc[2][2][4][2];
#pragma unroll
    for (int a = 0; a < 2; ++a)
#pragma unroll
        for (int b = 0; b < 2; ++b)
#pragma unroll
            for (int m = 0; m < 4; ++m)
#pragma unroll
                for (int n = 0; n < 2; ++n) acc[a][b][m][n] = (f32x4){0.f, 0.f, 0.f, 0.f};
    typedef int v8i_ __attribute__((ext_vector_type(8))); typedef int v4i_ __attribute__((ext_vector_type(4)));
    bf16x8 At[4][2], B0[2][2], B1[2][2]; v8i_ At8[4], B08[2], B18[2];
    const char* cA = S.abase(cur); const char* cB = S.bbase(cur);
    if constexpr (SP2) {
        PG8_STAGE(PG8_SB(0, 0), cB, voffB); PG8_STAGE(PG8_SB(0, 1), cB + hstep, voffB); PG8_STAGE(PG8_SA(0, 0), cA, voffA); PG8_STAGE(PG8_SA(0, 1), cA + hstep, voffA);
        if (wr == 1) PG8_BAR;
        PG8_WAIT_V(2); PG8_BAR;
        PG8_STAGE(PG8_SB(1, 0), cB + kstep, voffB); PG8_STAGE(PG8_SA(1, 0), cA + kstep, voffA); PG8_STAGE(PG8_SB(1, 1), cB + hstep + kstep, voffB);
        PG8_WAIT_V(6); PG8_BAR;
    } else {
        PG8_STAGE(PG8_SB(0, 0), cB, voffB); PG8_STAGE(PG8_SA(0, 0), cA, voffA); PG8_STAGE(PG8_SB(0, 1), cB + hstep, voffB); PG8_STAGE(PG8_SA(0, 1), cA + hstep, voffA);
        if (wr == 1) PG8_BAR;
        PG8_WAIT_V(4); PG8_BAR;
        PG8_STAGE(PG8_SB(1, 0), cB + kstep, voffB); PG8_STAGE(PG8_SA(1, 0), cA + kstep, voffA); PG8_STAGE(PG8_SB(1, 1), cB + hstep + kstep, voffB);
        PG8_WAIT_V(6); PG8_BAR;
    }
    for (;;) {
        const bool has_next = S.next(ui + 1, nxt);
        const char* nA = has_next ? S.abase(nxt) : cA; const char* nB = has_next ? S.bbase(nxt) : cB;
        for (int t = 0; t < nt; t += 2) {
            const bool last = (t == nt - 2);
            const char* a1 = cA + (size_t)(t + 1) * kstep;
            const char* a2 = last ? nA : cA + (size_t)(t + 2) * kstep; const char* b2 = last ? nB : cB + (size_t)(t + 2) * kstep;
            const char* a3 = a2 + kstep; const char* b3 = b2 + kstep;
            if constexpr (SP2) {
            PG8_LDB(B0, 0, 0); PG8_LDB(B1, 0, 1); PG8_SCHED; PG8_LDA(At, 0, 0); PG8_STAGE(PG8_SA(1, 1), a1 + hstep, voffA);
            PG8_WAIT_V(8); PG8_WAIT_L(0); PG8_BAR; if (!TAIL2 || cur.half != 2) { PG8_MMA(0, 0, At, B0); PG8_MMA(0, 1, At, B1); } PG8_BAR; PG8_SCHED;
            PG8_LDA(At, 0, 1); PG8_STAGE(PG8_SB(0, 0), b2, voffB); PG8_STAGE(PG8_SB(0, 1), b2 + hstep, voffB); PG8_STAGE(PG8_SA(0, 0), a2, voffA);
            PG8_WAIT_V(8); PG8_WAIT_L(0); PG8_BAR; if (!TAIL2 || cur.half != 1) { PG8_MMA(1, 0, At, B0); PG8_MMA(1, 1, At, B1); } PG8_BAR; PG8_SCHED;
            PG8_LDB(B0, 1, 0); PG8_LDB(B1, 1, 1); PG8_SCHED; PG8_LDA(At, 1, 0); PG8_STAGE(PG8_SA(0, 1), a2 + hstep, voffA);
            PG8_WAIT_V(8); PG8_WAIT_L(0); PG8_BAR; if (!TAIL2 || cur.half != 2) { PG8_MMA(0, 0, At, B0); PG8_MMA(0, 1, At, B1); } PG8_BAR; PG8_SCHED;
            PG8_LDA(At, 1, 1); PG8_STAGE(PG8_SB(1, 0), b3, voffB); PG8_STAGE(PG8_SB(1, 1), b3 + hstep, voffB); PG8_STAGE(PG8_SA(1, 0), a3, voffA);
            PG8_WAIT_V(8); PG8_WAIT_L(0); PG8_BAR; if (!TAIL2 || cur.half != 1) { PG8_MMA(1, 0, At, B0); PG8_MMA(1, 1, At, B1); } PG8_BAR; PG8_SCHED;
            } else {
            PG8_LDB(B0, 0, 0); PG8_SCHED; PG8_LDA(At, 0, 0); PG8_STAGE(PG8_SA(1, 1), a1 + hstep, voffA);
            PG8_WAIT_L(8); PG8_BAR; PG8_WAIT_L(0); PG8_MMA(0, 0, At, B0); PG8_BAR; PG8_SCHED;
            PG8_LDB(B1, 0, 1); PG8_STAGE(PG8_SB(0, 0), b2, voffB);
            PG8_BAR; PG8_WAIT_L(0); PG8_MMA(0, 1, At, B1); PG8_BAR;
            PG8_LDA(At, 0, 1); PG8_STAGE(PG8_SA(0, 0), a2, voffA);
            PG8_BAR; PG8_WAIT_L(0); PG8_MMA(1, 0, At, B0); PG8_BAR; PG8_SCHED;
            PG8_STAGE(PG8_SB(0, 1), b2 + hstep, voffB);
            PG8_WAIT_V(6); PG8_BAR; PG8_MMA(1, 1, At, B1); PG8_BAR;
            PG8_LDB(B0, 1, 0); PG8_SCHED; PG8_LDA(At, 1, 0); PG8_STAGE(PG8_SA(0, 1), a2 + hstep, voffA);
            PG8_WAIT_L(8); PG8_BAR; PG8_WAIT_L(0); PG8_MMA(0, 0, At, B0); PG8_BAR; PG8_SCHED;
            PG8_LDB(B1, 1, 1); PG8_STAGE(PG8_SB(1, 0), b3, voffB);
            PG8_BAR; PG8_WAIT_L(0); PG8_MMA(0, 1, At, B1); PG8_BAR;
            PG8_LDA(At, 1, 1); PG8_STAGE(PG8_SA(1, 0), a3, voffA);
            PG8_BAR; PG8_WAIT_L(0); PG8_MMA(1, 0, At, B0); PG8_BAR; PG8_SCHED;
            PG8_STAGE(PG8_SB(1, 1), b3 + hstep, voffB);
            PG8_WAIT_V(6); PG8_BAR; PG8_MMA(1, 1, At, B1); PG8_BAR;
            }
        }
        if constexpr (ALIGN_EPI) { if (wr == 0) PG8_BAR; }
        if constexpr (F8) asm volatile("s_nop 15\n\ts_nop 15" ::: "memory");
        if constexpr (I8) {
            const int l3_ = lane_id(); const int fr_ = l3_ & 15, fq_ = l3_ >> 4; const bool sw_ = S.swapped(cur);
            const float* rowS = sw_ ? cs + S.brow(cur) : rs + S.arow(cur); const float* colS = sw_ ? rs + S.arow(cur) : cs + S.brow(cur);
            f32x4 csv[2][2];
#pragma unroll
            for (int bj = 0; bj < 2; ++bj)
#pragma unroll
                for (int n = 0; n < 2; ++n) csv[bj][n] = *(const f32x4*)(colS + 128 * bj + 32 * wc + 16 * n + 4 * fq_);
#pragma unroll
            for (int ai = 0; ai < 2; ++ai)
#pragma unroll
                for (int m = 0; m < 4; ++m) { const float rsv = rowS[128 * ai + 64 * wr + 16 * m + fr_];
#pragma unroll
                    for (int bj = 0; bj < 2; ++bj)
#pragma unroll
                        for (int n = 0; n < 2; ++n)
#pragma unroll
                            for (int j = 0; j < 4; ++j) { const float t_ = acc[ai][bj][m][n][j];
                                acc[ai][bj][m][n][j] = (float)__float_as_int(t_) * (rsv * csv[bj][n][j]); } }
        }
        { const int l2_ = lane_id(); E(acc, cur, wr, wc, l2_ & 15, l2_ >> 4); }
        if (!has_next) break;
#pragma unroll
        for (int a = 0; a < 2; ++a)
#pragma unroll
            for (int b = 0; b < 2; ++b)
#pragma unroll
                for (int m = 0; m < 4; ++m)
#pragma unroll
                    for (int n = 0; n < 2; ++n) acc[a][b][m][n] = (f32x4){0.f, 0.f, 0.f, 0.f};
        cur = nxt; cA = nA; cB = nB; ++ui;
        if constexpr (ALIGN_EPI) { if (wr == 1) PG8_BAR; }
    }
    PG8_WAIT_V(0);
    if constexpr (!ALIGN_EPI) { if (wr == 0) PG8_BAR; }
    PG8_BAR;
#undef voffB
#undef PG8_SA
#undef PG8_SB
#undef PG8_STAGE
#undef PG8_LDA
#undef PG8_LDB
#undef PG8_MMA
#undef PG8_WAIT_V
#undef PG8_WAIT_L
#undef PG8_BAR
#undef PG8_SCHED
}
}
namespace pg8 {
__device__ __forceinline__ void st8(bf16* p, const f32x4& v0, const f32x4& v1) {
    v4u w; w.x = cvtpk(v0[0], v0[1]); w.y = cvtpk(v0[2], v0[3]); w.z = cvtpk(v1[0], v1[1]); w.w = cvtpk(v1[2], v1[3]);
    *(v4u*)p = w;
}
struct EpiIn {
    bf16 *convb, *zb, *qb, *xbcb, *kb, *vb; float* dtb; const float* ropec; const float* ropes; unsigned char* k8; unsigned char* v8;
    __device__ __forceinline__ void st_k8(int pm, int pn, int bj, int ai, int wr, int wc, int m, int fr, int fq, const f32x4& o1, const f32x4& o2) const {
        const int b = pm < 64 ? (pm >> 5) : (pm - 64), t = (pm < 64 ? CTXL / 64 + (pm & 31) * 4 : 0) + 2 * ai + wr, h = 2 * (pn - 16) + bj;
        const int chunk = (((wc >> 1) * 2 + (wc & 1)) * 2 + (fq >> 1)) * 64 + m * 16 + fr;
        const f32x4 lo = __builtin_elementwise_min(__builtin_elementwise_max(o1, (f32x4){-448.f, -448.f, -448.f, -448.f}), (f32x4){448.f, 448.f, 448.f, 448.f});
        const f32x4 hh = __builtin_elementwise_min(__builtin_elementwise_max(o2, (f32x4){-448.f, -448.f, -448.f, -448.f}), (f32x4){448.f, 448.f, 448.f, 448.f});
        v2u w;
        w.x = (unsigned)__builtin_amdgcn_cvt_pk_fp8_f32(lo[2], lo[3], __builtin_amdgcn_cvt_pk_fp8_f32(lo[0], lo[1], 0, false), true);
        w.y = (unsigned)__builtin_amdgcn_cvt_pk_fp8_f32(hh[2], hh[3], __builtin_amdgcn_cvt_pk_fp8_f32(hh[0], hh[1], 0, false), true);
        *(v2u*)(k8 + ((size_t)(b * (KVLEN / 64) + t) * 8 + h) * 8192 + chunk * 16 + 8 * (fq & 1)) = w;
    }
    __device__ __forceinline__ void st_q8(unsigned char* p, const f32x4& o1, const f32x4& o2) const {
        constexpr float C = 0.125f * 1.4426950408889634f * (ATT_Y8 ? 8.0f : 1.0f);
        const f32x4 lo = __builtin_elementwise_min(__builtin_elementwise_max(o1 * C, (f32x4){-448.f, -448.f, -448.f, -448.f}), (f32x4){448.f, 448.f, 448.f, 448.f});
        const f32x4 hh = __builtin_elementwise_min(__builtin_elementwise_max(o2 * C, (f32x4){-448.f, -448.f, -448.f, -448.f}), (f32x4){448.f, 448.f, 448.f, 448.f});
        v2u w;
        w.x = (unsigned)__builtin_amdgcn_cvt_pk_fp8_f32(lo[2], lo[3], __builtin_amdgcn_cvt_pk_fp8_f32(lo[0], lo[1], 0, false), true);
        w.y = (unsigned)__builtin_amdgcn_cvt_pk_fp8_f32(hh[2], hh[3], __builtin_amdgcn_cvt_pk_fp8_f32(hh[0], hh[1], 0, false), true);
        *(v2u*)p = w;
    }
    __device__ __forceinline__ void st_v8(const f32x4 (&acc)[2][2][4][2], int pm, int pn, int wr, int wc, int fr, int fq) const {
        const int b = pm < 64 ? (pm >> 5) : (pm - 64), t0 = (pm < 64 ? CTXL / 64 + (pm & 31) * 4 : 0) + (wc >> 1);
#pragma unroll
        for (int ai = 0; ai < 2; ++ai) { const int h = 2 * (pn - 20) + ai;
#pragma unroll
            for (int bj = 0; bj < 2; ++bj) { unsigned char* tile = v8 + ((size_t)(b * (KVLEN / 64) + t0 + 2 * bj) * 8 + h) * 8192;
#pragma unroll
                for (int m = 0; m < 4; ++m) {
                    unsigned Dw[2];
#pragma unroll
                    for (int n = 0; n < 2; ++n) { const f32x4 c = __builtin_elementwise_min(__builtin_elementwise_max(acc[ai][bj][m][n], (f32x4){-448.f, -448.f, -448.f, -448.f}), (f32x4){448.f, 448.f, 448.f, 448.f});
                        Dw[n] = (unsigned)__builtin_amdgcn_cvt_pk_fp8_f32(c[2], c[3], __builtin_amdgcn_cvt_pk_fp8_f32(c[0], c[1], 0, false), true); }
                    const int chunk = (((2 * wr + (m >> 1)) * 2 + (fq & 1)) * 2 + (wc & 1)) * 32 + 16 * (m & 1) + fr;
#if V8_NOSWAP
                    *(unsigned*)(tile + chunk * 16 + (fq >> 1) * 4) = Dw[0]; *(unsigned*)(tile + chunk * 16 + 8 + (fq >> 1) * 4) = Dw[1];
#else
                    swap32u(Dw[0], Dw[1]);
                    v2u w; w.x = Dw[0]; w.y = Dw[1];
                    *(v2u*)(tile + chunk * 16 + (fq >> 1) * 8) = w;
#endif
                } } }
    }
    __device__ __forceinline__ void operator()(const f32x4 (&acc)[2][2][4][2], const Unit& u, int wr, int wc, int fr, int fq) const {
        const int pn = u.pn, pm = u.pm;
        if (V8_DIRECT && pn >= 20 && pn < 24) { st_v8(acc, pm, pn, wr, wc, fr, fq); return; }
        if (CONV_U && pn >= 2 && pn < 6) {
            bf16* bu = convb + (size_t)pm * 256 * 1536 + 512 + 128 * (pn - 2) + wc * 32 + 8 * fq;
#pragma unroll
            for (int ai = 0; ai < 2; ++ai)
#pragma unroll
                for (int m = 0; m < 4; ++m) { const int rl = ai * 128 + wr * 64 + m * 16 + fr;
                    st8(bu + (size_t)rl * 1536, acc[ai][0][m][0] * acc[ai][0][m][1], acc[ai][1][m][0] * acc[ai][1][m][1]); }
            return;
        }
        if (pn == 24) {
            if (wc == 0) {
#pragma unroll
                for (int ai = 0; ai < 2; ++ai)
#pragma unroll
                    for (int m = 0; m < 4; ++m) { if (TAIL2 && u.half != 0 && u.half != ai + 1) continue; const int r = pm * 256 + ai * 128 + wr * 64 + m * 16 + fr; *(f32x4*)(dtb + (size_t)r * 16 + 4 * fq) = acc[ai][0][m][0]; }
            }
            return;
        }
        bf16* base; int ld, col0; bool rope = false, kv = false;
        if (pn < 6) { base = convb; ld = 1536; col0 = 256 * pn; }
        else if (pn < 8) { base = zb; ld = 512; col0 = 256 * (pn - 6); }
        else if (pn < 12) { base = qb; ld = 1024; col0 = 256 * (pn - 8); rope = pm < 64; }
        else if (pn < 16) { base = xbcb; ld = 1024; col0 = 256 * (pn - 12); }
        else if (pn < 20) { base = kb; ld = 1024; col0 = 256 * (pn - 16); rope = pm < 64; kv = true; }
        else { base = vb; ld = 1024; col0 = 256 * (pn - 20); kv = true; }
        const size_t rowbase = !kv ? (size_t)pm * 256 : (pm < 64 ? (size_t)(pm >> 5) * KVLEN + CTXL + (size_t)(pm & 31) * 256 : (size_t)(pm - 64) * KVLEN);
        bf16* bp = base + rowbase * ld + col0 + wc * 32 + 8 * fq;
        if (rope) {
#pragma unroll
            for (int ai = 0; ai < 2; ++ai)
#pragma unroll
                for (int m = 0; m < 4; ++m) { if (TAIL2 && u.half != 0 && u.half != ai + 1) continue;
                    const int rl = ai * 128 + wr * 64 + m * 16 + fr;
                    const int pos = (wc & 1) ? 128 + m * 16 + fr : 4 * (pm & 31) + 2 * ai + wr;
                    const f32x4 cs = *(const f32x4*)(ropec + pos * 16 + 4 * fq), sn = *(const f32x4*)(ropes + pos * 16 + 4 * fq);
#pragma unroll
                    for (int bj = 0; bj < 2; ++bj) {
                        const f32x4 a1 = acc[ai][bj][m][0], a2 = acc[ai][bj][m][1];
                        const f32x4 o1 = a1 * cs - a2 * sn, o2 = a2 * cs + a1 * sn;
                        if (K8_DIRECT && kv) st_k8(pm, pn, bj, ai, wr, wc, m, fr, fq, o1, o2);
                        else if (Q8_DIRECT && !kv) st_q8((unsigned char*)qb + (size_t)(pm * 16 + ai * 8 + wr * 4 + m) * 16384 + (size_t)(((col0 + bj * 128 + wc * 32) >> 3) + fq) * 128 + fr * 8, o1, o2);
                        else st8(bp + (size_t)rl * ld + bj * 128, o1, o2);
                    }
                }
        } else {
#pragma unroll
            for (int ai = 0; ai < 2; ++ai)
#pragma unroll
                for (int m = 0; m < 4; ++m) { if (TAIL2 && u.half != 0 && u.half != ai + 1) continue;
                    const int rl = ai * 128 + wr * 64 + m * 16 + fr;
#pragma unroll
                    for (int bj = 0; bj < 2; ++bj) { if (K8_DIRECT && kv && pn < 20) st_k8(pm, pn, bj, ai, wr, wc, m, fr, fq, acc[ai][bj][m][0], acc[ai][bj][m][1]);
                        else if (Q8_DIRECT && pn >= 8 && pn < 12) st_q8((unsigned char*)qb + (size_t)(pm * 16 + ai * 8 + wr * 4 + m) * 16384 + (size_t)(((col0 + bj * 128 + wc * 32) >> 3) + fq) * 128 + fr * 8, acc[ai][bj][m][0], acc[ai][bj][m][1]);
                        else st8(bp + (size_t)rl * ld + bj * 128, acc[ai][bj][m][0], acc[ai][bj][m][1]); }
                }
        }
    }
};
__device__ __forceinline__ void ld8b(const bf16* p, float (&o)[8]) { const v4u w = *(const v4u*)p; o[0] = bflo(w.x); o[1] = bfhi(w.x); o[2] = bflo(w.y); o[3] = bfhi(w.y); o[4] = bflo(w.z); o[5] = bfhi(w.z); o[6] = bflo(w.w); o[7] = bfhi(w.w); }
template <bool SRC16>
struct EpiResidT {
    const void* srcLat; const void* srcCtx; bf16* dst; const float* gate;
    __device__ __forceinline__ void operator()(const f32x4 (&acc)[2][2][4][2], const Unit& u, int wr, int wc, int fr, int fq) const {
        const int pm = u.pm; const int v = pm < 32 ? 0 : (pm < 64 ? 1 : 2);
        const float* gv = gate + (size_t)v * 6 * D;
        const size_t sro = pm < 64 ? (size_t)pm * 256 * D : (size_t)(pm - 64) * 256 * D;
        const float* s32 = (const float*)(pm < 64 ? srcLat : srcCtx) + sro; const bf16* s16 = (const bf16*)(pm < 64 ? srcLat : srcCtx) + sro;
        bf16* dp = dst + (size_t)pm * 256 * D;
#if PERM_OUT
        const int colb = u.pn * 256 + wc * 32 + 8 * fq;
        f32x4 g[2][2];
#pragma unroll
        for (int bj = 0; bj < 2; ++bj)
#pragma unroll
            for (int n = 0; n < 2; ++n) g[bj][n] = *(const f32x4*)(gv + colb + bj * 128 + n * 4);
#pragma unroll
        for (int ai = 0; ai < 2; ++ai)
#pragma unroll
            for (int m = 0; m < 4; ++m) { if (TAIL2 && u.half != 0 && u.half != ai + 1) continue;
                const size_t off = (size_t)(ai * 128 + wr * 64 + m * 16 + fr) * D + colb;
#pragma unroll
                for (int bj = 0; bj < 2; ++bj) { f32x4 s0, s1;
                    if (SRC16) { float t[8]; ld8b(s16 + off + bj * 128, t); s0 = (f32x4){t[0], t[1], t[2], t[3]}; s1 = (f32x4){t[4], t[5], t[6], t[7]}; }
                    else { s0 = ld4_f32(s32 + off + bj * 128); s1 = ld4_f32(s32 + off + bj * 128 + 4); }
                    st8(dp + off + bj * 128, s0 + g[bj][0] * acc[ai][bj][m][0], s1 + g[bj][1] * acc[ai][bj][m][1]); }
                asm volatile("" ::: "memory");
            }
#else
        const int colb = u.pn * 256 + wc * 32 + 4 * fq;
        f32x4 g[2][2];
#pragma unroll
        for (int bj = 0; bj < 2; ++bj)
#pragma unroll
            for (int n = 0; n < 2; ++n) g[bj][n] = *(const f32x4*)(gv + colb + bj * 128 + n * 16);
#pragma unroll
        for (int ai = 0; ai < 2; ++ai)
#pragma unroll
            for (int m = 0; m < 4; ++m) { if (TAIL2 && u.half != 0 && u.half != ai + 1) continue;
                const size_t off = (size_t)(ai * 128 + wr * 64 + m * 16 + fr) * D + colb;
#pragma unroll
                for (int bj = 0; bj < 2; ++bj)
#pragma unroll
                    for (int n = 0; n < 2; ++n) { const f32x4 s = SRC16 ? ld4_bf16(s16 + off + bj * 128 + n * 16) : ld4_f32(s32 + off + bj * 128 + n * 16);
                        st4_bf16(dp + off + bj * 128 + n * 16, s + g[bj][n] * acc[ai][bj][m][n]); }
                asm volatile("" ::: "memory");
            }
#endif
    }
};
struct EpiSwiGLU {
    bf16* act; int ld;
    __device__ __forceinline__ void operator()(const f32x4 (&acc)[2][2][4][2], const Unit& u, int wr, int wc, int fr, int fq) const {
        bf16* bp = act + (size_t)u.pm * 256 * ld + u.pn * 128 + wc * 32 + 8 * fq;
#pragma unroll
        for (int ai = 0; ai < 2; ++ai)
#pragma unroll
            for (int m = 0; m < 4; ++m) { if (TAIL2 && u.half != 0 && u.half != ai + 1) continue;
                const int rl = ai * 128 + wr * 64 + m * 16 + fr;
                f32x4 o[2];
#pragma unroll
                for (int bj = 0; bj < 2; ++bj) { const f32x4 g = acc[ai][bj][m][0], up = acc[ai][bj][m][1];
#pragma unroll
                    for (int j = 0; j < 4; ++j) o[bj][j] = silu_f(g[j]) * up[j]; }
                st8(bp + (size_t)rl * ld, o[0], o[1]);
            }
    }
};
constexpr float ACT_SCALE = 4.0f; constexpr int ACT_SC8 = 0x7D7D7D7D;
struct EpiSwiGLU8 {
    unsigned char* act; int ld;
    __device__ __forceinline__ void operator()(const f32x4 (&acc)[2][2][4][2], const Unit& u, int wr, int wc, int fr, int fq) const {
        unsigned char* bp = act + (size_t)u.pm * 256 * ld + u.pn * 128 + wc * 32 + 8 * fq;
#pragma unroll
        for (int ai = 0; ai < 2; ++ai)
#pragma unroll
            for (int m = 0; m < 4; ++m) { if (TAIL2 && u.half != 0 && u.half != ai + 1) continue;
                const int rl = ai * 128 + wr * 64 + m * 16 + fr;
                float o[8];
#pragma unroll
                for (int bj = 0; bj < 2; ++bj) { const f32x4 g = acc[ai][bj][m][0], up = acc[ai][bj][m][1];
#pragma unroll
                    for (int j = 0; j < 4; ++j) o[4 * bj + j] = fminf(fmaxf(silu_f(g[j]) * up[j] * ACT_SCALE, -448.f), 448.f); }
                v2u w;
                w.x = (unsigned)__builtin_amdgcn_cvt_pk_fp8_f32(o[2], o[3], __builtin_amdgcn_cvt_pk_fp8_f32(o[0], o[1], 0, false), true);
                w.y = (unsigned)__builtin_amdgcn_cvt_pk_fp8_f32(o[6], o[7], __builtin_amdgcn_cvt_pk_fp8_f32(o[4], o[5], 0, false), true);
                *(v2u*)(bp + (size_t)rl * ld) = w;
            }
    }
};
struct EpiBf16 {
    bf16* O; int ld;
    __device__ __forceinline__ void operator()(const f32x4 (&acc)[2][2][4][2], const Unit& u, int wr, int wc, int fr, int fq) const {
        bf16* bp = O + (size_t)u.pm * 256 * ld + u.pn * 256 + wc * 32 + 8 * fq;
#pragma unroll
        for (int ai = 0; ai < 2; ++ai)
#pragma unroll
            for (int m = 0; m < 4; ++m) { if (TAIL2 && u.half != 0 && u.half != ai + 1) continue;
                const int rl = ai * 128 + wr * 64 + m * 16 + fr;
#pragma unroll
                for (int bj = 0; bj < 2; ++bj) st8(bp + (size_t)rl * ld + bj * 128, acc[ai][bj][m][0], acc[ai][bj][m][1]);
                asm volatile("" ::: "memory");
            }
    }
};
struct EpiPartial {
    float* part;
    __device__ __forceinline__ void operator()(const f32x4 (&acc)[2][2][4][2], const Unit& u, int wr, int wc, int fr, int fq) const {
#if PART16 && PERM_OUT
        bf16* dp = (bf16*)part + ((size_t)u.ks * NCTX + (size_t)(u.pm - 64) * 256) * D + u.pn * 256 + wc * 32 + 8 * fq;
#pragma unroll
        for (int ai = 0; ai < 2; ++ai)
#pragma unroll
            for (int m = 0; m < 4; ++m) { if (TAIL2 && u.half != 0 && u.half != ai + 1) continue;
                const size_t off = (size_t)(ai * 128 + wr * 64 + m * 16 + fr) * D;
#pragma unroll
                for (int bj = 0; bj < 2; ++bj) st8(dp + off + bj * 128, acc[ai][bj][m][0], acc[ai][bj][m][1]);
                asm volatile("" ::: "memory");
            }
#else
        float* dp = part + ((size_t)u.ks * NCTX + (size_t)(u.pm - 64) * 256) * D + u.pn * 256 + wc * 32 + (PERM_OUT ? 8 : 4) * fq;
#pragma unroll
        for (int ai = 0; ai < 2; ++ai)
#pragma unroll
            for (int m = 0; m < 4; ++m) { if (TAIL2 && u.half != 0 && u.half != ai + 1) continue;
                const size_t off = (size_t)(ai * 128 + wr * 64 + m * 16 + fr) * D;
#pragma unroll
                for (int bj = 0; bj < 2; ++bj)
#pragma unroll
                    for (int n = 0; n < 2; ++n) *(f32x4*)(dp + off + bj * 128 + n * (PERM_OUT ? 4 : 16)) = acc[ai][bj][m][n];
                asm volatile("" ::: "memory");
            }
#endif
    }
};
}
struct Params { const float* in[28]; float* out; unsigned char* ws; };
enum { I_X = 0, I_C, I_CTX, I_CCTX, I_WMOD, I_BMOD, I_GMIX, I_GFFN, I_WIN, I_CONVW, I_SCONVW, I_SCONVB, I_ALOG, I_DTB, I_SSDD, I_SNORM, I_LAMBDA, I_SUBLN, I_WOUT,
       I_FG, I_FU, I_FD, I_RW, I_RB, I_MG, I_MU, I_MD, I_GFIN };
struct Frame {
    LAS unsigned char* lds; volatile LAS unsigned* MISC; gu32* ctl;
    int wave, vcu, G;
};
struct Lane { int tid, lane; __device__ __forceinline__ Lane(int wave) { tid = fresh_tid(wave); lane = tid & 63; } };

#define g_nostore (*(volatile LAS int*)(unsigned)(MISC_OFF + 512))
__device__ __forceinline__ void tr_item(const float* colptr, int ld, bool perm, bf16* wt, int K, int k0, LAS float* scr, int lane) {
    const int j = lane & 31;
    float tv[32];
#pragma unroll
    for (int i = 0; i < 32; ++i) { const int kk = 2 * i + (lane >> 5); tv[i] = colptr[(size_t)(k0 + kk) * ld]; }
#pragma unroll
    for (int i = 0; i < 32; ++i) { const int kk = 2 * i + (lane >> 5); scr[kk * 33 + j] = tv[i]; }
    LDS_WAIT(); asm volatile("" ::: "memory");
    const int c = lane & 7;
#pragma unroll
    for (int jj = 0; jj < 4; ++jj) { const int n = (lane >> 3) + 8 * jj; const int slot = perm ? pg8::perm32(n) : n; const LAS float* s = scr + (8 * c) * 33 + slot;
        v4u o; o.x = pk2(s[0 * 33], s[1 * 33]); o.y = pk2(s[2 * 33], s[3 * 33]); o.z = pk2(s[4 * 33], s[5 * 33]); o.w = pk2(s[6 * 33], s[7 * 33]);
        if (NOSTORE_PROBE && g_nostore) { asm volatile("" :: "v"(o.x), "v"(o.y), "v"(o.z), "v"(o.w)); } else *(GAS v4u*)(wt + (size_t)n * K + k0 + 8 * c) = o; }
    LDS_WAIT(); asm volatile("" ::: "memory");
}
constexpr float W8_SCALE = 64.0f; constexpr int W8_SC8 = 0x79797979;
template <bool I8 = false, bool MAYNULL = false>
__device__ __forceinline__ void tr_item8(const float* colptr, int ld, bool perm, unsigned char* wt, int K, int k0, LAS float* scr, int lane, float mulA = 0.f, float mulB = 0.f) {
    const int j = lane & 31;
    float tv[32];
#pragma unroll
    for (int i = 0; i < 32; ++i) { const int kk = 2 * i + (lane >> 5); tv[i] = (!MAYNULL || colptr) ? colptr[(size_t)(k0 + kk) * ld] : 0.f; }
#pragma unroll
    for (int i = 0; i < 32; ++i) { const int kk = 2 * i + (lane >> 5); scr[kk * 33 + j] = tv[i]; }
    LDS_WAIT(); asm volatile("" ::: "memory");
    const int c = lane & 3;
#pragma unroll
    for (int jj = 0; jj < 2; ++jj) { const int n = (lane >> 2) + 16 * jj; const int slot = perm ? pg8::perm32(n) : n; const LAS float* s = scr + (16 * c) * 33 + slot;
        float v[16]; v4u o;
        if constexpr (I8) { const float mul = jj ? mulB : mulA;
#pragma unroll
            for (int i = 0; i < 16; ++i) v[i] = __builtin_amdgcn_fmed3f(s[i * 33] * mul, -127.f, 127.f);
            o.x = pk_i8(v[0], v[1], v[2], v[3]); o.y = pk_i8(v[4], v[5], v[6], v[7]); o.z = pk_i8(v[8], v[9], v[10], v[11]); o.w = pk_i8(v[12], v[13], v[14], v[15]);
        } else {
#pragma unroll
        for (int i = 0; i < 16; ++i) v[i] = fminf(fmaxf(s[i * 33] * W8_SCALE, -448.f), 448.f);
        o.x = (unsigned)__builtin_amdgcn_cvt_pk_fp8_f32(v[2], v[3], __builtin_amdgcn_cvt_pk_fp8_f32(v[0], v[1], 0, false), true);
        o.y = (unsigned)__builtin_amdgcn_cvt_pk_fp8_f32(v[6], v[7], __builtin_amdgcn_cvt_pk_fp8_f32(v[4], v[5], 0, false), true);
        o.z = (unsigned)__builtin_amdgcn_cvt_pk_fp8_f32(v[10], v[11], __builtin_amdgcn_cvt_pk_fp8_f32(v[8], v[9], 0, false), true);
        o.w = (unsigned)__builtin_amdgcn_cvt_pk_fp8_f32(v[14], v[15], __builtin_amdgcn_cvt_pk_fp8_f32(v[12], v[13], 0, false), true);
        }
        if (NOSTORE_PROBE && g_nostore) { asm volatile("" :: "v"(o.x), "v"(o.y), "v"(o.z), "v"(o.w)); } else *(GAS v4u*)(wt + (size_t)n * K + k0 + 16 * c) = o; }
    LDS_WAIT(); asm volatile("" ::: "memory");
}
template <bool I8, bool MAYNULL>
__device__ __forceinline__ void tr_pair8(const float* colptr, int ld, bool perm, unsigned char* wt, int K, int k0, LAS float* scr, int lane, float mulA = 0.f, float mulB = 0.f) {
    const int j = lane & 31;
#pragma unroll
    for (int hf = 0; hf < 2; ++hf) {
        float tv[32];
#pragma unroll
        for (int i = 0; i < 32; ++i) { const int kk = 64 * hf + 2 * i + (lane >> 5); tv[i] = (!MAYNULL || colptr) ? colptr[(size_t)(k0 + kk) * ld] : 0.f; }
#pragma unroll
        for (int i = 0; i < 32; ++i) { const int kk = 64 * hf + 2 * i + (lane >> 5); scr[kk * 32 + (j ^ (4 * (kk >> 4)))] = tv[i]; }
    }
    LDS_WAIT(); asm volatile("" ::: "memory");
    const int c = lane & 7;
#pragma unroll
    for (int jj = 0; jj < 4; ++jj) { const int n = (lane >> 3) + 8 * jj; const int slot = perm ? pg8::perm32(n) : n; const LAS float* s = scr + (16 * c) * 32 + (slot ^ (4 * c));
        float v[16]; v4u o;
        if constexpr (I8) { const float mul = jj >= 2 ? mulB : mulA;
#pragma unroll
            for (int i = 0; i < 16; ++i) v[i] = __builtin_amdgcn_fmed3f(s[i * 32] * mul, -127.f, 127.f);
            o.x = pk_i8(v[0], v[1], v[2], v[3]); o.y = pk_i8(v[4], v[5], v[6], v[7]); o.z = pk_i8(v[8], v[9], v[10], v[11]); o.w = pk_i8(v[12], v[13], v[14], v[15]);
        } else {
#pragma unroll
            for (int i = 0; i < 16; ++i) v[i] = fminf(fmaxf(s[i * 32] * W8_SCALE, -448.f), 448.f);
            o.x = (unsigned)__builtin_amdgcn_cvt_pk_fp8_f32(v[2], v[3], __builtin_amdgcn_cvt_pk_fp8_f32(v[0], v[1], 0, false), true);
            o.y = (unsigned)__builtin_amdgcn_cvt_pk_fp8_f32(v[6], v[7], __builtin_amdgcn_cvt_pk_fp8_f32(v[4], v[5], 0, false), true);
            o.z = (unsigned)__builtin_amdgcn_cvt_pk_fp8_f32(v[10], v[11], __builtin_amdgcn_cvt_pk_fp8_f32(v[8], v[9], 0, false), true);
            o.w = (unsigned)__builtin_amdgcn_cvt_pk_fp8_f32(v[14], v[15], __builtin_amdgcn_cvt_pk_fp8_f32(v[12], v[13], 0, false), true);
        }
        *(GAS v4u*)(wt + (size_t)n * K + k0 + 16 * c) = o; }
    LDS_WAIT(); asm volatile("" ::: "memory");
}
__device__ __forceinline__ const float* gu_colptr(const float* gate, const float* up, int nb, int j) {
    const int pn = nb >> 3, r = nb & 7, bj = r >> 2, wc = r & 3, n = j >> 4, i = j & 15, fq = i >> 2, jj = i & 3;
    return (n ? up : gate) + 128 * pn + 32 * wc + 8 * fq + 4 * bj + jj;
}

#if CV_PAIR
constexpr int CV_IN = 200 * 16, CV_OUT = 64 * 32, CV_GU = 352 * 16, CV_DN = 64 * 44, CV_MGU1 = 176 * 16, CV_MDN1 = 64 * 22;
#else
constexpr int CV_IN = 200 * 32, CV_OUT = 64 * 32, CV_GU = 352 * 32, CV_DN = 64 * 88, CV_MGU1 = 176 * 32, CV_MDN1 = 64 * 44;
#endif
constexpr int CV_NEARLY = CV_IN + CV_OUT + CV_GU + CV_DN, CV_NITEMS = 2 * CV_IN + 2 * CV_OUT + CV_GU + CV_DN + NE * CV_MGU1 + NE * CV_MDN1, CV_NDEF = CV_NITEMS - CV_NEARLY;
__device__ __forceinline__ void conv_item(Frame& F, const Params& P, int it) {
    unsigned char* ws = fresh_ws(P.ws);
    const LAS float* wsc = (const LAS float*)(F.lds + MISC_OFF + 256);
    float* csw = (float*)(ws + WS_CS);
    LAS float* scr = (LAS float*)(F.lds + F.wave * 16384);
    const int lane = lane_id(), j = lane & 31;
    int r = it, l = 0;
    if (r >= CV_NEARLY) { r -= CV_NEARLY; l = 1; }
    if (r < CV_IN) { const int nb = r % 200, kb = r / 200, n0 = 32 * nb;
        const float* w = P.in[I_WIN] + (size_t)l * D * IN_COLS; const float* cp; bool perm;
        if (CONV_U && n0 >= 512 && n0 < 1536) { cp = gu_colptr(w + 512, w + 1024, (n0 - 512) >> 5, j); perm = false; }
        else if (n0 < 4096) { cp = w + n0 + j; perm = !(n0 >= 2048 && n0 < 3072); }
        else if (n0 < 5120) { cp = w + COL_K + (n0 - 4096) + j; perm = false; }
        else if (n0 < 6144) { cp = w + COL_V + (n0 - 5120) + j; perm = !V8_DIRECT; }
        else if (n0 == 6144) { cp = j < 16 ? w + COL_DT + j : nullptr; perm = false; }
        else { cp = nullptr; perm = false; }
        const float st = wsc[l], inv = 1.0f / st;
        if (kb == 0 && lane < 32) csw[CS_WIN + l * 6400 + n0 + lane] = st;
        if (CV_PAIR) tr_pair8<true, true>(cp, IN_COLS, perm, ws + WS_WIN + l * SZ_WIN + (size_t)n0 * D, D, 128 * kb, scr, lane, inv, inv);
        else tr_item8<true, true>(cp, IN_COLS, perm, ws + WS_WIN + l * SZ_WIN + (size_t)n0 * D, D, 64 * kb, scr, lane, inv, inv);
        return; }
    r -= CV_IN;
    if (r < CV_OUT) { const int nb = r % 64, kb = r / 64, n0 = 32 * nb;
        tr_item(P.in[I_WOUT] + (size_t)l * D * D + n0 + j, D, PERM_OUT != 0, (bf16*)(ws + WS_WOUT + l * SZ_WOUT) + (size_t)n0 * D, D, 64 * kb, scr, lane); return; }
    r -= CV_OUT;
    if (l == 0) {
        if (r < CV_GU) { const int nb = r % 352, kb = r / 352;
            const float sg = wsc[2], su = wsc[3];
            if (kb == 0 && lane < 32) csw[CS_WGU + 32 * nb + lane] = lane < 16 ? sg : su;
            if (CV_PAIR) tr_pair8<true, false>(gu_colptr(P.in[I_FG], P.in[I_FU], nb, j), FFD, false, ws + WS_WGU + (size_t)(32 * nb) * D, D, 128 * kb, scr, lane, 1.0f / sg, 1.0f / su);
            else tr_item8<true>(gu_colptr(P.in[I_FG], P.in[I_FU], nb, j), FFD, false, ws + WS_WGU + (size_t)(32 * nb) * D, D, 64 * kb, scr, lane, 1.0f / sg, 1.0f / su);
            return; }
        r -= CV_GU;
        { const int nb = r % 64, kb = r / 64, n0 = 32 * nb;
          if (CV_PAIR) tr_pair8<false, false>(P.in[I_FD] + n0 + j, D, PERM_OUT != 0, ws + WS_WDN + (size_t)n0 * FFD, FFD, 128 * kb, scr, lane);
          else tr_item8(P.in[I_FD] + n0 + j, D, PERM_OUT != 0, ws + WS_WDN + (size_t)n0 * FFD, FFD, 64 * kb, scr, lane);
          return; }
    }
    if (r < NE * CV_MGU1) { const int e = r / CV_MGU1; r -= e * CV_MGU1; const int nb = r % 176, kb = r / 176;
        const float sg = wsc[4 + e], su = wsc[12 + e];
        if (kb == 0 && lane < 32) csw[CS_MGU + e * (2 * FFE) + 32 * nb + lane] = lane < 16 ? sg : su;
        if (CV_PAIR) tr_pair8<true, false>(gu_colptr(P.in[I_MG] + (size_t)e * D * FFE, P.in[I_MU] + (size_t)e * D * FFE, nb, j), FFE, false, ws + WS_MGU + e * (SZ_MGU / 2) + (size_t)(32 * nb) * D, D, 128 * kb, scr, lane, 1.0f / sg, 1.0f / su);
        else tr_item8<true>(gu_colptr(P.in[I_MG] + (size_t)e * D * FFE, P.in[I_MU] + (size_t)e * D * FFE, nb, j), FFE, false, ws + WS_MGU + e * (SZ_MGU / 2) + (size_t)(32 * nb) * D, D, 64 * kb, scr, lane, 1.0f / sg, 1.0f / su);
        return; }
    r -= NE * CV_MGU1;
    { const int e = r / CV_MDN1; r -= e * CV_MDN1; const int nb = r % 64, kb = r / 64, n0 = 32 * nb;
      if (CV_PAIR) tr_pair8<false, false>(P.in[I_MD] + (size_t)e * FFE * D + n0 + j, D, true, ws + WS_MDN + e * (SZ_MDN / 2) + (size_t)n0 * FFE, FFE, 128 * kb, scr, lane);
      else tr_item8(P.in[I_MD] + (size_t)e * FFE * D + n0 + j, D, true, ws + WS_MDN + e * (SZ_MDN / 2) + (size_t)n0 * FFE, FFE, 64 * kb, scr, lane); }
}
#define ITEM_NB(r, N, NKB, OLD) (ITEM_NBFAST == 2 ? (((r) >> 3) / (NKB)) * 8 + ((r) & 7) : ITEM_NBFAST == 1 ? (r) % (N) : (OLD))
#define ITEM_KB(r, N, NKB, OLD) (ITEM_NBFAST == 2 ? ((r) >> 3) % (NKB) : ITEM_NBFAST == 1 ? (r) / (N) : (OLD))
__device__ __forceinline__ void p0_prologue(Frame& F, const Params& P) {
    const Lane L(F.wave);
    unsigned char* ws = fresh_ws(P.ws);
    if (F.vcu < 192) {
      for (int rep_ = 0; rep_ <= DUP_MODV; ++rep_) {
        const int l = F.vcu / 96, cb = F.vcu % 96;
        LAS float* sv = (LAS float*)(F.lds);
        LAS float* red = (LAS float*)(F.lds + 32768);
        for (int i = L.tid; i < 3 * D; i += 512) { const int v = i / D, k = i % D; const float c = v < 2 ? P.in[I_C][v * D + k] : P.in[I_CCTX][k]; sv[i] = c / (1.0f + __expf(-c)); }
        __syncthreads();
        const float* W = P.in[I_WMOD] + (size_t)l * D * 12288 + cb * 128 + 2 * L.lane;
        f32x2 a0 = {0.f, 0.f}, a1 = {0.f, 0.f}, a2 = {0.f, 0.f};
        const int kb = F.wave * 256;
#pragma unroll 16
        for (int k = 0; k < 256; ++k) { const f32x2 w = *(const f32x2*)(W + (size_t)(kb + k) * 12288); a0 += w * sv[kb + k]; a1 += w * sv[D + kb + k]; a2 += w * sv[2 * D + kb + k]; }
        *(LAS f32x2*)(red + (F.wave * 3 + 0) * 128 + 2 * L.lane) = a0; *(LAS f32x2*)(red + (F.wave * 3 + 1) * 128 + 2 * L.lane) = a1; *(LAS f32x2*)(red + (F.wave * 3 + 2) * 128 + 2 * L.lane) = a2;
        __syncthreads();
        if (L.tid < 384) { const int v = L.tid >> 7, col = L.tid & 127; float s = P.in[I_BMOD][l * 12288 + cb * 128 + col];
#pragma unroll
            for (int w = 0; w < 8; ++w) s += red[(w * 3 + v) * 128 + col];
            ((float*)(ws + WS_MOD))[(size_t)(l * 3 + v) * 12288 + cb * 128 + col] = s; }
        __syncthreads();
      }
    } else if (F.vcu == 192) {
        float* rc = (float*)(ws + WS_ROPE); float* rs = rc + 192 * 16;
        for (int i = L.tid; i < 192 * 16; i += 512) { const int pos = i >> 4, f = i & 15; const float inv = exp2f(-(float)f * (13.287712379549449f / 16.0f)); const float ang = (float)(pos < 128 ? pos : pos - 128) * inv; rc[i] = cosf(ang); rs[i] = sinf(ang); }
    }
    LAS float* wsc = (LAS float*)(F.lds + MISC_OFF + 256);
    for (int t = F.wave; t < 20; t += NWAVES) {
        const float* tp = t < 2 ? P.in[I_WIN] + (size_t)t * D * IN_COLS : t == 2 ? P.in[I_FG] : t == 3 ? P.in[I_FU] : t < 12 ? P.in[I_MG] + (size_t)(t - 4) * D * FFE : P.in[I_MU] + (size_t)(t - 12) * D * FFE;
        float ss = 0.f;
#pragma unroll
        for (int i = 0; i < 16; ++i) { const f32x4 w = *(const f32x4*)(tp + 4 * (L.lane + 64 * i)); ss += (w[0] * w[0] + w[1] * w[1]) + (w[2] * w[2] + w[3] * w[3]); }
        ss = wave_sum(ss);
        if (L.lane == 0) wsc[t] = sqrtf(ss * (1.0f / 4096.0f)) * (I8_CLIP / 127.0f);
    }
    __syncthreads();
    float* csw = (float*)(ws + WS_CS);
    const int gw = F.vcu * NWAVES + F.wave, NGW = F.G * NWAVES;
    constexpr int NPRE = 63 * NWAVES * (CV_PAIR ? 4 : 7);
    const bool early = F.vcu > 192;
    const int nA = early ? NPRE : 0, sA = early ? (F.vcu - 193) * NWAVES + F.wave : 0, stA = 63 * NWAVES;
    for (int ph = 0; ph < 2; ++ph) {
      const int lo = ph == 0 ? sA : NPRE + gw, hi2 = ph == 0 ? nA : ((DEFER && F.G == 256) ? CV_NEARLY : CV_NITEMS), st = ph == 0 ? stA : NGW;
      for (int it = lo; it < hi2; it += st) conv_item(F, P, it);
    }
}
__device__ __forceinline__ void deferred_slot(Frame& F, const Params& P, int dpos, int k, int nIdle, int ipw) {
    const int w0 = k * NWAVES + F.wave, st = nIdle * NWAVES;
    for (int i = 0; i < ipw; ++i) { const int it = CV_NEARLY + dpos + w0 + i * st; if (it < CV_NITEMS) conv_item(F, P, it); }
}
__device__ __forceinline__ void deferred_rest(Frame& F, const Params& P, int dpos) {
    for (int it = CV_NEARLY + dpos + F.vcu * NWAVES + F.wave; it < CV_NITEMS; it += F.G * NWAVES) conv_item(F, P, it);
}

__device__ __forceinline__ void store_row_i8(unsigned char* hr, float* hs, int r, const f32x4 (&x)[8], int lane) {
    float am = 0.f;
#pragma unroll
    for (int jq = 0; jq < 8; ++jq) am = fmaxf(fmaxf(am, fmaxf(fabsf(x[jq][0]), fabsf(x[jq][1]))), fmaxf(fabsf(x[jq][2]), fabsf(x[jq][3])));
    am = fmaxf(wave_max(am), 1e-30f);
    const float inv = 127.0f / am;
#pragma unroll
    for (int jq = 0; jq < 8; ++jq) *(unsigned*)(hr + 4 * lane + 256 * jq) = pk_i8(x[jq][0] * inv, x[jq][1] * inv, x[jq][2] * inv, x[jq][3] * inv);
    if (lane == 0) hs[r] = am * (1.0f / 127.0f);
}
template <bool ROUTE, int OUT8 = 0, bool SL16 = false, bool SC16 = false>
__device__ __forceinline__ void norm_phase(Frame& F, const void* srcLatV, const void* srcCtxV, const float* gvec, const float* modl, int ishift, int iscale, bf16* h, int nrows,
                                           const float* wrouter, const float* brouter, int* tok_e, int* tok_slot, float* tok_p,
                                           const float* part = nullptr, int nsl = 0, const float* pgate = nullptr, bf16* wb = nullptr, float* hs = nullptr) {
    const Lane L(F.wave);
    LAS float* wrT = (LAS float*)F.lds;
    if (ROUTE) {
        for (int i = L.tid; i < D * NE; i += 512) { const int k = i >> 3, e = i & 7; wrT[e * D + k] = wrouter[i]; }
        __syncthreads();
    }
    const int gw = F.vcu * NWAVES + F.wave, NGW = F.G * NWAVES, lane = L.lane;
    const int nmain = part != nullptr ? NLAT / 8 : nrows / 8;
    for (int run = gw; run < nmain; run += NGW) {
        const int r0 = run * 8; const int v = r0 < SEQ ? 0 : (r0 < NLAT ? 1 : 2);
        const float* sh = modl + (size_t)(v * 6 + ishift) * D; const float* sc = modl + (size_t)(v * 6 + iscale) * D;
        f32x4 A[8], B[8];
#pragma unroll
        for (int jq = 0; jq < 8; ++jq) { const int c = 4 * lane + 256 * jq; const f32x4 g = *(const f32x4*)(gvec + c), s = *(const f32x4*)(sc + c); A[jq] = g * (s + 1.0f); B[jq] = *(const f32x4*)(sh + c); }
        for (int rr = 0; rr < 8; ++rr) {
            const int r = r0 + rr;
            f32x4 x[8]; float ss = 0.f;
            if (r < NLAT) {
#pragma unroll
                for (int jq = 0; jq < 8; ++jq) x[jq] = SL16 ? ld4_bf16((const bf16*)srcLatV + (size_t)r * D + 4 * lane + 256 * jq) : ld4_f32((const float*)srcLatV + (size_t)r * D + 4 * lane + 256 * jq);
            } else {
#pragma unroll
                for (int jq = 0; jq < 8; ++jq) x[jq] = SC16 ? ld4_bf16((const bf16*)srcCtxV + (size_t)(r - NLAT) * D + 4 * lane + 256 * jq) : ld4_f32((const float*)srcCtxV + (size_t)(r - NLAT) * D + 4 * lane + 256 * jq);
            }
#pragma unroll
            for (int jq = 0; jq < 8; ++jq) ss += (x[jq][0] * x[jq][0] + x[jq][1] * x[jq][1]) + (x[jq][2] * x[jq][2] + x[jq][3] * x[jq][3]);
            const float rstd = 1.0f / sqrtf(wave_sum(ss) * (1.0f / D) + NORM_EPS);
#pragma unroll
            for (int jq = 0; jq < 8; ++jq) x[jq] = (x[jq] * rstd) * A[jq] + B[jq];
            if constexpr (OUT8 == 2 && ROUTE && MOE_SPARSE) {   }
            else if constexpr (OUT8 == 2) store_row_i8((unsigned char*)h + (size_t)r * D, hs, r, x, lane);
            else if constexpr (OUT8 == 1) {
                unsigned char* hr8 = (unsigned char*)h + (size_t)r * D;
#pragma unroll
                for (int jq = 0; jq < 8; ++jq) { const f32x4 y = __builtin_elementwise_min(__builtin_elementwise_max(x[jq], (f32x4){-448.f, -448.f, -448.f, -448.f}), (f32x4){448.f, 448.f, 448.f, 448.f});
                    *(unsigned*)(hr8 + 4 * lane + 256 * jq) = (unsigned)__builtin_amdgcn_cvt_pk_fp8_f32(y[2], y[3], __builtin_amdgcn_cvt_pk_fp8_f32(y[0], y[1], 0, false), true); }
            } else {
            bf16* hr = h + (size_t)r * D;
#pragma unroll
            for (int jq = 0; jq < 8; ++jq) { v2u w; w.x = cvtpk(x[jq][0], x[jq][1]); w.y = cvtpk(x[jq][2], x[jq][3]); *(v2u*)(hr + 4 * lane + 256 * jq) = w; }
            }
            if (ROUTE) {
                float lg[NE];
#pragma unroll
                for (int e = 0; e < NE; ++e) { float p = 0.f;
#pragma unroll
                    for (int jq = 0; jq < 8; ++jq) { const f32x4 w = *(const LAS f32x4*)(wrT + e * D + 4 * lane + 256 * jq); p += (x[jq][0] * w[0] + x[jq][1] * w[1]) + (x[jq][2] * w[2] + x[jq][3] * w[3]); }
                    lg[e] = wave_sum(p) + brouter[e]; }
                int i0 = 0; float v0 = lg[0];
#pragma unroll
                for (int e = 1; e < NE; ++e) if (lg[e] > v0) { v0 = lg[e]; i0 = e; }
                int i1 = -1; float v1 = -3.0e38f;
#pragma unroll
                for (int e = 0; e < NE; ++e) if (e != i0 && lg[e] > v1) { v1 = lg[e]; i1 = e; }
                int s0 = 0, s1 = 0;
                if (lane == 0) {
                    const float p0 = 1.0f / (1.0f + __expf(v1 - v0));
                    s0 = (int)__hip_atomic_fetch_add(F.ctl + CW_CNT + 64 * i0, 1u, RLX_AGENT);
                    s1 = (int)__hip_atomic_fetch_add(F.ctl + CW_CNT + 64 * i1, 1u, RLX_AGENT);
                    tok_e[2 * r] = i0; tok_e[2 * r + 1] = i1; tok_slot[2 * r] = s0; tok_slot[2 * r + 1] = s1; tok_p[2 * r] = p0; tok_p[2 * r + 1] = 1.0f - p0;
                }
                if constexpr (OUT8 == 2 && MOE_SPARSE) {
                    s0 = __builtin_amdgcn_readfirstlane(s0); s1 = __builtin_amdgcn_readfirstlane(s1);
                    float am = 0.f;
#pragma unroll
                    for (int jq = 0; jq < 8; ++jq) am = fmaxf(fmaxf(am, fmaxf(fabsf(x[jq][0]), fabsf(x[jq][1]))), fmaxf(fabsf(x[jq][2]), fabsf(x[jq][3])));
                    am = fmaxf(wave_max(am), 1e-30f);
                    const float inv = 127.0f / am;
                    const size_t ra = (size_t)i0 * NLAT + s0, rb = (size_t)i1 * NLAT + s1;
                    unsigned char* d0 = (unsigned char*)h + ra * D; unsigned char* d1 = (unsigned char*)h + rb * D;
#pragma unroll
                    for (int jq = 0; jq < 8; ++jq) { const unsigned w = pk_i8(x[jq][0] * inv, x[jq][1] * inv, x[jq][2] * inv, x[jq][3] * inv);
                        *(unsigned*)(d0 + 4 * lane + 256 * jq) = w; *(unsigned*)(d1 + 4 * lane + 256 * jq) = w; }
                    if (lane == 0) { hs[ra] = am * (1.0f / 127.0f); hs[rb] = am * (1.0f / 127.0f); }
                }
            }
        }
    }
    if (part != nullptr) {
        const float* sh = modl + (size_t)(2 * 6 + ishift) * D; const float* sc = modl + (size_t)(2 * 6 + iscale) * D;
        for (int r = NLAT + gw; r < NLAT + NCTX; r += NGW) {
            f32x4 x[8]; float ss = 0.f;
#pragma unroll
#if PART16 && PERM_OUT
            for (int jq = 0; jq < 8; ++jq) { const int c = 4 * lane + 256 * jq; f32x4 a = ld4_bf16((const bf16*)part + (size_t)(r - NLAT) * D + c);
                for (int s = 1; s < nsl; ++s) a += ld4_bf16((const bf16*)part + ((size_t)s * NCTX + (r - NLAT)) * D + c);
#else
            for (int jq = 0; jq < 8; ++jq) { const int c = 4 * lane + 256 * jq; f32x4 a = *(const f32x4*)(part + (size_t)(r - NLAT) * D + c);
                for (int s = 1; s < nsl; ++s) a += *(const f32x4*)(part + ((size_t)s * NCTX + (r - NLAT)) * D + c);
#endif
                const f32x4 xs = SC16 ? ld4_bf16((const bf16*)srcCtxV + (size_t)(r - NLAT) * D + c) : ld4_f32((const float*)srcCtxV + (size_t)(r - NLAT) * D + c);
                x[jq] = xs + *(const f32x4*)(pgate + c) * a;
                ss += (x[jq][0] * x[jq][0] + x[jq][1] * x[jq][1]) + (x[jq][2] * x[jq][2] + x[jq][3] * x[jq][3]); }
            if (wb) {
#pragma unroll
                for (int jq = 0; jq < 8; ++jq) st4_bf16(wb + (size_t)r * D + 4 * lane + 256 * jq, x[jq]);
            }
            const float rstd = 1.0f / sqrtf(wave_sum(ss) * (1.0f / D) + NORM_EPS);
            bf16* hr = h + (size_t)r * D;
            if constexpr (OUT8 == 2) {
#pragma unroll
                for (int jq = 0; jq < 8; ++jq) { const int c = 4 * lane + 256 * jq; const f32x4 g = *(const f32x4*)(gvec + c), s = *(const f32x4*)(sc + c), b = *(const f32x4*)(sh + c); x[jq] = (x[jq] * rstd) * (g * (s + 1.0f)) + b; }
                store_row_i8((unsigned char*)h + (size_t)r * D, hs, r, x, lane);
            } else
#pragma unroll
            for (int jq = 0; jq < 8; ++jq) { const int c = 4 * lane + 256 * jq; const f32x4 g = *(const f32x4*)(gvec + c), s = *(const f32x4*)(sc + c), b = *(const f32x4*)(sh + c);
                f32x4 y = (x[jq] * rstd) * (g * (s + 1.0f)) + b;
                if constexpr (OUT8 == 1) { y = __builtin_elementwise_min(__builtin_elementwise_max(y, (f32x4){-448.f, -448.f, -448.f, -448.f}), (f32x4){448.f, 448.f, 448.f, 448.f});
                    *(unsigned*)((unsigned char*)h + (size_t)r * D + c) = (unsigned)__builtin_amdgcn_cvt_pk_fp8_f32(y[2], y[3], __builtin_amdgcn_cvt_pk_fp8_f32(y[0], y[1], 0, false), true); }
                else { v2u w; w.x = cvtpk(y[0], y[1]); w.y = cvtpk(y[2], y[3]); *(v2u*)(hr + c) = w; } }
        }
    }
    if (ROUTE) __syncthreads();
}

__device__ __forceinline__ void ld8f(const bf16* p, float (&o)[8]) { const v4u w = *(const v4u*)p; o[0] = bflo(w.x); o[1] = bfhi(w.x); o[2] = bflo(w.y); o[3] = bfhi(w.y); o[4] = bflo(w.z); o[5] = bfhi(w.z); o[6] = bflo(w.w); o[7] = bfhi(w.w); }
__device__ __forceinline__ void st8f(bf16* p, const float (&o)[8]) { v4u w; w.x = cvtpk(o[0], o[1]); w.y = cvtpk(o[2], o[3]); w.z = cvtpk(o[4], o[5]); w.w = cvtpk(o[6], o[7]); *(v4u*)p = w; }
__device__ __forceinline__ void conv_phase(Frame& F, const bf16* convb, const bf16* xbcb, bf16* cat, bf16* xbcc, const float* cw  , const float* sw  , const float* sb  ) {
    const Lane L(F.wave);
    const int gt = F.vcu * 512 + L.tid, NT = F.G * 512;
    constexpr int NRUN = T / 16, NITEM = NRUN * 192;
    for (int it = gt; it < NITEM; it += NT) {
        const int cc = it % 192, run = it / 192, r0 = run * 16;
        const int tl = r0 < NLAT ? (r0 % SEQ) : ((r0 - NLAT) % CTXL); const int sl = r0 < NLAT ? SEQ : CTXL;
        const bool first = tl == 0, last = tl + 16 == sl;
        if (cc < 64) {
            const int c0 = 8 * cc; float w0[8], w1[8], w2[8];
#pragma unroll
            for (int j = 0; j < 8; ++j) { w0[j] = cw[c0 + j]; w1[j] = cw[512 + c0 + j]; w2[j] = cw[1024 + c0 + j]; }
            float up[8], uc[8], un[8], a[8], b[8];
            if (first) {
#pragma unroll
                for (int j = 0; j < 8; ++j) up[j] = 0.f;
            } else if (CONV_U) { ld8f(convb + (size_t)(r0 - 1) * 1536 + 512 + c0, up); }
            else { ld8f(convb + (size_t)(r0 - 1) * 1536 + 512 + c0, a); ld8f(convb + (size_t)(r0 - 1) * 1536 + 1024 + c0, b);
#pragma unroll
                for (int j = 0; j < 8; ++j) up[j] = a[j] * b[j]; }
            if (CONV_U) ld8f(convb + (size_t)r0 * 1536 + 512 + c0, uc);
            else { ld8f(convb + (size_t)r0 * 1536 + 512 + c0, a); ld8f(convb + (size_t)r0 * 1536 + 1024 + c0, b);
#pragma unroll
            for (int j = 0; j < 8; ++j) uc[j] = a[j] * b[j]; }
            for (int t = 0; t < 16; ++t) {
                const int r = r0 + t;
                if (t == 15 && last) {
#pragma unroll
                    for (int j = 0; j < 8; ++j) un[j] = 0.f;
                } else if (CONV_U) { ld8f(convb + (size_t)(r + 1) * 1536 + 512 + c0, un); }
                else { ld8f(convb + (size_t)(r + 1) * 1536 + 512 + c0, a); ld8f(convb + (size_t)(r + 1) * 1536 + 1024 + c0, b);
#pragma unroll
                    for (int j = 0; j < 8; ++j) un[j] = a[j] * b[j]; }
                float g[8], o[8]; ld8f(convb + (size_t)r * 1536 + c0, g);
#pragma unroll
                for (int j = 0; j < 8; ++j) { o[j] = g[j] * ((up[j] * w0[j] + uc[j] * w1[j]) + un[j] * w2[j]); up[j] = uc[j]; uc[j] = un[j]; }
                st8f(cat + (size_t)r * D + c0, o);
            }
        } else {
            const int c0 = 8 * (cc - 64); float w0[8], w1[8], w2[8], bb[8];
#pragma unroll
            for (int j = 0; j < 8; ++j) { w0[j] = sw[c0 + j]; w1[j] = sw[1024 + c0 + j]; w2[j] = sw[2048 + c0 + j]; bb[j] = sb[c0 + j]; }
            float up[8], uc[8], un[8];
            if (first) {
#pragma unroll
                for (int j = 0; j < 8; ++j) up[j] = 0.f;
            } else ld8f(xbcb + (size_t)(r0 - 1) * 1024 + c0, up);
            ld8f(xbcb + (size_t)r0 * 1024 + c0, uc);
            for (int t = 0; t < 16; ++t) {
                const int r = r0 + t;
                if (t == 15 && last) {
#pragma unroll
                    for (int j = 0; j < 8; ++j) un[j] = 0.f;
                } else ld8f(xbcb + (size_t)(r + 1) * 1024 + c0, un);
                float o[8];
#pragma unroll
                for (int j = 0; j < 8; ++j) { const float y = ((up[j] * w0[j] + uc[j] * w1[j]) + un[j] * w2[j]) + bb[j]; o[j] = silu_f(y); up[j] = uc[j]; uc[j] = un[j]; }
                st8f(xbcc + (size_t)r * 1024 + c0, o);
            }
        }
    }
}
__device__ __forceinline__ int chain_pos(int dir, int cn) { return dir == 0 ? cn : (cn < 2 ? 1 - cn : 67 - cn); }
__device__ __forceinline__ int crow(int r, int hi) { return (r & 3) + 8 * (r >> 2) + 4 * hi; }
__device__ __forceinline__ float softplus_f(float x) { return fmaxf(x, 0.f) + __logf(1.0f + __expf(-fabsf(x))); }
constexpr int TS = 136;

template <int SVAR = 0>
__device__ __forceinline__ void ssd_local_phase(Frame& F, const Params& P, int layer) {
    unsigned char* ws = fresh_ws(P.ws);
    const bf16* xbcc = (const bf16*)(ws + WS_XBCC); const float* dtb = (const float*)(ws + WS_DT);
    float* yd = (float*)(ws + WS_YD); float* cumb = (float*)(ws + WS_CUM); float* Sb = (float*)(ws + WS_SB); float* tot = (float*)(ws + WS_TOT);
    LAS bf16* Cs = (LAS bf16*)(F.lds); LAS bf16* Bs = (LAS bf16*)(F.lds + 34816); LAS bf16* XT = (LAS bf16*)(F.lds + 69632);
    LAS bf16* Gs = (LAS bf16*)(F.lds + 87040) + F.wave * 1280;
    LAS float* fa = (LAS float*)(F.lds + 107520);
    LAS float* daA = fa, *cumA = fa + 256, *dtA = fa + 512, *scA = fa + 768;
    const int wave = F.wave;
#if S1_PF
    v4u pfc[4], pfb[4], pfx[2]; float pfraw = 0.f;
#define S1_GLOAD(uid_) do { const int t_ = fresh_tid(F.wave); const int h_ = (uid_) & 7, b_ = ((uid_) >> 3) & 1, cn_ = (uid_) >> 4, g_ = h_ >> 2; \
        const int row0_ = cn_ < 2 ? NLAT + b_ * CTXL + 128 * cn_ : b_ * SEQ + 128 * (cn_ - 2); \
        _Pragma("unroll") for (int i = 0; i < 4; ++i) { const int q = t_ + 512 * i, s_ = q >> 4, c8 = (q & 15) * 8; \
            pfc[i] = *(const v4u*)(xbcc + (size_t)(row0_ + s_) * 1024 + 768 + g_ * 128 + c8); pfb[i] = *(const v4u*)(xbcc + (size_t)(row0_ + s_) * 1024 + 512 + g_ * 128 + c8); } \
        _Pragma("unroll") for (int i = 0; i < 2; ++i) { const int q = t_ + 512 * i, s_ = q & 127, p8 = (q >> 7) * 8; pfx[i] = *(const v4u*)(xbcc + (size_t)(row0_ + s_) * 1024 + h_ * 64 + p8); } \
        if (t_ < 256) { const int dir = t_ >> 7, s_ = t_ & 127; pfraw = dtb[(size_t)(row0_ + s_) * 16 + dir * 8 + h_] + P.in[I_DTB][layer * 16 + dir * 8 + h_]; } } while (0)
    if (F.vcu < NCH * NB * 8) S1_GLOAD(F.vcu);
#endif
    for (int uid = F.vcu; uid < NCH * NB * 8; uid += F.G) {
        const int tid = fresh_tid(F.wave), lane = tid & 63, r32 = lane & 31, hi = lane >> 5;
        const int h = uid & 7, b = (uid >> 3) & 1, cn = uid >> 4, g = h >> 2;
        const int row0 = cn < 2 ? NLAT + b * CTXL + 128 * cn : b * SEQ + 128 * (cn - 2);
#if S1_PF
#pragma unroll
        for (int i = 0; i < 4; ++i) { const int q = tid + 512 * i, s = q >> 4, c8 = (q & 15) * 8; *(LAS v4u*)(Cs + s * TS + c8) = pfc[i]; *(LAS v4u*)(Bs + s * TS + c8) = pfb[i]; }
#pragma unroll
        for (int i = 0; i < 2; ++i) { const int q = tid + 512 * i, s = q & 127, p8 = (q >> 7) * 8; const v4u w = pfx[i];
            XT[(p8 + 0) * TS + s] = (bf16)(w.x & 0xffff); XT[(p8 + 1) * TS + s] = (bf16)(w.x >> 16); XT[(p8 + 2) * TS + s] = (bf16)(w.y & 0xffff); XT[(p8 + 3) * TS + s] = (bf16)(w.y >> 16);
            XT[(p8 + 4) * TS + s] = (bf16)(w.z & 0xffff); XT[(p8 + 5) * TS + s] = (bf16)(w.z >> 16); XT[(p8 + 6) * TS + s] = (bf16)(w.w & 0xffff); XT[(p8 + 7) * TS + s] = (bf16)(w.w >> 16); }
        if (tid < 256) { const int dir = tid >> 7;
            const float dt = softplus_f(pfraw); const float A = -__expf(P.in[I_ALOG][layer * 16 + dir * 8 + h]);
            dtA[tid] = dt; daA[tid] = dt * A; }
        if (uid + F.G < NCH * NB * 8) S1_GLOAD(uid + F.G);
#else
#pragma unroll
        for (int i = 0; i < 4; ++i) { const int q = tid + 512 * i, s = q >> 4, c8 = (q & 15) * 8;
            *(LAS v4u*)(Cs + s * TS + c8) = *(const v4u*)(xbcc + (size_t)(row0 + s) * 1024 + 768 + g * 128 + c8);
            *(LAS v4u*)(Bs + s * TS + c8) = *(const v4u*)(xbcc + (size_t)(row0 + s) * 1024 + 512 + g * 128 + c8); }
#pragma unroll
        for (int i = 0; i < 2; ++i) { const int q = tid + 512 * i, s = q & 127, p8 = (q >> 7) * 8;
            const v4u w = *(const v4u*)(xbcc + (size_t)(row0 + s) * 1024 + h * 64 + p8);
            XT[(p8 + 0) * TS + s] = (bf16)(w.x & 0xffff); XT[(p8 + 1) * TS + s] = (bf16)(w.x >> 16); XT[(p8 + 2) * TS + s] = (bf16)(w.y & 0xffff); XT[(p8 + 3) * TS + s] = (bf16)(w.y >> 16);
            XT[(p8 + 4) * TS + s] = (bf16)(w.z & 0xffff); XT[(p8 + 5) * TS + s] = (bf16)(w.z >> 16); XT[(p8 + 6) * TS + s] = (bf16)(w.w & 0xffff); XT[(p8 + 7) * TS + s] = (bf16)(w.w >> 16); }
        if (tid < 256) { const int dir = tid >> 7, s = tid & 127;
            const float raw = dtb[(size_t)(row0 + s) * 16 + dir * 8 + h] + P.in[I_DTB][layer * 16 + dir * 8 + h];
            const float dt = softplus_f(raw); const float A = -__expf(P.in[I_ALOG][layer * 16 + dir * 8 + h]);
            dtA[tid] = dt; daA[tid] = dt * A; }
#endif
        __syncthreads();
        float cloc = 0.f;
        if (tid < 256) { const int dir = tid >> 7, s = tid & 127, b8 = s & ~7;
#pragma unroll
            for (int k = 0; k < 8; ++k) { const float a = daA[dir * 128 + b8 + k]; if (dir == 0 ? (b8 + k <= s) : (b8 + k >= s)) cloc += a; }
            if (dir == 0 ? ((s & 7) == 7) : ((s & 7) == 0)) scA[dir * 16 + (s >> 3)] = cloc; }
        __syncthreads();
        float cum = cloc, total = 0.f;
        if (tid < 256) { const int dir = tid >> 7, s = tid & 127, bi = s >> 3;
#pragma unroll
            for (int k = 0; k < 16; ++k) { const float a = scA[dir * 16 + k]; total += a; if (dir == 0 ? (k < bi) : (k > bi)) cum += a; } }
        __syncthreads();
        if (tid < 256) { const int dir = tid >> 7, s = tid & 127;
            cumA[tid] = cum; scA[tid] = __expf(total - cum) * dtA[tid];
            cumb[(size_t)(row0 + s) * 16 + dir * 8 + h] = cum;
            if (s == 0) tot[((dir * 2 + b) * 8 + h) * NCH + chain_pos(dir, cn)] = total; }
        __syncthreads();
        if (SVAR < 1 || SVAR == 4) {
            const int rb = wave >> 1, cb = wave & 1;
            f32x16 Y = {};
            float cl0[16], cl1[16];
#pragma unroll
            for (int r = 0; r < 16; ++r) { cl0[r] = cumA[32 * rb + crow(r, hi)]; cl1[r] = cumA[128 + 32 * rb + crow(r, hi)]; }
            for (int sb = 0; sb < 4; ++sb) {
                f32x16 CB = {};
#pragma unroll
                for (int ks = 0; ks < 8; ++ks) {
                    const bf16x8 a = *(const LAS bf16x8*)(Cs + (32 * rb + r32) * TS + 16 * ks + 8 * hi);
                    const bf16x8 bb = *(const LAS bf16x8*)(Bs + (32 * sb + r32) * TS + 16 * ks + 8 * hi);
                    CB = __builtin_amdgcn_mfma_f32_32x32x16_bf16(a, bb, CB, 0, 0, 0);
                }
                const int s = 32 * sb + r32; const float cs0 = cumA[s], cs1 = cumA[128 + s], d0 = dtA[s], d1 = dtA[128 + s];
#pragma unroll
                for (int r = 0; r < 16; ++r) { const int l = 32 * rb + crow(r, hi);
                    const float f0 = (s <= l) ? __expf(cl0[r] - cs0) * d0 : 0.f, f1 = (s >= l) ? __expf(cl1[r] - cs1) * d1 : 0.f;
                    Gs[crow(r, hi) * 40 + r32] = (bf16)f2bf(CB[r] * (f0 + f1)); }
                LDS_WAIT(); asm volatile("" ::: "memory");
#pragma unroll
                for (int k2 = 0; k2 < 2; ++k2) {
                    const bf16x8 ag = *(const LAS bf16x8*)(Gs + r32 * 40 + 16 * k2 + 8 * hi);
                    const bf16x8 bx = *(const LAS bf16x8*)(XT + (32 * cb + r32) * TS + 32 * sb + 16 * k2 + 8 * hi);
                    Y = __builtin_amdgcn_mfma_f32_32x32x16_bf16(ag, bx, Y, 0, 0, 0);
                }
                LDS_WAIT(); asm volatile("" ::: "memory");
            }
#if YD16
            {
                unsigned* yd16 = (unsigned*)yd; const int odd = r32 & 1;
#pragma unroll
                for (int r = 0; r < 16; r += 2) {
                    const float a = fminf(fmaxf(Y[r], -65504.f), 65504.f), bq = fminf(fmaxf(Y[r + 1], -65504.f), 65504.f);
                    const float pa = dpp_f(a, 0), pb = dpp_f(bq, 0);
                    const _Float16 lo = (_Float16)(odd ? pb : a), hh = (_Float16)(odd ? bq : pa);
                    const unsigned w = (unsigned)__builtin_bit_cast(unsigned short, lo) | ((unsigned)__builtin_bit_cast(unsigned short, hh) << 16);
                    yd16[((size_t)(row0 + 32 * rb + crow(r + odd, hi)) * 512 + h * 64 + 32 * cb + r32 - odd) >> 1] = w; }
            }
#else
#pragma unroll
            for (int r = 0; r < 16; ++r) yd[(size_t)(row0 + 32 * rb + crow(r, hi)) * 512 + h * 64 + 32 * cb + r32] = Y[r];
#endif
        }
        __syncthreads();
        LAS bf16* BT = Cs;
        if (SVAR < 2 || SVAR == 3) {
#pragma unroll
        for (int i = 0; i < 4; ++i) { const int q = tid + 512 * i, s = q & 127, n8 = (q >> 7) * 8; const v4u w = *(const LAS v4u*)(Bs + s * TS + n8);
            BT[(n8 + 0) * TS + s] = (bf16)(w.x & 0xffff); BT[(n8 + 1) * TS + s] = (bf16)(w.x >> 16); BT[(n8 + 2) * TS + s] = (bf16)(w.y & 0xffff); BT[(n8 + 3) * TS + s] = (bf16)(w.y >> 16);
            BT[(n8 + 4) * TS + s] = (bf16)(w.z & 0xffff); BT[(n8 + 5) * TS + s] = (bf16)(w.z >> 16); BT[(n8 + 6) * TS + s] = (bf16)(w.w & 0xffff); BT[(n8 + 7) * TS + s] = (bf16)(w.w >> 16); }
        __syncthreads();
        {
            const int dir = wave & 1, nb = wave >> 1;
            f32x16 S0 = {}, S1 = {};
#pragma unroll
            for (int ks = 0; ks < 8; ++ks) {
                const int s0 = 16 * ks + 8 * hi;
                const f32x4 sc0 = *(const LAS f32x4*)(scA + dir * 128 + s0), sc1 = *(const LAS f32x4*)(scA + dir * 128 + s0 + 4);
                const bf16x8 bb = *(const LAS bf16x8*)(BT + (32 * nb + r32) * TS + s0);
#pragma unroll
                for (int pb = 0; pb < 2; ++pb) {
                    const v4u xr = *(const LAS v4u*)(XT + (32 * pb + r32) * TS + s0);
                    v4u xs; xs.x = cvtpk(bflo(xr.x) * sc0[0], bfhi(xr.x) * sc0[1]); xs.y = cvtpk(bflo(xr.y) * sc0[2], bfhi(xr.y) * sc0[3]);
                    xs.z = cvtpk(bflo(xr.z) * sc1[0], bfhi(xr.z) * sc1[1]); xs.w = cvtpk(bflo(xr.w) * sc1[2], bfhi(xr.w) * sc1[3]);
                    const bf16x8 a = __builtin_bit_cast(bf16x8, xs);
                    if (pb == 0) S0 = __builtin_amdgcn_mfma_f32_32x32x16_bf16(a, bb, S0, 0, 0, 0); else S1 = __builtin_amdgcn_mfma_f32_32x32x16_bf16(a, bb, S1, 0, 0, 0);
                }
            }
#if S1_LDSST
            __syncthreads();
            LAS float* St = (LAS float*)F.lds;
#pragma unroll
            for (int r = 0; r < 16; ++r) { St[(dir * 64 + crow(r, hi)) * 128 + 32 * nb + r32] = S0[r]; St[(dir * 64 + 32 + crow(r, hi)) * 128 + 32 * nb + r32] = S1[r]; }
            __syncthreads();
            { const int tid3 = fresh_tid(F.wave);
#pragma unroll
              for (int i = 0; i < 8; ++i) { const int q = tid3 + 512 * i, d2 = q >> 11, e4 = (q & 2047) * 4;
                  float* sp2 = Sb + ((size_t)(((d2 * 2 + b) * 8 + h) * NCH + chain_pos(d2, cn))) * 8192;
                  *(f32x4*)(sp2 + e4) = *(const LAS f32x4*)(St + d2 * 8192 + e4); } }
#elif SB16
            { unsigned* sp16 = (unsigned*)Sb + ((size_t)(((dir * 2 + b) * 8 + h) * NCH + chain_pos(dir, cn))) * 4096;
              const int odd = r32 & 1;
#pragma unroll
              for (int r = 0; r < 16; ++r) {
                  const float p0 = dpp_f(S0[r], 0), p1 = dpp_f(S1[r], 0);
                  const unsigned w = odd ? cvtpk(p1, S1[r]) : cvtpk(S0[r], p0);
                  sp16[(size_t)((odd ? 32 : 0) + crow(r, hi)) * 64 + 16 * nb + (r32 >> 1)] = w; } }
#else
            float* sp = Sb + ((size_t)(((dir * 2 + b) * 8 + h) * NCH + chain_pos(dir, cn))) * 8192;
#pragma unroll
            for (int r = 0; r < 16; ++r) { if (SVAR == 3) { asm volatile("" :: "v"(S0[r]), "v"(S1[r])); } else if (S1_NT) { __builtin_nontemporal_store(S0[r], sp + (size_t)crow(r, hi) * 128 + 32 * nb + r32); __builtin_nontemporal_store(S1[r], sp + (size_t)(32 + crow(r, hi)) * 128 + 32 * nb + r32); } else { sp[(size_t)crow(r, hi) * 128 + 32 * nb + r32] = S0[r]; sp[(size_t)(32 + crow(r, hi)) * 128 + 32 * nb + r32] = S1[r]; } }
#endif
        }
        }
        __syncthreads();
    }
}

__device__ __forceinline__ void ssd_scan_phase(Frame& F, const Params& P) {
    unsigned char* ws = fresh_ws(P.ws);
    bf16* Hp = (bf16*)(ws + WS_HP); const float* tot = (const float*)(ws + WS_TOT);
    const Lane L(F.wave);
#if SB16
    const unsigned* Sb = (const unsigned*)(ws + WS_SB);
    for (int e = F.vcu * 512 + L.tid; e < 32 * 4096; e += F.G * 512) {
        const int chain = e >> 12, idx = e & 4095;
        const unsigned* sp = Sb + (size_t)chain * NCH * 4096 + idx; unsigned* hp = (unsigned*)Hp + (size_t)chain * NCH * 4096 + idx; const float* tp = tot + chain * NCH;
        float H0 = 0.f, H1 = 0.f;
        for (int i0 = 0; i0 < NCH; i0 += S2_DEPTH) {
            unsigned sv[S2_DEPTH]; float dv[S2_DEPTH];
#pragma unroll
            for (int q = 0; q < S2_DEPTH; ++q) { sv[q] = sp[(size_t)(i0 + q) * 4096]; dv[q] = __expf(tp[i0 + q]); }
#pragma unroll
            for (int q = 0; q < S2_DEPTH; ++q) { hp[(size_t)(i0 + q) * 4096] = cvtpk(H0, H1); H0 = dv[q] * H0 + bflo(sv[q]); H1 = dv[q] * H1 + bfhi(sv[q]); }
        }
    }
#else
    const float* Sb = (const float*)(ws + WS_SB);
    for (int e = F.vcu * 512 + L.tid; e < 32 * 8192; e += F.G * 512) {
        const int chain = e >> 13, idx = e & 8191;
        const float* sp = Sb + (size_t)chain * NCH * 8192 + idx; bf16* hp = Hp + (size_t)chain * NCH * 8192 + idx; const float* tp = tot + chain * NCH;
        float H = 0.f;
        for (int i0 = 0; i0 < NCH; i0 += 6) {
            float sv[6], dv[6];
#pragma unroll
            for (int q = 0; q < 6; ++q) { sv[q] = sp[(size_t)(i0 + q) * 8192]; dv[q] = __expf(tp[i0 + q]); }
#pragma unroll
            for (int q = 0; q < 6; ++q) { hp[(size_t)(i0 + q) * 8192] = (bf16)f2bf(H); H = dv[q] * H + sv[q]; }
        }
    }
#endif
}

__device__ __forceinline__ void ssd_out_phase(Frame& F, const Params& P, int layer) {
    unsigned char* ws = fresh_ws(P.ws);
    const bf16* xbcc = (const bf16*)(ws + WS_XBCC); const bf16* zb = (const bf16*)(ws + WS_Z); const float* yd = (const float*)(ws + WS_YD); const float* cumb = (const float*)(ws + WS_CUM);
    const bf16* Hp = (const bf16*)(ws + WS_HP); bf16* cat = (bf16*)(ws + WS_CAT);
    constexpr int YS = 260;
    LAS bf16* Cs = (LAS bf16*)(F.lds); LAS float* ec = (LAS float*)(F.lds + 34816); LAS float* Yl = (LAS float*)(F.lds + 34816 + 4096);
    const int wave = F.wave;
    for (int uid = (layer == 1 ? 8 : 0) + F.vcu; uid < NCH * NB * 2; uid += F.G) {
        const int tid = fresh_tid(F.wave), lane = tid & 63, r32 = lane & 31, hi = lane >> 5;
        const int g = uid & 1, b = (uid >> 1) & 1, cn = uid >> 2;
        const int row0 = cn < 2 ? NLAT + b * CTXL + 128 * cn : b * SEQ + 128 * (cn - 2);
#pragma unroll
        for (int i = 0; i < 4; ++i) { const int q = tid + 512 * i, s = q >> 4, c8 = (q & 15) * 8;
            *(LAS v4u*)(Cs + s * TS + c8) = *(const v4u*)(xbcc + (size_t)(row0 + s) * 1024 + 768 + g * 128 + c8); }
#pragma unroll
        for (int i = 0; i < 2; ++i) { const int idx = tid + 512 * i, hd = idx >> 7, s = idx & 127; ec[idx] = __expf(cumb[(size_t)(row0 + s) * 16 + (hd & 1) * 8 + 4 * g + (hd >> 1)]); }
        __syncthreads();
        const int hh = wave >> 1, cb = wave & 1, h = 4 * g + hh;
        f32x16 ys[4] = {};
        {
            bf16x8 Hf[2][8];
#pragma unroll
            for (int dir = 0; dir < 2; ++dir) {
                const bf16* hp = Hp + ((size_t)(((dir * 2 + b) * 8 + h) * NCH + chain_pos(dir, cn))) * 8192 + (size_t)(32 * cb + r32) * 128 + 8 * hi;
#pragma unroll
                for (int ks = 0; ks < 8; ++ks) Hf[dir][ks] = *(const bf16x8*)(hp + 16 * ks);
            }
#pragma unroll
            for (int rb = 0; rb < 4; ++rb) {
                bf16x8 af[8];
#pragma unroll
                for (int ks = 0; ks < 8; ++ks) af[ks] = *(const LAS bf16x8*)(Cs + (32 * rb + r32) * TS + 16 * ks + 8 * hi);
#pragma unroll
                for (int dir = 0; dir < 2; ++dir) {
                    f32x16 a0 = {};
#pragma unroll
                    for (int ks = 0; ks < 8; ++ks) a0 = __builtin_amdgcn_mfma_f32_32x32x16_bf16(af[ks], Hf[dir][ks], a0, 0, 0, 0);
#pragma unroll
                    for (int r = 0; r < 16; ++r) ys[rb][r] += a0[r] * ec[(hh * 2 + dir) * 128 + 32 * rb + crow(r, hi)];
                }
                asm volatile("" ::: "memory");
            }
        }
        const int lane2 = fresh_tid(F.wave) & 63;
        const float dsk = P.in[I_SSDD][layer * 8 + 4 * g + (lane2 >> 4)];
        const f32x4 ng = *(const f32x4*)(P.in[I_SNORM] + layer * 512 + g * 256 + 4 * lane2);
#pragma unroll
        for (int half = 0; half < 2; ++half) {
#pragma unroll
            for (int rb2 = 0; rb2 < 2; ++rb2)
#pragma unroll
                for (int r = 0; r < 16; ++r) Yl[(32 * rb2 + crow(r, hi)) * YS + hh * 64 + 32 * cb + r32] = ys[2 * half + rb2][r];
            __syncthreads();
#pragma unroll 2
            for (int q = 0; q < 8; ++q) {
                const int rl = 8 * wave + q, row = row0 + 64 * half + rl;
                const f32x4 yo = *(const LAS f32x4*)(Yl + rl * YS + 4 * lane2);
#if YD16
                f32x4 ydv; { const v2u yw = *(const v2u*)((const unsigned short*)yd + (size_t)row * 512 + g * 256 + 4 * lane2);
                  ydv[0] = (float)__builtin_bit_cast(_Float16, (unsigned short)(yw.x & 0xffff)); ydv[1] = (float)__builtin_bit_cast(_Float16, (unsigned short)(yw.x >> 16));
                  ydv[2] = (float)__builtin_bit_cast(_Float16, (unsigned short)(yw.y & 0xffff)); ydv[3] = (float)__builtin_bit_cast(_Float16, (unsigned short)(yw.y >> 16)); }
#else
                const f32x4 ydv = *(const f32x4*)(yd + (size_t)row * 512 + g * 256 + 4 * lane2);
#endif
                const v2u xv = *(const v2u*)(xbcc + (size_t)row * 1024 + g * 256 + 4 * lane2), zv = *(const v2u*)(zb + (size_t)row * 512 + g * 256 + 4 * lane2);
                f32x4 u;
                u[0] = (yo[0] + ydv[0] + dsk * bflo(xv.x)) * silu_f(bflo(zv.x)); u[1] = (yo[1] + ydv[1] + dsk * bfhi(xv.x)) * silu_f(bfhi(zv.x));
                u[2] = (yo[2] + ydv[2] + dsk * bflo(xv.y)) * silu_f(bflo(zv.y)); u[3] = (yo[3] + ydv[3] + dsk * bfhi(xv.y)) * silu_f(bfhi(zv.y));
                const float ss = wave_sum((u[0] * u[0] + u[1] * u[1]) + (u[2] * u[2] + u[3] * u[3]));
                const float rstd = 1.0f / sqrtf(ss * (1.0f / 256.0f) + NORM_EPS);
                v2u o; o.x = cvtpk(u[0] * rstd * ng[0], u[1] * rstd * ng[1]); o.y = cvtpk(u[2] * rstd * ng[2], u[3] * rstd * ng[3]);
                *(v2u*)(cat + (size_t)row * D + 512 + g * 256 + 4 * lane2) = o;
            }
            __syncthreads();
        }
    }
}
namespace att {
constexpr int KVBLK = 64, LDQ = 1024, LDK = 1024;
constexpr float SCALE = 0.125f;
constexpr float THR = 8.f;
constexpr size_t SHM_V = KVBLK * 128 * 2, SHM_K = KVBLK * 128 * 2;
#define KSWZ(row, colB) ((row) * 256 + ((colB) ^ (((row) & 7) << 4)))
#define SBAR() __builtin_amdgcn_sched_barrier(0)
constexpr float THRL = 11.5f;
#if ATT_FP8
constexpr float WLO = 0.5f, WHI = 7.5f, WMID = 4.0f;
#else
constexpr float WLO = -THRL, WHI = THRL, WMID = 0.f;
#endif
typedef int v8i __attribute__((ext_vector_type(8)));
__device__ __forceinline__ float max3f(float a, float b, float c) { return __builtin_fmaxf(__builtin_fmaxf(a, b), c); }
#if ATT_NEGM
typedef f32x16 mref_t;
#define MREF_INIT f32x16{}
__device__ __forceinline__ f32x16 mref_acc(const mref_t& m) { return m; }
#else
typedef float mref_t;
#define MREF_INIT 0.f
__device__ __forceinline__ f32x16 mref_acc(const mref_t&) { return f32x16{}; }
#endif
template <bool DOEXP = true>
__device__ __forceinline__ void partialSM(f32x16& p0, f32x16& p1, mref_t& mref, float& alpha) {
  float pmax = max3f(p0[0], p0[1], p0[2]);
#pragma unroll
  for (int r = 3; r < 15; r += 2) pmax = max3f(pmax, p0[r], p0[r + 1]);
  pmax = max3f(pmax, p0[15], p1[0]);
#pragma unroll
  for (int r = 1; r < 15; r += 2) pmax = max3f(pmax, p1[r], p1[r + 1]);
  pmax = fmaxf(pmax, p1[15]);
  pmax = cross_max(pmax);
#if ATT_NEGM
  if (__builtin_expect(__all(pmax >= WLO && pmax <= WHI), 1)) { alpha = 1.f; }
  else {
    const float d = (pmax < WLO || pmax > WHI) ? pmax - WMID : 0.f;
    alpha = __builtin_amdgcn_exp2f(-d);
#pragma unroll
    for (int r = 0; r < 16; ++r) { p0[r] -= d; p1[r] -= d; mref[r] -= d; }
  }
#else
  if (__builtin_expect(__all(fabsf(pmax - mref) <= THRL), 1)) { alpha = 1.f; }
  else { const float d = fabsf(pmax - mref) > THRL ? pmax - mref : 0.f; alpha = __builtin_amdgcn_exp2f(-d); mref += d; }
#pragma unroll
  for (int r = 0; r < 16; ++r) { p0[r] -= mref; p1[r] -= mref; }
#endif
  if constexpr (DOEXP) {
#pragma unroll
  for (int r = 0; r < 16; ++r) p0[r] = __builtin_amdgcn_exp2f(p0[r]);
  }
}
__device__ __forceinline__ void finishSM(f32x16& p0, f32x16& p1, float alpha, float& l_reg, bf16x8& pa0, bf16x8& pa1, bf16x8& pa2, bf16x8& pa3) {
#pragma unroll
  for (int r = 0; r < 16; ++r) p1[r] = __builtin_amdgcn_exp2f(p1[r]);
#if !ATT_LMFMA
  float ps = 0;
#pragma unroll
  for (int r = 0; r < 16; ++r) ps += p0[r];
#pragma unroll
  for (int r = 0; r < 16; ++r) ps += p1[r];
  ps = cross_sum(ps);
  l_reg = l_reg * alpha + ps;
#else
  (void)alpha; (void)l_reg;
#endif
#define PK4(P, BASE, OUT) do { unsigned a0 = cvtpk(P[BASE + 0], P[BASE + 1]), a1 = cvtpk(P[BASE + 2], P[BASE + 3]);   \
    unsigned b0 = cvtpk(P[BASE + 4], P[BASE + 5]), b1 = cvtpk(P[BASE + 6], P[BASE + 7]);                              \
    if (!ATT_NOSWAP) { swap32u(a0, b0); swap32u(a1, b1); } \
    v4u w = {a0, a1, b0, b1}; OUT = __builtin_bit_cast(bf16x8, w); } while (0)
  PK4(p0, 0, pa0); PK4(p0, 8, pa1); PK4(p1, 0, pa2); PK4(p1, 8, pa3);
#undef PK4
}

#if ATT_FP8
__device__ __forceinline__ void finishSM8(f32x16& p0, f32x16& p1, float alpha, float& l_reg, v8i& P8) {
#pragma unroll
  for (int r = 0; r < 16; ++r) p1[r] = __builtin_amdgcn_exp2f(p1[r]);
  float ps = 0;
#pragma unroll
  for (int r = 0; r < 16; ++r) ps += p0[r];
#pragma unroll
  for (int r = 0; r < 16; ++r) ps += p1[r];
  ps = cross_sum(ps);
  l_reg = l_reg * alpha + ps;
#pragma unroll
  for (int w = 0; w < 4; ++w) {
    P8[w]     = __builtin_amdgcn_cvt_pk_fp8_f32(p0[4 * w + 2], p0[4 * w + 3], __builtin_amdgcn_cvt_pk_fp8_f32(p0[4 * w], p0[4 * w + 1], 0, false), true);
    P8[4 + w] = __builtin_amdgcn_cvt_pk_fp8_f32(p1[4 * w + 2], p1[4 * w + 3], __builtin_amdgcn_cvt_pk_fp8_f32(p1[4 * w], p1[4 * w + 1], 0, false), true);
  }
}
__device__ __forceinline__ void pv8(f32x16* o, const LAS char* vb, const v8i& P8) {
  v4u lo[4], hh[4];
#pragma unroll
  for (int d0 = 0; d0 < 4; ++d0) { lo[d0] = *(const LAS v4u*)(vb + d0 * 2048); hh[d0] = *(const LAS v4u*)(vb + d0 * 2048 + 512); }
#pragma unroll
  for (int d0 = 0; d0 < 4; ++d0) {
    v8i B; B[0] = (int)lo[d0].x; B[1] = (int)lo[d0].y; B[2] = (int)lo[d0].z; B[3] = (int)lo[d0].w; B[4] = (int)hh[d0].x; B[5] = (int)hh[d0].y; B[6] = (int)hh[d0].z; B[7] = (int)hh[d0].w;
    o[d0] = __builtin_amdgcn_mfma_scale_f32_32x32x64_f8f6f4(P8, B, o[d0], 0, 0, 0, 0x7F7F7F7F, 0, 0x7F7F7F7F);
  }
}
__device__ __forceinline__ void pv8_exp(f32x16* o, const LAS char* vb, const v8i& P8, f32x16& pn) {
  v4u lo[4], hh[4];
#pragma unroll
  for (int d0 = 0; d0 < 4; ++d0) { lo[d0] = *(const LAS v4u*)(vb + d0 * 2048); hh[d0] = *(const LAS v4u*)(vb + d0 * 2048 + 512); }
  asm volatile("s_waitcnt lgkmcnt(0)" ::: "memory"); SBAR();
#pragma unroll
  for (int d0 = 0; d0 < 4; ++d0) {
    v8i B; B[0] = (int)lo[d0].x; B[1] = (int)lo[d0].y; B[2] = (int)lo[d0].z; B[3] = (int)lo[d0].w; B[4] = (int)hh[d0].x; B[5] = (int)hh[d0].y; B[6] = (int)hh[d0].z; B[7] = (int)hh[d0].w;
    o[d0] = __builtin_amdgcn_mfma_scale_f32_32x32x64_f8f6f4(P8, B, o[d0], 0, 0, 0, 0x7F7F7F7F, 0, 0x7F7F7F7F);
#pragma unroll
    for (int r = 0; r < 4; ++r) pn[4 * d0 + r] = __builtin_amdgcn_exp2f(pn[4 * d0 + r]);
  }
  asm volatile("" :: "v"(pn[0]), "v"(pn[1]), "v"(pn[2]), "v"(pn[3]), "v"(pn[4]), "v"(pn[5]), "v"(pn[6]), "v"(pn[7]), "v"(pn[8]), "v"(pn[9]), "v"(pn[10]), "v"(pn[11]), "v"(pn[12]), "v"(pn[13]), "v"(pn[14]), "v"(pn[15]));
#pragma unroll
  for (int d0 = 0; d0 < 4; ++d0) { __builtin_amdgcn_sched_group_barrier(0x008, 1, 0); __builtin_amdgcn_sched_group_barrier(PVX_MASK, 4, 0); }
  SBAR();
}

constexpr float YB = 56.0f + Y8_C, YLO = 8.0f * WLO + YB, YHI = 8.0f * WHI + YB, YMID = 8.0f * WMID + YB;
__device__ __forceinline__ void partialSMY(f32x16& p0, f32x16& p1, mref_t& mref, float& alpha) {
  float pmax = max3f(p0[0], p0[1], p0[2]);
#pragma unroll
  for (int r = 3; r < 15; r += 2) pmax = max3f(pmax, p0[r], p0[r + 1]);
  pmax = max3f(pmax, p0[15], p1[0]);
#pragma unroll
  for (int r = 1; r < 15; r += 2) pmax = max3f(pmax, p1[r], p1[r + 1]);
  pmax = fmaxf(pmax, p1[15]);
  pmax = cross_max(pmax);
  if (__builtin_expect(__all(pmax >= YLO && pmax <= YHI), 1)) { alpha = 1.f; }
  else {
    const float d = (pmax < YLO || pmax > YHI) ? 8.0f * __builtin_rintf((pmax - YMID) * 0.125f) : 0.f;
    alpha = __builtin_amdgcn_exp2f(-0.125f * d);
#pragma unroll
    for (int r = 0; r < 16; ++r) { p0[r] -= d; p1[r] -= d; mref[r] -= d; }
  }
}
__device__ __forceinline__ void finishSMY(const f32x16& p0, const f32x16& p1, v8i& P8) {
#pragma unroll
  for (int w = 0; w < 4; ++w) {
    unsigned a = 0u, b = 0u;
#pragma unroll
    for (int i = 0; i < 4; ++i) { a = __builtin_amdgcn_cvt_pk_u8_f32(p0[4 * w + i], (unsigned)i, a); b = __builtin_amdgcn_cvt_pk_u8_f32(p1[4 * w + i], (unsigned)i, b); }
    P8[w] = (int)a; P8[4 + w] = (int)b;
  }
}
__device__ __forceinline__ void pv8s(f32x16* o, f32x16& lacc, const LAS char* vb, const v8i& P8) {
  v4u lo[4], hh[4];
#pragma unroll
  for (int d0 = 0; d0 < 4; ++d0) { lo[d0] = *(const LAS v4u*)(vb + d0 * 2048); hh[d0] = *(const LAS v4u*)(vb + d0 * 2048 + 512); }
  if (ATT_PRIO) __builtin_amdgcn_s_setprio(1);
  { const v8i ones = {0x38383838, 0x38383838, 0x38383838, 0x38383838, 0x38383838, 0x38383838, 0x38383838, 0x38383838};
    lacc = __builtin_amdgcn_mfma_scale_f32_32x32x64_f8f6f4(P8, ones, lacc, 0, 0, 0, 0x7F7F7F7F, 0, 0x7F7F7F7F); }
#pragma unroll
  for (int d0 = 0; d0 < 4; ++d0) {
    v8i B; B[0] = (int)lo[d0].x; B[1] = (int)lo[d0].y; B[2] = (int)lo[d0].z; B[3] = (int)lo[d0].w; B[4] = (int)hh[d0].x; B[5] = (int)hh[d0].y; B[6] = (int)hh[d0].z; B[7] = (int)hh[d0].w;
    o[d0] = __builtin_amdgcn_mfma_scale_f32_32x32x64_f8f6f4(P8, B, o[d0], 0, 0, 0, 0x7F7F7F7F, 0, 0x7F7F7F7F);
  }
  if (ATT_PRIO) __builtin_amdgcn_s_setprio(0);
}
#endif
__device__ __forceinline__ void qkt(f32x16& p0, f32x16& p1, const LAS char* Ks, const bf16x8* qr, int r32, int hi, int map, const mref_t& negm) {
  p0 = mref_acc(negm); p1 = p0;
#pragma unroll
  for (int d0 = 0; d0 < 4; ++d0) { int cb = (map * 64 + d0 * 16 + hi * 8) * 2;
    bf16x8 b0 = *(const LAS bf16x8*)(Ks + KSWZ(r32, cb));
    bf16x8 b1 = *(const LAS bf16x8*)(Ks + KSWZ(32 + r32, cb));
    p0 = __builtin_amdgcn_mfma_f32_32x32x16_bf16(b0, qr[d0], p0, 0, 0, 0);
    p1 = __builtin_amdgcn_mfma_f32_32x32x16_bf16(b1, qr[d0], p1, 0, 0, 0); }
}
#if ATT_NOSWAP
__device__ __forceinline__ int v_st(int k, int c) { return ((k >> 3) * 4 + (c >> 5)) * 512 + ((k & 7) * 32 + (c & 31)) * 2; }
#else
__device__ __forceinline__ int v_st(int k, int c) { const int kk = (k & ~0xC) | ((k & 4) << 1) | ((k & 8) >> 1); return ((kk >> 3) * 4 + (c >> 5)) * 512 + ((kk & 7) * 32 + (c & 31)) * 2; }
#endif
__device__ __forceinline__ int v_rd_base(int lane) { return ((lane & 3) << 3) | (((lane >> 2) & 3) << 6) | (((lane >> 4) & 1) << 5) | (((lane >> 5) & 1) << 8); }
constexpr int v_rd_off(int d0, int ks, int half) { return d0 * 512 + ks * 4096 + half * 2048; }
template <int OFF> __device__ __forceinline__ s16x4 tr_read(int vb) {
  s16x4 r; asm volatile("ds_read_b64_tr_b16 %0, %1 offset:%2" : "=&v"(r) : "v"(vb), "i"(OFF) : "memory"); return r;
}
struct VG { s16x4 l0, h0, l1, h1, l2, h2, l3, h3; };
template <int D0> __device__ __forceinline__ void pv_load(VG& g, int vb) {
  g.l0 = tr_read<v_rd_off(D0, 0, 0)>(vb); g.h0 = tr_read<v_rd_off(D0, 0, 1)>(vb); g.l1 = tr_read<v_rd_off(D0, 1, 0)>(vb); g.h1 = tr_read<v_rd_off(D0, 1, 1)>(vb);
  g.l2 = tr_read<v_rd_off(D0, 2, 0)>(vb); g.h2 = tr_read<v_rd_off(D0, 2, 1)>(vb); g.l3 = tr_read<v_rd_off(D0, 3, 0)>(vb); g.h3 = tr_read<v_rd_off(D0, 3, 1)>(vb);
}
__device__ __forceinline__ void pv_mma(f32x16& od, const VG& g, bf16x8 pa0, bf16x8 pa1, bf16x8 pa2, bf16x8 pa3) {
#define PK(L, H) (bf16x8){L[0], L[1], L[2], L[3], H[0], H[1], H[2], H[3]}
  od = __builtin_amdgcn_mfma_f32_32x32x16_bf16(pa0, PK(g.l0, g.h0), od, 0, 0, 0);
  od = __builtin_amdgcn_mfma_f32_32x32x16_bf16(pa1, PK(g.l1, g.h1), od, 0, 0, 0);
  od = __builtin_amdgcn_mfma_f32_32x32x16_bf16(pa2, PK(g.l2, g.h2), od, 0, 0, 0);
  od = __builtin_amdgcn_mfma_f32_32x32x16_bf16(pa3, PK(g.l3, g.h3), od, 0, 0, 0);
#undef PK
}
__device__ __forceinline__ void pv_d0(f32x16* o, int vb, bf16x8 pa0, bf16x8 pa1, bf16x8 pa2, bf16x8 pa3, f32x16& lacc) {
#if ATT_LMFMA
  { const bf16x8 ones = {0x3F80, 0x3F80, 0x3F80, 0x3F80, 0x3F80, 0x3F80, 0x3F80, 0x3F80};
    lacc = __builtin_amdgcn_mfma_f32_32x32x16_bf16(pa0, ones, lacc, 0, 0, 0); lacc = __builtin_amdgcn_mfma_f32_32x32x16_bf16(pa1, ones, lacc, 0, 0, 0);
    lacc = __builtin_amdgcn_mfma_f32_32x32x16_bf16(pa2, ones, lacc, 0, 0, 0); lacc = __builtin_amdgcn_mfma_f32_32x32x16_bf16(pa3, ones, lacc, 0, 0, 0); }
#endif
#if ATT_PVPF
  VG ga, gb;
  pv_load<0>(ga, vb); pv_load<1>(gb, vb);
  asm volatile("s_waitcnt lgkmcnt(8)" ::: "memory"); SBAR(); pv_mma(o[0], ga, pa0, pa1, pa2, pa3);
  pv_load<2>(ga, vb);
  asm volatile("s_waitcnt lgkmcnt(8)" ::: "memory"); SBAR(); pv_mma(o[1], gb, pa0, pa1, pa2, pa3);
  pv_load<3>(gb, vb);
  asm volatile("s_waitcnt lgkmcnt(8)" ::: "memory"); SBAR(); pv_mma(o[2], ga, pa0, pa1, pa2, pa3);
  asm volatile("s_waitcnt lgkmcnt(0)" ::: "memory"); SBAR(); pv_mma(o[3], gb, pa0, pa1, pa2, pa3);
#else
  VG g;
  pv_load<0>(g, vb); asm volatile("s_waitcnt lgkmcnt(0)" ::: "memory"); SBAR(); pv_mma(o[0], g, pa0, pa1, pa2, pa3);
  pv_load<1>(g, vb); asm volatile("s_waitcnt lgkmcnt(0)" ::: "memory"); SBAR(); pv_mma(o[1], g, pa0, pa1, pa2, pa3);
  pv_load<2>(g, vb); asm volatile("s_waitcnt lgkmcnt(0)" ::: "memory"); SBAR(); pv_mma(o[2], g, pa0, pa1, pa2, pa3);
  pv_load<3>(g, vb); asm volatile("s_waitcnt lgkmcnt(0)" ::: "memory"); SBAR(); pv_mma(o[3], g, pa0, pa1, pa2, pa3);
#endif
}
template <int VAR>
__device__ __forceinline__ void diff_attn_unit(const bf16* __restrict__ Qb, const bf16* __restrict__ Kh, const bf16* __restrict__ Vh, bf16* __restrict__ Ob, int seq, LAS char* lds,
                                               float lam, const float* gsub, float oscale, const int wave, const unsigned char* V8h, const unsigned char* q8base = nullptr) {
  const int tid = fresh_tid(wave), wid = tid >> 6, lane = tid & 63, r32 = lane & 31, hi = lane >> 5, map = wid >> 2, wq = wid & 3;
  constexpr int BUFB = (int)(SHM_V + SHM_K), WSF_OFF = RING_BYTES + 1024;
  LAS float* wsf = (LAS float*)(lds + WSF_OFF) + wid * 64; LAS float* li_l = wsf; LAS float* al_l = wsf + 32;
  float l_reg = 0; f32x16 o[4], lacc; mref_t negm = MREF_INIT; bf16x8 qr[4];
  { float zf_ = 0.f; asm volatile("" : "+v"(zf_));
#pragma unroll
    for (int r = 0; r < 16; ++r) { lacc[r] = zf_; o[0][r] = zf_; o[1][r] = zf_; o[2][r] = zf_; o[3][r] = zf_; } }
  const bf16* Qw = Qb + (long)(wq * 32 + r32) * LDQ + map * 64 + hi * 8;
#pragma unroll
  for (int d0 = 0; d0 < 4; ++d0) { const v4u w = *reinterpret_cast<const v4u*>(Qw + d0 * 16); constexpr float C = SCALE * 1.4426950408889634f;
    v4u q; q.x = cvtpk(bflo(w.x) * C, bfhi(w.x) * C); q.y = cvtpk(bflo(w.y) * C, bfhi(w.y) * C); q.z = cvtpk(bflo(w.z) * C, bfhi(w.z) * C); q.w = cvtpk(bflo(w.w) * C, bfhi(w.w) * C);
    qr[d0] = __builtin_bit_cast(bf16x8, q); }
#if ATT_DMA && ATT_FP8 && ATT_QK8
  constexpr int TB = 16384, LEAD = ATT_LEAD, NBUF = LEAD > 2 ? 8 : 4;
  const unsigned pcoff = (unsigned)(wid * 1024 + lane * 16);
  const LAS char* vrd = lds + hi * 1024 + r32 * 16;
  const LAS char* krd = lds + 8192 + (map * 2 + hi) * 2048 + r32 * 16;
  v8i P8, Q8;
#if Q8_DIRECT
  {
    const unsigned char* q8b = (const unsigned char*)q8base; const long off_ = (const unsigned char*)Qb - q8b; const int row_ = (int)(off_ >> 10) + wq * 32 + r32, hcol_ = (int)(off_ & 1023) + map * 64 + hi * 32;
    const unsigned char* q8 = q8b + (size_t)(row_ >> 4) * 16384 + (size_t)(hcol_ >> 3) * 128 + (row_ & 15) * 8;
    const v2u a_ = *(const v2u*)q8, b_ = *(const v2u*)(q8 + 128), c_ = *(const v2u*)(q8 + 256), d_ = *(const v2u*)(q8 + 384);
    Q8 = (v8i){(int)a_.x, (int)a_.y, (int)b_.x, (int)b_.y, (int)c_.x, (int)c_.y, (int)d_.x, (int)d_.y}; }
#else
  { constexpr float C = SCALE * 1.4426950408889634f * (ATT_Y8 ? 8.0f : 1.0f); const bf16* qp = Qb + (long)(wq * 32 + r32) * LDQ + map * 64 + hi * 32;
#pragma unroll
    for (int w4 = 0; w4 < 4; ++w4) { float a[8]; ld8f(qp + 8 * w4, a);
      Q8[2 * w4]     = __builtin_amdgcn_cvt_pk_fp8_f32(a[2] * C, a[3] * C, __builtin_amdgcn_cvt_pk_fp8_f32(a[0] * C, a[1] * C, 0, false), true);
      Q8[2 * w4 + 1] = __builtin_amdgcn_cvt_pk_fp8_f32(a[6] * C, a[7] * C, __builtin_amdgcn_cvt_pk_fp8_f32(a[4] * C, a[5] * C, 0, false), true); } }
#endif
  const unsigned char* K8h = V8h + (WS_K8 - WS_V8);
#define DMA(t_) do { const int bo_ = ((t_) & (NBUF - 1)) * TB; \
    __builtin_amdgcn_global_load_lds((const unsigned*)(V8h + (size_t)(t_) * 65536 + pcoff), (LAS unsigned*)(lds + bo_ + wid * 1024), 16, 0, 0); \
    __builtin_amdgcn_global_load_lds((const unsigned*)(K8h + (size_t)(t_) * 65536 + pcoff), (LAS unsigned*)(lds + bo_ + 8192 + wid * 1024), 16, 0, 0); } while (0)
#define RESC(a) do { if (__any((a) != 1.f)) { if (hi == 0) al_l[r32] = (a); asm volatile("s_waitcnt lgkmcnt(0)" ::: "memory"); \
    _Pragma("unroll") for (int r = 0; r < 16; ++r) { const float a_ = al_l[crow(r, hi)]; lacc[r] *= a_; _Pragma("unroll") for (int d = 0; d < 4; ++d) o[d][r] *= a_; } } } while (0)
#define TBAR() do { asm volatile("s_waitcnt lgkmcnt(0)" ::: "memory"); __builtin_amdgcn_s_barrier(); asm volatile("" ::: "memory"); } while (0)
#if ATT_KPF || ATT_P2
  v8i kfa, kfb;
#define KLOAD(t_) do { const LAS char* kb_ = krd + ((t_) & (NBUF - 1)) * TB; \
    const v4u k0l = *(const LAS v4u*)(kb_), k0h = *(const LAS v4u*)(kb_ + 1024), k1l = *(const LAS v4u*)(kb_ + 512), k1h = *(const LAS v4u*)(kb_ + 1536); \
    kfa = (v8i){(int)k0l.x, (int)k0l.y, (int)k0l.z, (int)k0l.w, (int)k0h.x, (int)k0h.y, (int)k0h.z, (int)k0h.w}; kfb = (v8i){(int)k1l.x, (int)k1l.y, (int)k1l.z, (int)k1l.w, (int)k1h.x, (int)k1h.y, (int)k1h.z, (int)k1h.w}; } while (0)
#define QK8(P0, P1, t_) do { \
    P0 = __builtin_amdgcn_mfma_scale_f32_32x32x64_f8f6f4(kfa, Q8, mref_acc(negm), 0, 0, 0, 0x7F7F7F7F, 0, 0x7F7F7F7F); \
    P1 = __builtin_amdgcn_mfma_scale_f32_32x32x64_f8f6f4(kfb, Q8, mref_acc(negm), 0, 0, 0, 0x7F7F7F7F, 0, 0x7F7F7F7F); \
    SBAR(); if ((t_) + 1 < NT) KLOAD((t_) + 1); } while (0)
#else
#define KLOAD(t_) do {} while (0)
#define QK8(P0, P1, t_) do { const LAS char* kb_ = krd + ((t_) & (NBUF - 1)) * TB; \
    const v4u k0l = *(const LAS v4u*)(kb_), k0h = *(const LAS v4u*)(kb_ + 1024), k1l = *(const LAS v4u*)(kb_ + 512), k1h = *(const LAS v4u*)(kb_ + 1536); \
    v8i ka_ = {(int)k0l.x, (int)k0l.y, (int)k0l.z, (int)k0l.w, (int)k0h.x, (int)k0h.y, (int)k0h.z, (int)k0h.w}, kb2_ = {(int)k1l.x, (int)k1l.y, (int)k1l.z, (int)k1l.w, (int)k1h.x, (int)k1h.y, (int)k1h.z, (int)k1h.w}; \
    P0 = __builtin_amdgcn_mfma_scale_f32_32x32x64_f8f6f4(ka_, Q8, mref_acc(negm), 0, 0, 0, 0x7F7F7F7F, 0, 0x7F7F7F7F); \
    P1 = __builtin_amdgcn_mfma_scale_f32_32x32x64_f8f6f4(kb2_, Q8, mref_acc(negm), 0, 0, 0, 0x7F7F7F7F, 0, 0x7F7F7F7F); } while (0)
#endif
  f32x16 pA0, pA1, pB0, pB1; float alA, alB; const int NT = seq / KVBLK;
  (void)qr; (void)Qw;
#if ATT_Y8
  { float yb_ = YB; asm volatile("" : "+v"(yb_));
#pragma unroll
    for (int r = 0; r < 16; ++r) negm[r] = yb_; }
#define PSM(P0, P1, AL) partialSMY(P0, P1, negm, AL)
#else
#define PSM(P0, P1, AL) partialSM(P0, P1, negm, AL)
#endif
#define VMW(n) asm volatile("s_waitcnt vmcnt(%0)" :: "n"(n) : "memory")
#if ATT_Y8 && ATT_P2
  static_assert(LEAD == 5 && NBUF == 8, "pipeline v2");
  v8i vf[4]; float al2;
#define VLOAD(t_) do { const LAS char* vb_ = vrd + ((t_) & (NBUF - 1)) * TB; _Pragma("unroll") for (int d0 = 0; d0 < 4; ++d0) { const v4u l_ = *(const LAS v4u*)(vb_ + d0 * 2048), h_ = *(const LAS v4u*)(vb_ + d0 * 2048 + 512); \
    vf[d0] = (v8i){(int)l_.x, (int)l_.y, (int)l_.z, (int)l_.w, (int)h_.x, (int)h_.y, (int)h_.z, (int)h_.w}; } } while (0)
#define QKM() do { pA0 = __builtin_amdgcn_mfma_scale_f32_32x32x64_f8f6f4(kfa, Q8, mref_acc(negm), 0, 0, 0, 0x7F7F7F7F, 0, 0x7F7F7F7F); \
    pA1 = __builtin_amdgcn_mfma_scale_f32_32x32x64_f8f6f4(kfb, Q8, mref_acc(negm), 0, 0, 0, 0x7F7F7F7F, 0, 0x7F7F7F7F); } while (0)
#define PVM() do { { int on_ = 0x38383838; asm volatile("" : "+v"(on_)); const v8i ones_ = {on_, on_, on_, on_, on_, on_, on_, on_}; \
      lacc = __builtin_amdgcn_mfma_scale_f32_32x32x64_f8f6f4(P8, ones_, lacc, 0, 0, 0, 0x7F7F7F7F, 0, 0x7F7F7F7F); } \
    _Pragma("unroll") for (int d0 = 0; d0 < 4; ++d0) o[d0] = __builtin_amdgcn_mfma_scale_f32_32x32x64_f8f6f4(P8, vf[d0], o[d0], 0, 0, 0, 0x7F7F7F7F, 0, 0x7F7F7F7F); } while (0)
#define STEP(j) do { SBAR(); if (!P2_KPF) KLOAD(j); if (!P2_VPF) VLOAD((j) - 1); asm volatile("s_waitcnt lgkmcnt(0)" ::: "memory"); QKM(); PVM(); SBAR(); \
    if (P2_KPF) { if ((j) + 1 < NT) KLOAD((j) + 1); } if (P2_VPF) VLOAD(j); SBAR(); \
    partialSMY(pA0, pA1, negm, al2); RESC(al2); finishSMY(pA0, pA1, P8); } while (0)
#pragma unroll
  for (int t = 0; t <= LEAD; ++t) if (t < NT) DMA(t);
  if (LEAD < NT) VMW(2 * (LEAD - 1)); else VMW(0);
  TBAR();
#if P2_AB
  auto run_ = [&](auto G_) __attribute__((always_inline)) { constexpr int GRP = decltype(G_)::value;
  KLOAD(0); asm volatile("s_waitcnt lgkmcnt(0)" ::: "memory"); QKM(); SBAR();
  if constexpr (GRP == 0) { partialSMY(pA0, pA1, negm, al2); finishSMY(pA0, pA1, P8); }
  if (LEAD < NT) VMW(2 * (LEAD - 3)); else VMW(0);
  TBAR();
#define STEPB(j) do { SBAR(); partialSMY(pA0, pA1, negm, al2); RESC(al2); finishSMY(pA0, pA1, P8); SBAR(); \
    KLOAD(j); asm volatile("s_waitcnt lgkmcnt(0)" ::: "memory"); QKM(); SBAR(); VLOAD((j) - 1); asm volatile("s_waitcnt lgkmcnt(0)" ::: "memory"); PVM(); SBAR(); } while (0)
  if constexpr (GRP == 0) {
    for (int j = 1; j + 1 < NT; j += 2) {
      if (j + LEAD < NT) DMA(j + LEAD); if (j + LEAD + 1 < NT) DMA(j + LEAD + 1);
      STEP(j); STEP(j + 1);
      if (j + LEAD + 1 < NT) VMW(2 * (LEAD - 3)); else VMW(0); TBAR();
    }
    STEP(NT - 1);
  } else {
    for (int j = 1; j + 1 < NT; j += 2) {
      if (j + LEAD < NT) DMA(j + LEAD); if (j + LEAD + 1 < NT) DMA(j + LEAD + 1);
      STEPB(j); STEPB(j + 1);
      if (j + LEAD + 1 < NT) VMW(2 * (LEAD - 3)); else VMW(0); TBAR();
    }
    STEPB(NT - 1);
    partialSMY(pA0, pA1, negm, al2); RESC(al2); finishSMY(pA0, pA1, P8);
  }
  VLOAD(NT - 1);
  asm volatile("s_waitcnt lgkmcnt(0)" ::: "memory"); PVM();
#undef STEPB
#else
  KLOAD(0); asm volatile("s_waitcnt lgkmcnt(0)" ::: "memory"); QKM(); SBAR(); if (P2_KPF) KLOAD(1); if (P2_VPF) VLOAD(0); SBAR();
  partialSMY(pA0, pA1, negm, al2); finishSMY(pA0, pA1, P8);
  if (LEAD < NT) VMW(2 * (LEAD - 3)); else VMW(0);
  TBAR();
  for (int j = 1; j + 1 < NT; j += 2) {
    if (j + LEAD < NT) DMA(j + LEAD); if (j + LEAD + 1 < NT) DMA(j + LEAD + 1);
    STEP(j);
    STEP(j + 1);
    if (j + LEAD + 1 < NT) VMW(2 * (LEAD - 3)); else VMW(0); TBAR();
  }
  STEP(NT - 1);
  if (!P2_VPF) VLOAD(NT - 1);
  asm volatile("s_waitcnt lgkmcnt(0)" ::: "memory"); PVM();
#endif
  (void)pB0; (void)pB1; (void)alA; (void)alB;
#undef STEP
#undef PVM
#undef QKM
#undef VLOAD
#elif ATT_Y8 && ATT_AB
  static_assert(LEAD == 5 && NBUF == 8, "anti-phase schedule");
#pragma unroll
  for (int t = 0; t <= LEAD; ++t) if (t < NT) DMA(t);
  if (LEAD < NT) VMW(2 * LEAD); else VMW(0);
  TBAR();
  QK8(pA0, pA1, 0); PSM(pA0, pA1, alA);
  if (LEAD < NT) VMW(2 * (LEAD - 3)); else VMW(0);
  TBAR();
#define XCV(PO0, PO1, j) do { finishSMY(PO0, PO1, P8); SBAR(); pv8s(o, lacc, vrd + (((j) - 1) & (NBUF - 1)) * TB, P8); } while (0)
  if (map == 0) {
#define ITERA(j, PN0, PN1, ALN, PO0, PO1) do { SBAR(); QK8(PN0, PN1, j); XCV(PO0, PO1, j); partialSMY(PN0, PN1, negm, ALN); RESC(ALN); } while (0)
    for (int j = 1; j + 1 < NT; j += 2) {
      if (j + LEAD < NT) DMA(j + LEAD); if (j + LEAD + 1 < NT) DMA(j + LEAD + 1);
      ITERA(j, pB0, pB1, alB, pA0, pA1);
      ITERA(j + 1, pA0, pA1, alA, pB0, pB1);
      if (j + LEAD + 1 < NT) VMW(2 * (LEAD - 3)); else VMW(0); TBAR();
    }
    ITERA(NT - 1, pB0, pB1, alB, pA0, pA1);
#undef ITERA
  } else {
    QK8(pB0, pB1, 1);
#define ITERB(j, PN0, PN1, ALN, PO0, PO1) do { SBAR(); XCV(PO0, PO1, j); partialSMY(PN0, PN1, negm, ALN); RESC(ALN); SBAR(); if ((j) + 1 < NT) QK8(PO0, PO1, (j) + 1); } while (0)
    for (int j = 1; j + 1 < NT; j += 2) {
      if (j + LEAD < NT) DMA(j + LEAD); if (j + LEAD + 1 < NT) DMA(j + LEAD + 1);
      ITERB(j, pB0, pB1, alB, pA0, pA1);
      ITERB(j + 1, pA0, pA1, alA, pB0, pB1);
      if (j + LEAD + 1 < NT) VMW(2 * (LEAD - 3)); else VMW(0); TBAR();
    }
    ITERB(NT - 1, pB0, pB1, alB, pA0, pA1);
#undef ITERB
  }
  finishSMY(pB0, pB1, P8); SBAR();
  pv8s(o, lacc, vrd + ((NT - 1) & (NBUF - 1)) * TB, P8);
#undef XCV
#else
#pragma unroll
  for (int t = 0; t <= LEAD; ++t) if (t < NT) DMA(t);
  if (LEAD < NT) VMW(2 * (LEAD - ATT_KPF)); else VMW(0);
  TBAR();
  KLOAD(0);
  QK8(pA0, pA1, 0); PSM(pA0, pA1, alA);
  if (LEAD < NT) VMW(2 * (LEAD - 1 - ATT_BAR2 - ATT_KPF)); else VMW(0);
  TBAR();
#define ITER(j, PN0, PN1, ALN, PO0, PO1, ALO) do { \
    if (!ATT_BAR2) { if ((j) + LEAD < NT) DMA((j) + LEAD); } \
    SBAR(); if (!(ATT_STAG && map == 1)) QK8(PN0, PN1, j); \
    if (ATT_Y8) { if (VAR != 4) finishSMY(PO0, PO1, P8); SBAR(); \
        if (VAR == 2) { const LAS char* vb_ = vrd + (((j) - 1) & (NBUF - 1)) * TB; _Pragma("unroll") for (int d0 = 0; d0 < 4; ++d0) { const v4u l_ = *(const LAS v4u*)(vb_ + d0 * 2048), h_ = *(const LAS v4u*)(vb_ + d0 * 2048 + 512); asm volatile("" :: "v"(l_), "v"(h_)); } } \
        else if (VAR != 1) pv8s(o, lacc, vrd + (((j) - 1) & (NBUF - 1)) * TB, P8); \
        if (ATT_STAG && map == 1) { SBAR(); QK8(PN0, PN1, j); } \
        if (VAR != 5) partialSMY(PN0, PN1, negm, ALN); else ALN = 1.f; } \
    else { finishSM8(PO0, PO1, ALO, l_reg, P8); SBAR(); } \
    if (ATT_Y8) {} else if (ATT_PVX) { partialSM<false>(PN0, PN1, negm, ALN); SBAR(); pv8_exp(o, vrd + (((j) - 1) & (NBUF - 1)) * TB, P8, PN0); } \
    else { pv8(o, vrd + (((j) - 1) & (NBUF - 1)) * TB, P8); partialSM(PN0, PN1, negm, ALN); } \
    RESC(ALN); \
    if (!ATT_BAR2) { if ((j) + LEAD < NT) VMW(2 * (LEAD - 1)); else VMW(0); \
    TBAR(); } } while (0)
  for (int j = 1; j + 1 < NT; j += 2) {
    if (ATT_BAR2) { if (j + LEAD < NT) DMA(j + LEAD); if (j + LEAD + 1 < NT) DMA(j + LEAD + 1); }
    ITER(j, pB0, pB1, alB, pA0, pA1, alA);
    ITER(j + 1, pA0, pA1, alA, pB0, pB1, alB);
    if (ATT_BAR2) { if (j + LEAD + 1 < NT) VMW(2 * (LEAD - 2 - ATT_KPF)); else VMW(0); TBAR(); }
  }
  ITER(NT - 1, pB0, pB1, alB, pA0, pA1, alA);
#if ATT_Y8
  finishSMY(pB0, pB1, P8); SBAR();
  pv8s(o, lacc, vrd + ((NT - 1) & (NBUF - 1)) * TB, P8);
#else
  finishSM8(pB0, pB1, alB, l_reg, P8); SBAR();
  pv8(o, vrd + ((NT - 1) & (NBUF - 1)) * TB, P8);
#endif
#endif
#undef PSM
#undef VMW
#undef DMA
#undef TBAR
#undef QK8
#undef KLOAD
#undef ITER
#elif ATT_DMA && ATT_FP8
  const int vb0 = (int)(unsigned)(uintptr_t)lds + v_rd_base(lane);
  unsigned voffV[2], voffK[2];
#pragma unroll
  for (int t = 0; t < 2; ++t) { const int vi = wid * 2 + t, kg = vi >> 1, pair = vi & 1, sub = lane >> 5, row = (lane >> 2) & 7, chunk = lane & 3;
    voffV[t] = (unsigned)((8 * kg + row) * LDK + 32 * (2 * pair + sub) + 8 * chunk) * 2u;
    const int krow = 4 * vi + (lane >> 4), p = lane & 15;
    voffK[t] = (unsigned)(krow * LDK) * 2u + (unsigned)((p ^ (krow & 7)) * 16); }
  const int ldsw = wid * 2048; const unsigned v8off = (unsigned)(wid * 1024 + lane * 16); const LAS char* vrd = lds + hi * 1024 + r32 * 16; v8i P8;
  (void)voffV; (void)vb0;
#define DMA(t_) do { const char* vt_ = (const char*)(Vh + (size_t)(t_) * KVBLK * LDK); const char* kt_ = (const char*)(Kh + (size_t)(t_) * KVBLK * LDK); const int bo_ = ((t_) & 3) * BUFB; \
    _Pragma("unroll") for (int i_ = 0; i_ < 2; ++i_) { \
      __builtin_amdgcn_global_load_lds((const unsigned*)(kt_ + voffK[i_]), (LAS unsigned*)(lds + bo_ + (int)SHM_V + ldsw + i_ * 1024), 16, 0, 0); } \
    __builtin_amdgcn_global_load_lds((const unsigned*)(V8h + (size_t)(t_) * 65536 + v8off), (LAS unsigned*)(lds + bo_ + wid * 1024), 16, 0, 0); (void)vt_; } while (0)
#define RESC(a) do { if (__any((a) != 1.f)) { if (hi == 0) al_l[r32] = (a); asm volatile("s_waitcnt lgkmcnt(0)" ::: "memory"); \
    _Pragma("unroll") for (int r = 0; r < 16; ++r) { const float a_ = al_l[crow(r, hi)]; lacc[r] *= a_; _Pragma("unroll") for (int d = 0; d < 4; ++d) o[d][r] *= a_; } } } while (0)
#define TBAR() do { asm volatile("s_waitcnt lgkmcnt(0)" ::: "memory"); __builtin_amdgcn_s_barrier(); asm volatile("" ::: "memory"); } while (0)
#define KBUF(t_) (lds + ((t_) & 3) * BUFB + (int)SHM_V)
#define VBUF(t_) (vb0 + ((t_) & 3) * BUFB)
  f32x16 pA0, pA1, pB0, pB1; float alA, alB; bf16x8 pa0, pa1, pa2, pa3; const int NT = seq / KVBLK;
  DMA(0); DMA(1); if (2 < NT) DMA(2);
  if (2 < NT) asm volatile("s_waitcnt vmcnt(6)" ::: "memory"); else asm volatile("s_waitcnt vmcnt(3)" ::: "memory");
  TBAR();
  qkt(pA0, pA1, KBUF(0), qr, r32, hi, map, negm); partialSM(pA0, pA1, negm, alA);
  if (2 < NT) asm volatile("s_waitcnt vmcnt(3)" ::: "memory"); else asm volatile("s_waitcnt vmcnt(0)" ::: "memory");
  TBAR();
#define ITER(j, PN0, PN1, ALN, PO0, PO1, ALO) do { \
    if ((j) + 2 < NT) DMA((j) + 2); \
    SBAR(); qkt(PN0, PN1, KBUF(j), qr, r32, hi, map, negm); \
    finishSM8(PO0, PO1, ALO, l_reg, P8); SBAR(); \
    pv8(o, vrd + (((j) - 1) & 3) * BUFB, P8); partialSM(PN0, PN1, negm, ALN); \
    RESC(ALN); \
    if ((j) + 2 < NT) asm volatile("s_waitcnt vmcnt(3)" ::: "memory"); else asm volatile("s_waitcnt vmcnt(0)" ::: "memory"); \
    TBAR(); } while (0)
  for (int j = 1; j + 1 < NT; j += 2) {
    ITER(j, pB0, pB1, alB, pA0, pA1, alA);
    ITER(j + 1, pA0, pA1, alA, pB0, pB1, alB);
  }
  ITER(NT - 1, pB0, pB1, alB, pA0, pA1, alA);
  finishSM8(pB0, pB1, alB, l_reg, P8); SBAR();
  pv8(o, vrd + ((NT - 1) & 3) * BUFB, P8);
#undef DMA
#undef TBAR
#undef KBUF
#undef VBUF
#undef ITER
#elif ATT_DMA
  const int vb0 = (int)(unsigned)(uintptr_t)lds + v_rd_base(lane);
  unsigned voffV[2], voffK[2];
#pragma unroll
  for (int t = 0; t < 2; ++t) { const int vi = wid * 2 + t, kg = vi >> 1, pair = vi & 1, sub = lane >> 5, row = (lane >> 2) & 7, chunk = lane & 3;
    voffV[t] = (unsigned)((8 * kg + row) * LDK + 32 * (2 * pair + sub) + 8 * chunk) * 2u;
    const int krow = 4 * vi + (lane >> 4), p = lane & 15;
    voffK[t] = (unsigned)(krow * LDK) * 2u + (unsigned)((p ^ (krow & 7)) * 16); }
  const int ldsw = wid * 2048;
#define DMA(t_) do { const char* vt_ = (const char*)(Vh + (size_t)(t_) * KVBLK * LDK); const char* kt_ = (const char*)(Kh + (size_t)(t_) * KVBLK * LDK); const int bo_ = ((t_) & 3) * BUFB; \
    _Pragma("unroll") for (int i_ = 0; i_ < 2; ++i_) { \
      __builtin_amdgcn_global_load_lds((const unsigned*)(vt_ + voffV[i_]), (LAS unsigned*)(lds + bo_ + ldsw + i_ * 1024), 16, 0, 0); \
      __builtin_amdgcn_global_load_lds((const unsigned*)(kt_ + voffK[i_]), (LAS unsigned*)(lds + bo_ + (int)SHM_V + ldsw + i_ * 1024), 16, 0, 0); } } while (0)
#define RESC(a) do { if (__any((a) != 1.f)) { if (hi == 0) al_l[r32] = (a); asm volatile("s_waitcnt lgkmcnt(0)" ::: "memory"); \
    _Pragma("unroll") for (int r = 0; r < 16; ++r) { const float a_ = al_l[crow(r, hi)]; lacc[r] *= a_; _Pragma("unroll") for (int d = 0; d < 4; ++d) o[d][r] *= a_; } } } while (0)
#define TBAR() do { asm volatile("s_waitcnt lgkmcnt(0)" ::: "memory"); __builtin_amdgcn_s_barrier(); asm volatile("" ::: "memory"); } while (0)
#define KBUF(t_) (lds + ((t_) & 3) * BUFB + (int)SHM_V)
#define VBUF(t_) (vb0 + ((t_) & 3) * BUFB)
  f32x16 pA0, pA1, pB0, pB1; float alA, alB; bf16x8 pa0, pa1, pa2, pa3; const int NT = seq / KVBLK;
  DMA(0); DMA(1); if (2 < NT) DMA(2);
  if (2 < NT) asm volatile("s_waitcnt vmcnt(8)" ::: "memory"); else asm volatile("s_waitcnt vmcnt(4)" ::: "memory");
  TBAR();
  qkt(pA0, pA1, KBUF(0), qr, r32, hi, map, negm); partialSM(pA0, pA1, negm, alA);
  if (2 < NT) asm volatile("s_waitcnt vmcnt(4)" ::: "memory"); else asm volatile("s_waitcnt vmcnt(0)" ::: "memory");
  TBAR();
#define ITER(j, PN0, PN1, ALN, PO0, PO1, ALO) do { \
    if ((j) + 2 < NT) DMA((j) + 2); \
    SBAR(); qkt(PN0, PN1, KBUF(j), qr, r32, hi, map, negm); \
    finishSM(PO0, PO1, ALO, l_reg, pa0, pa1, pa2, pa3); SBAR(); \
    pv_d0(o, VBUF((j) - 1), pa0, pa1, pa2, pa3, lacc); partialSM(PN0, PN1, negm, ALN); \
    RESC(ALN); \
    if ((j) + 2 < NT) asm volatile("s_waitcnt vmcnt(4)" ::: "memory"); else asm volatile("s_waitcnt vmcnt(0)" ::: "memory"); \
    TBAR(); } while (0)
  for (int j = 1; j + 1 < NT; j += 2) {
    ITER(j, pB0, pB1, alB, pA0, pA1, alA);
    ITER(j + 1, pA0, pA1, alA, pB0, pB1, alB);
  }
  ITER(NT - 1, pB0, pB1, alB, pA0, pA1, alA);
  finishSM(pB0, pB1, alB, l_reg, pa0, pa1, pa2, pa3); SBAR();
  pv_d0(o, VBUF(NT - 1), pa0, pa1, pa2, pa3, lacc);
#undef DMA
#undef TBAR
#undef KBUF
#undef VBUF
#undef ITER
#else
  const int sr = tid >> 4, sc = (tid & 15) * 8, vst0 = v_st(sr, sc), vst1 = v_st(32 + sr, sc);
  const int vb0 = (int)(unsigned)(uintptr_t)lds + v_rd_base(lane);
  struct { bf16x8 vs0, vs1, ks0, ks1; } sr_[2];
  const unsigned goff = (unsigned)(sr * LDK + sc) * 2u;
#define SLOAD(i, k0) do { const char* vt_ = (const char*)(Vh + (size_t)(k0) * LDK); const char* kt_ = (const char*)(Kh + (size_t)(k0) * LDK); \
    sr_[i].vs0 = *(const bf16x8*)(vt_ + goff); sr_[i].vs1 = *(const bf16x8*)(vt_ + (size_t)32 * LDK * 2 + goff); sr_[i].ks0 = *(const bf16x8*)(kt_ + goff); sr_[i].ks1 = *(const bf16x8*)(kt_ + (size_t)32 * LDK * 2 + goff); } while (0)
#define SWRITE(b, i) do { *(LAS bf16x8*)(lds + (b) * BUFB + vst0) = sr_[i].vs0; *(LAS bf16x8*)(lds + (b) * BUFB + vst1) = sr_[i].vs1; const int kc = sc * 2; \
    *(LAS bf16x8*)(lds + (b) * BUFB + (int)SHM_V + KSWZ(sr, kc)) = sr_[i].ks0; *(LAS bf16x8*)(lds + (b) * BUFB + (int)SHM_V + KSWZ(32 + sr, kc)) = sr_[i].ks1; } while (0)
#define SWAIT() asm volatile("s_waitcnt vmcnt(4)" ::: "memory")
#define RESC(a) do { if (__any((a) != 1.f)) { if (hi == 0) al_l[r32] = (a); asm volatile("s_waitcnt lgkmcnt(0)" ::: "memory"); \
    _Pragma("unroll") for (int r = 0; r < 16; ++r) { const float a_ = al_l[crow(r, hi)]; lacc[r] *= a_; _Pragma("unroll") for (int d = 0; d < 4; ++d) o[d][r] *= a_; } } } while (0)
  f32x16 pA0, pA1, pB0, pB1; float alA, alB; bf16x8 pa0, pa1, pa2, pa3; const int NT = seq / KVBLK;
  constexpr int SE = 0, SO = 1;
  LAS char* K0 = lds + (int)SHM_V; LAS char* K1 = lds + BUFB + (int)SHM_V;
  SLOAD(SE, 0); asm volatile("s_waitcnt vmcnt(0)" ::: "memory"); SWRITE(0, SE); __syncthreads();
  qkt(pA0, pA1, K0, qr, r32, hi, map, negm); partialSM(pA0, pA1, negm, alA);
  SLOAD(SO, KVBLK); if (2 < NT) SLOAD(SE, 2 * KVBLK);
  SWAIT(); SWRITE(1, SO); __syncthreads();
#define XBAR() do { if (VAR != 1) __syncthreads(); } while (0)
#define XQK(P0, P1, KK) do { if (VAR != 5) qkt(P0, P1, KK, qr, r32, hi, map, negm); } while (0)
#define XFIN(P0, P1, AL) do { if (VAR != 2) finishSM(P0, P1, AL, l_reg, pa0, pa1, pa2, pa3); } while (0)
#define XPAR(P0, P1, AL) do { if (VAR != 2) partialSM(P0, P1, negm, AL); } while (0)
#define XPV(VB) do { if (VAR != 3) pv_d0(o, VB, pa0, pa1, pa2, pa3, lacc); } while (0)
#define XLOAD(i, k0) do { if (VAR != 4) SLOAD(i, k0); } while (0)
#define XWRITE(b, i) do { if (VAR != 4) { SWAIT(); SWRITE(b, i); } } while (0)
  if (VAR == 2) { pa0 = qr[0]; pa1 = qr[1]; pa2 = qr[2]; pa3 = qr[3]; alA = 1.f; alB = 1.f; }
  if (VAR == 5) { pA0 = f32x16{}; pA1 = pA0; pB0 = pA0; pB1 = pA0; }
  for (int j = 1; j + 1 < NT; j += 2) {
    SBAR(); XQK(pB0, pB1, K1);
    XFIN(pA0, pA1, alA); SBAR();
    XLOAD(SO, (j + 2) * KVBLK); SBAR();
    XPV(vb0); XPAR(pB0, pB1, alB);
    XBAR(); XWRITE(0, SE);
    RESC(alB); XBAR();
    SBAR(); XQK(pA0, pA1, K0);
    XFIN(pB0, pB1, alB); SBAR();
    if (j + 3 < NT) XLOAD(SE, (j + 3) * KVBLK); SBAR();
    XPV(vb0 + BUFB); XPAR(pA0, pA1, alA);
    XBAR(); XWRITE(1, SO);
    RESC(alA); XBAR();
  }
  SBAR(); qkt(pB0, pB1, K1, qr, r32, hi, map, negm);
  finishSM(pA0, pA1, alA, l_reg, pa0, pa1, pa2, pa3); SBAR();
  pv_d0(o, vb0, pa0, pa1, pa2, pa3, lacc); partialSM(pB0, pB1, negm, alB);
  __syncthreads(); RESC(alB);
  finishSM(pB0, pB1, alB, l_reg, pa0, pa1, pa2, pa3); SBAR();
  pv_d0(o, vb0 + BUFB, pa0, pa1, pa2, pa3, lacc);
#endif
  {
    const int tid2 = fresh_tid(wave), wid2 = tid2 >> 6, lane2 = tid2 & 63, r32b = lane2 & 31, hib = lane2 >> 5, mapb = wid2 >> 2, wqb = wid2 & 3;
    LAS float* li2 = (LAS float*)(lds + WSF_OFF) + wid2 * 64;
    float rli[16];
#if ATT_LMFMA || ATT_Y8
    (void)li2;
#pragma unroll
    for (int r = 0; r < 16; ++r) rli[r] = __builtin_amdgcn_rcpf(lacc[r]);
#else
    if (hib == 0) li2[r32b] = l_reg; asm volatile("s_waitcnt lgkmcnt(0)" ::: "memory");
#pragma unroll
    for (int r = 0; r < 16; ++r) rli[r] = __builtin_amdgcn_rcpf(li2[crow(r, hib)]);
#endif
    __syncthreads();
    LAS float* X = (LAS float*)lds + (wqb * 32 + 4 * hib) * 128 + r32b;
    if (mapb == 1) {
#pragma unroll
      for (int r = 0; r < 16; ++r)
#pragma unroll
        for (int d0 = 0; d0 < 4; ++d0) X[((r & 3) + 8 * (r >> 2)) * 128 + d0 * 32] = o[d0][r] * rli[r] * lam;
    }
    __syncthreads();
    if (mapb == 0) {
      float gs[4];
#pragma unroll
      for (int d0 = 0; d0 < 4; ++d0) gs[d0] = gsub[d0 * 32 + r32b] * oscale;
      bf16* Ow = Ob + (long)(wqb * 32 + 4 * hib) * D + r32b;
#pragma unroll
      for (int r = 0; r < 16; ++r) {
        float ss = 0.f;
#pragma unroll
        for (int d0 = 0; d0 < 4; ++d0) { const float v = o[d0][r] * rli[r] - X[((r & 3) + 8 * (r >> 2)) * 128 + d0 * 32]; o[d0][r] = v; ss += v * v; }
        ss = half_sum(ss);
        const float rs = 1.0f / sqrtf(ss * (1.0f / 128.0f) + NORM_EPS);
#pragma unroll
        for (int d0 = 0; d0 < 4; ++d0) Ow[(long)((r & 3) + 8 * (r >> 2)) * D + d0 * 32] = (bf16)f2bf(o[d0][r] * rs * gs[d0]);
      }
    }
    __syncthreads();
  }
#if ATT_DMA && ATT_FP8 && ATT_QK8 && ATT_Y8 && ATT_P2 && P2_AB
  };
  if (map == 0) run_(std::integral_constant<int, 0>{}); else run_(std::integral_constant<int, 1>{});
#endif
#if !ATT_DMA
#undef XBAR
#undef XQK
#undef XFIN
#undef XPAR
#undef XPV
#undef XLOAD
#undef XWRITE
#undef SLOAD
#undef SWRITE
#undef SWAIT
#endif
#undef RESC
}
#undef KSWZ
}


__device__ __forceinline__ void v8_phase(Frame& F, const Params& P) {
    unsigned char* ws = fresh_ws(P.ws);
    const bf16* vb = (const bf16*)(ws + WS_VB); unsigned char* v8 = ws + WS_V8;
    const Lane L(F.wave); const int gw = F.vcu * NWAVES + F.wave, NGW = F.G * NWAVES, lane = L.lane;
    for (int tile = gw; tile < NB * (KVLEN / 64) * 8; tile += NGW) {
        const int h = tile & 7, t = (tile >> 3) % (KVLEN / 64), b = (tile >> 3) / (KVLEN / 64);
        const bf16* src = vb + ((size_t)b * KVLEN + 64 * t) * 1024 + h * 128;
        v4u* dst = (v4u*)(v8 + (size_t)tile * 8192);
#pragma unroll 2
        for (int q = 0; q < 8; ++q) {
            const int c = lane + 64 * q, d = c & 31, half = (c >> 5) & 1, hi = (c >> 6) & 1, d0 = c >> 7;
            const bf16* col = src + 32 * d0 + d + (size_t)(4 * hi + 32 * half) * 1024;
            float v[16];
#pragma unroll
            for (int j = 0; j < 16; ++j) { const float x = bf2f(col[(size_t)((j & 3) + 8 * (j >> 2)) * 1024]); v[j] = fminf(fmaxf(x, -448.f), 448.f); }
            v4u w;
            w.x = (unsigned)__builtin_amdgcn_cvt_pk_fp8_f32(v[2], v[3], __builtin_amdgcn_cvt_pk_fp8_f32(v[0], v[1], 0, false), true);
            w.y = (unsigned)__builtin_amdgcn_cvt_pk_fp8_f32(v[6], v[7], __builtin_amdgcn_cvt_pk_fp8_f32(v[4], v[5], 0, false), true);
            w.z = (unsigned)__builtin_amdgcn_cvt_pk_fp8_f32(v[10], v[11], __builtin_amdgcn_cvt_pk_fp8_f32(v[8], v[9], 0, false), true);
            w.w = (unsigned)__builtin_amdgcn_cvt_pk_fp8_f32(v[14], v[15], __builtin_amdgcn_cvt_pk_fp8_f32(v[12], v[13], 0, false), true);
            dst[c] = w;
        }
#if ATT_QK8 && !K8_DIRECT
        const bf16* ksrc = (const bf16*)(ws + WS_KB) + ((size_t)b * KVLEN + 64 * t) * 1024 + h * 128;
        v4u* kdst = (v4u*)(ws + WS_K8 + (size_t)tile * 8192);
#pragma unroll 2
        for (int q = 0; q < 8; ++q) {
            const int c = lane + 64 * q, key = c & 63, half = (c >> 6) & 1, hi = (c >> 7) & 1, map = c >> 8;
            const bf16* p = ksrc + (size_t)key * 1024 + map * 64 + 32 * hi + 16 * half;
            float v[16]; { float a[8], bq[8]; ld8f(p, a); ld8f(p + 8, bq);
#pragma unroll
              for (int j = 0; j < 8; ++j) { v[j] = fminf(fmaxf(a[j], -448.f), 448.f); v[8 + j] = fminf(fmaxf(bq[j], -448.f), 448.f); } }
            v4u w;
            w.x = (unsigned)__builtin_amdgcn_cvt_pk_fp8_f32(v[2], v[3], __builtin_amdgcn_cvt_pk_fp8_f32(v[0], v[1], 0, false), true);
            w.y = (unsigned)__builtin_amdgcn_cvt_pk_fp8_f32(v[6], v[7], __builtin_amdgcn_cvt_pk_fp8_f32(v[4], v[5], 0, false), true);
            w.z = (unsigned)__builtin_amdgcn_cvt_pk_fp8_f32(v[10], v[11], __builtin_amdgcn_cvt_pk_fp8_f32(v[8], v[9], 0, false), true);
            w.w = (unsigned)__builtin_amdgcn_cvt_pk_fp8_f32(v[14], v[15], __builtin_amdgcn_cvt_pk_fp8_f32(v[12], v[13], 0, false), true);
            kdst[c] = w;
        }
#endif
    }
}
template <int VAR>
__device__ __forceinline__ void attn_phase(Frame& F, const Params& P, int layer, bool ctx_out, unsigned char* ldsg) {
    (void)ldsg;
    unsigned char* ws = fresh_ws(P.ws);
    const bf16* qb = (const bf16*)(ws + WS_Q); const bf16* kb = (const bf16*)(ws + WS_KB); const bf16* vb = (const bf16*)(ws + WS_VB); bf16* cat = (bf16*)(ws + (VAR == 0 ? WS_CAT : WS_H));
    const Lane L(F.wave);
    const float lam_init = __builtin_bit_cast(float, __builtin_amdgcn_readfirstlane(__builtin_bit_cast(int, 0.8f - 0.6f * expf(-0.3f * (float)layer))));
    const float* lv = P.in[I_LAMBDA] + layer * 256;
    const float d1 = wave_sum(lv[L.lane] * lv[64 + L.lane]), d2 = wave_sum(lv[128 + L.lane] * lv[192 + L.lane]);
    const float lam = __builtin_bit_cast(float, __builtin_amdgcn_readfirstlane(__builtin_bit_cast(int, expf(d1) - expf(d2) + lam_init)));
    const float* gsub = P.in[I_SUBLN] + layer * 128;
    const int nun = NB * 8 * 64 + (ctx_out ? NB * 8 * 2 : 0);
    for (int uid = F.vcu; uid < nun; uid += F.G) {
        int qt, h, b, seq; size_t qrow;
        if (uid < NB * 8 * 64) { qt = uid & 63; h = (uid >> 6) & 7; b = uid >> 9; qrow = (size_t)b * SEQ + 128 * qt; seq = KVLEN; }
        else { const int u2 = uid - NB * 8 * 64; qt = u2 & 1; h = (u2 >> 1) & 7; b = u2 >> 4; qrow = (size_t)NLAT + b * CTXL + 128 * qt; seq = CTXL; }
        att::diff_attn_unit<VAR>(Q8_DIRECT ? (const bf16*)((const unsigned char*)qb + qrow * 1024 + h * 128) : qb + qrow * 1024 + h * 128, kb + (size_t)b * KVLEN * 1024 + h * 128, vb + (size_t)b * KVLEN * 1024 + h * 128,
                            cat + qrow * D + 1024 + h * 128, seq, (LAS char*)F.lds, lam, gsub, 1.0f - lam_init, F.wave, ws + WS_V8 + ((size_t)b * (KVLEN / 64) * 8 + h) * 8192, (const unsigned char*)qb);
    }
}
struct MoePanels { int ps[9]; };
__device__ __forceinline__ MoePanels moe_panels(Frame& F) {
    MoePanels m; int acc = 0;
#pragma unroll
    for (int e = 0; e < NE; ++e) { m.ps[e] = acc; const int c = (int)__builtin_amdgcn_readfirstlane(__hip_atomic_load(F.ctl + CW_CNT + 64 * e, RLX_AGENT)); acc += (c + 255) >> 8; }
    m.ps[8] = acc; return m;
}
__device__ __forceinline__ void moe_gather_phase(Frame& F, const Params& P) {
    unsigned char* ws = fresh_ws(P.ws);
    const bf16* h = (const bf16*)(ws + WS_H); bf16* Ag = (bf16*)(ws + WS_AG);
    const int* tok_e = (const int*)(ws + WS_ROUTE); const int* tok_slot = tok_e + 2 * NLAT;
    const float* hs = (const float*)(ws + WS_HS); float* ags = (float*)(ws + WS_AGS);
    const MoePanels mp = moe_panels(F);
    const Lane L(F.wave); const int gw = F.vcu * NWAVES + F.wave, NGW = F.G * NWAVES, lane = L.lane;
    for (int a = gw; a < 2 * NLAT; a += NGW) {
        const int r = a >> 1, e = tok_e[a], slot = tok_slot[a];
        int pse = 0;
#pragma unroll
        for (int q = 0; q < NE; ++q) pse = (q == e) ? mp.ps[q] : pse;
        const v4u* src = (const v4u*)((const unsigned char*)h + (size_t)r * D) + lane; v4u* dst = (v4u*)((unsigned char*)Ag + ((size_t)pse * 256 + slot) * D) + lane;
#pragma unroll
        for (int j = 0; j < 2; ++j) dst[64 * j] = src[64 * j];
#if I8_GU
        if (lane == 0) ags[pse * 256 + slot] = hs[r];
#endif
    }
    for (int e = 0; e < NE; ++e) {
        const int c = (int)__builtin_amdgcn_readfirstlane(__hip_atomic_load(F.ctl + CW_CNT + 64 * e, RLX_AGENT));
        const int pad = ((c + 255) & ~255) - c;
        for (int q = gw; q < pad; q += NGW) { v4u* dst = (v4u*)((unsigned char*)Ag + ((size_t)mp.ps[e] * 256 + c + q) * D) + lane;
#pragma unroll
            for (int j = 0; j < 2; ++j) dst[64 * j] = (v4u){0u, 0u, 0u, 0u};
#if I8_GU
            if (lane == 0) ags[mp.ps[e] * 256 + c + q] = 0.f;
#endif
        }
    }
}
__device__ __forceinline__ void final_phase(Frame& F, const Params& P, const float* modl) {
    unsigned char* ws = fresh_ws(P.ws);
    const bf16* xl = (const bf16*)(ws + WS_XL); const bf16* yb = (const bf16*)(ws + WS_AG);
    const int* tok_e = (const int*)(ws + WS_ROUTE); const int* tok_slot = tok_e + 2 * NLAT; const float* tok_p = (const float*)(tok_slot + 2 * NLAT);
    const MoePanels mp = moe_panels(F);
    const Lane L(F.wave); const int gw = F.vcu * NWAVES + F.wave, NGW = F.G * NWAVES, lane = L.lane;
    const float* gf = P.in[I_GFIN];
    for (int r = gw; r < NLAT; r += NGW) {
        const int v = r < SEQ ? 0 : 1; const float* g5 = modl + (size_t)(v * 6 + 5) * D;
        const int e0 = tok_e[2 * r], e1 = tok_e[2 * r + 1];
        int p0s = 0, p1s = 0;
#pragma unroll
        for (int q = 0; q < NE; ++q) { p0s = (q == e0) ? mp.ps[q] : p0s; p1s = (q == e1) ? mp.ps[q] : p1s; }
        const bf16* y0 = yb + ((size_t)p0s * 256 + tok_slot[2 * r]) * D; const bf16* y1 = yb + ((size_t)p1s * 256 + tok_slot[2 * r + 1]) * D;
        const float w0 = tok_p[2 * r], w1 = tok_p[2 * r + 1];
        f32x4 x[8]; float ss = 0.f;
#pragma unroll
        for (int jq = 0; jq < 8; ++jq) { const int c = 4 * lane + 256 * jq;
            const v2u a = *(const v2u*)(y0 + c), bq = *(const v2u*)(y1 + c); const f32x4 g = *(const f32x4*)(g5 + c); const f32x4 xv = ld4_bf16(xl + (size_t)r * D + c);
            f32x4 y; y[0] = w0 * bflo(a.x) + w1 * bflo(bq.x); y[1] = w0 * bfhi(a.x) + w1 * bfhi(bq.x); y[2] = w0 * bflo(a.y) + w1 * bflo(bq.y); y[3] = w0 * bfhi(a.y) + w1 * bfhi(bq.y);
            x[jq] = xv + g * y; ss += (x[jq][0] * x[jq][0] + x[jq][1] * x[jq][1]) + (x[jq][2] * x[jq][2] + x[jq][3] * x[jq][3]); }
        const float rstd = 1.0f / sqrtf(wave_sum(ss) * (1.0f / D) + NORM_EPS);
#pragma unroll
        for (int jq = 0; jq < 8; ++jq) { const int c = 4 * lane + 256 * jq; const f32x4 ov_ = (x[jq] * rstd) * *(const f32x4*)(gf + c); if (FIN_NT) __builtin_nontemporal_store(ov_, (f32x4*)(P.out + (size_t)r * D + c)); else *(f32x4*)(P.out + (size_t)r * D + c) = ov_; }
    }
}
#if DBG == 1
constexpr size_t WS_DBG = 3 * MiB;
__device__ __forceinline__ void dbg_err(Frame& F, int k, float got, float want, float scale) {
    float e = fabsf(got - want) / scale; if (!(e == e)) e = 1e9f;
    atomicMax((unsigned*)(F.ctl + CW_DIAG + 64 * k), __float_as_uint(e));
}
__device__ __forceinline__ unsigned dbg_hash(unsigned x) { x ^= x >> 16; x *= 0x7feb352du; x ^= x >> 15; x *= 0x846ca68bu; x ^= x >> 16; return x; }
__device__ __forceinline__ float block_sum(float v, LAS float* red, int tid) {
    v = wave_sum(v); __syncthreads(); if ((tid & 63) == 0) red[tid >> 6] = v; __syncthreads();
    float s = 0.f; for (int w = 0; w < 8; ++w) s += red[w]; __syncthreads(); return s;
}
__device__ __forceinline__ float block_max(float v, LAS float* red, int tid) {
    v = fmaxf(v, dpp_f(v, 0)); v = fmaxf(v, dpp_f(v, 1)); v = fmaxf(v, dpp_f(v, 2)); v = fmaxf(v, dpp_f(v, 3));
    v = fmaxf(v, __builtin_bit_cast(float, __builtin_amdgcn_ds_swizzle(__builtin_bit_cast(int, v), 0x401F)));
    v = cross_max(v);
    __syncthreads(); if ((tid & 63) == 0) red[tid >> 6] = v; __syncthreads();
    float s = red[0]; for (int w = 1; w < 8; ++w) s = fmaxf(s, red[w]); __syncthreads(); return s;
}
__device__ __forceinline__ const float* dbg_res_row(const Params& P, int layer, int r) {
    const float* xl = (const float*)(fresh_ws(P.ws) + WS_XL);
    if (layer == 0) return r < NLAT ? P.in[I_X] + (size_t)r * D : P.in[I_CTX] + (size_t)(r - NLAT) * D;
    return xl + (size_t)r * D;
}
__device__ __forceinline__ int dbg_vec(int r) { return r < SEQ ? 0 : (r < NLAT ? 1 : 2); }

__device__ __forceinline__ void dbg_check_norm(Frame& F, const Params& P, int layer) {
    const int tid = fresh_tid(F.wave); LAS float* hn = (LAS float*)F.lds; LAS float* red = hn + D;
    const float* modl = (const float*)(fresh_ws(P.ws) + WS_MOD) + (size_t)layer * 3 * 12288;
    { const float t1 = block_sum(1.0f, red, tid), t2 = block_sum((float)tid, red, tid), t3 = wave_sum((float)(tid & 63));
      dbg_err(F, 2, t1, 512.0f, 1.0f); dbg_err(F, 3, t2, 130816.0f, 1.0f); dbg_err(F, 4, t3, 2016.0f, 1.0f); }
    for (int s = F.vcu; s < 256; s += F.G) {
        const unsigned hsh = dbg_hash(s * 2654435761u + 17u + layer);
        const int r = (s & 7) == 7 ? NLAT + (hsh % NCTX) : (int)(hsh % NLAT);
        const float* xr = dbg_res_row(P, layer, r); const int v = dbg_vec(r);
        float ss = 0.f; for (int k = tid; k < D; k += 512) ss += xr[k] * xr[k];
        ss = block_sum(ss, red, tid); const float rstd = 1.0f / sqrtf(ss / D + NORM_EPS);
        const bf16* hr = (const bf16*)(fresh_ws(P.ws) + WS_H) + (size_t)r * D;
        for (int k = tid; k < D; k += 512) { const float want = (xr[k] * rstd * P.in[I_GMIX][layer * D + k]) * (1.0f + modl[(v * 6 + 1) * D + k]) + modl[(v * 6 + 0) * D + k]; dbg_err(F, 0, bf2f(hr[k]), want, 1.0f); }
        const int v2 = s % 3, j = (int)((hsh >> 5) % 12288);
        float a = 0.f; for (int k = tid; k < D; k += 512) { const float c = v2 < 2 ? P.in[I_C][v2 * D + k] : P.in[I_CCTX][k]; a += c / (1.0f + expf(-c)) * P.in[I_WMOD][((size_t)layer * D + k) * 12288 + j]; }
        a = block_sum(a, red, tid);
        if (tid == 0) dbg_err(F, 1, modl[v2 * 12288 + j], a + P.in[I_BMOD][layer * 12288 + j], 1.0f);
        __syncthreads();
    }
}
__device__ __forceinline__ void dbg_check_inproj(Frame& F, const Params& P, int layer) {
    const int tid = fresh_tid(F.wave); LAS float* hn = (LAS float*)F.lds; LAS float* red = hn + D;
    const float* modl = (const float*)(fresh_ws(P.ws) + WS_MOD) + (size_t)layer * 3 * 12288;
    for (int s = F.vcu; s < 256; s += F.G) {
        const unsigned hsh = dbg_hash(s * 2654435761u + 17u + layer);
        const int r = (s & 7) == 7 ? NLAT + (hsh % NCTX) : (int)(hsh % NLAT);
        int c = (int)((hsh >> 8) % IN_COLS); if ((s & 3) == 1) c = COL_Q + (int)((hsh >> 8) % 1024); if ((s & 3) == 2) c = COL_K + (int)((hsh >> 8) % 1024); if ((s & 15) == 3) c = COL_DT + (int)((hsh >> 8) % 16);
        const float* xr = dbg_res_row(P, layer, r); const int v = dbg_vec(r);
        float ss = 0.f; for (int k = tid; k < D; k += 512) ss += xr[k] * xr[k];
        ss = block_sum(ss, red, tid); const float rstd = 1.0f / sqrtf(ss / D + NORM_EPS);
        for (int k = tid; k < D; k += 512) hn[k] = (xr[k] * rstd * P.in[I_GMIX][layer * D + k]) * (1.0f + modl[(v * 6 + 1) * D + k]) + modl[(v * 6 + 0) * D + k];
        __syncthreads();
        const float* w = P.in[I_WIN] + (size_t)layer * D * IN_COLS;
        const bool qk = (c >= COL_Q && c < COL_Q + 1024) || (c >= COL_K && c < COL_K + 1024);
        int cp = c; if (qk) { const int base = c >= COL_K ? COL_K : COL_Q; const int cl = (c - base) & 31; cp = c - cl + ((cl + 16) & 31); }
        float d0 = 0.f, d1 = 0.f; for (int k = tid; k < D; k += 512) { d0 += hn[k] * w[(size_t)k * IN_COLS + c]; d1 += hn[k] * w[(size_t)k * IN_COLS + cp]; }
        d0 = block_sum(d0, red, tid); d1 = block_sum(d1, red, tid);
        if (tid == 0) {
            float want = d0, got;
            if (c < COL_Z) got = bf2f(((const bf16*)(fresh_ws(P.ws) + WS_CONV))[(size_t)r * 1536 + c]);
            else if (c < COL_Q) got = bf2f(((const bf16*)(fresh_ws(P.ws) + WS_Z))[(size_t)r * 512 + c - COL_Z]);
            else if (c < COL_XBC) got = 0.f;
            else if (c < COL_DT) got = bf2f(((const bf16*)(fresh_ws(P.ws) + WS_XBC))[(size_t)r * 1024 + c - COL_XBC]);
            else if (c < COL_K) got = ((const float*)(fresh_ws(P.ws) + WS_DT))[(size_t)r * 16 + c - COL_DT];
            else if (c < COL_V) got = 0.f;
            else { const size_t kr = r < NLAT ? (size_t)(r / SEQ) * KVLEN + CTXL + (r % SEQ) : (size_t)((r - NLAT) / CTXL) * KVLEN + (r - NLAT) % CTXL; got = bf2f(((const bf16*)(fresh_ws(P.ws) + WS_VB))[kr * 1024 + c - COL_V]); }
            if (qk) {
                const int base = c >= COL_K ? COL_K : COL_Q; const int cc = c - base, cl = cc & 31, seg = (cc >> 5) & 1, f = cl & 15;
                if (r < NLAT) { const int t = r % SEQ; const float pos = seg ? (float)(t % 64) : (float)(t / 64); const float inv = powf(10000.0f, -(float)f / 16.0f); const float ang = pos * inv;
                    want = cl < 16 ? d0 * cosf(ang) - d1 * sinf(ang) : d0 * cosf(ang) + d1 * sinf(ang); }
                const int mem = (cc & ~31) + pg8::perm32(cl);
                if (base == COL_Q) got = bf2f(((const bf16*)(fresh_ws(P.ws) + WS_Q))[(size_t)r * 1024 + mem]);
                else { const size_t kr = r < NLAT ? (size_t)(r / SEQ) * KVLEN + CTXL + (r % SEQ) : (size_t)((r - NLAT) / CTXL) * KVLEN + (r - NLAT) % CTXL; got = bf2f(((const bf16*)(fresh_ws(P.ws) + WS_KB))[kr * 1024 + mem]); }
            }
            { const int seg = ((c - (c >= COL_K ? COL_K : COL_Q)) >> 5) & 1; const int slot = (r < NLAT ? 0 : 3) + (qk ? 1 + seg : 0); dbg_err(F, slot, got, want, 1.0f); }
        }
        __syncthreads();
    }
}
__device__ __forceinline__ void dbg_check_attn(Frame& F, const Params& P, int layer) {
    const int tid = fresh_tid(F.wave); LAS float* sc1 = (LAS float*)F.lds; LAS float* sc2 = sc1 + KVLEN; LAS float* red = sc2 + KVLEN; LAS float* ov = red + 16; LAS float* qv = ov + 512;
    const bf16* qb = (const bf16*)(fresh_ws(P.ws) + WS_Q); const bf16* kb = (const bf16*)(fresh_ws(P.ws) + WS_KB); const bf16* vb = (const bf16*)(fresh_ws(P.ws) + WS_VB); const bf16* cat = (const bf16*)(fresh_ws(P.ws) + WS_CAT);
    const float lam_init = 0.8f - 0.6f * expf(-0.3f * (float)layer); const float* lv = P.in[I_LAMBDA] + layer * 256;
    float d1 = 0.f, d2 = 0.f; for (int i = 0; i < 64; ++i) { d1 += lv[i] * lv[64 + i]; d2 += lv[128 + i] * lv[192 + i]; }
    const float lam = expf(d1) - expf(d2) + lam_init;
    for (int s = F.vcu; s < 64; s += F.G) {
        const unsigned hsh = dbg_hash(s * 2654435761u + 99u + layer);
        const bool isctx = layer == 0 && (s & 7) == 7; const int h = (hsh >> 4) & 7;
        const int r = isctx ? NLAT + (int)(hsh % NCTX) : (int)((hsh >> 7) % NLAT);
        const int b = isctx ? (r - NLAT) / CTXL : r / SEQ; const int nk = isctx ? CTXL : KVLEN;
        if (tid < 128) qv[tid] = bf2f(qb[(size_t)r * 1024 + h * 128 + tid]);
        __syncthreads();
        float m1 = -1e30f, m2 = -1e30f;
        for (int k = tid; k < nk; k += 512) { const bf16* kr = kb + ((size_t)b * KVLEN + k) * 1024 + h * 128; float a = 0.f, c2 = 0.f;
            for (int d = 0; d < 64; ++d) { a += qv[d] * bf2f(kr[d]); c2 += qv[64 + d] * bf2f(kr[64 + d]); }
            a *= 0.125f; c2 *= 0.125f; sc1[k] = a; sc2[k] = c2; m1 = fmaxf(m1, a); m2 = fmaxf(m2, c2); }
        m1 = block_max(m1, red, tid); m2 = block_max(m2, red, tid);
        float l1 = 0.f, l2 = 0.f;
        for (int k = tid; k < nk; k += 512) { const float p1 = expf(sc1[k] - m1), p2 = expf(sc2[k] - m2); sc1[k] = p1; sc2[k] = p2; l1 += p1; l2 += p2; }
        l1 = block_sum(l1, red, tid); l2 = block_sum(l2, red, tid);
        { const int d = tid & 127, part = tid >> 7; float o = 0.f;
          for (int k = part; k < nk; k += 4) o += (sc1[k] / l1 - lam * sc2[k] / l2) * bf2f(vb[((size_t)b * KVLEN + k) * 1024 + h * 128 + d]);
          ov[tid] = o; }
        __syncthreads();
        float o = 0.f, sq = 0.f; if (tid < 128) { o = ov[tid] + ov[128 + tid] + ov[256 + tid] + ov[384 + tid]; sq = o * o; }
        sq = block_sum(sq, red, tid);
        if (tid < 128) { const float want = o / sqrtf(sq / 128.0f + NORM_EPS) * P.in[I_SUBLN][layer * 128 + tid] * (1.0f - lam_init);
            dbg_err(F, 1, bf2f(cat[(size_t)r * D + 1024 + h * 128 + tid]), want, 1.0f); }
        __syncthreads();
    }
}
__device__ __forceinline__ void dbg_expect_rows(Frame& F, const Params& P, int layer, int which) {
    const int tid = fresh_tid(F.wave); LAS float* hn = (LAS float*)F.lds; LAS float* act = hn + D; LAS float* red = act + FFD;
    const float* modl = (const float*)(fresh_ws(P.ws) + WS_MOD) + (size_t)layer * 3 * 12288; float* ex = (float*)(fresh_ws(P.ws) + WS_DBG) + (size_t)which * 16 * D;
    for (int s = F.vcu; s < 16; s += F.G) {
        const unsigned hsh = dbg_hash(s * 2654435761u + 7u + which * 131u + layer);
        const int r = (s & 7) == 7 && layer == 0 ? NLAT + (int)(hsh % NCTX) : (int)(hsh % NLAT); const int v = dbg_vec(r);
        if (which == 0) {
            const bf16* cr = (const bf16*)(fresh_ws(P.ws) + WS_CAT) + (size_t)r * D; const float* w = P.in[I_WOUT] + (size_t)layer * D * D; const float* res = dbg_res_row(P, layer, r);
            for (int k = tid; k < D; k += 512) hn[k] = bf2f(cr[k]);
            __syncthreads();
            for (int c = tid; c < D; c += 512) { float a = 0.f; for (int k = 0; k < D; ++k) a += hn[k] * w[(size_t)k * D + c]; ex[s * D + c] = res[c] + modl[(v * 6 + 2) * D + c] * a; }
        } else {
            const float* xr = (const float*)(fresh_ws(P.ws) + WS_XL) + (size_t)r * D;
            float ss = 0.f; for (int k = tid; k < D; k += 512) ss += xr[k] * xr[k];
            ss = block_sum(ss, red, tid); const float rstd = 1.0f / sqrtf(ss / D + NORM_EPS);
            for (int k = tid; k < D; k += 512) hn[k] = (xr[k] * rstd * P.in[I_GFFN][layer * D + k]) * (1.0f + modl[(v * 6 + 4) * D + k]) + modl[(v * 6 + 3) * D + k];
            __syncthreads();
            for (int j = tid; j < FFD; j += 512) { float g = 0.f, u = 0.f; for (int k = 0; k < D; ++k) { g += hn[k] * P.in[I_FG][(size_t)k * FFD + j]; u += hn[k] * P.in[I_FU][(size_t)k * FFD + j]; } act[j] = g / (1.0f + expf(-g)) * u; }
            __syncthreads();
            { float* ex2 = (float*)(fresh_ws(P.ws) + WS_DBG + 256 * 1024) + (size_t)s * 7680; for (int k = tid; k < D; k += 512) ex2[k] = hn[k]; for (int j = tid; j < FFD; j += 512) ex2[D + j] = act[j]; }
            for (int c = tid; c < D; c += 512) { float a = 0.f; for (int j = 0; j < FFD; ++j) a += act[j] * P.in[I_FD][(size_t)j * D + c]; ex[s * D + c] = xr[c] + modl[(v * 6 + 5) * D + c] * a; }
        }
        __syncthreads();
    }
}
__device__ __forceinline__ void dbg_compare_rows(Frame& F, const Params& P, int layer, int which) {
    const int tid = fresh_tid(F.wave); const float* ex = (const float*)(fresh_ws(P.ws) + WS_DBG) + (size_t)which * 16 * D;
    for (int s = F.vcu; s < 16; s += F.G) {
        const unsigned hsh = dbg_hash(s * 2654435761u + 7u + which * 131u + layer);
        const int r = (s & 7) == 7 && layer == 0 ? NLAT + (int)(hsh % NCTX) : (int)(hsh % NLAT);
        const float* xr = (const float*)(fresh_ws(P.ws) + WS_XL) + (size_t)r * D;
        for (int c = tid; c < D; c += 512) dbg_err(F, 2 + which, xr[c], ex[s * D + c], 1.0f);
        if (which == 1) { const float* ex2 = (const float*)(fresh_ws(P.ws) + WS_DBG + 256 * 1024) + (size_t)s * 7680;
            const bf16* hr = (const bf16*)(fresh_ws(P.ws) + WS_H) + (size_t)r * D; const bf16* ar = (const bf16*)(fresh_ws(P.ws) + WS_ACT) + (size_t)r * FFD;
            for (int k = tid; k < D; k += 512) dbg_err(F, 0, bf2f(hr[k]), ex2[k], 1.0f);
            for (int j = tid; j < FFD; j += 512) dbg_err(F, 1, bf2f(ar[j]), ex2[D + j], 1.0f); }
    }
}
__device__ __forceinline__ void dbg_check_moe(Frame& F, const Params& P) {
    const int tid = fresh_tid(F.wave); LAS float* hn = (LAS float*)F.lds; LAS float* act = hn + D; LAS float* yv = act + FFE; LAS float* red = yv + D; LAS float* lg = red + 16;
    const float* modl = (const float*)(fresh_ws(P.ws) + WS_MOD) + (size_t)1 * 3 * 12288;
    for (int s = F.vcu; s < 16; s += F.G) {
        const unsigned hsh = dbg_hash(s * 2654435761u + 1234u); const int r = (int)(hsh % NLAT), v = dbg_vec(r);
        const float* xr = (const float*)(fresh_ws(P.ws) + WS_XL) + (size_t)r * D;
        float ss = 0.f; for (int k = tid; k < D; k += 512) ss += xr[k] * xr[k];
        ss = block_sum(ss, red, tid); const float rstd = 1.0f / sqrtf(ss / D + NORM_EPS);
        for (int k = tid; k < D; k += 512) { hn[k] = (xr[k] * rstd * P.in[I_GFFN][D + k]) * (1.0f + modl[(v * 6 + 4) * D + k]) + modl[(v * 6 + 3) * D + k]; yv[k] = 0.f; }
        __syncthreads();
        for (int e = 0; e < NE; ++e) { float a = 0.f; for (int k = tid; k < D; k += 512) a += hn[k] * P.in[I_RW][k * NE + e]; a = block_sum(a, red, tid); if (tid == 0) lg[e] = a + P.in[I_RB][e]; }
        __syncthreads();
        int i0 = 0; for (int e = 1; e < NE; ++e) if (lg[e] > lg[i0]) i0 = e;
        int i1 = -1; for (int e = 0; e < NE; ++e) if (e != i0 && (i1 < 0 || lg[e] > lg[i1])) i1 = e;
        const float p0 = 1.0f / (1.0f + expf(lg[i1] - lg[i0])), p1 = 1.0f - p0;
        for (int kk = 0; kk < 2; ++kk) {
            const int e = kk ? i1 : i0; const float pe = kk ? p1 : p0;
            const float* wg = P.in[I_MG] + (size_t)e * D * FFE; const float* wu = P.in[I_MU] + (size_t)e * D * FFE; const float* wd = P.in[I_MD] + (size_t)e * FFE * D;
            for (int j = tid; j < FFE; j += 512) { float g = 0.f, u = 0.f; for (int k = 0; k < D; ++k) { g += hn[k] * wg[(size_t)k * FFE + j]; u += hn[k] * wu[(size_t)k * FFE + j]; } act[j] = g / (1.0f + expf(-g)) * u; }
            __syncthreads();
            for (int c = tid; c < D; c += 512) { float a = 0.f; for (int j = 0; j < FFE; ++j) a += act[j] * wd[(size_t)j * D + c]; yv[c] += pe * a; }
            __syncthreads();
        }
        float q = 0.f; for (int c = tid; c < D; c += 512) { const float o = xr[c] + modl[(v * 6 + 5) * D + c] * yv[c]; yv[c] = o; q += o * o; }
        q = block_sum(q, red, tid); const float rs = 1.0f / sqrtf(q / D + NORM_EPS);
        for (int c = tid; c < D; c += 512) dbg_err(F, 4, P.out[(size_t)r * D + c], yv[c] * rs * P.in[I_GFIN][c], 1.0f);
        if (tid == 0) { const int* te = (const int*)(fresh_ws(P.ws) + WS_ROUTE); const float* tp = (const float*)(te + 4 * NLAT);
            const bool close = fabsf(lg[i1] - lg[i0]) < 1e-3f;
            if (!close) { dbg_err(F, 5, (float)te[2 * r], (float)i0, 1.0f); dbg_err(F, 5, tp[2 * r], p0, 1.0f); } }
        __syncthreads();
    }
}
__device__ __forceinline__ void dbg_report(Frame& F, const Params& P) {
    const int tid = fresh_tid(F.wave);
    for (size_t i = (size_t)F.vcu * 512 + tid; i < (size_t)NLAT * D; i += (size_t)F.G * 512) P.out[i] = 0.f;
    if (F.vcu == 0 && tid == 0) {
#if DBG_REPORT >= 0
        const float e = __uint_as_float(__hip_atomic_load(F.ctl + CW_DIAG + 64 * DBG_REPORT, RLX_AGENT));
        int bucket = 0; { float t = e * 1024.0f; while (t >= 2.0f && bucket < 60) { t *= 0.5f; ++bucket; } }
        P.out[0] = 1000.0f * (float)(10 + bucket);
#else
        const float thr[6] = {0.06f, 0.06f, 0.08f, 0.08f, 0.06f, 0.06f}; int mask = 0;
        for (int k = 0; k < 6; ++k) { const float e = __uint_as_float(__hip_atomic_load(F.ctl + CW_DIAG + 64 * k, RLX_AGENT)); if (e > thr[k]) mask |= 1 << k; }
        P.out[0] = 1000.0f * (float)(10 + mask);
#endif
    }
}
#endif
#ifndef EN_PRO
#define EN_PRO 1
#endif
#ifndef EN_NORM
#define EN_NORM 1
#endif
#ifndef EN_GIN
#define EN_GIN 1
#endif
#ifndef EN_CONV
#define EN_CONV 1
#endif
#ifndef EN_S1
#define EN_S1 1
#endif
#ifndef EN_S2
#define EN_S2 1
#endif
#ifndef EN_S3
#define EN_S3 1
#endif
#ifndef EN_ATT
#define EN_ATT 1
#endif
#ifndef EN_WOUT
#define EN_WOUT 1
#endif
#ifndef EN_GU
#define EN_GU 1
#endif
#ifndef EN_DN
#define EN_DN 1
#endif
#ifndef EN_ROUTE
#define EN_ROUTE 1
#endif
#ifndef EN_GATH
#define EN_GATH 1
#endif
#ifndef EN_MGU
#define EN_MGU 1
#endif
#ifndef EN_MDN
#define EN_MDN 1
#endif
#ifndef EN_FIN
#define EN_FIN 1
#endif
__global__ void __launch_bounds__(NWAVES * 64, 2) fwd_kernel(Params P) {
    extern __shared__ __attribute__((aligned(16))) unsigned char lds[];
    Frame F;
    F.lds = (LAS unsigned char*)lds;
    F.MISC = (volatile LAS unsigned*)(F.lds + MISC_OFF);
    F.wave = __builtin_amdgcn_readfirstlane(threadIdx.x >> 6);
    F.G = gridDim.x; { const int bx = blockIdx.x; F.vcu = (F.G % 8 == 0) ? (bx % 8) * (F.G / 8) + bx / 8 : bx; }
    unsigned char* ws = P.ws;
    F.ctl = (gu32*)(ws + WS_CTL);
    for (int u = threadIdx.x; u < (LDS_BYTES - LDSCTL_OFF) / 4; u += NWAVES * 64) ((LAS unsigned*)(F.lds + LDSCTL_OFF))[u] = 0u;
    __syncthreads();
    XcdBarrier bar = xcd_barrier_post((unsigned*)(ws + WS_CTL) + CW_BAR, F.MISC + 8);
#if DBG == 2
    unsigned long long* tsb = (unsigned long long*)(ws + WS_ROUTE + 512 * 1024); int nst = 0;
#define STAMP() do { if (blockIdx.x == 0 && threadIdx.x == 0) tsb[nst] = __builtin_amdgcn_s_memrealtime(); ++nst; } while (0)
    STAMP();
#else
#define STAMP() do {} while (0)
#endif
#if SIMPLE_BAR
    unsigned nbar = 0;
#define GRID_BAR() do { ++nbar; simple_barrier((unsigned*)(ws + WS_CTL) + 2048, nbar * (unsigned)gridDim.x); } while (0)
#else
#define GRID_BAR() do { xcd_barrier(bar); STAMP(); } while (0)
#endif

    bf16* xl = (bf16*)(ws + WS_XL); bf16* hb = (bf16*)(ws + WS_H); bf16* cat = (bf16*)(ws + WS_CAT);
    const float* mod = (const float*)(ws + WS_MOD);
    int* tok_e = (int*)(ws + WS_ROUTE); int* tok_slot = tok_e + 2 * NLAT; float* tok_p = (float*)(tok_slot + 2 * NLAT);

#if DUP_BAR
    for (int i_ = 0; i_ < DUP_BAR; ++i_) GRID_BAR();
#endif
#if EN_PRO
    p0_prologue(F, P);
#if DUP_PRO
    __syncthreads(); if (NOSTORE_PROBE) { if (threadIdx.x == 0) g_nostore = 1; __syncthreads(); } p0_prologue(F, P); if (NOSTORE_PROBE) { __syncthreads(); if (threadIdx.x == 0) g_nostore = 0; __syncthreads(); }
#endif
#endif
    GRID_BAR();

    constexpr int G0 = 256, RM_A = ((T / 256) * (NIN / 256)) % G0, RM_B = (NCH * NB * 8) % G0, RM_C = ((T / 256) * (2 * FFD / 256)) % G0;
    constexpr int CAP_T = (IPW_T > 0) ? (G0 - 32) * NWAVES * IPW_T + 24 * NWAVES * (IPW_T - 1) : 0;
    constexpr int DP_A0 = 0, DP_B0 = DP_A0 + (G0 - RM_A) * NWAVES * IPW_G, DP_T0 = DP_B0 + (G0 - RM_B) * NWAVES * IPW_S, DP_C0 = DP_T0 + CAP_T, DP_A1 = DP_C0 + (G0 - RM_C) * NWAVES * IPW_G,
                  DP_B1 = DP_A1 + (G0 - RM_A) * NWAVES * IPW_G, DP_END = DP_B1 + (G0 - RM_B) * NWAVES * IPW_S;
    static_assert(DP_A1 >= CV_IN + CV_OUT, "layer 1's w_in / w_out must be converted during layer 0");
    const bool slots = DEFER && (F.G == G0);
#define TAIL_SLOT(rem, myidx, ipw, dpos) do { if (slots && (myidx) >= (rem)) deferred_slot(F, P, (dpos), (myidx) - (rem), G0 - (rem), (ipw)); } while (0)
    for (int layer = 0; layer < 2; ++layer) {
        ws = fresh_ws(P.ws); F.wave = fresh_s(F.wave); F.vcu = fresh_s(F.vcu); F.G = fresh_s(F.G);
        const float* modl = mod + (size_t)layer * 3 * 12288;
        const void* resLat = layer == 0 ? (const void*)P.in[I_X] : (const void*)xl; const void* resCtx = layer == 0 ? (const void*)P.in[I_CTX] : (const void*)(xl + (size_t)NLAT * D);
#if EN_NORM
        if (layer == 0) norm_phase<false, I8_IN ? 2 : 0, false, false>(F, resLat, resCtx, P.in[I_GMIX] + layer * D, modl, 0, 1, hb, T, nullptr, nullptr, nullptr, nullptr, nullptr, nullptr, 11, nullptr, nullptr, (float*)(ws + WS_HS));
        else norm_phase<false, I8_IN ? 2 : 0, GEMM_AE, GEMM_SP2>(F, resLat, resCtx, P.in[I_GMIX] + layer * D, modl, 0, 1, hb, T, nullptr, nullptr, nullptr, nullptr, nullptr,
                          (const float*)(ws + WS_PART), 11, mod + (size_t)(2 * 6 + 5) * D, nullptr, (float*)(ws + WS_HS));
#if DUP_SMALL & 16
        norm_phase<false>(F, resLat, resCtx, P.in[I_GMIX] + layer * D, modl, 0, 1, hb, T, nullptr, nullptr, nullptr, nullptr, nullptr);
#endif
#endif
        GRID_BAR();
#if DBG == 1
        if ((DBG_MASK & 32) && layer == DBG_L) { dbg_check_norm(F, P, layer); }
#endif
        {
            pg8::PlainSched S; S.init(T / 256, NIN / 256, F.G, (int)blockIdx.x); S.A = (const char*)hb; S.Bt = (const char*)(ws + WS_WIN + layer * SZ_WIN); S.tstep = (size_t)256 * D * (I8_IN ? 1 : 2);
            pg8::EpiIn E{(bf16*)(ws + WS_CONV), (bf16*)(ws + WS_Z), (bf16*)(ws + WS_Q), (bf16*)(ws + WS_XBC), (bf16*)(ws + WS_KB), (bf16*)(ws + WS_VB), (float*)(ws + WS_DT),
                         (const float*)(ws + WS_ROPE), (const float*)(ws + WS_ROPE) + 192 * 16, ws + WS_K8, ws + WS_V8};
            if (V8_DIRECT) { S.swap_from = 20; S.swap_to = 24; }
#if EN_GIN && I8_IN
#if DUP_GIN
            pg8::gemm_phase<pg8::EpiIn, pg8::PlainSched, GEMM_AE, GEMM_SP2, 2>(F.lds + RING_OFF, D / 2, S, E, F.wave, DUP_GIN == 2 ? 8 : 0, 0, 0, (const float*)(ws + WS_HS), (const float*)(ws + WS_CS) + CS_WIN + layer * 6400); __syncthreads();
#endif
            pg8::gemm_phase<pg8::EpiIn, pg8::PlainSched, GEMM_AE, GEMM_SP2, 2>(F.lds + RING_OFF, D / 2, S, E, F.wave, 0, 0, 0, (const float*)(ws + WS_HS), (const float*)(ws + WS_CS) + CS_WIN + layer * 6400);
            TAIL_SLOT(RM_A, (int)blockIdx.x, IPW_G, layer ? DP_A1 : DP_A0);
#elif EN_GIN
            pg8::gemm_phase<pg8::EpiIn, pg8::PlainSched, GEMM_AE, GEMM_SP2>(F.lds + RING_OFF, D, S, E, F.wave);
#if DUP_GIN
            __syncthreads(); pg8::gemm_phase<pg8::EpiIn, pg8::PlainSched, GEMM_AE, GEMM_SP2>(F.lds + RING_OFF, D, S, E, F.wave);
#endif
#endif
        }
        GRID_BAR();
#if DBG == 1
        if ((DBG_MASK & 1) && layer == DBG_L) { dbg_check_inproj(F, P, layer); }
#endif
#if EN_CONV
        conv_phase(F, (const bf16*)(ws + WS_CONV), (const bf16*)(ws + WS_XBC), cat, (bf16*)(ws + WS_XBCC), P.in[I_CONVW] + layer * 1536, P.in[I_SCONVW] + layer * 3072, P.in[I_SCONVB] + layer * 1024);
#if ATT_FP8 && ATT_DMA && !V8_DIRECT
        v8_phase(F, P);
#endif
#if DUP_SMALL & 8
        conv_phase(F, (const bf16*)(ws + WS_CONV), (const bf16*)(ws + WS_XBC), cat, (bf16*)(ws + WS_XBCC), P.in[I_CONVW] + layer * 1536, P.in[I_SCONVW] + layer * 3072, P.in[I_SCONVB] + layer * 1024);
#endif
#endif
        GRID_BAR();
#if EN_S1
#if DUP_S1V
        ssd_local_phase<DUP_S1V>(F, P, layer);
#endif
        ssd_local_phase(F, P, layer);
        TAIL_SLOT(RM_B, F.vcu, IPW_S, layer ? DP_B1 : DP_B0);
#if DUP_SMALL & 1
        ssd_local_phase(F, P, layer);
#endif
#endif
        GRID_BAR();
#if EN_S2
        ssd_scan_phase(F, P);
#if DUP_SMALL & 2
        ssd_scan_phase(F, P);
#endif
#endif
        GRID_BAR();
#if EN_S3
        ssd_out_phase(F, P, layer);
#if DUP_SMALL & 4
        ssd_out_phase(F, P, layer);
#endif
#endif
#if EN_ATT
        attn_phase<0>(F, P, layer, layer == 0, lds);
        if (IPW_T > 0 && slots && layer == 0) {
            if (F.vcu >= 32) deferred_slot(F, P, DP_T0, F.vcu - 32, G0 - 32, IPW_T);
            else if (F.vcu >= 8 && IPW_T > 1) deferred_slot(F, P, DP_T0 + (G0 - 32) * NWAVES * IPW_T, F.vcu - 8, 24, IPW_T - 1);
        }
#if DUP_ATT
        attn_phase<DUP_ATT - 1>(F, P, layer, layer == 0, lds);
#endif
#endif
        GRID_BAR();
#if DBG == 1
        if (layer == DBG_L) { if (DBG_MASK & 2) dbg_check_attn(F, P, layer); if (DBG_MASK & 4) dbg_expect_rows(F, P, layer, 0); GRID_BAR(); }
#endif
        {
            pg8::PlainSched S; S.init(NLAT / 256, D / 256, F.G, (int)blockIdx.x); S.A = (const char*)cat; S.Bt = (const char*)(ws + WS_WOUT + layer * SZ_WOUT); S.tstep = (size_t)256 * D * 2;
#if EN_WOUT
            if (layer == 0) { pg8::EpiResidT<false> E{resLat, resCtx, xl, modl + 2 * D}; pg8::gemm_phase<pg8::EpiResidT<false>, pg8::PlainSched, GEMM_AE, GEMM_SP2>(F.lds + RING_OFF, D, S, E, F.wave); }
            else { pg8::EpiResidT<true> E{resLat, resCtx, xl, modl + 2 * D}; pg8::gemm_phase<pg8::EpiResidT<true>, pg8::PlainSched, GEMM_AE, GEMM_SP2>(F.lds + RING_OFF, D, S, E, F.wave); }
            if (layer == 0) {
                __syncthreads();
                pg8::CtxSplitSched C; C.nN = D / 256; C.nS = 8; C.G = F.G; C.c = (int)blockIdx.x; C.A = (const char*)cat; C.Bt = S.Bt; C.tstep = S.tstep; C.kslice = (size_t)(D / 8) * 2;
                pg8::EpiPartial EP{(float*)(ws + WS_PART)};
                pg8::gemm_phase<pg8::EpiPartial, pg8::CtxSplitSched, GEMM_AE, GEMM_SP2>(F.lds + RING_OFF, D, C, EP, F.wave, D / 8 / 64);
            }
#endif
        }
        GRID_BAR();
#if DBG == 1
        if ((DBG_MASK & 4) && layer == DBG_L) { dbg_compare_rows(F, P, layer, 0); }
        if ((DBG_MASK & 8) && layer == 0) { dbg_expect_rows(F, P, layer, 1); GRID_BAR(); }
#endif
        if (layer == 0) {
            norm_phase<false, I8_GU ? 2 : 1, true, false>(F, xl, P.in[I_CTX], P.in[I_GFFN], modl, 3, 4, hb, T, nullptr, nullptr, nullptr, nullptr, nullptr,
                              (const float*)(ws + WS_PART), 8, modl + (size_t)(2 * 6 + 2) * D, xl, (float*)(ws + WS_HS));
            GRID_BAR();
            {
                pg8::PlainSched S; S.init(T / 256, 2 * FFD / 256, F.G, (int)blockIdx.x); S.A = (const char*)hb; S.Bt = (const char*)(ws + WS_WGU); S.tstep = (size_t)256 * D;
                pg8::EpiSwiGLU8 E{ws + WS_ACT, FFD};
#if EN_GU
#if I8_GU
                pg8::gemm_phase<pg8::EpiSwiGLU8, pg8::PlainSched, GEMM_AE, GEMM_SP2, 2>(F.lds + RING_OFF, D / 2, S, E, F.wave, 0, 0, 0, (const float*)(ws + WS_HS), (const float*)(ws + WS_CS) + CS_WGU);
                TAIL_SLOT(RM_C, (int)blockIdx.x, IPW_G, DP_C0);
#else
                pg8::gemm_phase<pg8::EpiSwiGLU8, pg8::PlainSched, GEMM_AE, GEMM_SP2, 1>(F.lds + RING_OFF, D / 2, S, E, F.wave, 0, W8_SC8, 0x7F7F7F7F);
#endif
#endif
            }
            GRID_BAR();
            {
                pg8::PlainSched S; S.init(NLAT / 256, D / 256, F.G, (int)blockIdx.x); S.A = (const char*)(ws + WS_ACT); S.Bt = (const char*)(ws + WS_WDN); S.tstep = (size_t)256 * FFD;
                pg8::EpiResidT<true> E{xl, xl + (size_t)NLAT * D, xl, modl + 5 * D};
#if EN_DN
                pg8::gemm_phase<pg8::EpiResidT<true>, pg8::PlainSched, GEMM_AE, GEMM_SP2, 1>(F.lds + RING_OFF, FFD / 2, S, E, F.wave, 0, W8_SC8, pg8::ACT_SC8);
#if !NO_DNSPLIT
                {
                    __syncthreads();
                    pg8::CtxSplitSched C; C.nN = D / 256; C.nS = 11; C.G = F.G; C.c = (int)blockIdx.x; C.A = S.A; C.Bt = S.Bt; C.tstep = S.tstep; C.kslice = (size_t)512;
                    pg8::EpiPartial EP{(float*)(ws + WS_PART)};
                    pg8::gemm_phase<pg8::EpiPartial, pg8::CtxSplitSched, GEMM_AE, GEMM_SP2, 1>(F.lds + RING_OFF, FFD / 2, C, EP, F.wave, 4, W8_SC8, pg8::ACT_SC8);
                }
#endif
#endif
            }
            GRID_BAR();
#if DBG == 1
            if (DBG_MASK & 8) dbg_compare_rows(F, P, layer, 1);
#endif
        } else {
#if EN_ROUTE
#if MOE_SPARSE
            norm_phase<true, 2, GEMM_AE, GEMM_SP2>(F, xl, xl + (size_t)NLAT * D, P.in[I_GFFN] + D, modl, 3, 4, (bf16*)(ws + WS_AG), NLAT, P.in[I_RW], P.in[I_RB], tok_e, tok_slot, tok_p, nullptr, 0, nullptr, nullptr, (float*)(ws + WS_AGS2));
            if (slots) deferred_rest(F, P, DP_END);
#else
            norm_phase<true, I8_GU ? 2 : 1, GEMM_AE, GEMM_SP2>(F, xl, xl + (size_t)NLAT * D, P.in[I_GFFN] + D, modl, 3, 4, hb, NLAT, P.in[I_RW], P.in[I_RB], tok_e, tok_slot, tok_p, nullptr, 0, nullptr, nullptr, (float*)(ws + WS_HS));
#endif
#endif
            GRID_BAR();
#if !MOE_SPARSE
#if EN_GATH
            moe_gather_phase(F, P);
#endif
#if DEFER
            if (slots) { __syncthreads(); deferred_rest(F, P, DP_END); }
#endif
            GRID_BAR();
#endif
            {
                const MoePanels mp = moe_panels(F);
                pg8::MoeSched S; S.init(mp.ps[8], 2 * FFE / 256, F.G, (int)blockIdx.x); S.A = (const char*)(ws + WS_AG); S.Bt = (const char*)(ws + WS_MGU); S.tstep = (size_t)256 * D; S.estride = SZ_MGU / 2; S.erows = 2 * FFE; S.sparse = MOE_SPARSE; S.caprows = NLAT;
                S.ps1 = mp.ps[1]; S.ps2 = mp.ps[2]; S.ps3 = mp.ps[3]; S.ps4 = mp.ps[4]; S.ps5 = mp.ps[5]; S.ps6 = mp.ps[6]; S.ps7 = mp.ps[7];
                pg8::EpiSwiGLU8 E{ws + WS_MACT, FFE};
#if EN_MGU
#if I8_GU
                pg8::gemm_phase<pg8::EpiSwiGLU8, pg8::MoeSched, GEMM_AE, GEMM_SP2, 2>(F.lds + RING_OFF, D / 2, S, E, F.wave, 0, 0, 0, (const float*)(ws + (MOE_SPARSE ? WS_AGS2 : WS_AGS)), (const float*)(ws + WS_CS) + CS_MGU);
#else
                pg8::gemm_phase<pg8::EpiSwiGLU8, pg8::MoeSched, GEMM_AE, GEMM_SP2, 1>(F.lds + RING_OFF, D / 2, S, E, F.wave, 0, W8_SC8, 0x7F7F7F7F);
#endif
#endif
            }
            GRID_BAR();
            {
                const MoePanels mp = moe_panels(F);
                pg8::MoeSched S; S.init(mp.ps[8], D / 256, F.G, (int)blockIdx.x); S.A = (const char*)(ws + WS_MACT); S.Bt = (const char*)(ws + WS_MDN); S.tstep = (size_t)256 * FFE; S.estride = SZ_MDN / 2; S.erows = D; S.sparse = 0; S.caprows = 0;
                S.ps1 = mp.ps[1]; S.ps2 = mp.ps[2]; S.ps3 = mp.ps[3]; S.ps4 = mp.ps[4]; S.ps5 = mp.ps[5]; S.ps6 = mp.ps[6]; S.ps7 = mp.ps[7];
                pg8::EpiBf16 E{(bf16*)(ws + WS_AG), D};
#if EN_MDN
                pg8::gemm_phase<pg8::EpiBf16, pg8::MoeSched, GEMM_AE, GEMM_SP2, 1>(F.lds + RING_OFF, FFE / 2, S, E, F.wave, 0, W8_SC8, pg8::ACT_SC8);
#endif
            }
            GRID_BAR();
#if EN_FIN
            final_phase(F, P, modl);
#if DUP_FIN
            final_phase(F, P, modl);
#endif
#endif
#if PROBE
            {
                typedef int v8i_ __attribute__((ext_vector_type(8)));
                const int role = (F.wave < 4) ? (PROBE == 1 || PROBE == 2 || PROBE == 4 ? 1 : (PROBE == 3 ? 2 : 0)) : (PROBE == 1 ? 1 : (PROBE == 2 || PROBE == 3 || PROBE == 5 ? 2 : 0));
                f32x16 c0 = {}, c1 = {}, c2 = {}, c3 = {}; v8i_ a = {0x38383838, 0x38383838, 0x38383838, 0x38383838, 0x38383838, 0x38383838, 0x38383838, 0x38383838};
                float x0 = 1.0f, x1 = 2.0f, x2 = 3.0f, x3 = 4.0f;
                for (int it = 0; it < 2000; ++it) {
                    if (role == 1) {
#pragma unroll
                        for (int q = 0; q < 2; ++q) {
                            c0 = __builtin_amdgcn_mfma_scale_f32_32x32x64_f8f6f4(a, a, c0, 0, 0, 0, 0x7F7F7F7F, 0, 0x7F7F7F7F); c1 = __builtin_amdgcn_mfma_scale_f32_32x32x64_f8f6f4(a, a, c1, 0, 0, 0, 0x7F7F7F7F, 0, 0x7F7F7F7F);
                            c2 = __builtin_amdgcn_mfma_scale_f32_32x32x64_f8f6f4(a, a, c2, 0, 0, 0, 0x7F7F7F7F, 0, 0x7F7F7F7F); c3 = __builtin_amdgcn_mfma_scale_f32_32x32x64_f8f6f4(a, a, c3, 0, 0, 0, 0x7F7F7F7F, 0, 0x7F7F7F7F); }
                    } else if (role == 2) {
#pragma unroll
                        for (int q = 0; q < 32; ++q) asm volatile("v_fma_f32 %0, %0, %0, %0\n\tv_fma_f32 %1, %1, %1, %1\n\tv_fma_f32 %2, %2, %2, %2\n\tv_fma_f32 %3, %3, %3, %3" : "+v"(x0), "+v"(x1), "+v"(x2), "+v"(x3));
                    }
                }
                asm volatile("" :: "v"(c0), "v"(c1), "v"(c2), "v"(c3), "v"(x0), "v"(x1), "v"(x2), "v"(x3));
            }
#endif
#if DBG == 1
            GRID_BAR(); if (DBG_MASK & 16) dbg_check_moe(F, P); GRID_BAR(); dbg_report(F, P);
#endif
#if DBG == 2
            GRID_BAR();
            { const int tid = fresh_tid(F.wave);
              for (size_t i = (size_t)F.vcu * 512 + tid; i < (size_t)NLAT * D; i += (size_t)F.G * 512) P.out[i] = 0.f;
              __syncthreads(); GRID_BAR();
              float A = 0.f, B = 0.f;
              for (int i = 0; i + 1 < nst - 1; ++i) { const float d = (float)(tsb[i + 1] - tsb[i]) * 0.01f; if ((TSEL_A >> i) & 1ull) A += d; if ((TSEL_B >> i) & 1ull) B += d; }
              for (size_t i = (size_t)F.vcu * 512 + tid; i < 1000001; i += (size_t)F.G * 512) P.out[i] = i == 0 ? A : 10.0f * B; }
#endif
        }
    }
}

extern "C" void kernel_launch(void* const* d_in, const int* in_sizes, int n_in, void* d_out, int out_size, void* d_ws, size_t ws_size, hipStream_t stream) {
    static int grid = 0;
    if (grid == 0) {
        if (n_in != 28 || in_sizes[0] != NLAT * D || out_size != NLAT * D || ws_size < WS_END) {
            fprintf(stderr, "kernel_launch: built for 28 inputs, x/out of %d floats, >= %zu bytes of workspace; got n_in %d, in0 %d, out %d, ws %zu; nothing launched\n", NLAT * D, (size_t)WS_END, n_in, n_in > 0 ? in_sizes[0] : -1, out_size, ws_size);
            grid = -1; return; }
        int dev = 0, cus = 0, per_cu = 0;
        if (hipGetDevice(&dev) != hipSuccess || hipDeviceGetAttribute(&cus, hipDeviceAttributeMultiprocessorCount, dev) != hipSuccess) { fprintf(stderr, "kernel_launch: device query failed\n"); grid = -1; return; }
        if (hipFuncSetAttribute((const void*)fwd_kernel, hipFuncAttributeMaxDynamicSharedMemorySize, LDS_BYTES) != hipSuccess) { fprintf(stderr, "kernel_launch: hipFuncSetAttribute failed\n"); grid = -1; return; }
        if (hipOccupancyMaxActiveBlocksPerMultiprocessor(&per_cu, (const void*)fwd_kernel, NWAVES * 64, LDS_BYTES) != hipSuccess || per_cu < 1)
            fprintf(stderr, "kernel_launch: note: occupancy query reports %d workgroups per CU\n", per_cu);
        (void)hipGetLastError();
        grid = cus;
    }
    if (grid < 0) return;
    if (hipMemsetAsync((char*)d_ws + WS_CTL, 0, CTL_ZERO_BYTES, stream) != hipSuccess) { fprintf(stderr, "kernel_launch: memset failed\n"); return; }
    Params p{};
    for (int i = 0; i < 28; ++i) p.in[i] = (const float*)d_in[i];
    p.out = (float*)d_out; p.ws = (unsigned char*)d_ws;
    hipLaunchKernelGGL(fwd_kernel, dim3(grid), dim3(NWAVES * 64), LDS_BYTES, stream, p);
    const hipError_t le = hipPeekAtLastError();
    if (le != hipSuccess) fprintf(stderr, "kernel_launch: launch failed: %s\n", hipGetErrorName(le));
}
```
